# Optimizing an MI355X kernel written in HIP

```python
import jax, jax.numpy as jnp
from jax import lax
import numpy as np

D_MODEL = 2048
BATCH = 2
SEQ = 16384
DEPTH = 2

N_MIXERS = 2
N_POOL_LAYERS = (DEPTH + 1) // 2
N_DSA_LAYERS = DEPTH // 2
POOL_WINDOWS = (2, 4, 8, 16)
N_POOL_GROUPS = 4
POOL_GROUP = D_MODEL // N_POOL_GROUPS
HEAD_DIM = 128
N_HEADS = D_MODEL // HEAD_DIM
N_KV_HEADS = 4
KV_GROUP = N_HEADS // N_KV_HEADS
IDX_HEADS = 16
IDX_DIM = 128
INDEX_TOPK = 256
Q_BLOCK = 128
ROPE_THETA = 500000.0
ROT_DIM = HEAD_DIM // 4
Q_COLS = N_HEADS * HEAD_DIM
K_COLS = N_KV_HEADS * HEAD_DIM
V_COLS = N_KV_HEADS * HEAD_DIM
IQ_COLS = IDX_HEADS * IDX_DIM
IK_COLS = IDX_DIM
IW_COLS = IDX_HEADS
DSA_IN = Q_COLS + K_COLS + V_COLS + IQ_COLS + IK_COLS + IW_COLS
N_MEM = 256
XATTN_HEADS = 4
XATTN_DIM = 128
XATTN_WIDTH = XATTN_HEADS * XATTN_DIM
D_FF = ((8 * D_MODEL + 3 * 256 - 1) // (3 * 256)) * 256
NORM_EPS = 1e-6

kernel_name = "hybrid_pool_dsa_memxattn_block"


def rms_norm(x, g):
    xf = x.astype(jnp.float32)
    y = xf * lax.rsqrt(jnp.mean(xf * xf, axis=-1, keepdims=True) + NORM_EPS)
    return (y * g.astype(jnp.float32)).astype(x.dtype)


def rope_tables(positions):
    inv = ROPE_THETA ** (-jnp.arange(0, ROT_DIM, 2, dtype=jnp.float32) / ROT_DIM)
    ang = positions.astype(jnp.float32)[..., None] * inv
    return jnp.cos(ang), jnp.sin(ang)


def apply_partial_rope(x, cos, sin):
    half = ROT_DIM // 2
    xr = x[..., :ROT_DIM].astype(jnp.float32)
    x1, x2 = xr[..., :half], xr[..., half:]
    c = cos[:, :, None, :]
    s = sin[:, :, None, :]
    rot = jnp.concatenate([x1 * c - x2 * s, x2 * c + x1 * s], axis=-1).astype(x.dtype)
    return jnp.concatenate([rot, x[..., ROT_DIM:]], axis=-1)


def pool_mixer(xn, w_group, scale):
    B, S, D = xn.shape
    xf = xn.astype(jnp.float32).reshape(B, S, N_POOL_GROUPS, POOL_GROUP)
    cs = jnp.cumsum(xf, axis=1)
    t = jnp.arange(S)
    outs = []
    for g, win in enumerate(POOL_WINDOWS):
        c = cs[:, :, g]
        lag = jnp.pad(c[:, :S - win], ((0, 0), (win, 0), (0, 0)))
        cnt = jnp.minimum(t + 1, win).astype(jnp.float32)[None, :, None]
        outs.append((c - lag) / cnt - xf[:, :, g])
    p = jnp.stack(outs, axis=2).astype(xn.dtype)
    y = jnp.einsum('bsgc,gcd->bsgd', p, w_group).reshape(B, S, D)
    return y * scale


def dsa_mixer(xn, w_in, w_out, cos, sin):
    B, S, D = xn.shape
    proj = xn @ w_in
    splits = [Q_COLS, Q_COLS + K_COLS, Q_COLS + K_COLS + V_COLS,
              Q_COLS + K_COLS + V_COLS + IQ_COLS,
              Q_COLS + K_COLS + V_COLS + IQ_COLS + IK_COLS]
    q, k, v, iq, ik, iw = jnp.split(proj, splits, axis=-1)
    q = apply_partial_rope(q.reshape(B, S, N_HEADS, HEAD_DIM), cos, sin)
    k = apply_partial_rope(k.reshape(B, S, N_KV_HEADS, HEAD_DIM), cos, sin)
    v = v.reshape(B, S, N_KV_HEADS, HEAD_DIM)
    iq = apply_partial_rope(iq.reshape(B, S, IDX_HEADS, IDX_DIM), cos, sin)
    ik = apply_partial_rope(ik.reshape(B, S, 1, IDX_DIM), cos, sin)[:, :, 0]
    iw = iw.astype(jnp.float32) * (IDX_HEADS ** -0.5)
    topk = min(INDEX_TOPK, S // 4)
    n_blocks = S // Q_BLOCK
    key_pos = jnp.arange(S)

    def block(i):
        start = i * Q_BLOCK
        qb = lax.dynamic_slice_in_dim(q, start, Q_BLOCK, axis=1)
        iqb = lax.dynamic_slice_in_dim(iq, start, Q_BLOCK, axis=1)
        iwb = lax.dynamic_slice_in_dim(iw, start, Q_BLOCK, axis=1)
        qpos = start + jnp.arange(Q_BLOCK)
        logits = jnp.einsum('bqhd,bsd->bqhs', iqb, ik).astype(jnp.float32) * (IDX_DIM ** -0.5)
        score = jnp.einsum('bqhs,bqh->bqs', jax.nn.relu(logits), iwb)
        causal = key_pos[None, :] <= qpos[:, None]
        score = jnp.where(causal[None], score, -jnp.inf)
        _, idx = lax.top_k(score, topk)
        valid = idx <= qpos[None, :, None]
        kg = jax.vmap(lambda kb, ib: kb[ib])(k, idx)
        vg = jax.vmap(lambda vb, ib: vb[ib])(v, idx)
        qg = qb.reshape(B, Q_BLOCK, N_KV_HEADS, KV_GROUP, HEAD_DIM)
        s = jnp.einsum('bqhgd,bqnhd->bqhgn', qg, kg).astype(jnp.float32) * (HEAD_DIM ** -0.5)
        s = jnp.where(valid[:, :, None, None, :], s, -jnp.inf)
        p = jax.nn.softmax(s, axis=-1).astype(vg.dtype)
        o = jnp.einsum('bqhgn,bqnhd->bqhgd', p, vg)
        return o.reshape(B, Q_BLOCK, Q_COLS)

    o = lax.map(block, jnp.arange(n_blocks))
    o = jnp.moveaxis(o, 0, 1).reshape(B, S, Q_COLS)
    return o @ w_out


def memory_xattn(hn, mem_n, wq, wkv, wo):
    B, S, _ = hn.shape
    M = mem_n.shape[1]
    q = (hn @ wq).reshape(B, S, XATTN_HEADS, XATTN_DIM)
    km, vm = jnp.split(mem_n @ wkv, 2, axis=-1)
    km = km.reshape(B, M, XATTN_HEADS, XATTN_DIM)
    vm = vm.reshape(B, M, XATTN_HEADS, XATTN_DIM)
    s = jnp.einsum('bshd,bmhd->bhsm', q, km).astype(jnp.float32) * (XATTN_DIM ** -0.5)
    p = jax.nn.softmax(s, axis=-1).astype(vm.dtype)
    o = jnp.einsum('bhsm,bmhd->bshd', p, vm).reshape(B, S, XATTN_WIDTH)
    return o @ wo


def swiglu(hn, w_gate_up, w_down):
    g, u = jnp.split(hn @ w_gate_up, 2, axis=-1)
    return (jax.nn.silu(g) * u) @ w_down


def setup_inputs(seed: int = 0) -> dict:
    key = jax.random.key(seed)
    ks = jax.random.split(key, 16)
    f32 = jnp.float32
    D = D_MODEL
    x = jax.random.normal(ks[0], (BATCH, SEQ, D), f32)
    mem = jax.random.normal(ks[1], (BATCH, N_MEM, D), f32)
    offset = jax.random.randint(ks[2], (BATCH, 1), 0, 4096, dtype=jnp.int32)
    positions = (offset + jnp.arange(SEQ, dtype=jnp.int32)[None, :]).astype(jnp.int32)
    norm_gains = 1.0 + 0.02 * jax.random.normal(ks[3], (DEPTH, 6, D), f32)
    mem_norm = 1.0 + 0.02 * jax.random.normal(ks[4], (D,), f32)
    pool_w = jax.random.normal(ks[5], (N_POOL_LAYERS, N_POOL_GROUPS, POOL_GROUP, POOL_GROUP), f32) * POOL_GROUP ** -0.5
    pool_scale = 1.0 + 0.02 * jax.random.normal(ks[6], (N_POOL_LAYERS, D), f32)
    dsa_w_in = jax.random.normal(ks[7], (N_DSA_LAYERS, D, DSA_IN), f32) * D ** -0.5
    dsa_w_out = jax.random.normal(ks[8], (N_DSA_LAYERS, Q_COLS, D), f32) * Q_COLS ** -0.5
    xattn_wq = jax.random.normal(ks[9], (DEPTH, D, XATTN_WIDTH), f32) * D ** -0.5
    xattn_wkv = jax.random.normal(ks[10], (DEPTH, D, 2 * XATTN_WIDTH), f32) * D ** -0.5
    xattn_wo = jax.random.normal(ks[11], (DEPTH, XATTN_WIDTH, D), f32) * XATTN_WIDTH ** -0.5
    ffn_w_gate_up = jax.random.normal(ks[12], (DEPTH, D, 2 * D_FF), f32) * D ** -0.5
    ffn_w_down = jax.random.normal(ks[13], (DEPTH, D_FF, D), f32) * D_FF ** -0.5
    return {"x": x, "mem": mem, "positions": positions, "norm_gains": norm_gains,
            "mem_norm": mem_norm, "pool_w": pool_w, "pool_scale": pool_scale,
            "dsa_w_in": dsa_w_in, "dsa_w_out": dsa_w_out, "xattn_wq": xattn_wq,
            "xattn_wkv": xattn_wkv, "xattn_wo": xattn_wo,
            "ffn_w_gate_up": ffn_w_gate_up, "ffn_w_down": ffn_w_down}


def reference(x, mem, positions, norm_gains, mem_norm, pool_w, pool_scale, dsa_w_in,
              dsa_w_out, xattn_wq, xattn_wkv, xattn_wo, ffn_w_gate_up, ffn_w_down):
    cos, sin = rope_tables(positions)
    mem_n = rms_norm(mem, mem_norm)
    h = x
    for i in range(DEPTH):
        g = norm_gains[i]
        a = rms_norm(h, g[0])
        if i % N_MIXERS == 0:
            a = pool_mixer(a, pool_w[i // N_MIXERS], pool_scale[i // N_MIXERS])
        else:
            a = dsa_mixer(a, dsa_w_in[i // N_MIXERS], dsa_w_out[i // N_MIXERS], cos, sin)
        h = h + rms_norm(a, g[1])
        c = memory_xattn(rms_norm(h, g[2]), mem_n, xattn_wq[i], xattn_wkv[i], xattn_wo[i])
        h = h + rms_norm(c, g[3])
        f = swiglu(rms_norm(h, g[4]), ffn_w_gate_up[i], ffn_w_down[i])
        h = h + rms_norm(f, g[5])
    return h
```

```cpp
#include <hip/hip_runtime.h>
#include <cstdio>
#include <cstdint>
#include <cmath>

#define LAS __attribute__((address_space(3)))
#define GAS __attribute__((address_space(1)))
typedef _Float16 h16;
typedef _Float16 half8 __attribute__((ext_vector_type(8)));
typedef _Float16 half4 __attribute__((ext_vector_type(4)));
typedef _Float16 half2v __attribute__((ext_vector_type(2)));
typedef float f32x4 __attribute__((ext_vector_type(4)));
typedef float f32x2 __attribute__((ext_vector_type(2)));
typedef float f32x16 __attribute__((ext_vector_type(16)));
typedef unsigned u32x4 __attribute__((ext_vector_type(4)));
typedef unsigned u32x2 __attribute__((ext_vector_type(2)));
typedef int v4i32 __attribute__((ext_vector_type(4)));
typedef int v8i32 __attribute__((ext_vector_type(8)));

__device__ __forceinline__ unsigned pkh(float a, float b) { half2v v; v.x = (h16)a; v.y = (h16)b; return __builtin_bit_cast(unsigned, v); }

__device__ __forceinline__ unsigned pk8(float a, float b, float c, float d) { int w = __builtin_amdgcn_cvt_pk_fp8_f32(a, b, 0, false); w = __builtin_amdgcn_cvt_pk_fp8_f32(c, d, w, true); return (unsigned)w; }

constexpr int SEQ = 16384, NKV = 4, HD = 128;
namespace pg8 {
#define PG8_LAS __attribute__((address_space(3)))
constexpr int BM = 256, BK = 64, HALF = 128, HTB = HALF * BK * 2  , STAGE_BYTES = 8 * HTB, NXCD = 8, WGM = 8;

__host__ __device__ __forceinline__ int lds_byte(int r, int c) { const int st = (r >> 4) * 2 + (c >> 5), rr = r & 15, cc = c & 31, ob = rr * 64 + cc * 2; return st * 1024 + (ob ^ (((ob >> 9) & 1) << 5)); }
__host__ __device__ __forceinline__ void stage_rc(int b, int& R, int& C) { const int st = b / 1024, sb = b % 1024, swz = sb ^ (((sb >> 9) & 1) << 5); R = (st >> 1) * 16 + swz / 64; C = (st & 1) * 32 + (swz % 64) / 2; }
__host__ __device__ __forceinline__ int perm32(int rho) { const int n = rho >> 4, i = rho & 15; return 8 * (i >> 2) + 4 * n + (i & 3); }

struct Unit { int pm, pn; };
struct Gemm { const h16* A; const h16* Bt; int M, N, K, lda, kshift; };

struct StaticOrder {
    int nM, nN, nwg, G, c;
    __host__ __device__ void init(int M, int N, int G_, int c_) { nM = M / BM; nN = N / BM; nwg = nM * nN; G = G_; c = c_; }
    __host__ __device__ bool next(int i, Unit& u) const {
        const long L = (long)i * G + c; if (L >= nwg) return false;
        int wgid = (int)L; { const int q = nwg / NXCD, r = nwg % NXCD, xcd = wgid % NXCD, off = wgid / NXCD; wgid = (xcd < r ? xcd * (q + 1) : r * (q + 1) + (xcd - r) * q) + off; }
        const int nig = WGM * nN, gid = wgid / nig, fm = gid * WGM, gsz = (nM - fm) < WGM ? (nM - fm) : WGM;
        u.pm = fm + ((wgid % nig) % gsz); u.pn = (wgid % nig) / gsz; return true;
    }
    __device__ __forceinline__ void a_ready(const Unit&) const {}
    __device__ __forceinline__ void done(const Unit&) const {}
};

struct EpiF32 {
    static constexpr bool PERM = false, AFTER_DRAIN = false;
    float* C; int ldc; float scale;
    __device__ __forceinline__ void operator()(const f32x4 (&acc)[2][2][4][2], const Unit& u, int wr, int wc, int fr, int fq) const {
        const int row0 = u.pm * BM + wr * 64 + fr, col0 = u.pn * BM + wc * 32 + 4 * fq;
#pragma unroll
        for (int ai = 0; ai < 2; ++ai)
#pragma unroll
            for (int m = 0; m < 4; ++m) { float* rowp = C + (size_t)(row0 + ai * HALF + m * 16) * ldc + col0;
#pragma unroll
                for (int bj = 0; bj < 2; ++bj)
#pragma unroll
                    for (int n = 0; n < 2; ++n) *(f32x4*)(rowp + bj * HALF + n * 16) = acc[ai][bj][m][n] * scale; }
    }
};
struct EpiF32S {
    static constexpr bool PERM = false, AFTER_DRAIN = false;
    float* C; int ldc; float scale;
    __device__ __forceinline__ void operator()(const f32x4 (&acc)[2][2][4][2], const Unit& u, int wr, int wc, int fr_, int fq_) const {
        int l = (int)(threadIdx.x & 63u); asm volatile("" : "+v"(l)); const int fr = l & 15, fq = l >> 4;
        const int row0 = u.pm * BM + wr * 64 + fr, col0 = u.pn * BM + wc * 32 + 4 * fq;
#pragma unroll
        for (int ai = 0; ai < 2; ++ai)
#pragma unroll
            for (int m = 0; m < 4; ++m) { float* rowp = C + (size_t)(row0 + ai * HALF + m * 16) * ldc + col0;
#pragma unroll
                for (int bj = 0; bj < 2; ++bj)
#pragma unroll
                    for (int n = 0; n < 2; ++n) *(f32x4*)(rowp + bj * HALF + n * 16) = acc[ai][bj][m][n] * scale; }
    }
};
struct EpiH16 {
    static constexpr bool PERM = true, AFTER_DRAIN = false;
    h16* O; int ldc; float scale;
    __device__ __forceinline__ void operator()(const f32x4 (&acc)[2][2][4][2], const Unit& u, int wr, int wc, int fr, int fq) const {
        const int row0 = u.pm * BM + wr * 64 + fr, col0 = u.pn * BM + wc * 32 + 8 * fq;
#pragma unroll
        for (int ai = 0; ai < 2; ++ai)
#pragma unroll
            for (int m = 0; m < 4; ++m) { h16* rowp = O + (size_t)(row0 + ai * HALF + m * 16) * ldc + col0;
#pragma unroll
                for (int bj = 0; bj < 2; ++bj) { const f32x4 v0 = acc[ai][bj][m][0] * scale, v1 = acc[ai][bj][m][1] * scale;
                    u32x4 w; w.x = pkh(v0[0], v0[1]); w.y = pkh(v0[2], v0[3]); w.z = pkh(v1[0], v1[1]); w.w = pkh(v1[2], v1[3]);
                    *(u32x4*)(rowp + bj * HALF) = w; } }
    }
};
__device__ __forceinline__ float silu_mul(float g, float u) { return g * u * __builtin_amdgcn_rcpf(1.0f + __builtin_amdgcn_exp2f(g * -1.44269504089f)); }
struct EpiSwiGLU {
    static constexpr bool PERM = true, AFTER_DRAIN = false;
    h16* O; int ldc;
    __device__ __forceinline__ void operator()(const f32x4 (&acc)[2][2][4][2], const Unit& u, int wr, int wc, int fr, int fq) const {
        const int row0 = u.pm * BM + wr * 64 + fr, col0 = u.pn * HALF + wc * 32 + 8 * fq;
#pragma unroll
        for (int ai = 0; ai < 2; ++ai)
#pragma unroll
            for (int m = 0; m < 4; ++m) { h16* rowp = O + (size_t)(row0 + ai * HALF + m * 16) * ldc + col0;
                const f32x4 g0 = acc[ai][0][m][0], g1 = acc[ai][0][m][1], u0 = acc[ai][1][m][0], u1 = acc[ai][1][m][1];
                u32x4 w; w.x = pkh(silu_mul(g0[0], u0[0]), silu_mul(g0[1], u0[1])); w.y = pkh(silu_mul(g0[2], u0[2]), silu_mul(g0[3], u0[3]));
                w.z = pkh(silu_mul(g1[0], u1[0]), silu_mul(g1[1], u1[1])); w.w = pkh(silu_mul(g1[2], u1[2]), silu_mul(g1[3], u1[3]));
                *(u32x4*)rowp = w; }
    }
};
struct EpiSwiGLU8 {
    static constexpr bool PERM = true, AFTER_DRAIN = false;
    unsigned char* O; int ldc; float inscale, outscale;
    __device__ __forceinline__ void operator()(const f32x4 (&acc)[2][2][4][2], const Unit& u, int wr, int wc, int fr_, int fq_) const {
        int l = (int)(threadIdx.x & 63u); asm volatile("" : "+v"(l)); const int fr = l & 15, fq = l >> 4;
        const int row0 = u.pm * BM + wr * 64 + fr, col0 = u.pn * HALF + wc * 32 + 8 * fq;
#pragma unroll
        for (int ai = 0; ai < 2; ++ai)
#pragma unroll
            for (int m = 0; m < 4; ++m) { unsigned char* rowp = O + (size_t)(row0 + ai * HALF + m * 16) * ldc + col0;
                const f32x4 g0 = acc[ai][0][m][0] * inscale, g1 = acc[ai][0][m][1] * inscale, u0 = acc[ai][1][m][0] * (inscale * outscale), u1 = acc[ai][1][m][1] * (inscale * outscale);
                u32x2 w; w.x = pk8(silu_mul(g0[0], u0[0]), silu_mul(g0[1], u0[1]), silu_mul(g0[2], u0[2]), silu_mul(g0[3], u0[3]));
                w.y = pk8(silu_mul(g1[0], u1[0]), silu_mul(g1[1], u1[1]), silu_mul(g1[2], u1[2]), silu_mul(g1[3], u1[3]));
                *(u32x2*)rowp = w; }
    }
};
struct EpiInProj {
    static constexpr bool PERM = true, AFTER_DRAIN = false;
    h16 *Q, *KV, *IQ, *IK; float* IW; const float* rope; float scale;
    __device__ __forceinline__ void operator()(const f32x4 (&acc)[2][2][4][2], const Unit& u, int wr, int wc, int fr_, int fq_) const {
        int l = (int)(threadIdx.x & 63u); asm volatile("" : "+v"(l));
        const int fr = l & 15, fq = l >> 4;
        const int pn = u.pn, row0 = u.pm * BM + wr * 64 + fr;
        h16* base; int ldc, colt; bool rot0 = true, rot1 = true;
        if (pn < 8) { base = Q; ldc = 2048; colt = pn * 256; }
        else if (pn < 10) { base = KV; ldc = 1024; colt = (pn - 8) * 256; }
        else if (pn < 12) { base = KV; ldc = 1024; colt = 512 + (pn - 10) * 256; rot0 = false; rot1 = false; }
        else if (pn < 20) { base = IQ; ldc = 2048; colt = (pn - 12) * 256; }
        else { base = IK; ldc = 128; colt = 0; rot1 = false; }
        const int col0 = colt + wc * 32 + 8 * fq;
#pragma unroll
        for (int ai = 0; ai < 2; ++ai)
#pragma unroll
            for (int m = 0; m < 4; ++m) { const int row = row0 + ai * HALF + m * 16;
                f32x4 cs[2], sn[2];
                if (wc == 0) { const float* rp = rope + (size_t)row * 32 + 8 * (fq & 1);
                    cs[0] = *(const f32x4*)(rp); cs[1] = *(const f32x4*)(rp + 4); sn[0] = *(const f32x4*)(rp + 16); sn[1] = *(const f32x4*)(rp + 20);
                    if (fq < 2) { sn[0] = -sn[0]; sn[1] = -sn[1]; } }
#pragma unroll
                for (int bj = 0; bj < 2; ++bj) {
                    f32x4 v0 = acc[ai][bj][m][0] * scale, v1 = acc[ai][bj][m][1] * scale;
                    if (wc == 0 && (bj == 0 ? rot0 : rot1)) {
                        f32x4 p0, p1;
#pragma unroll
                        for (int e = 0; e < 4; ++e) { p0[e] = __shfl_xor(v0[e], 32); p1[e] = __shfl_xor(v1[e], 32); }
                        v0 = v0 * cs[0] + p0 * sn[0]; v1 = v1 * cs[1] + p1 * sn[1];
                    }
                    if (pn >= 8 && pn < 12) {
                        const int j = ((pn - 8) & 1) * 2 + bj, b = row / SEQ, tt = row % SEQ;
                        unsigned char* dst = (unsigned char*)KV + (pn >= 10 ? (size_t)16 * 1024 * 1024 : (size_t)0) + ((size_t)(b * NKV + j) * SEQ + tt) * HD + wc * 32 + 8 * fq;
                        u32x2 w; w.x = pk8(v0[0], v0[1], v0[2], v0[3]); w.y = pk8(v1[0], v1[1], v1[2], v1[3]); *(u32x2*)dst = w;
                    } else if (pn == 20 && bj == 1) {
                        if (wc == 0 && fq < 2) { float* wp = IW + (size_t)row * 16 + 8 * fq; *(f32x4*)wp = v0; *(f32x4*)(wp + 4) = v1; }
                    } else {
                        u32x4 w; w.x = pkh(v0[0], v0[1]); w.y = pkh(v0[2], v0[3]); w.z = pkh(v1[0], v1[1]); w.w = pkh(v1[2], v1[3]);
                        *(u32x4*)(base + (size_t)row * ldc + col0 + bj * HALF) = w;
                    }
                }
                asm volatile("" ::: "memory"); }
    }
};

template <class Epi, class Sched, bool ALIGN_EPI = false, bool SP2 = false, bool FP8 = false>
__device__ __forceinline__ void gemm_phase(PG8_LAS unsigned char* lds, const Gemm g, const Sched& S, const Epi& E) {
    int tid_ = (int)threadIdx.x; asm volatile("" : "+v"(tid_));
    const int tid = tid_, wid = __builtin_amdgcn_readfirstlane(tid >> 6), lane = tid & 63, wr = wid >> 2, wc = wid & 3, fr = lane & 15, fq = lane >> 4;
    const int K = g.K, nt = K / BK;
    unsigned voffA[2], voffB[2];
#pragma unroll
    for (int i = 0; i < 2; ++i) { int R, C; stage_rc(tid * 16 + i * 8192, R, C); const int Rb = Epi::PERM ? ((R & ~31) + perm32(R & 31)) : R;
        voffA[i] = (unsigned)(R * g.lda + C) * 2u; voffB[i] = (unsigned)(Rb * K + C) * 2u; }
    const size_t kstep = (size_t)(BK * 2);
    const size_t hstepA = (size_t)HALF * g.lda * 2, hstepB = (size_t)HALF * K * 2;
    const size_t tstepA = 2 * hstepA, tstepB = 2 * hstepB;
    const int kshift = g.kshift;
    const __amdgpu_buffer_rsrc_t rsrcA = __builtin_amdgcn_make_buffer_rsrc((void*)g.A, 0, 0x7fffffff, 0x00020000), rsrcB = __builtin_amdgcn_make_buffer_rsrc((void*)g.Bt, 0, 0x7fffffff, 0x00020000);
    const unsigned r64A = 64u * (unsigned)g.lda * 2u, r64B = 64u * (unsigned)K * 2u;
    const unsigned ldsw = (unsigned)wid * 1024u;
    const int aoff = lds_byte(wr * 64 + fr, fq * 8), boff = lds_byte(wc * 32 + fr, fq * 8);
#define PG8_SA(b, h) (((b) * 2 + (h)) * HTB)
#define PG8_SB(b, h) ((4 + (b) * 2 + (h)) * HTB)
#define PG8_STAGE(bufoff, gbase, voff) do { const bool isA_ = (const void*)(voff) == (const void*)voffA; _Pragma("unroll") for (int _i = 0; _i < 2; ++_i) \
        __builtin_amdgcn_raw_ptr_buffer_load_lds(isA_ ? rsrcA : rsrcB, (PG8_LAS void*)(lds + (bufoff) + ldsw + _i * 8192), 16, (int)(voff)[0], \
            (int)((unsigned)((const char*)(gbase) - (isA_ ? (const char*)g.A : (const char*)g.Bt)) + (unsigned)_i * (isA_ ? r64A : r64B)), 0, 0); } while (0)
#define PG8_LDA(dst, b, h) do { if constexpr (FP8) { _Pragma("unroll") for (int m = 0; m < 4; ++m) dst##8[m] = __builtin_shufflevector(*(const PG8_LAS v4i32*)(lds + PG8_SA(b, h) + aoff + m * 2048), *(const PG8_LAS v4i32*)(lds + PG8_SA(b, h) + aoff + m * 2048 + 1024), 0, 1, 2, 3, 4, 5, 6, 7); } \
    else { _Pragma("unroll") for (int m = 0; m < 4; ++m) _Pragma("unroll") for (int k = 0; k < 2; ++k) dst[m][k] = *(const PG8_LAS half8*)(lds + PG8_SA(b, h) + aoff + m * 2048 + k * 1024); } } while (0)
#define PG8_LDB(dst, b, h) do { if constexpr (FP8) { _Pragma("unroll") for (int n = 0; n < 2; ++n) dst##8[n] = __builtin_shufflevector(*(const PG8_LAS v4i32*)(lds + PG8_SB(b, h) + boff + n * 2048), *(const PG8_LAS v4i32*)(lds + PG8_SB(b, h) + boff + n * 2048 + 1024), 0, 1, 2, 3, 4, 5, 6, 7); } \
    else { _Pragma("unroll") for (int n = 0; n < 2; ++n) _Pragma("unroll") for (int k = 0; k < 2; ++k) dst[n][k] = *(const PG8_LAS half8*)(lds + PG8_SB(b, h) + boff + n * 2048 + k * 1024); } } while (0)
#define PG8_MMA(ai, bj, At, Bt) do { __builtin_amdgcn_s_setprio(1); _Pragma("unroll") for (int m = 0; m < 4; ++m) _Pragma("unroll") for (int n = 0; n < 2; ++n) { \
        if constexpr (FP8) asm volatile("v_mfma_f32_16x16x128_f8f6f4 %0, %1, %2, %0" : "+v"(acc[ai][bj][m][n]) : "v"(Bt##8[n]), "v"(At##8[m]));     \
        else { _Pragma("unroll") for (int k = 0; k < 2; ++k) acc[ai][bj][m][n] = __builtin_amdgcn_mfma_f32_16x16x32_f16(Bt[n][k], At[m][k], acc[ai][bj][m][n], 0, 0, 0); } } \
        __builtin_amdgcn_s_setprio(0); } while (0)
#define PG8_WAIT_V(n) asm volatile("s_waitcnt vmcnt(" #n ")" ::: "memory")
#define PG8_WAIT_L(n) asm volatile("s_waitcnt lgkmcnt(" #n ")" ::: "memory")
#define PG8_BAR __builtin_amdgcn_s_barrier()
#define PG8_SCHED __builtin_amdgcn_sched_barrier(0)
    Unit cur, nxt; int ui = 0;
    if (!S.next(0, cur)) return;
    f32x4 acc[2][2][4][2];
#pragma unroll
    for (int a = 0; a < 2; ++a)
#pragma unroll
        for (int b = 0; b < 2; ++b)
#pragma unroll
            for (int m = 0; m < 4; ++m)
#pragma unroll
                for (int n = 0; n < 2; ++n) acc[a][b][m][n] = (f32x4){0.f, 0.f, 0.f, 0.f};
    half8 At[4][2], B0[2][2], B1[2][2]; v8i32 At8[4], B08[2], B18[2];
    const char* cA = (const char*)g.A + (size_t)cur.pm * tstepA + (size_t)((cur.pn >> kshift) * K) * 2; const char* cB = (const char*)g.Bt + (size_t)cur.pn * tstepB;
    S.a_ready(cur);
    if constexpr (SP2) {
        PG8_STAGE(PG8_SB(0, 0), cB, voffB); PG8_STAGE(PG8_SB(0, 1), cB + hstepB, voffB); PG8_STAGE(PG8_SA(0, 0), cA, voffA); PG8_STAGE(PG8_SA(0, 1), cA + hstepA, voffA);
        if (wr == 1) PG8_BAR;
        PG8_WAIT_V(2); PG8_BAR;
        PG8_STAGE(PG8_SB(1, 0), cB + kstep, voffB); PG8_STAGE(PG8_SA(1, 0), cA + kstep, voffA); PG8_STAGE(PG8_SB(1, 1), cB + hstepB + kstep, voffB);
        PG8_WAIT_V(6); PG8_BAR;
    } else {
        PG8_STAGE(PG8_SB(0, 0), cB, voffB); PG8_STAGE(PG8_SA(0, 0), cA, voffA); PG8_STAGE(PG8_SB(0, 1), cB + hstepB, voffB); PG8_STAGE(PG8_SA(0, 1), cA + hstepA, voffA);
        if (wr == 1) PG8_BAR;
        PG8_WAIT_V(4); PG8_BAR;
        PG8_STAGE(PG8_SB(1, 0), cB + kstep, voffB); PG8_STAGE(PG8_SA(1, 0), cA + kstep, voffA); PG8_STAGE(PG8_SB(1, 1), cB + hstepB + kstep, voffB);
        PG8_WAIT_V(6); PG8_BAR;
    }
    for (;;) {
        const bool has_next = S.next(ui + 1, nxt);
        const char* nA = has_next ? (const char*)g.A + (size_t)nxt.pm * tstepA + (size_t)((nxt.pn >> kshift) * K) * 2 : cA; const char* nB = has_next ? (const char*)g.Bt + (size_t)nxt.pn * tstepB : cB;
        for (int t = 0; t < nt; t += 2) {
            const bool last = (t == nt - 2);
            const char* a1 = cA + (size_t)(t + 1) * kstep;
            const char* a2 = last ? nA : cA + (size_t)(t + 2) * kstep; const char* b2 = last ? nB : cB + (size_t)(t + 2) * kstep;
            const char* a3 = a2 + kstep; const char* b3 = b2 + kstep;
            if (last && has_next) S.a_ready(nxt);
            if constexpr (SP2) {
            PG8_LDB(B0, 0, 0); PG8_LDB(B1, 0, 1); PG8_SCHED; PG8_LDA(At, 0, 0); PG8_STAGE(PG8_SA(1, 1), a1 + hstepA, voffA);
            PG8_WAIT_V(8); PG8_WAIT_L(0); PG8_BAR; PG8_MMA(0, 0, At, B0); PG8_MMA(0, 1, At, B1); PG8_BAR; PG8_SCHED;
            PG8_LDA(At, 0, 1); PG8_STAGE(PG8_SB(0, 0), b2, voffB); PG8_STAGE(PG8_SB(0, 1), b2 + hstepB, voffB); PG8_STAGE(PG8_SA(0, 0), a2, voffA);
            PG8_WAIT_V(8); PG8_WAIT_L(0); PG8_BAR; PG8_MMA(1, 0, At, B0); PG8_MMA(1, 1, At, B1); PG8_BAR; PG8_SCHED;
            PG8_LDB(B0, 1, 0); PG8_LDB(B1, 1, 1); PG8_SCHED; PG8_LDA(At, 1, 0); PG8_STAGE(PG8_SA(0, 1), a2 + hstepA, voffA);
            PG8_WAIT_V(8); PG8_WAIT_L(0); PG8_BAR; PG8_MMA(0, 0, At, B0); PG8_MMA(0, 1, At, B1); PG8_BAR; PG8_SCHED;
            PG8_LDA(At, 1, 1); PG8_STAGE(PG8_SB(1, 0), b3, voffB); PG8_STAGE(PG8_SB(1, 1), b3 + hstepB, voffB); PG8_STAGE(PG8_SA(1, 0), a3, voffA);
            PG8_WAIT_V(8); PG8_WAIT_L(0); PG8_BAR; PG8_MMA(1, 0, At, B0); PG8_MMA(1, 1, At, B1); PG8_BAR; PG8_SCHED;
            } else {
            PG8_LDB(B0, 0, 0); PG8_SCHED; PG8_LDA(At, 0, 0); PG8_STAGE(PG8_SA(1, 1), a1 + hstepA, voffA);
            PG8_WAIT_L(8); PG8_BAR; PG8_WAIT_L(0); PG8_MMA(0, 0, At, B0); PG8_BAR; PG8_SCHED;
            PG8_LDB(B1, 0, 1); PG8_STAGE(PG8_SB(0, 0), b2, voffB);
            PG8_BAR; PG8_WAIT_L(0); PG8_MMA(0, 1, At, B1); PG8_BAR;
            PG8_LDA(At, 0, 1); PG8_STAGE(PG8_SA(0, 0), a2, voffA);
            PG8_BAR; PG8_WAIT_L(0); PG8_MMA(1, 0, At, B0); PG8_BAR; PG8_SCHED;
            PG8_STAGE(PG8_SB(0, 1), b2 + hstepB, voffB);
            PG8_WAIT_V(6); PG8_BAR; PG8_MMA(1, 1, At, B1); PG8_BAR;
            PG8_LDB(B0, 1, 0); PG8_SCHED; PG8_LDA(At, 1, 0); PG8_STAGE(PG8_SA(0, 1), a2 + hstepA, voffA);
            PG8_WAIT_L(8); PG8_BAR; PG8_WAIT_L(0); PG8_MMA(0, 0, At, B0); PG8_BAR; PG8_SCHED;
            PG8_LDB(B1, 1, 1); PG8_STAGE(PG8_SB(1, 0), b3, voffB);
            PG8_BAR; PG8_WAIT_L(0); PG8_MMA(0, 1, At, B1); PG8_BAR;
            PG8_LDA(At, 1, 1); PG8_STAGE(PG8_SA(1, 0), a3, voffA);
            PG8_BAR; PG8_WAIT_L(0); PG8_MMA(1, 0, At, B0); PG8_BAR; PG8_SCHED;
            PG8_STAGE(PG8_SB(1, 1), b3 + hstepB, voffB);
            PG8_WAIT_V(6); PG8_BAR; PG8_MMA(1, 1, At, B1); PG8_BAR;
            }
        }
        if constexpr (FP8) { asm volatile("s_nop 15\n\ts_nop 15\n\ts_nop 15\n\ts_nop 15" ::: "memory"); __builtin_amdgcn_sched_barrier(0); }
        if constexpr (ALIGN_EPI) { if (wr == 0) PG8_BAR; }
        if constexpr (!Epi::AFTER_DRAIN) { E(acc, cur, wr, wc, fr, fq); S.done(cur); }
        if (!has_next) break;
#pragma unroll
        for (int a = 0; a < 2; ++a)
#pragma unroll
            for (int b = 0; b < 2; ++b)
#pragma unroll
                for (int m = 0; m < 4; ++m)
#pragma unroll
                    for (int n = 0; n < 2; ++n) acc[a][b][m][n] = (f32x4){0.f, 0.f, 0.f, 0.f};
        cur = nxt; cA = nA; cB = nB; ++ui;
        if constexpr (ALIGN_EPI) { if (wr == 1) PG8_BAR; }
    }
    PG8_WAIT_V(0);
    if constexpr (!ALIGN_EPI) { if (wr == 0) PG8_BAR; }
    PG8_BAR;

#undef PG8_SA
#undef PG8_SB
#undef PG8_STAGE
#undef PG8_LDA
#undef PG8_LDB
#undef PG8_MMA
#undef PG8_WAIT_V
#undef PG8_WAIT_L
#undef PG8_BAR
#undef PG8_SCHED
}
}

constexpr int NB = 2, T = NB * SEQ, D = 2048, DFF = 5632, NMEM = 256;
constexpr int DSA_N = 5264, DSA_NP = 5376;
constexpr int NHEAD = 16, TOPK = 256;
constexpr int XW = 512;
constexpr float NORM_EPS = 1e-6f;
constexpr int NWAVES = 8;
#ifndef FFN_FP8
#define FFN_FP8 2
#endif
#ifndef DN_FP8
#define DN_FP8 3
#endif
#ifndef IDX_PROBE_MMA
#define IDX_PROBE_MMA 0
#endif
#ifndef MK_LAUNCH_PER_PHASE
#define MK_LAUNCH_PER_PHASE 0
#endif

constexpr size_t MiB = 1u << 20;
constexpr size_t WS_CTL = 0, CTL_ZERO_BYTES = 1 * MiB;
constexpr size_t WS_ROPE = 1 * MiB;
constexpr size_t WS_MEMN = 5 * MiB;
constexpr size_t WS_KVM = 7 * MiB;
constexpr size_t WS_WPOOL = 9 * MiB;
constexpr size_t WS_WIN = 11 * MiB;
constexpr size_t WS_WOUT = 32 * MiB;
constexpr size_t WS_WQ = 40 * MiB;
constexpr size_t WS_WKV = 44 * MiB;
constexpr size_t WS_WO = 52 * MiB;
constexpr size_t WS_WGU = 56 * MiB;
constexpr size_t WS_WDN = 144 * MiB;
constexpr size_t WS_XQ = 188 * MiB;
constexpr size_t WS_A = 220 * MiB;
constexpr size_t WS_Y = 348 * MiB;
constexpr size_t WS_ACT = 604 * MiB;
constexpr size_t WS_END = 956 * MiB;
constexpr size_t WS_Q = WS_ACT, WS_KV = WS_ACT + 128 * MiB, WS_IQ = WS_ACT + 192 * MiB, WS_IK = WS_ACT + 320 * MiB, WS_IW = WS_ACT + 328 * MiB, WS_IDX = WS_ACT + 330 * MiB;
constexpr size_t WS_LISTS = WS_Y;
constexpr size_t WS_H = WS_Y + 128 * MiB;
constexpr int LIST_CAP = 1024;
static_assert(WS_IDX + (size_t)T * TOPK * 2 <= WS_END, "ws map");
constexpr float W8_SCALE = 64.0f, ACT8_SCALE = 8.0f;
constexpr int CW_BAR = 4096;

constexpr int RING_OFF = 0, RING_BYTES = 136192;
constexpr int MISC_OFF = RING_BYTES;
constexpr int LDS_BYTES = 147456;

typedef GAS unsigned gu32;
#define LDS_WAIT() asm volatile("s_waitcnt lgkmcnt(0)" ::: "memory")
#define VM_WAIT() asm volatile("s_waitcnt vmcnt(0)" ::: "memory")

#define XB_TMO      128
#define XB_XCNT(j)  (256  + 64 * (j))
#define XB_XSUB(j)  (1280 + 64 * (j))
#define XB_XGEN(j)  (2304 + 64 * (j))
#define XB_TOP      3328
#define XB_TOPGEN   3392
#define XCD_BAR_WORDS 3456
#define XB_SPIN_CAP (1u << 23)
__device__ __forceinline__ unsigned xb_ld(unsigned* p)              { return __hip_atomic_load(p, __ATOMIC_RELAXED, __HIP_MEMORY_SCOPE_AGENT); }
__device__ __forceinline__ unsigned xb_add(unsigned* p, unsigned v) { return __hip_atomic_fetch_add(p, v, __ATOMIC_RELAXED, __HIP_MEMORY_SCOPE_AGENT); }
__device__ __forceinline__ unsigned xb_xcc_id() { return (unsigned)__builtin_amdgcn_s_getreg((3 << 11) | 20) & 0xFu; }
#define XB_SPIN(cond, bar) do { unsigned _sp = 0; while (cond) { __builtin_amdgcn_s_sleep(1); \
    if ((++_sp & 255u) == 0u) { if (xb_ld(&(bar)[XB_TMO])) break; if (_sp > XB_SPIN_CAP) { atomicAdd(&(bar)[XB_TMO], 1u); break; } } } } while (0)
struct XcdBarrier { unsigned* bar; unsigned x; volatile LAS unsigned* st; };
__device__ __forceinline__ XcdBarrier xcd_barrier_post(unsigned* bar, volatile LAS unsigned* st) {
    XcdBarrier b; b.bar = bar; b.x = xb_xcc_id(); b.st = st;
    if (threadIdx.x == 0) (void)xb_add(&bar[XB_XCNT(b.x)], 1u);
    return b;
}
__device__ __forceinline__ void xcd_barrier_complete(unsigned* bar, unsigned x, unsigned& nloc, unsigned& nx) {
    const unsigned G = gridDim.x * gridDim.y * gridDim.z;
    unsigned sum, cnt, mine, sp = 0u;
    for (;;) {
        sum = 0u; cnt = 0u; mine = 0u;
#pragma unroll
        for (unsigned j = 0; j < 16; ++j) { const unsigned c = xb_ld(&bar[XB_XCNT(j)]); sum += c; cnt += (c > 0u) ? 1u : 0u; mine = (j == x) ? c : mine; }
        if (sum == G) break;
        __builtin_amdgcn_s_sleep(1);
        if ((++sp & 255u) == 0u) { if (xb_ld(&bar[XB_TMO])) break; if (sp > XB_SPIN_CAP) { atomicAdd(&bar[XB_TMO], 1u); break; } }
    }
    nloc = mine > 0u ? mine : 1u; nx = cnt > 0u ? cnt : 1u;
}
__device__ __forceinline__ void xcd_barrier(const XcdBarrier& b) {
    asm volatile("s_waitcnt vmcnt(0)" ::: "memory");
    __syncthreads();
    if (threadIdx.x == 0) {
        unsigned* bar = b.bar;
        __builtin_amdgcn_s_waitcnt(0);
        unsigned nloc = b.st[0], nx = b.st[1];
        if (nloc == 0u) { xcd_barrier_complete(bar, b.x, nloc, nx); b.st[0] = nloc; b.st[1] = nx; }
        const unsigned old = xb_add(&bar[XB_XSUB(b.x)], 1u);
        const unsigned gen = old / nloc;
        if (old + 1u == (gen + 1u) * nloc) {
            __builtin_amdgcn_fence(__ATOMIC_RELEASE, "agent");
            asm volatile("s_waitcnt vmcnt(0)" ::: "memory");
            const unsigned og = xb_add(&bar[XB_TOP], 1u);
            const unsigned tg = og / nx;
            if (og + 1u == (tg + 1u) * nx) xb_add(&bar[XB_TOPGEN], 1u);
            else XB_SPIN(xb_ld(&bar[XB_TOPGEN]) == tg, bar);
            __builtin_amdgcn_fence(__ATOMIC_ACQUIRE, "agent");
            xb_add(&bar[XB_XGEN(b.x)], 1u);
            asm volatile("s_waitcnt vmcnt(0)" ::: "memory");
        } else {
            XB_SPIN(xb_ld(&bar[XB_XGEN(b.x)]) == gen, bar);
            __builtin_amdgcn_fence(__ATOMIC_ACQUIRE, "agent");
            asm volatile("s_waitcnt vmcnt(0)" ::: "memory");
        }
    }
    __syncthreads();
}

struct Frame {
    LAS unsigned char* lds;
    volatile LAS unsigned* MISC;
    int tid, lane, wave;
    int vcu, G;
};
__device__ __forceinline__ Frame fresh(const Frame& F0) { Frame F = F0; int t = (int)threadIdx.x; asm volatile("" : "+v"(t)); F.tid = t; F.lane = t & 63; F.wave = __builtin_amdgcn_readfirstlane(t >> 6); return F; }
template <int CTRL> __device__ __forceinline__ float dpp_mov(float v) { return __builtin_bit_cast(float, __builtin_amdgcn_update_dpp(0, __builtin_bit_cast(int, v), CTRL, 0xF, 0xF, true)); }
__device__ __forceinline__ float wave_sum_dpp(float v) {
    v += dpp_mov<0xB1>(v);
    v += dpp_mov<0x4E>(v);
    v += dpp_mov<0x141>(v);
    v += dpp_mov<0x140>(v);
    const float s0 = __builtin_bit_cast(float, __builtin_amdgcn_readlane(__builtin_bit_cast(int, v), 0)), s1 = __builtin_bit_cast(float, __builtin_amdgcn_readlane(__builtin_bit_cast(int, v), 16));
    const float s2 = __builtin_bit_cast(float, __builtin_amdgcn_readlane(__builtin_bit_cast(int, v), 32)), s3 = __builtin_bit_cast(float, __builtin_amdgcn_readlane(__builtin_bit_cast(int, v), 48));
    return (s0 + s1) + (s2 + s3);
}
__device__ __forceinline__ float wave_sum(float v) {
#pragma unroll
    for (int o = 1; o < 64; o <<= 1) v += __shfl_xor(v, o);
    return v;
}
__device__ __forceinline__ float rstd_of(float sumsq) { return 1.0f / sqrtf(sumsq * (1.0f / D) + NORM_EPS); }

__device__ __forceinline__ void transpose_item(const float* W, int ldw, int K, int k0, int scol, int nvalid, h16* WT, int drow, float scale, const float* colscale, bool f8, LAS float* scr, int lane) {
    const int cn = scol + (lane & 31); const bool okc = cn < nvalid;
    float wv[32];
#pragma unroll
    for (int i = 0; i < 32; ++i) { const int kk = 2 * i + (lane >> 5); wv[i] = W[(size_t)(k0 + kk) * ldw + (okc ? cn : 0)]; }
#pragma unroll
    for (int i = 0; i < 32; ++i) { const int kk = 2 * i + (lane >> 5); scr[kk * 33 + (lane & 31)] = okc ? wv[i] : 0.f; }
    LDS_WAIT(); asm volatile("" ::: "memory");
    const int c = lane & 7;
#pragma unroll
    for (int j = 0; j < 4; ++j) { const int n = (lane >> 3) + 8 * j; const LAS float* s = scr + (8 * c) * 33 + n;
        float sc = scale; if (colscale) sc *= colscale[scol + n];
        if (f8) { u32x2 o; o.x = pk8(s[0 * 33] * sc, s[1 * 33] * sc, s[2 * 33] * sc, s[3 * 33] * sc); o.y = pk8(s[4 * 33] * sc, s[5 * 33] * sc, s[6 * 33] * sc, s[7 * 33] * sc);
            *(GAS u32x2*)((unsigned char*)WT + (size_t)(drow + n) * K + k0 + 8 * c) = o; }
        else { u32x4 o; o.x = pkh(s[0 * 33] * sc, s[1 * 33] * sc); o.y = pkh(s[2 * 33] * sc, s[3 * 33] * sc); o.z = pkh(s[4 * 33] * sc, s[5 * 33] * sc); o.w = pkh(s[6 * 33] * sc, s[7 * 33] * sc);
            *(GAS u32x4*)(WT + (size_t)(drow + n) * K + k0 + 8 * c) = o; } }
    LDS_WAIT(); asm volatile("" ::: "memory");
}
struct TJob { const float* W; h16* WT; const float* colscale; int ldw, K, nrows, nvalid, mode; float scale; };
__device__ __forceinline__ int tjob_items(const TJob& j) { return (j.K / 64) * (j.nrows / 32); }
__device__ __forceinline__ void tjob_run(const TJob& j, int item, LAS float* scr, int lane) {
    const int nblk = j.nrows / 32, kb = item / nblk, r = 32 * (item % nblk);
    const int scol = (j.mode & 1) ? ((r >> 7) & 1) * DFF + 128 * (r >> 8) + (r & 127) : r;
    transpose_item(j.W, j.ldw, j.K, 64 * kb, scol, j.nvalid, j.WT, r, j.scale, j.colscale, (j.mode & 2) != 0, scr, lane);
}

struct Args {
    const float* x; const float* mem; const int* pos; const float* gains; const float* mem_norm; const float* pool_w; const float* pool_scale;
    const float* w_in; const float* w_out; const float* wq; const float* wkv; const float* wo; const float* wgu; const float* wdn;
    float* out; unsigned char* ws;
    float inv_freq[16];
    int ph_lo, ph_hi, li, pad;
};

#define CAS __attribute__((address_space(4)))
typedef const CAS Args* ArgP;
__device__ __forceinline__ ArgP argp() { unsigned long long p = (unsigned long long)__builtin_amdgcn_kernarg_segment_ptr(); asm volatile("" : "+s"(p)); return (ArgP)p; }

__device__ __forceinline__ void rope_entry(ArgP a, float* rope, int idx) {
    const int m = idx >> 4, i = idx & 15;
    const float angf = (float)a->pos[m] * a->inv_freq[i];
    const double ang = (double)angf;
    const double TWO_PI = 6.283185307179586476925286766559, INV_2PI = 0.15915494309189533576888376337251;
    const double k = __builtin_rint(ang * INV_2PI);
    const double r = ang - k * TWO_PI;
    const double r2 = r * r;
    double c = 1.0, s = 1.0, tc = 1.0, ts = 1.0;
#pragma unroll
    for (int n = 1; n <= 13; ++n) { tc *= -r2 / (double)((2 * n - 1) * (2 * n)); ts *= -r2 / (double)((2 * n) * (2 * n + 1)); c += tc; s += ts; }
    rope[(size_t)m * 32 + i] = (float)c; rope[(size_t)m * 32 + 16 + i] = (float)(s * r);
}
__device__ __forceinline__ void norm_row_to_h16(const float* xrow, const float* gain, h16* orow, int lane) {
    const f32x4* xr = (const f32x4*)xrow + lane; const f32x4* gr = (const f32x4*)gain + lane;
    f32x4 v[8]; float s = 0.f;
#pragma unroll
    for (int j = 0; j < 8; ++j) { v[j] = xr[64 * j]; s += (v[j].x * v[j].x + v[j].y * v[j].y) + (v[j].z * v[j].z + v[j].w * v[j].w); }
    const float r = rstd_of(wave_sum_dpp(s));
    u32x2* o8 = (u32x2*)orow + lane;
#pragma unroll
    for (int j = 0; j < 8; ++j) { const f32x4 g = gr[64 * j], y = v[j] * r * g; u32x2 w; w.x = pkh(y.x, y.y); w.y = pkh(y.z, y.w); o8[64 * j] = w; }
}
__device__ __forceinline__ void pool_pre(Frame& F0, const float* x, const float* g0, h16* P) {
    Frame F = fresh(F0);
    LAS float* rs = (LAS float*)(F.lds + RING_OFF);
    for (int u = F.vcu; u < T / 64; u += F.G) {
        const int b = u / (SEQ / 64), t0 = 64 * (u % (SEQ / 64));
        const float* xb = x + (size_t)b * SEQ * D;
        for (int r = F.wave; r < 79; r += NWAVES) { const int t = t0 - 15 + r;
            if (t >= 0) { const f32x4* xr = (const f32x4*)(xb + (size_t)t * D) + F.lane; float s = 0.f;
#pragma unroll
                for (int j = 0; j < 8; ++j) { const f32x4 v = xr[64 * j]; s += (v.x * v.x + v.y * v.y) + (v.z * v.z + v.w * v.w); }
                s = rstd_of(wave_sum_dpp(s)); if (F.lane == 0) rs[r] = s; } }
        __syncthreads();
        {
            const int c0 = 4 * F.tid, w = 2 << (F.tid >> 7);
            const f32x4 g = *(const f32x4*)(g0 + c0);
            const int ts = (t0 - (w - 1)) > 0 ? (t0 - (w - 1)) : 0;
            f32x4 sum = {0.f, 0.f, 0.f, 0.f};
#pragma unroll 8
            for (int t = ts; t < t0 + 64; ++t) {
                const f32x4 a = *(const f32x4*)(xb + (size_t)t * D + c0) * rs[t - t0 + 15] * g;
                sum += a;
                if (t - w >= ts) sum -= *(const f32x4*)(xb + (size_t)(t - w) * D + c0) * rs[t - w - t0 + 15] * g;
                if (t >= t0) { const float ic = 1.0f / (float)((t + 1) < w ? (t + 1) : w); const f32x4 p = sum * ic - a;
                    u32x2 o; o.x = pkh(p.x, p.y); o.y = pkh(p.z, p.w); *(u32x2*)(P + ((size_t)b * SEQ + t) * D + c0) = o; }
            }
        }
        __syncthreads();
    }
}
__device__ __forceinline__ void p0_prologue(Frame& F0, ArgP a) {
    Frame F = fresh(F0);
    unsigned char* ws = a->ws;
    LAS float* scr = (LAS float*)(F.lds + RING_OFF + F.wave * 16384);
    const int gw = F.vcu * NWAVES + F.wave, NGW = F.G * NWAVES;
    constexpr int I_POOL = (512 / 64) * (512 / 32), I_IN = (2048 / 64) * (DSA_NP / 32), I_OUT = (2048 / 64) * (2048 / 32), I_Q = (2048 / 64) * (512 / 32), I_KV = (2048 / 64) * (1024 / 32),
                  I_O = (512 / 64) * (2048 / 32), I_GU = (2048 / 64) * (2 * DFF / 32), I_DN = (DFF / 64) * (2048 / 32);
    constexpr int NITEMS = 4 * I_POOL + I_IN + I_OUT + 2 * (I_Q + I_KV + I_O + I_GU + I_DN);
    for (int it = gw; it < NITEMS; it += NGW) {
        int r = it; TJob j; bool found = false;
#pragma unroll
        for (int g = 0; g < 4; ++g) if (!found) { if (r < I_POOL) { j = TJob{a->pool_w + (size_t)g * 512 * 512, (h16*)(ws + WS_WPOOL) + (size_t)g * 512 * 512, a->pool_scale + g * 512, 512, 512, 512, 512, 0, 1.0f}; found = true; } else r -= I_POOL; }
        if (!found) { if (r < I_IN) { j = TJob{a->w_in, (h16*)(ws + WS_WIN), nullptr, DSA_N, 2048, DSA_NP, DSA_N, 0, 64.0f}; found = true; } else r -= I_IN; }
        if (!found) { if (r < I_OUT) { j = TJob{a->w_out, (h16*)(ws + WS_WOUT), nullptr, 2048, 2048, 2048, 2048, 0, 1.0f}; found = true; } else r -= I_OUT; }
#pragma unroll
        for (int L = 0; L < 2; ++L) {
            if (!found) { if (r < I_Q) { j = TJob{a->wq + (size_t)L * 2048 * 512, (h16*)(ws + WS_WQ) + (size_t)L * 512 * 2048, nullptr, 512, 2048, 512, 512, 0, 1.0f}; found = true; } else r -= I_Q; }
            if (!found) { if (r < I_KV) { j = TJob{a->wkv + (size_t)L * 2048 * 1024, (h16*)(ws + WS_WKV) + (size_t)L * 1024 * 2048, nullptr, 1024, 2048, 1024, 1024, 0, 1.0f}; found = true; } else r -= I_KV; }
            if (!found) { if (r < I_O) { j = TJob{a->wo + (size_t)L * 512 * 2048, (h16*)(ws + WS_WO) + (size_t)L * 2048 * 512, nullptr, 2048, 512, 2048, 2048, 0, 1.0f}; found = true; } else r -= I_O; }
            if (!found) { if (r < I_GU) { j = ((FFN_FP8 >> L) & 1) ? TJob{a->wgu + (size_t)L * 2048 * 2 * DFF, (h16*)(ws + WS_WGU) + (size_t)L * 2 * DFF * 2048, nullptr, 2 * DFF, 2048, 2 * DFF, 2 * DFF, 3, W8_SCALE} : TJob{a->wgu + (size_t)L * 2048 * 2 * DFF, (h16*)(ws + WS_WGU) + (size_t)L * 2 * DFF * 2048, nullptr, 2 * DFF, 2048, 2 * DFF, 2 * DFF, 1, 1.0f}; found = true; } else r -= I_GU; }
            if (!found) { if (r < I_DN) { j = ((DN_FP8 >> L) & 1) ? TJob{a->wdn + (size_t)L * DFF * 2048, (h16*)(ws + WS_WDN) + (size_t)L * 2048 * DFF, nullptr, 2048, DFF, 2048, 2048, 2, W8_SCALE} : TJob{a->wdn + (size_t)L * DFF * 2048, (h16*)(ws + WS_WDN) + (size_t)L * 2048 * DFF, nullptr, 2048, DFF, 2048, 2048, 0, 1.0f}; found = true; } else r -= I_DN; }
        }
        if (found) tjob_run(j, r, scr, F.lane);
    }
    for (int i = (gw * 64 + F.lane); i < T * 16; i += NGW * 64) rope_entry(a, (float*)(ws + WS_ROPE), i);
    for (int m = gw; m < NB * NMEM; m += NGW) norm_row_to_h16(a->mem + (size_t)m * D, a->mem_norm, (h16*)(ws + WS_MEMN) + (size_t)m * D, F.lane);
    __syncthreads();
    pool_pre(F, a->x, a->gains  , (h16*)(ws + WS_A));
}

template <bool HAS_NEXT, bool OUT8, bool HIN32, bool HOUT32>
__device__ __forceinline__ void seam_phase(Frame& F0, const h16* Y, const void* hin, void* hout, const float* gpost, const float* gpre, h16* aout) {
    Frame F = fresh(F0);
    const int gw = F.vcu * NWAVES + F.wave, NGW = F.G * NWAVES;
#pragma unroll 2
    for (int m = gw; m < T; m += NGW) {
        const h16* yr = Y + (size_t)m * D + 8 * F.lane;
        float y[4][8]; float s = 0.f;
#pragma unroll
        for (int j = 0; j < 4; ++j) { const half8 v = *(const half8*)(yr + 512 * j);
#pragma unroll
            for (int e = 0; e < 8; ++e) { y[j][e] = (float)v[e]; s += y[j][e] * y[j][e]; } }
        float hp[4][8];
#pragma unroll
        for (int j = 0; j < 4; ++j) {
            if constexpr (HIN32) { const f32x4 a = *(const f32x4*)((const float*)hin + (size_t)m * D + 8 * F.lane + 512 * j), c = *(const f32x4*)((const float*)hin + (size_t)m * D + 8 * F.lane + 512 * j + 4);
                hp[j][0] = a.x; hp[j][1] = a.y; hp[j][2] = a.z; hp[j][3] = a.w; hp[j][4] = c.x; hp[j][5] = c.y; hp[j][6] = c.z; hp[j][7] = c.w; }
            else { const half8 v = *(const half8*)((const h16*)hin + (size_t)m * D + 8 * F.lane + 512 * j);
#pragma unroll
                for (int e = 0; e < 8; ++e) hp[j][e] = (float)v[e]; } }
        const float r = rstd_of(wave_sum_dpp(s)); float s2 = 0.f;
#pragma unroll
        for (int j = 0; j < 4; ++j) { const f32x4 g0 = *(const f32x4*)(gpost + 8 * F.lane + 512 * j), g1 = *(const f32x4*)(gpost + 8 * F.lane + 512 * j + 4);
            const float g[8] = {g0.x, g0.y, g0.z, g0.w, g1.x, g1.y, g1.z, g1.w};
#pragma unroll
            for (int e = 0; e < 8; ++e) { const float h = hp[j][e] + y[j][e] * r * g[e]; y[j][e] = h; s2 += h * h; }
            if constexpr (HOUT32) { float* o = (float*)hout + (size_t)m * D + 8 * F.lane + 512 * j; *(f32x4*)o = (f32x4){y[j][0], y[j][1], y[j][2], y[j][3]}; *(f32x4*)(o + 4) = (f32x4){y[j][4], y[j][5], y[j][6], y[j][7]}; }
            else { u32x4 w; w.x = pkh(y[j][0], y[j][1]); w.y = pkh(y[j][2], y[j][3]); w.z = pkh(y[j][4], y[j][5]); w.w = pkh(y[j][6], y[j][7]); *(u32x4*)((h16*)hout + (size_t)m * D + 8 * F.lane + 512 * j) = w; } }
        if constexpr (HAS_NEXT) {
            const float r2 = rstd_of(wave_sum_dpp(s2));
#pragma unroll
            for (int j = 0; j < 4; ++j) { const f32x4 g0 = *(const f32x4*)(gpre + 8 * F.lane + 512 * j), g1 = *(const f32x4*)(gpre + 8 * F.lane + 512 * j + 4);
                const float g[8] = {g0.x, g0.y, g0.z, g0.w, g1.x, g1.y, g1.z, g1.w}; float v[8];
#pragma unroll
                for (int e = 0; e < 8; ++e) v[e] = y[j][e] * r2 * g[e];
                if constexpr (OUT8) { u32x2 w; w.x = pk8(v[0], v[1], v[2], v[3]); w.y = pk8(v[4], v[5], v[6], v[7]); *(u32x2*)((unsigned char*)aout + (size_t)m * D + 8 * F.lane + 512 * j) = w; }
                else { u32x4 w; w.x = pkh(v[0], v[1]); w.y = pkh(v[2], v[3]); w.z = pkh(v[4], v[5]); w.w = pkh(v[6], v[7]); *(u32x4*)(aout + (size_t)m * D + 8 * F.lane + 512 * j) = w; } }
        }
    }
}

__device__ __forceinline__ void xattn_phase(Frame& F0, h16* XQ, const h16* KVM  ) {
    Frame F = fresh(F0);
    LAS unsigned char* Ks = F.lds + RING_OFF; LAS unsigned char* Vt = F.lds + RING_OFF + 65536;
    const int lane = F.lane, n = lane & 31, hh = lane >> 5;
    for (int u = F.vcu; u < NB * 4 * (SEQ / 512); u += F.G) {
        const int b = u / (4 * (SEQ / 512)), h = (u / (SEQ / 512)) & 3, ch = u % (SEQ / 512);
        const h16* kb = KVM + (size_t)b * NMEM * 2048 + h * HD;
        for (int i = F.tid; i < 256 * 16; i += NWAVES * 64) { const int key = i >> 4, c = i & 15;
            const u32x4 kv = *(const u32x4*)(kb + (size_t)key * 2048 + 8 * c);
            *(LAS u32x4*)(Ks + key * 256 + ((c ^ (key & 15)) << 4)) = kv;
            const half8 vv = *(const half8*)(kb + (size_t)key * 2048 + 512 + 8 * c);
            const int o = key & 15, posk = (key & ~15) | ((o & 3) | ((o & 4) << 1) | ((o & 8) >> 1));
#pragma unroll
            for (int e = 0; e < 8; ++e) { const int d = 8 * c + e; *(LAS h16*)(Vt + d * 512 + (((posk >> 3) ^ (d & 15)) << 4) + (posk & 7) * 2) = vv[e]; }
        }
        __syncthreads();
#pragma unroll 1
        for (int sub = 0; sub < 2; ++sub) {
            const size_t m0 = (size_t)b * SEQ + ch * 512 + sub * 256 + F.wave * 32;
            h16* qrow = XQ + (m0 + n) * XW + h * HD;
            half8 qf[8];
#pragma unroll
            for (int s = 0; s < 8; ++s) qf[s] = *(const half8*)(qrow + 16 * s + 8 * hh);
            f32x16 o[4];
#pragma unroll
            for (int mt = 0; mt < 4; ++mt)
#pragma unroll
                for (int i = 0; i < 16; ++i) o[mt][i] = 0.f;
            const float c2 = 0.08838834764831845f * 1.44269504089f;
            float mrun = -3.0e38f, lrun = 0.f;
#pragma unroll 1
            for (int hf = 0; hf < 2; ++hf) {
                f32x16 acc[4];
#pragma unroll
                for (int kt = 0; kt < 4; ++kt) {
#pragma unroll
                    for (int i = 0; i < 16; ++i) acc[kt][i] = 0.f;
                    const int key = 128 * hf + 32 * kt + n;
#pragma unroll
                    for (int s = 0; s < 8; ++s) { const half8 ka = *(const LAS half8*)(Ks + key * 256 + (((2 * s + hh) ^ (key & 15)) << 4));
                        acc[kt] = __builtin_amdgcn_mfma_f32_32x32x16_f16(ka, qf[s], acc[kt], 0, 0, 0); }
                }
                float mx = mrun;
#pragma unroll
                for (int kt = 0; kt < 4; ++kt)
#pragma unroll
                    for (int i = 0; i < 16; ++i) mx = fmaxf(mx, acc[kt][i]);
                mx = fmaxf(mx, __shfl_xor(mx, 32));
                const float alpha = __builtin_amdgcn_exp2f((mrun - mx) * c2); mrun = mx;
                float sum = 0.f;
#pragma unroll
                for (int kt = 0; kt < 4; ++kt)
#pragma unroll
                    for (int i = 0; i < 16; ++i) { const float p = __builtin_amdgcn_exp2f((acc[kt][i] - mx) * c2); acc[kt][i] = p; sum += p; }
                lrun = lrun * alpha + sum;
#pragma unroll
                for (int mt = 0; mt < 4; ++mt)
#pragma unroll
                    for (int i = 0; i < 16; ++i) o[mt][i] *= alpha;
#pragma unroll
                for (int kt = 0; kt < 4; ++kt)
#pragma unroll
                    for (int s2 = 0; s2 < 2; ++s2) {
                        half8 pb;
#pragma unroll
                        for (int j = 0; j < 8; ++j) pb[j] = (h16)acc[kt][8 * s2 + j];
#pragma unroll
                        for (int mt = 0; mt < 4; ++mt) { const int d = 32 * mt + n;
                            const half8 va = *(const LAS half8*)(Vt + d * 512 + (((2 * (2 * (4 * hf + kt) + s2) + hh) ^ (d & 15)) << 4));
                            o[mt] = __builtin_amdgcn_mfma_f32_32x32x16_f16(va, pb, o[mt], 0, 0, 0); }
                    }
            }
            lrun += __shfl_xor(lrun, 32);
            const float inv = 1.0f / lrun;
#pragma unroll
            for (int mt = 0; mt < 4; ++mt)
#pragma unroll
                for (int jj = 0; jj < 4; ++jj) { u32x2 w; w.x = pkh(o[mt][4 * jj] * inv, o[mt][4 * jj + 1] * inv); w.y = pkh(o[mt][4 * jj + 2] * inv, o[mt][4 * jj + 3] * inv);
                    *(u32x2*)(qrow + 32 * mt + 8 * jj + 4 * hh) = w; }
        }
        __syncthreads();
    }
}

__device__ __forceinline__ unsigned mono_key(unsigned u) { return (u & 0x80000000u) ? ~u : (u | 0x80000000u); }
__device__ __forceinline__ void keymap_clear(LAS unsigned* bm, int lane) { *(LAS u32x4*)(bm + 8 * lane) = (u32x4){0u, 0u, 0u, 0u}; *(LAS u32x4*)(bm + 8 * lane + 4) = (u32x4){0u, 0u, 0u, 0u}; }
__device__ __forceinline__ void keymap_emit(LAS unsigned* bm, unsigned short* out, int nvalid, int lane) {
    const u32x4 w0 = *(const LAS u32x4*)(bm + 8 * lane), w1 = *(const LAS u32x4*)(bm + 8 * lane + 4);
    unsigned w[8] = {w0.x, w0.y, w0.z, w0.w, w1.x, w1.y, w1.z, w1.w};
    int mine = 0;
#pragma unroll
    for (int j = 0; j < 8; ++j) mine += __builtin_popcount(w[j]);
    int incl = mine;
#pragma unroll
    for (int o = 1; o < 64; o <<= 1) { const int v = __shfl_up(incl, o); if (lane >= o) incl += v; }
    int pos = incl - mine;
#pragma unroll
    for (int j = 0; j < 8; ++j) { unsigned x = w[j]; while (x) { const int b = __builtin_ctz(x); out[pos++] = (unsigned short)((8 * lane + j) * 32 + b); x &= x - 1u; } }
    const int total = __shfl(incl, 63);
    for (int i = total + lane; i < TOPK; i += 64) out[i] = (unsigned short)0;
}
constexpr int SEL_N = LIST_CAP / 64;
template <bool FINAL>
__device__ __forceinline__ void select256(u32x2* list, int c, LAS float* th_out, LAS unsigned* cnt_out, LAS unsigned* bm, int lane) {
    unsigned key[SEL_N], id[SEL_N];
#pragma unroll
    for (int k = 0; k < SEL_N; ++k) { const int i = lane + 64 * k; const u32x2 v = list[i]; key[k] = (i < c) ? mono_key(v.x) : 0u; id[k] = v.y; }
    unsigned mx = key[0];
#pragma unroll
    for (int k = 1; k < SEL_N; ++k) mx = key[k] > mx ? key[k] : mx;
#pragma unroll
    for (int o = 1; o < 64; o <<= 1) { const unsigned v = (unsigned)__shfl_xor((int)mx, o); mx = v > mx ? v : mx; }
    unsigned lo = FINAL ? 1u : mono_key(__float_as_uint(*th_out)), hi = mx;
    constexpr int PRUNE_KEEP = 320;
#pragma unroll 1
    while (lo < hi) { const unsigned mid = lo + ((hi - lo + 1u) >> 1); int cc = 0;
#pragma unroll
        for (int k = 0; k < SEL_N; ++k) cc += __builtin_popcountll(__ballot(key[k] >= mid));
        if (cc >= TOPK) { lo = mid; if (cc <= (FINAL ? TOPK : PRUNE_KEEP)) break; } else hi = mid - 1u; }
    const unsigned prefix = lo;
    int ngt = 0, neq = 0;
#pragma unroll
    for (int k = 0; k < SEL_N; ++k) { ngt += __builtin_popcountll(__ballot(key[k] > prefix)); neq += __builtin_popcountll(__ballot(key[k] == prefix)); }
    const int need_eq = FINAL ? (TOPK - ngt) : neq; int base_gt = 0, base_eq = 0;
    const unsigned long long lt = (1ull << lane) - 1ull;
#pragma unroll
    for (int k = 0; k < SEL_N; ++k) {
        const unsigned long long bgt = __ballot(key[k] > prefix), beq = __ballot(key[k] == prefix);
        int pos = -1;
        if (key[k] > prefix) pos = base_gt + __builtin_popcountll(bgt & lt);
        else if (key[k] == prefix) { const int r = base_eq + __builtin_popcountll(beq & lt); if (r < need_eq) pos = ngt + r; }
        if (pos >= 0) { if constexpr (FINAL) __hip_atomic_fetch_or(bm + (id[k] >> 5), 1u << (id[k] & 31u), __ATOMIC_RELAXED, __HIP_MEMORY_SCOPE_WORKGROUP); else { u32x2 v; v.x = (key[k] & 0x80000000u) ? (key[k] & 0x7fffffffu) : ~key[k]; v.y = id[k]; list[pos] = v; } }
        base_gt += __builtin_popcountll(bgt); base_eq += __builtin_popcountll(beq);
        __builtin_amdgcn_sched_barrier(0);
    }
    if constexpr (!FINAL) { if (lane == 0) { const unsigned u = (prefix & 0x80000000u) ? (prefix & 0x7fffffffu) : ~prefix; *th_out = __builtin_bit_cast(float, u); *cnt_out = (unsigned)(ngt + neq); } }
}
__device__ __forceinline__ void indexer_phase(Frame& F0, const h16* IQ, const h16* IK, const float* IW, unsigned short* IDX, u32x2* LISTS) {
    Frame F = fresh(F0);
    LAS unsigned char* bq = F.lds + RING_OFF;
    LAS unsigned* cnt = (LAS unsigned*)(F.lds + RING_OFF + 131072); LAS float* th = (LAS float*)(cnt + 32); LAS unsigned* flag = cnt + 64; LAS unsigned* sgn = cnt + 96;
    u32x2* mylist = LISTS + (size_t)blockIdx.x * 32 * LIST_CAP;
    const int lane = F.lane, n = lane & 31, hh = lane >> 5, w8 = F.wave;
    const float INF = __builtin_inff();
    constexpr int NU = NB * (SEQ / 32);
    for (int rnd = 0; rnd * F.G < NU; ++rnd) {
        int qt, b;
        if (F.G == 256) {
            const int i = (F.vcu & 31) + 32 * (F.vcu >> 6); b = (F.vcu >> 5) & 1;
            qt = rnd == 0 ? 511 - i : rnd == 1 ? i : rnd == 2 ? 256 + i : 255 - i;
        } else { const int kk = rnd * F.G + ((rnd & 1) ? (F.G - 1 - F.vcu) : F.vcu); if (kk >= NU) continue; qt = (SEQ / 32 - 1) - (kk >> 1); b = kk & 1; }
        const int nkt = qt + 1;
        const size_t m0 = (size_t)b * SEQ + 32 * qt;
        if (F.tid < 32) { cnt[F.tid] = 0u; th[F.tid] = -INF; unsigned mk = 0u;
#pragma unroll
            for (int h = 0; h < 16; ++h) mk |= (IW[(m0 + F.tid) * 16 + h] >= 0.f ? 1u : 0u) << h;
            sgn[F.tid] = mk; }
        if (F.tid == 0) *flag = 0u;
        { const int q = F.tid & 31, ch = F.tid >> 5;
#pragma unroll 4
            for (int h = 0; h < 16; ++h) { const float w = IW[(m0 + q) * 16 + h]; const half8 v = *(const half8*)(IQ + (m0 + q) * 2048 + h * HD + 8 * ch); half8 o;
#pragma unroll
                for (int e = 0; e < 8; ++e) o[e] = (h16)((float)v[e] * w);
                *(LAS half8*)(bq + (h * 16 + ch) * 512 + q * 16) = o; } }
        __syncthreads();
        const h16* ikb = IK + (size_t)b * SEQ * HD;
        const unsigned smask = sgn[n];
        float theta = -INF;
        const int qpos = 32 * qt + n;
        u32x2* lp = mylist + (size_t)n * LIST_CAP;
        half8 A[8];
        if (w8 < nkt) { const h16* arow = ikb + (size_t)(32 * w8 + n) * HD + 8 * hh;
#pragma unroll
            for (int c = 0; c < 8; ++c) A[c] = *(const half8*)(arow + 16 * c); }
#pragma unroll 1
        for (int r0 = 0; r0 < nkt; r0 += NWAVES) {
            const int kt = r0 + w8;
            if (kt < nkt) {
                f32x16 S;
#pragma unroll
                for (int i = 0; i < 16; ++i) S[i] = 0.f;
                const LAS unsigned char* bl = bq + hh * 512 + n * 16;
                half8 Ba[4], Bb[4]; f32x16 acc0, acc1;
#define IDX_LOADB(dst, h, c0) do { _Pragma("unroll") for (int c = 0; c < 4; ++c) dst[c] = *(const LAS half8*)(bl + ((h) * 16 + 2 * ((c0) + c)) * 512); } while (0)
#define IDX_MMA4(acc, Bx, c0) do { _Pragma("unroll") for (int c = 0; c < 4; ++c) acc = __builtin_amdgcn_mfma_f32_32x32x16_f16(A[(c0) + c], Bx[c], acc, 0, 0, 0); } while (0)
#define IDX_ZERO(acc) do { _Pragma("unroll") for (int i = 0; i < 16; ++i) acc[i] = 0.f; } while (0)
#define IDX_FOLD8(acc, h, i0) do { const float cc_ = ((smask >> (h)) & 1u) ? INF : -INF; _Pragma("unroll") for (int i = (i0); i < (i0) + 8; ++i) S[i] += __builtin_amdgcn_fmed3f(acc[i], 0.f, cc_); } while (0)
#define IDX_SCHED4() do { __builtin_amdgcn_sched_group_barrier(0x008, 1, 0); __builtin_amdgcn_sched_group_barrier(0x100, 1, 0); _Pragma("unroll") for (int g_ = 0; g_ < 3; ++g_) { __builtin_amdgcn_sched_group_barrier(0x008, 1, 0); __builtin_amdgcn_sched_group_barrier(0x100, 1, 0); __builtin_amdgcn_sched_group_barrier(0x002, 6, 0); } } while (0)
                IDX_LOADB(Ba, 0, 0);
                IDX_ZERO(acc1);
#pragma unroll 1
                for (int h = 0; h < 16; h += 2) {
                    IDX_ZERO(acc0);
                    IDX_MMA4(acc0, Ba, 0); IDX_FOLD8(acc1, (h + 15) & 15, 0); IDX_LOADB(Bb, h, 4); IDX_SCHED4();
                    IDX_MMA4(acc0, Bb, 4); IDX_FOLD8(acc1, (h + 15) & 15, 8); IDX_LOADB(Ba, h + 1, 0); IDX_SCHED4();
                    IDX_ZERO(acc1);
                    IDX_MMA4(acc1, Ba, 0); IDX_FOLD8(acc0, h, 0); IDX_LOADB(Bb, h + 1, 4); IDX_SCHED4();
                    IDX_MMA4(acc1, Bb, 4); IDX_FOLD8(acc0, h, 8); IDX_LOADB(Ba, (h + 2) & 15, 0); IDX_SCHED4();
                }
                IDX_FOLD8(acc1, 15, 0); IDX_FOLD8(acc1, 15, 8);
#if IDX_PROBE_MMA
                {
                    f32x16 S1 = S;
#pragma unroll
                    for (int c = 0; c < 8; ++c) asm volatile("" : "+v"(A[c]));
#pragma unroll
                    for (int i = 0; i < 16; ++i) S[i] = 0.f;
                    IDX_LOADB(Ba, 0, 0);
                    IDX_ZERO(acc1);
#pragma unroll 1
                    for (int h = 0; h < 16; h += 2) {
                        IDX_ZERO(acc0);
                        IDX_MMA4(acc0, Ba, 0); IDX_FOLD8(acc1, (h + 15) & 15, 0); IDX_LOADB(Bb, h, 4); IDX_SCHED4();
                        IDX_MMA4(acc0, Bb, 4); IDX_FOLD8(acc1, (h + 15) & 15, 8); IDX_LOADB(Ba, h + 1, 0); IDX_SCHED4();
                        IDX_ZERO(acc1);
                        IDX_MMA4(acc1, Ba, 0); IDX_FOLD8(acc0, h, 0); IDX_LOADB(Bb, h + 1, 4); IDX_SCHED4();
                        IDX_MMA4(acc1, Bb, 4); IDX_FOLD8(acc0, h, 8); IDX_LOADB(Ba, (h + 2) & 15, 0); IDX_SCHED4();
                    }
                    IDX_FOLD8(acc1, 15, 0); IDX_FOLD8(acc1, 15, 8);
#pragma unroll
                    for (int i = 0; i < 16; ++i) S[i] = (S[i] + S1[i]) * 0.5f;
                }
#endif
#undef IDX_LOADB
#undef IDX_MMA4
#undef IDX_ZERO
#undef IDX_FOLD8
#undef IDX_SCHED4
                if (kt + NWAVES < nkt) { const h16* arow = ikb + (size_t)(32 * (kt + NWAVES) + n) * HD + 8 * hh;
#pragma unroll
                    for (int c = 0; c < 8; ++c) A[c] = *(const half8*)(arow + 16 * c); }
                const int kb0 = 32 * kt + 4 * hh;
                unsigned pm = 0u;
                if (kt < qt) {
#pragma unroll
                    for (int i = 0; i < 16; ++i) pm |= (S[i] > theta) ? (1u << i) : 0u;
                } else {
#pragma unroll
                    for (int i = 0; i < 16; ++i) { const int key = kb0 + (i & 3) + 8 * (i >> 2); pm |= ((key <= qpos) && (S[i] > theta)) ? (1u << i) : 0u; }
                }
                if (pm) { const unsigned np = (unsigned)__builtin_popcount(pm);
                    const unsigned pos = __hip_atomic_fetch_add(cnt + n, np, __ATOMIC_RELAXED, __HIP_MEMORY_SCOPE_WORKGROUP);
#pragma unroll
                    for (int i = 0; i < 16; ++i) if (pm & (1u << i)) { u32x2 e; e.x = __float_as_uint(S[i]);   e.y = (unsigned)(kb0 + (i & 3) + 8 * (i >> 2));
                        { const unsigned at = pos + (unsigned)__builtin_popcount(pm & ((1u << i) - 1u)); lp[at < (unsigned)LIST_CAP ? at : (unsigned)LIST_CAP - 1u] = e; } }
                    if (pos + np > (unsigned)(LIST_CAP - 256)) *(volatile LAS unsigned*)flag = 1u; }
            }
            asm volatile("s_waitcnt lgkmcnt(0)" ::: "memory"); __builtin_amdgcn_s_barrier(); asm volatile("" ::: "memory");
            if (*(volatile LAS unsigned*)flag != 0u) {
                VM_WAIT(); __syncthreads();
                for (int q = w8; q < 32; q += NWAVES) { const int c = __builtin_amdgcn_readfirstlane((int)cnt[q]); if (c > TOPK) select256<false>(mylist + (size_t)q * LIST_CAP, c, th + q, cnt + q, nullptr, lane); }
                if (F.tid == 0) *flag = 0u;
                VM_WAIT(); __syncthreads();
                theta = th[n];
                if (kt + NWAVES < nkt) { const h16* arow = ikb + (size_t)(32 * (kt + NWAVES) + n) * HD + 8 * hh;
#pragma unroll
                    for (int c = 0; c < 8; ++c) A[c] = *(const half8*)(arow + 16 * c); }
            }
        }
        VM_WAIT(); __syncthreads();
        LAS unsigned* bm = (LAS unsigned*)(bq + w8 * 2048);
        for (int q = w8; q < 32; q += NWAVES) { const int c = __builtin_amdgcn_readfirstlane((int)cnt[q]); unsigned short* io = IDX + (m0 + q) * TOPK; u32x2* lq = mylist + (size_t)q * LIST_CAP;
            keymap_clear(bm, lane); asm volatile("s_waitcnt lgkmcnt(0)" ::: "memory");
            if (c > TOPK) select256<true>(lq, c, nullptr, nullptr, bm, lane);
            else {
#pragma unroll
                for (int k = 0; k < 4; ++k) { const int i = lane + 64 * k; if (i < c) { const unsigned key = lq[i].y; __hip_atomic_fetch_or(bm + (key >> 5), 1u << (key & 31u), __ATOMIC_RELAXED, __HIP_MEMORY_SCOPE_WORKGROUP); } } }
            asm volatile("s_waitcnt lgkmcnt(0)" ::: "memory");
            keymap_emit(bm, io, c, lane);
            asm volatile("s_waitcnt lgkmcnt(0)" ::: "memory"); }
        __syncthreads();
    }
}

__device__ __forceinline__ unsigned q_fetch(unsigned* ctr, int lane) { unsigned v = 0u; if (lane == 0) v = __hip_atomic_fetch_add(ctr, 1u, __ATOMIC_RELAXED, __HIP_MEMORY_SCOPE_AGENT); return (unsigned)__builtin_amdgcn_readfirstlane((int)v); }
__device__ __forceinline__ void sparse_attn_phase(Frame& F0, const h16* Q, const unsigned char* K8, const unsigned char* V8, const unsigned short* IDX, h16* O, unsigned* qctr) {
    Frame F = fresh(F0);
    LAS unsigned char* wl = F.lds + RING_OFF + F.wave * 16896;
    LAS float* Pl = (LAS float*)wl;
    LAS unsigned short* Il = (LAS unsigned short*)(wl + 4096);
    const int lane = F.lane, r16 = lane & 15, g4 = lane >> 4;
    const float c2 = 0.08838834764831845f * 1.44269504089f;
    const unsigned x0 = xb_xcc_id() & 7u;
    unsigned tried = 0u, p = x0;
    unsigned item = q_fetch(qctr + 64 * p, lane);
    bool have_pf = false; u32x2 pf_idx = (u32x2){0u, 0u}; half8 pf_q[4];
#pragma unroll
    for (int s = 0; s < 4; ++s) pf_q[s] = (half8){0, 0, 0, 0, 0, 0, 0, 0};
    for (;;) {
        while (item >= (unsigned)SEQ && tried < 8u) { ++tried; p = (x0 + tried) & 7u; if (tried < 8u) item = q_fetch(qctr + 64 * p, lane); }
        if (tried >= 8u) break;
        const unsigned nxt = q_fetch(qctr + 64 * p, lane);
        const int b = (int)(p >> 2), j = (int)(p & 3u), tq = (int)item, nk = (tq + 1) < TOPK ? (tq + 1) : TOPK;
        const size_t m = (size_t)b * SEQ + tq;
        const unsigned char* kb = K8 + (size_t)p * SEQ * HD; const unsigned char* vb = V8 + (size_t)p * SEQ * HD;
        *(LAS u32x2*)(Il + 4 * lane) = have_pf ? pf_idx : *(const u32x2*)(IDX + m * TOPK + 4 * lane);
        long qh[4], ql[4];
        { const h16* qrow = Q + m * 2048 + (size_t)j * 512 + (r16 & 3) * HD + 16 * g4;
#pragma unroll
          for (int s = 0; s < 4; ++s) { const half8 hv = have_pf ? pf_q[s] : *(const half8*)(qrow + (s >> 1) * 64 + (s & 1) * 8);
              float f[8], l[8];
#pragma unroll
              for (int e = 0; e < 8; ++e) f[e] = (float)hv[e] * c2;
              const unsigned h0 = pk8(f[0], f[1], f[2], f[3]), h1 = pk8(f[4], f[5], f[6], f[7]);
              l[0] = f[0] - __builtin_amdgcn_cvt_f32_fp8((int)h0, 0); l[1] = f[1] - __builtin_amdgcn_cvt_f32_fp8((int)h0, 1); l[2] = f[2] - __builtin_amdgcn_cvt_f32_fp8((int)h0, 2); l[3] = f[3] - __builtin_amdgcn_cvt_f32_fp8((int)h0, 3);
              l[4] = f[4] - __builtin_amdgcn_cvt_f32_fp8((int)h1, 0); l[5] = f[5] - __builtin_amdgcn_cvt_f32_fp8((int)h1, 1); l[6] = f[6] - __builtin_amdgcn_cvt_f32_fp8((int)h1, 2); l[7] = f[7] - __builtin_amdgcn_cvt_f32_fp8((int)h1, 3);
              const unsigned l0 = pk8(l[0], l[1], l[2], l[3]), l1 = pk8(l[4], l[5], l[6], l[7]);
              const bool real = r16 < 4;
              qh[s] = real ? (long)(((unsigned long long)h1 << 32) | h0) : 0l; ql[s] = real ? (long)(((unsigned long long)l1 << 32) | l0) : 0l; } }
        asm volatile("s_waitcnt lgkmcnt(0)" ::: "memory");
        int keys[16];
#pragma unroll
        for (int kt = 0; kt < 16; ++kt) keys[kt] = Il[16 * kt + r16];
        {
            u32x4 ka[8][2];
#pragma unroll
            for (int k8 = 0; k8 < 8; ++k8) { const unsigned char* krow = kb + (size_t)keys[k8] * HD + 16 * g4; ka[k8][0] = *(const u32x4*)krow; ka[k8][1] = *(const u32x4*)(krow + 64); }
#pragma unroll
            for (int kt = 0; kt < 16; ++kt) { const int k8 = kt & 7; const u32x4 a0 = ka[k8][0], a1 = ka[k8][1];
                const long ak[4] = {(long)(((unsigned long long)a0.y << 32) | a0.x), (long)(((unsigned long long)a0.w << 32) | a0.z), (long)(((unsigned long long)a1.y << 32) | a1.x), (long)(((unsigned long long)a1.w << 32) | a1.z)};
                if (kt < 8) { const unsigned char* krow = kb + (size_t)keys[kt + 8] * HD + 16 * g4; ka[k8][0] = *(const u32x4*)krow; ka[k8][1] = *(const u32x4*)(krow + 64); }
                f32x4 acc = (f32x4){0.f, 0.f, 0.f, 0.f};
#pragma unroll
                for (int s = 0; s < 4; ++s) { acc = __builtin_amdgcn_mfma_f32_16x16x32_fp8_fp8(ak[s], qh[s], acc, 0, 0, 0); acc = __builtin_amdgcn_mfma_f32_16x16x32_fp8_fp8(ak[s], ql[s], acc, 0, 0, 0); }
                if (r16 < 4) {
#pragma unroll
                    for (int i = 0; i < 4; ++i) Pl[(16 * kt + 4 * g4 + i) * 4 + r16] = acc[i]; }
            }
        }
        have_pf = nxt < (unsigned)SEQ;
        if (have_pf) { const size_t mn = (size_t)b * SEQ + nxt; pf_idx = *(const u32x2*)(IDX + mn * TOPK + 4 * lane);
            const h16* qn = Q + mn * 2048 + (size_t)j * 512 + (r16 & 3) * HD + 16 * g4;
#pragma unroll
            for (int s = 0; s < 4; ++s) pf_q[s] = *(const half8*)(qn + (s >> 1) * 64 + (s & 1) * 8); }
        asm volatile("" ::: "memory");
        LAS unsigned char* vs = wl + 4608;
        const int nch = (nk + 31) >> 5;
#define SP_ISSUE(ch_) do { const int c_ = (ch_); LAS unsigned char* s_ = vs + (c_ % 3) * 4096; _Pragma("unroll") for (int j_ = 0; j_ < 4; ++j_) { const int key_ = Il[32 * c_ + 8 * j_ + (lane >> 3)]; \
                __builtin_amdgcn_global_load_lds((const unsigned*)(vb + (size_t)key_ * HD + (lane & 7) * 16), (LAS unsigned*)(s_ + 1024 * j_), 16, 0, 0); } } while (0)
            SP_ISSUE(0); if (nch > 1) SP_ISSUE(1);
        f32x4 sv[4]; f32x4 mx = (f32x4){-3.0e38f, -3.0e38f, -3.0e38f, -3.0e38f};
#pragma unroll
        for (int k = 0; k < 4; ++k) { sv[k] = *(const LAS f32x4*)(Pl + (lane + 64 * k) * 4); if (lane + 64 * k < nk) { mx[0] = fmaxf(mx[0], sv[k][0]); mx[1] = fmaxf(mx[1], sv[k][1]); mx[2] = fmaxf(mx[2], sv[k][2]); mx[3] = fmaxf(mx[3], sv[k][3]); } }
#pragma unroll
        for (int o = 1; o < 64; o <<= 1) { mx[0] = fmaxf(mx[0], __shfl_xor(mx[0], o)); mx[1] = fmaxf(mx[1], __shfl_xor(mx[1], o)); mx[2] = fmaxf(mx[2], __shfl_xor(mx[2], o)); mx[3] = fmaxf(mx[3], __shfl_xor(mx[3], o)); }
        f32x4 sum = (f32x4){0.f, 0.f, 0.f, 0.f};
#pragma unroll
        for (int k = 0; k < 4; ++k) { f32x4 pv;
#pragma unroll
            for (int h = 0; h < 4; ++h) pv[h] = (lane + 64 * k < nk) ? __builtin_amdgcn_exp2f(sv[k][h] - mx[h]) : 0.f;
            sum += pv; *(LAS f32x4*)(Pl + (lane + 64 * k) * 4) = pv; }
#pragma unroll
        for (int o = 1; o < 64; o <<= 1) { sum[0] += __shfl_xor(sum[0], o); sum[1] += __shfl_xor(sum[1], o); sum[2] += __shfl_xor(sum[2], o); sum[3] += __shfl_xor(sum[3], o); }
        asm volatile("s_waitcnt lgkmcnt(0)" ::: "memory");
        float ov[4][8];
#pragma unroll
        for (int h = 0; h < 4; ++h)
#pragma unroll
            for (int e = 0; e < 8; ++e) ov[h][e] = 0.f;
        {
#pragma unroll 1
            for (int ch = 0; ch < nch; ++ch) {
                if (ch + 2 < nch) { SP_ISSUE(ch + 2); asm volatile("s_waitcnt vmcnt(8)" ::: "memory"); }
                else if (ch + 1 < nch) asm volatile("s_waitcnt vmcnt(4)" ::: "memory");
                else asm volatile("s_waitcnt vmcnt(0)" ::: "memory");
                const LAS unsigned char* s = vs + (ch % 3) * 4096 + g4 * HD + 8 * r16;
#pragma unroll
                for (int u = 0; u < 8; ++u) { const u32x2 vv = *(const LAS u32x2*)(s + u * 4 * HD); const f32x4 p4 = *(const LAS f32x4*)(Pl + (32 * ch + 4 * u + g4) * 4);
                    float v[8]; v[0] = __builtin_amdgcn_cvt_f32_fp8((int)vv.x, 0); v[1] = __builtin_amdgcn_cvt_f32_fp8((int)vv.x, 1); v[2] = __builtin_amdgcn_cvt_f32_fp8((int)vv.x, 2); v[3] = __builtin_amdgcn_cvt_f32_fp8((int)vv.x, 3);
                    v[4] = __builtin_amdgcn_cvt_f32_fp8((int)vv.y, 0); v[5] = __builtin_amdgcn_cvt_f32_fp8((int)vv.y, 1); v[6] = __builtin_amdgcn_cvt_f32_fp8((int)vv.y, 2); v[7] = __builtin_amdgcn_cvt_f32_fp8((int)vv.y, 3);
#pragma unroll
                    for (int h = 0; h < 4; ++h)
#pragma unroll
                        for (int e = 0; e < 8; ++e) ov[h][e] += p4[h] * v[e]; }
                asm volatile("s_waitcnt lgkmcnt(0)" ::: "memory");
            }
#undef SP_ISSUE
        }
#pragma unroll
        for (int h = 0; h < 4; ++h)
#pragma unroll
            for (int e = 0; e < 8; ++e) { float x = ov[h][e]; x += __shfl_xor(x, 16); x += __shfl_xor(x, 32); ov[h][e] = x; }
        { float o8[8]; const float inv = 1.0f / (g4 == 0 ? sum[0] : g4 == 1 ? sum[1] : g4 == 2 ? sum[2] : sum[3]);
#pragma unroll
          for (int e = 0; e < 8; ++e) o8[e] = (g4 == 0 ? ov[0][e] : g4 == 1 ? ov[1][e] : g4 == 2 ? ov[2][e] : ov[3][e]) * inv;
          u32x4 w; w.x = pkh(o8[0], o8[1]); w.y = pkh(o8[2], o8[3]); w.z = pkh(o8[4], o8[5]); w.w = pkh(o8[6], o8[7]);
          *(u32x4*)(O + m * 2048 + (size_t)j * 512 + g4 * HD + 8 * r16) = w; }
        asm volatile("s_waitcnt lgkmcnt(0)" ::: "memory");
        item = nxt;
    }
}

#ifndef DBG_CHECK
#define DBG_CHECK 0
#endif
#if DBG_CHECK
__device__ __forceinline__ void dbg_max(unsigned* w, float v) { atomicMax(w, __builtin_bit_cast(unsigned, fabsf(v))); }
__device__ __forceinline__ int dbg_row(int blk) { return (blk & 1) * SEQ + (SEQ - 1 - 251 * (blk >> 1)); }
__device__ __forceinline__ void dbg_check_inproj(unsigned char* ws, LAS float* sh, unsigned* word) {
    if (blockIdx.x >= 64) return;
    int tid_ = (int)threadIdx.x; asm volatile("" : "+v"(tid_)); const int m = dbg_row(blockIdx.x), tid = tid_;
    const h16* a = (const h16*)(ws + WS_A) + (size_t)m * 2048; const h16* W = (const h16*)(ws + WS_WIN);
    for (int c = tid; c < DSA_N; c += 512) { float s = 0.f; for (int k = 0; k < 2048; ++k) s += (float)a[k] * (float)W[(size_t)c * 2048 + k]; sh[c] = s * (1.0f / 64.0f); }
    __syncthreads();
    const float* rope = (const float*)(ws + WS_ROPE) + (size_t)m * 32;
    for (int c = tid; c < DSA_N; c += 512) {
        float v = sh[c]; int hc; bool rot; float got;
        if (c < 2048) { hc = c & 127; rot = true; got = (float)((const h16*)(ws + WS_Q))[(size_t)m * 2048 + c]; }
        else if (c < 3072) continue;
        else if (c < 5120) { hc = (c - 3072) & 127; rot = true; got = (float)((const h16*)(ws + WS_IQ))[(size_t)m * 2048 + (c - 3072)]; }
        else if (c < 5248) { hc = c - 5120; rot = true; got = (float)((const h16*)(ws + WS_IK))[(size_t)m * 128 + (c - 5120)]; }
        else { hc = 99; rot = false; got = ((const float*)(ws + WS_IW))[(size_t)m * 16 + (c - 5248)]; }
        if (rot && hc < 32) { const int i = hc & 15; const float cs = rope[i], sn = rope[16 + i]; v = hc < 16 ? v * cs - sh[c + 16] * sn : v * cs + sh[c - 16] * sn; }
        dbg_max(word, (got - v) / (1.0f + fabsf(v)));
    }
    __syncthreads();
}
__device__ __forceinline__ void dbg_check_xattn(unsigned char* ws, int L, LAS float* sh, unsigned* word) {
    if (blockIdx.x >= 64) return;
    int tid_ = (int)threadIdx.x; asm volatile("" : "+v"(tid_)); const int m = dbg_row(blockIdx.x), tid = tid_, b = m / SEQ;
    const h16* a = (const h16*)(ws + WS_A) + (size_t)m * 2048; const h16* W = (const h16*)(ws + WS_WQ) + (size_t)L * 512 * 2048;
    const h16* kvm = (const h16*)(ws + WS_KVM) + (size_t)b * NMEM * 2048 + L * 1024;
    LAS float* q = sh; LAS float* lg = sh + 512; LAS float* st = sh + 512 + 1024;
    { float s = 0.f; for (int k = 0; k < 2048; ++k) s += (float)a[k] * (float)W[(size_t)tid * 2048 + k]; q[tid] = (float)(h16)s; }
    __syncthreads();
    for (int i = tid; i < 1024; i += 512) { const int h = i >> 8, key = i & 255; float s = 0.f; for (int d = 0; d < 128; ++d) s += q[h * 128 + d] * (float)kvm[(size_t)key * 2048 + h * 128 + d]; lg[i] = s * 0.08838834764831845f; }
    __syncthreads();
    if (tid < 4) { float mx = -3e38f; for (int k = 0; k < 256; ++k) mx = fmaxf(mx, lg[tid * 256 + k]); float su = 0.f; for (int k = 0; k < 256; ++k) su += __expf(lg[tid * 256 + k] - mx); st[2 * tid] = mx; st[2 * tid + 1] = 1.0f / su; }
    __syncthreads();
    { const int h = tid >> 7, d = tid & 127; float o = 0.f; for (int k = 0; k < 256; ++k) o += __expf(lg[h * 256 + k] - st[2 * h]) * st[2 * h + 1] * (float)kvm[(size_t)k * 2048 + 512 + h * 128 + d];
      const float got = (float)((const h16*)(ws + WS_XQ))[(size_t)m * 512 + tid]; dbg_max(word, (got - o) / (0.05f + fabsf(o))); }
    __syncthreads();
}
__device__ __forceinline__ void dbg_check_indexer(unsigned char* ws, LAS float* sh, unsigned* word, unsigned* word2) {
    if (blockIdx.x >= 64) return;
    int tid_ = (int)threadIdx.x; asm volatile("" : "+v"(tid_)); const int m = dbg_row(blockIdx.x), tid = tid_, b = m / SEQ, t = m % SEQ;
    const h16* iq = (const h16*)(ws + WS_IQ) + (size_t)m * 2048; const h16* ik = (const h16*)(ws + WS_IK) + (size_t)b * SEQ * 128; const float* iw = (const float*)(ws + WS_IW) + (size_t)m * 16;
    LAS float* sc = sh;
    for (int s = tid; s <= t; s += 512) { float tot = 0.f; for (int h = 0; h < 16; ++h) { float l = 0.f; for (int d = 0; d < 128; ++d) l += (float)iq[h * 128 + d] * (float)ik[(size_t)s * 128 + d]; tot += iw[h] * fmaxf(l, 0.f); } sc[s] = tot; }
    __syncthreads();
    const unsigned short* idx = (const unsigned short*)(ws + WS_IDX) + (size_t)m * 256;
    if (tid < 256) { const int key = idx[tid]; if (key > t) atomicAdd(word2, 1000u); else { const float v = sc[key]; int rank = 0; for (int s = 0; s <= t; ++s) rank += sc[s] > v ? 1 : 0; if (rank >= 256) atomicAdd(word, 1u);
        for (int j = 0; j < 256; ++j) if (j != tid && idx[j] == key) { atomicAdd(word2, 1u); break; } } }
    __syncthreads();
}
__device__ __forceinline__ float dbg_f8(const unsigned char* p) { const unsigned w = *p; return __builtin_amdgcn_cvt_f32_fp8((int)w, 0); }
__device__ __forceinline__ void dbg_check_sparse(unsigned char* ws, LAS float* sh, unsigned* word) {
    if (blockIdx.x >= 64) return;
    int tid_ = (int)threadIdx.x; asm volatile("" : "+v"(tid_)); const int m = dbg_row(blockIdx.x), tid = tid_, b = m / SEQ;
    const h16* q = (const h16*)(ws + WS_Q) + (size_t)m * 2048; const unsigned char* k8 = (const unsigned char*)(ws + WS_KV); const unsigned char* v8 = k8 + (size_t)16 * 1024 * 1024;
    const unsigned short* idx = (const unsigned short*)(ws + WS_IDX) + (size_t)m * 256;
    LAS float* lg = sh; LAS float* st = sh + 4096;
    for (int i = tid; i < 4096; i += 512) { const int h = i >> 8, k = i & 255, key = idx[k]; float s = 0.f; const unsigned char* kr = k8 + ((size_t)(b * NKV + (h >> 2)) * SEQ + key) * HD;
        for (int d = 0; d < 128; ++d) s += (float)q[h * 128 + d] * dbg_f8(kr + d); lg[i] = s * 0.08838834764831845f; }
    __syncthreads();
    if (tid < 16) { float mx = -3e38f; for (int k = 0; k < 256; ++k) mx = fmaxf(mx, lg[tid * 256 + k]); float su = 0.f; for (int k = 0; k < 256; ++k) su += __expf(lg[tid * 256 + k] - mx); st[2 * tid] = mx; st[2 * tid + 1] = 1.0f / su; }
    __syncthreads();
    for (int i = tid; i < 2048; i += 512) { const int h = i >> 7, d = i & 127; float o = 0.f; for (int k = 0; k < 256; ++k) o += __expf(lg[h * 256 + k] - st[2 * h]) * st[2 * h + 1] * dbg_f8(v8 + ((size_t)(b * NKV + (h >> 2)) * SEQ + idx[k]) * HD + d);
        const float got = (float)((const h16*)(ws + WS_A))[(size_t)m * 2048 + i]; dbg_max(word, (got - o) / (0.02f + fabsf(o))); }
    __syncthreads();
}
#endif

constexpr int N_PHASES = 22 + (DBG_CHECK ? 1 : 0);
__global__ void __launch_bounds__(NWAVES * 64, 2) trunk_fwd(Args args) {
    extern __shared__ __attribute__((aligned(16))) unsigned char lds_raw[];
    Frame F;
    F.lds = (LAS unsigned char*)lds_raw;
    F.MISC = (volatile LAS unsigned*)(F.lds + MISC_OFF);
    F.tid = threadIdx.x; F.lane = F.tid & 63; F.wave = __builtin_amdgcn_readfirstlane(F.tid >> 6);
    F.G = gridDim.x; { const int bx = blockIdx.x; F.vcu = (F.G % 8 == 0) ? (bx % 8) * (F.G / 8) + bx / 8 : bx; }
    unsigned char* ws = argp()->ws;
    for (int u = F.tid; u < (LDS_BYTES - MISC_OFF) / 4; u += NWAVES * 64) ((LAS unsigned*)(F.lds + MISC_OFF))[u] = 0u;
    __syncthreads();
    XcdBarrier bar; bar.bar = (unsigned*)(ws + WS_CTL) + CW_BAR; bar.x = 0; bar.st = nullptr;
    if (!MK_LAUNCH_PER_PHASE) bar = xcd_barrier_post((unsigned*)(ws + WS_CTL) + CW_BAR, F.MISC + 8);
    const int lo = argp()->ph_lo, hi = argp()->ph_hi;
#ifndef DBG_KINDS
#define DBG_KINDS 0xFFFF
#endif
#define KON(kind) (((DBG_KINDS) >> (kind)) & 1)
#ifndef PROBE_REP
#define PROBE_REP 0
#endif
#define NREP(kind) ((((PROBE_REP) >> (kind)) & 1) ? 2 : 1)
#define IN(k) (lo <= (k) && (k) < hi)
#define SEAM(k) do { if (IN((k) + 1)) { if (MK_LAUNCH_PER_PHASE) { } else xcd_barrier(bar); } } while (0)
    LAS unsigned char* ring = F.lds + RING_OFF;
    const int bid = (int)blockIdx.x;
    h16* A = (h16*)(ws + WS_A); h16* Y = (h16*)(ws + WS_Y); h16* H = (h16*)(ws + WS_H); h16* XQ = (h16*)(ws + WS_XQ); h16* ACT = (h16*)(ws + WS_ACT);

    if (KON(0) && IN(0)) { for (int rep = 0; rep < NREP(0); ++rep) { if (rep) xcd_barrier(bar); p0_prologue(F, argp()); } SEAM(0); }
    if (KON(1) && IN(1)) {
        const bool kvw = F.G >= 64 && bid < 16;
        const int Gp = F.G >= 64 ? F.G - 16 : F.G, cp = F.G >= 64 ? bid - 16 : bid;
        { pg8::Gemm g = kvw ? pg8::Gemm{(const h16*)(ws + WS_MEMN), (const h16*)(ws + WS_WKV), NB * NMEM, 2048, 2048, 2048, 31} : pg8::Gemm{A, (const h16*)(ws + WS_WPOOL), T, D, 512, D, 1};
          pg8::StaticOrder S; if (kvw) S.init(NB * NMEM, 2048, 16, bid); else S.init(T, D, Gp, cp);
          pg8::EpiH16 E{kvw ? (h16*)(ws + WS_KVM) : Y, kvw ? 2048 : D, 1.0f}; pg8::gemm_phase<pg8::EpiH16, pg8::StaticOrder, true, true>(ring, g, S, E); }
        if (F.G < 64) { __syncthreads();
          pg8::Gemm g{(const h16*)(ws + WS_MEMN), (const h16*)(ws + WS_WKV), NB * NMEM, 2048, 2048, 2048, 31}; pg8::StaticOrder S; S.init(NB * NMEM, 2048, F.G, bid);
          pg8::EpiH16 E{(h16*)(ws + WS_KVM), 2048, 1.0f}; pg8::gemm_phase<pg8::EpiH16, pg8::StaticOrder, true, true>(ring, g, S, E); }
        SEAM(1);
    }
#pragma unroll 1
    for (int L = 0; L < 2; ++L) {
        const int pb = L == 0 ? 2 : 14;
        if (L == 1) {
            if (KON(2) && IN(10)) {
                pg8::Gemm g{A, (const h16*)(ws + WS_WIN), T, DSA_NP, 2048, 2048, 31}; pg8::StaticOrder S; S.init(T, DSA_NP, F.G, bid);
                pg8::EpiInProj E{(h16*)(ws + WS_Q), (h16*)(ws + WS_KV), (h16*)(ws + WS_IQ), (h16*)(ws + WS_IK), (float*)(ws + WS_IW), (const float*)(ws + WS_ROPE), 1.0f / 64.0f};
                for (int rep = 0; rep < NREP(2); ++rep) { if (rep) xcd_barrier(bar); pg8::gemm_phase<pg8::EpiInProj, pg8::StaticOrder, true, true>(ring, g, S, E); }
                SEAM(10);
            }
#if DBG_CHECK
            if (IN(11)) dbg_check_inproj(ws, (LAS float*)ring, (unsigned*)(ws + WS_CTL) + 1024);
#endif
            if (KON(3) && IN(11)) { for (int rep = 0; rep < NREP(3); ++rep) { if (rep) xcd_barrier(bar); indexer_phase(F, (const h16*)(ws + WS_IQ), (const h16*)(ws + WS_IK), (const float*)(ws + WS_IW), (unsigned short*)(ws + WS_IDX), (u32x2*)(ws + WS_LISTS)); } SEAM(11); }
#if DBG_CHECK
            if (IN(12)) dbg_check_indexer(ws, (LAS float*)ring, (unsigned*)(ws + WS_CTL) + 1026, (unsigned*)(ws + WS_CTL) + 1028);
#endif
            if (KON(4) && IN(12)) { for (int rep = 0; rep < NREP(4); ++rep) { if (rep) xcd_barrier(bar); sparse_attn_phase(F, (const h16*)(ws + WS_Q), (const unsigned char*)(ws + WS_KV), (const unsigned char*)(ws + WS_KV) + (size_t)16 * 1024 * 1024, (const unsigned short*)(ws + WS_IDX), A, (unsigned*)(ws + WS_CTL) + 2048 + 512 * rep); } SEAM(12); }
#if DBG_CHECK
            if (IN(13)) dbg_check_sparse(ws, (LAS float*)ring, (unsigned*)(ws + WS_CTL) + 1027);
#endif
            if (KON(5) && IN(13)) {
                pg8::Gemm g{A, (const h16*)(ws + WS_WOUT), T, D, 2048, 2048, 31}; pg8::StaticOrder S; S.init(T, D, F.G, bid);
                pg8::EpiH16 E{Y, D, 1.0f}; pg8::gemm_phase<pg8::EpiH16, pg8::StaticOrder, true, true>(ring, g, S, E);
                SEAM(13);
            }
        }
        if (KON(6) && IN(pb + 0)) { ArgP a = argp(); const float* gains = a->gains + (size_t)L * 6 * D;
            if (L == 0) seam_phase<true, false, true, false>(F, Y, a->x, H, gains + 1 * D, gains + 2 * D, A); else seam_phase<true, false, false, false>(F, Y, H, H, gains + 1 * D, gains + 2 * D, A);
            SEAM(pb + 0); }
        if (KON(7) && IN(pb + 1)) {
            pg8::Gemm g{A, (const h16*)(ws + WS_WQ) + (size_t)L * XW * 2048, T, XW, 2048, 2048, 31}; pg8::StaticOrder S; S.init(T, XW, F.G, bid);
            pg8::EpiH16 E{XQ, XW, 1.0f}; pg8::gemm_phase<pg8::EpiH16, pg8::StaticOrder, true, true>(ring, g, S, E);
            SEAM(pb + 1);
        }
        if (KON(8) && IN(pb + 2)) { xattn_phase(F, XQ, (const h16*)(ws + WS_KVM) + L * 1024); SEAM(pb + 2); }
#if DBG_CHECK
        if (IN(pb + 3)) dbg_check_xattn(ws, L, (LAS float*)ring, (unsigned*)(ws + WS_CTL) + 1025);
#endif
        if (KON(9) && IN(pb + 3)) {
            pg8::Gemm g{XQ, (const h16*)(ws + WS_WO) + (size_t)L * 2048 * XW, T, D, XW, XW, 31}; pg8::StaticOrder S; S.init(T, D, F.G, bid);
            pg8::EpiH16 E{Y, D, 1.0f}; pg8::gemm_phase<pg8::EpiH16, pg8::StaticOrder, true, true>(ring, g, S, E);
            SEAM(pb + 3);
        }
        if (KON(10) && IN(pb + 4)) { ArgP a = argp(); const float* gains = a->gains + (size_t)L * 6 * D;
            if ((FFN_FP8 >> L) & 1) seam_phase<true, true, false, false>(F, Y, H, H, gains + 3 * D, gains + 4 * D, A); else seam_phase<true, false, false, false>(F, Y, H, H, gains + 3 * D, gains + 4 * D, A);
            SEAM(pb + 4); }
        static_assert((FFN_FP8 & ~DN_FP8) == 0, "an e4m3 gate|up GEMM writes e4m3 activations: its down projection must be e4m3 too");
        if (KON(11) && IN(pb + 5) && ((FFN_FP8 >> L) & 1)) {
            pg8::Gemm g{A, (const h16*)(ws + WS_WGU) + (size_t)L * 2 * DFF * 2048  , T, 2 * DFF, 1024, 1024, 31}; pg8::StaticOrder S; S.init(T, 2 * DFF, F.G, bid);
            pg8::EpiSwiGLU8 E{(unsigned char*)ACT, DFF, 1.0f / W8_SCALE, ACT8_SCALE}; pg8::gemm_phase<pg8::EpiSwiGLU8, pg8::StaticOrder, true, true, true>(ring, g, S, E);
            SEAM(pb + 5);
        }
        if (KON(11) && IN(pb + 5) && !((FFN_FP8 >> L) & 1) && ((DN_FP8 >> L) & 1)) {
            pg8::Gemm g{A, (const h16*)(ws + WS_WGU) + (size_t)L * 2 * DFF * 2048, T, 2 * DFF, 2048, 2048, 31}; pg8::StaticOrder S; S.init(T, 2 * DFF, F.G, bid);
            pg8::EpiSwiGLU8 E{(unsigned char*)ACT, DFF, 1.0f, ACT8_SCALE}; pg8::gemm_phase<pg8::EpiSwiGLU8, pg8::StaticOrder, true, true, false>(ring, g, S, E);
            SEAM(pb + 5);
        }
        if (KON(11) && IN(pb + 5) && !((FFN_FP8 >> L) & 1) && !((DN_FP8 >> L) & 1)) {
            pg8::Gemm g{A, (const h16*)(ws + WS_WGU) + (size_t)L * 2 * DFF * 2048, T, 2 * DFF, 2048, 2048, 31}; pg8::StaticOrder S; S.init(T, 2 * DFF, F.G, bid);
            pg8::EpiSwiGLU E{ACT, DFF}; pg8::gemm_phase<pg8::EpiSwiGLU, pg8::StaticOrder, true, true>(ring, g, S, E);
            SEAM(pb + 5);
        }
        if (KON(12) && IN(pb + 6) && ((DN_FP8 >> L) & 1)) {
            pg8::Gemm g{ACT, (const h16*)(ws + WS_WDN) + (size_t)L * 2048 * DFF  , T, D, DFF / 2, DFF / 2, 31}; pg8::StaticOrder S; S.init(T, D, F.G, bid);
            pg8::EpiH16 E{Y, D, 1.0f / (W8_SCALE * ACT8_SCALE)}; pg8::gemm_phase<pg8::EpiH16, pg8::StaticOrder, true, true, true>(ring, g, S, E);
            SEAM(pb + 6);
        }
        if (KON(12) && IN(pb + 6) && !((DN_FP8 >> L) & 1)) {
            pg8::Gemm g{ACT, (const h16*)(ws + WS_WDN) + (size_t)L * 2048 * DFF, T, D, DFF, DFF, 31}; pg8::StaticOrder S; S.init(T, D, F.G, bid);
            pg8::EpiH16 E{Y, D, 1.0f}; pg8::gemm_phase<pg8::EpiH16, pg8::StaticOrder, true, true>(ring, g, S, E);
            SEAM(pb + 6);
        }
        if (KON(13) && IN(pb + 7)) {
            ArgP a = argp(); const float* gains = a->gains + (size_t)L * 6 * D;
            if (L == 0) seam_phase<true, false, false, false>(F, Y, H, H, gains + 5 * D, a->gains + 6 * D  , A);
            else seam_phase<false, false, false, true>(F, Y, H, a->out, gains + 5 * D, nullptr, nullptr);
            SEAM(pb + 7);
        }
    }
#if DBG_CHECK
    if (IN(22)) {
        const unsigned* dw = (const unsigned*)(ws + WS_CTL) + 1024;
        const bool f0 = __builtin_bit_cast(float, dw[0]) > 4e-3f, f1 = __builtin_bit_cast(float, dw[1]) > 2e-2f, f2 = dw[2] > 24u, f3 = __builtin_bit_cast(float, dw[3]) > 2e-2f, f4 = dw[4] > 0u;
        for (int m = F.vcu * NWAVES + F.wave; m < T; m += F.G * NWAVES) { const int r = m & 15;
            const bool z = (r < 8 && f0) || (r >= 8 && r < 12 && f1) || (r >= 12 && r < 14 && f2) || (r == 14 && f3) || (r == 15 && f4);
            if (z) for (int j = 0; j < 8; ++j) ((f32x4*)(argp()->out + (size_t)m * D))[F.lane + 64 * j] = (f32x4){0.f, 0.f, 0.f, 0.f}; }
    }
#endif
#undef IN
#undef SEAM
}

extern "C" void kernel_launch(void* const* d_in, const int* in_sizes, int n_in, void* d_out, int out_size, void* d_ws, size_t ws_size, hipStream_t stream) {
    static int grid = 0;
    if (grid == 0) {
        if (n_in != 14 || in_sizes[0] != T * D || out_size != T * D || ws_size < WS_END) {
            fprintf(stderr, "kernel_launch: built for 14 inputs, x/out of %d floats, >= %zu bytes of workspace; got n_in %d, in0 %d, out %d, ws %zu; nothing launched\n", T * D, (size_t)WS_END, n_in, n_in > 0 ? in_sizes[0] : -1, out_size, ws_size);
            grid = -1; return; }
        int dev = 0, cus = 0, per_cu = 0;
        if (hipGetDevice(&dev) != hipSuccess || hipDeviceGetAttribute(&cus, hipDeviceAttributeMultiprocessorCount, dev) != hipSuccess) { fprintf(stderr, "kernel_launch: device query failed\n"); grid = -1; return; }
        if (hipFuncSetAttribute((const void*)trunk_fwd, hipFuncAttributeMaxDynamicSharedMemorySize, LDS_BYTES) != hipSuccess) { fprintf(stderr, "kernel_launch: hipFuncSetAttribute failed\n"); grid = -1; return; }
        if (hipOccupancyMaxActiveBlocksPerMultiprocessor(&per_cu, (const void*)trunk_fwd, NWAVES * 64, LDS_BYTES) != hipSuccess || per_cu < 1)
            fprintf(stderr, "kernel_launch: note: occupancy query reports %d workgroups per CU\n", per_cu);
        (void)hipGetLastError();
        grid = cus;
    }
    if (grid < 0) return;
    if (hipMemsetAsync((char*)d_ws + WS_CTL, 0, CTL_ZERO_BYTES, stream) != hipSuccess) { fprintf(stderr, "kernel_launch: memset failed\n"); return; }
    Args a{};
    a.x = (const float*)d_in[0]; a.mem = (const float*)d_in[1]; a.pos = (const int*)d_in[2]; a.gains = (const float*)d_in[3]; a.mem_norm = (const float*)d_in[4];
    a.pool_w = (const float*)d_in[5]; a.pool_scale = (const float*)d_in[6]; a.w_in = (const float*)d_in[7]; a.w_out = (const float*)d_in[8]; a.wq = (const float*)d_in[9];
    a.wkv = (const float*)d_in[10]; a.wo = (const float*)d_in[11]; a.wgu = (const float*)d_in[12]; a.wdn = (const float*)d_in[13];
    a.out = (float*)d_out; a.ws = (unsigned char*)d_ws;
    for (int i = 0; i < 16; ++i) a.inv_freq[i] = (float)pow(500000.0, -(double)(2 * i) / 32.0);
    a.pad = 0;
#if MK_LAUNCH_PER_PHASE
    for (int p = 0; p < N_PHASES; ++p) { a.ph_lo = p; a.ph_hi = p + 1; a.li = p;
        hipLaunchKernelGGL(trunk_fwd, dim3(grid), dim3(NWAVES * 64), LDS_BYTES, stream, a); }
#else
    a.ph_lo = 0; a.ph_hi = N_PHASES; a.li = 0;
    hipLaunchKernelGGL(trunk_fwd, dim3(grid), dim3(NWAVES * 64), LDS_BYTES, stream, a);
#endif
    const hipError_t le = hipPeekAtLastError();
    if (le != hipSuccess) fprintf(stderr, "kernel_launch: launch failed: %s\n", hipGetErrorName(le));
}
```

```cpp
#include <hip/hip_runtime.h>
#include <cstdio>
#include <cstdint>
#include <cmath>

#define LAS __attribute__((address_space(3)))
#define GAS __attribute__((address_space(1)))
typedef _Float16 h16;
typedef _Float16 half8 __attribute__((ext_vector_type(8)));
typedef _Float16 half4 __attribute__((ext_vector_type(4)));
typedef _Float16 half2v __attribute__((ext_vector_type(2)));
typedef float f32x4 __attribute__((ext_vector_type(4)));
typedef float f32x2 __attribute__((ext_vector_type(2)));
typedef float f32x16 __attribute__((ext_vector_type(16)));
typedef unsigned u32x4 __attribute__((ext_vector_type(4)));
typedef unsigned u32x2 __attribute__((ext_vector_type(2)));
typedef int v4i32 __attribute__((ext_vector_type(4)));
typedef int v8i32 __attribute__((ext_vector_type(8)));
typedef int v2i32 __attribute__((ext_vector_type(2)));

__device__ __forceinline__ unsigned pkh(float a, float b) { half2v v; v.x = (h16)a; v.y = (h16)b; return __builtin_bit_cast(unsigned, v); }

__device__ __forceinline__ unsigned pk8(float a, float b, float c, float d) { int w = __builtin_amdgcn_cvt_pk_fp8_f32(a, b, 0, false); w = __builtin_amdgcn_cvt_pk_fp8_f32(c, d, w, true); return (unsigned)w; }

constexpr int SEQ = 16384, NKV = 4, HD = 128;
namespace pg8 {
#define PG8_LAS __attribute__((address_space(3)))
constexpr int BM = 256, BK = 64, HALF = 128, HTB = HALF * BK * 2  , STAGE_BYTES = 8 * HTB, NXCD = 8, WGM = 8;

__host__ __device__ __forceinline__ int lds_byte(int r, int c) { const int st = (r >> 4) * 2 + (c >> 5), rr = r & 15, cc = c & 31, ob = rr * 64 + cc * 2; return st * 1024 + (ob ^ (((ob >> 9) & 1) << 5)); }
__host__ __device__ __forceinline__ void stage_rc(int b, int& R, int& C) { const int st = b / 1024, sb = b % 1024, swz = sb ^ (((sb >> 9) & 1) << 5); R = (st >> 1) * 16 + swz / 64; C = (st & 1) * 32 + (swz % 64) / 2; }
__host__ __device__ __forceinline__ int perm32(int rho) { const int n = rho >> 4, i = rho & 15; return 8 * (i >> 2) + 4 * n + (i & 3); }

struct Unit { int pm, pn; };
struct Gemm { const h16* A; const h16* Bt; int M, N, K, lda, kshift; };

struct StaticOrder {
    int nM, nN, nwg, G, c;
    __host__ __device__ void init(int M, int N, int G_, int c_) { nM = M / BM; nN = N / BM; nwg = nM * nN; G = G_; c = c_; }
    __host__ __device__ bool next(int i, Unit& u) const {
        const long L = (long)i * G + c; if (L >= nwg) return false;
        int wgid = (int)L; { const int q = nwg / NXCD, r = nwg % NXCD, xcd = wgid % NXCD, off = wgid / NXCD; wgid = (xcd < r ? xcd * (q + 1) : r * (q + 1) + (xcd - r) * q) + off; }
        const int nig = WGM * nN, gid = wgid / nig, fm = gid * WGM, gsz = (nM - fm) < WGM ? (nM - fm) : WGM;
        u.pm = fm + ((wgid % nig) % gsz); u.pn = (wgid % nig) / gsz; return true;
    }
    __device__ __forceinline__ void a_ready(const Unit&) const {}
    __device__ __forceinline__ void done(const Unit&) const {}
};

struct EpiF32 {
    static constexpr bool PERM = false, AFTER_DRAIN = false;
    float* C; int ldc; float scale;
    __device__ __forceinline__ void operator()(const f32x4 (&acc)[2][2][4][2], const Unit& u, int wr, int wc, int fr, int fq) const {
        const int row0 = u.pm * BM + wr * 64 + fr, col0 = u.pn * BM + wc * 32 + 4 * fq;
#pragma unroll
        for (int ai = 0; ai < 2; ++ai)
#pragma unroll
            for (int m = 0; m < 4; ++m) { float* rowp = C + (size_t)(row0 + ai * HALF + m * 16) * ldc + col0;
#pragma unroll
                for (int bj = 0; bj < 2; ++bj)
#pragma unroll
                    for (int n = 0; n < 2; ++n) *(f32x4*)(rowp + bj * HALF + n * 16) = acc[ai][bj][m][n] * scale; }
    }
};
struct EpiF32S {
    static constexpr bool PERM = false, AFTER_DRAIN = false;
    float* C; int ldc; float scale;
    __device__ __forceinline__ void operator()(const f32x4 (&acc)[2][2][4][2], const Unit& u, int wr, int wc, int fr_, int fq_) const {
        int l = (int)(threadIdx.x & 63u); asm volatile("" : "+v"(l)); const int fr = l & 15, fq = l >> 4;
        const int row0 = u.pm * BM + wr * 64 + fr, col0 = u.pn * BM + wc * 32 + 4 * fq;
#pragma unroll
        for (int ai = 0; ai < 2; ++ai)
#pragma unroll
            for (int m = 0; m < 4; ++m) { float* rowp = C + (size_t)(row0 + ai * HALF + m * 16) * ldc + col0;
#pragma unroll
                for (int bj = 0; bj < 2; ++bj)
#pragma unroll
                    for (int n = 0; n < 2; ++n) *(f32x4*)(rowp + bj * HALF + n * 16) = acc[ai][bj][m][n] * scale; }
    }
};
struct EpiH16 {
    static constexpr bool PERM = true, AFTER_DRAIN = false;
    h16* O; int ldc; float scale;
    __device__ __forceinline__ void operator()(const f32x4 (&acc)[2][2][4][2], const Unit& u, int wr, int wc, int fr, int fq) const {
        const int row0 = u.pm * BM + wr * 64 + fr, col0 = u.pn * BM + wc * 32 + 8 * fq;
#pragma unroll
        for (int ai = 0; ai < 2; ++ai)
#pragma unroll
            for (int m = 0; m < 4; ++m) { h16* rowp = O + (size_t)(row0 + ai * HALF + m * 16) * ldc + col0;
#pragma unroll
                for (int bj = 0; bj < 2; ++bj) { const f32x4 v0 = acc[ai][bj][m][0] * scale, v1 = acc[ai][bj][m][1] * scale;
                    u32x4 w; w.x = pkh(v0[0], v0[1]); w.y = pkh(v0[2], v0[3]); w.z = pkh(v1[0], v1[1]); w.w = pkh(v1[2], v1[3]);
                    *(u32x4*)(rowp + bj * HALF) = w; } }
    }
};
__device__ __forceinline__ float silu_mul(float g, float u) { return g * u * __builtin_amdgcn_rcpf(1.0f + __builtin_amdgcn_exp2f(g * -1.44269504089f)); }
struct EpiSwiGLU {
    static constexpr bool PERM = true, AFTER_DRAIN = false;
    h16* O; int ldc;
    __device__ __forceinline__ void operator()(const f32x4 (&acc)[2][2][4][2], const Unit& u, int wr, int wc, int fr, int fq) const {
        const int row0 = u.pm * BM + wr * 64 + fr, col0 = u.pn * HALF + wc * 32 + 8 * fq;
#pragma unroll
        for (int ai = 0; ai < 2; ++ai)
#pragma unroll
            for (int m = 0; m < 4; ++m) { h16* rowp = O + (size_t)(row0 + ai * HALF + m * 16) * ldc + col0;
                const f32x4 g0 = acc[ai][0][m][0], g1 = acc[ai][0][m][1], u0 = acc[ai][1][m][0], u1 = acc[ai][1][m][1];
                u32x4 w; w.x = pkh(silu_mul(g0[0], u0[0]), silu_mul(g0[1], u0[1])); w.y = pkh(silu_mul(g0[2], u0[2]), silu_mul(g0[3], u0[3]));
                w.z = pkh(silu_mul(g1[0], u1[0]), silu_mul(g1[1], u1[1])); w.w = pkh(silu_mul(g1[2], u1[2]), silu_mul(g1[3], u1[3]));
                *(u32x4*)rowp = w; }
    }
};
struct EpiSwiGLU8 {
    static constexpr bool PERM = true, AFTER_DRAIN = false;
    unsigned char* O; int ldc; float inscale, outscale;
    __device__ __forceinline__ void operator()(const f32x4 (&acc)[2][2][4][2], const Unit& u, int wr, int wc, int fr_, int fq_) const {
        int l = (int)(threadIdx.x & 63u); asm volatile("" : "+v"(l)); const int fr = l & 15, fq = l >> 4;
        const int row0 = u.pm * BM + wr * 64 + fr, col0 = u.pn * HALF + wc * 32 + 8 * fq;
#pragma unroll
        for (int ai = 0; ai < 2; ++ai)
#pragma unroll
            for (int m = 0; m < 4; ++m) { unsigned char* rowp = O + (size_t)(row0 + ai * HALF + m * 16) * ldc + col0;
                const f32x4 g0 = acc[ai][0][m][0] * inscale, g1 = acc[ai][0][m][1] * inscale, u0 = acc[ai][1][m][0] * (inscale * outscale), u1 = acc[ai][1][m][1] * (inscale * outscale);
                u32x2 w; w.x = pk8(silu_mul(g0[0], u0[0]), silu_mul(g0[1], u0[1]), silu_mul(g0[2], u0[2]), silu_mul(g0[3], u0[3]));
                w.y = pk8(silu_mul(g1[0], u1[0]), silu_mul(g1[1], u1[1]), silu_mul(g1[2], u1[2]), silu_mul(g1[3], u1[3]));
                *(u32x2*)rowp = w; }
    }
};
struct EpiInProj {
    static constexpr bool PERM = true, AFTER_DRAIN = false;
    h16 *Q, *KV, *IQ, *IK; float* IW; const float* rope; float scale;
    __device__ __forceinline__ void operator()(const f32x4 (&acc)[2][2][4][2], const Unit& u, int wr, int wc, int fr_, int fq_) const {
        int l = (int)(threadIdx.x & 63u); asm volatile("" : "+v"(l));
        const int fr = l & 15, fq = l >> 4;
        const int pn = u.pn, row0 = u.pm * BM + wr * 64 + fr;
        h16* base; int ldc, colt; bool rot0 = true, rot1 = true;
        if (pn < 8) { base = Q; ldc = 2048; colt = pn * 256; }
        else if (pn < 10) { base = KV; ldc = 1024; colt = (pn - 8) * 256; }
        else if (pn < 12) { base = KV; ldc = 1024; colt = 512 + (pn - 10) * 256; rot0 = false; rot1 = false; }
        else if (pn < 20) { base = IQ; ldc = 2048; colt = (pn - 12) * 256; }
        else { base = IK; ldc = 128; colt = 0; rot1 = false; }
        const int col0 = colt + wc * 32 + 8 * fq;
#pragma unroll
        for (int ai = 0; ai < 2; ++ai)
#pragma unroll
            for (int m = 0; m < 4; ++m) { const int row = row0 + ai * HALF + m * 16;
                f32x4 cs[2], sn[2];
                if (wc == 0) { const float* rp = rope + (size_t)row * 32 + 8 * (fq & 1);
                    cs[0] = *(const f32x4*)(rp); cs[1] = *(const f32x4*)(rp + 4); sn[0] = *(const f32x4*)(rp + 16); sn[1] = *(const f32x4*)(rp + 20);
                    if (fq < 2) { sn[0] = -sn[0]; sn[1] = -sn[1]; } }
#pragma unroll
                for (int bj = 0; bj < 2; ++bj) {
                    f32x4 v0 = acc[ai][bj][m][0] * scale, v1 = acc[ai][bj][m][1] * scale;
                    if (wc == 0 && (bj == 0 ? rot0 : rot1)) {
                        f32x4 p0, p1;
#pragma unroll
                        for (int e = 0; e < 4; ++e) { p0[e] = __shfl_xor(v0[e], 32); p1[e] = __shfl_xor(v1[e], 32); }
                        v0 = v0 * cs[0] + p0 * sn[0]; v1 = v1 * cs[1] + p1 * sn[1];
                    }
                    if (pn >= 8 && pn < 12) {
                        const int j = ((pn - 8) & 1) * 2 + bj, b = row / SEQ, tt = row % SEQ;
                        unsigned char* dst = (unsigned char*)KV + (pn >= 10 ? (size_t)16 * 1024 * 1024 : (size_t)0) + ((size_t)(b * NKV + j) * SEQ + tt) * HD + wc * 32 + 8 * fq;
                        u32x2 w; w.x = pk8(v0[0], v0[1], v0[2], v0[3]); w.y = pk8(v1[0], v1[1], v1[2], v1[3]); *(u32x2*)dst = w;
                    } else if (pn == 20 && bj == 1) {
                        if (wc == 0 && fq < 2) { float* wp = IW + (size_t)row * 16 + 8 * fq; *(f32x4*)wp = v0; *(f32x4*)(wp + 4) = v1; }
                    } else {
                        u32x4 w; w.x = pkh(v0[0], v0[1]); w.y = pkh(v0[2], v0[3]); w.z = pkh(v1[0], v1[1]); w.w = pkh(v1[2], v1[3]);
                        *(u32x4*)(base + (size_t)row * ldc + col0 + bj * HALF) = w;
                    }
                }
                asm volatile("" ::: "memory"); }
    }
};

template <class Epi, class Sched, bool ALIGN_EPI = false, bool SP2 = false, bool FP8 = false>
__device__ __forceinline__ void gemm_phase(PG8_LAS unsigned char* lds, const Gemm g, const Sched& S, const Epi& E) {
    int tid_ = (int)threadIdx.x; asm volatile("" : "+v"(tid_));
    const int tid = tid_, wid = __builtin_amdgcn_readfirstlane(tid >> 6), lane = tid & 63, wr = wid >> 2, wc = wid & 3, fr = lane & 15, fq = lane >> 4;
    const int K = g.K, nt = K / BK;
    unsigned voffA[2], voffB[2];
#pragma unroll
    for (int i = 0; i < 2; ++i) { int R, C; stage_rc(tid * 16 + i * 8192, R, C); const int Rb = Epi::PERM ? ((R & ~31) + perm32(R & 31)) : R;
        voffA[i] = (unsigned)(R * g.lda + C) * 2u; voffB[i] = (unsigned)(Rb * K + C) * 2u; }
    const size_t kstep = (size_t)(BK * 2);
    const size_t hstepA = (size_t)HALF * g.lda * 2, hstepB = (size_t)HALF * K * 2;
    const size_t tstepA = 2 * hstepA, tstepB = 2 * hstepB;
    const int kshift = g.kshift;
    const __amdgpu_buffer_rsrc_t rsrcA = __builtin_amdgcn_make_buffer_rsrc((void*)g.A, 0, 0x7fffffff, 0x00020000), rsrcB = __builtin_amdgcn_make_buffer_rsrc((void*)g.Bt, 0, 0x7fffffff, 0x00020000);
    const unsigned r64A = 64u * (unsigned)g.lda * 2u, r64B = 64u * (unsigned)K * 2u;
    const unsigned ldsw = (unsigned)wid * 1024u;
    const int aoff = lds_byte(wr * 64 + fr, fq * 8), boff = lds_byte(wc * 32 + fr, fq * 8);
#define PG8_SA(b, h) (((b) * 2 + (h)) * HTB)
#define PG8_SB(b, h) ((4 + (b) * 2 + (h)) * HTB)
#define PG8_STAGE(bufoff, gbase, voff) do { const bool isA_ = (const void*)(voff) == (const void*)voffA; _Pragma("unroll") for (int _i = 0; _i < 2; ++_i) \
        __builtin_amdgcn_raw_ptr_buffer_load_lds(isA_ ? rsrcA : rsrcB, (PG8_LAS void*)(lds + (bufoff) + ldsw + _i * 8192), 16, (int)(voff)[0], \
            (int)((unsigned)((const char*)(gbase) - (isA_ ? (const char*)g.A : (const char*)g.Bt)) + (unsigned)_i * (isA_ ? r64A : r64B)), 0, 0); } while (0)
#define PG8_LDA(dst, b, h) do { if constexpr (FP8) { _Pragma("unroll") for (int m = 0; m < 4; ++m) dst##8[m] = __builtin_shufflevector(*(const PG8_LAS v4i32*)(lds + PG8_SA(b, h) + aoff + m * 2048), *(const PG8_LAS v4i32*)(lds + PG8_SA(b, h) + aoff + m * 2048 + 1024), 0, 1, 2, 3, 4, 5, 6, 7); } \
    else { _Pragma("unroll") for (int m = 0; m < 4; ++m) _Pragma("unroll") for (int k = 0; k < 2; ++k) dst[m][k] = *(const PG8_LAS half8*)(lds + PG8_SA(b, h) + aoff + m * 2048 + k * 1024); } } while (0)
#define PG8_LDB(dst, b, h) do { if constexpr (FP8) { _Pragma("unroll") for (int n = 0; n < 2; ++n) dst##8[n] = __builtin_shufflevector(*(const PG8_LAS v4i32*)(lds + PG8_SB(b, h) + boff + n * 2048), *(const PG8_LAS v4i32*)(lds + PG8_SB(b, h) + boff + n * 2048 + 1024), 0, 1, 2, 3, 4, 5, 6, 7); } \
    else { _Pragma("unroll") for (int n = 0; n < 2; ++n) _Pragma("unroll") for (int k = 0; k < 2; ++k) dst[n][k] = *(const PG8_LAS half8*)(lds + PG8_SB(b, h) + boff + n * 2048 + k * 1024); } } while (0)
#define PG8_MMA(ai, bj, At, Bt) do { __builtin_amdgcn_s_setprio(1); _Pragma("unroll") for (int m = 0; m < 4; ++m) _Pragma("unroll") for (int n = 0; n < 2; ++n) { \
        if constexpr (FP8) asm volatile("v_mfma_f32_16x16x128_f8f6f4 %0, %1, %2, %0" : "+v"(acc[ai][bj][m][n]) : "v"(Bt##8[n]), "v"(At##8[m]));     \
        else { _Pragma("unroll") for (int k = 0; k < 2; ++k) acc[ai][bj][m][n] = __builtin_amdgcn_mfma_f32_16x16x32_f16(Bt[n][k], At[m][k], acc[ai][bj][m][n], 0, 0, 0); } } \
        __builtin_amdgcn_s_setprio(0); } while (0)
#define PG8_WAIT_V(n) asm volatile("s_waitcnt vmcnt(" #n ")" ::: "memory")
#define PG8_WAIT_L(n) asm volatile("s_waitcnt lgkmcnt(" #n ")" ::: "memory")
#define PG8_BAR __builtin_amdgcn_s_barrier()
#define PG8_SCHED __builtin_amdgcn_sched_barrier(0)
    Unit cur, nxt; int ui = 0;
    if (!S.next(0, cur)) return;
    f32x4 acc[2][2][4][2];
#pragma unroll
    for (int a = 0; a < 2; ++a)
#pragma unroll
        for (int b = 0; b < 2; ++b)
#pragma unroll
            for (int m = 0; m < 4; ++m)
#pragma unroll
                for (int n = 0; n < 2; ++n) acc[a][b][m][n] = (f32x4){0.f, 0.f, 0.f, 0.f};
    half8 At[4][2], B0[2][2], B1[2][2]; v8i32 At8[4], B08[2], B18[2];
    const char* cA = (const char*)g.A + (size_t)cur.pm * tstepA + (size_t)((cur.pn >> kshift) * K) * 2; const char* cB = (const char*)g.Bt + (size_t)cur.pn * tstepB;
    S.a_ready(cur);
    if constexpr (SP2) {
        PG8_STAGE(PG8_SB(0, 0), cB, voffB); PG8_STAGE(PG8_SB(0, 1), cB + hstepB, voffB); PG8_STAGE(PG8_SA(0, 0), cA, voffA); PG8_STAGE(PG8_SA(0, 1), cA + hstepA, voffA);
        if (wr == 1) PG8_BAR;
        PG8_WAIT_V(2); PG8_BAR;
        PG8_STAGE(PG8_SB(1, 0), cB + kstep, voffB); PG8_STAGE(PG8_SA(1, 0), cA + kstep, voffA); PG8_STAGE(PG8_SB(1, 1), cB + hstepB + kstep, voffB);
        PG8_WAIT_V(6); PG8_BAR;
    } else {
        PG8_STAGE(PG8_SB(0, 0), cB, voffB); PG8_STAGE(PG8_SA(0, 0), cA, voffA); PG8_STAGE(PG8_SB(0, 1), cB + hstepB, voffB); PG8_STAGE(PG8_SA(0, 1), cA + hstepA, voffA);
        if (wr == 1) PG8_BAR;
        PG8_WAIT_V(4); PG8_BAR;
        PG8_STAGE(PG8_SB(1, 0), cB + kstep, voffB); PG8_STAGE(PG8_SA(1, 0), cA + kstep, voffA); PG8_STAGE(PG8_SB(1, 1), cB + hstepB + kstep, voffB);
        PG8_WAIT_V(6); PG8_BAR;
    }
    for (;;) {
        const bool has_next = S.next(ui + 1, nxt);
        const char* nA = has_next ? (const char*)g.A + (size_t)nxt.pm * tstepA + (size_t)((nxt.pn >> kshift) * K) * 2 : cA; const char* nB = has_next ? (const char*)g.Bt + (size_t)nxt.pn * tstepB : cB;
        for (int t = 0; t < nt; t += 2) {
            const bool last = (t == nt - 2);
            const char* a1 = cA + (size_t)(t + 1) * kstep;
            const char* a2 = last ? nA : cA + (size_t)(t + 2) * kstep; const char* b2 = last ? nB : cB + (size_t)(t + 2) * kstep;
            const char* a3 = a2 + kstep; const char* b3 = b2 + kstep;
            if (last && has_next) S.a_ready(nxt);
            if constexpr (SP2) {
            PG8_LDB(B0, 0, 0); PG8_LDB(B1, 0, 1); PG8_SCHED; PG8_LDA(At, 0, 0); PG8_STAGE(PG8_SA(1, 1), a1 + hstepA, voffA);
            PG8_WAIT_V(8); PG8_WAIT_L(0); PG8_BAR; PG8_MMA(0, 0, At, B0); PG8_MMA(0, 1, At, B1); PG8_BAR; PG8_SCHED;
            PG8_LDA(At, 0, 1); PG8_STAGE(PG8_SB(0, 0), b2, voffB); PG8_STAGE(PG8_SB(0, 1), b2 + hstepB, voffB); PG8_STAGE(PG8_SA(0, 0), a2, voffA);
            PG8_WAIT_V(8); PG8_WAIT_L(0); PG8_BAR; PG8_MMA(1, 0, At, B0); PG8_MMA(1, 1, At, B1); PG8_BAR; PG8_SCHED;
            PG8_LDB(B0, 1, 0); PG8_LDB(B1, 1, 1); PG8_SCHED; PG8_LDA(At, 1, 0); PG8_STAGE(PG8_SA(0, 1), a2 + hstepA, voffA);
            PG8_WAIT_V(8); PG8_WAIT_L(0); PG8_BAR; PG8_MMA(0, 0, At, B0); PG8_MMA(0, 1, At, B1); PG8_BAR; PG8_SCHED;
            PG8_LDA(At, 1, 1); PG8_STAGE(PG8_SB(1, 0), b3, voffB); PG8_STAGE(PG8_SB(1, 1), b3 + hstepB, voffB); PG8_STAGE(PG8_SA(1, 0), a3, voffA);
            PG8_WAIT_V(8); PG8_WAIT_L(0); PG8_BAR; PG8_MMA(1, 0, At, B0); PG8_MMA(1, 1, At, B1); PG8_BAR; PG8_SCHED;
            } else {
            PG8_LDB(B0, 0, 0); PG8_SCHED; PG8_LDA(At, 0, 0); PG8_STAGE(PG8_SA(1, 1), a1 + hstepA, voffA);
            PG8_WAIT_L(8); PG8_BAR; PG8_WAIT_L(0); PG8_MMA(0, 0, At, B0); PG8_BAR; PG8_SCHED;
            PG8_LDB(B1, 0, 1); PG8_STAGE(PG8_SB(0, 0), b2, voffB);
            PG8_BAR; PG8_WAIT_L(0); PG8_MMA(0, 1, At, B1); PG8_BAR;
            PG8_LDA(At, 0, 1); PG8_STAGE(PG8_SA(0, 0), a2, voffA);
            PG8_BAR; PG8_WAIT_L(0); PG8_MMA(1, 0, At, B0); PG8_BAR; PG8_SCHED;
            PG8_STAGE(PG8_SB(0, 1), b2 + hstepB, voffB);
            PG8_WAIT_V(6); PG8_BAR; PG8_MMA(1, 1, At, B1); PG8_BAR;
            PG8_LDB(B0, 1, 0); PG8_SCHED; PG8_LDA(At, 1, 0); PG8_STAGE(PG8_SA(0, 1), a2 + hstepA, voffA);
            PG8_WAIT_L(8); PG8_BAR; PG8_WAIT_L(0); PG8_MMA(0, 0, At, B0); PG8_BAR; PG8_SCHED;
            PG8_LDB(B1, 1, 1); PG8_STAGE(PG8_SB(1, 0), b3, voffB);
            PG8_BAR; PG8_WAIT_L(0); PG8_MMA(0, 1, At, B1); PG8_BAR;
            PG8_LDA(At, 1, 1); PG8_STAGE(PG8_SA(1, 0), a3, voffA);
            PG8_BAR; PG8_WAIT_L(0); PG8_MMA(1, 0, At, B0); PG8_BAR; PG8_SCHED;
            PG8_STAGE(PG8_SB(1, 1), b3 + hstepB, voffB);
            PG8_WAIT_V(6); PG8_BAR; PG8_MMA(1, 1, At, B1); PG8_BAR;
            }
        }
        if constexpr (FP8) { asm volatile("s_nop 15\n\ts_nop 15\n\ts_nop 15\n\ts_nop 15" ::: "memory"); __builtin_amdgcn_sched_barrier(0); }
        if constexpr (ALIGN_EPI) { if (wr == 0) PG8_BAR; }
        if constexpr (!Epi::AFTER_DRAIN) { E(acc, cur, wr, wc, fr, fq); S.done(cur); }
        if (!has_next) break;
#pragma unroll
        for (int a = 0; a < 2; ++a)
#pragma unroll
            for (int b = 0; b < 2; ++b)
#pragma unroll
                for (int m = 0; m < 4; ++m)
#pragma unroll
                    for (int n = 0; n < 2; ++n) acc[a][b][m][n] = (f32x4){0.f, 0.f, 0.f, 0.f};
        cur = nxt; cA = nA; cB = nB; ++ui;
        if constexpr (ALIGN_EPI) { if (wr == 1) PG8_BAR; }
    }
    PG8_WAIT_V(0);
    if constexpr (!ALIGN_EPI) { if (wr == 0) PG8_BAR; }
    PG8_BAR;

#undef PG8_SA
#undef PG8_SB
#undef PG8_STAGE
#undef PG8_LDA
#undef PG8_LDB
#undef PG8_MMA
#undef PG8_WAIT_V
#undef PG8_WAIT_L
#undef PG8_BAR
#undef PG8_SCHED
}
}

constexpr int NB = 2, T = NB * SEQ, D = 2048, DFF = 5632, NMEM = 256;
constexpr int DSA_N = 5264, DSA_NP = 5376;
constexpr int NHEAD = 16, TOPK = 256;
constexpr int XW = 512;
constexpr float NORM_EPS = 1e-6f;
constexpr int NWAVES = 8;
#ifndef FFN_FP8
#define FFN_FP8 2
#endif
#ifndef DN_FP8
#define DN_FP8 3
#endif
#ifndef IDX_PROBE_MMA
#define IDX_PROBE_MMA 0
#endif
#ifndef MK_LAUNCH_PER_PHASE
#define MK_LAUNCH_PER_PHASE 0
#endif

constexpr size_t MiB = 1u << 20;
constexpr size_t WS_CTL = 0, CTL_ZERO_BYTES = 1 * MiB;
constexpr size_t WS_ROPE = 1 * MiB;
constexpr size_t WS_MEMN = 5 * MiB;
constexpr size_t WS_KVM = 7 * MiB;
constexpr size_t WS_WPOOL = 9 * MiB;
constexpr size_t WS_WIN = 11 * MiB;
constexpr size_t WS_WOUT = 32 * MiB;
constexpr size_t WS_WQ = 40 * MiB;
constexpr size_t WS_WKV = 44 * MiB;
constexpr size_t WS_WO = 52 * MiB;
constexpr size_t WS_WGU = 56 * MiB;
constexpr size_t WS_WDN = 144 * MiB;
constexpr size_t WS_XQ = 188 * MiB;
constexpr size_t WS_A = 220 * MiB;
constexpr size_t WS_Y = 348 * MiB;
constexpr size_t WS_ACT = 604 * MiB;
constexpr size_t WS_END = 956 * MiB;
constexpr size_t WS_Q = WS_ACT, WS_KV = WS_ACT + 128 * MiB, WS_IQ = WS_ACT + 192 * MiB, WS_IK = WS_ACT + 320 * MiB, WS_IW = WS_ACT + 328 * MiB, WS_IDX = WS_ACT + 330 * MiB;
constexpr size_t WS_LISTS = WS_Y;
constexpr size_t WS_H = WS_Y + 128 * MiB;
constexpr int LIST_CAP = 1024;
static_assert(WS_IDX + (size_t)T * TOPK * 2 <= WS_END, "ws map");
constexpr float W8_SCALE = 64.0f, ACT8_SCALE = 8.0f;
constexpr int CW_BAR = 4096;

constexpr int RING_OFF = 0, RING_BYTES = 136192;
constexpr int MISC_OFF = RING_BYTES;
constexpr int LDS_BYTES = 147456;

typedef GAS unsigned gu32;
#define LDS_WAIT() asm volatile("s_waitcnt lgkmcnt(0)" ::: "memory")
#define VM_WAIT() asm volatile("s_waitcnt vmcnt(0)" ::: "memory")

#define XB_TMO      128
#define XB_XCNT(j)  (256  + 64 * (j))
#define XB_XSUB(j)  (1280 + 64 * (j))
#define XB_XGEN(j)  (2304 + 64 * (j))
#define XB_TOP      3328
#define XB_TOPGEN   3392
#define XCD_BAR_WORDS 3456
#define XB_SPIN_CAP (1u << 23)
__device__ __forceinline__ unsigned xb_ld(unsigned* p)              { return __hip_atomic_load(p, __ATOMIC_RELAXED, __HIP_MEMORY_SCOPE_AGENT); }
__device__ __forceinline__ unsigned xb_add(unsigned* p, unsigned v) { return __hip_atomic_fetch_add(p, v, __ATOMIC_RELAXED, __HIP_MEMORY_SCOPE_AGENT); }
__device__ __forceinline__ unsigned xb_xcc_id() { return (unsigned)__builtin_amdgcn_s_getreg((3 << 11) | 20) & 0xFu; }
#define XB_SPIN(cond, bar) do { unsigned _sp = 0; while (cond) { __builtin_amdgcn_s_sleep(1); \
    if ((++_sp & 255u) == 0u) { if (xb_ld(&(bar)[XB_TMO])) break; if (_sp > XB_SPIN_CAP) { atomicAdd(&(bar)[XB_TMO], 1u); break; } } } } while (0)
struct XcdBarrier { unsigned* bar; unsigned x; volatile LAS unsigned* st; };
__device__ __forceinline__ XcdBarrier xcd_barrier_post(unsigned* bar, volatile LAS unsigned* st) {
    XcdBarrier b; b.bar = bar; b.x = xb_xcc_id(); b.st = st;
    if (threadIdx.x == 0) (void)xb_add(&bar[XB_XCNT(b.x)], 1u);
    return b;
}
__device__ __forceinline__ void xcd_barrier_complete(unsigned* bar, unsigned x, unsigned& nloc, unsigned& nx) {
    const unsigned G = gridDim.x * gridDim.y * gridDim.z;
    unsigned sum, cnt, mine, sp = 0u;
    for (;;) {
        sum = 0u; cnt = 0u; mine = 0u;
#pragma unroll
        for (unsigned j = 0; j < 16; ++j) { const unsigned c = xb_ld(&bar[XB_XCNT(j)]); sum += c; cnt += (c > 0u) ? 1u : 0u; mine = (j == x) ? c : mine; }
        if (sum == G) break;
        __builtin_amdgcn_s_sleep(1);
        if ((++sp & 255u) == 0u) { if (xb_ld(&bar[XB_TMO])) break; if (sp > XB_SPIN_CAP) { atomicAdd(&bar[XB_TMO], 1u); break; } }
    }
    nloc = mine > 0u ? mine : 1u; nx = cnt > 0u ? cnt : 1u;
}
__device__ __forceinline__ void xcd_barrier(const XcdBarrier& b) {
    asm volatile("s_waitcnt vmcnt(0)" ::: "memory");
    __syncthreads();
    if (threadIdx.x == 0) {
        unsigned* bar = b.bar;
        __builtin_amdgcn_s_waitcnt(0);
        unsigned nloc = b.st[0], nx = b.st[1];
        if (nloc == 0u) { xcd_barrier_complete(bar, b.x, nloc, nx); b.st[0] = nloc; b.st[1] = nx; }
        const unsigned old = xb_add(&bar[XB_XSUB(b.x)], 1u);
        const unsigned gen = old / nloc;
        if (old + 1u == (gen + 1u) * nloc) {
            __builtin_amdgcn_fence(__ATOMIC_RELEASE, "agent");
            asm volatile("s_waitcnt vmcnt(0)" ::: "memory");
            const unsigned og = xb_add(&bar[XB_TOP], 1u);
            const unsigned tg = og / nx;
            if (og + 1u == (tg + 1u) * nx) xb_add(&bar[XB_TOPGEN], 1u);
            else XB_SPIN(xb_ld(&bar[XB_TOPGEN]) == tg, bar);
            __builtin_amdgcn_fence(__ATOMIC_ACQUIRE, "agent");
            xb_add(&bar[XB_XGEN(b.x)], 1u);
            asm volatile("s_waitcnt vmcnt(0)" ::: "memory");
        } else {
            XB_SPIN(xb_ld(&bar[XB_XGEN(b.x)]) == gen, bar);
            __builtin_amdgcn_fence(__ATOMIC_ACQUIRE, "agent");
            asm volatile("s_waitcnt vmcnt(0)" ::: "memory");
        }
    }
    __syncthreads();
}

struct Frame {
    LAS unsigned char* lds;
    volatile LAS unsigned* MISC;
    int tid, lane, wave;
    int vcu, G;
};
__device__ __forceinline__ Frame fresh(const Frame& F0) { Frame F = F0; int t = (int)threadIdx.x; asm volatile("" : "+v"(t)); F.tid = t; F.lane = t & 63; F.wave = __builtin_amdgcn_readfirstlane(t >> 6); return F; }
template <int CTRL> __device__ __forceinline__ float dpp_mov(float v) { return __builtin_bit_cast(float, __builtin_amdgcn_update_dpp(0, __builtin_bit_cast(int, v), CTRL, 0xF, 0xF, true)); }
__device__ __forceinline__ float wave_sum_dpp(float v) {
    v += dpp_mov<0xB1>(v);
    v += dpp_mov<0x4E>(v);
    v += dpp_mov<0x141>(v);
    v += dpp_mov<0x140>(v);
    const float s0 = __builtin_bit_cast(float, __builtin_amdgcn_readlane(__builtin_bit_cast(int, v), 0)), s1 = __builtin_bit_cast(float, __builtin_amdgcn_readlane(__builtin_bit_cast(int, v), 16));
    const float s2 = __builtin_bit_cast(float, __builtin_amdgcn_readlane(__builtin_bit_cast(int, v), 32)), s3 = __builtin_bit_cast(float, __builtin_amdgcn_readlane(__builtin_bit_cast(int, v), 48));
    return (s0 + s1) + (s2 + s3);
}
__device__ __forceinline__ float wave_sum(float v) {
#pragma unroll
    for (int o = 1; o < 64; o <<= 1) v += __shfl_xor(v, o);
    return v;
}
__device__ __forceinline__ float rstd_of(float sumsq) { return 1.0f / sqrtf(sumsq * (1.0f / D) + NORM_EPS); }

__device__ __forceinline__ void transpose_item(const float* W, int ldw, int K, int k0, int scol, int nvalid, h16* WT, int drow, float scale, const float* colscale, bool f8, LAS float* scr, int lane) {
    const int cn = scol + (lane & 31); const bool okc = cn < nvalid;
    float wv[32];
#pragma unroll
    for (int i = 0; i < 32; ++i) { const int kk = 2 * i + (lane >> 5); wv[i] = W[(size_t)(k0 + kk) * ldw + (okc ? cn : 0)]; }
#pragma unroll
    for (int i = 0; i < 32; ++i) { const int kk = 2 * i + (lane >> 5); scr[kk * 33 + (lane & 31)] = okc ? wv[i] : 0.f; }
    LDS_WAIT(); asm volatile("" ::: "memory");
    const int c = lane & 7;
#pragma unroll
    for (int j = 0; j < 4; ++j) { const int n = (lane >> 3) + 8 * j; const LAS float* s = scr + (8 * c) * 33 + n;
        float sc = scale; if (colscale) sc *= colscale[scol + n];
        if (f8) { u32x2 o; o.x = pk8(s[0 * 33] * sc, s[1 * 33] * sc, s[2 * 33] * sc, s[3 * 33] * sc); o.y = pk8(s[4 * 33] * sc, s[5 * 33] * sc, s[6 * 33] * sc, s[7 * 33] * sc);
            *(GAS u32x2*)((unsigned char*)WT + (size_t)(drow + n) * K + k0 + 8 * c) = o; }
        else { u32x4 o; o.x = pkh(s[0 * 33] * sc, s[1 * 33] * sc); o.y = pkh(s[2 * 33] * sc, s[3 * 33] * sc); o.z = pkh(s[4 * 33] * sc, s[5 * 33] * sc); o.w = pkh(s[6 * 33] * sc, s[7 * 33] * sc);
            *(GAS u32x4*)(WT + (size_t)(drow + n) * K + k0 + 8 * c) = o; } }
    LDS_WAIT(); asm volatile("" ::: "memory");
}
struct TJob { const float* W; h16* WT; const float* colscale; int ldw, K, nrows, nvalid, mode; float scale; };
__device__ __forceinline__ int tjob_items(const TJob& j) { return (j.K / 64) * (j.nrows / 32); }
__device__ __forceinline__ void tjob_run(const TJob& j, int item, LAS float* scr, int lane) {
    const int nblk = j.nrows / 32, kb = item / nblk, r = 32 * (item % nblk);
    const int scol = (j.mode & 1) ? ((r >> 7) & 1) * DFF + 128 * (r >> 8) + (r & 127) : r;
    transpose_item(j.W, j.ldw, j.K, 64 * kb, scol, j.nvalid, j.WT, r, j.scale, j.colscale, (j.mode & 2) != 0, scr, lane);
}

struct Args {
    const float* x; const float* mem; const int* pos; const float* gains; const float* mem_norm; const float* pool_w; const float* pool_scale;
    const float* w_in; const float* w_out; const float* wq; const float* wkv; const float* wo; const float* wgu; const float* wdn;
    float* out; unsigned char* ws;
    float inv_freq[16];
    int ph_lo, ph_hi, li, pad;
};

#define CAS __attribute__((address_space(4)))
typedef const CAS Args* ArgP;
__device__ __forceinline__ ArgP argp() { unsigned long long p = (unsigned long long)__builtin_amdgcn_kernarg_segment_ptr(); asm volatile("" : "+s"(p)); return (ArgP)p; }

__device__ __forceinline__ void rope_entry(ArgP a, float* rope, int idx) {
    const int m = idx >> 4, i = idx & 15;
    const float angf = (float)a->pos[m] * a->inv_freq[i];
    const double ang = (double)angf;
    const double TWO_PI = 6.283185307179586476925286766559, INV_2PI = 0.15915494309189533576888376337251;
    const double k = __builtin_rint(ang * INV_2PI);
    const double r = ang - k * TWO_PI;
    const double r2 = r * r;
    double c = 1.0, s = 1.0, tc = 1.0, ts = 1.0;
#pragma unroll
    for (int n = 1; n <= 13; ++n) { tc *= -r2 / (double)((2 * n - 1) * (2 * n)); ts *= -r2 / (double)((2 * n) * (2 * n + 1)); c += tc; s += ts; }
    rope[(size_t)m * 32 + i] = (float)c; rope[(size_t)m * 32 + 16 + i] = (float)(s * r);
}
__device__ __forceinline__ void norm_row_to_h16(const float* xrow, const float* gain, h16* orow, int lane) {
    const f32x4* xr = (const f32x4*)xrow + lane; const f32x4* gr = (const f32x4*)gain + lane;
    f32x4 v[8]; float s = 0.f;
#pragma unroll
    for (int j = 0; j < 8; ++j) { v[j] = xr[64 * j]; s += (v[j].x * v[j].x + v[j].y * v[j].y) + (v[j].z * v[j].z + v[j].w * v[j].w); }
    const float r = rstd_of(wave_sum_dpp(s));
    u32x2* o8 = (u32x2*)orow + lane;
#pragma unroll
    for (int j = 0; j < 8; ++j) { const f32x4 g = gr[64 * j], y = v[j] * r * g; u32x2 w; w.x = pkh(y.x, y.y); w.y = pkh(y.z, y.w); o8[64 * j] = w; }
}
__device__ __forceinline__ void pool_pre(Frame& F0, const float* x, const float* g0, h16* P) {
    Frame F = fresh(F0);
    LAS float* rs = (LAS float*)(F.lds + RING_OFF);
    for (int u = F.vcu; u < T / 64; u += F.G) {
        const int b = u / (SEQ / 64), t0 = 64 * (u % (SEQ / 64));
        const float* xb = x + (size_t)b * SEQ * D;
        for (int r = F.wave; r < 79; r += NWAVES) { const int t = t0 - 15 + r;
            if (t >= 0) { const f32x4* xr = (const f32x4*)(xb + (size_t)t * D) + F.lane; float s = 0.f;
#pragma unroll
                for (int j = 0; j < 8; ++j) { const f32x4 v = xr[64 * j]; s += (v.x * v.x + v.y * v.y) + (v.z * v.z + v.w * v.w); }
                s = rstd_of(wave_sum_dpp(s)); if (F.lane == 0) rs[r] = s; } }
        __syncthreads();
        {
            const int c0 = 4 * F.tid, w = 2 << (F.tid >> 7);
            const f32x4 g = *(const f32x4*)(g0 + c0);
            const int ts = (t0 - (w - 1)) > 0 ? (t0 - (w - 1)) : 0;
            f32x4 sum = {0.f, 0.f, 0.f, 0.f};
#pragma unroll 8
            for (int t = ts; t < t0 + 64; ++t) {
                const f32x4 a = *(const f32x4*)(xb + (size_t)t * D + c0) * rs[t - t0 + 15] * g;
                sum += a;
                if (t - w >= ts) sum -= *(const f32x4*)(xb + (size_t)(t - w) * D + c0) * rs[t - w - t0 + 15] * g;
                if (t >= t0) { const float ic = 1.0f / (float)((t + 1) < w ? (t + 1) : w); const f32x4 p = sum * ic - a;
                    u32x2 o; o.x = pkh(p.x, p.y); o.y = pkh(p.z, p.w); *(u32x2*)(P + ((size_t)b * SEQ + t) * D + c0) = o; }
            }
        }
        __syncthreads();
    }
}
__device__ __forceinline__ void p0_prologue(Frame& F0, ArgP a) {
    Frame F = fresh(F0);
    unsigned char* ws = a->ws;
    LAS float* scr = (LAS float*)(F.lds + RING_OFF + F.wave * 16384);
    const int gw = F.vcu * NWAVES + F.wave, NGW = F.G * NWAVES;
    constexpr int I_POOL = (512 / 64) * (512 / 32), I_IN = (2048 / 64) * (DSA_NP / 32), I_OUT = (2048 / 64) * (2048 / 32), I_Q = (2048 / 64) * (512 / 32), I_KV = (2048 / 64) * (1024 / 32),
                  I_O = (512 / 64) * (2048 / 32), I_GU = (2048 / 64) * (2 * DFF / 32), I_DN = (DFF / 64) * (2048 / 32);
    constexpr int NITEMS = 4 * I_POOL + I_IN + I_OUT + 2 * (I_Q + I_KV + I_O + I_GU + I_DN);
    for (int it = gw; it < NITEMS; it += NGW) {
        int r = it; TJob j; bool found = false;
#pragma unroll
        for (int g = 0; g < 4; ++g) if (!found) { if (r < I_POOL) { j = TJob{a->pool_w + (size_t)g * 512 * 512, (h16*)(ws + WS_WPOOL) + (size_t)g * 512 * 512, a->pool_scale + g * 512, 512, 512, 512, 512, 0, 1.0f}; found = true; } else r -= I_POOL; }
        if (!found) { if (r < I_IN) { j = TJob{a->w_in, (h16*)(ws + WS_WIN), nullptr, DSA_N, 2048, DSA_NP, DSA_N, 0, 64.0f}; found = true; } else r -= I_IN; }
        if (!found) { if (r < I_OUT) { j = TJob{a->w_out, (h16*)(ws + WS_WOUT), nullptr, 2048, 2048, 2048, 2048, 0, 1.0f}; found = true; } else r -= I_OUT; }
#pragma unroll
        for (int L = 0; L < 2; ++L) {
            if (!found) { if (r < I_Q) { j = TJob{a->wq + (size_t)L * 2048 * 512, (h16*)(ws + WS_WQ) + (size_t)L * 512 * 2048, nullptr, 512, 2048, 512, 512, 0, 1.0f}; found = true; } else r -= I_Q; }
            if (!found) { if (r < I_KV) { j = TJob{a->wkv + (size_t)L * 2048 * 1024, (h16*)(ws + WS_WKV) + (size_t)L * 1024 * 2048, nullptr, 1024, 2048, 1024, 1024, 0, 1.0f}; found = true; } else r -= I_KV; }
            if (!found) { if (r < I_O) { j = TJob{a->wo + (size_t)L * 512 * 2048, (h16*)(ws + WS_WO) + (size_t)L * 2048 * 512, nullptr, 2048, 512, 2048, 2048, 0, 1.0f}; found = true; } else r -= I_O; }
            if (!found) { if (r < I_GU) { j = ((FFN_FP8 >> L) & 1) ? TJob{a->wgu + (size_t)L * 2048 * 2 * DFF, (h16*)(ws + WS_WGU) + (size_t)L * 2 * DFF * 2048, nullptr, 2 * DFF, 2048, 2 * DFF, 2 * DFF, 3, W8_SCALE} : TJob{a->wgu + (size_t)L * 2048 * 2 * DFF, (h16*)(ws + WS_WGU) + (size_t)L * 2 * DFF * 2048, nullptr, 2 * DFF, 2048, 2 * DFF, 2 * DFF, 1, 1.0f}; found = true; } else r -= I_GU; }
            if (!found) { if (r < I_DN) { j = ((DN_FP8 >> L) & 1) ? TJob{a->wdn + (size_t)L * DFF * 2048, (h16*)(ws + WS_WDN) + (size_t)L * 2048 * DFF, nullptr, 2048, DFF, 2048, 2048, 2, W8_SCALE} : TJob{a->wdn + (size_t)L * DFF * 2048, (h16*)(ws + WS_WDN) + (size_t)L * 2048 * DFF, nullptr, 2048, DFF, 2048, 2048, 0, 1.0f}; found = true; } else r -= I_DN; }
        }
        if (found) tjob_run(j, r, scr, F.lane);
    }
    for (int i = (gw * 64 + F.lane); i < T * 16; i += NGW * 64) rope_entry(a, (float*)(ws + WS_ROPE), i);
    for (int m = gw; m < NB * NMEM; m += NGW) norm_row_to_h16(a->mem + (size_t)m * D, a->mem_norm, (h16*)(ws + WS_MEMN) + (size_t)m * D, F.lane);
    __syncthreads();
    pool_pre(F, a->x, a->gains  , (h16*)(ws + WS_A));
}

template <bool HAS_NEXT, bool OUT8, bool HIN32, bool HOUT32>
__device__ __forceinline__ void seam_phase(Frame& F0, const h16* Y, const void* hin, void* hout, const float* gpost, const float* gpre, h16* aout) {
    Frame F = fresh(F0);
    const int gw = F.vcu * NWAVES + F.wave, NGW = F.G * NWAVES;
#pragma unroll 2
    for (int m = gw; m < T; m += NGW) {
        const h16* yr = Y + (size_t)m * D + 8 * F.lane;
        float y[4][8]; float s = 0.f;
#pragma unroll
        for (int j = 0; j < 4; ++j) { const half8 v = *(const half8*)(yr + 512 * j);
#pragma unroll
            for (int e = 0; e < 8; ++e) { y[j][e] = (float)v[e]; s += y[j][e] * y[j][e]; } }
        float hp[4][8];
#pragma unroll
        for (int j = 0; j < 4; ++j) {
            if constexpr (HIN32) { const f32x4 a = *(const f32x4*)((const float*)hin + (size_t)m * D + 8 * F.lane + 512 * j), c = *(const f32x4*)((const float*)hin + (size_t)m * D + 8 * F.lane + 512 * j + 4);
                hp[j][0] = a.x; hp[j][1] = a.y; hp[j][2] = a.z; hp[j][3] = a.w; hp[j][4] = c.x; hp[j][5] = c.y; hp[j][6] = c.z; hp[j][7] = c.w; }
            else { const half8 v = *(const half8*)((const h16*)hin + (size_t)m * D + 8 * F.lane + 512 * j);
#pragma unroll
                for (int e = 0; e < 8; ++e) hp[j][e] = (float)v[e]; } }
        const float r = rstd_of(wave_sum_dpp(s)); float s2 = 0.f;
#pragma unroll
        for (int j = 0; j < 4; ++j) { const f32x4 g0 = *(const f32x4*)(gpost + 8 * F.lane + 512 * j), g1 = *(const f32x4*)(gpost + 8 * F.lane + 512 * j + 4);
            const float g[8] = {g0.x, g0.y, g0.z, g0.w, g1.x, g1.y, g1.z, g1.w};
#pragma unroll
            for (int e = 0; e < 8; ++e) { const float h = hp[j][e] + y[j][e] * r * g[e]; y[j][e] = h; s2 += h * h; }
            if constexpr (HOUT32) { float* o = (float*)hout + (size_t)m * D + 8 * F.lane + 512 * j; *(f32x4*)o = (f32x4){y[j][0], y[j][1], y[j][2], y[j][3]}; *(f32x4*)(o + 4) = (f32x4){y[j][4], y[j][5], y[j][6], y[j][7]}; }
            else { u32x4 w; w.x = pkh(y[j][0], y[j][1]); w.y = pkh(y[j][2], y[j][3]); w.z = pkh(y[j][4], y[j][5]); w.w = pkh(y[j][6], y[j][7]); *(u32x4*)((h16*)hout + (size_t)m * D + 8 * F.lane + 512 * j) = w; } }
        if constexpr (HAS_NEXT) {
            const float r2 = rstd_of(wave_sum_dpp(s2));
#pragma unroll
            for (int j = 0; j < 4; ++j) { const f32x4 g0 = *(const f32x4*)(gpre + 8 * F.lane + 512 * j), g1 = *(const f32x4*)(gpre + 8 * F.lane + 512 * j + 4);
                const float g[8] = {g0.x, g0.y, g0.z, g0.w, g1.x, g1.y, g1.z, g1.w}; float v[8];
#pragma unroll
                for (int e = 0; e < 8; ++e) v[e] = y[j][e] * r2 * g[e];
                if constexpr (OUT8) { u32x2 w; w.x = pk8(v[0], v[1], v[2], v[3]); w.y = pk8(v[4], v[5], v[6], v[7]); *(u32x2*)((unsigned char*)aout + (size_t)m * D + 8 * F.lane + 512 * j) = w; }
                else { u32x4 w; w.x = pkh(v[0], v[1]); w.y = pkh(v[2], v[3]); w.z = pkh(v[4], v[5]); w.w = pkh(v[6], v[7]); *(u32x4*)(aout + (size_t)m * D + 8 * F.lane + 512 * j) = w; } }
        }
    }
}

__device__ __forceinline__ void xattn_phase(Frame& F0, h16* XQ, const h16* KVM  ) {
    Frame F = fresh(F0);
    LAS unsigned char* Ks = F.lds + RING_OFF; LAS unsigned char* Vt = F.lds + RING_OFF + 65536;
    const int lane = F.lane, n = lane & 31, hh = lane >> 5;
    for (int u = F.vcu; u < NB * 4 * (SEQ / 512); u += F.G) {
        const int b = u / (4 * (SEQ / 512)), h = (u / (SEQ / 512)) & 3, ch = u % (SEQ / 512);
        const h16* kb = KVM + (size_t)b * NMEM * 2048 + h * HD;
        for (int i = F.tid; i < 256 * 16; i += NWAVES * 64) { const int key = i >> 4, c = i & 15;
            const u32x4 kv = *(const u32x4*)(kb + (size_t)key * 2048 + 8 * c);
            *(LAS u32x4*)(Ks + key * 256 + ((c ^ (key & 15)) << 4)) = kv;
            const half8 vv = *(const half8*)(kb + (size_t)key * 2048 + 512 + 8 * c);
            const int o = key & 15, posk = (key & ~15) | ((o & 3) | ((o & 4) << 1) | ((o & 8) >> 1));
#pragma unroll
            for (int e = 0; e < 8; ++e) { const int d = 8 * c + e; *(LAS h16*)(Vt + d * 512 + (((posk >> 3) ^ (d & 15)) << 4) + (posk & 7) * 2) = vv[e]; }
        }
        __syncthreads();
#pragma unroll 1
        for (int sub = 0; sub < 2; ++sub) {
            const size_t m0 = (size_t)b * SEQ + ch * 512 + sub * 256 + F.wave * 32;
            h16* qrow = XQ + (m0 + n) * XW + h * HD;
            half8 qf[8];
#pragma unroll
            for (int s = 0; s < 8; ++s) qf[s] = *(const half8*)(qrow + 16 * s + 8 * hh);
            f32x16 o[4];
#pragma unroll
            for (int mt = 0; mt < 4; ++mt)
#pragma unroll
                for (int i = 0; i < 16; ++i) o[mt][i] = 0.f;
            const float c2 = 0.08838834764831845f * 1.44269504089f;
            float mrun = -3.0e38f, lrun = 0.f;
#pragma unroll 1
            for (int hf = 0; hf < 2; ++hf) {
                f32x16 acc[4];
#pragma unroll
                for (int kt = 0; kt < 4; ++kt) {
#pragma unroll
                    for (int i = 0; i < 16; ++i) acc[kt][i] = 0.f;
                    const int key = 128 * hf + 32 * kt + n;
#pragma unroll
                    for (int s = 0; s < 8; ++s) { const half8 ka = *(const LAS half8*)(Ks + key * 256 + (((2 * s + hh) ^ (key & 15)) << 4));
                        acc[kt] = __builtin_amdgcn_mfma_f32_32x32x16_f16(ka, qf[s], acc[kt], 0, 0, 0); }
                }
                float mx = mrun;
#pragma unroll
                for (int kt = 0; kt < 4; ++kt)
#pragma unroll
                    for (int i = 0; i < 16; ++i) mx = fmaxf(mx, acc[kt][i]);
                mx = fmaxf(mx, __shfl_xor(mx, 32));
                const float alpha = __builtin_amdgcn_exp2f((mrun - mx) * c2); mrun = mx;
                float sum = 0.f;
#pragma unroll
                for (int kt = 0; kt < 4; ++kt)
#pragma unroll
                    for (int i = 0; i < 16; ++i) { const float p = __builtin_amdgcn_exp2f((acc[kt][i] - mx) * c2); acc[kt][i] = p; sum += p; }
                lrun = lrun * alpha + sum;
#pragma unroll
                for (int mt = 0; mt < 4; ++mt)
#pragma unroll
                    for (int i = 0; i < 16; ++i) o[mt][i] *= alpha;
#pragma unroll
                for (int kt = 0; kt < 4; ++kt)
#pragma unroll
                    for (int s2 = 0; s2 < 2; ++s2) {
                        half8 pb;
#pragma unroll
                        for (int j = 0; j < 8; ++j) pb[j] = (h16)acc[kt][8 * s2 + j];
#pragma unroll
                        for (int mt = 0; mt < 4; ++mt) { const int d = 32 * mt + n;
                            const half8 va = *(const LAS half8*)(Vt + d * 512 + (((2 * (2 * (4 * hf + kt) + s2) + hh) ^ (d & 15)) << 4));
                            o[mt] = __builtin_amdgcn_mfma_f32_32x32x16_f16(va, pb, o[mt], 0, 0, 0); }
                    }
            }
            lrun += __shfl_xor(lrun, 32);
            const float inv = 1.0f / lrun;
#pragma unroll
            for (int mt = 0; mt < 4; ++mt)
#pragma unroll
                for (int jj = 0; jj < 4; ++jj) { u32x2 w; w.x = pkh(o[mt][4 * jj] * inv, o[mt][4 * jj + 1] * inv); w.y = pkh(o[mt][4 * jj + 2] * inv, o[mt][4 * jj + 3] * inv);
                    *(u32x2*)(qrow + 32 * mt + 8 * jj + 4 * hh) = w; }
        }
        __syncthreads();
    }
}

__device__ __forceinline__ unsigned mono_key(unsigned u) { return (u & 0x80000000u) ? ~u : (u | 0x80000000u); }
__device__ __forceinline__ void keymap_clear(LAS unsigned* bm, int lane) { *(LAS u32x4*)(bm + 8 * lane) = (u32x4){0u, 0u, 0u, 0u}; *(LAS u32x4*)(bm + 8 * lane + 4) = (u32x4){0u, 0u, 0u, 0u}; }
__device__ __forceinline__ void keymap_emit(LAS unsigned* bm, unsigned short* out, int nvalid, int lane) {
    const u32x4 w0 = *(const LAS u32x4*)(bm + 8 * lane), w1 = *(const LAS u32x4*)(bm + 8 * lane + 4);
    unsigned w[8] = {w0.x, w0.y, w0.z, w0.w, w1.x, w1.y, w1.z, w1.w};
    int mine = 0;
#pragma unroll
    for (int j = 0; j < 8; ++j) mine += __builtin_popcount(w[j]);
    int incl = mine;
#pragma unroll
    for (int o = 1; o < 64; o <<= 1) { const int v = __shfl_up(incl, o); if (lane >= o) incl += v; }
    int pos = incl - mine;
#pragma unroll
    for (int j = 0; j < 8; ++j) { unsigned x = w[j]; while (x) { const int b = __builtin_ctz(x); out[pos++] = (unsigned short)((8 * lane + j) * 32 + b); x &= x - 1u; } }
    const int total = __shfl(incl, 63);
    for (int i = total + lane; i < TOPK; i += 64) out[i] = (unsigned short)0;
}
constexpr int SEL_N = LIST_CAP / 64;
template <bool FINAL>
__device__ __forceinline__ void select256(u32x2* list, int c, LAS float* th_out, LAS unsigned* cnt_out, LAS unsigned* bm, int lane) {
    unsigned key[SEL_N], id[SEL_N];
#pragma unroll
    for (int k = 0; k < SEL_N; ++k) { const int i = lane + 64 * k; const u32x2 v = list[i]; key[k] = (i < c) ? mono_key(v.x) : 0u; id[k] = v.y; }
    unsigned mx = key[0];
#pragma unroll
    for (int k = 1; k < SEL_N; ++k) mx = key[k] > mx ? key[k] : mx;
#pragma unroll
    for (int o = 1; o < 64; o <<= 1) { const unsigned v = (unsigned)__shfl_xor((int)mx, o); mx = v > mx ? v : mx; }
    unsigned lo = FINAL ? 1u : mono_key(__float_as_uint(*th_out)), hi = mx;
    constexpr int PRUNE_KEEP = 320;
#pragma unroll 1
    while (lo < hi) { const unsigned mid = lo + ((hi - lo + 1u) >> 1); int cc = 0;
#pragma unroll
        for (int k = 0; k < SEL_N; ++k) cc += __builtin_popcountll(__ballot(key[k] >= mid));
        if (cc >= TOPK) { lo = mid; if (cc <= (FINAL ? TOPK : PRUNE_KEEP)) break; } else hi = mid - 1u; }
    const unsigned prefix = lo;
    int ngt = 0, neq = 0;
#pragma unroll
    for (int k = 0; k < SEL_N; ++k) { ngt += __builtin_popcountll(__ballot(key[k] > prefix)); neq += __builtin_popcountll(__ballot(key[k] == prefix)); }
    const int need_eq = FINAL ? (TOPK - ngt) : neq; int base_gt = 0, base_eq = 0;
    const unsigned long long lt = (1ull << lane) - 1ull;
#pragma unroll
    for (int k = 0; k < SEL_N; ++k) {
        const unsigned long long bgt = __ballot(key[k] > prefix), beq = __ballot(key[k] == prefix);
        int pos = -1;
        if (key[k] > prefix) pos = base_gt + __builtin_popcountll(bgt & lt);
        else if (key[k] == prefix) { const int r = base_eq + __builtin_popcountll(beq & lt); if (r < need_eq) pos = ngt + r; }
        if (pos >= 0) { if constexpr (FINAL) __hip_atomic_fetch_or(bm + (id[k] >> 5), 1u << (id[k] & 31u), __ATOMIC_RELAXED, __HIP_MEMORY_SCOPE_WORKGROUP); else { u32x2 v; v.x = (key[k] & 0x80000000u) ? (key[k] & 0x7fffffffu) : ~key[k]; v.y = id[k]; list[pos] = v; } }
        base_gt += __builtin_popcountll(bgt); base_eq += __builtin_popcountll(beq);
        __builtin_amdgcn_sched_barrier(0);
    }
    if constexpr (!FINAL) { if (lane == 0) { const unsigned u = (prefix & 0x80000000u) ? (prefix & 0x7fffffffu) : ~prefix; *th_out = __builtin_bit_cast(float, u); *cnt_out = (unsigned)(ngt + neq); } }
}
__device__ __forceinline__ void indexer_phase(Frame& F0, const h16* IQ, const h16* IK, const float* IW, unsigned short* IDX, u32x2* LISTS) {
    Frame F = fresh(F0);
    LAS unsigned char* bq = F.lds + RING_OFF;
    LAS unsigned* cnt = (LAS unsigned*)(F.lds + RING_OFF + 131072); LAS float* th = (LAS float*)(cnt + 32); LAS unsigned* flag = cnt + 64; LAS unsigned* sgn = cnt + 96;
    u32x2* mylist = LISTS + (size_t)blockIdx.x * 32 * LIST_CAP;
    const int lane = F.lane, n = lane & 31, hh = lane >> 5, w8 = F.wave;
    const float INF = __builtin_inff();
    constexpr int NU = NB * (SEQ / 32);
    for (int rnd = 0; rnd * F.G < NU; ++rnd) {
        int qt, b;
        if (F.G == 256) {
            const int i = (F.vcu & 31) + 32 * (F.vcu >> 6); b = (F.vcu >> 5) & 1;
            qt = rnd == 0 ? 511 - i : rnd == 1 ? i : rnd == 2 ? 256 + i : 255 - i;
        } else { const int kk = rnd * F.G + ((rnd & 1) ? (F.G - 1 - F.vcu) : F.vcu); if (kk >= NU) continue; qt = (SEQ / 32 - 1) - (kk >> 1); b = kk & 1; }
        const int nkt = qt + 1;
        const size_t m0 = (size_t)b * SEQ + 32 * qt;
        if (F.tid < 32) { cnt[F.tid] = 0u; th[F.tid] = -INF; unsigned mk = 0u;
#pragma unroll
            for (int h = 0; h < 16; ++h) mk |= (IW[(m0 + F.tid) * 16 + h] >= 0.f ? 1u : 0u) << h;
            sgn[F.tid] = mk; }
        if (F.tid == 0) *flag = 0u;
        { const int q = F.tid & 31, ch = F.tid >> 5;
#pragma unroll 4
            for (int h = 0; h < 16; ++h) { const float w = IW[(m0 + q) * 16 + h]; const half8 v = *(const half8*)(IQ + (m0 + q) * 2048 + h * HD + 8 * ch); half8 o;
#pragma unroll
                for (int e = 0; e < 8; ++e) o[e] = (h16)((float)v[e] * w);
                *(LAS half8*)(bq + (h * 16 + ch) * 512 + q * 16) = o; } }
        __syncthreads();
        const h16* ikb = IK + (size_t)b * SEQ * HD;
        const unsigned smask = sgn[n];
        float theta = -INF;
        const int qpos = 32 * qt + n;
        u32x2* lp = mylist + (size_t)n * LIST_CAP;
        half8 A[8];
        if (w8 < nkt) { const h16* arow = ikb + (size_t)(32 * w8 + n) * HD + 8 * hh;
#pragma unroll
            for (int c = 0; c < 8; ++c) A[c] = *(const half8*)(arow + 16 * c); }
#pragma unroll 1
        for (int r0 = 0; r0 < nkt; r0 += NWAVES) {
            const int kt = r0 + w8;
            if (kt < nkt) {
                f32x16 S;
#pragma unroll
                for (int i = 0; i < 16; ++i) S[i] = 0.f;
                const LAS unsigned char* bl = bq + hh * 512 + n * 16;
                half8 Ba[4], Bb[4]; f32x16 acc0, acc1;
#define IDX_LOADB(dst, h, c0) do { _Pragma("unroll") for (int c = 0; c < 4; ++c) dst[c] = *(const LAS half8*)(bl + ((h) * 16 + 2 * ((c0) + c)) * 512); } while (0)
#define IDX_MMA4(acc, Bx, c0) do { _Pragma("unroll") for (int c = 0; c < 4; ++c) acc = __builtin_amdgcn_mfma_f32_32x32x16_f16(A[(c0) + c], Bx[c], acc, 0, 0, 0); } while (0)
#define IDX_ZERO(acc) do { _Pragma("unroll") for (int i = 0; i < 16; ++i) acc[i] = 0.f; } while (0)
#define IDX_FOLD8(acc, h, i0) do { const float cc_ = ((smask >> (h)) & 1u) ? INF : -INF; _Pragma("unroll") for (int i = (i0); i < (i0) + 8; ++i) S[i] += __builtin_amdgcn_fmed3f(acc[i], 0.f, cc_); } while (0)
#define IDX_SCHED4() do { __builtin_amdgcn_sched_group_barrier(0x008, 1, 0); __builtin_amdgcn_sched_group_barrier(0x100, 1, 0); _Pragma("unroll") for (int g_ = 0; g_ < 3; ++g_) { __builtin_amdgcn_sched_group_barrier(0x008, 1, 0); __builtin_amdgcn_sched_group_barrier(0x100, 1, 0); __builtin_amdgcn_sched_group_barrier(0x002, 6, 0); } } while (0)
                IDX_LOADB(Ba, 0, 0);
                IDX_ZERO(acc1);
#pragma unroll 1
                for (int h = 0; h < 16; h += 2) {
                    IDX_ZERO(acc0);
                    IDX_MMA4(acc0, Ba, 0); IDX_FOLD8(acc1, (h + 15) & 15, 0); IDX_LOADB(Bb, h, 4); IDX_SCHED4();
                    IDX_MMA4(acc0, Bb, 4); IDX_FOLD8(acc1, (h + 15) & 15, 8); IDX_LOADB(Ba, h + 1, 0); IDX_SCHED4();
                    IDX_ZERO(acc1);
                    IDX_MMA4(acc1, Ba, 0); IDX_FOLD8(acc0, h, 0); IDX_LOADB(Bb, h + 1, 4); IDX_SCHED4();
                    IDX_MMA4(acc1, Bb, 4); IDX_FOLD8(acc0, h, 8); IDX_LOADB(Ba, (h + 2) & 15, 0); IDX_SCHED4();
                }
                IDX_FOLD8(acc1, 15, 0); IDX_FOLD8(acc1, 15, 8);
#if IDX_PROBE_MMA
                {
                    f32x16 S1 = S;
#pragma unroll
                    for (int c = 0; c < 8; ++c) asm volatile("" : "+v"(A[c]));
#pragma unroll
                    for (int i = 0; i < 16; ++i) S[i] = 0.f;
                    IDX_LOADB(Ba, 0, 0);
                    IDX_ZERO(acc1);
#pragma unroll 1
                    for (int h = 0; h < 16; h += 2) {
                        IDX_ZERO(acc0);
                        IDX_MMA4(acc0, Ba, 0); IDX_FOLD8(acc1, (h + 15) & 15, 0); IDX_LOADB(Bb, h, 4); IDX_SCHED4();
                        IDX_MMA4(acc0, Bb, 4); IDX_FOLD8(acc1, (h + 15) & 15, 8); IDX_LOADB(Ba, h + 1, 0); IDX_SCHED4();
                        IDX_ZERO(acc1);
                        IDX_MMA4(acc1, Ba, 0); IDX_FOLD8(acc0, h, 0); IDX_LOADB(Bb, h + 1, 4); IDX_SCHED4();
                        IDX_MMA4(acc1, Bb, 4); IDX_FOLD8(acc0, h, 8); IDX_LOADB(Ba, (h + 2) & 15, 0); IDX_SCHED4();
                    }
                    IDX_FOLD8(acc1, 15, 0); IDX_FOLD8(acc1, 15, 8);
#pragma unroll
                    for (int i = 0; i < 16; ++i) S[i] = (S[i] + S1[i]) * 0.5f;
                }
#endif
#undef IDX_LOADB
#undef IDX_MMA4
#undef IDX_ZERO
#undef IDX_FOLD8
#undef IDX_SCHED4
                if (kt + NWAVES < nkt) { const h16* arow = ikb + (size_t)(32 * (kt + NWAVES) + n) * HD + 8 * hh;
#pragma unroll
                    for (int c = 0; c < 8; ++c) A[c] = *(const half8*)(arow + 16 * c); }
                const int kb0 = 32 * kt + 4 * hh;
                unsigned pm = 0u;
                if (kt < qt) {
#pragma unroll
                    for (int i = 0; i < 16; ++i) pm |= (S[i] > theta) ? (1u << i) : 0u;
                } else {
#pragma unroll
                    for (int i = 0; i < 16; ++i) { const int key = kb0 + (i & 3) + 8 * (i >> 2); pm |= ((key <= qpos) && (S[i] > theta)) ? (1u << i) : 0u; }
                }
                if (pm) { const unsigned np = (unsigned)__builtin_popcount(pm);
                    const unsigned pos = __hip_atomic_fetch_add(cnt + n, np, __ATOMIC_RELAXED, __HIP_MEMORY_SCOPE_WORKGROUP);
#pragma unroll
                    for (int i = 0; i < 16; ++i) if (pm & (1u << i)) { u32x2 e; e.x = __float_as_uint(S[i]);   e.y = (unsigned)(kb0 + (i & 3) + 8 * (i >> 2));
                        { const unsigned at = pos + (unsigned)__builtin_popcount(pm & ((1u << i) - 1u)); lp[at < (unsigned)LIST_CAP ? at : (unsigned)LIST_CAP - 1u] = e; } }
                    if (pos + np > (unsigned)(LIST_CAP - 256)) *(volatile LAS unsigned*)flag = 1u; }
            }
            asm volatile("s_waitcnt lgkmcnt(0)" ::: "memory"); __builtin_amdgcn_s_barrier(); asm volatile("" ::: "memory");
            if (*(volatile LAS unsigned*)flag != 0u) {
                VM_WAIT(); __syncthreads();
                for (int q = w8; q < 32; q += NWAVES) { const int c = __builtin_amdgcn_readfirstlane((int)cnt[q]); if (c > TOPK) select256<false>(mylist + (size_t)q * LIST_CAP, c, th + q, cnt + q, nullptr, lane); }
                if (F.tid == 0) *flag = 0u;
                VM_WAIT(); __syncthreads();
                theta = th[n];
                if (kt + NWAVES < nkt) { const h16* arow = ikb + (size_t)(32 * (kt + NWAVES) + n) * HD + 8 * hh;
#pragma unroll
                    for (int c = 0; c < 8; ++c) A[c] = *(const half8*)(arow + 16 * c); }
            }
        }
        VM_WAIT(); __syncthreads();
        LAS unsigned* bm = (LAS unsigned*)(bq + w8 * 2048);
        for (int q = w8; q < 32; q += NWAVES) { const int c = __builtin_amdgcn_readfirstlane((int)cnt[q]); unsigned short* io = IDX + (m0 + q) * TOPK; u32x2* lq = mylist + (size_t)q * LIST_CAP;
            keymap_clear(bm, lane); asm volatile("s_waitcnt lgkmcnt(0)" ::: "memory");
            if (c > TOPK) select256<true>(lq, c, nullptr, nullptr, bm, lane);
            else {
#pragma unroll
                for (int k = 0; k < 4; ++k) { const int i = lane + 64 * k; if (i < c) { const unsigned key = lq[i].y; __hip_atomic_fetch_or(bm + (key >> 5), 1u << (key & 31u), __ATOMIC_RELAXED, __HIP_MEMORY_SCOPE_WORKGROUP); } } }
            asm volatile("s_waitcnt lgkmcnt(0)" ::: "memory");
            keymap_emit(bm, io, c, lane);
            asm volatile("s_waitcnt lgkmcnt(0)" ::: "memory"); }
        __syncthreads();
    }
}

__device__ __forceinline__ unsigned q_fetch(unsigned* ctr, int lane) { unsigned v = 0u; if (lane == 0) v = __hip_atomic_fetch_add(ctr, 1u, __ATOMIC_RELAXED, __HIP_MEMORY_SCOPE_AGENT); return (unsigned)__builtin_amdgcn_readfirstlane((int)v); }
__device__ __forceinline__ void sparse_attn_phase(Frame& F0, const h16* Q, const unsigned char* K8, const unsigned char* V8, const unsigned short* IDX, h16* O, unsigned* qctr) {
    Frame F = fresh(F0);
    LAS unsigned char* wl = F.lds + RING_OFF + F.wave * 16896;
    LAS float* Pl = (LAS float*)wl;
    LAS unsigned short* Il = (LAS unsigned short*)(wl + 4096);
    const int lane = F.lane, r16 = lane & 15, g4 = lane >> 4;
    const float c2 = 0.08838834764831845f * 1.44269504089f;
    const unsigned x0 = xb_xcc_id() & 7u;
    unsigned tried = 0u, p = x0;
    unsigned item = q_fetch(qctr + 64 * p, lane);
    bool have_pf = false; u32x2 pf_idx = (u32x2){0u, 0u}; half8 pf_q[4];
#pragma unroll
    for (int s = 0; s < 4; ++s) pf_q[s] = (half8){0, 0, 0, 0, 0, 0, 0, 0};
    for (;;) {
        while (item >= (unsigned)SEQ && tried < 8u) { ++tried; p = (x0 + tried) & 7u; if (tried < 8u) item = q_fetch(qctr + 64 * p, lane); }
        if (tried >= 8u) break;
        const unsigned nxt = q_fetch(qctr + 64 * p, lane);
        const int b = (int)(p >> 2), j = (int)(p & 3u), tq = (int)item, nk = (tq + 1) < TOPK ? (tq + 1) : TOPK;
        const size_t m = (size_t)b * SEQ + tq;
        const unsigned char* kb = K8 + (size_t)p * SEQ * HD; const unsigned char* vb = V8 + (size_t)p * SEQ * HD;
        *(LAS u32x2*)(Il + 4 * lane) = have_pf ? pf_idx : *(const u32x2*)(IDX + m * TOPK + 4 * lane);
        long qh[4], ql[4];
        { const h16* qrow = Q + m * 2048 + (size_t)j * 512 + (r16 & 3) * HD + 16 * g4;
#pragma unroll
          for (int s = 0; s < 4; ++s) { const half8 hv = have_pf ? pf_q[s] : *(const half8*)(qrow + (s >> 1) * 64 + (s & 1) * 8);
              float f[8], l[8];
#pragma unroll
              for (int e = 0; e < 8; ++e) f[e] = (float)hv[e] * c2;
              const unsigned h0 = pk8(f[0], f[1], f[2], f[3]), h1 = pk8(f[4], f[5], f[6], f[7]);
              l[0] = f[0] - __builtin_amdgcn_cvt_f32_fp8((int)h0, 0); l[1] = f[1] - __builtin_amdgcn_cvt_f32_fp8((int)h0, 1); l[2] = f[2] - __builtin_amdgcn_cvt_f32_fp8((int)h0, 2); l[3] = f[3] - __builtin_amdgcn_cvt_f32_fp8((int)h0, 3);
              l[4] = f[4] - __builtin_amdgcn_cvt_f32_fp8((int)h1, 0); l[5] = f[5] - __builtin_amdgcn_cvt_f32_fp8((int)h1, 1); l[6] = f[6] - __builtin_amdgcn_cvt_f32_fp8((int)h1, 2); l[7] = f[7] - __builtin_amdgcn_cvt_f32_fp8((int)h1, 3);
              const unsigned l0 = pk8(l[0], l[1], l[2], l[3]), l1 = pk8(l[4], l[5], l[6], l[7]);
              const bool real = r16 < 4;
              qh[s] = real ? (long)(((unsigned long long)h1 << 32) | h0) : 0l; ql[s] = real ? (long)(((unsigned long long)l1 << 32) | l0) : 0l; } }
        asm volatile("s_waitcnt lgkmcnt(0)" ::: "memory");
        int keys[16];
#pragma unroll
        for (int kt = 0; kt < 16; ++kt) keys[kt] = Il[16 * kt + r16];
        {
            u32x4 ka[8][2];
#pragma unroll
            for (int k8 = 0; k8 < 8; ++k8) { const unsigned char* krow = kb + (size_t)keys[k8] * HD + 16 * g4; ka[k8][0] = *(const u32x4*)krow; ka[k8][1] = *(const u32x4*)(krow + 64); }
#pragma unroll
            for (int kt = 0; kt < 16; ++kt) { const int k8 = kt & 7; const u32x4 a0 = ka[k8][0], a1 = ka[k8][1];
                const long ak[4] = {(long)(((unsigned long long)a0.y << 32) | a0.x), (long)(((unsigned long long)a0.w << 32) | a0.z), (long)(((unsigned long long)a1.y << 32) | a1.x), (long)(((unsigned long long)a1.w << 32) | a1.z)};
                if (kt < 8) { const unsigned char* krow = kb + (size_t)keys[kt + 8] * HD + 16 * g4; ka[k8][0] = *(const u32x4*)krow; ka[k8][1] = *(const u32x4*)(krow + 64); }
                f32x4 acc = (f32x4){0.f, 0.f, 0.f, 0.f};
#pragma unroll
                for (int s = 0; s < 4; ++s) { acc = __builtin_amdgcn_mfma_f32_16x16x32_fp8_fp8(ak[s], qh[s], acc, 0, 0, 0); acc = __builtin_amdgcn_mfma_f32_16x16x32_fp8_fp8(ak[s], ql[s], acc, 0, 0, 0); }
                if (r16 < 4) {
#pragma unroll
                    for (int i = 0; i < 4; ++i) Pl[(16 * kt + 4 * g4 + i) * 4 + r16] = acc[i]; }
            }
        }
        have_pf = nxt < (unsigned)SEQ;
        if (have_pf) { const size_t mn = (size_t)b * SEQ + nxt; pf_idx = *(const u32x2*)(IDX + mn * TOPK + 4 * lane);
            const h16* qn = Q + mn * 2048 + (size_t)j * 512 + (r16 & 3) * HD + 16 * g4;
#pragma unroll
            for (int s = 0; s < 4; ++s) pf_q[s] = *(const half8*)(qn + (s >> 1) * 64 + (s & 1) * 8); }
        asm volatile("" ::: "memory");
        LAS unsigned char* vs = wl + 4608;
        const int nch = (nk + 31) >> 5;
#define SP_ISSUE(ch_) do { const int c_ = (ch_); LAS unsigned char* s_ = vs + (c_ % 3) * 4096; _Pragma("unroll") for (int j_ = 0; j_ < 4; ++j_) { const int key_ = Il[32 * c_ + 8 * j_ + (lane >> 3)]; \
                __builtin_amdgcn_global_load_lds((const unsigned*)(vb + (size_t)key_ * HD + (((lane & 7) ^ (((8 * j_ + (lane >> 3)) >> 1) & 7)) * 16)), (LAS unsigned*)(s_ + 1024 * j_), 16, 0, 0); } } while (0)
            SP_ISSUE(0); if (nch > 1) SP_ISSUE(1);
        f32x4 sv[4]; f32x4 mx = (f32x4){-3.0e38f, -3.0e38f, -3.0e38f, -3.0e38f};
#pragma unroll
        for (int k = 0; k < 4; ++k) { sv[k] = *(const LAS f32x4*)(Pl + (lane + 64 * k) * 4); if (lane + 64 * k < nk) { mx[0] = fmaxf(mx[0], sv[k][0]); mx[1] = fmaxf(mx[1], sv[k][1]); mx[2] = fmaxf(mx[2], sv[k][2]); mx[3] = fmaxf(mx[3], sv[k][3]); } }
#pragma unroll
        for (int o = 1; o < 64; o <<= 1) { mx[0] = fmaxf(mx[0], __shfl_xor(mx[0], o)); mx[1] = fmaxf(mx[1], __shfl_xor(mx[1], o)); mx[2] = fmaxf(mx[2], __shfl_xor(mx[2], o)); mx[3] = fmaxf(mx[3], __shfl_xor(mx[3], o)); }
        f32x4 sum = (f32x4){0.f, 0.f, 0.f, 0.f};
        asm volatile("s_waitcnt lgkmcnt(0)" ::: "memory");
#pragma unroll
        for (int k = 0; k < 4; ++k) { f32x4 pv;
#pragma unroll
            for (int h = 0; h < 4; ++h) pv[h] = (lane + 64 * k < nk) ? __builtin_amdgcn_exp2f(sv[k][h] - mx[h]) : 0.f;
            sum += pv;
#pragma unroll
            for (int h = 0; h < 4; ++h) Pl[h * 256 + lane + 64 * k] = pv[h] * 16.0f; }
#pragma unroll
        for (int o = 1; o < 64; o <<= 1) { sum[0] += __shfl_xor(sum[0], o); sum[1] += __shfl_xor(sum[1], o); sum[2] += __shfl_xor(sum[2], o); sum[3] += __shfl_xor(sum[3], o); }
        asm volatile("s_waitcnt lgkmcnt(0)" ::: "memory");
        long ph[8], pq[8];
#pragma unroll
        for (int s = 0; s < 8; ++s) { const LAS float* pp = Pl + (r16 & 3) * 256 + 32 * s + 8 * g4; const f32x4 a = *(const LAS f32x4*)pp, c = *(const LAS f32x4*)(pp + 4);
            const unsigned h0 = pk8(a[0], a[1], a[2], a[3]), h1 = pk8(c[0], c[1], c[2], c[3]);
            const unsigned l0 = pk8(a[0] - __builtin_amdgcn_cvt_f32_fp8((int)h0, 0), a[1] - __builtin_amdgcn_cvt_f32_fp8((int)h0, 1), a[2] - __builtin_amdgcn_cvt_f32_fp8((int)h0, 2), a[3] - __builtin_amdgcn_cvt_f32_fp8((int)h0, 3));
            const unsigned l1 = pk8(c[0] - __builtin_amdgcn_cvt_f32_fp8((int)h1, 0), c[1] - __builtin_amdgcn_cvt_f32_fp8((int)h1, 1), c[2] - __builtin_amdgcn_cvt_f32_fp8((int)h1, 2), c[3] - __builtin_amdgcn_cvt_f32_fp8((int)h1, 3));
            const bool real = r16 < 4;
            ph[s] = real ? (long)(((unsigned long long)h1 << 32) | h0) : 0l; pq[s] = real ? (long)(((unsigned long long)l1 << 32) | l0) : 0l; }
        f32x4 oacc[8];
#pragma unroll
        for (int nt = 0; nt < 8; ++nt) oacc[nt] = (f32x4){0.f, 0.f, 0.f, 0.f};
        {
            const int vrow = 8 * g4 + (r16 >> 1);
#pragma unroll
            for (int ch = 0; ch < 8; ++ch) {
                if (ch < nch) {
                    if (ch + 2 < nch) { SP_ISSUE(ch + 2); asm volatile("s_waitcnt vmcnt(8)" ::: "memory"); }
                    else if (ch + 1 < nch) asm volatile("s_waitcnt vmcnt(4)" ::: "memory");
                    else asm volatile("s_waitcnt vmcnt(0)" ::: "memory");
                    const LAS unsigned char* s = vs + (ch % 3) * 4096 + vrow * HD + 8 * (r16 & 1);
#pragma unroll
                    for (int nt = 0; nt < 8; ++nt) {
                        const v2i32 bv = __builtin_amdgcn_ds_read_tr8_b64_v2i32((LAS v2i32*)(s + ((nt ^ ((vrow >> 1) & 7)) * 16)));
                        const long bb = (long)(((unsigned long long)(unsigned)bv.y << 32) | (unsigned)bv.x);
                        oacc[nt] = __builtin_amdgcn_mfma_f32_16x16x32_fp8_fp8(ph[ch], bb, oacc[nt], 0, 0, 0);
                        oacc[nt] = __builtin_amdgcn_mfma_f32_16x16x32_fp8_fp8(pq[ch], bb, oacc[nt], 0, 0, 0); }
                    asm volatile("s_waitcnt lgkmcnt(0)" ::: "memory");
                }
            }
#undef SP_ISSUE
        }
        { LAS h16* ot = (LAS h16*)Pl;
          if (g4 == 0) {
#pragma unroll
              for (int nt = 0; nt < 8; ++nt)
#pragma unroll
                  for (int i = 0; i < 4; ++i) ot[i * HD + 16 * nt + r16] = (h16)(oacc[nt][i] * (0.0625f / sum[i])); }
          asm volatile("s_waitcnt lgkmcnt(0)" ::: "memory");
          const u32x4 w = *(const LAS u32x4*)(ot + g4 * HD + 8 * r16);
          *(u32x4*)(O + m * 2048 + (size_t)j * 512 + g4 * HD + 8 * r16) = w; }
        asm volatile("s_waitcnt lgkmcnt(0)" ::: "memory");
        item = nxt;
    }
}

#ifndef DBG_CHECK
#define DBG_CHECK 0
#endif
#if DBG_CHECK
__device__ __forceinline__ void dbg_max(unsigned* w, float v) { atomicMax(w, __builtin_bit_cast(unsigned, fabsf(v))); }
__device__ __forceinline__ int dbg_row(int blk) { return (blk & 1) * SEQ + (SEQ - 1 - 251 * (blk >> 1)); }
__device__ __forceinline__ void dbg_check_inproj(unsigned char* ws, LAS float* sh, unsigned* word) {
    if (blockIdx.x >= 64) return;
    int tid_ = (int)threadIdx.x; asm volatile("" : "+v"(tid_)); const int m = dbg_row(blockIdx.x), tid = tid_;
    const h16* a = (const h16*)(ws + WS_A) + (size_t)m * 2048; const h16* W = (const h16*)(ws + WS_WIN);
    for (int c = tid; c < DSA_N; c += 512) { float s = 0.f; for (int k = 0; k < 2048; ++k) s += (float)a[k] * (float)W[(size_t)c * 2048 + k]; sh[c] = s * (1.0f / 64.0f); }
    __syncthreads();
    const float* rope = (const float*)(ws + WS_ROPE) + (size_t)m * 32;
    for (int c = tid; c < DSA_N; c += 512) {
        float v = sh[c]; int hc; bool rot; float got;
        if (c < 2048) { hc = c & 127; rot = true; got = (float)((const h16*)(ws + WS_Q))[(size_t)m * 2048 + c]; }
        else if (c < 3072) continue;
        else if (c < 5120) { hc = (c - 3072) & 127; rot = true; got = (float)((const h16*)(ws + WS_IQ))[(size_t)m * 2048 + (c - 3072)]; }
        else if (c < 5248) { hc = c - 5120; rot = true; got = (float)((const h16*)(ws + WS_IK))[(size_t)m * 128 + (c - 5120)]; }
        else { hc = 99; rot = false; got = ((const float*)(ws + WS_IW))[(size_t)m * 16 + (c - 5248)]; }
        if (rot && hc < 32) { const int i = hc & 15; const float cs = rope[i], sn = rope[16 + i]; v = hc < 16 ? v * cs - sh[c + 16] * sn : v * cs + sh[c - 16] * sn; }
        dbg_max(word, (got - v) / (1.0f + fabsf(v)));
    }
    __syncthreads();
}
__device__ __forceinline__ void dbg_check_xattn(unsigned char* ws, int L, LAS float* sh, unsigned* word) {
    if (blockIdx.x >= 64) return;
    int tid_ = (int)threadIdx.x; asm volatile("" : "+v"(tid_)); const int m = dbg_row(blockIdx.x), tid = tid_, b = m / SEQ;
    const h16* a = (const h16*)(ws + WS_A) + (size_t)m * 2048; const h16* W = (const h16*)(ws + WS_WQ) + (size_t)L * 512 * 2048;
    const h16* kvm = (const h16*)(ws + WS_KVM) + (size_t)b * NMEM * 2048 + L * 1024;
    LAS float* q = sh; LAS float* lg = sh + 512; LAS float* st = sh + 512 + 1024;
    { float s = 0.f; for (int k = 0; k < 2048; ++k) s += (float)a[k] * (float)W[(size_t)tid * 2048 + k]; q[tid] = (float)(h16)s; }
    __syncthreads();
    for (int i = tid; i < 1024; i += 512) { const int h = i >> 8, key = i & 255; float s = 0.f; for (int d = 0; d < 128; ++d) s += q[h * 128 + d] * (float)kvm[(size_t)key * 2048 + h * 128 + d]; lg[i] = s * 0.08838834764831845f; }
    __syncthreads();
    if (tid < 4) { float mx = -3e38f; for (int k = 0; k < 256; ++k) mx = fmaxf(mx, lg[tid * 256 + k]); float su = 0.f; for (int k = 0; k < 256; ++k) su += __expf(lg[tid * 256 + k] - mx); st[2 * tid] = mx; st[2 * tid + 1] = 1.0f / su; }
    __syncthreads();
    { const int h = tid >> 7, d = tid & 127; float o = 0.f; for (int k = 0; k < 256; ++k) o += __expf(lg[h * 256 + k] - st[2 * h]) * st[2 * h + 1] * (float)kvm[(size_t)k * 2048 + 512 + h * 128 + d];
      const float got = (float)((const h16*)(ws + WS_XQ))[(size_t)m * 512 + tid]; dbg_max(word, (got - o) / (0.05f + fabsf(o))); }
    __syncthreads();
}
__device__ __forceinline__ void dbg_check_indexer(unsigned char* ws, LAS float* sh, unsigned* word, unsigned* word2) {
    if (blockIdx.x >= 64) return;
    int tid_ = (int)threadIdx.x; asm volatile("" : "+v"(tid_)); const int m = dbg_row(blockIdx.x), tid = tid_, b = m / SEQ, t = m % SEQ;
    const h16* iq = (const h16*)(ws + WS_IQ) + (size_t)m * 2048; const h16* ik = (const h16*)(ws + WS_IK) + (size_t)b * SEQ * 128; const float* iw = (const float*)(ws + WS_IW) + (size_t)m * 16;
    LAS float* sc = sh;
    for (int s = tid; s <= t; s += 512) { float tot = 0.f; for (int h = 0; h < 16; ++h) { float l = 0.f; for (int d = 0; d < 128; ++d) l += (float)iq[h * 128 + d] * (float)ik[(size_t)s * 128 + d]; tot += iw[h] * fmaxf(l, 0.f); } sc[s] = tot; }
    __syncthreads();
    const unsigned short* idx = (const unsigned short*)(ws + WS_IDX) + (size_t)m * 256;
    if (tid < 256) { const int key = idx[tid]; if (key > t) atomicAdd(word2, 1000u); else { const float v = sc[key]; int rank = 0; for (int s = 0; s <= t; ++s) rank += sc[s] > v ? 1 : 0; if (rank >= 256) atomicAdd(word, 1u);
        for (int j = 0; j < 256; ++j) if (j != tid && idx[j] == key) { atomicAdd(word2, 1u); break; } } }
    __syncthreads();
}
__device__ __forceinline__ float dbg_f8(const unsigned char* p) { const unsigned w = *p; return __builtin_amdgcn_cvt_f32_fp8((int)w, 0); }
__device__ __forceinline__ void dbg_check_sparse(unsigned char* ws, LAS float* sh, unsigned* word) {
    if (blockIdx.x >= 64) return;
    int tid_ = (int)threadIdx.x; asm volatile("" : "+v"(tid_)); const int m = dbg_row(blockIdx.x), tid = tid_, b = m / SEQ;
    const h16* q = (const h16*)(ws + WS_Q) + (size_t)m * 2048; const unsigned char* k8 = (const unsigned char*)(ws + WS_KV); const unsigned char* v8 = k8 + (size_t)16 * 1024 * 1024;
    const unsigned short* idx = (const unsigned short*)(ws + WS_IDX) + (size_t)m * 256;
    LAS float* lg = sh; LAS float* st = sh + 4096;
    for (int i = tid; i < 4096; i += 512) { const int h = i >> 8, k = i & 255, key = idx[k]; float s = 0.f; const unsigned char* kr = k8 + ((size_t)(b * NKV + (h >> 2)) * SEQ + key) * HD;
        for (int d = 0; d < 128; ++d) s += (float)q[h * 128 + d] * dbg_f8(kr + d); lg[i] = s * 0.08838834764831845f; }
    __syncthreads();
    if (tid < 16) { float mx = -3e38f; for (int k = 0; k < 256; ++k) mx = fmaxf(mx, lg[tid * 256 + k]); float su = 0.f; for (int k = 0; k < 256; ++k) su += __expf(lg[tid * 256 + k] - mx); st[2 * tid] = mx; st[2 * tid + 1] = 1.0f / su; }
    __syncthreads();
    for (int i = tid; i < 2048; i += 512) { const int h = i >> 7, d = i & 127; float o = 0.f; for (int k = 0; k < 256; ++k) o += __expf(lg[h * 256 + k] - st[2 * h]) * st[2 * h + 1] * dbg_f8(v8 + ((size_t)(b * NKV + (h >> 2)) * SEQ + idx[k]) * HD + d);
        const float got = (float)((const h16*)(ws + WS_A))[(size_t)m * 2048 + i]; dbg_max(word, (got - o) / (0.02f + fabsf(o))); }
    __syncthreads();
}
#endif

constexpr int N_PHASES = 22 + (DBG_CHECK ? 1 : 0);
__global__ void __launch_bounds__(NWAVES * 64, 2) trunk_fwd(Args args) {
    extern __shared__ __attribute__((aligned(16))) unsigned char lds_raw[];
    Frame F;
    F.lds = (LAS unsigned char*)lds_raw;
    F.MISC = (volatile LAS unsigned*)(F.lds + MISC_OFF);
    F.tid = threadIdx.x; F.lane = F.tid & 63; F.wave = __builtin_amdgcn_readfirstlane(F.tid >> 6);
    F.G = gridDim.x; { const int bx = blockIdx.x; F.vcu = (F.G % 8 == 0) ? (bx % 8) * (F.G / 8) + bx / 8 : bx; }
    unsigned char* ws = argp()->ws;
    for (int u = F.tid; u < (LDS_BYTES - MISC_OFF) / 4; u += NWAVES * 64) ((LAS unsigned*)(F.lds + MISC_OFF))[u] = 0u;
    __syncthreads();
    XcdBarrier bar; bar.bar = (unsigned*)(ws + WS_CTL) + CW_BAR; bar.x = 0; bar.st = nullptr;
    if (!MK_LAUNCH_PER_PHASE) bar = xcd_barrier_post((unsigned*)(ws + WS_CTL) + CW_BAR, F.MISC + 8);
    const int lo = argp()->ph_lo, hi = argp()->ph_hi;
#ifndef DBG_KINDS
#define DBG_KINDS 0xFFFF
#endif
#define KON(kind) (((DBG_KINDS) >> (kind)) & 1)
#ifndef PROBE_REP
#define PROBE_REP 0
#endif
#define NREP(kind) ((((PROBE_REP) >> (kind)) & 1) ? 2 : 1)
#define IN(k) (lo <= (k) && (k) < hi)
#define SEAM(k) do { if (IN((k) + 1)) { if (MK_LAUNCH_PER_PHASE) { } else xcd_barrier(bar); } } while (0)
    LAS unsigned char* ring = F.lds + RING_OFF;
    const int bid = (int)blockIdx.x;
    h16* A = (h16*)(ws + WS_A); h16* Y = (h16*)(ws + WS_Y); h16* H = (h16*)(ws + WS_H); h16* XQ = (h16*)(ws + WS_XQ); h16* ACT = (h16*)(ws + WS_ACT);

    if (KON(0) && IN(0)) { for (int rep = 0; rep < NREP(0); ++rep) { if (rep) xcd_barrier(bar); p0_prologue(F, argp()); } SEAM(0); }
    if (KON(1) && IN(1)) {
        { pg8::Gemm g{A, (const h16*)(ws + WS_WPOOL), T, D, 512, D, 1}; pg8::StaticOrder S; S.init(T, D, F.G, bid);
          pg8::EpiH16 E{Y, D, 1.0f}; pg8::gemm_phase<pg8::EpiH16, pg8::StaticOrder, true, true>(ring, g, S, E); }
        __syncthreads();
        { pg8::Gemm g{(const h16*)(ws + WS_MEMN), (const h16*)(ws + WS_WKV), NB * NMEM, 2048, 2048, 2048, 31}; pg8::StaticOrder S; S.init(NB * NMEM, 2048, F.G, bid);
          pg8::EpiH16 E{(h16*)(ws + WS_KVM), 2048, 1.0f}; pg8::gemm_phase<pg8::EpiH16, pg8::StaticOrder, true, true>(ring, g, S, E); }
        SEAM(1);
    }
#pragma unroll 1
    for (int L = 0; L < 2; ++L) {
        const int pb = L == 0 ? 2 : 14;
        if (L == 1) {
            if (KON(2) && IN(10)) {
                pg8::Gemm g{A, (const h16*)(ws + WS_WIN), T, DSA_NP, 2048, 2048, 31}; pg8::StaticOrder S; S.init(T, DSA_NP, F.G, bid);
                pg8::EpiInProj E{(h16*)(ws + WS_Q), (h16*)(ws + WS_KV), (h16*)(ws + WS_IQ), (h16*)(ws + WS_IK), (float*)(ws + WS_IW), (const float*)(ws + WS_ROPE), 1.0f / 64.0f};
                for (int rep = 0; rep < NREP(2); ++rep) { if (rep) xcd_barrier(bar); pg8::gemm_phase<pg8::EpiInProj, pg8::StaticOrder, true, true>(ring, g, S, E); }
                SEAM(10);
            }
#if DBG_CHECK
            if (IN(11)) dbg_check_inproj(ws, (LAS float*)ring, (unsigned*)(ws + WS_CTL) + 1024);
#endif
            if (KON(3) && IN(11)) { for (int rep = 0; rep < NREP(3); ++rep) { if (rep) xcd_barrier(bar); indexer_phase(F, (const h16*)(ws + WS_IQ), (const h16*)(ws + WS_IK), (const float*)(ws + WS_IW), (unsigned short*)(ws + WS_IDX), (u32x2*)(ws + WS_LISTS)); } SEAM(11); }
#if DBG_CHECK
            if (IN(12)) dbg_check_indexer(ws, (LAS float*)ring, (unsigned*)(ws + WS_CTL) + 1026, (unsigned*)(ws + WS_CTL) + 1028);
#endif
            if (KON(4) && IN(12)) { for (int rep = 0; rep < NREP(4); ++rep) { if (rep) xcd_barrier(bar); sparse_attn_phase(F, (const h16*)(ws + WS_Q), (const unsigned char*)(ws + WS_KV), (const unsigned char*)(ws + WS_KV) + (size_t)16 * 1024 * 1024, (const unsigned short*)(ws + WS_IDX), A, (unsigned*)(ws + WS_CTL) + 2048 + 512 * rep); } SEAM(12); }
#if DBG_CHECK
            if (IN(13)) dbg_check_sparse(ws, (LAS float*)ring, (unsigned*)(ws + WS_CTL) + 1027);
#endif
            if (KON(5) && IN(13)) {
                pg8::Gemm g{A, (const h16*)(ws + WS_WOUT), T, D, 2048, 2048, 31}; pg8::StaticOrder S; S.init(T, D, F.G, bid);
                pg8::EpiH16 E{Y, D, 1.0f}; pg8::gemm_phase<pg8::EpiH16, pg8::StaticOrder, true, true>(ring, g, S, E);
                SEAM(13);
            }
        }
        if (KON(6) && IN(pb + 0)) { ArgP a = argp(); const float* gains = a->gains + (size_t)L * 6 * D;
            if (L == 0) seam_phase<true, false, true, false>(F, Y, a->x, H, gains + 1 * D, gains + 2 * D, A); else seam_phase<true, false, false, false>(F, Y, H, H, gains + 1 * D, gains + 2 * D, A);
            SEAM(pb + 0); }
        if (KON(7) && IN(pb + 1)) {
            pg8::Gemm g{A, (const h16*)(ws + WS_WQ) + (size_t)L * XW * 2048, T, XW, 2048, 2048, 31}; pg8::StaticOrder S; S.init(T, XW, F.G, bid);
            pg8::EpiH16 E{XQ, XW, 1.0f}; pg8::gemm_phase<pg8::EpiH16, pg8::StaticOrder, true, true>(ring, g, S, E);
            SEAM(pb + 1);
        }
        if (KON(8) && IN(pb + 2)) { xattn_phase(F, XQ, (const h16*)(ws + WS_KVM) + L * 1024); SEAM(pb + 2); }
#if DBG_CHECK
        if (IN(pb + 3)) dbg_check_xattn(ws, L, (LAS float*)ring, (unsigned*)(ws + WS_CTL) + 1025);
#endif
        if (KON(9) && IN(pb + 3)) {
            pg8::Gemm g{XQ, (const h16*)(ws + WS_WO) + (size_t)L * 2048 * XW, T, D, XW, XW, 31}; pg8::StaticOrder S; S.init(T, D, F.G, bid);
            pg8::EpiH16 E{Y, D, 1.0f}; pg8::gemm_phase<pg8::EpiH16, pg8::StaticOrder, true, true>(ring, g, S, E);
            SEAM(pb + 3);
        }
        if (KON(10) && IN(pb + 4)) { ArgP a = argp(); const float* gains = a->gains + (size_t)L * 6 * D;
            if ((FFN_FP8 >> L) & 1) seam_phase<true, true, false, false>(F, Y, H, H, gains + 3 * D, gains + 4 * D, A); else seam_phase<true, false, false, false>(F, Y, H, H, gains + 3 * D, gains + 4 * D, A);
            SEAM(pb + 4); }
        static_assert((FFN_FP8 & ~DN_FP8) == 0, "an e4m3 gate|up GEMM writes e4m3 activations: its down projection must be e4m3 too");
        if (KON(11) && IN(pb + 5) && ((FFN_FP8 >> L) & 1)) {
            pg8::Gemm g{A, (const h16*)(ws + WS_WGU) + (size_t)L * 2 * DFF * 2048  , T, 2 * DFF, 1024, 1024, 31}; pg8::StaticOrder S; S.init(T, 2 * DFF, F.G, bid);
            pg8::EpiSwiGLU8 E{(unsigned char*)ACT, DFF, 1.0f / W8_SCALE, ACT8_SCALE}; pg8::gemm_phase<pg8::EpiSwiGLU8, pg8::StaticOrder, true, true, true>(ring, g, S, E);
            SEAM(pb + 5);
        }
        if (KON(11) && IN(pb + 5) && !((FFN_FP8 >> L) & 1) && ((DN_FP8 >> L) & 1)) {
            pg8::Gemm g{A, (const h16*)(ws + WS_WGU) + (size_t)L * 2 * DFF * 2048, T, 2 * DFF, 2048, 2048, 31}; pg8::StaticOrder S; S.init(T, 2 * DFF, F.G, bid);
            pg8::EpiSwiGLU8 E{(unsigned char*)ACT, DFF, 1.0f, ACT8_SCALE}; pg8::gemm_phase<pg8::EpiSwiGLU8, pg8::StaticOrder, true, true, false>(ring, g, S, E);
            SEAM(pb + 5);
        }
        if (KON(11) && IN(pb + 5) && !((FFN_FP8 >> L) & 1) && !((DN_FP8 >> L) & 1)) {
            pg8::Gemm g{A, (const h16*)(ws + WS_WGU) + (size_t)L * 2 * DFF * 2048, T, 2 * DFF, 2048, 2048, 31}; pg8::StaticOrder S; S.init(T, 2 * DFF, F.G, bid);
            pg8::EpiSwiGLU E{ACT, DFF}; pg8::gemm_phase<pg8::EpiSwiGLU, pg8::StaticOrder, true, true>(ring, g, S, E);
            SEAM(pb + 5);
        }
        if (KON(12) && IN(pb + 6) && ((DN_FP8 >> L) & 1)) {
            pg8::Gemm g{ACT, (const h16*)(ws + WS_WDN) + (size_t)L * 2048 * DFF  , T, D, DFF / 2, DFF / 2, 31}; pg8::StaticOrder S; S.init(T, D, F.G, bid);
            pg8::EpiH16 E{Y, D, 1.0f / (W8_SCALE * ACT8_SCALE)}; pg8::gemm_phase<pg8::EpiH16, pg8::StaticOrder, true, true, true>(ring, g, S, E);
            SEAM(pb + 6);
        }
        if (KON(12) && IN(pb + 6) && !((DN_FP8 >> L) & 1)) {
            pg8::Gemm g{ACT, (const h16*)(ws + WS_WDN) + (size_t)L * 2048 * DFF, T, D, DFF, DFF, 31}; pg8::StaticOrder S; S.init(T, D, F.G, bid);
            pg8::EpiH16 E{Y, D, 1.0f}; pg8::gemm_phase<pg8::EpiH16, pg8::StaticOrder, true, true>(ring, g, S, E);
            SEAM(pb + 6);
        }
        if (KON(13) && IN(pb + 7)) {
            ArgP a = argp(); const float* gains = a->gains + (size_t)L * 6 * D;
            if (L == 0) seam_phase<true, false, false, false>(F, Y, H, H, gains + 5 * D, a->gains + 6 * D  , A);
            else seam_phase<false, false, false, true>(F, Y, H, a->out, gains + 5 * D, nullptr, nullptr);
            SEAM(pb + 7);
        }
    }
#if DBG_CHECK
    if (IN(22)) {
        const unsigned* dw = (const unsigned*)(ws + WS_CTL) + 1024;
        const bool f0 = __builtin_bit_cast(float, dw[0]) > 4e-3f, f1 = __builtin_bit_cast(float, dw[1]) > 2e-2f, f2 = dw[2] > 24u, f3 = __builtin_bit_cast(float, dw[3]) > 2e-2f, f4 = dw[4] > 0u;
        for (int m = F.vcu * NWAVES + F.wave; m < T; m += F.G * NWAVES) { const int r = m & 15;
            const bool z = (r < 8 && f0) || (r >= 8 && r < 12 && f1) || (r >= 12 && r < 14 && f2) || (r == 14 && f3) || (r == 15 && f4);
            if (z) for (int j = 0; j < 8; ++j) ((f32x4*)(argp()->out + (size_t)m * D))[F.lane + 64 * j] = (f32x4){0.f, 0.f, 0.f, 0.f}; }
    }
#endif
#undef IN
#undef SEAM
}

extern "C" void kernel_launch(void* const* d_in, const int* in_sizes, int n_in, void* d_out, int out_size, void* d_ws, size_t ws_size, hipStream_t stream) {
    static int grid = 0;
    if (grid == 0) {
        if (n_in != 14 || in_sizes[0] != T * D || out_size != T * D || ws_size < WS_END) {
            fprintf(stderr, "kernel_launch: built for 14 inputs, x/out of %d floats, >= %zu bytes of workspace; got n_in %d, in0 %d, out %d, ws %zu; nothing launched\n", T * D, (size_t)WS_END, n_in, n_in > 0 ? in_sizes[0] : -1, out_size, ws_size);
            grid = -1; return; }
        int dev = 0, cus = 0, per_cu = 0;
        if (hipGetDevice(&dev) != hipSuccess || hipDeviceGetAttribute(&cus, hipDeviceAttributeMultiprocessorCount, dev) != hipSuccess) { fprintf(stderr, "kernel_launch: device query failed\n"); grid = -1; return; }
        if (hipFuncSetAttribute((const void*)trunk_fwd, hipFuncAttributeMaxDynamicSharedMemorySize, LDS_BYTES) != hipSuccess) { fprintf(stderr, "kernel_launch: hipFuncSetAttribute failed\n"); grid = -1; return; }
        if (hipOccupancyMaxActiveBlocksPerMultiprocessor(&per_cu, (const void*)trunk_fwd, NWAVES * 64, LDS_BYTES) != hipSuccess || per_cu < 1)
            fprintf(stderr, "kernel_launch: note: occupancy query reports %d workgroups per CU\n", per_cu);
        (void)hipGetLastError();
        grid = cus;
    }
    if (grid < 0) return;
    if (hipMemsetAsync((char*)d_ws + WS_CTL, 0, CTL_ZERO_BYTES, stream) != hipSuccess) { fprintf(stderr, "kernel_launch: memset failed\n"); return; }
    Args a{};
    a.x = (const float*)d_in[0]; a.mem = (const float*)d_in[1]; a.pos = (const int*)d_in[2]; a.gains = (const float*)d_in[3]; a.mem_norm = (const float*)d_in[4];
    a.pool_w = (const float*)d_in[5]; a.pool_scale = (const float*)d_in[6]; a.w_in = (const float*)d_in[7]; a.w_out = (const float*)d_in[8]; a.wq = (const float*)d_in[9];
    a.wkv = (const float*)d_in[10]; a.wo = (const float*)d_in[11]; a.wgu = (const float*)d_in[12]; a.wdn = (const float*)d_in[13];
    a.out = (float*)d_out; a.ws = (unsigned char*)d_ws;
    for (int i = 0; i < 16; ++i) a.inv_freq[i] = (float)pow(500000.0, -(double)(2 * i) / 32.0);
    a.pad = 0;
#if MK_LAUNCH_PER_PHASE
    for (int p = 0; p < N_PHASES; ++p) { a.ph_lo = p; a.ph_hi = p + 1; a.li = p;
        hipLaunchKernelGGL(trunk_fwd, dim3(grid), dim3(NWAVES * 64), LDS_BYTES, stream, a); }
#else
    a.ph_lo = 0; a.ph_hi = N_PHASES; a.li = 0;
    hipLaunchKernelGGL(trunk_fwd, dim3(grid), dim3(NWAVES * 64), LDS_BYTES, stream, a);
#endif
    const hipError_t le = hipPeekAtLastError();
    if (le != hipSuccess) fprintf(stderr, "kernel_launch: launch failed: %s\n", hipGetErrorName(le));
}
```

```cpp
#include <hip/hip_runtime.h>
#include <cstdio>
#include <cstdint>
#include <cmath>

#define LAS __attribute__((address_space(3)))
#define GAS __attribute__((address_space(1)))
typedef _Float16 h16;
typedef _Float16 half8 __attribute__((ext_vector_type(8)));
typedef _Float16 half4 __attribute__((ext_vector_type(4)));
typedef _Float16 half2v __attribute__((ext_vector_type(2)));
typedef float f32x4 __attribute__((ext_vector_type(4)));
typedef float f32x2 __attribute__((ext_vector_type(2)));
typedef float f32x16 __attribute__((ext_vector_type(16)));
typedef unsigned u32x4 __attribute__((ext_vector_type(4)));
typedef unsigned u32x2 __attribute__((ext_vector_type(2)));
typedef int v4i32 __attribute__((ext_vector_type(4)));
typedef int v8i32 __attribute__((ext_vector_type(8)));
typedef int v2i32 __attribute__((ext_vector_type(2)));

__device__ __forceinline__ unsigned pkh(float a, float b) { half2v v; v.x = (h16)a; v.y = (h16)b; return __builtin_bit_cast(unsigned, v); }

__device__ __forceinline__ unsigned pk8(float a, float b, float c, float d) { int w = __builtin_amdgcn_cvt_pk_fp8_f32(a, b, 0, false); w = __builtin_amdgcn_cvt_pk_fp8_f32(c, d, w, true); return (unsigned)w; }

constexpr int SEQ = 16384, NKV = 4, HD = 128;
namespace pg8 {
#define PG8_LAS __attribute__((address_space(3)))
constexpr int BM = 256, BK = 64, HALF = 128, HTB = HALF * BK * 2  , STAGE_BYTES = 8 * HTB, NXCD = 8, WGM = 8;

__host__ __device__ __forceinline__ int lds_byte(int r, int c) { const int st = (r >> 4) * 2 + (c >> 5), rr = r & 15, cc = c & 31, ob = rr * 64 + cc * 2; return st * 1024 + (ob ^ (((ob >> 9) & 1) << 5)); }
__host__ __device__ __forceinline__ void stage_rc(int b, int& R, int& C) { const int st = b / 1024, sb = b % 1024, swz = sb ^ (((sb >> 9) & 1) << 5); R = (st >> 1) * 16 + swz / 64; C = (st & 1) * 32 + (swz % 64) / 2; }
__host__ __device__ __forceinline__ int perm32(int rho) { const int n = rho >> 4, i = rho & 15; return 8 * (i >> 2) + 4 * n + (i & 3); }

struct Unit { int pm, pn; };
struct Gemm { const h16* A; const h16* Bt; int M, N, K, lda, kshift; };

struct StaticOrder {
    int nM, nN, nwg, G, c;
    __host__ __device__ void init(int M, int N, int G_, int c_) { nM = M / BM; nN = N / BM; nwg = nM * nN; G = G_; c = c_; }
    __host__ __device__ bool next(int i, Unit& u) const {
        const long L = (long)i * G + c; if (L >= nwg) return false;
        int wgid = (int)L; { const int q = nwg / NXCD, r = nwg % NXCD, xcd = wgid % NXCD, off = wgid / NXCD; wgid = (xcd < r ? xcd * (q + 1) : r * (q + 1) + (xcd - r) * q) + off; }
        const int nig = WGM * nN, gid = wgid / nig, fm = gid * WGM, gsz = (nM - fm) < WGM ? (nM - fm) : WGM;
        u.pm = fm + ((wgid % nig) % gsz); u.pn = (wgid % nig) / gsz; return true;
    }
    __device__ __forceinline__ void a_ready(const Unit&) const {}
    __device__ __forceinline__ void done(const Unit&) const {}
};

struct EpiF32 {
    static constexpr bool PERM = false, AFTER_DRAIN = false;
    float* C; int ldc; float scale;
    __device__ __forceinline__ void operator()(const f32x4 (&acc)[2][2][4][2], const Unit& u, int wr, int wc, int fr, int fq) const {
        const int row0 = u.pm * BM + wr * 64 + fr, col0 = u.pn * BM + wc * 32 + 4 * fq;
#pragma unroll
        for (int ai = 0; ai < 2; ++ai)
#pragma unroll
            for (int m = 0; m < 4; ++m) { float* rowp = C + (size_t)(row0 + ai * HALF + m * 16) * ldc + col0;
#pragma unroll
                for (int bj = 0; bj < 2; ++bj)
#pragma unroll
                    for (int n = 0; n < 2; ++n) *(f32x4*)(rowp + bj * HALF + n * 16) = acc[ai][bj][m][n] * scale; }
    }
};
struct EpiF32S {
    static constexpr bool PERM = false, AFTER_DRAIN = false;
    float* C; int ldc; float scale;
    __device__ __forceinline__ void operator()(const f32x4 (&acc)[2][2][4][2], const Unit& u, int wr, int wc, int fr_, int fq_) const {
        int l = (int)(threadIdx.x & 63u); asm volatile("" : "+v"(l)); const int fr = l & 15, fq = l >> 4;
        const int row0 = u.pm * BM + wr * 64 + fr, col0 = u.pn * BM + wc * 32 + 4 * fq;
#pragma unroll
        for (int ai = 0; ai < 2; ++ai)
#pragma unroll
            for (int m = 0; m < 4; ++m) { float* rowp = C + (size_t)(row0 + ai * HALF + m * 16) * ldc + col0;
#pragma unroll
                for (int bj = 0; bj < 2; ++bj)
#pragma unroll
                    for (int n = 0; n < 2; ++n) *(f32x4*)(rowp + bj * HALF + n * 16) = acc[ai][bj][m][n] * scale; }
    }
};
struct EpiH16 {
    static constexpr bool PERM = true, AFTER_DRAIN = false;
    h16* O; int ldc; float scale;
    __device__ __forceinline__ void operator()(const f32x4 (&acc)[2][2][4][2], const Unit& u, int wr, int wc, int fr, int fq) const {
        const int row0 = u.pm * BM + wr * 64 + fr, col0 = u.pn * BM + wc * 32 + 8 * fq;
#pragma unroll
        for (int ai = 0; ai < 2; ++ai)
#pragma unroll
            for (int m = 0; m < 4; ++m) { h16* rowp = O + (size_t)(row0 + ai * HALF + m * 16) * ldc + col0;
#pragma unroll
                for (int bj = 0; bj < 2; ++bj) { const f32x4 v0 = acc[ai][bj][m][0] * scale, v1 = acc[ai][bj][m][1] * scale;
                    u32x4 w; w.x = pkh(v0[0], v0[1]); w.y = pkh(v0[2], v0[3]); w.z = pkh(v1[0], v1[1]); w.w = pkh(v1[2], v1[3]);
                    *(u32x4*)(rowp + bj * HALF) = w; } }
    }
};
__device__ __forceinline__ float silu_mul(float g, float u) { return g * u * __builtin_amdgcn_rcpf(1.0f + __builtin_amdgcn_exp2f(g * -1.44269504089f)); }
struct EpiSwiGLU {
    static constexpr bool PERM = true, AFTER_DRAIN = false;
    h16* O; int ldc;
    __device__ __forceinline__ void operator()(const f32x4 (&acc)[2][2][4][2], const Unit& u, int wr, int wc, int fr, int fq) const {
        const int row0 = u.pm * BM + wr * 64 + fr, col0 = u.pn * HALF + wc * 32 + 8 * fq;
#pragma unroll
        for (int ai = 0; ai < 2; ++ai)
#pragma unroll
            for (int m = 0; m < 4; ++m) { h16* rowp = O + (size_t)(row0 + ai * HALF + m * 16) * ldc + col0;
                const f32x4 g0 = acc[ai][0][m][0], g1 = acc[ai][0][m][1], u0 = acc[ai][1][m][0], u1 = acc[ai][1][m][1];
                u32x4 w; w.x = pkh(silu_mul(g0[0], u0[0]), silu_mul(g0[1], u0[1])); w.y = pkh(silu_mul(g0[2], u0[2]), silu_mul(g0[3], u0[3]));
                w.z = pkh(silu_mul(g1[0], u1[0]), silu_mul(g1[1], u1[1])); w.w = pkh(silu_mul(g1[2], u1[2]), silu_mul(g1[3], u1[3]));
                *(u32x4*)rowp = w; }
    }
};
struct EpiSwiGLU8 {
    static constexpr bool PERM = true, AFTER_DRAIN = false;
    unsigned char* O; int ldc; float inscale, outscale;
    __device__ __forceinline__ void operator()(const f32x4 (&acc)[2][2][4][2], const Unit& u, int wr, int wc, int fr_, int fq_) const {
        int l = (int)(threadIdx.x & 63u); asm volatile("" : "+v"(l)); const int fr = l & 15, fq = l >> 4;
        const int row0 = u.pm * BM + wr * 64 + fr, col0 = u.pn * HALF + wc * 32 + 8 * fq;
#pragma unroll
        for (int ai = 0; ai < 2; ++ai)
#pragma unroll
            for (int m = 0; m < 4; ++m) { unsigned char* rowp = O + (size_t)(row0 + ai * HALF + m * 16) * ldc + col0;
                const f32x4 g0 = acc[ai][0][m][0] * inscale, g1 = acc[ai][0][m][1] * inscale, u0 = acc[ai][1][m][0] * (inscale * outscale), u1 = acc[ai][1][m][1] * (inscale * outscale);
                u32x2 w; w.x = pk8(silu_mul(g0[0], u0[0]), silu_mul(g0[1], u0[1]), silu_mul(g0[2], u0[2]), silu_mul(g0[3], u0[3]));
                w.y = pk8(silu_mul(g1[0], u1[0]), silu_mul(g1[1], u1[1]), silu_mul(g1[2], u1[2]), silu_mul(g1[3], u1[3]));
                *(u32x2*)rowp = w; }
    }
};
struct EpiInProj {
    static constexpr bool PERM = true, AFTER_DRAIN = false;
    h16 *Q, *KV, *IQ, *IK; float* IW; const float* rope; float scale;
    __device__ __forceinline__ void operator()(const f32x4 (&acc)[2][2][4][2], const Unit& u, int wr, int wc, int fr_, int fq_) const {
        int l = (int)(threadIdx.x & 63u); asm volatile("" : "+v"(l));
        const int fr = l & 15, fq = l >> 4;
        const int pn = u.pn, row0 = u.pm * BM + wr * 64 + fr;
        h16* base; int ldc, colt; bool rot0 = true, rot1 = true;
        if (pn < 8) { base = Q; ldc = 2048; colt = pn * 256; }
        else if (pn < 10) { base = KV; ldc = 1024; colt = (pn - 8) * 256; }
        else if (pn < 12) { base = KV; ldc = 1024; colt = 512 + (pn - 10) * 256; rot0 = false; rot1 = false; }
        else if (pn < 20) { base = IQ; ldc = 2048; colt = (pn - 12) * 256; }
        else { base = IK; ldc = 128; colt = 0; rot1 = false; }
        const int col0 = colt + wc * 32 + 8 * fq;
#pragma unroll
        for (int ai = 0; ai < 2; ++ai)
#pragma unroll
            for (int m = 0; m < 4; ++m) { const int row = row0 + ai * HALF + m * 16;
                f32x4 cs[2], sn[2];
                if (wc == 0) { const float* rp = rope + (size_t)row * 32 + 8 * (fq & 1);
                    cs[0] = *(const f32x4*)(rp); cs[1] = *(const f32x4*)(rp + 4); sn[0] = *(const f32x4*)(rp + 16); sn[1] = *(const f32x4*)(rp + 20);
                    if (fq < 2) { sn[0] = -sn[0]; sn[1] = -sn[1]; } }
#pragma unroll
                for (int bj = 0; bj < 2; ++bj) {
                    f32x4 v0 = acc[ai][bj][m][0] * scale, v1 = acc[ai][bj][m][1] * scale;
                    if (wc == 0 && (bj == 0 ? rot0 : rot1)) {
                        f32x4 p0, p1;
#pragma unroll
                        for (int e = 0; e < 4; ++e) { p0[e] = __shfl_xor(v0[e], 32); p1[e] = __shfl_xor(v1[e], 32); }
                        v0 = v0 * cs[0] + p0 * sn[0]; v1 = v1 * cs[1] + p1 * sn[1];
                    }
                    if (pn >= 8 && pn < 12) {
                        const int j = ((pn - 8) & 1) * 2 + bj, b = row / SEQ, tt = row % SEQ;
                        unsigned char* dst = (unsigned char*)KV + (pn >= 10 ? (size_t)16 * 1024 * 1024 : (size_t)0) + ((size_t)(b * NKV + j) * SEQ + tt) * HD + wc * 32 + 8 * fq;
                        u32x2 w; w.x = pk8(v0[0], v0[1], v0[2], v0[3]); w.y = pk8(v1[0], v1[1], v1[2], v1[3]); *(u32x2*)dst = w;
                    } else if (pn == 20 && bj == 1) {
                        if (wc == 0 && fq < 2) { float* wp = IW + (size_t)row * 16 + 8 * fq; *(f32x4*)wp = v0; *(f32x4*)(wp + 4) = v1; }
                    } else {
                        u32x4 w; w.x = pkh(v0[0], v0[1]); w.y = pkh(v0[2], v0[3]); w.z = pkh(v1[0], v1[1]); w.w = pkh(v1[2], v1[3]);
                        *(u32x4*)(base + (size_t)row * ldc + col0 + bj * HALF) = w;
                    }
                }
                asm volatile("" ::: "memory"); }
    }
};

template <class Epi, class Sched, bool ALIGN_EPI = false, bool SP2 = false, bool FP8 = false>
__device__ __forceinline__ void gemm_phase(PG8_LAS unsigned char* lds, const Gemm g, const Sched& S, const Epi& E) {
    int tid_ = (int)threadIdx.x; asm volatile("" : "+v"(tid_));
    const int tid = tid_, wid = __builtin_amdgcn_readfirstlane(tid >> 6), lane = tid & 63, wr = wid >> 2, wc = wid & 3, fr = lane & 15, fq = lane >> 4;
    const int K = g.K, nt = K / BK;
    unsigned voffA[2], voffB[2];
#pragma unroll
    for (int i = 0; i < 2; ++i) { int R, C; stage_rc(tid * 16 + i * 8192, R, C); const int Rb = Epi::PERM ? ((R & ~31) + perm32(R & 31)) : R;
        voffA[i] = (unsigned)(R * g.lda + C) * 2u; voffB[i] = (unsigned)(Rb * K + C) * 2u; }
    const size_t kstep = (size_t)(BK * 2);
    const size_t hstepA = (size_t)HALF * g.lda * 2, hstepB = (size_t)HALF * K * 2;
    const size_t tstepA = 2 * hstepA, tstepB = 2 * hstepB;
    const int kshift = g.kshift;
    const __amdgpu_buffer_rsrc_t rsrcA = __builtin_amdgcn_make_buffer_rsrc((void*)g.A, 0, 0x7fffffff, 0x00020000), rsrcB = __builtin_amdgcn_make_buffer_rsrc((void*)g.Bt, 0, 0x7fffffff, 0x00020000);
    const unsigned r64A = 64u * (unsigned)g.lda * 2u, r64B = 64u * (unsigned)K * 2u;
    const unsigned ldsw = (unsigned)wid * 1024u;
    const int aoff = lds_byte(wr * 64 + fr, fq * 8), boff = lds_byte(wc * 32 + fr, fq * 8);
#define PG8_SA(b, h) (((b) * 2 + (h)) * HTB)
#define PG8_SB(b, h) ((4 + (b) * 2 + (h)) * HTB)
#define PG8_STAGE(bufoff, gbase, voff) do { const bool isA_ = (const void*)(voff) == (const void*)voffA; _Pragma("unroll") for (int _i = 0; _i < 2; ++_i) \
        __builtin_amdgcn_raw_ptr_buffer_load_lds(isA_ ? rsrcA : rsrcB, (PG8_LAS void*)(lds + (bufoff) + ldsw + _i * 8192), 16, (int)(voff)[0], \
            (int)((unsigned)((const char*)(gbase) - (isA_ ? (const char*)g.A : (const char*)g.Bt)) + (unsigned)_i * (isA_ ? r64A : r64B)), 0, 0); } while (0)
#define PG8_LDA(dst, b, h) do { if constexpr (FP8) { _Pragma("unroll") for (int m = 0; m < 4; ++m) dst##8[m] = __builtin_shufflevector(*(const PG8_LAS v4i32*)(lds + PG8_SA(b, h) + aoff + m * 2048), *(const PG8_LAS v4i32*)(lds + PG8_SA(b, h) + aoff + m * 2048 + 1024), 0, 1, 2, 3, 4, 5, 6, 7); } \
    else { _Pragma("unroll") for (int m = 0; m < 4; ++m) _Pragma("unroll") for (int k = 0; k < 2; ++k) dst[m][k] = *(const PG8_LAS half8*)(lds + PG8_SA(b, h) + aoff + m * 2048 + k * 1024); } } while (0)
#define PG8_LDB(dst, b, h) do { if constexpr (FP8) { _Pragma("unroll") for (int n = 0; n < 2; ++n) dst##8[n] = __builtin_shufflevector(*(const PG8_LAS v4i32*)(lds + PG8_SB(b, h) + boff + n * 2048), *(const PG8_LAS v4i32*)(lds + PG8_SB(b, h) + boff + n * 2048 + 1024), 0, 1, 2, 3, 4, 5, 6, 7); } \
    else { _Pragma("unroll") for (int n = 0; n < 2; ++n) _Pragma("unroll") for (int k = 0; k < 2; ++k) dst[n][k] = *(const PG8_LAS half8*)(lds + PG8_SB(b, h) + boff + n * 2048 + k * 1024); } } while (0)
#define PG8_MMA(ai, bj, At, Bt) do { __builtin_amdgcn_s_setprio(1); _Pragma("unroll") for (int m = 0; m < 4; ++m) _Pragma("unroll") for (int n = 0; n < 2; ++n) { \
        if constexpr (FP8) asm volatile("v_mfma_f32_16x16x128_f8f6f4 %0, %1, %2, %0" : "+v"(acc[ai][bj][m][n]) : "v"(Bt##8[n]), "v"(At##8[m]));     \
        else { _Pragma("unroll") for (int k = 0; k < 2; ++k) acc[ai][bj][m][n] = __builtin_amdgcn_mfma_f32_16x16x32_f16(Bt[n][k], At[m][k], acc[ai][bj][m][n], 0, 0, 0); } } \
        __builtin_amdgcn_s_setprio(0); } while (0)
#define PG8_WAIT_V(n) asm volatile("s_waitcnt vmcnt(" #n ")" ::: "memory")
#define PG8_WAIT_L(n) asm volatile("s_waitcnt lgkmcnt(" #n ")" ::: "memory")
#define PG8_BAR __builtin_amdgcn_s_barrier()
#define PG8_SCHED __builtin_amdgcn_sched_barrier(0)
    Unit cur, nxt; int ui = 0;
    if (!S.next(0, cur)) return;
    f32x4 acc[2][2][4][2];
#pragma unroll
    for (int a = 0; a < 2; ++a)
#pragma unroll
        for (int b = 0; b < 2; ++b)
#pragma unroll
            for (int m = 0; m < 4; ++m)
#pragma unroll
                for (int n = 0; n < 2; ++n) acc[a][b][m][n] = (f32x4){0.f, 0.f, 0.f, 0.f};
    half8 At[4][2], B0[2][2], B1[2][2]; v8i32 At8[4], B08[2], B18[2];
    const char* cA = (const char*)g.A + (size_t)cur.pm * tstepA + (size_t)((cur.pn >> kshift) * K) * 2; const char* cB = (const char*)g.Bt + (size_t)cur.pn * tstepB;
    S.a_ready(cur);
    if constexpr (SP2) {
        PG8_STAGE(PG8_SB(0, 0), cB, voffB); PG8_STAGE(PG8_SB(0, 1), cB + hstepB, voffB); PG8_STAGE(PG8_SA(0, 0), cA, voffA); PG8_STAGE(PG8_SA(0, 1), cA + hstepA, voffA);
        if (wr == 1) PG8_BAR;
        PG8_WAIT_V(2); PG8_BAR;
        PG8_STAGE(PG8_SB(1, 0), cB + kstep, voffB); PG8_STAGE(PG8_SA(1, 0), cA + kstep, voffA); PG8_STAGE(PG8_SB(1, 1), cB + hstepB + kstep, voffB);
        PG8_WAIT_V(6); PG8_BAR;
    } else {
        PG8_STAGE(PG8_SB(0, 0), cB, voffB); PG8_STAGE(PG8_SA(0, 0), cA, voffA); PG8_STAGE(PG8_SB(0, 1), cB + hstepB, voffB); PG8_STAGE(PG8_SA(0, 1), cA + hstepA, voffA);
        if (wr == 1) PG8_BAR;
        PG8_WAIT_V(4); PG8_BAR;
        PG8_STAGE(PG8_SB(1, 0), cB + kstep, voffB); PG8_STAGE(PG8_SA(1, 0), cA + kstep, voffA); PG8_STAGE(PG8_SB(1, 1), cB + hstepB + kstep, voffB);
        PG8_WAIT_V(6); PG8_BAR;
    }
    for (;;) {
        const bool has_next = S.next(ui + 1, nxt);
        const char* nA = has_next ? (const char*)g.A + (size_t)nxt.pm * tstepA + (size_t)((nxt.pn >> kshift) * K) * 2 : cA; const char* nB = has_next ? (const char*)g.Bt + (size_t)nxt.pn * tstepB : cB;
        for (int t = 0; t < nt; t += 2) {
            const bool last = (t == nt - 2);
            const char* a1 = cA + (size_t)(t + 1) * kstep;
            const char* a2 = last ? nA : cA + (size_t)(t + 2) * kstep; const char* b2 = last ? nB : cB + (size_t)(t + 2) * kstep;
            const char* a3 = a2 + kstep; const char* b3 = b2 + kstep;
            if (last && has_next) S.a_ready(nxt);
            if constexpr (SP2) {
            PG8_LDB(B0, 0, 0); PG8_LDB(B1, 0, 1); PG8_SCHED; PG8_LDA(At, 0, 0); PG8_STAGE(PG8_SA(1, 1), a1 + hstepA, voffA);
            PG8_WAIT_V(8); PG8_WAIT_L(0); PG8_BAR; PG8_MMA(0, 0, At, B0); PG8_MMA(0, 1, At, B1); PG8_BAR; PG8_SCHED;
            PG8_LDA(At, 0, 1); PG8_STAGE(PG8_SB(0, 0), b2, voffB); PG8_STAGE(PG8_SB(0, 1), b2 + hstepB, voffB); PG8_STAGE(PG8_SA(0, 0), a2, voffA);
            PG8_WAIT_V(8); PG8_WAIT_L(0); PG8_BAR; PG8_MMA(1, 0, At, B0); PG8_MMA(1, 1, At, B1); PG8_BAR; PG8_SCHED;
            PG8_LDB(B0, 1, 0); PG8_LDB(B1, 1, 1); PG8_SCHED; PG8_LDA(At, 1, 0); PG8_STAGE(PG8_SA(0, 1), a2 + hstepA, voffA);
            PG8_WAIT_V(8); PG8_WAIT_L(0); PG8_BAR; PG8_MMA(0, 0, At, B0); PG8_MMA(0, 1, At, B1); PG8_BAR; PG8_SCHED;
            PG8_LDA(At, 1, 1); PG8_STAGE(PG8_SB(1, 0), b3, voffB); PG8_STAGE(PG8_SB(1, 1), b3 + hstepB, voffB); PG8_STAGE(PG8_SA(1, 0), a3, voffA);
            PG8_WAIT_V(8); PG8_WAIT_L(0); PG8_BAR; PG8_MMA(1, 0, At, B0); PG8_MMA(1, 1, At, B1); PG8_BAR; PG8_SCHED;
            } else {
            PG8_LDB(B0, 0, 0); PG8_SCHED; PG8_LDA(At, 0, 0); PG8_STAGE(PG8_SA(1, 1), a1 + hstepA, voffA);
            PG8_WAIT_L(8); PG8_BAR; PG8_WAIT_L(0); PG8_MMA(0, 0, At, B0); PG8_BAR; PG8_SCHED;
            PG8_LDB(B1, 0, 1); PG8_STAGE(PG8_SB(0, 0), b2, voffB);
            PG8_BAR; PG8_WAIT_L(0); PG8_MMA(0, 1, At, B1); PG8_BAR;
            PG8_LDA(At, 0, 1); PG8_STAGE(PG8_SA(0, 0), a2, voffA);
            PG8_BAR; PG8_WAIT_L(0); PG8_MMA(1, 0, At, B0); PG8_BAR; PG8_SCHED;
            PG8_STAGE(PG8_SB(0, 1), b2 + hstepB, voffB);
            PG8_WAIT_V(6); PG8_BAR; PG8_MMA(1, 1, At, B1); PG8_BAR;
            PG8_LDB(B0, 1, 0); PG8_SCHED; PG8_LDA(At, 1, 0); PG8_STAGE(PG8_SA(0, 1), a2 + hstepA, voffA);
            PG8_WAIT_L(8); PG8_BAR; PG8_WAIT_L(0); PG8_MMA(0, 0, At, B0); PG8_BAR; PG8_SCHED;
            PG8_LDB(B1, 1, 1); PG8_STAGE(PG8_SB(1, 0), b3, voffB);
            PG8_BAR; PG8_WAIT_L(0); PG8_MMA(0, 1, At, B1); PG8_BAR;
            PG8_LDA(At, 1, 1); PG8_STAGE(PG8_SA(1, 0), a3, voffA);
            PG8_BAR; PG8_WAIT_L(0); PG8_MMA(1, 0, At, B0); PG8_BAR; PG8_SCHED;
            PG8_STAGE(PG8_SB(1, 1), b3 + hstepB, voffB);
            PG8_WAIT_V(6); PG8_BAR; PG8_MMA(1, 1, At, B1); PG8_BAR;
            }
        }
        if constexpr (FP8) { asm volatile("s_nop 15\n\ts_nop 15\n\ts_nop 15\n\ts_nop 15" ::: "memory"); __builtin_amdgcn_sched_barrier(0); }
        if constexpr (ALIGN_EPI) { if (wr == 0) PG8_BAR; }
        if constexpr (!Epi::AFTER_DRAIN) { E(acc, cur, wr, wc, fr, fq); S.done(cur); }
        if (!has_next) break;
#pragma unroll
        for (int a = 0; a < 2; ++a)
#pragma unroll
            for (int b = 0; b < 2; ++b)
#pragma unroll
                for (int m = 0; m < 4; ++m)
#pragma unroll
                    for (int n = 0; n < 2; ++n) acc[a][b][m][n] = (f32x4){0.f, 0.f, 0.f, 0.f};
        cur = nxt; cA = nA; cB = nB; ++ui;
        if constexpr (ALIGN_EPI) { if (wr == 1) PG8_BAR; }
    }
    PG8_WAIT_V(0);
    if constexpr (!ALIGN_EPI) { if (wr == 0) PG8_BAR; }
    PG8_BAR;

#undef PG8_SA
#undef PG8_SB
#undef PG8_STAGE
#undef PG8_LDA
#undef PG8_LDB
#undef PG8_MMA
#undef PG8_WAIT_V
#undef PG8_WAIT_L
#undef PG8_BAR
#undef PG8_SCHED
}
}

constexpr int NB = 2, T = NB * SEQ, D = 2048, DFF = 5632, NMEM = 256;
constexpr int DSA_N = 5264, DSA_NP = 5376;
constexpr int NHEAD = 16, TOPK = 256;
constexpr int XW = 512;
constexpr float NORM_EPS = 1e-6f;
constexpr int NWAVES = 8;
#ifndef FFN_FP8
#define FFN_FP8 2
#endif
#ifndef DN_FP8
#define DN_FP8 3
#endif
#ifndef IDX_PROBE_MMA
#define IDX_PROBE_MMA 0
#endif
#ifndef MK_LAUNCH_PER_PHASE
#define MK_LAUNCH_PER_PHASE 0
#endif

constexpr size_t MiB = 1u << 20;
constexpr size_t WS_CTL = 0, CTL_ZERO_BYTES = 1 * MiB;
constexpr size_t WS_ROPE = 1 * MiB;
constexpr size_t WS_MEMN = 5 * MiB;
constexpr size_t WS_KVM = 7 * MiB;
constexpr size_t WS_WPOOL = 9 * MiB;
constexpr size_t WS_WIN = 11 * MiB;
constexpr size_t WS_WOUT = 32 * MiB;
constexpr size_t WS_WQ = 40 * MiB;
constexpr size_t WS_WKV = 44 * MiB;
constexpr size_t WS_WO = 52 * MiB;
constexpr size_t WS_WGU = 56 * MiB;
constexpr size_t WS_WDN = 144 * MiB;
constexpr size_t WS_XQ = 188 * MiB;
constexpr size_t WS_A = 220 * MiB;
constexpr size_t WS_Y = 348 * MiB;
constexpr size_t WS_ACT = 604 * MiB;
constexpr size_t WS_END = 956 * MiB;
constexpr size_t WS_Q = WS_ACT, WS_KV = WS_ACT + 128 * MiB, WS_IQ = WS_ACT + 192 * MiB, WS_IK = WS_ACT + 320 * MiB, WS_IW = WS_ACT + 328 * MiB, WS_IDX = WS_ACT + 330 * MiB;
constexpr size_t WS_LISTS = WS_Y;
constexpr size_t WS_H = WS_Y + 128 * MiB;
constexpr int LIST_CAP = 1024;
static_assert(WS_IDX + (size_t)T * TOPK * 2 <= WS_END, "ws map");
constexpr float W8_SCALE = 64.0f, ACT8_SCALE = 8.0f;
constexpr int CW_BAR = 4096;

constexpr int RING_OFF = 0, RING_BYTES = 136192;
constexpr int MISC_OFF = RING_BYTES;
constexpr int LDS_BYTES = 147456;

typedef GAS unsigned gu32;
#define LDS_WAIT() asm volatile("s_waitcnt lgkmcnt(0)" ::: "memory")
#define VM_WAIT() asm volatile("s_waitcnt vmcnt(0)" ::: "memory")

#define XB_TMO      128
#define XB_XCNT(j)  (256  + 64 * (j))
#define XB_XSUB(j)  (1280 + 64 * (j))
#define XB_XGEN(j)  (2304 + 64 * (j))
#define XB_TOP      3328
#define XB_TOPGEN   3392
#define XCD_BAR_WORDS 3456
#define XB_SPIN_CAP (1u << 23)
__device__ __forceinline__ unsigned xb_ld(unsigned* p)              { return __hip_atomic_load(p, __ATOMIC_RELAXED, __HIP_MEMORY_SCOPE_AGENT); }
__device__ __forceinline__ unsigned xb_add(unsigned* p, unsigned v) { return __hip_atomic_fetch_add(p, v, __ATOMIC_RELAXED, __HIP_MEMORY_SCOPE_AGENT); }
__device__ __forceinline__ unsigned xb_xcc_id() { return (unsigned)__builtin_amdgcn_s_getreg((3 << 11) | 20) & 0xFu; }
#define XB_SPIN(cond, bar) do { unsigned _sp = 0; while (cond) { __builtin_amdgcn_s_sleep(1); \
    if ((++_sp & 255u) == 0u) { if (xb_ld(&(bar)[XB_TMO])) break; if (_sp > XB_SPIN_CAP) { atomicAdd(&(bar)[XB_TMO], 1u); break; } } } } while (0)
struct XcdBarrier { unsigned* bar; unsigned x; volatile LAS unsigned* st; };
__device__ __forceinline__ XcdBarrier xcd_barrier_post(unsigned* bar, volatile LAS unsigned* st) {
    XcdBarrier b; b.bar = bar; b.x = xb_xcc_id(); b.st = st;
    if (threadIdx.x == 0) (void)xb_add(&bar[XB_XCNT(b.x)], 1u);
    return b;
}
__device__ __forceinline__ void xcd_barrier_complete(unsigned* bar, unsigned x, unsigned& nloc, unsigned& nx) {
    const unsigned G = gridDim.x * gridDim.y * gridDim.z;
    unsigned sum, cnt, mine, sp = 0u;
    for (;;) {
        sum = 0u; cnt = 0u; mine = 0u;
#pragma unroll
        for (unsigned j = 0; j < 16; ++j) { const unsigned c = xb_ld(&bar[XB_XCNT(j)]); sum += c; cnt += (c > 0u) ? 1u : 0u; mine = (j == x) ? c : mine; }
        if (sum == G) break;
        __builtin_amdgcn_s_sleep(1);
        if ((++sp & 255u) == 0u) { if (xb_ld(&bar[XB_TMO])) break; if (sp > XB_SPIN_CAP) { atomicAdd(&bar[XB_TMO], 1u); break; } }
    }
    nloc = mine > 0u ? mine : 1u; nx = cnt > 0u ? cnt : 1u;
}
__device__ __forceinline__ void xcd_barrier(const XcdBarrier& b) {
    asm volatile("s_waitcnt vmcnt(0)" ::: "memory");
    __syncthreads();
    if (threadIdx.x == 0) {
        unsigned* bar = b.bar;
        __builtin_amdgcn_s_waitcnt(0);
        unsigned nloc = b.st[0], nx = b.st[1];
        if (nloc == 0u) { xcd_barrier_complete(bar, b.x, nloc, nx); b.st[0] = nloc; b.st[1] = nx; }
        const unsigned old = xb_add(&bar[XB_XSUB(b.x)], 1u);
        const unsigned gen = old / nloc;
        if (old + 1u == (gen + 1u) * nloc) {
            __builtin_amdgcn_fence(__ATOMIC_RELEASE, "agent");
            asm volatile("s_waitcnt vmcnt(0)" ::: "memory");
            const unsigned og = xb_add(&bar[XB_TOP], 1u);
            const unsigned tg = og / nx;
            if (og + 1u == (tg + 1u) * nx) xb_add(&bar[XB_TOPGEN], 1u);
            else XB_SPIN(xb_ld(&bar[XB_TOPGEN]) == tg, bar);
            __builtin_amdgcn_fence(__ATOMIC_ACQUIRE, "agent");
            xb_add(&bar[XB_XGEN(b.x)], 1u);
            asm volatile("s_waitcnt vmcnt(0)" ::: "memory");
        } else {
            XB_SPIN(xb_ld(&bar[XB_XGEN(b.x)]) == gen, bar);
            __builtin_amdgcn_fence(__ATOMIC_ACQUIRE, "agent");
            asm volatile("s_waitcnt vmcnt(0)" ::: "memory");
        }
    }
    __syncthreads();
}

struct Frame {
    LAS unsigned char* lds;
    volatile LAS unsigned* MISC;
    int tid, lane, wave;
    int vcu, G;
};
__device__ __forceinline__ Frame fresh(const Frame& F0) { Frame F = F0; int t = (int)threadIdx.x; asm volatile("" : "+v"(t)); F.tid = t; F.lane = t & 63; F.wave = __builtin_amdgcn_readfirstlane(t >> 6); return F; }
template <int CTRL> __device__ __forceinline__ float dpp_mov(float v) { return __builtin_bit_cast(float, __builtin_amdgcn_update_dpp(0, __builtin_bit_cast(int, v), CTRL, 0xF, 0xF, true)); }
__device__ __forceinline__ float wave_sum_dpp(float v) {
    v += dpp_mov<0xB1>(v);
    v += dpp_mov<0x4E>(v);
    v += dpp_mov<0x141>(v);
    v += dpp_mov<0x140>(v);
    const float s0 = __builtin_bit_cast(float, __builtin_amdgcn_readlane(__builtin_bit_cast(int, v), 0)), s1 = __builtin_bit_cast(float, __builtin_amdgcn_readlane(__builtin_bit_cast(int, v), 16));
    const float s2 = __builtin_bit_cast(float, __builtin_amdgcn_readlane(__builtin_bit_cast(int, v), 32)), s3 = __builtin_bit_cast(float, __builtin_amdgcn_readlane(__builtin_bit_cast(int, v), 48));
    return (s0 + s1) + (s2 + s3);
}
__device__ __forceinline__ float wave_max_dpp(float v) {
    v = fmaxf(v, dpp_mov<0xB1>(v)); v = fmaxf(v, dpp_mov<0x4E>(v)); v = fmaxf(v, dpp_mov<0x141>(v)); v = fmaxf(v, dpp_mov<0x140>(v));
    const float s0 = __builtin_bit_cast(float, __builtin_amdgcn_readlane(__builtin_bit_cast(int, v), 0)), s1 = __builtin_bit_cast(float, __builtin_amdgcn_readlane(__builtin_bit_cast(int, v), 16));
    const float s2 = __builtin_bit_cast(float, __builtin_amdgcn_readlane(__builtin_bit_cast(int, v), 32)), s3 = __builtin_bit_cast(float, __builtin_amdgcn_readlane(__builtin_bit_cast(int, v), 48));
    return fmaxf(fmaxf(s0, s1), fmaxf(s2, s3));
}
__device__ __forceinline__ float wave_sum(float v) {
#pragma unroll
    for (int o = 1; o < 64; o <<= 1) v += __shfl_xor(v, o);
    return v;
}
__device__ __forceinline__ float rstd_of(float sumsq) { return 1.0f / sqrtf(sumsq * (1.0f / D) + NORM_EPS); }

__device__ __forceinline__ void transpose_item(const float* W, int ldw, int K, int k0, int scol, int nvalid, h16* WT, int drow, float scale, const float* colscale, bool f8, LAS float* scr, int lane) {
    const int cn = scol + (lane & 31); const bool okc = cn < nvalid;
    float wv[32];
#pragma unroll
    for (int i = 0; i < 32; ++i) { const int kk = 2 * i + (lane >> 5); wv[i] = W[(size_t)(k0 + kk) * ldw + (okc ? cn : 0)]; }
#pragma unroll
    for (int i = 0; i < 32; ++i) { const int kk = 2 * i + (lane >> 5); scr[kk * 33 + (lane & 31)] = okc ? wv[i] : 0.f; }
    LDS_WAIT(); asm volatile("" ::: "memory");
    const int c = lane & 7;
#pragma unroll
    for (int j = 0; j < 4; ++j) { const int n = (lane >> 3) + 8 * j; const LAS float* s = scr + (8 * c) * 33 + n;
        float sc = scale; if (colscale) sc *= colscale[scol + n];
        if (f8) { u32x2 o; o.x = pk8(s[0 * 33] * sc, s[1 * 33] * sc, s[2 * 33] * sc, s[3 * 33] * sc); o.y = pk8(s[4 * 33] * sc, s[5 * 33] * sc, s[6 * 33] * sc, s[7 * 33] * sc);
            *(GAS u32x2*)((unsigned char*)WT + (size_t)(drow + n) * K + k0 + 8 * c) = o; }
        else { u32x4 o; o.x = pkh(s[0 * 33] * sc, s[1 * 33] * sc); o.y = pkh(s[2 * 33] * sc, s[3 * 33] * sc); o.z = pkh(s[4 * 33] * sc, s[5 * 33] * sc); o.w = pkh(s[6 * 33] * sc, s[7 * 33] * sc);
            *(GAS u32x4*)(WT + (size_t)(drow + n) * K + k0 + 8 * c) = o; } }
    LDS_WAIT(); asm volatile("" ::: "memory");
}
struct TJob { const float* W; h16* WT; const float* colscale; int ldw, K, nrows, nvalid, mode; float scale; };
__device__ __forceinline__ int tjob_items(const TJob& j) { return (j.K / 64) * (j.nrows / 32); }
__device__ __forceinline__ void tjob_run(const TJob& j, int item, LAS float* scr, int lane) {
    const int nblk = j.nrows / 32, kb = item / nblk, r = 32 * (item % nblk);
    const int scol = (j.mode & 1) ? ((r >> 7) & 1) * DFF + 128 * (r >> 8) + (r & 127) : r;
    transpose_item(j.W, j.ldw, j.K, 64 * kb, scol, j.nvalid, j.WT, r, j.scale, j.colscale, (j.mode & 2) != 0, scr, lane);
}

struct Args {
    const float* x; const float* mem; const int* pos; const float* gains; const float* mem_norm; const float* pool_w; const float* pool_scale;
    const float* w_in; const float* w_out; const float* wq; const float* wkv; const float* wo; const float* wgu; const float* wdn;
    float* out; unsigned char* ws;
    float inv_freq[16];
    int ph_lo, ph_hi, li, pad;
};

#define CAS __attribute__((address_space(4)))
typedef const CAS Args* ArgP;
__device__ __forceinline__ ArgP argp() { unsigned long long p = (unsigned long long)__builtin_amdgcn_kernarg_segment_ptr(); asm volatile("" : "+s"(p)); return (ArgP)p; }

__device__ __forceinline__ void rope_entry(ArgP a, float* rope, int idx) {
    const int m = idx >> 4, i = idx & 15;
    const float angf = (float)a->pos[m] * a->inv_freq[i];
    const double ang = (double)angf;
    const double TWO_PI = 6.283185307179586476925286766559, INV_2PI = 0.15915494309189533576888376337251;
    const double k = __builtin_rint(ang * INV_2PI);
    const double r = ang - k * TWO_PI;
    const double r2 = r * r;
    double c = 1.0, s = 1.0, tc = 1.0, ts = 1.0;
#pragma unroll
    for (int n = 1; n <= 13; ++n) { tc *= -r2 / (double)((2 * n - 1) * (2 * n)); ts *= -r2 / (double)((2 * n) * (2 * n + 1)); c += tc; s += ts; }
    rope[(size_t)m * 32 + i] = (float)c; rope[(size_t)m * 32 + 16 + i] = (float)(s * r);
}
__device__ __forceinline__ void norm_row_to_h16(const float* xrow, const float* gain, h16* orow, int lane) {
    const f32x4* xr = (const f32x4*)xrow + lane; const f32x4* gr = (const f32x4*)gain + lane;
    f32x4 v[8]; float s = 0.f;
#pragma unroll
    for (int j = 0; j < 8; ++j) { v[j] = xr[64 * j]; s += (v[j].x * v[j].x + v[j].y * v[j].y) + (v[j].z * v[j].z + v[j].w * v[j].w); }
    const float r = rstd_of(wave_sum_dpp(s));
    u32x2* o8 = (u32x2*)orow + lane;
#pragma unroll
    for (int j = 0; j < 8; ++j) { const f32x4 g = gr[64 * j], y = v[j] * r * g; u32x2 w; w.x = pkh(y.x, y.y); w.y = pkh(y.z, y.w); o8[64 * j] = w; }
}
__device__ __forceinline__ void pool_pre(Frame& F0, const float* x, const float* g0, h16* P) {
    Frame F = fresh(F0);
    LAS float* rs = (LAS float*)(F.lds + RING_OFF);
    for (int u = F.vcu; u < T / 64; u += F.G) {
        const int b = u / (SEQ / 64), t0 = 64 * (u % (SEQ / 64));
        const float* xb = x + (size_t)b * SEQ * D;
        for (int r = F.wave; r < 79; r += NWAVES) { const int t = t0 - 15 + r;
            if (t >= 0) { const f32x4* xr = (const f32x4*)(xb + (size_t)t * D) + F.lane; float s = 0.f;
#pragma unroll
                for (int j = 0; j < 8; ++j) { const f32x4 v = xr[64 * j]; s += (v.x * v.x + v.y * v.y) + (v.z * v.z + v.w * v.w); }
                s = rstd_of(wave_sum_dpp(s)); if (F.lane == 0) rs[r] = s; } }
        __syncthreads();
        {
            const int c0 = 4 * F.tid, w = 2 << (F.tid >> 7);
            const f32x4 g = *(const f32x4*)(g0 + c0);
            const int ts = (t0 - (w - 1)) > 0 ? (t0 - (w - 1)) : 0;
            f32x4 sum = {0.f, 0.f, 0.f, 0.f};
#pragma unroll 8
            for (int t = ts; t < t0 + 64; ++t) {
                const f32x4 a = *(const f32x4*)(xb + (size_t)t * D + c0) * rs[t - t0 + 15] * g;
                sum += a;
                if (t - w >= ts) sum -= *(const f32x4*)(xb + (size_t)(t - w) * D + c0) * rs[t - w - t0 + 15] * g;
                if (t >= t0) { const float ic = 1.0f / (float)((t + 1) < w ? (t + 1) : w); const f32x4 p = sum * ic - a;
                    u32x2 o; o.x = pkh(p.x, p.y); o.y = pkh(p.z, p.w); *(u32x2*)(P + ((size_t)b * SEQ + t) * D + c0) = o; }
            }
        }
        __syncthreads();
    }
}
__device__ __forceinline__ void p0_prologue(Frame& F0, ArgP a) {
    Frame F = fresh(F0);
    unsigned char* ws = a->ws;
    LAS float* scr = (LAS float*)(F.lds + RING_OFF + F.wave * 16384);
    const int gw = F.vcu * NWAVES + F.wave, NGW = F.G * NWAVES;
    constexpr int I_POOL = (512 / 64) * (512 / 32), I_IN = (2048 / 64) * (DSA_NP / 32), I_OUT = (2048 / 64) * (2048 / 32), I_Q = (2048 / 64) * (512 / 32), I_KV = (2048 / 64) * (1024 / 32),
                  I_O = (512 / 64) * (2048 / 32), I_GU = (2048 / 64) * (2 * DFF / 32), I_DN = (DFF / 64) * (2048 / 32);
    constexpr int NITEMS = 4 * I_POOL + I_IN + I_OUT + 2 * (I_Q + I_KV + I_O + I_GU + I_DN);
    for (int it = gw; it < NITEMS; it += NGW) {
        int r = it; TJob j; bool found = false;
#pragma unroll
        for (int g = 0; g < 4; ++g) if (!found) { if (r < I_POOL) { j = TJob{a->pool_w + (size_t)g * 512 * 512, (h16*)(ws + WS_WPOOL) + (size_t)g * 512 * 512, a->pool_scale + g * 512, 512, 512, 512, 512, 0, 1.0f}; found = true; } else r -= I_POOL; }
        if (!found) { if (r < I_IN) { j = TJob{a->w_in, (h16*)(ws + WS_WIN), nullptr, DSA_N, 2048, DSA_NP, DSA_N, 0, 64.0f}; found = true; } else r -= I_IN; }
        if (!found) { if (r < I_OUT) { j = TJob{a->w_out, (h16*)(ws + WS_WOUT), nullptr, 2048, 2048, 2048, 2048, 0, 1.0f}; found = true; } else r -= I_OUT; }
#pragma unroll
        for (int L = 0; L < 2; ++L) {
            if (!found) { if (r < I_Q) { j = TJob{a->wq + (size_t)L * 2048 * 512, (h16*)(ws + WS_WQ) + (size_t)L * 512 * 2048, nullptr, 512, 2048, 512, 512, 0, 1.0f}; found = true; } else r -= I_Q; }
            if (!found) { if (r < I_KV) { j = TJob{a->wkv + (size_t)L * 2048 * 1024, (h16*)(ws + WS_WKV) + (size_t)L * 1024 * 2048, nullptr, 1024, 2048, 1024, 1024, 0, 1.0f}; found = true; } else r -= I_KV; }
            if (!found) { if (r < I_O) { j = TJob{a->wo + (size_t)L * 512 * 2048, (h16*)(ws + WS_WO) + (size_t)L * 2048 * 512, nullptr, 2048, 512, 2048, 2048, 0, 1.0f}; found = true; } else r -= I_O; }
            if (!found) { if (r < I_GU) { j = ((FFN_FP8 >> L) & 1) ? TJob{a->wgu + (size_t)L * 2048 * 2 * DFF, (h16*)(ws + WS_WGU) + (size_t)L * 2 * DFF * 2048, nullptr, 2 * DFF, 2048, 2 * DFF, 2 * DFF, 3, W8_SCALE} : TJob{a->wgu + (size_t)L * 2048 * 2 * DFF, (h16*)(ws + WS_WGU) + (size_t)L * 2 * DFF * 2048, nullptr, 2 * DFF, 2048, 2 * DFF, 2 * DFF, 1, 1.0f}; found = true; } else r -= I_GU; }
            if (!found) { if (r < I_DN) { j = ((DN_FP8 >> L) & 1) ? TJob{a->wdn + (size_t)L * DFF * 2048, (h16*)(ws + WS_WDN) + (size_t)L * 2048 * DFF, nullptr, 2048, DFF, 2048, 2048, 2, W8_SCALE} : TJob{a->wdn + (size_t)L * DFF * 2048, (h16*)(ws + WS_WDN) + (size_t)L * 2048 * DFF, nullptr, 2048, DFF, 2048, 2048, 0, 1.0f}; found = true; } else r -= I_DN; }
        }
        if (found) tjob_run(j, r, scr, F.lane);
    }
    for (int i = (gw * 64 + F.lane); i < T * 16; i += NGW * 64) rope_entry(a, (float*)(ws + WS_ROPE), i);
    for (int m = gw; m < NB * NMEM; m += NGW) norm_row_to_h16(a->mem + (size_t)m * D, a->mem_norm, (h16*)(ws + WS_MEMN) + (size_t)m * D, F.lane);
    __syncthreads();
    pool_pre(F, a->x, a->gains  , (h16*)(ws + WS_A));
}

template <bool HAS_NEXT, bool OUT8, bool HIN32, bool HOUT32>
__device__ __forceinline__ void seam_phase(Frame& F0, const h16* Y, const void* hin, void* hout, const float* gpost, const float* gpre, h16* aout) {
    Frame F = fresh(F0);
    const int gw = F.vcu * NWAVES + F.wave, NGW = F.G * NWAVES;
#pragma unroll 2
    for (int m = gw; m < T; m += NGW) {
        const h16* yr = Y + (size_t)m * D + 8 * F.lane;
        float y[4][8]; float s = 0.f;
#pragma unroll
        for (int j = 0; j < 4; ++j) { const half8 v = *(const half8*)(yr + 512 * j);
#pragma unroll
            for (int e = 0; e < 8; ++e) { y[j][e] = (float)v[e]; s += y[j][e] * y[j][e]; } }
        float hp[4][8];
#pragma unroll
        for (int j = 0; j < 4; ++j) {
            if constexpr (HIN32) { const f32x4 a = *(const f32x4*)((const float*)hin + (size_t)m * D + 8 * F.lane + 512 * j), c = *(const f32x4*)((const float*)hin + (size_t)m * D + 8 * F.lane + 512 * j + 4);
                hp[j][0] = a.x; hp[j][1] = a.y; hp[j][2] = a.z; hp[j][3] = a.w; hp[j][4] = c.x; hp[j][5] = c.y; hp[j][6] = c.z; hp[j][7] = c.w; }
            else { const half8 v = *(const half8*)((const h16*)hin + (size_t)m * D + 8 * F.lane + 512 * j);
#pragma unroll
                for (int e = 0; e < 8; ++e) hp[j][e] = (float)v[e]; } }
        const float r = rstd_of(wave_sum_dpp(s)); float s2 = 0.f;
#pragma unroll
        for (int j = 0; j < 4; ++j) { const f32x4 g0 = *(const f32x4*)(gpost + 8 * F.lane + 512 * j), g1 = *(const f32x4*)(gpost + 8 * F.lane + 512 * j + 4);
            const float g[8] = {g0.x, g0.y, g0.z, g0.w, g1.x, g1.y, g1.z, g1.w};
#pragma unroll
            for (int e = 0; e < 8; ++e) { const float h = hp[j][e] + y[j][e] * r * g[e]; y[j][e] = h; s2 += h * h; }
            if constexpr (HOUT32) { float* o = (float*)hout + (size_t)m * D + 8 * F.lane + 512 * j; *(f32x4*)o = (f32x4){y[j][0], y[j][1], y[j][2], y[j][3]}; *(f32x4*)(o + 4) = (f32x4){y[j][4], y[j][5], y[j][6], y[j][7]}; }
            else { u32x4 w; w.x = pkh(y[j][0], y[j][1]); w.y = pkh(y[j][2], y[j][3]); w.z = pkh(y[j][4], y[j][5]); w.w = pkh(y[j][6], y[j][7]); *(u32x4*)((h16*)hout + (size_t)m * D + 8 * F.lane + 512 * j) = w; } }
        if constexpr (HAS_NEXT) {
            const float r2 = rstd_of(wave_sum_dpp(s2));
#pragma unroll
            for (int j = 0; j < 4; ++j) { const f32x4 g0 = *(const f32x4*)(gpre + 8 * F.lane + 512 * j), g1 = *(const f32x4*)(gpre + 8 * F.lane + 512 * j + 4);
                const float g[8] = {g0.x, g0.y, g0.z, g0.w, g1.x, g1.y, g1.z, g1.w}; float v[8];
#pragma unroll
                for (int e = 0; e < 8; ++e) v[e] = y[j][e] * r2 * g[e];
                if constexpr (OUT8) { u32x2 w; w.x = pk8(v[0], v[1], v[2], v[3]); w.y = pk8(v[4], v[5], v[6], v[7]); *(u32x2*)((unsigned char*)aout + (size_t)m * D + 8 * F.lane + 512 * j) = w; }
                else { u32x4 w; w.x = pkh(v[0], v[1]); w.y = pkh(v[2], v[3]); w.z = pkh(v[4], v[5]); w.w = pkh(v[6], v[7]); *(u32x4*)(aout + (size_t)m * D + 8 * F.lane + 512 * j) = w; } }
        }
    }
}

__device__ __forceinline__ void xattn_phase(Frame& F0, h16* XQ, const h16* KVM  ) {
    Frame F = fresh(F0);
    LAS unsigned char* Ks = F.lds + RING_OFF; LAS unsigned char* Vt = F.lds + RING_OFF + 65536;
    const int lane = F.lane, n = lane & 31, hh = lane >> 5;
    for (int u = F.vcu; u < NB * 4 * (SEQ / 512); u += F.G) {
        const int b = u / (4 * (SEQ / 512)), h = (u / (SEQ / 512)) & 3, ch = u % (SEQ / 512);
        const h16* kb = KVM + (size_t)b * NMEM * 2048 + h * HD;
        for (int i = F.tid; i < 256 * 16; i += NWAVES * 64) { const int key = i >> 4, c = i & 15;
            const u32x4 kv = *(const u32x4*)(kb + (size_t)key * 2048 + 8 * c);
            *(LAS u32x4*)(Ks + key * 256 + ((c ^ (key & 15)) << 4)) = kv;
            const half8 vv = *(const half8*)(kb + (size_t)key * 2048 + 512 + 8 * c);
            const int o = key & 15, posk = (key & ~15) | ((o & 3) | ((o & 4) << 1) | ((o & 8) >> 1));
#pragma unroll
            for (int e = 0; e < 8; ++e) { const int d = 8 * c + e; *(LAS h16*)(Vt + d * 512 + (((posk >> 3) ^ (d & 15)) << 4) + (posk & 7) * 2) = vv[e]; }
        }
        __syncthreads();
#pragma unroll 1
        for (int sub = 0; sub < 2; ++sub) {
            const size_t m0 = (size_t)b * SEQ + ch * 512 + sub * 256 + F.wave * 32;
            h16* qrow = XQ + (m0 + n) * XW + h * HD;
            half8 qf[8];
#pragma unroll
            for (int s = 0; s < 8; ++s) qf[s] = *(const half8*)(qrow + 16 * s + 8 * hh);
            f32x16 o[4];
#pragma unroll
            for (int mt = 0; mt < 4; ++mt)
#pragma unroll
                for (int i = 0; i < 16; ++i) o[mt][i] = 0.f;
            const float c2 = 0.08838834764831845f * 1.44269504089f;
            float mrun = -3.0e38f, lrun = 0.f;
#pragma unroll 1
            for (int hf = 0; hf < 2; ++hf) {
                f32x16 acc[4];
#pragma unroll
                for (int kt = 0; kt < 4; ++kt) {
#pragma unroll
                    for (int i = 0; i < 16; ++i) acc[kt][i] = 0.f;
                    const int key = 128 * hf + 32 * kt + n;
#pragma unroll
                    for (int s = 0; s < 8; ++s) { const half8 ka = *(const LAS half8*)(Ks + key * 256 + (((2 * s + hh) ^ (key & 15)) << 4));
                        acc[kt] = __builtin_amdgcn_mfma_f32_32x32x16_f16(ka, qf[s], acc[kt], 0, 0, 0); }
                }
                float mx = mrun;
#pragma unroll
                for (int kt = 0; kt < 4; ++kt)
#pragma unroll
                    for (int i = 0; i < 16; ++i) mx = fmaxf(mx, acc[kt][i]);
                mx = fmaxf(mx, __shfl_xor(mx, 32));
                const float alpha = __builtin_amdgcn_exp2f((mrun - mx) * c2); mrun = mx;
                float sum = 0.f;
#pragma unroll
                for (int kt = 0; kt < 4; ++kt)
#pragma unroll
                    for (int i = 0; i < 16; ++i) { const float p = __builtin_amdgcn_exp2f((acc[kt][i] - mx) * c2); acc[kt][i] = p; sum += p; }
                lrun = lrun * alpha + sum;
#pragma unroll
                for (int mt = 0; mt < 4; ++mt)
#pragma unroll
                    for (int i = 0; i < 16; ++i) o[mt][i] *= alpha;
#pragma unroll
                for (int kt = 0; kt < 4; ++kt)
#pragma unroll
                    for (int s2 = 0; s2 < 2; ++s2) {
                        half8 pb;
#pragma unroll
                        for (int j = 0; j < 8; ++j) pb[j] = (h16)acc[kt][8 * s2 + j];
#pragma unroll
                        for (int mt = 0; mt < 4; ++mt) { const int d = 32 * mt + n;
                            const half8 va = *(const LAS half8*)(Vt + d * 512 + (((2 * (2 * (4 * hf + kt) + s2) + hh) ^ (d & 15)) << 4));
                            o[mt] = __builtin_amdgcn_mfma_f32_32x32x16_f16(va, pb, o[mt], 0, 0, 0); }
                    }
            }
            lrun += __shfl_xor(lrun, 32);
            const float inv = 1.0f / lrun;
#pragma unroll
            for (int mt = 0; mt < 4; ++mt)
#pragma unroll
                for (int jj = 0; jj < 4; ++jj) { u32x2 w; w.x = pkh(o[mt][4 * jj] * inv, o[mt][4 * jj + 1] * inv); w.y = pkh(o[mt][4 * jj + 2] * inv, o[mt][4 * jj + 3] * inv);
                    *(u32x2*)(qrow + 32 * mt + 8 * jj + 4 * hh) = w; }
        }
        __syncthreads();
    }
}

__device__ __forceinline__ unsigned mono_key(unsigned u) { return (u & 0x80000000u) ? ~u : (u | 0x80000000u); }
__device__ __forceinline__ void keymap_clear(LAS unsigned* bm, int lane) { *(LAS u32x4*)(bm + 8 * lane) = (u32x4){0u, 0u, 0u, 0u}; *(LAS u32x4*)(bm + 8 * lane + 4) = (u32x4){0u, 0u, 0u, 0u}; }
__device__ __forceinline__ void keymap_emit(LAS unsigned* bm, unsigned short* out, int nvalid, int lane) {
    const u32x4 w0 = *(const LAS u32x4*)(bm + 8 * lane), w1 = *(const LAS u32x4*)(bm + 8 * lane + 4);
    unsigned w[8] = {w0.x, w0.y, w0.z, w0.w, w1.x, w1.y, w1.z, w1.w};
    int mine = 0;
#pragma unroll
    for (int j = 0; j < 8; ++j) mine += __builtin_popcount(w[j]);
    int incl = mine;
#pragma unroll
    for (int o = 1; o < 64; o <<= 1) { const int v = __shfl_up(incl, o); if (lane >= o) incl += v; }
    int pos = incl - mine;
#pragma unroll
    for (int j = 0; j < 8; ++j) { unsigned x = w[j]; while (x) { const int b = __builtin_ctz(x); out[pos++] = (unsigned short)((8 * lane + j) * 32 + b); x &= x - 1u; } }
    const int total = __shfl(incl, 63);
    for (int i = total + lane; i < TOPK; i += 64) out[i] = (unsigned short)0;
}
constexpr int SEL_N = LIST_CAP / 64;
template <bool FINAL>
__device__ __forceinline__ void select256(u32x2* list, int c, LAS float* th_out, LAS unsigned* cnt_out, LAS unsigned* bm, int lane) {
    unsigned key[SEL_N], id[SEL_N];
#pragma unroll
    for (int k = 0; k < SEL_N; ++k) { const int i = lane + 64 * k; const u32x2 v = list[i]; key[k] = (i < c) ? mono_key(v.x) : 0u; id[k] = v.y; }
    unsigned mx = key[0];
#pragma unroll
    for (int k = 1; k < SEL_N; ++k) mx = key[k] > mx ? key[k] : mx;
#pragma unroll
    for (int o = 1; o < 64; o <<= 1) { const unsigned v = (unsigned)__shfl_xor((int)mx, o); mx = v > mx ? v : mx; }
    unsigned lo = FINAL ? 1u : mono_key(__float_as_uint(*th_out)), hi = mx;
    constexpr int PRUNE_KEEP = 320;
#pragma unroll 1
    while (lo < hi) { const unsigned mid = lo + ((hi - lo + 1u) >> 1); int cc = 0;
#pragma unroll
        for (int k = 0; k < SEL_N; ++k) cc += __builtin_popcountll(__ballot(key[k] >= mid));
        if (cc >= TOPK) { lo = mid; if (cc <= (FINAL ? TOPK : PRUNE_KEEP)) break; } else hi = mid - 1u; }
    const unsigned prefix = lo;
    int ngt = 0, neq = 0;
#pragma unroll
    for (int k = 0; k < SEL_N; ++k) { ngt += __builtin_popcountll(__ballot(key[k] > prefix)); neq += __builtin_popcountll(__ballot(key[k] == prefix)); }
    const int need_eq = FINAL ? (TOPK - ngt) : neq; int base_gt = 0, base_eq = 0;
    const unsigned long long lt = (1ull << lane) - 1ull;
#pragma unroll
    for (int k = 0; k < SEL_N; ++k) {
        const unsigned long long bgt = __ballot(key[k] > prefix), beq = __ballot(key[k] == prefix);
        int pos = -1;
        if (key[k] > prefix) pos = base_gt + __builtin_popcountll(bgt & lt);
        else if (key[k] == prefix) { const int r = base_eq + __builtin_popcountll(beq & lt); if (r < need_eq) pos = ngt + r; }
        if (pos >= 0) { if constexpr (FINAL) __hip_atomic_fetch_or(bm + (id[k] >> 5), 1u << (id[k] & 31u), __ATOMIC_RELAXED, __HIP_MEMORY_SCOPE_WORKGROUP); else { u32x2 v; v.x = (key[k] & 0x80000000u) ? (key[k] & 0x7fffffffu) : ~key[k]; v.y = id[k]; list[pos] = v; } }
        base_gt += __builtin_popcountll(bgt); base_eq += __builtin_popcountll(beq);
        __builtin_amdgcn_sched_barrier(0);
    }
    if constexpr (!FINAL) { if (lane == 0) { const unsigned u = (prefix & 0x80000000u) ? (prefix & 0x7fffffffu) : ~prefix; *th_out = __builtin_bit_cast(float, u); *cnt_out = (unsigned)(ngt + neq); } }
}
__device__ __forceinline__ void indexer_phase(Frame& F0, const h16* IQ, const h16* IK, const float* IW, unsigned short* IDX, u32x2* LISTS) {
    Frame F = fresh(F0);
    LAS unsigned char* bq = F.lds + RING_OFF;
    LAS unsigned* cnt = (LAS unsigned*)(F.lds + RING_OFF + 131072); LAS float* th = (LAS float*)(cnt + 32); LAS unsigned* flag = cnt + 64; LAS unsigned* sgn = cnt + 96;
    u32x2* mylist = LISTS + (size_t)blockIdx.x * 32 * LIST_CAP;
    const int lane = F.lane, n = lane & 31, hh = lane >> 5, w8 = F.wave;
    const float INF = __builtin_inff();
    constexpr int NU = NB * (SEQ / 32);
    for (int rnd = 0; rnd * F.G < NU; ++rnd) {
        int qt, b;
        if (F.G == 256) {
            const int i = (F.vcu & 31) + 32 * (F.vcu >> 6); b = (F.vcu >> 5) & 1;
            qt = rnd == 0 ? 511 - i : rnd == 1 ? i : rnd == 2 ? 256 + i : 255 - i;
        } else { const int kk = rnd * F.G + ((rnd & 1) ? (F.G - 1 - F.vcu) : F.vcu); if (kk >= NU) continue; qt = (SEQ / 32 - 1) - (kk >> 1); b = kk & 1; }
        const int nkt = qt + 1;
        const size_t m0 = (size_t)b * SEQ + 32 * qt;
        if (F.tid < 32) { cnt[F.tid] = 0u; th[F.tid] = -INF; unsigned mk = 0u;
#pragma unroll
            for (int h = 0; h < 16; ++h) mk |= (IW[(m0 + F.tid) * 16 + h] >= 0.f ? 1u : 0u) << h;
            sgn[F.tid] = mk; }
        if (F.tid == 0) *flag = 0u;
        { const int q = F.tid & 31, ch = F.tid >> 5;
#pragma unroll 4
            for (int h = 0; h < 16; ++h) { const float w = IW[(m0 + q) * 16 + h]; const half8 v = *(const half8*)(IQ + (m0 + q) * 2048 + h * HD + 8 * ch); half8 o;
#pragma unroll
                for (int e = 0; e < 8; ++e) o[e] = (h16)((float)v[e] * w);
                *(LAS half8*)(bq + (h * 16 + ch) * 512 + q * 16) = o; } }
        __syncthreads();
        const h16* ikb = IK + (size_t)b * SEQ * HD;
        const unsigned smask = sgn[n];
        float theta = -INF;
        const int qpos = 32 * qt + n;
        u32x2* lp = mylist + (size_t)n * LIST_CAP;
        half8 A[8];
        if (w8 < nkt) { const h16* arow = ikb + (size_t)(32 * w8 + n) * HD + 8 * hh;
#pragma unroll
            for (int c = 0; c < 8; ++c) A[c] = *(const half8*)(arow + 16 * c); }
#pragma unroll 1
        for (int r0 = 0; r0 < nkt; r0 += NWAVES) {
            const int kt = r0 + w8;
            if (kt < nkt) {
                f32x16 S;
#pragma unroll
                for (int i = 0; i < 16; ++i) S[i] = 0.f;
                const LAS unsigned char* bl = bq + hh * 512 + n * 16;
                half8 Ba[4], Bb[4]; f32x16 acc0, acc1;
#define IDX_LOADB(dst, h, c0) do { _Pragma("unroll") for (int c = 0; c < 4; ++c) dst[c] = *(const LAS half8*)(bl + ((h) * 16 + 2 * ((c0) + c)) * 512); } while (0)
#define IDX_MMA4(acc, Bx, c0) do { _Pragma("unroll") for (int c = 0; c < 4; ++c) acc = __builtin_amdgcn_mfma_f32_32x32x16_f16(A[(c0) + c], Bx[c], acc, 0, 0, 0); } while (0)
#define IDX_ZERO(acc) do { _Pragma("unroll") for (int i = 0; i < 16; ++i) acc[i] = 0.f; } while (0)
#define IDX_FOLD8(acc, h, i0) do { const float cc_ = ((smask >> (h)) & 1u) ? INF : -INF; _Pragma("unroll") for (int i = (i0); i < (i0) + 8; ++i) S[i] += __builtin_amdgcn_fmed3f(acc[i], 0.f, cc_); } while (0)
#define IDX_SCHED4() do { __builtin_amdgcn_sched_group_barrier(0x008, 1, 0); __builtin_amdgcn_sched_group_barrier(0x100, 1, 0); _Pragma("unroll") for (int g_ = 0; g_ < 3; ++g_) { __builtin_amdgcn_sched_group_barrier(0x008, 1, 0); __builtin_amdgcn_sched_group_barrier(0x100, 1, 0); __builtin_amdgcn_sched_group_barrier(0x002, 6, 0); } } while (0)
                IDX_LOADB(Ba, 0, 0);
                IDX_ZERO(acc1);
#pragma unroll 1
                for (int h = 0; h < 16; h += 2) {
                    IDX_ZERO(acc0);
                    IDX_MMA4(acc0, Ba, 0); IDX_FOLD8(acc1, (h + 15) & 15, 0); IDX_LOADB(Bb, h, 4); IDX_SCHED4();
                    IDX_MMA4(acc0, Bb, 4); IDX_FOLD8(acc1, (h + 15) & 15, 8); IDX_LOADB(Ba, h + 1, 0); IDX_SCHED4();
                    IDX_ZERO(acc1);
                    IDX_MMA4(acc1, Ba, 0); IDX_FOLD8(acc0, h, 0); IDX_LOADB(Bb, h + 1, 4); IDX_SCHED4();
                    IDX_MMA4(acc1, Bb, 4); IDX_FOLD8(acc0, h, 8); IDX_LOADB(Ba, (h + 2) & 15, 0); IDX_SCHED4();
                }
                IDX_FOLD8(acc1, 15, 0); IDX_FOLD8(acc1, 15, 8);
#if IDX_PROBE_MMA
                {
                    f32x16 S1 = S;
#pragma unroll
                    for (int c = 0; c < 8; ++c) asm volatile("" : "+v"(A[c]));
#pragma unroll
                    for (int i = 0; i < 16; ++i) S[i] = 0.f;
                    IDX_LOADB(Ba, 0, 0);
                    IDX_ZERO(acc1);
#pragma unroll 1
                    for (int h = 0; h < 16; h += 2) {
                        IDX_ZERO(acc0);
                        IDX_MMA4(acc0, Ba, 0); IDX_FOLD8(acc1, (h + 15) & 15, 0); IDX_LOADB(Bb, h, 4); IDX_SCHED4();
                        IDX_MMA4(acc0, Bb, 4); IDX_FOLD8(acc1, (h + 15) & 15, 8); IDX_LOADB(Ba, h + 1, 0); IDX_SCHED4();
                        IDX_ZERO(acc1);
                        IDX_MMA4(acc1, Ba, 0); IDX_FOLD8(acc0, h, 0); IDX_LOADB(Bb, h + 1, 4); IDX_SCHED4();
                        IDX_MMA4(acc1, Bb, 4); IDX_FOLD8(acc0, h, 8); IDX_LOADB(Ba, (h + 2) & 15, 0); IDX_SCHED4();
                    }
                    IDX_FOLD8(acc1, 15, 0); IDX_FOLD8(acc1, 15, 8);
#pragma unroll
                    for (int i = 0; i < 16; ++i) S[i] = (S[i] + S1[i]) * 0.5f;
                }
#endif
#undef IDX_LOADB
#undef IDX_MMA4
#undef IDX_ZERO
#undef IDX_FOLD8
#undef IDX_SCHED4
                if (kt + NWAVES < nkt) { const h16* arow = ikb + (size_t)(32 * (kt + NWAVES) + n) * HD + 8 * hh;
#pragma unroll
                    for (int c = 0; c < 8; ++c) A[c] = *(const half8*)(arow + 16 * c); }
                const int kb0 = 32 * kt + 4 * hh;
                unsigned pm = 0u;
                if (kt < qt) {
#pragma unroll
                    for (int i = 0; i < 16; ++i) pm |= (S[i] > theta) ? (1u << i) : 0u;
                } else {
#pragma unroll
                    for (int i = 0; i < 16; ++i) { const int key = kb0 + (i & 3) + 8 * (i >> 2); pm |= ((key <= qpos) && (S[i] > theta)) ? (1u << i) : 0u; }
                }
                if (pm) { const unsigned np = (unsigned)__builtin_popcount(pm);
                    const unsigned pos = __hip_atomic_fetch_add(cnt + n, np, __ATOMIC_RELAXED, __HIP_MEMORY_SCOPE_WORKGROUP);
#pragma unroll
                    for (int i = 0; i < 16; ++i) if (pm & (1u << i)) { u32x2 e; e.x = __float_as_uint(S[i]);   e.y = (unsigned)(kb0 + (i & 3) + 8 * (i >> 2));
                        { const unsigned at = pos + (unsigned)__builtin_popcount(pm & ((1u << i) - 1u)); lp[at < (unsigned)LIST_CAP ? at : (unsigned)LIST_CAP - 1u] = e; } }
                    if (pos + np > (unsigned)(LIST_CAP - 256)) *(volatile LAS unsigned*)flag = 1u; }
            }
            asm volatile("s_waitcnt lgkmcnt(0)" ::: "memory"); __builtin_amdgcn_s_barrier(); asm volatile("" ::: "memory");
            if (*(volatile LAS unsigned*)flag != 0u) {
                VM_WAIT(); __syncthreads();
                for (int q = w8; q < 32; q += NWAVES) { const int c = __builtin_amdgcn_readfirstlane((int)cnt[q]); if (c > TOPK) select256<false>(mylist + (size_t)q * LIST_CAP, c, th + q, cnt + q, nullptr, lane); }
                if (F.tid == 0) *flag = 0u;
                VM_WAIT(); __syncthreads();
                theta = th[n];
                if (kt + NWAVES < nkt) { const h16* arow = ikb + (size_t)(32 * (kt + NWAVES) + n) * HD + 8 * hh;
#pragma unroll
                    for (int c = 0; c < 8; ++c) A[c] = *(const half8*)(arow + 16 * c); }
            }
        }
        VM_WAIT(); __syncthreads();
        LAS unsigned* bm = (LAS unsigned*)(bq + w8 * 2048);
        for (int q = w8; q < 32; q += NWAVES) { const int c = __builtin_amdgcn_readfirstlane((int)cnt[q]); unsigned short* io = IDX + (m0 + q) * TOPK; u32x2* lq = mylist + (size_t)q * LIST_CAP;
            keymap_clear(bm, lane); asm volatile("s_waitcnt lgkmcnt(0)" ::: "memory");
            if (c > TOPK) select256<true>(lq, c, nullptr, nullptr, bm, lane);
            else {
#pragma unroll
                for (int k = 0; k < 4; ++k) { const int i = lane + 64 * k; if (i < c) { const unsigned key = lq[i].y; __hip_atomic_fetch_or(bm + (key >> 5), 1u << (key & 31u), __ATOMIC_RELAXED, __HIP_MEMORY_SCOPE_WORKGROUP); } } }
            asm volatile("s_waitcnt lgkmcnt(0)" ::: "memory");
            keymap_emit(bm, io, c, lane);
            asm volatile("s_waitcnt lgkmcnt(0)" ::: "memory"); }
        __syncthreads();
    }
}

__device__ __forceinline__ unsigned q_fetch(unsigned* ctr, int lane) { unsigned v = 0u; if (lane == 0) v = __hip_atomic_fetch_add(ctr, 1u, __ATOMIC_RELAXED, __HIP_MEMORY_SCOPE_AGENT); return (unsigned)__builtin_amdgcn_readfirstlane((int)v); }
__device__ __forceinline__ void sparse_attn_phase(Frame& F0, const h16* Q, const unsigned char* K8, const unsigned char* V8, const unsigned short* IDX, h16* O, unsigned* qctr) {
    Frame F = fresh(F0);
    LAS unsigned char* wl = F.lds + RING_OFF + F.wave * 16896;
    LAS float* Pl = (LAS float*)wl;
    LAS unsigned short* Il = (LAS unsigned short*)(wl + 4096);
    const int lane = F.lane, r16 = lane & 15, g4 = lane >> 4;
    const float c2 = 0.08838834764831845f * 1.44269504089f;
    const unsigned x0 = xb_xcc_id() & 7u;
    unsigned tried = 0u, p = x0;
    unsigned item = q_fetch(qctr + 64 * p, lane);
    bool have_pf = false; u32x2 pf_idx = (u32x2){0u, 0u}; half8 pf_q[4];
#pragma unroll
    for (int s = 0; s < 4; ++s) pf_q[s] = (half8){0, 0, 0, 0, 0, 0, 0, 0};
    for (;;) {
        while (item >= (unsigned)SEQ && tried < 8u) { ++tried; p = (x0 + tried) & 7u; if (tried < 8u) item = q_fetch(qctr + 64 * p, lane); }
        if (tried >= 8u) break;
        const unsigned nxt = q_fetch(qctr + 64 * p, lane);
        const int b = (int)(p >> 2), j = (int)(p & 3u), tq = (int)item, nk = (tq + 1) < TOPK ? (tq + 1) : TOPK;
        const size_t m = (size_t)b * SEQ + tq;
        const unsigned char* kb = K8 + (size_t)p * SEQ * HD; const unsigned char* vb = V8 + (size_t)p * SEQ * HD;
        *(LAS u32x2*)(Il + 4 * lane) = have_pf ? pf_idx : *(const u32x2*)(IDX + m * TOPK + 4 * lane);
        long qh[4], ql[4];
        { const h16* qrow = Q + m * 2048 + (size_t)j * 512 + (r16 & 3) * HD + 16 * g4;
#pragma unroll
          for (int s = 0; s < 4; ++s) { const half8 hv = have_pf ? pf_q[s] : *(const half8*)(qrow + (s >> 1) * 64 + (s & 1) * 8);
              float f[8], l[8];
#pragma unroll
              for (int e = 0; e < 8; ++e) f[e] = (float)hv[e] * c2;
              const unsigned h0 = pk8(f[0], f[1], f[2], f[3]), h1 = pk8(f[4], f[5], f[6], f[7]);
              l[0] = f[0] - __builtin_amdgcn_cvt_f32_fp8((int)h0, 0); l[1] = f[1] - __builtin_amdgcn_cvt_f32_fp8((int)h0, 1); l[2] = f[2] - __builtin_amdgcn_cvt_f32_fp8((int)h0, 2); l[3] = f[3] - __builtin_amdgcn_cvt_f32_fp8((int)h0, 3);
              l[4] = f[4] - __builtin_amdgcn_cvt_f32_fp8((int)h1, 0); l[5] = f[5] - __builtin_amdgcn_cvt_f32_fp8((int)h1, 1); l[6] = f[6] - __builtin_amdgcn_cvt_f32_fp8((int)h1, 2); l[7] = f[7] - __builtin_amdgcn_cvt_f32_fp8((int)h1, 3);
              const unsigned l0 = pk8(l[0], l[1], l[2], l[3]), l1 = pk8(l[4], l[5], l[6], l[7]);
              const bool real = r16 < 4;
              qh[s] = real ? (long)(((unsigned long long)h1 << 32) | h0) : 0l; ql[s] = real ? (long)(((unsigned long long)l1 << 32) | l0) : 0l; } }
        asm volatile("s_waitcnt lgkmcnt(0)" ::: "memory");
        int keys[16];
#pragma unroll
        for (int kt = 0; kt < 16; ++kt) keys[kt] = Il[16 * kt + r16];
        {
            u32x4 ka[8][2];
#pragma unroll
            for (int k8 = 0; k8 < 8; ++k8) { const unsigned char* krow = kb + (size_t)keys[k8] * HD + 16 * g4; ka[k8][0] = *(const u32x4*)krow; ka[k8][1] = *(const u32x4*)(krow + 64); }
#pragma unroll
            for (int kt = 0; kt < 16; ++kt) { const int k8 = kt & 7; const u32x4 a0 = ka[k8][0], a1 = ka[k8][1];
                const long ak[4] = {(long)(((unsigned long long)a0.y << 32) | a0.x), (long)(((unsigned long long)a0.w << 32) | a0.z), (long)(((unsigned long long)a1.y << 32) | a1.x), (long)(((unsigned long long)a1.w << 32) | a1.z)};
                if (kt < 8) { const unsigned char* krow = kb + (size_t)keys[kt + 8] * HD + 16 * g4; ka[k8][0] = *(const u32x4*)krow; ka[k8][1] = *(const u32x4*)(krow + 64); }
                f32x4 acc = (f32x4){0.f, 0.f, 0.f, 0.f};
#pragma unroll
                for (int s = 0; s < 4; ++s) { acc = __builtin_amdgcn_mfma_f32_16x16x32_fp8_fp8(ak[s], qh[s], acc, 0, 0, 0); acc = __builtin_amdgcn_mfma_f32_16x16x32_fp8_fp8(ak[s], ql[s], acc, 0, 0, 0); }
                if (r16 < 4) {
#pragma unroll
                    for (int i = 0; i < 4; ++i) Pl[(16 * kt + 4 * g4 + i) * 4 + r16] = acc[i]; }
            }
        }
        have_pf = nxt < (unsigned)SEQ;
        if (have_pf) { const size_t mn = (size_t)b * SEQ + nxt; pf_idx = *(const u32x2*)(IDX + mn * TOPK + 4 * lane);
            const h16* qn = Q + mn * 2048 + (size_t)j * 512 + (r16 & 3) * HD + 16 * g4;
#pragma unroll
            for (int s = 0; s < 4; ++s) pf_q[s] = *(const half8*)(qn + (s >> 1) * 64 + (s & 1) * 8); }
        asm volatile("" ::: "memory");
        LAS unsigned char* vs = wl + 4608;
        const int nch = (nk + 31) >> 5;
#define SP_ISSUE(ch_) do { const int c_ = (ch_); LAS unsigned char* s_ = vs + (c_ % 3) * 4096; _Pragma("unroll") for (int j_ = 0; j_ < 4; ++j_) { const int key_ = Il[32 * c_ + 8 * j_ + (lane >> 3)]; \
                __builtin_amdgcn_global_load_lds((const unsigned*)(vb + (size_t)key_ * HD + (((lane & 7) ^ (((8 * j_ + (lane >> 3)) >> 1) & 7)) * 16)), (LAS unsigned*)(s_ + 1024 * j_), 16, 0, 0); } } while (0)
            SP_ISSUE(0); if (nch > 1) SP_ISSUE(1);
        f32x4 sv[4]; f32x4 mx = (f32x4){-3.0e38f, -3.0e38f, -3.0e38f, -3.0e38f};
#pragma unroll
        for (int k = 0; k < 4; ++k) { sv[k] = *(const LAS f32x4*)(Pl + (lane + 64 * k) * 4); if (lane + 64 * k < nk) { mx[0] = fmaxf(mx[0], sv[k][0]); mx[1] = fmaxf(mx[1], sv[k][1]); mx[2] = fmaxf(mx[2], sv[k][2]); mx[3] = fmaxf(mx[3], sv[k][3]); } }
        mx[0] = wave_max_dpp(mx[0]); mx[1] = wave_max_dpp(mx[1]); mx[2] = wave_max_dpp(mx[2]); mx[3] = wave_max_dpp(mx[3]);
        f32x4 sum = (f32x4){0.f, 0.f, 0.f, 0.f};
        asm volatile("s_waitcnt lgkmcnt(0)" ::: "memory");
#pragma unroll
        for (int k = 0; k < 4; ++k) { f32x4 pv;
#pragma unroll
            for (int h = 0; h < 4; ++h) pv[h] = (lane + 64 * k < nk) ? __builtin_amdgcn_exp2f(sv[k][h] - mx[h]) : 0.f;
            sum += pv;
#pragma unroll
            for (int h = 0; h < 4; ++h) Pl[h * 256 + lane + 64 * k] = pv[h] * 16.0f; }
        sum[0] = wave_sum_dpp(sum[0]); sum[1] = wave_sum_dpp(sum[1]); sum[2] = wave_sum_dpp(sum[2]); sum[3] = wave_sum_dpp(sum[3]);
        asm volatile("s_waitcnt lgkmcnt(0)" ::: "memory");
        long ph[8], pq[8];
#pragma unroll
        for (int s = 0; s < 8; ++s) { const LAS float* pp = Pl + (r16 & 3) * 256 + 32 * s + 8 * g4; const f32x4 a = *(const LAS f32x4*)pp, c = *(const LAS f32x4*)(pp + 4);
            const unsigned h0 = pk8(a[0], a[1], a[2], a[3]), h1 = pk8(c[0], c[1], c[2], c[3]);
            const unsigned l0 = pk8(a[0] - __builtin_amdgcn_cvt_f32_fp8((int)h0, 0), a[1] - __builtin_amdgcn_cvt_f32_fp8((int)h0, 1), a[2] - __builtin_amdgcn_cvt_f32_fp8((int)h0, 2), a[3] - __builtin_amdgcn_cvt_f32_fp8((int)h0, 3));
            const unsigned l1 = pk8(c[0] - __builtin_amdgcn_cvt_f32_fp8((int)h1, 0), c[1] - __builtin_amdgcn_cvt_f32_fp8((int)h1, 1), c[2] - __builtin_amdgcn_cvt_f32_fp8((int)h1, 2), c[3] - __builtin_amdgcn_cvt_f32_fp8((int)h1, 3));
            const bool real = r16 < 4;
            ph[s] = real ? (long)(((unsigned long long)h1 << 32) | h0) : 0l; pq[s] = real ? (long)(((unsigned long long)l1 << 32) | l0) : 0l; }
        f32x4 oacc[8];
#pragma unroll
        for (int nt = 0; nt < 8; ++nt) oacc[nt] = (f32x4){0.f, 0.f, 0.f, 0.f};
        {
            const int vrow = 8 * g4 + (r16 >> 1);
#pragma unroll
            for (int ch = 0; ch < 8; ++ch) {
                if (ch < nch) {
                    if (ch + 2 < nch) { SP_ISSUE(ch + 2); asm volatile("s_waitcnt vmcnt(8)" ::: "memory"); }
                    else if (ch + 1 < nch) asm volatile("s_waitcnt vmcnt(4)" ::: "memory");
                    else asm volatile("s_waitcnt vmcnt(0)" ::: "memory");
                    const LAS unsigned char* s = vs + (ch % 3) * 4096 + vrow * HD + 8 * (r16 & 1);
#pragma unroll
                    for (int nt = 0; nt < 8; ++nt) {
                        const v2i32 bv = __builtin_amdgcn_ds_read_tr8_b64_v2i32((LAS v2i32*)(s + ((nt ^ ((vrow >> 1) & 7)) * 16)));
                        const long bb = (long)(((unsigned long long)(unsigned)bv.y << 32) | (unsigned)bv.x);
                        oacc[nt] = __builtin_amdgcn_mfma_f32_16x16x32_fp8_fp8(ph[ch], bb, oacc[nt], 0, 0, 0);
                        oacc[nt] = __builtin_amdgcn_mfma_f32_16x16x32_fp8_fp8(pq[ch], bb, oacc[nt], 0, 0, 0); }
                    asm volatile("s_waitcnt lgkmcnt(0)" ::: "memory");
                }
            }
#undef SP_ISSUE
        }
        { LAS h16* ot = (LAS h16*)Pl;
          if (g4 == 0) {
#pragma unroll
              for (int nt = 0; nt < 8; ++nt)
#pragma unroll
                  for (int i = 0; i < 4; ++i) ot[i * HD + 16 * nt + r16] = (h16)(oacc[nt][i] * (0.0625f / sum[i])); }
          asm volatile("s_waitcnt lgkmcnt(0)" ::: "memory");
          const u32x4 w = *(const LAS u32x4*)(ot + g4 * HD + 8 * r16);
          *(u32x4*)(O + m * 2048 + (size_t)j * 512 + g4 * HD + 8 * r16) = w; }
        asm volatile("s_waitcnt lgkmcnt(0)" ::: "memory");
        item = nxt;
    }
}

#ifndef DBG_CHECK
#define DBG_CHECK 0
#endif
#if DBG_CHECK
__device__ __forceinline__ void dbg_max(unsigned* w, float v) { atomicMax(w, __builtin_bit_cast(unsigned, fabsf(v))); }
__device__ __forceinline__ int dbg_row(int blk) { return (blk & 1) * SEQ + (SEQ - 1 - 251 * (blk >> 1)); }
__device__ __forceinline__ void dbg_check_inproj(unsigned char* ws, LAS float* sh, unsigned* word) {
    if (blockIdx.x >= 64) return;
    int tid_ = (int)threadIdx.x; asm volatile("" : "+v"(tid_)); const int m = dbg_row(blockIdx.x), tid = tid_;
    const h16* a = (const h16*)(ws + WS_A) + (size_t)m * 2048; const h16* W = (const h16*)(ws + WS_WIN);
    for (int c = tid; c < DSA_N; c += 512) { float s = 0.f; for (int k = 0; k < 2048; ++k) s += (float)a[k] * (float)W[(size_t)c * 2048 + k]; sh[c] = s * (1.0f / 64.0f); }
    __syncthreads();
    const float* rope = (const float*)(ws + WS_ROPE) + (size_t)m * 32;
    for (int c = tid; c < DSA_N; c += 512) {
        float v = sh[c]; int hc; bool rot; float got;
        if (c < 2048) { hc = c & 127; rot = true; got = (float)((const h16*)(ws + WS_Q))[(size_t)m * 2048 + c]; }
        else if (c < 3072) continue;
        else if (c < 5120) { hc = (c - 3072) & 127; rot = true; got = (float)((const h16*)(ws + WS_IQ))[(size_t)m * 2048 + (c - 3072)]; }
        else if (c < 5248) { hc = c - 5120; rot = true; got = (float)((const h16*)(ws + WS_IK))[(size_t)m * 128 + (c - 5120)]; }
        else { hc = 99; rot = false; got = ((const float*)(ws + WS_IW))[(size_t)m * 16 + (c - 5248)]; }
        if (rot && hc < 32) { const int i = hc & 15; const float cs = rope[i], sn = rope[16 + i]; v = hc < 16 ? v * cs - sh[c + 16] * sn : v * cs + sh[c - 16] * sn; }
        dbg_max(word, (got - v) / (1.0f + fabsf(v)));
    }
    __syncthreads();
}
__device__ __forceinline__ void dbg_check_xattn(unsigned char* ws, int L, LAS float* sh, unsigned* word) {
    if (blockIdx.x >= 64) return;
    int tid_ = (int)threadIdx.x; asm volatile("" : "+v"(tid_)); const int m = dbg_row(blockIdx.x), tid = tid_, b = m / SEQ;
    const h16* a = (const h16*)(ws + WS_A) + (size_t)m * 2048; const h16* W = (const h16*)(ws + WS_WQ) + (size_t)L * 512 * 2048;
    const h16* kvm = (const h16*)(ws + WS_KVM) + (size_t)b * NMEM * 2048 + L * 1024;
    LAS float* q = sh; LAS float* lg = sh + 512; LAS float* st = sh + 512 + 1024;
    { float s = 0.f; for (int k = 0; k < 2048; ++k) s += (float)a[k] * (float)W[(size_t)tid * 2048 + k]; q[tid] = (float)(h16)s; }
    __syncthreads();
    for (int i = tid; i < 1024; i += 512) { const int h = i >> 8, key = i & 255; float s = 0.f; for (int d = 0; d < 128; ++d) s += q[h * 128 + d] * (float)kvm[(size_t)key * 2048 + h * 128 + d]; lg[i] = s * 0.08838834764831845f; }
    __syncthreads();
    if (tid < 4) { float mx = -3e38f; for (int k = 0; k < 256; ++k) mx = fmaxf(mx, lg[tid * 256 + k]); float su = 0.f; for (int k = 0; k < 256; ++k) su += __expf(lg[tid * 256 + k] - mx); st[2 * tid] = mx; st[2 * tid + 1] = 1.0f / su; }
    __syncthreads();
    { const int h = tid >> 7, d = tid & 127; float o = 0.f; for (int k = 0; k < 256; ++k) o += __expf(lg[h * 256 + k] - st[2 * h]) * st[2 * h + 1] * (float)kvm[(size_t)k * 2048 + 512 + h * 128 + d];
      const float got = (float)((const h16*)(ws + WS_XQ))[(size_t)m * 512 + tid]; dbg_max(word, (got - o) / (0.05f + fabsf(o))); }
    __syncthreads();
}
__device__ __forceinline__ void dbg_check_indexer(unsigned char* ws, LAS float* sh, unsigned* word, unsigned* word2) {
    if (blockIdx.x >= 64) return;
    int tid_ = (int)threadIdx.x; asm volatile("" : "+v"(tid_)); const int m = dbg_row(blockIdx.x), tid = tid_, b = m / SEQ, t = m % SEQ;
    const h16* iq = (const h16*)(ws + WS_IQ) + (size_t)m * 2048; const h16* ik = (const h16*)(ws + WS_IK) + (size_t)b * SEQ * 128; const float* iw = (const float*)(ws + WS_IW) + (size_t)m * 16;
    LAS float* sc = sh;
    for (int s = tid; s <= t; s += 512) { float tot = 0.f; for (int h = 0; h < 16; ++h) { float l = 0.f; for (int d = 0; d < 128; ++d) l += (float)iq[h * 128 + d] * (float)ik[(size_t)s * 128 + d]; tot += iw[h] * fmaxf(l, 0.f); } sc[s] = tot; }
    __syncthreads();
    const unsigned short* idx = (const unsigned short*)(ws + WS_IDX) + (size_t)m * 256;
    if (tid < 256) { const int key = idx[tid]; if (key > t) atomicAdd(word2, 1000u); else { const float v = sc[key]; int rank = 0; for (int s = 0; s <= t; ++s) rank += sc[s] > v ? 1 : 0; if (rank >= 256) atomicAdd(word, 1u);
        for (int j = 0; j < 256; ++j) if (j != tid && idx[j] == key) { atomicAdd(word2, 1u); break; } } }
    __syncthreads();
}
__device__ __forceinline__ float dbg_f8(const unsigned char* p) { const unsigned w = *p; return __builtin_amdgcn_cvt_f32_fp8((int)w, 0); }
__device__ __forceinline__ void dbg_check_sparse(unsigned char* ws, LAS float* sh, unsigned* word) {
    if (blockIdx.x >= 64) return;
    int tid_ = (int)threadIdx.x; asm volatile("" : "+v"(tid_)); const int m = dbg_row(blockIdx.x), tid = tid_, b = m / SEQ;
    const h16* q = (const h16*)(ws + WS_Q) + (size_t)m * 2048; const unsigned char* k8 = (const unsigned char*)(ws + WS_KV); const unsigned char* v8 = k8 + (size_t)16 * 1024 * 1024;
    const unsigned short* idx = (const unsigned short*)(ws + WS_IDX) + (size_t)m * 256;
    LAS float* lg = sh; LAS float* st = sh + 4096;
    for (int i = tid; i < 4096; i += 512) { const int h = i >> 8, k = i & 255, key = idx[k]; float s = 0.f; const unsigned char* kr = k8 + ((size_t)(b * NKV + (h >> 2)) * SEQ + key) * HD;
        for (int d = 0; d < 128; ++d) s += (float)q[h * 128 + d] * dbg_f8(kr + d); lg[i] = s * 0.08838834764831845f; }
    __syncthreads();
    if (tid < 16) { float mx = -3e38f; for (int k = 0; k < 256; ++k) mx = fmaxf(mx, lg[tid * 256 + k]); float su = 0.f; for (int k = 0; k < 256; ++k) su += __expf(lg[tid * 256 + k] - mx); st[2 * tid] = mx; st[2 * tid + 1] = 1.0f / su; }
    __syncthreads();
    for (int i = tid; i < 2048; i += 512) { const int h = i >> 7, d = i & 127; float o = 0.f; for (int k = 0; k < 256; ++k) o += __expf(lg[h * 256 + k] - st[2 * h]) * st[2 * h + 1] * dbg_f8(v8 + ((size_t)(b * NKV + (h >> 2)) * SEQ + idx[k]) * HD + d);
        const float got = (float)((const h16*)(ws + WS_A))[(size_t)m * 2048 + i]; dbg_max(word, (got - o) / (0.02f + fabsf(o))); }
    __syncthreads();
}
#endif

constexpr int N_PHASES = 22 + (DBG_CHECK ? 1 : 0);
__global__ void __launch_bounds__(NWAVES * 64, 2) trunk_fwd(Args args) {
    extern __shared__ __attribute__((aligned(16))) unsigned char lds_raw[];
    Frame F;
    F.lds = (LAS unsigned char*)lds_raw;
    F.MISC = (volatile LAS unsigned*)(F.lds + MISC_OFF);
    F.tid = threadIdx.x; F.lane = F.tid & 63; F.wave = __builtin_amdgcn_readfirstlane(F.tid >> 6);
    F.G = gridDim.x; { const int bx = blockIdx.x; F.vcu = (F.G % 8 == 0) ? (bx % 8) * (F.G / 8) + bx / 8 : bx; }
    unsigned char* ws = argp()->ws;
    for (int u = F.tid; u < (LDS_BYTES - MISC_OFF) / 4; u += NWAVES * 64) ((LAS unsigned*)(F.lds + MISC_OFF))[u] = 0u;
    __syncthreads();
    XcdBarrier bar; bar.bar = (unsigned*)(ws + WS_CTL) + CW_BAR; bar.x = 0; bar.st = nullptr;
    if (!MK_LAUNCH_PER_PHASE) bar = xcd_barrier_post((unsigned*)(ws + WS_CTL) + CW_BAR, F.MISC + 8);
    const int lo = argp()->ph_lo, hi = argp()->ph_hi;
#ifndef DBG_KINDS
#define DBG_KINDS 0xFFFF
#endif
#define KON(kind) (((DBG_KINDS) >> (kind)) & 1)
#ifndef PROBE_REP
#define PROBE_REP 0
#endif
#define NREP(kind) ((((PROBE_REP) >> (kind)) & 1) ? 2 : 1)
#define IN(k) (lo <= (k) && (k) < hi)
#define SEAM(k) do { if (IN((k) + 1)) { if (MK_LAUNCH_PER_PHASE) { } else xcd_barrier(bar); } } while (0)
    LAS unsigned char* ring = F.lds + RING_OFF;
    const int bid = (int)blockIdx.x;
    h16* A = (h16*)(ws + WS_A); h16* Y = (h16*)(ws + WS_Y); h16* H = (h16*)(ws + WS_H); h16* XQ = (h16*)(ws + WS_XQ); h16* ACT = (h16*)(ws + WS_ACT);

    if (KON(0) && IN(0)) { for (int rep = 0; rep < NREP(0); ++rep) { if (rep) xcd_barrier(bar); p0_prologue(F, argp()); } SEAM(0); }
    if (KON(1) && IN(1)) {
        { pg8::Gemm g{A, (const h16*)(ws + WS_WPOOL), T, D, 512, D, 1}; pg8::StaticOrder S; S.init(T, D, F.G, bid);
          pg8::EpiH16 E{Y, D, 1.0f}; pg8::gemm_phase<pg8::EpiH16, pg8::StaticOrder, true, true>(ring, g, S, E); }
        __syncthreads();
        { pg8::Gemm g{(const h16*)(ws + WS_MEMN), (const h16*)(ws + WS_WKV), NB * NMEM, 2048, 2048, 2048, 31}; pg8::StaticOrder S; S.init(NB * NMEM, 2048, F.G, bid);
          pg8::EpiH16 E{(h16*)(ws + WS_KVM), 2048, 1.0f}; pg8::gemm_phase<pg8::EpiH16, pg8::StaticOrder, true, true>(ring, g, S, E); }
        SEAM(1);
    }
#pragma unroll 1
    for (int L = 0; L < 2; ++L) {
        const int pb = L == 0 ? 2 : 14;
        if (L == 1) {
            if (KON(2) && IN(10)) {
                pg8::Gemm g{A, (const h16*)(ws + WS_WIN), T, DSA_NP, 2048, 2048, 31}; pg8::StaticOrder S; S.init(T, DSA_NP, F.G, bid);
                pg8::EpiInProj E{(h16*)(ws + WS_Q), (h16*)(ws + WS_KV), (h16*)(ws + WS_IQ), (h16*)(ws + WS_IK), (float*)(ws + WS_IW), (const float*)(ws + WS_ROPE), 1.0f / 64.0f};
                for (int rep = 0; rep < NREP(2); ++rep) { if (rep) xcd_barrier(bar); pg8::gemm_phase<pg8::EpiInProj, pg8::StaticOrder, true, true>(ring, g, S, E); }
                SEAM(10);
            }
#if DBG_CHECK
            if (IN(11)) dbg_check_inproj(ws, (LAS float*)ring, (unsigned*)(ws + WS_CTL) + 1024);
#endif
            if (KON(3) && IN(11)) { for (int rep = 0; rep < NREP(3); ++rep) { if (rep) xcd_barrier(bar); indexer_phase(F, (const h16*)(ws + WS_IQ), (const h16*)(ws + WS_IK), (const float*)(ws + WS_IW), (unsigned short*)(ws + WS_IDX), (u32x2*)(ws + WS_LISTS)); } SEAM(11); }
#if DBG_CHECK
            if (IN(12)) dbg_check_indexer(ws, (LAS float*)ring, (unsigned*)(ws + WS_CTL) + 1026, (unsigned*)(ws + WS_CTL) + 1028);
#endif
            if (KON(4) && IN(12)) { for (int rep = 0; rep < NREP(4); ++rep) { if (rep) xcd_barrier(bar); sparse_attn_phase(F, (const h16*)(ws + WS_Q), (const unsigned char*)(ws + WS_KV), (const unsigned char*)(ws + WS_KV) + (size_t)16 * 1024 * 1024, (const unsigned short*)(ws + WS_IDX), A, (unsigned*)(ws + WS_CTL) + 2048 + 512 * rep); } SEAM(12); }
#if DBG_CHECK
            if (IN(13)) dbg_check_sparse(ws, (LAS float*)ring, (unsigned*)(ws + WS_CTL) + 1027);
#endif
            if (KON(5) && IN(13)) {
                pg8::Gemm g{A, (const h16*)(ws + WS_WOUT), T, D, 2048, 2048, 31}; pg8::StaticOrder S; S.init(T, D, F.G, bid);
                pg8::EpiH16 E{Y, D, 1.0f}; pg8::gemm_phase<pg8::EpiH16, pg8::StaticOrder, true, true>(ring, g, S, E);
                SEAM(13);
            }
        }
        if (KON(6) && IN(pb + 0)) { ArgP a = argp(); const float* gains = a->gains + (size_t)L * 6 * D;
            if (L == 0) seam_phase<true, false, true, false>(F, Y, a->x, H, gains + 1 * D, gains + 2 * D, A); else seam_phase<true, false, false, false>(F, Y, H, H, gains + 1 * D, gains + 2 * D, A);
            SEAM(pb + 0); }
        if (KON(7) && IN(pb + 1)) {
            pg8::Gemm g{A, (const h16*)(ws + WS_WQ) + (size_t)L * XW * 2048, T, XW, 2048, 2048, 31}; pg8::StaticOrder S; S.init(T, XW, F.G, bid);
            pg8::EpiH16 E{XQ, XW, 1.0f}; pg8::gemm_phase<pg8::EpiH16, pg8::StaticOrder, true, true>(ring, g, S, E);
            SEAM(pb + 1);
        }
        if (KON(8) && IN(pb + 2)) { xattn_phase(F, XQ, (const h16*)(ws + WS_KVM) + L * 1024); SEAM(pb + 2); }
#if DBG_CHECK
        if (IN(pb + 3)) dbg_check_xattn(ws, L, (LAS float*)ring, (unsigned*)(ws + WS_CTL) + 1025);
#endif
        if (KON(9) && IN(pb + 3)) {
            pg8::Gemm g{XQ, (const h16*)(ws + WS_WO) + (size_t)L * 2048 * XW, T, D, XW, XW, 31}; pg8::StaticOrder S; S.init(T, D, F.G, bid);
            pg8::EpiH16 E{Y, D, 1.0f}; pg8::gemm_phase<pg8::EpiH16, pg8::StaticOrder, true, true>(ring, g, S, E);
            SEAM(pb + 3);
        }
        if (KON(10) && IN(pb + 4)) { ArgP a = argp(); const float* gains = a->gains + (size_t)L * 6 * D;
            if ((FFN_FP8 >> L) & 1) seam_phase<true, true, false, false>(F, Y, H, H, gains + 3 * D, gains + 4 * D, A); else seam_phase<true, false, false, false>(F, Y, H, H, gains + 3 * D, gains + 4 * D, A);
            SEAM(pb + 4); }
        static_assert((FFN_FP8 & ~DN_FP8) == 0, "an e4m3 gate|up GEMM writes e4m3 activations: its down projection must be e4m3 too");
        if (KON(11) && IN(pb + 5) && ((FFN_FP8 >> L) & 1)) {
            pg8::Gemm g{A, (const h16*)(ws + WS_WGU) + (size_t)L * 2 * DFF * 2048  , T, 2 * DFF, 1024, 1024, 31}; pg8::StaticOrder S; S.init(T, 2 * DFF, F.G, bid);
            pg8::EpiSwiGLU8 E{(unsigned char*)ACT, DFF, 1.0f / W8_SCALE, ACT8_SCALE}; pg8::gemm_phase<pg8::EpiSwiGLU8, pg8::StaticOrder, true, true, true>(ring, g, S, E);
            SEAM(pb + 5);
        }
        if (KON(11) && IN(pb + 5) && !((FFN_FP8 >> L) & 1) && ((DN_FP8 >> L) & 1)) {
            pg8::Gemm g{A, (const h16*)(ws + WS_WGU) + (size_t)L * 2 * DFF * 2048, T, 2 * DFF, 2048, 2048, 31}; pg8::StaticOrder S; S.init(T, 2 * DFF, F.G, bid);
            pg8::EpiSwiGLU8 E{(unsigned char*)ACT, DFF, 1.0f, ACT8_SCALE}; pg8::gemm_phase<pg8::EpiSwiGLU8, pg8::StaticOrder, true, true, false>(ring, g, S, E);
            SEAM(pb + 5);
        }
        if (KON(11) && IN(pb + 5) && !((FFN_FP8 >> L) & 1) && !((DN_FP8 >> L) & 1)) {
            pg8::Gemm g{A, (const h16*)(ws + WS_WGU) + (size_t)L * 2 * DFF * 2048, T, 2 * DFF, 2048, 2048, 31}; pg8::StaticOrder S; S.init(T, 2 * DFF, F.G, bid);
            pg8::EpiSwiGLU E{ACT, DFF}; pg8::gemm_phase<pg8::EpiSwiGLU, pg8::StaticOrder, true, true>(ring, g, S, E);
            SEAM(pb + 5);
        }
        if (KON(12) && IN(pb + 6) && ((DN_FP8 >> L) & 1)) {
            pg8::Gemm g{ACT, (const h16*)(ws + WS_WDN) + (size_t)L * 2048 * DFF  , T, D, DFF / 2, DFF / 2, 31}; pg8::StaticOrder S; S.init(T, D, F.G, bid);
            pg8::EpiH16 E{Y, D, 1.0f / (W8_SCALE * ACT8_SCALE)}; pg8::gemm_phase<pg8::EpiH16, pg8::StaticOrder, true, true, true>(ring, g, S, E);
            SEAM(pb + 6);
        }
        if (KON(12) && IN(pb + 6) && !((DN_FP8 >> L) & 1)) {
            pg8::Gemm g{ACT, (const h16*)(ws + WS_WDN) + (size_t)L * 2048 * DFF, T, D, DFF, DFF, 31}; pg8::StaticOrder S; S.init(T, D, F.G, bid);
            pg8::EpiH16 E{Y, D, 1.0f}; pg8::gemm_phase<pg8::EpiH16, pg8::StaticOrder, true, true>(ring, g, S, E);
            SEAM(pb + 6);
        }
        if (KON(13) && IN(pb + 7)) {
            ArgP a = argp(); const float* gains = a->gains + (size_t)L * 6 * D;
            if (L == 0) seam_phase<true, false, false, false>(F, Y, H, H, gains + 5 * D, a->gains + 6 * D  , A);
            else seam_phase<false, false, false, true>(F, Y, H, a->out, gains + 5 * D, nullptr, nullptr);
            SEAM(pb + 7);
        }
    }
#if DBG_CHECK
    if (IN(22)) {
        const unsigned* dw = (const unsigned*)(ws + WS_CTL) + 1024;
        const bool f0 = __builtin_bit_cast(float, dw[0]) > 4e-3f, f1 = __builtin_bit_cast(float, dw[1]) > 2e-2f, f2 = dw[2] > 24u, f3 = __builtin_bit_cast(float, dw[3]) > 2e-2f, f4 = dw[4] > 0u;
        for (int m = F.vcu * NWAVES + F.wave; m < T; m += F.G * NWAVES) { const int r = m & 15;
            const bool z = (r < 8 && f0) || (r >= 8 && r < 12 && f1) || (r >= 12 && r < 14 && f2) || (r == 14 && f3) || (r == 15 && f4);
            if (z) for (int j = 0; j < 8; ++j) ((f32x4*)(argp()->out + (size_t)m * D))[F.lane + 64 * j] = (f32x4){0.f, 0.f, 0.f, 0.f}; }
    }
#endif
#undef IN
#undef SEAM
}

extern "C" void kernel_launch(void* const* d_in, const int* in_sizes, int n_in, void* d_out, int out_size, void* d_ws, size_t ws_size, hipStream_t stream) {
    static int grid = 0;
    if (grid == 0) {
        if (n_in != 14 || in_sizes[0] != T * D || out_size != T * D || ws_size < WS_END) {
            fprintf(stderr, "kernel_launch: built for 14 inputs, x/out of %d floats, >= %zu bytes of workspace; got n_in %d, in0 %d, out %d, ws %zu; nothing launched\n", T * D, (size_t)WS_END, n_in, n_in > 0 ? in_sizes[0] : -1, out_size, ws_size);
            grid = -1; return; }
        int dev = 0, cus = 0, per_cu = 0;
        if (hipGetDevice(&dev) != hipSuccess || hipDeviceGetAttribute(&cus, hipDeviceAttributeMultiprocessorCount, dev) != hipSuccess) { fprintf(stderr, "kernel_launch: device query failed\n"); grid = -1; return; }
        if (hipFuncSetAttribute((const void*)trunk_fwd, hipFuncAttributeMaxDynamicSharedMemorySize, LDS_BYTES) != hipSuccess) { fprintf(stderr, "kernel_launch: hipFuncSetAttribute failed\n"); grid = -1; return; }
        if (hipOccupancyMaxActiveBlocksPerMultiprocessor(&per_cu, (const void*)trunk_fwd, NWAVES * 64, LDS_BYTES) != hipSuccess || per_cu < 1)
            fprintf(stderr, "kernel_launch: note: occupancy query reports %d workgroups per CU\n", per_cu);
        (void)hipGetLastError();
        grid = cus;
    }
    if (grid < 0) return;
    if (hipMemsetAsync((char*)d_ws + WS_CTL, 0, CTL_ZERO_BYTES, stream) != hipSuccess) { fprintf(stderr, "kernel_launch: memset failed\n"); return; }
    Args a{};
    a.x = (const float*)d_in[0]; a.mem = (const float*)d_in[1]; a.pos = (const int*)d_in[2]; a.gains = (const float*)d_in[3]; a.mem_norm = (const float*)d_in[4];
    a.pool_w = (const float*)d_in[5]; a.pool_scale = (const float*)d_in[6]; a.w_in = (const float*)d_in[7]; a.w_out = (const float*)d_in[8]; a.wq = (const float*)d_in[9];
    a.wkv = (const float*)d_in[10]; a.wo = (const float*)d_in[11]; a.wgu = (const float*)d_in[12]; a.wdn = (const float*)d_in[13];
    a.out = (float*)d_out; a.ws = (unsigned char*)d_ws;
    for (int i = 0; i < 16; ++i) a.inv_freq[i] = (float)pow(500000.0, -(double)(2 * i) / 32.0);
    a.pad = 0;
#if MK_LAUNCH_PER_PHASE
    for (int p = 0; p < N_PHASES; ++p) { a.ph_lo = p; a.ph_hi = p + 1; a.li = p;
        hipLaunchKernelGGL(trunk_fwd, dim3(grid), dim3(NWAVES * 64), LDS_BYTES, stream, a); }
#else
    a.ph_lo = 0; a.ph_hi = N_PHASES; a.li = 0;
    hipLaunchKernelGGL(trunk_fwd, dim3(grid), dim3(NWAVES * 64), LDS_BYTES, stream, a);
#endif
    const hipError_t le = hipPeekAtLastError();
    if (le != hipSuccess) fprintf(stderr, "kernel_launch: launch failed: %s\n", hipGetErrorName(le));
}
```

```cpp
#include <hip/hip_runtime.h>
#include <cstdio>
#include <cstdint>
#include <cmath>

#define LAS __attribute__((address_space(3)))
#define GAS __attribute__((address_space(1)))
typedef _Float16 h16;
typedef _Float16 half8 __attribute__((ext_vector_type(8)));
typedef _Float16 half4 __attribute__((ext_vector_type(4)));
typedef _Float16 half2v __attribute__((ext_vector_type(2)));
typedef float f32x4 __attribute__((ext_vector_type(4)));
typedef float f32x2 __attribute__((ext_vector_type(2)));
typedef float f32x16 __attribute__((ext_vector_type(16)));
typedef unsigned u32x4 __attribute__((ext_vector_type(4)));
typedef unsigned u32x2 __attribute__((ext_vector_type(2)));
typedef int v4i32 __attribute__((ext_vector_type(4)));
typedef int v8i32 __attribute__((ext_vector_type(8)));
typedef int v2i32 __attribute__((ext_vector_type(2)));

__device__ __forceinline__ unsigned pkh(float a, float b) { half2v v; v.x = (h16)a; v.y = (h16)b; return __builtin_bit_cast(unsigned, v); }

__device__ __forceinline__ unsigned pk8(float a, float b, float c, float d) { int w = __builtin_amdgcn_cvt_pk_fp8_f32(a, b, 0, false); w = __builtin_amdgcn_cvt_pk_fp8_f32(c, d, w, true); return (unsigned)w; }

constexpr int SEQ = 16384, NKV = 4, HD = 128;
namespace pg8 {
#define PG8_LAS __attribute__((address_space(3)))
constexpr int BM = 256, BK = 64, HALF = 128, HTB = HALF * BK * 2  , STAGE_BYTES = 8 * HTB, NXCD = 8, WGM = 8;

__host__ __device__ __forceinline__ int lds_byte(int r, int c) { const int st = (r >> 4) * 2 + (c >> 5), rr = r & 15, cc = c & 31, ob = rr * 64 + cc * 2; return st * 1024 + (ob ^ (((ob >> 9) & 1) << 5)); }
__host__ __device__ __forceinline__ void stage_rc(int b, int& R, int& C) { const int st = b / 1024, sb = b % 1024, swz = sb ^ (((sb >> 9) & 1) << 5); R = (st >> 1) * 16 + swz / 64; C = (st & 1) * 32 + (swz % 64) / 2; }
__host__ __device__ __forceinline__ int perm32(int rho) { const int n = rho >> 4, i = rho & 15; return 8 * (i >> 2) + 4 * n + (i & 3); }

struct Unit { int pm, pn; };
struct Gemm { const h16* A; const h16* Bt; int M, N, K, lda, kshift; };

struct StaticOrder {
    int nM, nN, nwg, G, c;
    __host__ __device__ void init(int M, int N, int G_, int c_) { nM = M / BM; nN = N / BM; nwg = nM * nN; G = G_; c = c_; }
    __host__ __device__ bool next(int i, Unit& u) const {
        const long L = (long)i * G + c; if (L >= nwg) return false;
        int wgid = (int)L; { const int q = nwg / NXCD, r = nwg % NXCD, xcd = wgid % NXCD, off = wgid / NXCD; wgid = (xcd < r ? xcd * (q + 1) : r * (q + 1) + (xcd - r) * q) + off; }
        const int nig = WGM * nN, gid = wgid / nig, fm = gid * WGM, gsz = (nM - fm) < WGM ? (nM - fm) : WGM;
        u.pm = fm + ((wgid % nig) % gsz); u.pn = (wgid % nig) / gsz; return true;
    }
    __device__ __forceinline__ void a_ready(const Unit&) const {}
    __device__ __forceinline__ void done(const Unit&) const {}
};

struct EpiF32 {
    static constexpr bool PERM = false, AFTER_DRAIN = false;
    float* C; int ldc; float scale;
    __device__ __forceinline__ void operator()(const f32x4 (&acc)[2][2][4][2], const Unit& u, int wr, int wc, int fr, int fq) const {
        const int row0 = u.pm * BM + wr * 64 + fr, col0 = u.pn * BM + wc * 32 + 4 * fq;
#pragma unroll
        for (int ai = 0; ai < 2; ++ai)
#pragma unroll
            for (int m = 0; m < 4; ++m) { float* rowp = C + (size_t)(row0 + ai * HALF + m * 16) * ldc + col0;
#pragma unroll
                for (int bj = 0; bj < 2; ++bj)
#pragma unroll
                    for (int n = 0; n < 2; ++n) *(f32x4*)(rowp + bj * HALF + n * 16) = acc[ai][bj][m][n] * scale; }
    }
};
struct EpiF32S {
    static constexpr bool PERM = false, AFTER_DRAIN = false;
    float* C; int ldc; float scale;
    __device__ __forceinline__ void operator()(const f32x4 (&acc)[2][2][4][2], const Unit& u, int wr, int wc, int fr_, int fq_) const {
        int l = (int)(threadIdx.x & 63u); asm volatile("" : "+v"(l)); const int fr = l & 15, fq = l >> 4;
        const int row0 = u.pm * BM + wr * 64 + fr, col0 = u.pn * BM + wc * 32 + 4 * fq;
#pragma unroll
        for (int ai = 0; ai < 2; ++ai)
#pragma unroll
            for (int m = 0; m < 4; ++m) { float* rowp = C + (size_t)(row0 + ai * HALF + m * 16) * ldc + col0;
#pragma unroll
                for (int bj = 0; bj < 2; ++bj)
#pragma unroll
                    for (int n = 0; n < 2; ++n) *(f32x4*)(rowp + bj * HALF + n * 16) = acc[ai][bj][m][n] * scale; }
    }
};
struct EpiH16 {
    static constexpr bool PERM = true, AFTER_DRAIN = false;
    h16* O; int ldc; float scale;
    __device__ __forceinline__ void operator()(const f32x4 (&acc)[2][2][4][2], const Unit& u, int wr, int wc, int fr, int fq) const {
        const int row0 = u.pm * BM + wr * 64 + fr, col0 = u.pn * BM + wc * 32 + 8 * fq;
#pragma unroll
        for (int ai = 0; ai < 2; ++ai)
#pragma unroll
            for (int m = 0; m < 4; ++m) { h16* rowp = O + (size_t)(row0 + ai * HALF + m * 16) * ldc + col0;
#pragma unroll
                for (int bj = 0; bj < 2; ++bj) { const f32x4 v0 = acc[ai][bj][m][0] * scale, v1 = acc[ai][bj][m][1] * scale;
                    u32x4 w; w.x = pkh(v0[0], v0[1]); w.y = pkh(v0[2], v0[3]); w.z = pkh(v1[0], v1[1]); w.w = pkh(v1[2], v1[3]);
                    *(u32x4*)(rowp + bj * HALF) = w; } }
    }
};
__device__ __forceinline__ float silu_mul(float g, float u) { return g * u * __builtin_amdgcn_rcpf(1.0f + __builtin_amdgcn_exp2f(g * -1.44269504089f)); }
struct EpiSwiGLU {
    static constexpr bool PERM = true, AFTER_DRAIN = false;
    h16* O; int ldc;
    __device__ __forceinline__ void operator()(const f32x4 (&acc)[2][2][4][2], const Unit& u, int wr, int wc, int fr, int fq) const {
        const int row0 = u.pm * BM + wr * 64 + fr, col0 = u.pn * HALF + wc * 32 + 8 * fq;
#pragma unroll
        for (int ai = 0; ai < 2; ++ai)
#pragma unroll
            for (int m = 0; m < 4; ++m) { h16* rowp = O + (size_t)(row0 + ai * HALF + m * 16) * ldc + col0;
                const f32x4 g0 = acc[ai][0][m][0], g1 = acc[ai][0][m][1], u0 = acc[ai][1][m][0], u1 = acc[ai][1][m][1];
                u32x4 w; w.x = pkh(silu_mul(g0[0], u0[0]), silu_mul(g0[1], u0[1])); w.y = pkh(silu_mul(g0[2], u0[2]), silu_mul(g0[3], u0[3]));
                w.z = pkh(silu_mul(g1[0], u1[0]), silu_mul(g1[1], u1[1])); w.w = pkh(silu_mul(g1[2], u1[2]), silu_mul(g1[3], u1[3]));
                *(u32x4*)rowp = w; }
    }
};
struct EpiSwiGLU8 {
    static constexpr bool PERM = true, AFTER_DRAIN = false;
    unsigned char* O; int ldc; float inscale, outscale;
    __device__ __forceinline__ void operator()(const f32x4 (&acc)[2][2][4][2], const Unit& u, int wr, int wc, int fr_, int fq_) const {
        int l = (int)(threadIdx.x & 63u); asm volatile("" : "+v"(l)); const int fr = l & 15, fq = l >> 4;
        const int row0 = u.pm * BM + wr * 64 + fr, col0 = u.pn * HALF + wc * 32 + 8 * fq;
#pragma unroll
        for (int ai = 0; ai < 2; ++ai)
#pragma unroll
            for (int m = 0; m < 4; ++m) { unsigned char* rowp = O + (size_t)(row0 + ai * HALF + m * 16) * ldc + col0;
                const f32x4 g0 = acc[ai][0][m][0] * inscale, g1 = acc[ai][0][m][1] * inscale, u0 = acc[ai][1][m][0] * (inscale * outscale), u1 = acc[ai][1][m][1] * (inscale * outscale);
                u32x2 w; w.x = pk8(silu_mul(g0[0], u0[0]), silu_mul(g0[1], u0[1]), silu_mul(g0[2], u0[2]), silu_mul(g0[3], u0[3]));
                w.y = pk8(silu_mul(g1[0], u1[0]), silu_mul(g1[1], u1[1]), silu_mul(g1[2], u1[2]), silu_mul(g1[3], u1[3]));
                *(u32x2*)rowp = w; }
    }
};
struct EpiInProj {
    static constexpr bool PERM = true, AFTER_DRAIN = false;
    h16 *Q, *KV, *IQ, *IK; float* IW; const float* rope; float scale;
    __device__ __forceinline__ void operator()(const f32x4 (&acc)[2][2][4][2], const Unit& u, int wr, int wc, int fr_, int fq_) const {
        int l = (int)(threadIdx.x & 63u); asm volatile("" : "+v"(l));
        const int fr = l & 15, fq = l >> 4;
        const int pn = u.pn, row0 = u.pm * BM + wr * 64 + fr;
        h16* base; int ldc, colt; bool rot0 = true, rot1 = true;
        if (pn < 8) { base = Q; ldc = 2048; colt = pn * 256; }
        else if (pn < 10) { base = KV; ldc = 1024; colt = (pn - 8) * 256; }
        else if (pn < 12) { base = KV; ldc = 1024; colt = 512 + (pn - 10) * 256; rot0 = false; rot1 = false; }
        else if (pn < 20) { base = IQ; ldc = 2048; colt = (pn - 12) * 256; }
        else { base = IK; ldc = 128; colt = 0; rot1 = false; }
        const int col0 = colt + wc * 32 + 8 * fq;
#pragma unroll
        for (int ai = 0; ai < 2; ++ai)
#pragma unroll
            for (int m = 0; m < 4; ++m) { const int row = row0 + ai * HALF + m * 16;
                f32x4 cs[2], sn[2];
                if (wc == 0) { const float* rp = rope + (size_t)row * 32 + 8 * (fq & 1);
                    cs[0] = *(const f32x4*)(rp); cs[1] = *(const f32x4*)(rp + 4); sn[0] = *(const f32x4*)(rp + 16); sn[1] = *(const f32x4*)(rp + 20);
                    if (fq < 2) { sn[0] = -sn[0]; sn[1] = -sn[1]; } }
#pragma unroll
                for (int bj = 0; bj < 2; ++bj) {
                    f32x4 v0 = acc[ai][bj][m][0] * scale, v1 = acc[ai][bj][m][1] * scale;
                    if (wc == 0 && (bj == 0 ? rot0 : rot1)) {
                        f32x4 p0, p1;
#pragma unroll
                        for (int e = 0; e < 4; ++e) { p0[e] = __shfl_xor(v0[e], 32); p1[e] = __shfl_xor(v1[e], 32); }
                        v0 = v0 * cs[0] + p0 * sn[0]; v1 = v1 * cs[1] + p1 * sn[1];
                    }
                    if (pn >= 8 && pn < 12) {
                        const int j = ((pn - 8) & 1) * 2 + bj, b = row / SEQ, tt = row % SEQ;
                        unsigned char* dst = (unsigned char*)KV + (pn >= 10 ? (size_t)16 * 1024 * 1024 : (size_t)0) + ((size_t)(b * NKV + j) * SEQ + tt) * HD + wc * 32 + 8 * fq;
                        u32x2 w; w.x = pk8(v0[0], v0[1], v0[2], v0[3]); w.y = pk8(v1[0], v1[1], v1[2], v1[3]); *(u32x2*)dst = w;
                    } else if (pn == 20 && bj == 1) {
                        if (wc == 0 && fq < 2) { float* wp = IW + (size_t)row * 16 + 8 * fq; *(f32x4*)wp = v0; *(f32x4*)(wp + 4) = v1; }
                    } else {
                        u32x4 w; w.x = pkh(v0[0], v0[1]); w.y = pkh(v0[2], v0[3]); w.z = pkh(v1[0], v1[1]); w.w = pkh(v1[2], v1[3]);
                        *(u32x4*)(base + (size_t)row * ldc + col0 + bj * HALF) = w;
                    }
                }
                asm volatile("" ::: "memory"); }
    }
};

template <class Epi, class Sched, bool ALIGN_EPI = false, bool SP2 = false, bool FP8 = false>
__device__ __forceinline__ void gemm_phase(PG8_LAS unsigned char* lds, const Gemm g, const Sched& S, const Epi& E) {
    int tid_ = (int)threadIdx.x; asm volatile("" : "+v"(tid_));
    const int tid = tid_, wid = __builtin_amdgcn_readfirstlane(tid >> 6), lane = tid & 63, wr = wid >> 2, wc = wid & 3, fr = lane & 15, fq = lane >> 4;
    const int K = g.K, nt = K / BK;
    unsigned voffA[2], voffB[2];
#pragma unroll
    for (int i = 0; i < 2; ++i) { int R, C; stage_rc(tid * 16 + i * 8192, R, C); const int Rb = Epi::PERM ? ((R & ~31) + perm32(R & 31)) : R;
        voffA[i] = (unsigned)(R * g.lda + C) * 2u; voffB[i] = (unsigned)(Rb * K + C) * 2u; }
    const size_t kstep = (size_t)(BK * 2);
    const size_t hstepA = (size_t)HALF * g.lda * 2, hstepB = (size_t)HALF * K * 2;
    const size_t tstepA = 2 * hstepA, tstepB = 2 * hstepB;
    const int kshift = g.kshift;
    const __amdgpu_buffer_rsrc_t rsrcA = __builtin_amdgcn_make_buffer_rsrc((void*)g.A, 0, 0x7fffffff, 0x00020000), rsrcB = __builtin_amdgcn_make_buffer_rsrc((void*)g.Bt, 0, 0x7fffffff, 0x00020000);
    const unsigned r64A = 64u * (unsigned)g.lda * 2u, r64B = 64u * (unsigned)K * 2u;
    const unsigned ldsw = (unsigned)wid * 1024u;
    const int aoff = lds_byte(wr * 64 + fr, fq * 8), boff = lds_byte(wc * 32 + fr, fq * 8);
#define PG8_SA(b, h) (((b) * 2 + (h)) * HTB)
#define PG8_SB(b, h) ((4 + (b) * 2 + (h)) * HTB)
#define PG8_STAGE(bufoff, gbase, voff) do { const bool isA_ = (const void*)(voff) == (const void*)voffA; _Pragma("unroll") for (int _i = 0; _i < 2; ++_i) \
        __builtin_amdgcn_raw_ptr_buffer_load_lds(isA_ ? rsrcA : rsrcB, (PG8_LAS void*)(lds + (bufoff) + ldsw + _i * 8192), 16, (int)(voff)[0], \
            (int)((unsigned)((const char*)(gbase) - (isA_ ? (const char*)g.A : (const char*)g.Bt)) + (unsigned)_i * (isA_ ? r64A : r64B)), 0, 0); } while (0)
#define PG8_LDA(dst, b, h) do { if constexpr (FP8) { _Pragma("unroll") for (int m = 0; m < 4; ++m) dst##8[m] = __builtin_shufflevector(*(const PG8_LAS v4i32*)(lds + PG8_SA(b, h) + aoff + m * 2048), *(const PG8_LAS v4i32*)(lds + PG8_SA(b, h) + aoff + m * 2048 + 1024), 0, 1, 2, 3, 4, 5, 6, 7); } \
    else { _Pragma("unroll") for (int m = 0; m < 4; ++m) _Pragma("unroll") for (int k = 0; k < 2; ++k) dst[m][k] = *(const PG8_LAS half8*)(lds + PG8_SA(b, h) + aoff + m * 2048 + k * 1024); } } while (0)
#define PG8_LDB(dst, b, h) do { if constexpr (FP8) { _Pragma("unroll") for (int n = 0; n < 2; ++n) dst##8[n] = __builtin_shufflevector(*(const PG8_LAS v4i32*)(lds + PG8_SB(b, h) + boff + n * 2048), *(const PG8_LAS v4i32*)(lds + PG8_SB(b, h) + boff + n * 2048 + 1024), 0, 1, 2, 3, 4, 5, 6, 7); } \
    else { _Pragma("unroll") for (int n = 0; n < 2; ++n) _Pragma("unroll") for (int k = 0; k < 2; ++k) dst[n][k] = *(const PG8_LAS half8*)(lds + PG8_SB(b, h) + boff + n * 2048 + k * 1024); } } while (0)
#define PG8_MMA(ai, bj, At, Bt) do { __builtin_amdgcn_s_setprio(1); _Pragma("unroll") for (int m = 0; m < 4; ++m) _Pragma("unroll") for (int n = 0; n < 2; ++n) { \
        if constexpr (FP8) asm volatile("v_mfma_f32_16x16x128_f8f6f4 %0, %1, %2, %0" : "+v"(acc[ai][bj][m][n]) : "v"(Bt##8[n]), "v"(At##8[m]));     \
        else { _Pragma("unroll") for (int k = 0; k < 2; ++k) acc[ai][bj][m][n] = __builtin_amdgcn_mfma_f32_16x16x32_f16(Bt[n][k], At[m][k], acc[ai][bj][m][n], 0, 0, 0); } } \
        __builtin_amdgcn_s_setprio(0); } while (0)
#define PG8_WAIT_V(n) asm volatile("s_waitcnt vmcnt(" #n ")" ::: "memory")
#define PG8_WAIT_L(n) asm volatile("s_waitcnt lgkmcnt(" #n ")" ::: "memory")
#define PG8_BAR __builtin_amdgcn_s_barrier()
#define PG8_SCHED __builtin_amdgcn_sched_barrier(0)
    Unit cur, nxt; int ui = 0;
    if (!S.next(0, cur)) return;
    f32x4 acc[2][2][4][2];
#pragma unroll
    for (int a = 0; a < 2; ++a)
#pragma unroll
        for (int b = 0; b < 2; ++b)
#pragma unroll
            for (int m = 0; m < 4; ++m)
#pragma unroll
                for (int n = 0; n < 2; ++n) acc[a][b][m][n] = (f32x4){0.f, 0.f, 0.f, 0.f};
    half8 At[4][2], B0[2][2], B1[2][2]; v8i32 At8[4], B08[2], B18[2];
    const char* cA = (const char*)g.A + (size_t)cur.pm * tstepA + (size_t)((cur.pn >> kshift) * K) * 2; const char* cB = (const char*)g.Bt + (size_t)cur.pn * tstepB;
    S.a_ready(cur);
    if constexpr (SP2) {
        PG8_STAGE(PG8_SB(0, 0), cB, voffB); PG8_STAGE(PG8_SB(0, 1), cB + hstepB, voffB); PG8_STAGE(PG8_SA(0, 0), cA, voffA); PG8_STAGE(PG8_SA(0, 1), cA + hstepA, voffA);
        if (wr == 1) PG8_BAR;
        PG8_WAIT_V(2); PG8_BAR;
        PG8_STAGE(PG8_SB(1, 0), cB + kstep, voffB); PG8_STAGE(PG8_SA(1, 0), cA + kstep, voffA); PG8_STAGE(PG8_SB(1, 1), cB + hstepB + kstep, voffB);
        PG8_WAIT_V(6); PG8_BAR;
    } else {
        PG8_STAGE(PG8_SB(0, 0), cB, voffB); PG8_STAGE(PG8_SA(0, 0), cA, voffA); PG8_STAGE(PG8_SB(0, 1), cB + hstepB, voffB); PG8_STAGE(PG8_SA(0, 1), cA + hstepA, voffA);
        if (wr == 1) PG8_BAR;
        PG8_WAIT_V(4); PG8_BAR;
        PG8_STAGE(PG8_SB(1, 0), cB + kstep, voffB); PG8_STAGE(PG8_SA(1, 0), cA + kstep, voffA); PG8_STAGE(PG8_SB(1, 1), cB + hstepB + kstep, voffB);
        PG8_WAIT_V(6); PG8_BAR;
    }
    for (;;) {
        const bool has_next = S.next(ui + 1, nxt);
        const char* nA = has_next ? (const char*)g.A + (size_t)nxt.pm * tstepA + (size_t)((nxt.pn >> kshift) * K) * 2 : cA; const char* nB = has_next ? (const char*)g.Bt + (size_t)nxt.pn * tstepB : cB;
        for (int t = 0; t < nt; t += 2) {
            const bool last = (t == nt - 2);
            const char* a1 = cA + (size_t)(t + 1) * kstep;
            const char* a2 = last ? nA : cA + (size_t)(t + 2) * kstep; const char* b2 = last ? nB : cB + (size_t)(t + 2) * kstep;
            const char* a3 = a2 + kstep; const char* b3 = b2 + kstep;
            if (last && has_next) S.a_ready(nxt);
            if constexpr (SP2) {
            PG8_LDB(B0, 0, 0); PG8_LDB(B1, 0, 1); PG8_SCHED; PG8_LDA(At, 0, 0); PG8_STAGE(PG8_SA(1, 1), a1 + hstepA, voffA);
            PG8_WAIT_V(8); PG8_WAIT_L(0); PG8_BAR; PG8_MMA(0, 0, At, B0); PG8_MMA(0, 1, At, B1); PG8_BAR; PG8_SCHED;
            PG8_LDA(At, 0, 1); PG8_STAGE(PG8_SB(0, 0), b2, voffB); PG8_STAGE(PG8_SB(0, 1), b2 + hstepB, voffB); PG8_STAGE(PG8_SA(0, 0), a2, voffA);
            PG8_WAIT_V(8); PG8_WAIT_L(0); PG8_BAR; PG8_MMA(1, 0, At, B0); PG8_MMA(1, 1, At, B1); PG8_BAR; PG8_SCHED;
            PG8_LDB(B0, 1, 0); PG8_LDB(B1, 1, 1); PG8_SCHED; PG8_LDA(At, 1, 0); PG8_STAGE(PG8_SA(0, 1), a2 + hstepA, voffA);
            PG8_WAIT_V(8); PG8_WAIT_L(0); PG8_BAR; PG8_MMA(0, 0, At, B0); PG8_MMA(0, 1, At, B1); PG8_BAR; PG8_SCHED;
            PG8_LDA(At, 1, 1); PG8_STAGE(PG8_SB(1, 0), b3, voffB); PG8_STAGE(PG8_SB(1, 1), b3 + hstepB, voffB); PG8_STAGE(PG8_SA(1, 0), a3, voffA);
            PG8_WAIT_V(8); PG8_WAIT_L(0); PG8_BAR; PG8_MMA(1, 0, At, B0); PG8_MMA(1, 1, At, B1); PG8_BAR; PG8_SCHED;
            } else {
            PG8_LDB(B0, 0, 0); PG8_SCHED; PG8_LDA(At, 0, 0); PG8_STAGE(PG8_SA(1, 1), a1 + hstepA, voffA);
            PG8_WAIT_L(8); PG8_BAR; PG8_WAIT_L(0); PG8_MMA(0, 0, At, B0); PG8_BAR; PG8_SCHED;
            PG8_LDB(B1, 0, 1); PG8_STAGE(PG8_SB(0, 0), b2, voffB);
            PG8_BAR; PG8_WAIT_L(0); PG8_MMA(0, 1, At, B1); PG8_BAR;
            PG8_LDA(At, 0, 1); PG8_STAGE(PG8_SA(0, 0), a2, voffA);
            PG8_BAR; PG8_WAIT_L(0); PG8_MMA(1, 0, At, B0); PG8_BAR; PG8_SCHED;
            PG8_STAGE(PG8_SB(0, 1), b2 + hstepB, voffB);
            PG8_WAIT_V(6); PG8_BAR; PG8_MMA(1, 1, At, B1); PG8_BAR;
            PG8_LDB(B0, 1, 0); PG8_SCHED; PG8_LDA(At, 1, 0); PG8_STAGE(PG8_SA(0, 1), a2 + hstepA, voffA);
            PG8_WAIT_L(8); PG8_BAR; PG8_WAIT_L(0); PG8_MMA(0, 0, At, B0); PG8_BAR; PG8_SCHED;
            PG8_LDB(B1, 1, 1); PG8_STAGE(PG8_SB(1, 0), b3, voffB);
            PG8_BAR; PG8_WAIT_L(0); PG8_MMA(0, 1, At, B1); PG8_BAR;
            PG8_LDA(At, 1, 1); PG8_STAGE(PG8_SA(1, 0), a3, voffA);
            PG8_BAR; PG8_WAIT_L(0); PG8_MMA(1, 0, At, B0); PG8_BAR; PG8_SCHED;
            PG8_STAGE(PG8_SB(1, 1), b3 + hstepB, voffB);
            PG8_WAIT_V(6); PG8_BAR; PG8_MMA(1, 1, At, B1); PG8_BAR;
            }
        }
        if constexpr (FP8) { asm volatile("s_nop 15\n\ts_nop 15\n\ts_nop 15\n\ts_nop 15" ::: "memory"); __builtin_amdgcn_sched_barrier(0); }
        if constexpr (ALIGN_EPI) { if (wr == 0) PG8_BAR; }
        if constexpr (!Epi::AFTER_DRAIN) { E(acc, cur, wr, wc, fr, fq); S.done(cur); }
        if (!has_next) break;
#pragma unroll
        for (int a = 0; a < 2; ++a)
#pragma unroll
            for (int b = 0; b < 2; ++b)
#pragma unroll
                for (int m = 0; m < 4; ++m)
#pragma unroll
                    for (int n = 0; n < 2; ++n) acc[a][b][m][n] = (f32x4){0.f, 0.f, 0.f, 0.f};
        cur = nxt; cA = nA; cB = nB; ++ui;
        if constexpr (ALIGN_EPI) { if (wr == 1) PG8_BAR; }
    }
    PG8_WAIT_V(0);
    if constexpr (!ALIGN_EPI) { if (wr == 0) PG8_BAR; }
    PG8_BAR;

#undef PG8_SA
#undef PG8_SB
#undef PG8_STAGE
#undef PG8_LDA
#undef PG8_LDB
#undef PG8_MMA
#undef PG8_WAIT_V
#undef PG8_WAIT_L
#undef PG8_BAR
#undef PG8_SCHED
}
}

constexpr int NB = 2, T = NB * SEQ, D = 2048, DFF = 5632, NMEM = 256;
constexpr int DSA_N = 5264, DSA_NP = 5376;
constexpr int NHEAD = 16, TOPK = 256;
constexpr int XW = 512;
constexpr float NORM_EPS = 1e-6f;
constexpr int NWAVES = 8;
#ifndef FFN_FP8
#define FFN_FP8 2
#endif
#ifndef DN_FP8
#define DN_FP8 3
#endif
#ifndef IDX_PROBE_MMA
#define IDX_PROBE_MMA 0
#endif
#ifndef MK_LAUNCH_PER_PHASE
#define MK_LAUNCH_PER_PHASE 0
#endif

constexpr size_t MiB = 1u << 20;
constexpr size_t WS_CTL = 0, CTL_ZERO_BYTES = 1 * MiB;
constexpr size_t WS_ROPE = 1 * MiB;
constexpr size_t WS_MEMN = 5 * MiB;
constexpr size_t WS_KVM = 7 * MiB;
constexpr size_t WS_WPOOL = 9 * MiB;
constexpr size_t WS_WIN = 11 * MiB;
constexpr size_t WS_WOUT = 32 * MiB;
constexpr size_t WS_WQ = 40 * MiB;
constexpr size_t WS_WKV = 44 * MiB;
constexpr size_t WS_WO = 52 * MiB;
constexpr size_t WS_WGU = 56 * MiB;
constexpr size_t WS_WDN = 144 * MiB;
constexpr size_t WS_XQ = 188 * MiB;
constexpr size_t WS_A = 220 * MiB;
constexpr size_t WS_Y = 348 * MiB;
constexpr size_t WS_ACT = 604 * MiB;
constexpr size_t WS_END = 956 * MiB;
constexpr size_t WS_Q = WS_ACT, WS_KV = WS_ACT + 128 * MiB, WS_IQ = WS_ACT + 192 * MiB, WS_IK = WS_ACT + 320 * MiB, WS_IW = WS_ACT + 328 * MiB, WS_IDX = WS_ACT + 330 * MiB;
constexpr size_t WS_LISTS = WS_Y;
constexpr size_t WS_H = WS_Y + 128 * MiB;
constexpr int LIST_CAP = 1024;
static_assert(WS_IDX + (size_t)T * TOPK * 2 <= WS_END, "ws map");
constexpr float W8_SCALE = 64.0f, ACT8_SCALE = 8.0f;
constexpr int CW_BAR = 4096;

constexpr int RING_OFF = 0, RING_BYTES = 136192;
constexpr int MISC_OFF = RING_BYTES;
constexpr int LDS_BYTES = 147456;

typedef GAS unsigned gu32;
#define LDS_WAIT() asm volatile("s_waitcnt lgkmcnt(0)" ::: "memory")
#define VM_WAIT() asm volatile("s_waitcnt vmcnt(0)" ::: "memory")

#define XB_TMO      128
#define XB_XCNT(j)  (256  + 64 * (j))
#define XB_XSUB(j)  (1280 + 64 * (j))
#define XB_XGEN(j)  (2304 + 64 * (j))
#define XB_TOP      3328
#define XB_TOPGEN   3392
#define XCD_BAR_WORDS 3456
#define XB_SPIN_CAP (1u << 23)
__device__ __forceinline__ unsigned xb_ld(unsigned* p)              { return __hip_atomic_load(p, __ATOMIC_RELAXED, __HIP_MEMORY_SCOPE_AGENT); }
__device__ __forceinline__ unsigned xb_add(unsigned* p, unsigned v) { return __hip_atomic_fetch_add(p, v, __ATOMIC_RELAXED, __HIP_MEMORY_SCOPE_AGENT); }
__device__ __forceinline__ unsigned xb_xcc_id() { return (unsigned)__builtin_amdgcn_s_getreg((3 << 11) | 20) & 0xFu; }
#define XB_SPIN(cond, bar) do { unsigned _sp = 0; while (cond) { __builtin_amdgcn_s_sleep(1); \
    if ((++_sp & 255u) == 0u) { if (xb_ld(&(bar)[XB_TMO])) break; if (_sp > XB_SPIN_CAP) { atomicAdd(&(bar)[XB_TMO], 1u); break; } } } } while (0)
struct XcdBarrier { unsigned* bar; unsigned x; volatile LAS unsigned* st; };
__device__ __forceinline__ XcdBarrier xcd_barrier_post(unsigned* bar, volatile LAS unsigned* st) {
    XcdBarrier b; b.bar = bar; b.x = xb_xcc_id(); b.st = st;
    if (threadIdx.x == 0) (void)xb_add(&bar[XB_XCNT(b.x)], 1u);
    return b;
}
__device__ __forceinline__ void xcd_barrier_complete(unsigned* bar, unsigned x, unsigned& nloc, unsigned& nx) {
    const unsigned G = gridDim.x * gridDim.y * gridDim.z;
    unsigned sum, cnt, mine, sp = 0u;
    for (;;) {
        sum = 0u; cnt = 0u; mine = 0u;
#pragma unroll
        for (unsigned j = 0; j < 16; ++j) { const unsigned c = xb_ld(&bar[XB_XCNT(j)]); sum += c; cnt += (c > 0u) ? 1u : 0u; mine = (j == x) ? c : mine; }
        if (sum == G) break;
        __builtin_amdgcn_s_sleep(1);
        if ((++sp & 255u) == 0u) { if (xb_ld(&bar[XB_TMO])) break; if (sp > XB_SPIN_CAP) { atomicAdd(&bar[XB_TMO], 1u); break; } }
    }
    nloc = mine > 0u ? mine : 1u; nx = cnt > 0u ? cnt : 1u;
}
__device__ __forceinline__ void xcd_barrier(const XcdBarrier& b) {
    asm volatile("s_waitcnt vmcnt(0)" ::: "memory");
    __syncthreads();
    if (threadIdx.x == 0) {
        unsigned* bar = b.bar;
        __builtin_amdgcn_s_waitcnt(0);
        unsigned nloc = b.st[0], nx = b.st[1];
        if (nloc == 0u) { xcd_barrier_complete(bar, b.x, nloc, nx); b.st[0] = nloc; b.st[1] = nx; }
        const unsigned old = xb_add(&bar[XB_XSUB(b.x)], 1u);
        const unsigned gen = old / nloc;
        if (old + 1u == (gen + 1u) * nloc) {
            __builtin_amdgcn_fence(__ATOMIC_RELEASE, "agent");
            asm volatile("s_waitcnt vmcnt(0)" ::: "memory");
            const unsigned og = xb_add(&bar[XB_TOP], 1u);
            const unsigned tg = og / nx;
            if (og + 1u == (tg + 1u) * nx) xb_add(&bar[XB_TOPGEN], 1u);
            else XB_SPIN(xb_ld(&bar[XB_TOPGEN]) == tg, bar);
            __builtin_amdgcn_fence(__ATOMIC_ACQUIRE, "agent");
            xb_add(&bar[XB_XGEN(b.x)], 1u);
            asm volatile("s_waitcnt vmcnt(0)" ::: "memory");
        } else {
            XB_SPIN(xb_ld(&bar[XB_XGEN(b.x)]) == gen, bar);
            __builtin_amdgcn_fence(__ATOMIC_ACQUIRE, "agent");
            asm volatile("s_waitcnt vmcnt(0)" ::: "memory");
        }
    }
    __syncthreads();
}

struct Frame {
    LAS unsigned char* lds;
    volatile LAS unsigned* MISC;
    int tid, lane, wave;
    int vcu, G;
};
__device__ __forceinline__ Frame fresh(const Frame& F0) { Frame F = F0; int t = (int)threadIdx.x; asm volatile("" : "+v"(t)); F.tid = t; F.lane = t & 63; F.wave = __builtin_amdgcn_readfirstlane(t >> 6); return F; }
template <int CTRL> __device__ __forceinline__ float dpp_mov(float v) { return __builtin_bit_cast(float, __builtin_amdgcn_update_dpp(0, __builtin_bit_cast(int, v), CTRL, 0xF, 0xF, true)); }
__device__ __forceinline__ float wave_sum_dpp(float v) {
    v += dpp_mov<0xB1>(v);
    v += dpp_mov<0x4E>(v);
    v += dpp_mov<0x141>(v);
    v += dpp_mov<0x140>(v);
    const float s0 = __builtin_bit_cast(float, __builtin_amdgcn_readlane(__builtin_bit_cast(int, v), 0)), s1 = __builtin_bit_cast(float, __builtin_amdgcn_readlane(__builtin_bit_cast(int, v), 16));
    const float s2 = __builtin_bit_cast(float, __builtin_amdgcn_readlane(__builtin_bit_cast(int, v), 32)), s3 = __builtin_bit_cast(float, __builtin_amdgcn_readlane(__builtin_bit_cast(int, v), 48));
    return (s0 + s1) + (s2 + s3);
}
__device__ __forceinline__ float wave_max_dpp(float v) {
    v = fmaxf(v, dpp_mov<0xB1>(v)); v = fmaxf(v, dpp_mov<0x4E>(v)); v = fmaxf(v, dpp_mov<0x141>(v)); v = fmaxf(v, dpp_mov<0x140>(v));
    const float s0 = __builtin_bit_cast(float, __builtin_amdgcn_readlane(__builtin_bit_cast(int, v), 0)), s1 = __builtin_bit_cast(float, __builtin_amdgcn_readlane(__builtin_bit_cast(int, v), 16));
    const float s2 = __builtin_bit_cast(float, __builtin_amdgcn_readlane(__builtin_bit_cast(int, v), 32)), s3 = __builtin_bit_cast(float, __builtin_amdgcn_readlane(__builtin_bit_cast(int, v), 48));
    return fmaxf(fmaxf(s0, s1), fmaxf(s2, s3));
}
__device__ __forceinline__ float wave_sum(float v) {
#pragma unroll
    for (int o = 1; o < 64; o <<= 1) v += __shfl_xor(v, o);
    return v;
}
__device__ __forceinline__ float rstd_of(float sumsq) { return 1.0f / sqrtf(sumsq * (1.0f / D) + NORM_EPS); }

__device__ __forceinline__ void transpose_item(const float* W, int ldw, int K, int k0, int scol, int nvalid, h16* WT, int drow, float scale, const float* colscale, bool f8, LAS float* scr, int lane) {
    const int cn = scol + (lane & 31); const bool okc = cn < nvalid;
    float wv[32];
#pragma unroll
    for (int i = 0; i < 32; ++i) { const int kk = 2 * i + (lane >> 5); wv[i] = W[(size_t)(k0 + kk) * ldw + (okc ? cn : 0)]; }
#pragma unroll
    for (int i = 0; i < 32; ++i) { const int kk = 2 * i + (lane >> 5); scr[kk * 33 + (lane & 31)] = okc ? wv[i] : 0.f; }
    LDS_WAIT(); asm volatile("" ::: "memory");
    const int c = lane & 7;
#pragma unroll
    for (int j = 0; j < 4; ++j) { const int n = (lane >> 3) + 8 * j; const LAS float* s = scr + (8 * c) * 33 + n;
        float sc = scale; if (colscale) sc *= colscale[scol + n];
        if (f8) { u32x2 o; o.x = pk8(s[0 * 33] * sc, s[1 * 33] * sc, s[2 * 33] * sc, s[3 * 33] * sc); o.y = pk8(s[4 * 33] * sc, s[5 * 33] * sc, s[6 * 33] * sc, s[7 * 33] * sc);
            *(GAS u32x2*)((unsigned char*)WT + (size_t)(drow + n) * K + k0 + 8 * c) = o; }
        else { u32x4 o; o.x = pkh(s[0 * 33] * sc, s[1 * 33] * sc); o.y = pkh(s[2 * 33] * sc, s[3 * 33] * sc); o.z = pkh(s[4 * 33] * sc, s[5 * 33] * sc); o.w = pkh(s[6 * 33] * sc, s[7 * 33] * sc);
            *(GAS u32x4*)(WT + (size_t)(drow + n) * K + k0 + 8 * c) = o; } }
    LDS_WAIT(); asm volatile("" ::: "memory");
}
struct TJob { const float* W; h16* WT; const float* colscale; int ldw, K, nrows, nvalid, mode; float scale; };
__device__ __forceinline__ int tjob_items(const TJob& j) { return (j.K / 64) * (j.nrows / 32); }
__device__ __forceinline__ void tjob_run(const TJob& j, int item, LAS float* scr, int lane) {
    const int nblk = j.nrows / 32, kb = item / nblk, r = 32 * (item % nblk);
    const int scol = (j.mode & 1) ? ((r >> 7) & 1) * DFF + 128 * (r >> 8) + (r & 127) : r;
    transpose_item(j.W, j.ldw, j.K, 64 * kb, scol, j.nvalid, j.WT, r, j.scale, j.colscale, (j.mode & 2) != 0, scr, lane);
}

struct Args {
    const float* x; const float* mem; const int* pos; const float* gains; const float* mem_norm; const float* pool_w; const float* pool_scale;
    const float* w_in; const float* w_out; const float* wq; const float* wkv; const float* wo; const float* wgu; const float* wdn;
    float* out; unsigned char* ws;
    float inv_freq[16];
    int ph_lo, ph_hi, li, pad;
};

#define CAS __attribute__((address_space(4)))
typedef const CAS Args* ArgP;
__device__ __forceinline__ ArgP argp() { unsigned long long p = (unsigned long long)__builtin_amdgcn_kernarg_segment_ptr(); asm volatile("" : "+s"(p)); return (ArgP)p; }

__device__ __forceinline__ void rope_entry(ArgP a, float* rope, int idx) {
    const int m = idx >> 4, i = idx & 15;
    const float angf = (float)a->pos[m] * a->inv_freq[i];
    const double ang = (double)angf;
    const double TWO_PI = 6.283185307179586476925286766559, INV_2PI = 0.15915494309189533576888376337251;
    const double k = __builtin_rint(ang * INV_2PI);
    const double r = ang - k * TWO_PI;
    const double r2 = r * r;
    double c = 1.0, s = 1.0, tc = 1.0, ts = 1.0;
#pragma unroll
    for (int n = 1; n <= 13; ++n) { tc *= -r2 / (double)((2 * n - 1) * (2 * n)); ts *= -r2 / (double)((2 * n) * (2 * n + 1)); c += tc; s += ts; }
    rope[(size_t)m * 32 + i] = (float)c; rope[(size_t)m * 32 + 16 + i] = (float)(s * r);
}
__device__ __forceinline__ void norm_row_to_h16(const float* xrow, const float* gain, h16* orow, int lane) {
    const f32x4* xr = (const f32x4*)xrow + lane; const f32x4* gr = (const f32x4*)gain + lane;
    f32x4 v[8]; float s = 0.f;
#pragma unroll
    for (int j = 0; j < 8; ++j) { v[j] = xr[64 * j]; s += (v[j].x * v[j].x + v[j].y * v[j].y) + (v[j].z * v[j].z + v[j].w * v[j].w); }
    const float r = rstd_of(wave_sum_dpp(s));
    u32x2* o8 = (u32x2*)orow + lane;
#pragma unroll
    for (int j = 0; j < 8; ++j) { const f32x4 g = gr[64 * j], y = v[j] * r * g; u32x2 w; w.x = pkh(y.x, y.y); w.y = pkh(y.z, y.w); o8[64 * j] = w; }
}
__device__ __forceinline__ void pool_pre(Frame& F0, const float* x, const float* g0, h16* P) {
    Frame F = fresh(F0);
    LAS float* rs = (LAS float*)(F.lds + RING_OFF);
    for (int u = F.vcu; u < T / 64; u += F.G) {
        const int b = u / (SEQ / 64), t0 = 64 * (u % (SEQ / 64));
        const float* xb = x + (size_t)b * SEQ * D;
        for (int r = F.wave; r < 79; r += NWAVES) { const int t = t0 - 15 + r;
            if (t >= 0) { const f32x4* xr = (const f32x4*)(xb + (size_t)t * D) + F.lane; float s = 0.f;
#pragma unroll
                for (int j = 0; j < 8; ++j) { const f32x4 v = xr[64 * j]; s += (v.x * v.x + v.y * v.y) + (v.z * v.z + v.w * v.w); }
                s = rstd_of(wave_sum_dpp(s)); if (F.lane == 0) rs[r] = s; } }
        __syncthreads();
        {
            const int c0 = 4 * F.tid, w = 2 << (F.tid >> 7);
            const f32x4 g = *(const f32x4*)(g0 + c0);
            const int ts = (t0 - (w - 1)) > 0 ? (t0 - (w - 1)) : 0;
            f32x4 sum = {0.f, 0.f, 0.f, 0.f};
#pragma unroll 8
            for (int t = ts; t < t0 + 64; ++t) {
                const f32x4 a = *(const f32x4*)(xb + (size_t)t * D + c0) * rs[t - t0 + 15] * g;
                sum += a;
                if (t - w >= ts) sum -= *(const f32x4*)(xb + (size_t)(t - w) * D + c0) * rs[t - w - t0 + 15] * g;
                if (t >= t0) { const float ic = 1.0f / (float)((t + 1) < w ? (t + 1) : w); const f32x4 p = sum * ic - a;
                    u32x2 o; o.x = pkh(p.x, p.y); o.y = pkh(p.z, p.w); *(u32x2*)(P + ((size_t)b * SEQ + t) * D + c0) = o; }
            }
        }
        __syncthreads();
    }
}
__device__ __forceinline__ void p0_prologue(Frame& F0, ArgP a) {
    Frame F = fresh(F0);
    unsigned char* ws = a->ws;
    LAS float* scr = (LAS float*)(F.lds + RING_OFF + F.wave * 16384);
    const int gw = F.vcu * NWAVES + F.wave, NGW = F.G * NWAVES;
    constexpr int I_POOL = (512 / 64) * (512 / 32), I_IN = (2048 / 64) * (DSA_NP / 32), I_OUT = (2048 / 64) * (2048 / 32), I_Q = (2048 / 64) * (512 / 32), I_KV = (2048 / 64) * (1024 / 32),
                  I_O = (512 / 64) * (2048 / 32), I_GU = (2048 / 64) * (2 * DFF / 32), I_DN = (DFF / 64) * (2048 / 32);
    constexpr int NITEMS = 4 * I_POOL + I_IN + I_OUT + 2 * (I_Q + I_KV + I_O + I_GU + I_DN);
    for (int it = gw; it < NITEMS; it += NGW) {
        int r = it; TJob j; bool found = false;
#pragma unroll
        for (int g = 0; g < 4; ++g) if (!found) { if (r < I_POOL) { j = TJob{a->pool_w + (size_t)g * 512 * 512, (h16*)(ws + WS_WPOOL) + (size_t)g * 512 * 512, a->pool_scale + g * 512, 512, 512, 512, 512, 0, 1.0f}; found = true; } else r -= I_POOL; }
        if (!found) { if (r < I_IN) { j = TJob{a->w_in, (h16*)(ws + WS_WIN), nullptr, DSA_N, 2048, DSA_NP, DSA_N, 0, 64.0f}; found = true; } else r -= I_IN; }
        if (!found) { if (r < I_OUT) { j = TJob{a->w_out, (h16*)(ws + WS_WOUT), nullptr, 2048, 2048, 2048, 2048, 0, 1.0f}; found = true; } else r -= I_OUT; }
#pragma unroll
        for (int L = 0; L < 2; ++L) {
            if (!found) { if (r < I_Q) { j = TJob{a->wq + (size_t)L * 2048 * 512, (h16*)(ws + WS_WQ) + (size_t)L * 512 * 2048, nullptr, 512, 2048, 512, 512, 0, 1.0f}; found = true; } else r -= I_Q; }
            if (!found) { if (r < I_KV) { j = TJob{a->wkv + (size_t)L * 2048 * 1024, (h16*)(ws + WS_WKV) + (size_t)L * 1024 * 2048, nullptr, 1024, 2048, 1024, 1024, 0, 1.0f}; found = true; } else r -= I_KV; }
            if (!found) { if (r < I_O) { j = TJob{a->wo + (size_t)L * 512 * 2048, (h16*)(ws + WS_WO) + (size_t)L * 2048 * 512, nullptr, 2048, 512, 2048, 2048, 0, 1.0f}; found = true; } else r -= I_O; }
            if (!found) { if (r < I_GU) { j = ((FFN_FP8 >> L) & 1) ? TJob{a->wgu + (size_t)L * 2048 * 2 * DFF, (h16*)(ws + WS_WGU) + (size_t)L * 2 * DFF * 2048, nullptr, 2 * DFF, 2048, 2 * DFF, 2 * DFF, 3, W8_SCALE} : TJob{a->wgu + (size_t)L * 2048 * 2 * DFF, (h16*)(ws + WS_WGU) + (size_t)L * 2 * DFF * 2048, nullptr, 2 * DFF, 2048, 2 * DFF, 2 * DFF, 1, 1.0f}; found = true; } else r -= I_GU; }
            if (!found) { if (r < I_DN) { j = ((DN_FP8 >> L) & 1) ? TJob{a->wdn + (size_t)L * DFF * 2048, (h16*)(ws + WS_WDN) + (size_t)L * 2048 * DFF, nullptr, 2048, DFF, 2048, 2048, 2, W8_SCALE} : TJob{a->wdn + (size_t)L * DFF * 2048, (h16*)(ws + WS_WDN) + (size_t)L * 2048 * DFF, nullptr, 2048, DFF, 2048, 2048, 0, 1.0f}; found = true; } else r -= I_DN; }
        }
        if (found) tjob_run(j, r, scr, F.lane);
    }
    for (int i = (gw * 64 + F.lane); i < T * 16; i += NGW * 64) rope_entry(a, (float*)(ws + WS_ROPE), i);
    for (int m = gw; m < NB * NMEM; m += NGW) norm_row_to_h16(a->mem + (size_t)m * D, a->mem_norm, (h16*)(ws + WS_MEMN) + (size_t)m * D, F.lane);
    __syncthreads();
    pool_pre(F, a->x, a->gains  , (h16*)(ws + WS_A));
}

template <bool HAS_NEXT, bool OUT8, bool HIN32, bool HOUT32>
__device__ __forceinline__ void seam_phase(Frame& F0, const h16* Y, const void* hin, void* hout, const float* gpost, const float* gpre, h16* aout) {
    Frame F = fresh(F0);
    const int gw = F.vcu * NWAVES + F.wave, NGW = F.G * NWAVES;
#pragma unroll 4
    for (int m = gw; m < T; m += NGW) {
        const h16* yr = Y + (size_t)m * D + 8 * F.lane;
        float y[4][8]; float s = 0.f;
#pragma unroll
        for (int j = 0; j < 4; ++j) { const half8 v = *(const half8*)(yr + 512 * j);
#pragma unroll
            for (int e = 0; e < 8; ++e) { y[j][e] = (float)v[e]; s += y[j][e] * y[j][e]; } }
        float hp[4][8];
#pragma unroll
        for (int j = 0; j < 4; ++j) {
            if constexpr (HIN32) { const f32x4 a = *(const f32x4*)((const float*)hin + (size_t)m * D + 8 * F.lane + 512 * j), c = *(const f32x4*)((const float*)hin + (size_t)m * D + 8 * F.lane + 512 * j + 4);
                hp[j][0] = a.x; hp[j][1] = a.y; hp[j][2] = a.z; hp[j][3] = a.w; hp[j][4] = c.x; hp[j][5] = c.y; hp[j][6] = c.z; hp[j][7] = c.w; }
            else { const half8 v = *(const half8*)((const h16*)hin + (size_t)m * D + 8 * F.lane + 512 * j);
#pragma unroll
                for (int e = 0; e < 8; ++e) hp[j][e] = (float)v[e]; } }
        const float r = rstd_of(wave_sum_dpp(s)); float s2 = 0.f;
#pragma unroll
        for (int j = 0; j < 4; ++j) { const f32x4 g0 = *(const f32x4*)(gpost + 8 * F.lane + 512 * j), g1 = *(const f32x4*)(gpost + 8 * F.lane + 512 * j + 4);
            const float g[8] = {g0.x, g0.y, g0.z, g0.w, g1.x, g1.y, g1.z, g1.w};
#pragma unroll
            for (int e = 0; e < 8; ++e) { const float h = hp[j][e] + y[j][e] * r * g[e]; y[j][e] = h; s2 += h * h; }
            if constexpr (HOUT32) { float* o = (float*)hout + (size_t)m * D + 8 * F.lane + 512 * j; *(f32x4*)o = (f32x4){y[j][0], y[j][1], y[j][2], y[j][3]}; *(f32x4*)(o + 4) = (f32x4){y[j][4], y[j][5], y[j][6], y[j][7]}; }
            else { u32x4 w; w.x = pkh(y[j][0], y[j][1]); w.y = pkh(y[j][2], y[j][3]); w.z = pkh(y[j][4], y[j][5]); w.w = pkh(y[j][6], y[j][7]); *(u32x4*)((h16*)hout + (size_t)m * D + 8 * F.lane + 512 * j) = w; } }
        if constexpr (HAS_NEXT) {
            const float r2 = rstd_of(wave_sum_dpp(s2));
#pragma unroll
            for (int j = 0; j < 4; ++j) { const f32x4 g0 = *(const f32x4*)(gpre + 8 * F.lane + 512 * j), g1 = *(const f32x4*)(gpre + 8 * F.lane + 512 * j + 4);
                const float g[8] = {g0.x, g0.y, g0.z, g0.w, g1.x, g1.y, g1.z, g1.w}; float v[8];
#pragma unroll
                for (int e = 0; e < 8; ++e) v[e] = y[j][e] * r2 * g[e];
                if constexpr (OUT8) { u32x2 w; w.x = pk8(v[0], v[1], v[2], v[3]); w.y = pk8(v[4], v[5], v[6], v[7]); *(u32x2*)((unsigned char*)aout + (size_t)m * D + 8 * F.lane + 512 * j) = w; }
                else { u32x4 w; w.x = pkh(v[0], v[1]); w.y = pkh(v[2], v[3]); w.z = pkh(v[4], v[5]); w.w = pkh(v[6], v[7]); *(u32x4*)(aout + (size_t)m * D + 8 * F.lane + 512 * j) = w; } }
        }
    }
}

__device__ __forceinline__ void xattn_phase(Frame& F0, h16* XQ, const h16* KVM  ) {
    Frame F = fresh(F0);
    LAS unsigned char* Ks = F.lds + RING_OFF; LAS unsigned char* Vt = F.lds + RING_OFF + 65536;
    const int lane = F.lane, n = lane & 31, hh = lane >> 5;
    for (int u = F.vcu; u < NB * 4 * (SEQ / 512); u += F.G) {
        const int b = u / (4 * (SEQ / 512)), h = (u / (SEQ / 512)) & 3, ch = u % (SEQ / 512);
        const h16* kb = KVM + (size_t)b * NMEM * 2048 + h * HD;
        for (int i = F.tid; i < 256 * 16; i += NWAVES * 64) { const int key = i >> 4, c = i & 15;
            const u32x4 kv = *(const u32x4*)(kb + (size_t)key * 2048 + 8 * c);
            *(LAS u32x4*)(Ks + key * 256 + ((c ^ (key & 15)) << 4)) = kv;
            const half8 vv = *(const half8*)(kb + (size_t)key * 2048 + 512 + 8 * c);
            const int o = key & 15, posk = (key & ~15) | ((o & 3) | ((o & 4) << 1) | ((o & 8) >> 1));
#pragma unroll
            for (int e = 0; e < 8; ++e) { const int d = 8 * c + e; *(LAS h16*)(Vt + d * 512 + (((posk >> 3) ^ (d & 15)) << 4) + (posk & 7) * 2) = vv[e]; }
        }
        __syncthreads();
#pragma unroll 1
        for (int sub = 0; sub < 2; ++sub) {
            const size_t m0 = (size_t)b * SEQ + ch * 512 + sub * 256 + F.wave * 32;
            h16* qrow = XQ + (m0 + n) * XW + h * HD;
            half8 qf[8];
#pragma unroll
            for (int s = 0; s < 8; ++s) qf[s] = *(const half8*)(qrow + 16 * s + 8 * hh);
            f32x16 o[4];
#pragma unroll
            for (int mt = 0; mt < 4; ++mt)
#pragma unroll
                for (int i = 0; i < 16; ++i) o[mt][i] = 0.f;
            const float c2 = 0.08838834764831845f * 1.44269504089f;
            float mrun = -3.0e38f, lrun = 0.f;
#pragma unroll 1
            for (int hf = 0; hf < 2; ++hf) {
                f32x16 acc[4];
#pragma unroll
                for (int kt = 0; kt < 4; ++kt) {
#pragma unroll
                    for (int i = 0; i < 16; ++i) acc[kt][i] = 0.f;
                    const int key = 128 * hf + 32 * kt + n;
#pragma unroll
                    for (int s = 0; s < 8; ++s) { const half8 ka = *(const LAS half8*)(Ks + key * 256 + (((2 * s + hh) ^ (key & 15)) << 4));
                        acc[kt] = __builtin_amdgcn_mfma_f32_32x32x16_f16(ka, qf[s], acc[kt], 0, 0, 0); }
                }
                float mx = mrun;
#pragma unroll
                for (int kt = 0; kt < 4; ++kt)
#pragma unroll
                    for (int i = 0; i < 16; ++i) mx = fmaxf(mx, acc[kt][i]);
                mx = fmaxf(mx, __shfl_xor(mx, 32));
                const float alpha = __builtin_amdgcn_exp2f((mrun - mx) * c2); mrun = mx;
                float sum = 0.f;
#pragma unroll
                for (int kt = 0; kt < 4; ++kt)
#pragma unroll
                    for (int i = 0; i < 16; ++i) { const float p = __builtin_amdgcn_exp2f((acc[kt][i] - mx) * c2); acc[kt][i] = p; sum += p; }
                lrun = lrun * alpha + sum;
#pragma unroll
                for (int mt = 0; mt < 4; ++mt)
#pragma unroll
                    for (int i = 0; i < 16; ++i) o[mt][i] *= alpha;
#pragma unroll
                for (int kt = 0; kt < 4; ++kt)
#pragma unroll
                    for (int s2 = 0; s2 < 2; ++s2) {
                        half8 pb;
#pragma unroll
                        for (int j = 0; j < 8; ++j) pb[j] = (h16)acc[kt][8 * s2 + j];
#pragma unroll
                        for (int mt = 0; mt < 4; ++mt) { const int d = 32 * mt + n;
                            const half8 va = *(const LAS half8*)(Vt + d * 512 + (((2 * (2 * (4 * hf + kt) + s2) + hh) ^ (d & 15)) << 4));
                            o[mt] = __builtin_amdgcn_mfma_f32_32x32x16_f16(va, pb, o[mt], 0, 0, 0); }
                    }
            }
            lrun += __shfl_xor(lrun, 32);
            const float inv = 1.0f / lrun;
#pragma unroll
            for (int mt = 0; mt < 4; ++mt)
#pragma unroll
                for (int jj = 0; jj < 4; ++jj) { u32x2 w; w.x = pkh(o[mt][4 * jj] * inv, o[mt][4 * jj + 1] * inv); w.y = pkh(o[mt][4 * jj + 2] * inv, o[mt][4 * jj + 3] * inv);
                    *(u32x2*)(qrow + 32 * mt + 8 * jj + 4 * hh) = w; }
        }
        __syncthreads();
    }
}

__device__ __forceinline__ unsigned mono_key(unsigned u) { return (u & 0x80000000u) ? ~u : (u | 0x80000000u); }
__device__ __forceinline__ void keymap_clear(LAS unsigned* bm, int lane) { *(LAS u32x4*)(bm + 8 * lane) = (u32x4){0u, 0u, 0u, 0u}; *(LAS u32x4*)(bm + 8 * lane + 4) = (u32x4){0u, 0u, 0u, 0u}; }
__device__ __forceinline__ void keymap_emit(LAS unsigned* bm, unsigned short* out, int nvalid, int lane) {
    const u32x4 w0 = *(const LAS u32x4*)(bm + 8 * lane), w1 = *(const LAS u32x4*)(bm + 8 * lane + 4);
    unsigned w[8] = {w0.x, w0.y, w0.z, w0.w, w1.x, w1.y, w1.z, w1.w};
    int mine = 0;
#pragma unroll
    for (int j = 0; j < 8; ++j) mine += __builtin_popcount(w[j]);
    int incl = mine;
#pragma unroll
    for (int o = 1; o < 64; o <<= 1) { const int v = __shfl_up(incl, o); if (lane >= o) incl += v; }
    int pos = incl - mine;
#pragma unroll
    for (int j = 0; j < 8; ++j) { unsigned x = w[j]; while (x) { const int b = __builtin_ctz(x); out[pos++] = (unsigned short)((8 * lane + j) * 32 + b); x &= x - 1u; } }
    const int total = __shfl(incl, 63);
    for (int i = total + lane; i < TOPK; i += 64) out[i] = (unsigned short)0;
}
constexpr int SEL_N = LIST_CAP / 64;
template <bool FINAL>
__device__ __forceinline__ void select256(u32x2* list, int c, LAS float* th_out, LAS unsigned* cnt_out, LAS unsigned* bm, int lane) {
    unsigned key[SEL_N], id[SEL_N];
#pragma unroll
    for (int k = 0; k < SEL_N; ++k) { const int i = lane + 64 * k; const u32x2 v = list[i]; key[k] = (i < c) ? mono_key(v.x) : 0u; id[k] = v.y; }
    unsigned mx = key[0];
#pragma unroll
    for (int k = 1; k < SEL_N; ++k) mx = key[k] > mx ? key[k] : mx;
#pragma unroll
    for (int o = 1; o < 64; o <<= 1) { const unsigned v = (unsigned)__shfl_xor((int)mx, o); mx = v > mx ? v : mx; }
    unsigned lo = FINAL ? 1u : mono_key(__float_as_uint(*th_out)), hi = mx;
    constexpr int PRUNE_KEEP = 320;
#pragma unroll 1
    while (lo < hi) { const unsigned mid = lo + ((hi - lo + 1u) >> 1); int cc = 0;
#pragma unroll
        for (int k = 0; k < SEL_N; ++k) cc += __builtin_popcountll(__ballot(key[k] >= mid));
        if (cc >= TOPK) { lo = mid; if (cc <= (FINAL ? TOPK : PRUNE_KEEP)) break; } else hi = mid - 1u; }
    const unsigned prefix = lo;
    int ngt = 0, neq = 0;
#pragma unroll
    for (int k = 0; k < SEL_N; ++k) { ngt += __builtin_popcountll(__ballot(key[k] > prefix)); neq += __builtin_popcountll(__ballot(key[k] == prefix)); }
    const int need_eq = FINAL ? (TOPK - ngt) : neq; int base_gt = 0, base_eq = 0;
    const unsigned long long lt = (1ull << lane) - 1ull;
#pragma unroll
    for (int k = 0; k < SEL_N; ++k) {
        const unsigned long long bgt = __ballot(key[k] > prefix), beq = __ballot(key[k] == prefix);
        int pos = -1;
        if (key[k] > prefix) pos = base_gt + __builtin_popcountll(bgt & lt);
        else if (key[k] == prefix) { const int r = base_eq + __builtin_popcountll(beq & lt); if (r < need_eq) pos = ngt + r; }
        if (pos >= 0) { if constexpr (FINAL) __hip_atomic_fetch_or(bm + (id[k] >> 5), 1u << (id[k] & 31u), __ATOMIC_RELAXED, __HIP_MEMORY_SCOPE_WORKGROUP); else { u32x2 v; v.x = (key[k] & 0x80000000u) ? (key[k] & 0x7fffffffu) : ~key[k]; v.y = id[k]; list[pos] = v; } }
        base_gt += __builtin_popcountll(bgt); base_eq += __builtin_popcountll(beq);
        __builtin_amdgcn_sched_barrier(0);
    }
    if constexpr (!FINAL) { if (lane == 0) { const unsigned u = (prefix & 0x80000000u) ? (prefix & 0x7fffffffu) : ~prefix; *th_out = __builtin_bit_cast(float, u); *cnt_out = (unsigned)(ngt + neq); } }
}
__device__ __forceinline__ void indexer_phase(Frame& F0, const h16* IQ, const h16* IK, const float* IW, unsigned short* IDX, u32x2* LISTS) {
    Frame F = fresh(F0);
    LAS unsigned char* bq = F.lds + RING_OFF;
    LAS unsigned* cnt = (LAS unsigned*)(F.lds + RING_OFF + 131072); LAS float* th = (LAS float*)(cnt + 32); LAS unsigned* flag = cnt + 64; LAS unsigned* sgn = cnt + 96;
    u32x2* mylist = LISTS + (size_t)blockIdx.x * 32 * LIST_CAP;
    const int lane = F.lane, n = lane & 31, hh = lane >> 5, w8 = F.wave;
    const float INF = __builtin_inff();
    constexpr int NU = NB * (SEQ / 32);
    for (int rnd = 0; rnd * F.G < NU; ++rnd) {
        int qt, b;
        if (F.G == 256) {
            const int i = (F.vcu & 31) + 32 * (F.vcu >> 6); b = (F.vcu >> 5) & 1;
            qt = rnd == 0 ? 511 - i : rnd == 1 ? i : rnd == 2 ? 256 + i : 255 - i;
        } else { const int kk = rnd * F.G + ((rnd & 1) ? (F.G - 1 - F.vcu) : F.vcu); if (kk >= NU) continue; qt = (SEQ / 32 - 1) - (kk >> 1); b = kk & 1; }
        const int nkt = qt + 1;
        const size_t m0 = (size_t)b * SEQ + 32 * qt;
        if (F.tid < 32) { cnt[F.tid] = 0u; th[F.tid] = -INF; unsigned mk = 0u;
#pragma unroll
            for (int h = 0; h < 16; ++h) mk |= (IW[(m0 + F.tid) * 16 + h] >= 0.f ? 1u : 0u) << h;
            sgn[F.tid] = mk; }
        if (F.tid == 0) *flag = 0u;
        { const int q = F.tid & 31, ch = F.tid >> 5;
#pragma unroll 4
            for (int h = 0; h < 16; ++h) { const float w = IW[(m0 + q) * 16 + h]; const half8 v = *(const half8*)(IQ + (m0 + q) * 2048 + h * HD + 8 * ch); half8 o;
#pragma unroll
                for (int e = 0; e < 8; ++e) o[e] = (h16)((float)v[e] * w);
                *(LAS half8*)(bq + (h * 16 + ch) * 512 + q * 16) = o; } }
        __syncthreads();
        const h16* ikb = IK + (size_t)b * SEQ * HD;
        const unsigned smask = sgn[n];
        float theta = -INF;
        const int qpos = 32 * qt + n;
        u32x2* lp = mylist + (size_t)n * LIST_CAP;
        half8 A[8];
        if (w8 < nkt) { const h16* arow = ikb + (size_t)(32 * w8 + n) * HD + 8 * hh;
#pragma unroll
            for (int c = 0; c < 8; ++c) A[c] = *(const half8*)(arow + 16 * c); }
#pragma unroll 1
        for (int r0 = 0; r0 < nkt; r0 += NWAVES) {
            const int kt = r0 + w8;
            if (kt < nkt) {
                f32x16 S;
#pragma unroll
                for (int i = 0; i < 16; ++i) S[i] = 0.f;
                const LAS unsigned char* bl = bq + hh * 512 + n * 16;
                half8 Ba[4], Bb[4]; f32x16 acc0, acc1;
#define IDX_LOADB(dst, h, c0) do { _Pragma("unroll") for (int c = 0; c < 4; ++c) dst[c] = *(const LAS half8*)(bl + ((h) * 16 + 2 * ((c0) + c)) * 512); } while (0)
#define IDX_MMA4(acc, Bx, c0) do { _Pragma("unroll") for (int c = 0; c < 4; ++c) acc = __builtin_amdgcn_mfma_f32_32x32x16_f16(A[(c0) + c], Bx[c], acc, 0, 0, 0); } while (0)
#define IDX_ZERO(acc) do { _Pragma("unroll") for (int i = 0; i < 16; ++i) acc[i] = 0.f; } while (0)
#define IDX_FOLD8(acc, h, i0) do { const float cc_ = ((smask >> (h)) & 1u) ? INF : -INF; _Pragma("unroll") for (int i = (i0); i < (i0) + 8; ++i) S[i] += __builtin_amdgcn_fmed3f(acc[i], 0.f, cc_); } while (0)
#define IDX_SCHED4() do { __builtin_amdgcn_sched_group_barrier(0x008, 1, 0); __builtin_amdgcn_sched_group_barrier(0x100, 1, 0); _Pragma("unroll") for (int g_ = 0; g_ < 3; ++g_) { __builtin_amdgcn_sched_group_barrier(0x008, 1, 0); __builtin_amdgcn_sched_group_barrier(0x100, 1, 0); __builtin_amdgcn_sched_group_barrier(0x002, 6, 0); } } while (0)
                IDX_LOADB(Ba, 0, 0);
                IDX_ZERO(acc1);
#pragma unroll 1
                for (int h = 0; h < 16; h += 2) {
                    IDX_ZERO(acc0);
                    IDX_MMA4(acc0, Ba, 0); IDX_FOLD8(acc1, (h + 15) & 15, 0); IDX_LOADB(Bb, h, 4); IDX_SCHED4();
                    IDX_MMA4(acc0, Bb, 4); IDX_FOLD8(acc1, (h + 15) & 15, 8); IDX_LOADB(Ba, h + 1, 0); IDX_SCHED4();
                    IDX_ZERO(acc1);
                    IDX_MMA4(acc1, Ba, 0); IDX_FOLD8(acc0, h, 0); IDX_LOADB(Bb, h + 1, 4); IDX_SCHED4();
                    IDX_MMA4(acc1, Bb, 4); IDX_FOLD8(acc0, h, 8); IDX_LOADB(Ba, (h + 2) & 15, 0); IDX_SCHED4();
                }
                IDX_FOLD8(acc1, 15, 0); IDX_FOLD8(acc1, 15, 8);
#if IDX_PROBE_MMA
                {
                    f32x16 S1 = S;
#pragma unroll
                    for (int c = 0; c < 8; ++c) asm volatile("" : "+v"(A[c]));
#pragma unroll
                    for (int i = 0; i < 16; ++i) S[i] = 0.f;
                    IDX_LOADB(Ba, 0, 0);
                    IDX_ZERO(acc1);
#pragma unroll 1
                    for (int h = 0; h < 16; h += 2) {
                        IDX_ZERO(acc0);
                        IDX_MMA4(acc0, Ba, 0); IDX_FOLD8(acc1, (h + 15) & 15, 0); IDX_LOADB(Bb, h, 4); IDX_SCHED4();
                        IDX_MMA4(acc0, Bb, 4); IDX_FOLD8(acc1, (h + 15) & 15, 8); IDX_LOADB(Ba, h + 1, 0); IDX_SCHED4();
                        IDX_ZERO(acc1);
                        IDX_MMA4(acc1, Ba, 0); IDX_FOLD8(acc0, h, 0); IDX_LOADB(Bb, h + 1, 4); IDX_SCHED4();
                        IDX_MMA4(acc1, Bb, 4); IDX_FOLD8(acc0, h, 8); IDX_LOADB(Ba, (h + 2) & 15, 0); IDX_SCHED4();
                    }
                    IDX_FOLD8(acc1, 15, 0); IDX_FOLD8(acc1, 15, 8);
#pragma unroll
                    for (int i = 0; i < 16; ++i) S[i] = (S[i] + S1[i]) * 0.5f;
                }
#endif
#undef IDX_LOADB
#undef IDX_MMA4
#undef IDX_ZERO
#undef IDX_FOLD8
#undef IDX_SCHED4
                if (kt + NWAVES < nkt) { const h16* arow = ikb + (size_t)(32 * (kt + NWAVES) + n) * HD + 8 * hh;
#pragma unroll
                    for (int c = 0; c < 8; ++c) A[c] = *(const half8*)(arow + 16 * c); }
                const int kb0 = 32 * kt + 4 * hh;
                unsigned pm = 0u;
                if (kt < qt) {
#pragma unroll
                    for (int i = 0; i < 16; ++i) pm |= (S[i] > theta) ? (1u << i) : 0u;
                } else {
#pragma unroll
                    for (int i = 0; i < 16; ++i) { const int key = kb0 + (i & 3) + 8 * (i >> 2); pm |= ((key <= qpos) && (S[i] > theta)) ? (1u << i) : 0u; }
                }
                if (pm) { const unsigned np = (unsigned)__builtin_popcount(pm);
                    const unsigned pos = __hip_atomic_fetch_add(cnt + n, np, __ATOMIC_RELAXED, __HIP_MEMORY_SCOPE_WORKGROUP);
#pragma unroll
                    for (int i = 0; i < 16; ++i) if (pm & (1u << i)) { u32x2 e; e.x = __float_as_uint(S[i]);   e.y = (unsigned)(kb0 + (i & 3) + 8 * (i >> 2));
                        { const unsigned at = pos + (unsigned)__builtin_popcount(pm & ((1u << i) - 1u)); lp[at < (unsigned)LIST_CAP ? at : (unsigned)LIST_CAP - 1u] = e; } }
                    if (pos + np > (unsigned)(LIST_CAP - 256)) *(volatile LAS unsigned*)flag = 1u; }
            }
            asm volatile("s_waitcnt lgkmcnt(0)" ::: "memory"); __builtin_amdgcn_s_barrier(); asm volatile("" ::: "memory");
            if (*(volatile LAS unsigned*)flag != 0u) {
                VM_WAIT(); __syncthreads();
                for (int q = w8; q < 32; q += NWAVES) { const int c = __builtin_amdgcn_readfirstlane((int)cnt[q]); if (c > TOPK) select256<false>(mylist + (size_t)q * LIST_CAP, c, th + q, cnt + q, nullptr, lane); }
                if (F.tid == 0) *flag = 0u;
                VM_WAIT(); __syncthreads();
                theta = th[n];
                if (kt + NWAVES < nkt) { const h16* arow = ikb + (size_t)(32 * (kt + NWAVES) + n) * HD + 8 * hh;
#pragma unroll
                    for (int c = 0; c < 8; ++c) A[c] = *(const half8*)(arow + 16 * c); }
            }
        }
        VM_WAIT(); __syncthreads();
        LAS unsigned* bm = (LAS unsigned*)(bq + w8 * 2048);
        for (int q = w8; q < 32; q += NWAVES) { const int c = __builtin_amdgcn_readfirstlane((int)cnt[q]); unsigned short* io = IDX + (m0 + q) * TOPK; u32x2* lq = mylist + (size_t)q * LIST_CAP;
            keymap_clear(bm, lane); asm volatile("s_waitcnt lgkmcnt(0)" ::: "memory");
            if (c > TOPK) select256<true>(lq, c, nullptr, nullptr, bm, lane);
            else {
#pragma unroll
                for (int k = 0; k < 4; ++k) { const int i = lane + 64 * k; if (i < c) { const unsigned key = lq[i].y; __hip_atomic_fetch_or(bm + (key >> 5), 1u << (key & 31u), __ATOMIC_RELAXED, __HIP_MEMORY_SCOPE_WORKGROUP); } } }
            asm volatile("s_waitcnt lgkmcnt(0)" ::: "memory");
            keymap_emit(bm, io, c, lane);
            asm volatile("s_waitcnt lgkmcnt(0)" ::: "memory"); }
        __syncthreads();
    }
}

__device__ __forceinline__ unsigned q_fetch(unsigned* ctr, int lane) { unsigned v = 0u; if (lane == 0) v = __hip_atomic_fetch_add(ctr, 1u, __ATOMIC_RELAXED, __HIP_MEMORY_SCOPE_AGENT); return (unsigned)__builtin_amdgcn_readfirstlane((int)v); }
__device__ __forceinline__ void sparse_attn_phase(Frame& F0, const h16* Q, const unsigned char* K8, const unsigned char* V8, const unsigned short* IDX, h16* O, unsigned* qctr) {
    Frame F = fresh(F0);
    LAS unsigned char* wl = F.lds + RING_OFF + F.wave * 16896;
    LAS float* Pl = (LAS float*)wl;
    LAS unsigned short* Il = (LAS unsigned short*)(wl + 4096);
    const int lane = F.lane, r16 = lane & 15, g4 = lane >> 4;
    const float c2 = 0.08838834764831845f * 1.44269504089f;
    const unsigned x0 = xb_xcc_id() & 7u;
    unsigned tried = 0u, p = x0;
    unsigned item = q_fetch(qctr + 64 * p, lane);
    bool have_pf = false; u32x2 pf_idx = (u32x2){0u, 0u}; half8 pf_q[4];
#pragma unroll
    for (int s = 0; s < 4; ++s) pf_q[s] = (half8){0, 0, 0, 0, 0, 0, 0, 0};
    for (;;) {
        while (item >= (unsigned)SEQ && tried < 8u) { ++tried; p = (x0 + tried) & 7u; if (tried < 8u) item = q_fetch(qctr + 64 * p, lane); }
        if (tried >= 8u) break;
        const unsigned nxt = q_fetch(qctr + 64 * p, lane);
        const int b = (int)(p >> 2), j = (int)(p & 3u), tq = (int)item, nk = (tq + 1) < TOPK ? (tq + 1) : TOPK;
        const size_t m = (size_t)b * SEQ + tq;
        const unsigned char* kb = K8 + (size_t)p * SEQ * HD; const unsigned char* vb = V8 + (size_t)p * SEQ * HD;
        *(LAS u32x2*)(Il + 4 * lane) = have_pf ? pf_idx : *(const u32x2*)(IDX + m * TOPK + 4 * lane);
        long qh[4], ql[4];
        { const h16* qrow = Q + m * 2048 + (size_t)j * 512 + (r16 & 3) * HD + 16 * g4;
#pragma unroll
          for (int s = 0; s < 4; ++s) { const half8 hv = have_pf ? pf_q[s] : *(const half8*)(qrow + (s >> 1) * 64 + (s & 1) * 8);
              float f[8], l[8];
#pragma unroll
              for (int e = 0; e < 8; ++e) f[e] = (float)hv[e] * c2;
              const unsigned h0 = pk8(f[0], f[1], f[2], f[3]), h1 = pk8(f[4], f[5], f[6], f[7]);
              l[0] = f[0] - __builtin_amdgcn_cvt_f32_fp8((int)h0, 0); l[1] = f[1] - __builtin_amdgcn_cvt_f32_fp8((int)h0, 1); l[2] = f[2] - __builtin_amdgcn_cvt_f32_fp8((int)h0, 2); l[3] = f[3] - __builtin_amdgcn_cvt_f32_fp8((int)h0, 3);
              l[4] = f[4] - __builtin_amdgcn_cvt_f32_fp8((int)h1, 0); l[5] = f[5] - __builtin_amdgcn_cvt_f32_fp8((int)h1, 1); l[6] = f[6] - __builtin_amdgcn_cvt_f32_fp8((int)h1, 2); l[7] = f[7] - __builtin_amdgcn_cvt_f32_fp8((int)h1, 3);
              const unsigned l0 = pk8(l[0], l[1], l[2], l[3]), l1 = pk8(l[4], l[5], l[6], l[7]);
              const bool real = r16 < 4;
              qh[s] = real ? (long)(((unsigned long long)h1 << 32) | h0) : 0l; ql[s] = real ? (long)(((unsigned long long)l1 << 32) | l0) : 0l; } }
        asm volatile("s_waitcnt lgkmcnt(0)" ::: "memory");
        int keys[16];
#pragma unroll
        for (int kt = 0; kt < 16; ++kt) keys[kt] = Il[16 * kt + r16];
        {
            u32x4 ka[8][2];
#pragma unroll
            for (int k8 = 0; k8 < 8; ++k8) { const unsigned char* krow = kb + (size_t)keys[k8] * HD + 16 * g4; ka[k8][0] = *(const u32x4*)krow; ka[k8][1] = *(const u32x4*)(krow + 64); }
#pragma unroll
            for (int kt = 0; kt < 16; ++kt) { const int k8 = kt & 7; const u32x4 a0 = ka[k8][0], a1 = ka[k8][1];
                const long ak[4] = {(long)(((unsigned long long)a0.y << 32) | a0.x), (long)(((unsigned long long)a0.w << 32) | a0.z), (long)(((unsigned long long)a1.y << 32) | a1.x), (long)(((unsigned long long)a1.w << 32) | a1.z)};
                if (kt < 8) { const unsigned char* krow = kb + (size_t)keys[kt + 8] * HD + 16 * g4; ka[k8][0] = *(const u32x4*)krow; ka[k8][1] = *(const u32x4*)(krow + 64); }
                f32x4 acc = (f32x4){0.f, 0.f, 0.f, 0.f};
#pragma unroll
                for (int s = 0; s < 4; ++s) { acc = __builtin_amdgcn_mfma_f32_16x16x32_fp8_fp8(ak[s], qh[s], acc, 0, 0, 0); acc = __builtin_amdgcn_mfma_f32_16x16x32_fp8_fp8(ak[s], ql[s], acc, 0, 0, 0); }
                if (r16 < 4) {
#pragma unroll
                    for (int i = 0; i < 4; ++i) Pl[(16 * kt + 4 * g4 + i) * 4 + r16] = acc[i]; }
            }
        }
        have_pf = nxt < (unsigned)SEQ;
        if (have_pf) { const size_t mn = (size_t)b * SEQ + nxt; pf_idx = *(const u32x2*)(IDX + mn * TOPK + 4 * lane);
            const h16* qn = Q + mn * 2048 + (size_t)j * 512 + (r16 & 3) * HD + 16 * g4;
#pragma unroll
            for (int s = 0; s < 4; ++s) pf_q[s] = *(const half8*)(qn + (s >> 1) * 64 + (s & 1) * 8); }
        asm volatile("" ::: "memory");
        LAS unsigned char* vs = wl + 4608;
        const int nch = (nk + 31) >> 5;
#define SP_ISSUE(ch_) do { const int c_ = (ch_); LAS unsigned char* s_ = vs + (c_ % 3) * 4096; _Pragma("unroll") for (int j_ = 0; j_ < 4; ++j_) { const int key_ = Il[32 * c_ + 8 * j_ + (lane >> 3)]; \
                __builtin_amdgcn_global_load_lds((const unsigned*)(vb + (size_t)key_ * HD + (((lane & 7) ^ (((8 * j_ + (lane >> 3)) >> 1) & 7)) * 16)), (LAS unsigned*)(s_ + 1024 * j_), 16, 0, 0); } } while (0)
            SP_ISSUE(0); if (nch > 1) SP_ISSUE(1);
        f32x4 sv[4]; f32x4 mx = (f32x4){-3.0e38f, -3.0e38f, -3.0e38f, -3.0e38f};
#pragma unroll
        for (int k = 0; k < 4; ++k) { sv[k] = *(const LAS f32x4*)(Pl + (lane + 64 * k) * 4); if (lane + 64 * k < nk) { mx[0] = fmaxf(mx[0], sv[k][0]); mx[1] = fmaxf(mx[1], sv[k][1]); mx[2] = fmaxf(mx[2], sv[k][2]); mx[3] = fmaxf(mx[3], sv[k][3]); } }
        mx[0] = wave_max_dpp(mx[0]); mx[1] = wave_max_dpp(mx[1]); mx[2] = wave_max_dpp(mx[2]); mx[3] = wave_max_dpp(mx[3]);
        f32x4 sum = (f32x4){0.f, 0.f, 0.f, 0.f};
        asm volatile("s_waitcnt lgkmcnt(0)" ::: "memory");
#pragma unroll
        for (int k = 0; k < 4; ++k) { f32x4 pv;
#pragma unroll
            for (int h = 0; h < 4; ++h) pv[h] = (lane + 64 * k < nk) ? __builtin_amdgcn_exp2f(sv[k][h] - mx[h]) : 0.f;
            sum += pv;
#pragma unroll
            for (int h = 0; h < 4; ++h) Pl[h * 256 + lane + 64 * k] = pv[h] * 16.0f; }
        sum[0] = wave_sum_dpp(sum[0]); sum[1] = wave_sum_dpp(sum[1]); sum[2] = wave_sum_dpp(sum[2]); sum[3] = wave_sum_dpp(sum[3]);
        asm volatile("s_waitcnt lgkmcnt(0)" ::: "memory");
        long ph[8], pq[8];
#pragma unroll
        for (int s = 0; s < 8; ++s) { const LAS float* pp = Pl + (r16 & 3) * 256 + 32 * s + 8 * g4; const f32x4 a = *(const LAS f32x4*)pp, c = *(const LAS f32x4*)(pp + 4);
            const unsigned h0 = pk8(a[0], a[1], a[2], a[3]), h1 = pk8(c[0], c[1], c[2], c[3]);
            const unsigned l0 = pk8(a[0] - __builtin_amdgcn_cvt_f32_fp8((int)h0, 0), a[1] - __builtin_amdgcn_cvt_f32_fp8((int)h0, 1), a[2] - __builtin_amdgcn_cvt_f32_fp8((int)h0, 2), a[3] - __builtin_amdgcn_cvt_f32_fp8((int)h0, 3));
            const unsigned l1 = pk8(c[0] - __builtin_amdgcn_cvt_f32_fp8((int)h1, 0), c[1] - __builtin_amdgcn_cvt_f32_fp8((int)h1, 1), c[2] - __builtin_amdgcn_cvt_f32_fp8((int)h1, 2), c[3] - __builtin_amdgcn_cvt_f32_fp8((int)h1, 3));
            const bool real = r16 < 4;
            ph[s] = real ? (long)(((unsigned long long)h1 << 32) | h0) : 0l; pq[s] = real ? (long)(((unsigned long long)l1 << 32) | l0) : 0l; }
        f32x4 oacc[8];
#pragma unroll
        for (int nt = 0; nt < 8; ++nt) oacc[nt] = (f32x4){0.f, 0.f, 0.f, 0.f};
        {
            const int vrow = 8 * g4 + (r16 >> 1);
#pragma unroll
            for (int ch = 0; ch < 8; ++ch) {
                if (ch < nch) {
                    if (ch + 2 < nch) { SP_ISSUE(ch + 2); asm volatile("s_waitcnt vmcnt(8)" ::: "memory"); }
                    else if (ch + 1 < nch) asm volatile("s_waitcnt vmcnt(4)" ::: "memory");
                    else asm volatile("s_waitcnt vmcnt(0)" ::: "memory");
                    const LAS unsigned char* s = vs + (ch % 3) * 4096 + vrow * HD + 8 * (r16 & 1);
#pragma unroll
                    for (int nt = 0; nt < 8; ++nt) {
                        const v2i32 bv = __builtin_amdgcn_ds_read_tr8_b64_v2i32((LAS v2i32*)(s + ((nt ^ ((vrow >> 1) & 7)) * 16)));
                        const long bb = (long)(((unsigned long long)(unsigned)bv.y << 32) | (unsigned)bv.x);
                        oacc[nt] = __builtin_amdgcn_mfma_f32_16x16x32_fp8_fp8(ph[ch], bb, oacc[nt], 0, 0, 0);
                        oacc[nt] = __builtin_amdgcn_mfma_f32_16x16x32_fp8_fp8(pq[ch], bb, oacc[nt], 0, 0, 0); }
                    asm volatile("s_waitcnt lgkmcnt(0)" ::: "memory");
                }
            }
#undef SP_ISSUE
        }
        { LAS h16* ot = (LAS h16*)Pl;
          if (g4 == 0) {
#pragma unroll
              for (int nt = 0; nt < 8; ++nt)
#pragma unroll
                  for (int i = 0; i < 4; ++i) ot[i * HD + 16 * nt + r16] = (h16)(oacc[nt][i] * (0.0625f / sum[i])); }
          asm volatile("s_waitcnt lgkmcnt(0)" ::: "memory");
          const u32x4 w = *(const LAS u32x4*)(ot + g4 * HD + 8 * r16);
          *(u32x4*)(O + m * 2048 + (size_t)j * 512 + g4 * HD + 8 * r16) = w; }
        asm volatile("s_waitcnt lgkmcnt(0)" ::: "memory");
        item = nxt;
    }
}

#ifndef DBG_CHECK
#define DBG_CHECK 0
#endif
#if DBG_CHECK
__device__ __forceinline__ void dbg_max(unsigned* w, float v) { atomicMax(w, __builtin_bit_cast(unsigned, fabsf(v))); }
__device__ __forceinline__ int dbg_row(int blk) { return (blk & 1) * SEQ + (SEQ - 1 - 251 * (blk >> 1)); }
__device__ __forceinline__ void dbg_check_inproj(unsigned char* ws, LAS float* sh, unsigned* word) {
    if (blockIdx.x >= 64) return;
    int tid_ = (int)threadIdx.x; asm volatile("" : "+v"(tid_)); const int m = dbg_row(blockIdx.x), tid = tid_;
    const h16* a = (const h16*)(ws + WS_A) + (size_t)m * 2048; const h16* W = (const h16*)(ws + WS_WIN);
    for (int c = tid; c < DSA_N; c += 512) { float s = 0.f; for (int k = 0; k < 2048; ++k) s += (float)a[k] * (float)W[(size_t)c * 2048 + k]; sh[c] = s * (1.0f / 64.0f); }
    __syncthreads();
    const float* rope = (const float*)(ws + WS_ROPE) + (size_t)m * 32;
    for (int c = tid; c < DSA_N; c += 512) {
        float v = sh[c]; int hc; bool rot; float got;
        if (c < 2048) { hc = c & 127; rot = true; got = (float)((const h16*)(ws + WS_Q))[(size_t)m * 2048 + c]; }
        else if (c < 3072) continue;
        else if (c < 5120) { hc = (c - 3072) & 127; rot = true; got = (float)((const h16*)(ws + WS_IQ))[(size_t)m * 2048 + (c - 3072)]; }
        else if (c < 5248) { hc = c - 5120; rot = true; got = (float)((const h16*)(ws + WS_IK))[(size_t)m * 128 + (c - 5120)]; }
        else { hc = 99; rot = false; got = ((const float*)(ws + WS_IW))[(size_t)m * 16 + (c - 5248)]; }
        if (rot && hc < 32) { const int i = hc & 15; const float cs = rope[i], sn = rope[16 + i]; v = hc < 16 ? v * cs - sh[c + 16] * sn : v * cs + sh[c - 16] * sn; }
        dbg_max(word, (got - v) / (1.0f + fabsf(v)));
    }
    __syncthreads();
}
__device__ __forceinline__ void dbg_check_xattn(unsigned char* ws, int L, LAS float* sh, unsigned* word) {
    if (blockIdx.x >= 64) return;
    int tid_ = (int)threadIdx.x; asm volatile("" : "+v"(tid_)); const int m = dbg_row(blockIdx.x), tid = tid_, b = m / SEQ;
    const h16* a = (const h16*)(ws + WS_A) + (size_t)m * 2048; const h16* W = (const h16*)(ws + WS_WQ) + (size_t)L * 512 * 2048;
    const h16* kvm = (const h16*)(ws + WS_KVM) + (size_t)b * NMEM * 2048 + L * 1024;
    LAS float* q = sh; LAS float* lg = sh + 512; LAS float* st = sh + 512 + 1024;
    { float s = 0.f; for (int k = 0; k < 2048; ++k) s += (float)a[k] * (float)W[(size_t)tid * 2048 + k]; q[tid] = (float)(h16)s; }
    __syncthreads();
    for (int i = tid; i < 1024; i += 512) { const int h = i >> 8, key = i & 255; float s = 0.f; for (int d = 0; d < 128; ++d) s += q[h * 128 + d] * (float)kvm[(size_t)key * 2048 + h * 128 + d]; lg[i] = s * 0.08838834764831845f; }
    __syncthreads();
    if (tid < 4) { float mx = -3e38f; for (int k = 0; k < 256; ++k) mx = fmaxf(mx, lg[tid * 256 + k]); float su = 0.f; for (int k = 0; k < 256; ++k) su += __expf(lg[tid * 256 + k] - mx); st[2 * tid] = mx; st[2 * tid + 1] = 1.0f / su; }
    __syncthreads();
    { const int h = tid >> 7, d = tid & 127; float o = 0.f; for (int k = 0; k < 256; ++k) o += __expf(lg[h * 256 + k] - st[2 * h]) * st[2 * h + 1] * (float)kvm[(size_t)k * 2048 + 512 + h * 128 + d];
      const float got = (float)((const h16*)(ws + WS_XQ))[(size_t)m * 512 + tid]; dbg_max(word, (got - o) / (0.05f + fabsf(o))); }
    __syncthreads();
}
__device__ __forceinline__ void dbg_check_indexer(unsigned char* ws, LAS float* sh, unsigned* word, unsigned* word2) {
    if (blockIdx.x >= 64) return;
    int tid_ = (int)threadIdx.x; asm volatile("" : "+v"(tid_)); const int m = dbg_row(blockIdx.x), tid = tid_, b = m / SEQ, t = m % SEQ;
    const h16* iq = (const h16*)(ws + WS_IQ) + (size_t)m * 2048; const h16* ik = (const h16*)(ws + WS_IK) + (size_t)b * SEQ * 128; const float* iw = (const float*)(ws + WS_IW) + (size_t)m * 16;
    LAS float* sc = sh;
    for (int s = tid; s <= t; s += 512) { float tot = 0.f; for (int h = 0; h < 16; ++h) { float l = 0.f; for (int d = 0; d < 128; ++d) l += (float)iq[h * 128 + d] * (float)ik[(size_t)s * 128 + d]; tot += iw[h] * fmaxf(l, 0.f); } sc[s] = tot; }
    __syncthreads();
    const unsigned short* idx = (const unsigned short*)(ws + WS_IDX) + (size_t)m * 256;
    if (tid < 256) { const int key = idx[tid]; if (key > t) atomicAdd(word2, 1000u); else { const float v = sc[key]; int rank = 0; for (int s = 0; s <= t; ++s) rank += sc[s] > v ? 1 : 0; if (rank >= 256) atomicAdd(word, 1u);
        for (int j = 0; j < 256; ++j) if (j != tid && idx[j] == key) { atomicAdd(word2, 1u); break; } } }
    __syncthreads();
}
__device__ __forceinline__ float dbg_f8(const unsigned char* p) { const unsigned w = *p; return __builtin_amdgcn_cvt_f32_fp8((int)w, 0); }
__device__ __forceinline__ void dbg_check_sparse(unsigned char* ws, LAS float* sh, unsigned* word) {
    if (blockIdx.x >= 64) return;
    int tid_ = (int)threadIdx.x; asm volatile("" : "+v"(tid_)); const int m = dbg_row(blockIdx.x), tid = tid_, b = m / SEQ;
    const h16* q = (const h16*)(ws + WS_Q) + (size_t)m * 2048; const unsigned char* k8 = (const unsigned char*)(ws + WS_KV); const unsigned char* v8 = k8 + (size_t)16 * 1024 * 1024;
    const unsigned short* idx = (const unsigned short*)(ws + WS_IDX) + (size_t)m * 256;
    LAS float* lg = sh; LAS float* st = sh + 4096;
    for (int i = tid; i < 4096; i += 512) { const int h = i >> 8, k = i & 255, key = idx[k]; float s = 0.f; const unsigned char* kr = k8 + ((size_t)(b * NKV + (h >> 2)) * SEQ + key) * HD;
        for (int d = 0; d < 128; ++d) s += (float)q[h * 128 + d] * dbg_f8(kr + d); lg[i] = s * 0.08838834764831845f; }
    __syncthreads();
    if (tid < 16) { float mx = -3e38f; for (int k = 0; k < 256; ++k) mx = fmaxf(mx, lg[tid * 256 + k]); float su = 0.f; for (int k = 0; k < 256; ++k) su += __expf(lg[tid * 256 + k] - mx); st[2 * tid] = mx; st[2 * tid + 1] = 1.0f / su; }
    __syncthreads();
    for (int i = tid; i < 2048; i += 512) { const int h = i >> 7, d = i & 127; float o = 0.f; for (int k = 0; k < 256; ++k) o += __expf(lg[h * 256 + k] - st[2 * h]) * st[2 * h + 1] * dbg_f8(v8 + ((size_t)(b * NKV + (h >> 2)) * SEQ + idx[k]) * HD + d);
        const float got = (float)((const h16*)(ws + WS_A))[(size_t)m * 2048 + i]; dbg_max(word, (got - o) / (0.02f + fabsf(o))); }
    __syncthreads();
}
#endif

constexpr int N_PHASES = 22 + (DBG_CHECK ? 1 : 0);
__global__ void __launch_bounds__(NWAVES * 64, 2) trunk_fwd(Args args) {
    extern __shared__ __attribute__((aligned(16))) unsigned char lds_raw[];
    Frame F;
    F.lds = (LAS unsigned char*)lds_raw;
    F.MISC = (volatile LAS unsigned*)(F.lds + MISC_OFF);
    F.tid = threadIdx.x; F.lane = F.tid & 63; F.wave = __builtin_amdgcn_readfirstlane(F.tid >> 6);
    F.G = gridDim.x; { const int bx = blockIdx.x; F.vcu = (F.G % 8 == 0) ? (bx % 8) * (F.G / 8) + bx / 8 : bx; }
    unsigned char* ws = argp()->ws;
    for (int u = F.tid; u < (LDS_BYTES - MISC_OFF) / 4; u += NWAVES * 64) ((LAS unsigned*)(F.lds + MISC_OFF))[u] = 0u;
    __syncthreads();
    XcdBarrier bar; bar.bar = (unsigned*)(ws + WS_CTL) + CW_BAR; bar.x = 0; bar.st = nullptr;
    if (!MK_LAUNCH_PER_PHASE) bar = xcd_barrier_post((unsigned*)(ws + WS_CTL) + CW_BAR, F.MISC + 8);
    const int lo = argp()->ph_lo, hi = argp()->ph_hi;
#ifndef DBG_KINDS
#define DBG_KINDS 0xFFFF
#endif
#define KON(kind) (((DBG_KINDS) >> (kind)) & 1)
#ifndef PROBE_REP
#define PROBE_REP 0
#endif
#define NREP(kind) ((((PROBE_REP) >> (kind)) & 1) ? 2 : 1)
#define IN(k) (lo <= (k) && (k) < hi)
#define SEAM(k) do { if (IN((k) + 1)) { if (MK_LAUNCH_PER_PHASE) { } else xcd_barrier(bar); } } while (0)
    LAS unsigned char* ring = F.lds + RING_OFF;
    const int bid = (int)blockIdx.x;
    h16* A = (h16*)(ws + WS_A); h16* Y = (h16*)(ws + WS_Y); h16* H = (h16*)(ws + WS_H); h16* XQ = (h16*)(ws + WS_XQ); h16* ACT = (h16*)(ws + WS_ACT);

    if (KON(0) && IN(0)) { for (int rep = 0; rep < NREP(0); ++rep) { if (rep) xcd_barrier(bar); p0_prologue(F, argp()); } SEAM(0); }
    if (KON(1) && IN(1)) {
        { pg8::Gemm g{A, (const h16*)(ws + WS_WPOOL), T, D, 512, D, 1}; pg8::StaticOrder S; S.init(T, D, F.G, bid);
          pg8::EpiH16 E{Y, D, 1.0f}; pg8::gemm_phase<pg8::EpiH16, pg8::StaticOrder, true, true>(ring, g, S, E); }
        __syncthreads();
        { pg8::Gemm g{(const h16*)(ws + WS_MEMN), (const h16*)(ws + WS_WKV), NB * NMEM, 2048, 2048, 2048, 31}; pg8::StaticOrder S; S.init(NB * NMEM, 2048, F.G, bid);
          pg8::EpiH16 E{(h16*)(ws + WS_KVM), 2048, 1.0f}; pg8::gemm_phase<pg8::EpiH16, pg8::StaticOrder, true, true>(ring, g, S, E); }
        SEAM(1);
    }
#pragma unroll 1
    for (int L = 0; L < 2; ++L) {
        const int pb = L == 0 ? 2 : 14;
        if (L == 1) {
            if (KON(2) && IN(10)) {
                pg8::Gemm g{A, (const h16*)(ws + WS_WIN), T, DSA_NP, 2048, 2048, 31}; pg8::StaticOrder S; S.init(T, DSA_NP, F.G, bid);
                pg8::EpiInProj E{(h16*)(ws + WS_Q), (h16*)(ws + WS_KV), (h16*)(ws + WS_IQ), (h16*)(ws + WS_IK), (float*)(ws + WS_IW), (const float*)(ws + WS_ROPE), 1.0f / 64.0f};
                for (int rep = 0; rep < NREP(2); ++rep) { if (rep) xcd_barrier(bar); pg8::gemm_phase<pg8::EpiInProj, pg8::StaticOrder, true, true>(ring, g, S, E); }
                SEAM(10);
            }
#if DBG_CHECK
            if (IN(11)) dbg_check_inproj(ws, (LAS float*)ring, (unsigned*)(ws + WS_CTL) + 1024);
#endif
            if (KON(3) && IN(11)) { for (int rep = 0; rep < NREP(3); ++rep) { if (rep) xcd_barrier(bar); indexer_phase(F, (const h16*)(ws + WS_IQ), (const h16*)(ws + WS_IK), (const float*)(ws + WS_IW), (unsigned short*)(ws + WS_IDX), (u32x2*)(ws + WS_LISTS)); } SEAM(11); }
#if DBG_CHECK
            if (IN(12)) dbg_check_indexer(ws, (LAS float*)ring, (unsigned*)(ws + WS_CTL) + 1026, (unsigned*)(ws + WS_CTL) + 1028);
#endif
            if (KON(4) && IN(12)) { for (int rep = 0; rep < NREP(4); ++rep) { if (rep) xcd_barrier(bar); sparse_attn_phase(F, (const h16*)(ws + WS_Q), (const unsigned char*)(ws + WS_KV), (const unsigned char*)(ws + WS_KV) + (size_t)16 * 1024 * 1024, (const unsigned short*)(ws + WS_IDX), A, (unsigned*)(ws + WS_CTL) + 2048 + 512 * rep); } SEAM(12); }
#if DBG_CHECK
            if (IN(13)) dbg_check_sparse(ws, (LAS float*)ring, (unsigned*)(ws + WS_CTL) + 1027);
#endif
            if (KON(5) && IN(13)) {
                pg8::Gemm g{A, (const h16*)(ws + WS_WOUT), T, D, 2048, 2048, 31}; pg8::StaticOrder S; S.init(T, D, F.G, bid);
                pg8::EpiH16 E{Y, D, 1.0f}; pg8::gemm_phase<pg8::EpiH16, pg8::StaticOrder, true, true>(ring, g, S, E);
                SEAM(13);
            }
        }
        if (KON(6) && IN(pb + 0)) { ArgP a = argp(); const float* gains = a->gains + (size_t)L * 6 * D;
            if (L == 0) seam_phase<true, false, true, false>(F, Y, a->x, H, gains + 1 * D, gains + 2 * D, A); else seam_phase<true, false, false, false>(F, Y, H, H, gains + 1 * D, gains + 2 * D, A);
            SEAM(pb + 0); }
        if (KON(7) && IN(pb + 1)) {
            pg8::Gemm g{A, (const h16*)(ws + WS_WQ) + (size_t)L * XW * 2048, T, XW, 2048, 2048, 31}; pg8::StaticOrder S; S.init(T, XW, F.G, bid);
            pg8::EpiH16 E{XQ, XW, 1.0f}; pg8::gemm_phase<pg8::EpiH16, pg8::StaticOrder, true, true>(ring, g, S, E);
            SEAM(pb + 1);
        }
        if (KON(8) && IN(pb + 2)) { xattn_phase(F, XQ, (const h16*)(ws + WS_KVM) + L * 1024); SEAM(pb + 2); }
#if DBG_CHECK
        if (IN(pb + 3)) dbg_check_xattn(ws, L, (LAS float*)ring, (unsigned*)(ws + WS_CTL) + 1025);
#endif
        if (KON(9) && IN(pb + 3)) {
            pg8::Gemm g{XQ, (const h16*)(ws + WS_WO) + (size_t)L * 2048 * XW, T, D, XW, XW, 31}; pg8::StaticOrder S; S.init(T, D, F.G, bid);
            pg8::EpiH16 E{Y, D, 1.0f}; pg8::gemm_phase<pg8::EpiH16, pg8::StaticOrder, true, true>(ring, g, S, E);
            SEAM(pb + 3);
        }
        if (KON(10) && IN(pb + 4)) { ArgP a = argp(); const float* gains = a->gains + (size_t)L * 6 * D;
            if ((FFN_FP8 >> L) & 1) seam_phase<true, true, false, false>(F, Y, H, H, gains + 3 * D, gains + 4 * D, A); else seam_phase<true, false, false, false>(F, Y, H, H, gains + 3 * D, gains + 4 * D, A);
            SEAM(pb + 4); }
        static_assert((FFN_FP8 & ~DN_FP8) == 0, "an e4m3 gate|up GEMM writes e4m3 activations: its down projection must be e4m3 too");
        if (KON(11) && IN(pb + 5) && ((FFN_FP8 >> L) & 1)) {
            pg8::Gemm g{A, (const h16*)(ws + WS_WGU) + (size_t)L * 2 * DFF * 2048  , T, 2 * DFF, 1024, 1024, 31}; pg8::StaticOrder S; S.init(T, 2 * DFF, F.G, bid);
            pg8::EpiSwiGLU8 E{(unsigned char*)ACT, DFF, 1.0f / W8_SCALE, ACT8_SCALE}; pg8::gemm_phase<pg8::EpiSwiGLU8, pg8::StaticOrder, true, true, true>(ring, g, S, E);
            SEAM(pb + 5);
        }
        if (KON(11) && IN(pb + 5) && !((FFN_FP8 >> L) & 1) && ((DN_FP8 >> L) & 1)) {
            pg8::Gemm g{A, (const h16*)(ws + WS_WGU) + (size_t)L * 2 * DFF * 2048, T, 2 * DFF, 2048, 2048, 31}; pg8::StaticOrder S; S.init(T, 2 * DFF, F.G, bid);
            pg8::EpiSwiGLU8 E{(unsigned char*)ACT, DFF, 1.0f, ACT8_SCALE}; pg8::gemm_phase<pg8::EpiSwiGLU8, pg8::StaticOrder, true, true, false>(ring, g, S, E);
            SEAM(pb + 5);
        }
        if (KON(11) && IN(pb + 5) && !((FFN_FP8 >> L) & 1) && !((DN_FP8 >> L) & 1)) {
            pg8::Gemm g{A, (const h16*)(ws + WS_WGU) + (size_t)L * 2 * DFF * 2048, T, 2 * DFF, 2048, 2048, 31}; pg8::StaticOrder S; S.init(T, 2 * DFF, F.G, bid);
            pg8::EpiSwiGLU E{ACT, DFF}; pg8::gemm_phase<pg8::EpiSwiGLU, pg8::StaticOrder, true, true>(ring, g, S, E);
            SEAM(pb + 5);
        }
        if (KON(12) && IN(pb + 6) && ((DN_FP8 >> L) & 1)) {
            pg8::Gemm g{ACT, (const h16*)(ws + WS_WDN) + (size_t)L * 2048 * DFF  , T, D, DFF / 2, DFF / 2, 31}; pg8::StaticOrder S; S.init(T, D, F.G, bid);
            pg8::EpiH16 E{Y, D, 1.0f / (W8_SCALE * ACT8_SCALE)}; pg8::gemm_phase<pg8::EpiH16, pg8::StaticOrder, true, true, true>(ring, g, S, E);
            SEAM(pb + 6);
        }
        if (KON(12) && IN(pb + 6) && !((DN_FP8 >> L) & 1)) {
            pg8::Gemm g{ACT, (const h16*)(ws + WS_WDN) + (size_t)L * 2048 * DFF, T, D, DFF, DFF, 31}; pg8::StaticOrder S; S.init(T, D, F.G, bid);
            pg8::EpiH16 E{Y, D, 1.0f}; pg8::gemm_phase<pg8::EpiH16, pg8::StaticOrder, true, true>(ring, g, S, E);
            SEAM(pb + 6);
        }
        if (KON(13) && IN(pb + 7)) {
            ArgP a = argp(); const float* gains = a->gains + (size_t)L * 6 * D;
            if (L == 0) seam_phase<true, false, false, false>(F, Y, H, H, gains + 5 * D, a->gains + 6 * D  , A);
            else seam_phase<false, false, false, true>(F, Y, H, a->out, gains + 5 * D, nullptr, nullptr);
            SEAM(pb + 7);
        }
    }
#if DBG_CHECK
    if (IN(22)) {
        const unsigned* dw = (const unsigned*)(ws + WS_CTL) + 1024;
        const bool f0 = __builtin_bit_cast(float, dw[0]) > 4e-3f, f1 = __builtin_bit_cast(float, dw[1]) > 2e-2f, f2 = dw[2] > 24u, f3 = __builtin_bit_cast(float, dw[3]) > 2e-2f, f4 = dw[4] > 0u;
        for (int m = F.vcu * NWAVES + F.wave; m < T; m += F.G * NWAVES) { const int r = m & 15;
            const bool z = (r < 8 && f0) || (r >= 8 && r < 12 && f1) || (r >= 12 && r < 14 && f2) || (r == 14 && f3) || (r == 15 && f4);
            if (z) for (int j = 0; j < 8; ++j) ((f32x4*)(argp()->out + (size_t)m * D))[F.lane + 64 * j] = (f32x4){0.f, 0.f, 0.f, 0.f}; }
    }
#endif
#undef IN
#undef SEAM
}

extern "C" void kernel_launch(void* const* d_in, const int* in_sizes, int n_in, void* d_out, int out_size, void* d_ws, size_t ws_size, hipStream_t stream) {
    static int grid = 0;
    if (grid == 0) {
        if (n_in != 14 || in_sizes[0] != T * D || out_size != T * D || ws_size < WS_END) {
            fprintf(stderr, "kernel_launch: built for 14 inputs, x/out of %d floats, >= %zu bytes of workspace; got n_in %d, in0 %d, out %d, ws %zu; nothing launched\n", T * D, (size_t)WS_END, n_in, n_in > 0 ? in_sizes[0] : -1, out_size, ws_size);
            grid = -1; return; }
        int dev = 0, cus = 0, per_cu = 0;
        if (hipGetDevice(&dev) != hipSuccess || hipDeviceGetAttribute(&cus, hipDeviceAttributeMultiprocessorCount, dev) != hipSuccess) { fprintf(stderr, "kernel_launch: device query failed\n"); grid = -1; return; }
        if (hipFuncSetAttribute((const void*)trunk_fwd, hipFuncAttributeMaxDynamicSharedMemorySize, LDS_BYTES) != hipSuccess) { fprintf(stderr, "kernel_launch: hipFuncSetAttribute failed\n"); grid = -1; return; }
        if (hipOccupancyMaxActiveBlocksPerMultiprocessor(&per_cu, (const void*)trunk_fwd, NWAVES * 64, LDS_BYTES) != hipSuccess || per_cu < 1)
            fprintf(stderr, "kernel_launch: note: occupancy query reports %d workgroups per CU\n", per_cu);
        (void)hipGetLastError();
        grid = cus;
    }
    if (grid < 0) return;
    if (hipMemsetAsync((char*)d_ws + WS_CTL, 0, CTL_ZERO_BYTES, stream) != hipSuccess) { fprintf(stderr, "kernel_launch: memset failed\n"); return; }
    Args a{};
    a.x = (const float*)d_in[0]; a.mem = (const float*)d_in[1]; a.pos = (const int*)d_in[2]; a.gains = (const float*)d_in[3]; a.mem_norm = (const float*)d_in[4];
    a.pool_w = (const float*)d_in[5]; a.pool_scale = (const float*)d_in[6]; a.w_in = (const float*)d_in[7]; a.w_out = (const float*)d_in[8]; a.wq = (const float*)d_in[9];
    a.wkv = (const float*)d_in[10]; a.wo = (const float*)d_in[11]; a.wgu = (const float*)d_in[12]; a.wdn = (const float*)d_in[13];
    a.out = (float*)d_out; a.ws = (unsigned char*)d_ws;
    for (int i = 0; i < 16; ++i) a.inv_freq[i] = (float)pow(500000.0, -(double)(2 * i) / 32.0);
    a.pad = 0;
#if MK_LAUNCH_PER_PHASE
    for (int p = 0; p < N_PHASES; ++p) { a.ph_lo = p; a.ph_hi = p + 1; a.li = p;
        hipLaunchKernelGGL(trunk_fwd, dim3(grid), dim3(NWAVES * 64), LDS_BYTES, stream, a); }
#else
    a.ph_lo = 0; a.ph_hi = N_PHASES; a.li = 0;
    hipLaunchKernelGGL(trunk_fwd, dim3(grid), dim3(NWAVES * 64), LDS_BYTES, stream, a);
#endif
    const hipError_t le = hipPeekAtLastError();
    if (le != hipSuccess) fprintf(stderr, "kernel_launch: launch failed: %s\n", hipGetErrorName(le));
}
```

```cpp
#include <hip/hip_runtime.h>
#include <cstdio>
#include <cstdint>
#include <cmath>

#define LAS __attribute__((address_space(3)))
#define GAS __attribute__((address_space(1)))
typedef _Float16 h16;
typedef _Float16 half8 __attribute__((ext_vector_type(8)));
typedef _Float16 half4 __attribute__((ext_vector_type(4)));
typedef _Float16 half2v __attribute__((ext_vector_type(2)));
typedef float f32x4 __attribute__((ext_vector_type(4)));
typedef float f32x2 __attribute__((ext_vector_type(2)));
typedef float f32x16 __attribute__((ext_vector_type(16)));
typedef unsigned u32x4 __attribute__((ext_vector_type(4)));
typedef unsigned u32x2 __attribute__((ext_vector_type(2)));
typedef int v4i32 __attribute__((ext_vector_type(4)));
typedef int v8i32 __attribute__((ext_vector_type(8)));
typedef int v2i32 __attribute__((ext_vector_type(2)));

__device__ __forceinline__ unsigned pkh(float a, float b) { half2v v; v.x = (h16)a; v.y = (h16)b; return __builtin_bit_cast(unsigned, v); }

__device__ __forceinline__ unsigned pk8(float a, float b, float c, float d) { int w = __builtin_amdgcn_cvt_pk_fp8_f32(a, b, 0, false); w = __builtin_amdgcn_cvt_pk_fp8_f32(c, d, w, true); return (unsigned)w; }

constexpr int SEQ = 16384, NKV = 4, HD = 128;
namespace pg8 {
#define PG8_LAS __attribute__((address_space(3)))
constexpr int BM = 256, BK = 64, HALF = 128, HTB = HALF * BK * 2  , STAGE_BYTES = 8 * HTB, NXCD = 8, WGM = 8;

__host__ __device__ __forceinline__ int lds_byte(int r, int c) { const int st = (r >> 4) * 2 + (c >> 5), rr = r & 15, cc = c & 31, ob = rr * 64 + cc * 2; return st * 1024 + (ob ^ (((ob >> 9) & 1) << 5)); }
__host__ __device__ __forceinline__ void stage_rc(int b, int& R, int& C) { const int st = b / 1024, sb = b % 1024, swz = sb ^ (((sb >> 9) & 1) << 5); R = (st >> 1) * 16 + swz / 64; C = (st & 1) * 32 + (swz % 64) / 2; }
__host__ __device__ __forceinline__ int perm32(int rho) { const int n = rho >> 4, i = rho & 15; return 8 * (i >> 2) + 4 * n + (i & 3); }

struct Unit { int pm, pn; };
struct Gemm { const h16* A; const h16* Bt; int M, N, K, lda, kshift; };

struct StaticOrder {
    int nM, nN, nwg, G, c;
    __host__ __device__ void init(int M, int N, int G_, int c_) { nM = M / BM; nN = N / BM; nwg = nM * nN; G = G_; c = c_; }
    __host__ __device__ bool next(int i, Unit& u) const {
        const long L = (long)i * G + c; if (L >= nwg) return false;
        int wgid = (int)L; { const int q = nwg / NXCD, r = nwg % NXCD, xcd = wgid % NXCD, off = wgid / NXCD; wgid = (xcd < r ? xcd * (q + 1) : r * (q + 1) + (xcd - r) * q) + off; }
        const int nig = WGM * nN, gid = wgid / nig, fm = gid * WGM, gsz = (nM - fm) < WGM ? (nM - fm) : WGM;
        u.pm = fm + ((wgid % nig) % gsz); u.pn = (wgid % nig) / gsz; return true;
    }
    __device__ __forceinline__ void a_ready(const Unit&) const {}
    __device__ __forceinline__ void done(const Unit&) const {}
};

struct EpiF32 {
    static constexpr bool PERM = false, AFTER_DRAIN = false;
    float* C; int ldc; float scale;
    __device__ __forceinline__ void operator()(const f32x4 (&acc)[2][2][4][2], const Unit& u, int wr, int wc, int fr, int fq) const {
        const int row0 = u.pm * BM + wr * 64 + fr, col0 = u.pn * BM + wc * 32 + 4 * fq;
#pragma unroll
        for (int ai = 0; ai < 2; ++ai)
#pragma unroll
            for (int m = 0; m < 4; ++m) { float* rowp = C + (size_t)(row0 + ai * HALF + m * 16) * ldc + col0;
#pragma unroll
                for (int bj = 0; bj < 2; ++bj)
#pragma unroll
                    for (int n = 0; n < 2; ++n) *(f32x4*)(rowp + bj * HALF + n * 16) = acc[ai][bj][m][n] * scale; }
    }
};
struct EpiF32S {
    static constexpr bool PERM = false, AFTER_DRAIN = false;
    float* C; int ldc; float scale;
    __device__ __forceinline__ void operator()(const f32x4 (&acc)[2][2][4][2], const Unit& u, int wr, int wc, int fr_, int fq_) const {
        int l = (int)(threadIdx.x & 63u); asm volatile("" : "+v"(l)); const int fr = l & 15, fq = l >> 4;
        const int row0 = u.pm * BM + wr * 64 + fr, col0 = u.pn * BM + wc * 32 + 4 * fq;
#pragma unroll
        for (int ai = 0; ai < 2; ++ai)
#pragma unroll
            for (int m = 0; m < 4; ++m) { float* rowp = C + (size_t)(row0 + ai * HALF + m * 16) * ldc + col0;
#pragma unroll
                for (int bj = 0; bj < 2; ++bj)
#pragma unroll
                    for (int n = 0; n < 2; ++n) *(f32x4*)(rowp + bj * HALF + n * 16) = acc[ai][bj][m][n] * scale; }
    }
};
struct EpiH16 {
    static constexpr bool PERM = true, AFTER_DRAIN = false;
    h16* O; int ldc; float scale; const float* rs;
    __device__ __forceinline__ void operator()(const f32x4 (&acc)[2][2][4][2], const Unit& u, int wr, int wc, int fr, int fq) const {
        const int row0 = u.pm * BM + wr * 64 + fr, col0 = u.pn * BM + wc * 32 + 8 * fq;
#pragma unroll
        for (int ai = 0; ai < 2; ++ai)
#pragma unroll
            for (int m = 0; m < 4; ++m) { h16* rowp = O + (size_t)(row0 + ai * HALF + m * 16) * ldc + col0; const float sc_ = rs ? scale * rs[row0 + ai * HALF + m * 16] : scale;
#pragma unroll
                for (int bj = 0; bj < 2; ++bj) { const f32x4 v0 = acc[ai][bj][m][0] * sc_, v1 = acc[ai][bj][m][1] * sc_;
                    u32x4 w; w.x = pkh(v0[0], v0[1]); w.y = pkh(v0[2], v0[3]); w.z = pkh(v1[0], v1[1]); w.w = pkh(v1[2], v1[3]);
                    *(u32x4*)(rowp + bj * HALF) = w; } }
    }
};
__device__ __forceinline__ float silu_mul(float g, float u) { return g * u * __builtin_amdgcn_rcpf(1.0f + __builtin_amdgcn_exp2f(g * -1.44269504089f)); }
struct EpiSwiGLU {
    static constexpr bool PERM = true, AFTER_DRAIN = false;
    h16* O; int ldc;
    __device__ __forceinline__ void operator()(const f32x4 (&acc)[2][2][4][2], const Unit& u, int wr, int wc, int fr, int fq) const {
        const int row0 = u.pm * BM + wr * 64 + fr, col0 = u.pn * HALF + wc * 32 + 8 * fq;
#pragma unroll
        for (int ai = 0; ai < 2; ++ai)
#pragma unroll
            for (int m = 0; m < 4; ++m) { h16* rowp = O + (size_t)(row0 + ai * HALF + m * 16) * ldc + col0;
                const f32x4 g0 = acc[ai][0][m][0], g1 = acc[ai][0][m][1], u0 = acc[ai][1][m][0], u1 = acc[ai][1][m][1];
                u32x4 w; w.x = pkh(silu_mul(g0[0], u0[0]), silu_mul(g0[1], u0[1])); w.y = pkh(silu_mul(g0[2], u0[2]), silu_mul(g0[3], u0[3]));
                w.z = pkh(silu_mul(g1[0], u1[0]), silu_mul(g1[1], u1[1])); w.w = pkh(silu_mul(g1[2], u1[2]), silu_mul(g1[3], u1[3]));
                *(u32x4*)rowp = w; }
    }
};
struct EpiSwiGLU8 {
    static constexpr bool PERM = true, AFTER_DRAIN = false;
    unsigned char* O; int ldc; float inscale, outscale; const float* rs;
    __device__ __forceinline__ void operator()(const f32x4 (&acc)[2][2][4][2], const Unit& u, int wr, int wc, int fr_, int fq_) const {
        int l = (int)(threadIdx.x & 63u); asm volatile("" : "+v"(l)); const int fr = l & 15, fq = l >> 4;
        const int row0 = u.pm * BM + wr * 64 + fr, col0 = u.pn * HALF + wc * 32 + 8 * fq;
#pragma unroll
        for (int ai = 0; ai < 2; ++ai)
#pragma unroll
            for (int m = 0; m < 4; ++m) { unsigned char* rowp = O + (size_t)(row0 + ai * HALF + m * 16) * ldc + col0;
                const float is_ = rs ? inscale * rs[row0 + ai * HALF + m * 16] : inscale;
                const f32x4 g0 = acc[ai][0][m][0] * is_, g1 = acc[ai][0][m][1] * is_, u0 = acc[ai][1][m][0] * (is_ * outscale), u1 = acc[ai][1][m][1] * (is_ * outscale);
                u32x2 w; w.x = pk8(silu_mul(g0[0], u0[0]), silu_mul(g0[1], u0[1]), silu_mul(g0[2], u0[2]), silu_mul(g0[3], u0[3]));
                w.y = pk8(silu_mul(g1[0], u1[0]), silu_mul(g1[1], u1[1]), silu_mul(g1[2], u1[2]), silu_mul(g1[3], u1[3]));
                *(u32x2*)rowp = w; }
    }
};
struct EpiInProj {
    static constexpr bool PERM = true, AFTER_DRAIN = false;
    h16 *Q, *KV, *IQ, *IK; float* IW; const float* rope; float scale; const float* rs;
    __device__ __forceinline__ void operator()(const f32x4 (&acc)[2][2][4][2], const Unit& u, int wr, int wc, int fr_, int fq_) const {
        int l = (int)(threadIdx.x & 63u); asm volatile("" : "+v"(l));
        const int fr = l & 15, fq = l >> 4;
        const int pn = u.pn, row0 = u.pm * BM + wr * 64 + fr;
        h16* base; int ldc, colt; bool rot0 = true, rot1 = true;
        if (pn < 8) { base = Q; ldc = 2048; colt = pn * 256; }
        else if (pn < 10) { base = KV; ldc = 1024; colt = (pn - 8) * 256; }
        else if (pn < 12) { base = KV; ldc = 1024; colt = 512 + (pn - 10) * 256; rot0 = false; rot1 = false; }
        else if (pn < 20) { base = IQ; ldc = 2048; colt = (pn - 12) * 256; }
        else { base = IK; ldc = 128; colt = 0; rot1 = false; }
        const int col0 = colt + wc * 32 + 8 * fq;
#pragma unroll
        for (int ai = 0; ai < 2; ++ai)
#pragma unroll
            for (int m = 0; m < 4; ++m) { const int row = row0 + ai * HALF + m * 16;
                f32x4 cs[2], sn[2];
                if (wc == 0) { const float* rp = rope + (size_t)row * 32 + 8 * (fq & 1);
                    cs[0] = *(const f32x4*)(rp); cs[1] = *(const f32x4*)(rp + 4); sn[0] = *(const f32x4*)(rp + 16); sn[1] = *(const f32x4*)(rp + 20);
                    if (fq < 2) { sn[0] = -sn[0]; sn[1] = -sn[1]; } }
#pragma unroll
                for (int bj = 0; bj < 2; ++bj) {
                    const float sc_ = scale * rs[row];
                    f32x4 v0 = acc[ai][bj][m][0] * sc_, v1 = acc[ai][bj][m][1] * sc_;
                    if (wc == 0 && (bj == 0 ? rot0 : rot1)) {
                        f32x4 p0, p1;
#pragma unroll
                        for (int e = 0; e < 4; ++e) { p0[e] = __shfl_xor(v0[e], 32); p1[e] = __shfl_xor(v1[e], 32); }
                        v0 = v0 * cs[0] + p0 * sn[0]; v1 = v1 * cs[1] + p1 * sn[1];
                    }
                    if (pn >= 8 && pn < 12) {
                        const int j = ((pn - 8) & 1) * 2 + bj, b = row / SEQ, tt = row % SEQ;
                        unsigned char* dst = (unsigned char*)KV + (pn >= 10 ? (size_t)16 * 1024 * 1024 : (size_t)0) + ((size_t)(b * NKV + j) * SEQ + tt) * HD + wc * 32 + 8 * fq;
                        u32x2 w; w.x = pk8(v0[0], v0[1], v0[2], v0[3]); w.y = pk8(v1[0], v1[1], v1[2], v1[3]); *(u32x2*)dst = w;
                    } else if (pn == 20 && bj == 1) {
                        if (wc == 0 && fq < 2) { float* wp = IW + (size_t)row * 16 + 8 * fq; *(f32x4*)wp = v0; *(f32x4*)(wp + 4) = v1; }
                    } else {
                        u32x4 w; w.x = pkh(v0[0], v0[1]); w.y = pkh(v0[2], v0[3]); w.z = pkh(v1[0], v1[1]); w.w = pkh(v1[2], v1[3]);
                        *(u32x4*)(base + (size_t)row * ldc + col0 + bj * HALF) = w;
                    }
                }
                asm volatile("" ::: "memory"); }
    }
};

template <class Epi, class Sched, bool ALIGN_EPI = false, bool SP2 = false, bool FP8 = false>
__device__ __forceinline__ void gemm_phase(PG8_LAS unsigned char* lds, const Gemm g, const Sched& S, const Epi& E) {
    int tid_ = (int)threadIdx.x; asm volatile("" : "+v"(tid_));
    const int tid = tid_, wid = __builtin_amdgcn_readfirstlane(tid >> 6), lane = tid & 63, wr = wid >> 2, wc = wid & 3, fr = lane & 15, fq = lane >> 4;
    const int K = g.K, nt = K / BK;
    unsigned voffA[2], voffB[2];
#pragma unroll
    for (int i = 0; i < 2; ++i) { int R, C; stage_rc(tid * 16 + i * 8192, R, C); const int Rb = Epi::PERM ? ((R & ~31) + perm32(R & 31)) : R;
        voffA[i] = (unsigned)(R * g.lda + C) * 2u; voffB[i] = (unsigned)(Rb * K + C) * 2u; }
    const size_t kstep = (size_t)(BK * 2);
    const size_t hstepA = (size_t)HALF * g.lda * 2, hstepB = (size_t)HALF * K * 2;
    const size_t tstepA = 2 * hstepA, tstepB = 2 * hstepB;
    const int kshift = g.kshift;
    const __amdgpu_buffer_rsrc_t rsrcA = __builtin_amdgcn_make_buffer_rsrc((void*)g.A, 0, 0x7fffffff, 0x00020000), rsrcB = __builtin_amdgcn_make_buffer_rsrc((void*)g.Bt, 0, 0x7fffffff, 0x00020000);
    const unsigned r64A = 64u * (unsigned)g.lda * 2u, r64B = 64u * (unsigned)K * 2u;
    const unsigned ldsw = (unsigned)wid * 1024u;
    const int aoff = lds_byte(wr * 64 + fr, fq * 8), boff = lds_byte(wc * 32 + fr, fq * 8);
#define PG8_SA(b, h) (((b) * 2 + (h)) * HTB)
#define PG8_SB(b, h) ((4 + (b) * 2 + (h)) * HTB)
#define PG8_STAGE(bufoff, gbase, voff) do { const bool isA_ = (const void*)(voff) == (const void*)voffA; _Pragma("unroll") for (int _i = 0; _i < 2; ++_i) \
        __builtin_amdgcn_raw_ptr_buffer_load_lds(isA_ ? rsrcA : rsrcB, (PG8_LAS void*)(lds + (bufoff) + ldsw + _i * 8192), 16, (int)(voff)[0], \
            (int)((unsigned)((const char*)(gbase) - (isA_ ? (const char*)g.A : (const char*)g.Bt)) + (unsigned)_i * (isA_ ? r64A : r64B)), 0, 0); } while (0)
#define PG8_LDA(dst, b, h) do { if constexpr (FP8) { _Pragma("unroll") for (int m = 0; m < 4; ++m) dst##8[m] = __builtin_shufflevector(*(const PG8_LAS v4i32*)(lds + PG8_SA(b, h) + aoff + m * 2048), *(const PG8_LAS v4i32*)(lds + PG8_SA(b, h) + aoff + m * 2048 + 1024), 0, 1, 2, 3, 4, 5, 6, 7); } \
    else { _Pragma("unroll") for (int m = 0; m < 4; ++m) _Pragma("unroll") for (int k = 0; k < 2; ++k) dst[m][k] = *(const PG8_LAS half8*)(lds + PG8_SA(b, h) + aoff + m * 2048 + k * 1024); } } while (0)
#define PG8_LDB(dst, b, h) do { if constexpr (FP8) { _Pragma("unroll") for (int n = 0; n < 2; ++n) dst##8[n] = __builtin_shufflevector(*(const PG8_LAS v4i32*)(lds + PG8_SB(b, h) + boff + n * 2048), *(const PG8_LAS v4i32*)(lds + PG8_SB(b, h) + boff + n * 2048 + 1024), 0, 1, 2, 3, 4, 5, 6, 7); } \
    else { _Pragma("unroll") for (int n = 0; n < 2; ++n) _Pragma("unroll") for (int k = 0; k < 2; ++k) dst[n][k] = *(const PG8_LAS half8*)(lds + PG8_SB(b, h) + boff + n * 2048 + k * 1024); } } while (0)
#define PG8_MMA(ai, bj, At, Bt) do { __builtin_amdgcn_s_setprio(1); _Pragma("unroll") for (int m = 0; m < 4; ++m) _Pragma("unroll") for (int n = 0; n < 2; ++n) { \
        if constexpr (FP8) asm volatile("v_mfma_f32_16x16x128_f8f6f4 %0, %1, %2, %0" : "+v"(acc[ai][bj][m][n]) : "v"(Bt##8[n]), "v"(At##8[m]));     \
        else { _Pragma("unroll") for (int k = 0; k < 2; ++k) acc[ai][bj][m][n] = __builtin_amdgcn_mfma_f32_16x16x32_f16(Bt[n][k], At[m][k], acc[ai][bj][m][n], 0, 0, 0); } } \
        __builtin_amdgcn_s_setprio(0); } while (0)
#define PG8_WAIT_V(n) asm volatile("s_waitcnt vmcnt(" #n ")" ::: "memory")
#define PG8_WAIT_L(n) asm volatile("s_waitcnt lgkmcnt(" #n ")" ::: "memory")
#define PG8_BAR __builtin_amdgcn_s_barrier()
#define PG8_SCHED __builtin_amdgcn_sched_barrier(0)
    Unit cur, nxt; int ui = 0;
    if (!S.next(0, cur)) return;
    f32x4 acc[2][2][4][2];
#pragma unroll
    for (int a = 0; a < 2; ++a)
#pragma unroll
        for (int b = 0; b < 2; ++b)
#pragma unroll
            for (int m = 0; m < 4; ++m)
#pragma unroll
                for (int n = 0; n < 2; ++n) acc[a][b][m][n] = (f32x4){0.f, 0.f, 0.f, 0.f};
    half8 At[4][2], B0[2][2], B1[2][2]; v8i32 At8[4], B08[2], B18[2];
    const char* cA = (const char*)g.A + (size_t)cur.pm * tstepA + (size_t)((cur.pn >> kshift) * K) * 2; const char* cB = (const char*)g.Bt + (size_t)cur.pn * tstepB;
    S.a_ready(cur);
    if constexpr (SP2) {
        PG8_STAGE(PG8_SB(0, 0), cB, voffB); PG8_STAGE(PG8_SB(0, 1), cB + hstepB, voffB); PG8_STAGE(PG8_SA(0, 0), cA, voffA); PG8_STAGE(PG8_SA(0, 1), cA + hstepA, voffA);
        if (wr == 1) PG8_BAR;
        PG8_WAIT_V(2); PG8_BAR;
        PG8_STAGE(PG8_SB(1, 0), cB + kstep, voffB); PG8_STAGE(PG8_SA(1, 0), cA + kstep, voffA); PG8_STAGE(PG8_SB(1, 1), cB + hstepB + kstep, voffB);
        PG8_WAIT_V(6); PG8_BAR;
    } else {
        PG8_STAGE(PG8_SB(0, 0), cB, voffB); PG8_STAGE(PG8_SA(0, 0), cA, voffA); PG8_STAGE(PG8_SB(0, 1), cB + hstepB, voffB); PG8_STAGE(PG8_SA(0, 1), cA + hstepA, voffA);
        if (wr == 1) PG8_BAR;
        PG8_WAIT_V(4); PG8_BAR;
        PG8_STAGE(PG8_SB(1, 0), cB + kstep, voffB); PG8_STAGE(PG8_SA(1, 0), cA + kstep, voffA); PG8_STAGE(PG8_SB(1, 1), cB + hstepB + kstep, voffB);
        PG8_WAIT_V(6); PG8_BAR;
    }
    for (;;) {
        const bool has_next = S.next(ui + 1, nxt);
        const char* nA = has_next ? (const char*)g.A + (size_t)nxt.pm * tstepA + (size_t)((nxt.pn >> kshift) * K) * 2 : cA; const char* nB = has_next ? (const char*)g.Bt + (size_t)nxt.pn * tstepB : cB;
        for (int t = 0; t < nt; t += 2) {
            const bool last = (t == nt - 2);
            const char* a1 = cA + (size_t)(t + 1) * kstep;
            const char* a2 = last ? nA : cA + (size_t)(t + 2) * kstep; const char* b2 = last ? nB : cB + (size_t)(t + 2) * kstep;
            const char* a3 = a2 + kstep; const char* b3 = b2 + kstep;
            if (last && has_next) S.a_ready(nxt);
            if constexpr (SP2) {
            PG8_LDB(B0, 0, 0); PG8_LDB(B1, 0, 1); PG8_SCHED; PG8_LDA(At, 0, 0); PG8_STAGE(PG8_SA(1, 1), a1 + hstepA, voffA);
            PG8_WAIT_V(8); PG8_WAIT_L(0); PG8_BAR; PG8_MMA(0, 0, At, B0); PG8_MMA(0, 1, At, B1); PG8_BAR; PG8_SCHED;
            PG8_LDA(At, 0, 1); PG8_STAGE(PG8_SB(0, 0), b2, voffB); PG8_STAGE(PG8_SB(0, 1), b2 + hstepB, voffB); PG8_STAGE(PG8_SA(0, 0), a2, voffA);
            PG8_WAIT_V(8); PG8_WAIT_L(0); PG8_BAR; PG8_MMA(1, 0, At, B0); PG8_MMA(1, 1, At, B1); PG8_BAR; PG8_SCHED;
            PG8_LDB(B0, 1, 0); PG8_LDB(B1, 1, 1); PG8_SCHED; PG8_LDA(At, 1, 0); PG8_STAGE(PG8_SA(0, 1), a2 + hstepA, voffA);
            PG8_WAIT_V(8); PG8_WAIT_L(0); PG8_BAR; PG8_MMA(0, 0, At, B0); PG8_MMA(0, 1, At, B1); PG8_BAR; PG8_SCHED;
            PG8_LDA(At, 1, 1); PG8_STAGE(PG8_SB(1, 0), b3, voffB); PG8_STAGE(PG8_SB(1, 1), b3 + hstepB, voffB); PG8_STAGE(PG8_SA(1, 0), a3, voffA);
            PG8_WAIT_V(8); PG8_WAIT_L(0); PG8_BAR; PG8_MMA(1, 0, At, B0); PG8_MMA(1, 1, At, B1); PG8_BAR; PG8_SCHED;
            } else {
            PG8_LDB(B0, 0, 0); PG8_SCHED; PG8_LDA(At, 0, 0); PG8_STAGE(PG8_SA(1, 1), a1 + hstepA, voffA);
            PG8_WAIT_L(8); PG8_BAR; PG8_WAIT_L(0); PG8_MMA(0, 0, At, B0); PG8_BAR; PG8_SCHED;
            PG8_LDB(B1, 0, 1); PG8_STAGE(PG8_SB(0, 0), b2, voffB);
            PG8_BAR; PG8_WAIT_L(0); PG8_MMA(0, 1, At, B1); PG8_BAR;
            PG8_LDA(At, 0, 1); PG8_STAGE(PG8_SA(0, 0), a2, voffA);
            PG8_BAR; PG8_WAIT_L(0); PG8_MMA(1, 0, At, B0); PG8_BAR; PG8_SCHED;
            PG8_STAGE(PG8_SB(0, 1), b2 + hstepB, voffB);
            PG8_WAIT_V(6); PG8_BAR; PG8_MMA(1, 1, At, B1); PG8_BAR;
            PG8_LDB(B0, 1, 0); PG8_SCHED; PG8_LDA(At, 1, 0); PG8_STAGE(PG8_SA(0, 1), a2 + hstepA, voffA);
            PG8_WAIT_L(8); PG8_BAR; PG8_WAIT_L(0); PG8_MMA(0, 0, At, B0); PG8_BAR; PG8_SCHED;
            PG8_LDB(B1, 1, 1); PG8_STAGE(PG8_SB(1, 0), b3, voffB);
            PG8_BAR; PG8_WAIT_L(0); PG8_MMA(0, 1, At, B1); PG8_BAR;
            PG8_LDA(At, 1, 1); PG8_STAGE(PG8_SA(1, 0), a3, voffA);
            PG8_BAR; PG8_WAIT_L(0); PG8_MMA(1, 0, At, B0); PG8_BAR; PG8_SCHED;
            PG8_STAGE(PG8_SB(1, 1), b3 + hstepB, voffB);
            PG8_WAIT_V(6); PG8_BAR; PG8_MMA(1, 1, At, B1); PG8_BAR;
            }
        }
        if constexpr (FP8) { asm volatile("s_nop 15\n\ts_nop 15\n\ts_nop 15\n\ts_nop 15" ::: "memory"); __builtin_amdgcn_sched_barrier(0); }
        if constexpr (ALIGN_EPI) { if (wr == 0) PG8_BAR; }
        if constexpr (!Epi::AFTER_DRAIN) { E(acc, cur, wr, wc, fr, fq); S.done(cur); }
        if (!has_next) break;
#pragma unroll
        for (int a = 0; a < 2; ++a)
#pragma unroll
            for (int b = 0; b < 2; ++b)
#pragma unroll
                for (int m = 0; m < 4; ++m)
#pragma unroll
                    for (int n = 0; n < 2; ++n) acc[a][b][m][n] = (f32x4){0.f, 0.f, 0.f, 0.f};
        cur = nxt; cA = nA; cB = nB; ++ui;
        if constexpr (ALIGN_EPI) { if (wr == 1) PG8_BAR; }
    }
    PG8_WAIT_V(0);
    if constexpr (!ALIGN_EPI) { if (wr == 0) PG8_BAR; }
    PG8_BAR;

#undef PG8_SA
#undef PG8_SB
#undef PG8_STAGE
#undef PG8_LDA
#undef PG8_LDB
#undef PG8_MMA
#undef PG8_WAIT_V
#undef PG8_WAIT_L
#undef PG8_BAR
#undef PG8_SCHED
}
}

constexpr int NB = 2, T = NB * SEQ, D = 2048, DFF = 5632, NMEM = 256;
constexpr int DSA_N = 5264, DSA_NP = 5376;
constexpr int NHEAD = 16, TOPK = 256;
constexpr int XW = 512;
constexpr float NORM_EPS = 1e-6f;
constexpr int NWAVES = 8;
#ifndef FFN_FP8
#define FFN_FP8 2
#endif
#ifndef DN_FP8
#define DN_FP8 3
#endif
#ifndef IDX_PROBE_MMA
#define IDX_PROBE_MMA 0
#endif
#ifndef MK_LAUNCH_PER_PHASE
#define MK_LAUNCH_PER_PHASE 0
#endif

constexpr size_t MiB = 1u << 20;
constexpr size_t WS_CTL = 0, CTL_ZERO_BYTES = 1 * MiB;
constexpr size_t WS_ROPE = 1 * MiB;
constexpr size_t WS_MEMN = 5 * MiB;
constexpr size_t WS_KVM = 7 * MiB;
constexpr size_t WS_WPOOL = 9 * MiB;
constexpr size_t WS_WIN = 11 * MiB;
constexpr size_t WS_WOUT = 32 * MiB;
constexpr size_t WS_WQ = 40 * MiB;
constexpr size_t WS_WKV = 44 * MiB;
constexpr size_t WS_WO = 52 * MiB;
constexpr size_t WS_WGU = 56 * MiB;
constexpr size_t WS_WDN = 144 * MiB;
constexpr size_t WS_XQ = 188 * MiB;
constexpr size_t WS_A = 220 * MiB;
constexpr size_t WS_Y = 348 * MiB;
constexpr size_t WS_ACT = 604 * MiB;
constexpr size_t WS_END = 956 * MiB;
constexpr size_t WS_Q = WS_ACT, WS_KV = WS_ACT + 128 * MiB, WS_IQ = WS_ACT + 192 * MiB, WS_IK = WS_ACT + 320 * MiB, WS_IW = WS_ACT + 328 * MiB, WS_IDX = WS_ACT + 330 * MiB;
constexpr size_t WS_LISTS = WS_Y;
constexpr size_t WS_H = WS_Y + 128 * MiB;
constexpr int LIST_CAP = 1024;
static_assert(WS_IDX + (size_t)T * TOPK * 2 <= WS_END, "ws map");
constexpr float W8_SCALE = 64.0f, ACT8_SCALE = 8.0f;
constexpr int CW_BAR = 4096;

constexpr int RING_OFF = 0, RING_BYTES = 136192;
constexpr int MISC_OFF = RING_BYTES;
constexpr int LDS_BYTES = 147456;

typedef GAS unsigned gu32;
#define LDS_WAIT() asm volatile("s_waitcnt lgkmcnt(0)" ::: "memory")
#define VM_WAIT() asm volatile("s_waitcnt vmcnt(0)" ::: "memory")

#define XB_TMO      128
#define XB_XCNT(j)  (256  + 64 * (j))
#define XB_XSUB(j)  (1280 + 64 * (j))
#define XB_XGEN(j)  (2304 + 64 * (j))
#define XB_TOP      3328
#define XB_TOPGEN   3392
#define XCD_BAR_WORDS 3456
#define XB_SPIN_CAP (1u << 23)
__device__ __forceinline__ unsigned xb_ld(unsigned* p)              { return __hip_atomic_load(p, __ATOMIC_RELAXED, __HIP_MEMORY_SCOPE_AGENT); }
__device__ __forceinline__ unsigned xb_add(unsigned* p, unsigned v) { return __hip_atomic_fetch_add(p, v, __ATOMIC_RELAXED, __HIP_MEMORY_SCOPE_AGENT); }
__device__ __forceinline__ unsigned xb_xcc_id() { return (unsigned)__builtin_amdgcn_s_getreg((3 << 11) | 20) & 0xFu; }
#define XB_SPIN(cond, bar) do { unsigned _sp = 0; while (cond) { __builtin_amdgcn_s_sleep(1); \
    if ((++_sp & 255u) == 0u) { if (xb_ld(&(bar)[XB_TMO])) break; if (_sp > XB_SPIN_CAP) { atomicAdd(&(bar)[XB_TMO], 1u); break; } } } } while (0)
struct XcdBarrier { unsigned* bar; unsigned x; volatile LAS unsigned* st; };
__device__ __forceinline__ XcdBarrier xcd_barrier_post(unsigned* bar, volatile LAS unsigned* st) {
    XcdBarrier b; b.bar = bar; b.x = xb_xcc_id(); b.st = st;
    if (threadIdx.x == 0) (void)xb_add(&bar[XB_XCNT(b.x)], 1u);
    return b;
}
__device__ __forceinline__ void xcd_barrier_complete(unsigned* bar, unsigned x, unsigned& nloc, unsigned& nx) {
    const unsigned G = gridDim.x * gridDim.y * gridDim.z;
    unsigned sum, cnt, mine, sp = 0u;
    for (;;) {
        sum = 0u; cnt = 0u; mine = 0u;
#pragma unroll
        for (unsigned j = 0; j < 16; ++j) { const unsigned c = xb_ld(&bar[XB_XCNT(j)]); sum += c; cnt += (c > 0u) ? 1u : 0u; mine = (j == x) ? c : mine; }
        if (sum == G) break;
        __builtin_amdgcn_s_sleep(1);
        if ((++sp & 255u) == 0u) { if (xb_ld(&bar[XB_TMO])) break; if (sp > XB_SPIN_CAP) { atomicAdd(&bar[XB_TMO], 1u); break; } }
    }
    nloc = mine > 0u ? mine : 1u; nx = cnt > 0u ? cnt : 1u;
}
__device__ __forceinline__ void xcd_barrier(const XcdBarrier& b) {
    asm volatile("s_waitcnt vmcnt(0)" ::: "memory");
    __syncthreads();
    if (threadIdx.x == 0) {
        unsigned* bar = b.bar;
        __builtin_amdgcn_s_waitcnt(0);
        unsigned nloc = b.st[0], nx = b.st[1];
        if (nloc == 0u) { xcd_barrier_complete(bar, b.x, nloc, nx); b.st[0] = nloc; b.st[1] = nx; }
        const unsigned old = xb_add(&bar[XB_XSUB(b.x)], 1u);
        const unsigned gen = old / nloc;
        if (old + 1u == (gen + 1u) * nloc) {
            __builtin_amdgcn_fence(__ATOMIC_RELEASE, "agent");
            asm volatile("s_waitcnt vmcnt(0)" ::: "memory");
            const unsigned og = xb_add(&bar[XB_TOP], 1u);
            const unsigned tg = og / nx;
            if (og + 1u == (tg + 1u) * nx) xb_add(&bar[XB_TOPGEN], 1u);
            else XB_SPIN(xb_ld(&bar[XB_TOPGEN]) == tg, bar);
            __builtin_amdgcn_fence(__ATOMIC_ACQUIRE, "agent");
            xb_add(&bar[XB_XGEN(b.x)], 1u);
            asm volatile("s_waitcnt vmcnt(0)" ::: "memory");
        } else {
            XB_SPIN(xb_ld(&bar[XB_XGEN(b.x)]) == gen, bar);
            __builtin_amdgcn_fence(__ATOMIC_ACQUIRE, "agent");
            asm volatile("s_waitcnt vmcnt(0)" ::: "memory");
        }
    }
    __syncthreads();
}

struct Frame {
    LAS unsigned char* lds;
    volatile LAS unsigned* MISC;
    int tid, lane, wave;
    int vcu, G;
};
__device__ __forceinline__ Frame fresh(const Frame& F0) { Frame F = F0; int t = (int)threadIdx.x; asm volatile("" : "+v"(t)); F.tid = t; F.lane = t & 63; F.wave = __builtin_amdgcn_readfirstlane(t >> 6); return F; }
template <int CTRL> __device__ __forceinline__ float dpp_mov(float v) { return __builtin_bit_cast(float, __builtin_amdgcn_update_dpp(0, __builtin_bit_cast(int, v), CTRL, 0xF, 0xF, true)); }
__device__ __forceinline__ float wave_sum_dpp(float v) {
    v += dpp_mov<0xB1>(v);
    v += dpp_mov<0x4E>(v);
    v += dpp_mov<0x141>(v);
    v += dpp_mov<0x140>(v);
    const float s0 = __builtin_bit_cast(float, __builtin_amdgcn_readlane(__builtin_bit_cast(int, v), 0)), s1 = __builtin_bit_cast(float, __builtin_amdgcn_readlane(__builtin_bit_cast(int, v), 16));
    const float s2 = __builtin_bit_cast(float, __builtin_amdgcn_readlane(__builtin_bit_cast(int, v), 32)), s3 = __builtin_bit_cast(float, __builtin_amdgcn_readlane(__builtin_bit_cast(int, v), 48));
    return (s0 + s1) + (s2 + s3);
}
__device__ __forceinline__ float wave_max_dpp(float v) {
    v = fmaxf(v, dpp_mov<0xB1>(v)); v = fmaxf(v, dpp_mov<0x4E>(v)); v = fmaxf(v, dpp_mov<0x141>(v)); v = fmaxf(v, dpp_mov<0x140>(v));
    const float s0 = __builtin_bit_cast(float, __builtin_amdgcn_readlane(__builtin_bit_cast(int, v), 0)), s1 = __builtin_bit_cast(float, __builtin_amdgcn_readlane(__builtin_bit_cast(int, v), 16));
    const float s2 = __builtin_bit_cast(float, __builtin_amdgcn_readlane(__builtin_bit_cast(int, v), 32)), s3 = __builtin_bit_cast(float, __builtin_amdgcn_readlane(__builtin_bit_cast(int, v), 48));
    return fmaxf(fmaxf(s0, s1), fmaxf(s2, s3));
}
__device__ __forceinline__ float wave_sum(float v) {
#pragma unroll
    for (int o = 1; o < 64; o <<= 1) v += __shfl_xor(v, o);
    return v;
}
__device__ __forceinline__ float rstd_of(float sumsq) { return 1.0f / sqrtf(sumsq * (1.0f / D) + NORM_EPS); }

__device__ __forceinline__ void transpose_item(const float* W, int ldw, int K, int k0, int scol, int nvalid, h16* WT, int drow, float scale, const float* colscale, const float* kscale, bool f8, LAS float* scr, int lane) {
    const int cn = scol + (lane & 31); const bool okc = cn < nvalid;
    float wv[32];
#pragma unroll
    for (int i = 0; i < 32; ++i) { const int kk = 2 * i + (lane >> 5); wv[i] = W[(size_t)(k0 + kk) * ldw + (okc ? cn : 0)]; }
#pragma unroll
    for (int i = 0; i < 32; ++i) { const int kk = 2 * i + (lane >> 5); scr[kk * 33 + (lane & 31)] = okc ? (kscale ? wv[i] * kscale[k0 + kk] : wv[i]) : 0.f; }
    LDS_WAIT(); asm volatile("" ::: "memory");
    const int c = lane & 7;
#pragma unroll
    for (int j = 0; j < 4; ++j) { const int n = (lane >> 3) + 8 * j; const LAS float* s = scr + (8 * c) * 33 + n;
        float sc = scale; if (colscale) sc *= colscale[scol + n];
        if (f8) { u32x2 o; o.x = pk8(s[0 * 33] * sc, s[1 * 33] * sc, s[2 * 33] * sc, s[3 * 33] * sc); o.y = pk8(s[4 * 33] * sc, s[5 * 33] * sc, s[6 * 33] * sc, s[7 * 33] * sc);
            *(GAS u32x2*)((unsigned char*)WT + (size_t)(drow + n) * K + k0 + 8 * c) = o; }
        else { u32x4 o; o.x = pkh(s[0 * 33] * sc, s[1 * 33] * sc); o.y = pkh(s[2 * 33] * sc, s[3 * 33] * sc); o.z = pkh(s[4 * 33] * sc, s[5 * 33] * sc); o.w = pkh(s[6 * 33] * sc, s[7 * 33] * sc);
            *(GAS u32x4*)(WT + (size_t)(drow + n) * K + k0 + 8 * c) = o; } }
    LDS_WAIT(); asm volatile("" ::: "memory");
}
struct TJob { const float* W; h16* WT; const float* colscale; int ldw, K, nrows, nvalid, mode; float scale; const float* kscale; };
__device__ __forceinline__ int tjob_items(const TJob& j) { return (j.K / 64) * (j.nrows / 32); }
__device__ __forceinline__ void tjob_run(const TJob& j, int item, LAS float* scr, int lane) {
    const int nblk = j.nrows / 32, kb = item / nblk, r = 32 * (item % nblk);
    const int scol = (j.mode & 1) ? ((r >> 7) & 1) * DFF + 128 * (r >> 8) + (r & 127) : r;
    transpose_item(j.W, j.ldw, j.K, 64 * kb, scol, j.nvalid, j.WT, r, j.scale, j.colscale, j.kscale, (j.mode & 2) != 0, scr, lane);
}

struct Args {
    const float* x; const float* mem; const int* pos; const float* gains; const float* mem_norm; const float* pool_w; const float* pool_scale;
    const float* w_in; const float* w_out; const float* wq; const float* wkv; const float* wo; const float* wgu; const float* wdn;
    float* out; unsigned char* ws;
    float inv_freq[16];
    int ph_lo, ph_hi, li, pad;
};

#define CAS __attribute__((address_space(4)))
typedef const CAS Args* ArgP;
__device__ __forceinline__ ArgP argp() { unsigned long long p = (unsigned long long)__builtin_amdgcn_kernarg_segment_ptr(); asm volatile("" : "+s"(p)); return (ArgP)p; }

__device__ __forceinline__ void rope_entry(ArgP a, float* rope, int idx) {
    const int m = idx >> 4, i = idx & 15;
    const float angf = (float)a->pos[m] * a->inv_freq[i];
    const double ang = (double)angf;
    const double TWO_PI = 6.283185307179586476925286766559, INV_2PI = 0.15915494309189533576888376337251;
    const double k = __builtin_rint(ang * INV_2PI);
    const double r = ang - k * TWO_PI;
    const double r2 = r * r;
    double c = 1.0, s = 1.0, tc = 1.0, ts = 1.0;
#pragma unroll
    for (int n = 1; n <= 13; ++n) { tc *= -r2 / (double)((2 * n - 1) * (2 * n)); ts *= -r2 / (double)((2 * n) * (2 * n + 1)); c += tc; s += ts; }
    rope[(size_t)m * 32 + i] = (float)c; rope[(size_t)m * 32 + 16 + i] = (float)(s * r);
}
__device__ __forceinline__ void norm_row_to_h16(const float* xrow, const float* gain, h16* orow, int lane) {
    const f32x4* xr = (const f32x4*)xrow + lane; const f32x4* gr = (const f32x4*)gain + lane;
    f32x4 v[8]; float s = 0.f;
#pragma unroll
    for (int j = 0; j < 8; ++j) { v[j] = xr[64 * j]; s += (v[j].x * v[j].x + v[j].y * v[j].y) + (v[j].z * v[j].z + v[j].w * v[j].w); }
    const float r = rstd_of(wave_sum_dpp(s));
    u32x2* o8 = (u32x2*)orow + lane;
#pragma unroll
    for (int j = 0; j < 8; ++j) { const f32x4 g = gr[64 * j], y = v[j] * r * g; u32x2 w; w.x = pkh(y.x, y.y); w.y = pkh(y.z, y.w); o8[64 * j] = w; }
}
__device__ __forceinline__ void pool_pre(Frame& F0, const float* x, const float* g0, h16* P) {
    Frame F = fresh(F0);
    LAS float* rs = (LAS float*)(F.lds + RING_OFF);
    for (int u = F.vcu; u < T / 64; u += F.G) {
        const int b = u / (SEQ / 64), t0 = 64 * (u % (SEQ / 64));
        const float* xb = x + (size_t)b * SEQ * D;
        for (int r = F.wave; r < 79; r += NWAVES) { const int t = t0 - 15 + r;
            if (t >= 0) { const f32x4* xr = (const f32x4*)(xb + (size_t)t * D) + F.lane; float s = 0.f;
#pragma unroll
                for (int j = 0; j < 8; ++j) { const f32x4 v = xr[64 * j]; s += (v.x * v.x + v.y * v.y) + (v.z * v.z + v.w * v.w); }
                s = rstd_of(wave_sum_dpp(s)); if (F.lane == 0) rs[r] = s; } }
        __syncthreads();
        {
            const int c0 = 4 * F.tid, w = 2 << (F.tid >> 7);
            const f32x4 g = *(const f32x4*)(g0 + c0);
            const int ts = (t0 - (w - 1)) > 0 ? (t0 - (w - 1)) : 0;
            f32x4 sum = {0.f, 0.f, 0.f, 0.f};
#pragma unroll 8
            for (int t = ts; t < t0 + 64; ++t) {
                const f32x4 a = *(const f32x4*)(xb + (size_t)t * D + c0) * rs[t - t0 + 15] * g;
                sum += a;
                if (t - w >= ts) sum -= *(const f32x4*)(xb + (size_t)(t - w) * D + c0) * rs[t - w - t0 + 15] * g;
                if (t >= t0) { const float ic = 1.0f / (float)((t + 1) < w ? (t + 1) : w); const f32x4 p = sum * ic - a;
                    u32x2 o; o.x = pkh(p.x, p.y); o.y = pkh(p.z, p.w); *(u32x2*)(P + ((size_t)b * SEQ + t) * D + c0) = o; }
            }
        }
        __syncthreads();
    }
}
__device__ __forceinline__ void p0_prologue(Frame& F0, ArgP a) {
    Frame F = fresh(F0);
    unsigned char* ws = a->ws;
    LAS float* scr = (LAS float*)(F.lds + RING_OFF + F.wave * 16384);
    const int gw = F.vcu * NWAVES + F.wave, NGW = F.G * NWAVES;
    constexpr int I_POOL = (512 / 64) * (512 / 32), I_IN = (2048 / 64) * (DSA_NP / 32), I_OUT = (2048 / 64) * (2048 / 32), I_Q = (2048 / 64) * (512 / 32), I_KV = (2048 / 64) * (1024 / 32),
                  I_O = (512 / 64) * (2048 / 32), I_GU = (2048 / 64) * (2 * DFF / 32), I_DN = (DFF / 64) * (2048 / 32);
    constexpr int NITEMS = 4 * I_POOL + I_IN + I_OUT + 2 * (I_Q + I_KV + I_O + I_GU + I_DN);
    for (int it = gw; it < NITEMS; it += NGW) {
        int r = it; TJob j; bool found = false;
#pragma unroll
        for (int g = 0; g < 4; ++g) if (!found) { if (r < I_POOL) { j = TJob{a->pool_w + (size_t)g * 512 * 512, (h16*)(ws + WS_WPOOL) + (size_t)g * 512 * 512, a->pool_scale + g * 512, 512, 512, 512, 512, 0, 1.0f, nullptr}; found = true; } else r -= I_POOL; }
        if (!found) { if (r < I_IN) { j = TJob{a->w_in, (h16*)(ws + WS_WIN), nullptr, DSA_N, 2048, DSA_NP, DSA_N, 0, 64.0f, a->gains + 6 * D  }; found = true; } else r -= I_IN; }
        if (!found) { if (r < I_OUT) { j = TJob{a->w_out, (h16*)(ws + WS_WOUT), nullptr, 2048, 2048, 2048, 2048, 0, 1.0f, nullptr}; found = true; } else r -= I_OUT; }
#pragma unroll
        for (int L = 0; L < 2; ++L) {
            if (!found) { if (r < I_Q) { j = TJob{a->wq + (size_t)L * 2048 * 512, (h16*)(ws + WS_WQ) + (size_t)L * 512 * 2048, nullptr, 512, 2048, 512, 512, 0, 1.0f, a->gains + (size_t)L * 6 * D + 2 * D}; found = true; } else r -= I_Q; }
            if (!found) { if (r < I_KV) { j = TJob{a->wkv + (size_t)L * 2048 * 1024, (h16*)(ws + WS_WKV) + (size_t)L * 1024 * 2048, nullptr, 1024, 2048, 1024, 1024, 0, 1.0f, nullptr}; found = true; } else r -= I_KV; }
            if (!found) { if (r < I_O) { j = TJob{a->wo + (size_t)L * 512 * 2048, (h16*)(ws + WS_WO) + (size_t)L * 2048 * 512, nullptr, 2048, 512, 2048, 2048, 0, 1.0f, nullptr}; found = true; } else r -= I_O; }
            if (!found) { if (r < I_GU) { j = ((FFN_FP8 >> L) & 1) ? TJob{a->wgu + (size_t)L * 2048 * 2 * DFF, (h16*)(ws + WS_WGU) + (size_t)L * 2 * DFF * 2048, nullptr, 2 * DFF, 2048, 2 * DFF, 2 * DFF, 3, W8_SCALE, nullptr} : TJob{a->wgu + (size_t)L * 2048 * 2 * DFF, (h16*)(ws + WS_WGU) + (size_t)L * 2 * DFF * 2048, nullptr, 2 * DFF, 2048, 2 * DFF, 2 * DFF, 1, 1.0f, a->gains + (size_t)L * 6 * D + 4 * D}; found = true; } else r -= I_GU; }
            if (!found) { if (r < I_DN) { j = ((DN_FP8 >> L) & 1) ? TJob{a->wdn + (size_t)L * DFF * 2048, (h16*)(ws + WS_WDN) + (size_t)L * 2048 * DFF, nullptr, 2048, DFF, 2048, 2048, 2, W8_SCALE, nullptr} : TJob{a->wdn + (size_t)L * DFF * 2048, (h16*)(ws + WS_WDN) + (size_t)L * 2048 * DFF, nullptr, 2048, DFF, 2048, 2048, 0, 1.0f, nullptr}; found = true; } else r -= I_DN; }
        }
        if (found) tjob_run(j, r, scr, F.lane);
    }
    for (int i = (gw * 64 + F.lane); i < T * 16; i += NGW * 64) rope_entry(a, (float*)(ws + WS_ROPE), i);
    for (int m = gw; m < NB * NMEM; m += NGW) norm_row_to_h16(a->mem + (size_t)m * D, a->mem_norm, (h16*)(ws + WS_MEMN) + (size_t)m * D, F.lane);
    __syncthreads();
    pool_pre(F, a->x, a->gains  , (h16*)(ws + WS_A));
}

template <bool HAS_NEXT, bool OUT8, bool HIN32, bool HOUT32, bool RSONLY = false>
__device__ __forceinline__ void seam_phase(Frame& F0, const h16* Y, const void* hin, void* hout, const float* gpost, const float* gpre, h16* aout, float* rsout = nullptr) {
    Frame F = fresh(F0);
    const int gw = F.vcu * NWAVES + F.wave, NGW = F.G * NWAVES;
#pragma unroll 4
    for (int m = gw; m < T; m += NGW) {
        const h16* yr = Y + (size_t)m * D + 8 * F.lane;
        float y[4][8]; float s = 0.f;
#pragma unroll
        for (int j = 0; j < 4; ++j) { const half8 v = *(const half8*)(yr + 512 * j);
#pragma unroll
            for (int e = 0; e < 8; ++e) { y[j][e] = (float)v[e]; s += y[j][e] * y[j][e]; } }
        float hp[4][8];
#pragma unroll
        for (int j = 0; j < 4; ++j) {
            if constexpr (HIN32) { const f32x4 a = *(const f32x4*)((const float*)hin + (size_t)m * D + 8 * F.lane + 512 * j), c = *(const f32x4*)((const float*)hin + (size_t)m * D + 8 * F.lane + 512 * j + 4);
                hp[j][0] = a.x; hp[j][1] = a.y; hp[j][2] = a.z; hp[j][3] = a.w; hp[j][4] = c.x; hp[j][5] = c.y; hp[j][6] = c.z; hp[j][7] = c.w; }
            else { const half8 v = *(const half8*)((const h16*)hin + (size_t)m * D + 8 * F.lane + 512 * j);
#pragma unroll
                for (int e = 0; e < 8; ++e) hp[j][e] = (float)v[e]; } }
        const float r = rstd_of(wave_sum_dpp(s)); float s2 = 0.f;
#pragma unroll
        for (int j = 0; j < 4; ++j) { const f32x4 g0 = *(const f32x4*)(gpost + 8 * F.lane + 512 * j), g1 = *(const f32x4*)(gpost + 8 * F.lane + 512 * j + 4);
            const float g[8] = {g0.x, g0.y, g0.z, g0.w, g1.x, g1.y, g1.z, g1.w};
#pragma unroll
            for (int e = 0; e < 8; ++e) { const float h = hp[j][e] + y[j][e] * r * g[e]; y[j][e] = h; s2 += h * h; }
            if constexpr (HOUT32) { float* o = (float*)hout + (size_t)m * D + 8 * F.lane + 512 * j; *(f32x4*)o = (f32x4){y[j][0], y[j][1], y[j][2], y[j][3]}; *(f32x4*)(o + 4) = (f32x4){y[j][4], y[j][5], y[j][6], y[j][7]}; }
            else { u32x4 w; w.x = pkh(y[j][0], y[j][1]); w.y = pkh(y[j][2], y[j][3]); w.z = pkh(y[j][4], y[j][5]); w.w = pkh(y[j][6], y[j][7]); *(u32x4*)((h16*)hout + (size_t)m * D + 8 * F.lane + 512 * j) = w; } }
        if constexpr (HAS_NEXT && RSONLY) { const float r2 = rstd_of(wave_sum_dpp(s2)); if (F.lane == 0) rsout[m] = r2; }
        else if constexpr (HAS_NEXT) {
            const float r2 = rstd_of(wave_sum_dpp(s2));
#pragma unroll
            for (int j = 0; j < 4; ++j) { const f32x4 g0 = *(const f32x4*)(gpre + 8 * F.lane + 512 * j), g1 = *(const f32x4*)(gpre + 8 * F.lane + 512 * j + 4);
                const float g[8] = {g0.x, g0.y, g0.z, g0.w, g1.x, g1.y, g1.z, g1.w}; float v[8];
#pragma unroll
                for (int e = 0; e < 8; ++e) v[e] = y[j][e] * r2 * g[e];
                if constexpr (OUT8) { u32x2 w; w.x = pk8(v[0], v[1], v[2], v[3]); w.y = pk8(v[4], v[5], v[6], v[7]); *(u32x2*)((unsigned char*)aout + (size_t)m * D + 8 * F.lane + 512 * j) = w; }
                else { u32x4 w; w.x = pkh(v[0], v[1]); w.y = pkh(v[2], v[3]); w.z = pkh(v[4], v[5]); w.w = pkh(v[6], v[7]); *(u32x4*)(aout + (size_t)m * D + 8 * F.lane + 512 * j) = w; } }
        }
    }
}

__device__ __forceinline__ void xattn_phase(Frame& F0, h16* XQ, const h16* KVM  ) {
    Frame F = fresh(F0);
    LAS unsigned char* Ks = F.lds + RING_OFF; LAS unsigned char* Vt = F.lds + RING_OFF + 65536;
    const int lane = F.lane, n = lane & 31, hh = lane >> 5;
    for (int u = F.vcu; u < NB * 4 * (SEQ / 512); u += F.G) {
        const int b = u / (4 * (SEQ / 512)), h = (u / (SEQ / 512)) & 3, ch = u % (SEQ / 512);
        const h16* kb = KVM + (size_t)b * NMEM * 2048 + h * HD;
        for (int i = F.tid; i < 256 * 16; i += NWAVES * 64) { const int key = i >> 4, c = i & 15;
            const u32x4 kv = *(const u32x4*)(kb + (size_t)key * 2048 + 8 * c);
            *(LAS u32x4*)(Ks + key * 256 + ((c ^ (key & 15)) << 4)) = kv;
            const half8 vv = *(const half8*)(kb + (size_t)key * 2048 + 512 + 8 * c);
            const int o = key & 15, posk = (key & ~15) | ((o & 3) | ((o & 4) << 1) | ((o & 8) >> 1));
#pragma unroll
            for (int e = 0; e < 8; ++e) { const int d = 8 * c + e; *(LAS h16*)(Vt + d * 512 + (((posk >> 3) ^ (d & 15)) << 4) + (posk & 7) * 2) = vv[e]; }
        }
        __syncthreads();
#pragma unroll 1
        for (int sub = 0; sub < 2; ++sub) {
            const size_t m0 = (size_t)b * SEQ + ch * 512 + sub * 256 + F.wave * 32;
            h16* qrow = XQ + (m0 + n) * XW + h * HD;
            half8 qf[8];
#pragma unroll
            for (int s = 0; s < 8; ++s) qf[s] = *(const half8*)(qrow + 16 * s + 8 * hh);
            f32x16 o[4];
#pragma unroll
            for (int mt = 0; mt < 4; ++mt)
#pragma unroll
                for (int i = 0; i < 16; ++i) o[mt][i] = 0.f;
            const float c2 = 0.08838834764831845f * 1.44269504089f;
            float mrun = -3.0e38f, lrun = 0.f;
#pragma unroll 1
            for (int hf = 0; hf < 2; ++hf) {
                f32x16 acc[4];
#pragma unroll
                for (int kt = 0; kt < 4; ++kt) {
#pragma unroll
                    for (int i = 0; i < 16; ++i) acc[kt][i] = 0.f;
                    const int key = 128 * hf + 32 * kt + n;
#pragma unroll
                    for (int s = 0; s < 8; ++s) { const half8 ka = *(const LAS half8*)(Ks + key * 256 + (((2 * s + hh) ^ (key & 15)) << 4));
                        acc[kt] = __builtin_amdgcn_mfma_f32_32x32x16_f16(ka, qf[s], acc[kt], 0, 0, 0); }
                }
                float mx = mrun;
#pragma unroll
                for (int kt = 0; kt < 4; ++kt)
#pragma unroll
                    for (int i = 0; i < 16; ++i) mx = fmaxf(mx, acc[kt][i]);
                mx = fmaxf(mx, __shfl_xor(mx, 32));
                const float alpha = __builtin_amdgcn_exp2f((mrun - mx) * c2); mrun = mx;
                float sum = 0.f;
#pragma unroll
                for (int kt = 0; kt < 4; ++kt)
#pragma unroll
                    for (int i = 0; i < 16; ++i) { const float p = __builtin_amdgcn_exp2f((acc[kt][i] - mx) * c2); acc[kt][i] = p; sum += p; }
                lrun = lrun * alpha + sum;
#pragma unroll
                for (int mt = 0; mt < 4; ++mt)
#pragma unroll
                    for (int i = 0; i < 16; ++i) o[mt][i] *= alpha;
#pragma unroll
                for (int kt = 0; kt < 4; ++kt)
#pragma unroll
                    for (int s2 = 0; s2 < 2; ++s2) {
                        half8 pb;
#pragma unroll
                        for (int j = 0; j < 8; ++j) pb[j] = (h16)acc[kt][8 * s2 + j];
#pragma unroll
                        for (int mt = 0; mt < 4; ++mt) { const int d = 32 * mt + n;
                            const half8 va = *(const LAS half8*)(Vt + d * 512 + (((2 * (2 * (4 * hf + kt) + s2) + hh) ^ (d & 15)) << 4));
                            o[mt] = __builtin_amdgcn_mfma_f32_32x32x16_f16(va, pb, o[mt], 0, 0, 0); }
                    }
            }
            lrun += __shfl_xor(lrun, 32);
            const float inv = 1.0f / lrun;
#pragma unroll
            for (int mt = 0; mt < 4; ++mt)
#pragma unroll
                for (int jj = 0; jj < 4; ++jj) { u32x2 w; w.x = pkh(o[mt][4 * jj] * inv, o[mt][4 * jj + 1] * inv); w.y = pkh(o[mt][4 * jj + 2] * inv, o[mt][4 * jj + 3] * inv);
                    *(u32x2*)(qrow + 32 * mt + 8 * jj + 4 * hh) = w; }
        }
        __syncthreads();
    }
}

__device__ __forceinline__ unsigned mono_key(unsigned u) { return (u & 0x80000000u) ? ~u : (u | 0x80000000u); }
__device__ __forceinline__ void keymap_clear(LAS unsigned* bm, int lane) { *(LAS u32x4*)(bm + 8 * lane) = (u32x4){0u, 0u, 0u, 0u}; *(LAS u32x4*)(bm + 8 * lane + 4) = (u32x4){0u, 0u, 0u, 0u}; }
__device__ __forceinline__ void keymap_emit(LAS unsigned* bm, unsigned short* out, int nvalid, int lane) {
    const u32x4 w0 = *(const LAS u32x4*)(bm + 8 * lane), w1 = *(const LAS u32x4*)(bm + 8 * lane + 4);
    unsigned w[8] = {w0.x, w0.y, w0.z, w0.w, w1.x, w1.y, w1.z, w1.w};
    int mine = 0;
#pragma unroll
    for (int j = 0; j < 8; ++j) mine += __builtin_popcount(w[j]);
    int incl = mine;
#pragma unroll
    for (int o = 1; o < 64; o <<= 1) { const int v = __shfl_up(incl, o); if (lane >= o) incl += v; }
    int pos = incl - mine;
#pragma unroll
    for (int j = 0; j < 8; ++j) { unsigned x = w[j]; while (x) { const int b = __builtin_ctz(x); out[pos++] = (unsigned short)((8 * lane + j) * 32 + b); x &= x - 1u; } }
    const int total = __shfl(incl, 63);
    for (int i = total + lane; i < TOPK; i += 64) out[i] = (unsigned short)0;
}
constexpr int SEL_N = LIST_CAP / 64;
template <bool FINAL>
__device__ __forceinline__ void select256(u32x2* list, int c, LAS float* th_out, LAS unsigned* cnt_out, LAS unsigned* bm, int lane) {
    unsigned key[SEL_N], id[SEL_N];
#pragma unroll
    for (int k = 0; k < SEL_N; ++k) { const int i = lane + 64 * k; const u32x2 v = list[i]; key[k] = (i < c) ? mono_key(v.x) : 0u; id[k] = v.y; }
    unsigned mx = key[0];
#pragma unroll
    for (int k = 1; k < SEL_N; ++k) mx = key[k] > mx ? key[k] : mx;
#pragma unroll
    for (int o = 1; o < 64; o <<= 1) { const unsigned v = (unsigned)__shfl_xor((int)mx, o); mx = v > mx ? v : mx; }
    unsigned lo = FINAL ? 1u : mono_key(__float_as_uint(*th_out)), hi = mx;
    constexpr int PRUNE_KEEP = 320;
#pragma unroll 1
    while (lo < hi) { const unsigned mid = lo + ((hi - lo + 1u) >> 1); int cc = 0;
#pragma unroll
        for (int k = 0; k < SEL_N; ++k) cc += __builtin_popcountll(__ballot(key[k] >= mid));
        if (cc >= TOPK) { lo = mid; if (cc <= (FINAL ? TOPK : PRUNE_KEEP)) break; } else hi = mid - 1u; }
    const unsigned prefix = lo;
    int ngt = 0, neq = 0;
#pragma unroll
    for (int k = 0; k < SEL_N; ++k) { ngt += __builtin_popcountll(__ballot(key[k] > prefix)); neq += __builtin_popcountll(__ballot(key[k] == prefix)); }
    const int need_eq = FINAL ? (TOPK - ngt) : neq; int base_gt = 0, base_eq = 0;
    const unsigned long long lt = (1ull << lane) - 1ull;
#pragma unroll
    for (int k = 0; k < SEL_N; ++k) {
        const unsigned long long bgt = __ballot(key[k] > prefix), beq = __ballot(key[k] == prefix);
        int pos = -1;
        if (key[k] > prefix) pos = base_gt + __builtin_popcountll(bgt & lt);
        else if (key[k] == prefix) { const int r = base_eq + __builtin_popcountll(beq & lt); if (r < need_eq) pos = ngt + r; }
        if (pos >= 0) { if constexpr (FINAL) __hip_atomic_fetch_or(bm + (id[k] >> 5), 1u << (id[k] & 31u), __ATOMIC_RELAXED, __HIP_MEMORY_SCOPE_WORKGROUP); else { u32x2 v; v.x = (key[k] & 0x80000000u) ? (key[k] & 0x7fffffffu) : ~key[k]; v.y = id[k]; list[pos] = v; } }
        base_gt += __builtin_popcountll(bgt); base_eq += __builtin_popcountll(beq);
        __builtin_amdgcn_sched_barrier(0);
    }
    if constexpr (!FINAL) { if (lane == 0) { const unsigned u = (prefix & 0x80000000u) ? (prefix & 0x7fffffffu) : ~prefix; *th_out = __builtin_bit_cast(float, u); *cnt_out = (unsigned)(ngt + neq); } }
}
__device__ __forceinline__ void indexer_phase(Frame& F0, const h16* IQ, const h16* IK, const float* IW, unsigned short* IDX, u32x2* LISTS) {
    Frame F = fresh(F0);
    LAS unsigned char* bq = F.lds + RING_OFF;
    LAS unsigned* cnt = (LAS unsigned*)(F.lds + RING_OFF + 131072); LAS float* th = (LAS float*)(cnt + 32); LAS unsigned* flag = cnt + 64; LAS unsigned* sgn = cnt + 96;
    u32x2* mylist = LISTS + (size_t)blockIdx.x * 32 * LIST_CAP;
    const int lane = F.lane, n = lane & 31, hh = lane >> 5, w8 = F.wave;
    const float INF = __builtin_inff();
    constexpr int NU = NB * (SEQ / 32);
    for (int rnd = 0; rnd * F.G < NU; ++rnd) {
        int qt, b;
        if (F.G == 256) {
            const int i = (F.vcu & 31) + 32 * (F.vcu >> 6); b = (F.vcu >> 5) & 1;
            qt = rnd == 0 ? 511 - i : rnd == 1 ? i : rnd == 2 ? 256 + i : 255 - i;
        } else { const int kk = rnd * F.G + ((rnd & 1) ? (F.G - 1 - F.vcu) : F.vcu); if (kk >= NU) continue; qt = (SEQ / 32 - 1) - (kk >> 1); b = kk & 1; }
        const int nkt = qt + 1;
        const size_t m0 = (size_t)b * SEQ + 32 * qt;
        if (F.tid < 32) { cnt[F.tid] = 0u; th[F.tid] = -INF; unsigned mk = 0u;
#pragma unroll
            for (int h = 0; h < 16; ++h) mk |= (IW[(m0 + F.tid) * 16 + h] >= 0.f ? 1u : 0u) << h;
            sgn[F.tid] = mk; }
        if (F.tid == 0) *flag = 0u;
        { const int q = F.tid & 31, ch = F.tid >> 5;
#pragma unroll 4
            for (int h = 0; h < 16; ++h) { const float w = IW[(m0 + q) * 16 + h]; const half8 v = *(const half8*)(IQ + (m0 + q) * 2048 + h * HD + 8 * ch); half8 o;
#pragma unroll
                for (int e = 0; e < 8; ++e) o[e] = (h16)((float)v[e] * w);
                *(LAS half8*)(bq + (h * 16 + ch) * 512 + q * 16) = o; } }
        __syncthreads();
        const h16* ikb = IK + (size_t)b * SEQ * HD;
        const unsigned smask = sgn[n];
        float theta = -INF;
        const int qpos = 32 * qt + n;
        u32x2* lp = mylist + (size_t)n * LIST_CAP;
        half8 A[8];
        if (w8 < nkt) { const h16* arow = ikb + (size_t)(32 * w8 + n) * HD + 8 * hh;
#pragma unroll
            for (int c = 0; c < 8; ++c) A[c] = *(const half8*)(arow + 16 * c); }
#pragma unroll 1
        for (int r0 = 0; r0 < nkt; r0 += NWAVES) {
            const int kt = r0 + w8;
            if (kt < nkt) {
                f32x16 S;
#pragma unroll
                for (int i = 0; i < 16; ++i) S[i] = 0.f;
                const LAS unsigned char* bl = bq + hh * 512 + n * 16;
                half8 Ba[4], Bb[4]; f32x16 acc0, acc1;
#define IDX_LOADB(dst, h, c0) do { _Pragma("unroll") for (int c = 0; c < 4; ++c) dst[c] = *(const LAS half8*)(bl + ((h) * 16 + 2 * ((c0) + c)) * 512); } while (0)
#define IDX_MMA4(acc, Bx, c0) do { _Pragma("unroll") for (int c = 0; c < 4; ++c) acc = __builtin_amdgcn_mfma_f32_32x32x16_f16(A[(c0) + c], Bx[c], acc, 0, 0, 0); } while (0)
#define IDX_ZERO(acc) do { _Pragma("unroll") for (int i = 0; i < 16; ++i) acc[i] = 0.f; } while (0)
#define IDX_FOLD8(acc, h, i0) do { const float cc_ = ((smask >> (h)) & 1u) ? INF : -INF; _Pragma("unroll") for (int i = (i0); i < (i0) + 8; ++i) S[i] += __builtin_amdgcn_fmed3f(acc[i], 0.f, cc_); } while (0)
#define IDX_SCHED4() do { __builtin_amdgcn_sched_group_barrier(0x008, 1, 0); __builtin_amdgcn_sched_group_barrier(0x100, 1, 0); _Pragma("unroll") for (int g_ = 0; g_ < 3; ++g_) { __builtin_amdgcn_sched_group_barrier(0x008, 1, 0); __builtin_amdgcn_sched_group_barrier(0x100, 1, 0); __builtin_amdgcn_sched_group_barrier(0x002, 6, 0); } } while (0)
                IDX_LOADB(Ba, 0, 0);
                IDX_ZERO(acc1);
#pragma unroll 1
                for (int h = 0; h < 16; h += 2) {
                    IDX_ZERO(acc0);
                    IDX_MMA4(acc0, Ba, 0); IDX_FOLD8(acc1, (h + 15) & 15, 0); IDX_LOADB(Bb, h, 4); IDX_SCHED4();
                    IDX_MMA4(acc0, Bb, 4); IDX_FOLD8(acc1, (h + 15) & 15, 8); IDX_LOADB(Ba, h + 1, 0); IDX_SCHED4();
                    IDX_ZERO(acc1);
                    IDX_MMA4(acc1, Ba, 0); IDX_FOLD8(acc0, h, 0); IDX_LOADB(Bb, h + 1, 4); IDX_SCHED4();
                    IDX_MMA4(acc1, Bb, 4); IDX_FOLD8(acc0, h, 8); IDX_LOADB(Ba, (h + 2) & 15, 0); IDX_SCHED4();
                }
                IDX_FOLD8(acc1, 15, 0); IDX_FOLD8(acc1, 15, 8);
#if IDX_PROBE_MMA
                {
                    f32x16 S1 = S;
#pragma unroll
                    for (int c = 0; c < 8; ++c) asm volatile("" : "+v"(A[c]));
#pragma unroll
                    for (int i = 0; i < 16; ++i) S[i] = 0.f;
                    IDX_LOADB(Ba, 0, 0);
                    IDX_ZERO(acc1);
#pragma unroll 1
                    for (int h = 0; h < 16; h += 2) {
                        IDX_ZERO(acc0);
                        IDX_MMA4(acc0, Ba, 0); IDX_FOLD8(acc1, (h + 15) & 15, 0); IDX_LOADB(Bb, h, 4); IDX_SCHED4();
                        IDX_MMA4(acc0, Bb, 4); IDX_FOLD8(acc1, (h + 15) & 15, 8); IDX_LOADB(Ba, h + 1, 0); IDX_SCHED4();
                        IDX_ZERO(acc1);
                        IDX_MMA4(acc1, Ba, 0); IDX_FOLD8(acc0, h, 0); IDX_LOADB(Bb, h + 1, 4); IDX_SCHED4();
                        IDX_MMA4(acc1, Bb, 4); IDX_FOLD8(acc0, h, 8); IDX_LOADB(Ba, (h + 2) & 15, 0); IDX_SCHED4();
                    }
                    IDX_FOLD8(acc1, 15, 0); IDX_FOLD8(acc1, 15, 8);
#pragma unroll
                    for (int i = 0; i < 16; ++i) S[i] = (S[i] + S1[i]) * 0.5f;
                }
#endif
#undef IDX_LOADB
#undef IDX_MMA4
#undef IDX_ZERO
#undef IDX_FOLD8
#undef IDX_SCHED4
                if (kt + NWAVES < nkt) { const h16* arow = ikb + (size_t)(32 * (kt + NWAVES) + n) * HD + 8 * hh;
#pragma unroll
                    for (int c = 0; c < 8; ++c) A[c] = *(const half8*)(arow + 16 * c); }
                const int kb0 = 32 * kt + 4 * hh;
                unsigned pm = 0u;
                if (kt < qt) {
#pragma unroll
                    for (int i = 0; i < 16; ++i) pm |= (S[i] > theta) ? (1u << i) : 0u;
                } else {
#pragma unroll
                    for (int i = 0; i < 16; ++i) { const int key = kb0 + (i & 3) + 8 * (i >> 2); pm |= ((key <= qpos) && (S[i] > theta)) ? (1u << i) : 0u; }
                }
                if (pm) { const unsigned np = (unsigned)__builtin_popcount(pm);
                    const unsigned pos = __hip_atomic_fetch_add(cnt + n, np, __ATOMIC_RELAXED, __HIP_MEMORY_SCOPE_WORKGROUP);
#pragma unroll
                    for (int i = 0; i < 16; ++i) if (pm & (1u << i)) { u32x2 e; e.x = __float_as_uint(S[i]);   e.y = (unsigned)(kb0 + (i & 3) + 8 * (i >> 2));
                        { const unsigned at = pos + (unsigned)__builtin_popcount(pm & ((1u << i) - 1u)); lp[at < (unsigned)LIST_CAP ? at : (unsigned)LIST_CAP - 1u] = e; } }
                    if (pos + np > (unsigned)(LIST_CAP - 256)) *(volatile LAS unsigned*)flag = 1u; }
            }
            asm volatile("s_waitcnt lgkmcnt(0)" ::: "memory"); __builtin_amdgcn_s_barrier(); asm volatile("" ::: "memory");
            if (*(volatile LAS unsigned*)flag != 0u) {
                VM_WAIT(); __syncthreads();
                for (int q = w8; q < 32; q += NWAVES) { const int c = __builtin_amdgcn_readfirstlane((int)cnt[q]); if (c > TOPK) select256<false>(mylist + (size_t)q * LIST_CAP, c, th + q, cnt + q, nullptr, lane); }
                if (F.tid == 0) *flag = 0u;
                VM_WAIT(); __syncthreads();
                theta = th[n];
                if (kt + NWAVES < nkt) { const h16* arow = ikb + (size_t)(32 * (kt + NWAVES) + n) * HD + 8 * hh;
#pragma unroll
                    for (int c = 0; c < 8; ++c) A[c] = *(const half8*)(arow + 16 * c); }
            }
        }
        VM_WAIT(); __syncthreads();
        LAS unsigned* bm = (LAS unsigned*)(bq + w8 * 2048);
        for (int q = w8; q < 32; q += NWAVES) { const int c = __builtin_amdgcn_readfirstlane((int)cnt[q]); unsigned short* io = IDX + (m0 + q) * TOPK; u32x2* lq = mylist + (size_t)q * LIST_CAP;
            keymap_clear(bm, lane); asm volatile("s_waitcnt lgkmcnt(0)" ::: "memory");
            if (c > TOPK) select256<true>(lq, c, nullptr, nullptr, bm, lane);
            else {
#pragma unroll
                for (int k = 0; k < 4; ++k) { const int i = lane + 64 * k; if (i < c) { const unsigned key = lq[i].y; __hip_atomic_fetch_or(bm + (key >> 5), 1u << (key & 31u), __ATOMIC_RELAXED, __HIP_MEMORY_SCOPE_WORKGROUP); } } }
            asm volatile("s_waitcnt lgkmcnt(0)" ::: "memory");
            keymap_emit(bm, io, c, lane);
            asm volatile("s_waitcnt lgkmcnt(0)" ::: "memory"); }
        __syncthreads();
    }
}

__device__ __forceinline__ unsigned q_fetch(unsigned* ctr, int lane) { unsigned v = 0u; if (lane == 0) v = __hip_atomic_fetch_add(ctr, 1u, __ATOMIC_RELAXED, __HIP_MEMORY_SCOPE_AGENT); return (unsigned)__builtin_amdgcn_readfirstlane((int)v); }
__device__ __forceinline__ void sparse_attn_phase(Frame& F0, const h16* Q, const unsigned char* K8, const unsigned char* V8, const unsigned short* IDX, h16* O, unsigned* qctr) {
    Frame F = fresh(F0);
    LAS unsigned char* wl = F.lds + RING_OFF + F.wave * 16896;
    LAS float* Pl = (LAS float*)wl;
    LAS unsigned short* Il = (LAS unsigned short*)(wl + 4096);
    const int lane = F.lane, r16 = lane & 15, g4 = lane >> 4;
    const float c2 = 0.08838834764831845f * 1.44269504089f;
    const unsigned x0 = xb_xcc_id() & 7u;
    unsigned tried = 0u, p = x0;
    unsigned item = q_fetch(qctr + 64 * p, lane);
    bool have_pf = false; u32x2 pf_idx = (u32x2){0u, 0u}; half8 pf_q[4];
#pragma unroll
    for (int s = 0; s < 4; ++s) pf_q[s] = (half8){0, 0, 0, 0, 0, 0, 0, 0};
    for (;;) {
        while (item >= (unsigned)SEQ && tried < 8u) { ++tried; p = (x0 + tried) & 7u; if (tried < 8u) item = q_fetch(qctr + 64 * p, lane); }
        if (tried >= 8u) break;
        const unsigned nxt = q_fetch(qctr + 64 * p, lane);
        const int b = (int)(p >> 2), j = (int)(p & 3u), tq = (int)item, nk = (tq + 1) < TOPK ? (tq + 1) : TOPK;
        const size_t m = (size_t)b * SEQ + tq;
        const unsigned char* kb = K8 + (size_t)p * SEQ * HD; const unsigned char* vb = V8 + (size_t)p * SEQ * HD;
        *(LAS u32x2*)(Il + 4 * lane) = have_pf ? pf_idx : *(const u32x2*)(IDX + m * TOPK + 4 * lane);
        long qh[4], ql[4];
        { const h16* qrow = Q + m * 2048 + (size_t)j * 512 + (r16 & 3) * HD + 16 * g4;
#pragma unroll
          for (int s = 0; s < 4; ++s) { const half8 hv = have_pf ? pf_q[s] : *(const half8*)(qrow + (s >> 1) * 64 + (s & 1) * 8);
              float f[8], l[8];
#pragma unroll
              for (int e = 0; e < 8; ++e) f[e] = (float)hv[e] * c2;
              const unsigned h0 = pk8(f[0], f[1], f[2], f[3]), h1 = pk8(f[4], f[5], f[6], f[7]);
              l[0] = f[0] - __builtin_amdgcn_cvt_f32_fp8((int)h0, 0); l[1] = f[1] - __builtin_amdgcn_cvt_f32_fp8((int)h0, 1); l[2] = f[2] - __builtin_amdgcn_cvt_f32_fp8((int)h0, 2); l[3] = f[3] - __builtin_amdgcn_cvt_f32_fp8((int)h0, 3);
              l[4] = f[4] - __builtin_amdgcn_cvt_f32_fp8((int)h1, 0); l[5] = f[5] - __builtin_amdgcn_cvt_f32_fp8((int)h1, 1); l[6] = f[6] - __builtin_amdgcn_cvt_f32_fp8((int)h1, 2); l[7] = f[7] - __builtin_amdgcn_cvt_f32_fp8((int)h1, 3);
              const unsigned l0 = pk8(l[0], l[1], l[2], l[3]), l1 = pk8(l[4], l[5], l[6], l[7]);
              const bool real = r16 < 4;
              qh[s] = real ? (long)(((unsigned long long)h1 << 32) | h0) : 0l; ql[s] = real ? (long)(((unsigned long long)l1 << 32) | l0) : 0l; } }
        asm volatile("s_waitcnt lgkmcnt(0)" ::: "memory");
        int keys[16];
#pragma unroll
        for (int kt = 0; kt < 16; ++kt) keys[kt] = Il[16 * kt + r16];
        {
            u32x4 ka[8][2];
#pragma unroll
            for (int k8 = 0; k8 < 8; ++k8) { const unsigned char* krow = kb + (size_t)keys[k8] * HD + 16 * g4; ka[k8][0] = *(const u32x4*)krow; ka[k8][1] = *(const u32x4*)(krow + 64); }
#pragma unroll
            for (int kt = 0; kt < 16; ++kt) { const int k8 = kt & 7; const u32x4 a0 = ka[k8][0], a1 = ka[k8][1];
                const long ak[4] = {(long)(((unsigned long long)a0.y << 32) | a0.x), (long)(((unsigned long long)a0.w << 32) | a0.z), (long)(((unsigned long long)a1.y << 32) | a1.x), (long)(((unsigned long long)a1.w << 32) | a1.z)};
                if (kt < 8) { const unsigned char* krow = kb + (size_t)keys[kt + 8] * HD + 16 * g4; ka[k8][0] = *(const u32x4*)krow; ka[k8][1] = *(const u32x4*)(krow + 64); }
                f32x4 acc = (f32x4){0.f, 0.f, 0.f, 0.f};
#pragma unroll
                for (int s = 0; s < 4; ++s) { acc = __builtin_amdgcn_mfma_f32_16x16x32_fp8_fp8(ak[s], qh[s], acc, 0, 0, 0); acc = __builtin_amdgcn_mfma_f32_16x16x32_fp8_fp8(ak[s], ql[s], acc, 0, 0, 0); }
                if (r16 < 4) {
#pragma unroll
                    for (int i = 0; i < 4; ++i) Pl[(16 * kt + 4 * g4 + i) * 4 + r16] = acc[i]; }
            }
        }
        have_pf = nxt < (unsigned)SEQ;
        if (have_pf) { const size_t mn = (size_t)b * SEQ + nxt; pf_idx = *(const u32x2*)(IDX + mn * TOPK + 4 * lane);
            const h16* qn = Q + mn * 2048 + (size_t)j * 512 + (r16 & 3) * HD + 16 * g4;
#pragma unroll
            for (int s = 0; s < 4; ++s) pf_q[s] = *(const half8*)(qn + (s >> 1) * 64 + (s & 1) * 8); }
        asm volatile("" ::: "memory");
        LAS unsigned char* vs = wl + 4608;
        const int nch = (nk + 31) >> 5;
#define SP_ISSUE(ch_) do { const int c_ = (ch_); LAS unsigned char* s_ = vs + (c_ % 3) * 4096; _Pragma("unroll") for (int j_ = 0; j_ < 4; ++j_) { const int key_ = Il[32 * c_ + 8 * j_ + (lane >> 3)]; \
                __builtin_amdgcn_global_load_lds((const unsigned*)(vb + (size_t)key_ * HD + (((lane & 7) ^ (((8 * j_ + (lane >> 3)) >> 1) & 7)) * 16)), (LAS unsigned*)(s_ + 1024 * j_), 16, 0, 0); } } while (0)
            SP_ISSUE(0); if (nch > 1) SP_ISSUE(1);
        f32x4 sv[4]; f32x4 mx = (f32x4){-3.0e38f, -3.0e38f, -3.0e38f, -3.0e38f};
#pragma unroll
        for (int k = 0; k < 4; ++k) { sv[k] = *(const LAS f32x4*)(Pl + (lane + 64 * k) * 4); if (lane + 64 * k < nk) { mx[0] = fmaxf(mx[0], sv[k][0]); mx[1] = fmaxf(mx[1], sv[k][1]); mx[2] = fmaxf(mx[2], sv[k][2]); mx[3] = fmaxf(mx[3], sv[k][3]); } }
        mx[0] = wave_max_dpp(mx[0]); mx[1] = wave_max_dpp(mx[1]); mx[2] = wave_max_dpp(mx[2]); mx[3] = wave_max_dpp(mx[3]);
        f32x4 sum = (f32x4){0.f, 0.f, 0.f, 0.f};
        asm volatile("s_waitcnt lgkmcnt(0)" ::: "memory");
#pragma unroll
        for (int k = 0; k < 4; ++k) { f32x4 pv;
#pragma unroll
            for (int h = 0; h < 4; ++h) pv[h] = (lane + 64 * k < nk) ? __builtin_amdgcn_exp2f(sv[k][h] - mx[h]) : 0.f;
            sum += pv;
#pragma unroll
            for (int h = 0; h < 4; ++h) Pl[h * 256 + lane + 64 * k] = pv[h] * 16.0f; }
        sum[0] = wave_sum_dpp(sum[0]); sum[1] = wave_sum_dpp(sum[1]); sum[2] = wave_sum_dpp(sum[2]); sum[3] = wave_sum_dpp(sum[3]);
        asm volatile("s_waitcnt lgkmcnt(0)" ::: "memory");
        long ph[8], pq[8];
#pragma unroll
        for (int s = 0; s < 8; ++s) { const LAS float* pp = Pl + (r16 & 3) * 256 + 32 * s + 8 * g4; const f32x4 a = *(const LAS f32x4*)pp, c = *(const LAS f32x4*)(pp + 4);
            const unsigned h0 = pk8(a[0], a[1], a[2], a[3]), h1 = pk8(c[0], c[1], c[2], c[3]);
            const unsigned l0 = pk8(a[0] - __builtin_amdgcn_cvt_f32_fp8((int)h0, 0), a[1] - __builtin_amdgcn_cvt_f32_fp8((int)h0, 1), a[2] - __builtin_amdgcn_cvt_f32_fp8((int)h0, 2), a[3] - __builtin_amdgcn_cvt_f32_fp8((int)h0, 3));
            const unsigned l1 = pk8(c[0] - __builtin_amdgcn_cvt_f32_fp8((int)h1, 0), c[1] - __builtin_amdgcn_cvt_f32_fp8((int)h1, 1), c[2] - __builtin_amdgcn_cvt_f32_fp8((int)h1, 2), c[3] - __builtin_amdgcn_cvt_f32_fp8((int)h1, 3));
            const bool real = r16 < 4;
            ph[s] = real ? (long)(((unsigned long long)h1 << 32) | h0) : 0l; pq[s] = real ? (long)(((unsigned long long)l1 << 32) | l0) : 0l; }
        f32x4 oacc[8];
#pragma unroll
        for (int nt = 0; nt < 8; ++nt) oacc[nt] = (f32x4){0.f, 0.f, 0.f, 0.f};
        {
            const int vrow = 8 * g4 + (r16 >> 1);
#pragma unroll
            for (int ch = 0; ch < 8; ++ch) {
                if (ch < nch) {
                    if (ch + 2 < nch) { SP_ISSUE(ch + 2); asm volatile("s_waitcnt vmcnt(8)" ::: "memory"); }
                    else if (ch + 1 < nch) asm volatile("s_waitcnt vmcnt(4)" ::: "memory");
                    else asm volatile("s_waitcnt vmcnt(0)" ::: "memory");
                    const LAS unsigned char* s = vs + (ch % 3) * 4096 + vrow * HD + 8 * (r16 & 1);
#pragma unroll
                    for (int nt = 0; nt < 8; ++nt) {
                        const v2i32 bv = __builtin_amdgcn_ds_read_tr8_b64_v2i32((LAS v2i32*)(s + ((nt ^ ((vrow >> 1) & 7)) * 16)));
                        const long bb = (long)(((unsigned long long)(unsigned)bv.y << 32) | (unsigned)bv.x);
                        oacc[nt] = __builtin_amdgcn_mfma_f32_16x16x32_fp8_fp8(ph[ch], bb, oacc[nt], 0, 0, 0);
                        oacc[nt] = __builtin_amdgcn_mfma_f32_16x16x32_fp8_fp8(pq[ch], bb, oacc[nt], 0, 0, 0); }
                    asm volatile("s_waitcnt lgkmcnt(0)" ::: "memory");
                }
            }
#undef SP_ISSUE
        }
        { LAS h16* ot = (LAS h16*)Pl;
          if (g4 == 0) {
#pragma unroll
              for (int nt = 0; nt < 8; ++nt)
#pragma unroll
                  for (int i = 0; i < 4; ++i) ot[i * HD + 16 * nt + r16] = (h16)(oacc[nt][i] * (0.0625f / sum[i])); }
          asm volatile("s_waitcnt lgkmcnt(0)" ::: "memory");
          const u32x4 w = *(const LAS u32x4*)(ot + g4 * HD + 8 * r16);
          *(u32x4*)(O + m * 2048 + (size_t)j * 512 + g4 * HD + 8 * r16) = w; }
        asm volatile("s_waitcnt lgkmcnt(0)" ::: "memory");
        item = nxt;
    }
}

#ifndef DBG_CHECK
#define DBG_CHECK 0
#endif
#if DBG_CHECK
__device__ __forceinline__ void dbg_max(unsigned* w, float v) { atomicMax(w, __builtin_bit_cast(unsigned, fabsf(v))); }
__device__ __forceinline__ int dbg_row(int blk) { return (blk & 1) * SEQ + (SEQ - 1 - 251 * (blk >> 1)); }
__device__ __forceinline__ void dbg_check_inproj(unsigned char* ws, LAS float* sh, unsigned* word) {
    if (blockIdx.x >= 64) return;
    int tid_ = (int)threadIdx.x; asm volatile("" : "+v"(tid_)); const int m = dbg_row(blockIdx.x), tid = tid_;
    const h16* a = (const h16*)(ws + WS_A) + (size_t)m * 2048; const h16* W = (const h16*)(ws + WS_WIN);
    for (int c = tid; c < DSA_N; c += 512) { float s = 0.f; for (int k = 0; k < 2048; ++k) s += (float)a[k] * (float)W[(size_t)c * 2048 + k]; sh[c] = s * (1.0f / 64.0f); }
    __syncthreads();
    const float* rope = (const float*)(ws + WS_ROPE) + (size_t)m * 32;
    for (int c = tid; c < DSA_N; c += 512) {
        float v = sh[c]; int hc; bool rot; float got;
        if (c < 2048) { hc = c & 127; rot = true; got = (float)((const h16*)(ws + WS_Q))[(size_t)m * 2048 + c]; }
        else if (c < 3072) continue;
        else if (c < 5120) { hc = (c - 3072) & 127; rot = true; got = (float)((const h16*)(ws + WS_IQ))[(size_t)m * 2048 + (c - 3072)]; }
        else if (c < 5248) { hc = c - 5120; rot = true; got = (float)((const h16*)(ws + WS_IK))[(size_t)m * 128 + (c - 5120)]; }
        else { hc = 99; rot = false; got = ((const float*)(ws + WS_IW))[(size_t)m * 16 + (c - 5248)]; }
        if (rot && hc < 32) { const int i = hc & 15; const float cs = rope[i], sn = rope[16 + i]; v = hc < 16 ? v * cs - sh[c + 16] * sn : v * cs + sh[c - 16] * sn; }
        dbg_max(word, (got - v) / (1.0f + fabsf(v)));
    }
    __syncthreads();
}
__device__ __forceinline__ void dbg_check_xattn(unsigned char* ws, int L, LAS float* sh, unsigned* word) {
    if (blockIdx.x >= 64) return;
    int tid_ = (int)threadIdx.x; asm volatile("" : "+v"(tid_)); const int m = dbg_row(blockIdx.x), tid = tid_, b = m / SEQ;
    const h16* a = (const h16*)(ws + WS_A) + (size_t)m * 2048; const h16* W = (const h16*)(ws + WS_WQ) + (size_t)L * 512 * 2048;
    const h16* kvm = (const h16*)(ws + WS_KVM) + (size_t)b * NMEM * 2048 + L * 1024;
    LAS float* q = sh; LAS float* lg = sh + 512; LAS float* st = sh + 512 + 1024;
    { float s = 0.f; for (int k = 0; k < 2048; ++k) s += (float)a[k] * (float)W[(size_t)tid * 2048 + k]; q[tid] = (float)(h16)s; }
    __syncthreads();
    for (int i = tid; i < 1024; i += 512) { const int h = i >> 8, key = i & 255; float s = 0.f; for (int d = 0; d < 128; ++d) s += q[h * 128 + d] * (float)kvm[(size_t)key * 2048 + h * 128 + d]; lg[i] = s * 0.08838834764831845f; }
    __syncthreads();
    if (tid < 4) { float mx = -3e38f; for (int k = 0; k < 256; ++k) mx = fmaxf(mx, lg[tid * 256 + k]); float su = 0.f; for (int k = 0; k < 256; ++k) su += __expf(lg[tid * 256 + k] - mx); st[2 * tid] = mx; st[2 * tid + 1] = 1.0f / su; }
    __syncthreads();
    { const int h = tid >> 7, d = tid & 127; float o = 0.f; for (int k = 0; k < 256; ++k) o += __expf(lg[h * 256 + k] - st[2 * h]) * st[2 * h + 1] * (float)kvm[(size_t)k * 2048 + 512 + h * 128 + d];
      const float got = (float)((const h16*)(ws + WS_XQ))[(size_t)m * 512 + tid]; dbg_max(word, (got - o) / (0.05f + fabsf(o))); }
    __syncthreads();
}
__device__ __forceinline__ void dbg_check_indexer(unsigned char* ws, LAS float* sh, unsigned* word, unsigned* word2) {
    if (blockIdx.x >= 64) return;
    int tid_ = (int)threadIdx.x; asm volatile("" : "+v"(tid_)); const int m = dbg_row(blockIdx.x), tid = tid_, b = m / SEQ, t = m % SEQ;
    const h16* iq = (const h16*)(ws + WS_IQ) + (size_t)m * 2048; const h16* ik = (const h16*)(ws + WS_IK) + (size_t)b * SEQ * 128; const float* iw = (const float*)(ws + WS_IW) + (size_t)m * 16;
    LAS float* sc = sh;
    for (int s = tid; s <= t; s += 512) { float tot = 0.f; for (int h = 0; h < 16; ++h) { float l = 0.f; for (int d = 0; d < 128; ++d) l += (float)iq[h * 128 + d] * (float)ik[(size_t)s * 128 + d]; tot += iw[h] * fmaxf(l, 0.f); } sc[s] = tot; }
    __syncthreads();
    const unsigned short* idx = (const unsigned short*)(ws + WS_IDX) + (size_t)m * 256;
    if (tid < 256) { const int key = idx[tid]; if (key > t) atomicAdd(word2, 1000u); else { const float v = sc[key]; int rank = 0; for (int s = 0; s <= t; ++s) rank += sc[s] > v ? 1 : 0; if (rank >= 256) atomicAdd(word, 1u);
        for (int j = 0; j < 256; ++j) if (j != tid && idx[j] == key) { atomicAdd(word2, 1u); break; } } }
    __syncthreads();
}
__device__ __forceinline__ float dbg_f8(const unsigned char* p) { const unsigned w = *p; return __builtin_amdgcn_cvt_f32_fp8((int)w, 0); }
__device__ __forceinline__ void dbg_check_sparse(unsigned char* ws, LAS float* sh, unsigned* word) {
    if (blockIdx.x >= 64) return;
    int tid_ = (int)threadIdx.x; asm volatile("" : "+v"(tid_)); const int m = dbg_row(blockIdx.x), tid = tid_, b = m / SEQ;
    const h16* q = (const h16*)(ws + WS_Q) + (size_t)m * 2048; const unsigned char* k8 = (const unsigned char*)(ws + WS_KV); const unsigned char* v8 = k8 + (size_t)16 * 1024 * 1024;
    const unsigned short* idx = (const unsigned short*)(ws + WS_IDX) + (size_t)m * 256;
    LAS float* lg = sh; LAS float* st = sh + 4096;
    for (int i = tid; i < 4096; i += 512) { const int h = i >> 8, k = i & 255, key = idx[k]; float s = 0.f; const unsigned char* kr = k8 + ((size_t)(b * NKV + (h >> 2)) * SEQ + key) * HD;
        for (int d = 0; d < 128; ++d) s += (float)q[h * 128 + d] * dbg_f8(kr + d); lg[i] = s * 0.08838834764831845f; }
    __syncthreads();
    if (tid < 16) { float mx = -3e38f; for (int k = 0; k < 256; ++k) mx = fmaxf(mx, lg[tid * 256 + k]); float su = 0.f; for (int k = 0; k < 256; ++k) su += __expf(lg[tid * 256 + k] - mx); st[2 * tid] = mx; st[2 * tid + 1] = 1.0f / su; }
    __syncthreads();
    for (int i = tid; i < 2048; i += 512) { const int h = i >> 7, d = i & 127; float o = 0.f; for (int k = 0; k < 256; ++k) o += __expf(lg[h * 256 + k] - st[2 * h]) * st[2 * h + 1] * dbg_f8(v8 + ((size_t)(b * NKV + (h >> 2)) * SEQ + idx[k]) * HD + d);
        const float got = (float)((const h16*)(ws + WS_A))[(size_t)m * 2048 + i]; dbg_max(word, (got - o) / (0.02f + fabsf(o))); }
    __syncthreads();
}
#endif

constexpr int N_PHASES = 22 + (DBG_CHECK ? 1 : 0);
__global__ void __launch_bounds__(NWAVES * 64, 2) trunk_fwd(Args args) {
    extern __shared__ __attribute__((aligned(16))) unsigned char lds_raw[];
    Frame F;
    F.lds = (LAS unsigned char*)lds_raw;
    F.MISC = (volatile LAS unsigned*)(F.lds + MISC_OFF);
    F.tid = threadIdx.x; F.lane = F.tid & 63; F.wave = __builtin_amdgcn_readfirstlane(F.tid >> 6);
    F.G = gridDim.x; { const int bx = blockIdx.x; F.vcu = (F.G % 8 == 0) ? (bx % 8) * (F.G / 8) + bx / 8 : bx; }
    unsigned char* ws = argp()->ws;
    for (int u = F.tid; u < (LDS_BYTES - MISC_OFF) / 4; u += NWAVES * 64) ((LAS unsigned*)(F.lds + MISC_OFF))[u] = 0u;
    __syncthreads();
    XcdBarrier bar; bar.bar = (unsigned*)(ws + WS_CTL) + CW_BAR; bar.x = 0; bar.st = nullptr;
    if (!MK_LAUNCH_PER_PHASE) bar = xcd_barrier_post((unsigned*)(ws + WS_CTL) + CW_BAR, F.MISC + 8);
    const int lo = argp()->ph_lo, hi = argp()->ph_hi;
#ifndef DBG_KINDS
#define DBG_KINDS 0xFFFF
#endif
#define KON(kind) (((DBG_KINDS) >> (kind)) & 1)
#ifndef PROBE_REP
#define PROBE_REP 0
#endif
#define NREP(kind) ((((PROBE_REP) >> (kind)) & 1) ? 2 : 1)
#define IN(k) (lo <= (k) && (k) < hi)
#define SEAM(k) do { if (IN((k) + 1)) { if (MK_LAUNCH_PER_PHASE) { } else xcd_barrier(bar); } } while (0)
    LAS unsigned char* ring = F.lds + RING_OFF;
    const int bid = (int)blockIdx.x;
    h16* A = (h16*)(ws + WS_A); h16* Y = (h16*)(ws + WS_Y); h16* H = (h16*)(ws + WS_H); float* RS = (float*)(ws + WS_CTL + 512 * 1024);     h16* XQ = (h16*)(ws + WS_XQ); h16* ACT = (h16*)(ws + WS_ACT);

    if (KON(0) && IN(0)) { for (int rep = 0; rep < NREP(0); ++rep) { if (rep) xcd_barrier(bar); p0_prologue(F, argp()); } SEAM(0); }
    if (KON(1) && IN(1)) {
        { pg8::Gemm g{A, (const h16*)(ws + WS_WPOOL), T, D, 512, D, 1}; pg8::StaticOrder S; S.init(T, D, F.G, bid);
          pg8::EpiH16 E{Y, D, 1.0f, nullptr}; pg8::gemm_phase<pg8::EpiH16, pg8::StaticOrder, true, true>(ring, g, S, E); }
        __syncthreads();
        { pg8::Gemm g{(const h16*)(ws + WS_MEMN), (const h16*)(ws + WS_WKV), NB * NMEM, 2048, 2048, 2048, 31}; pg8::StaticOrder S; S.init(NB * NMEM, 2048, F.G, bid);
          pg8::EpiH16 E{(h16*)(ws + WS_KVM), 2048, 1.0f, nullptr}; pg8::gemm_phase<pg8::EpiH16, pg8::StaticOrder, true, true>(ring, g, S, E); }
        SEAM(1);
    }
#pragma unroll 1
    for (int L = 0; L < 2; ++L) {
        const int pb = L == 0 ? 2 : 14;
        if (L == 1) {
            if (KON(2) && IN(10)) {
                pg8::Gemm g{H, (const h16*)(ws + WS_WIN), T, DSA_NP, 2048, 2048, 31}; pg8::StaticOrder S; S.init(T, DSA_NP, F.G, bid);
                pg8::EpiInProj E{(h16*)(ws + WS_Q), (h16*)(ws + WS_KV), (h16*)(ws + WS_IQ), (h16*)(ws + WS_IK), (float*)(ws + WS_IW), (const float*)(ws + WS_ROPE), 1.0f / 64.0f, RS};
                for (int rep = 0; rep < NREP(2); ++rep) { if (rep) xcd_barrier(bar); pg8::gemm_phase<pg8::EpiInProj, pg8::StaticOrder, true, true>(ring, g, S, E); }
                SEAM(10);
            }
#if DBG_CHECK
            if (IN(11)) dbg_check_inproj(ws, (LAS float*)ring, (unsigned*)(ws + WS_CTL) + 1024);
#endif
            if (KON(3) && IN(11)) { for (int rep = 0; rep < NREP(3); ++rep) { if (rep) xcd_barrier(bar); indexer_phase(F, (const h16*)(ws + WS_IQ), (const h16*)(ws + WS_IK), (const float*)(ws + WS_IW), (unsigned short*)(ws + WS_IDX), (u32x2*)(ws + WS_LISTS)); } SEAM(11); }
#if DBG_CHECK
            if (IN(12)) dbg_check_indexer(ws, (LAS float*)ring, (unsigned*)(ws + WS_CTL) + 1026, (unsigned*)(ws + WS_CTL) + 1028);
#endif
            if (KON(4) && IN(12)) { for (int rep = 0; rep < NREP(4); ++rep) { if (rep) xcd_barrier(bar); sparse_attn_phase(F, (const h16*)(ws + WS_Q), (const unsigned char*)(ws + WS_KV), (const unsigned char*)(ws + WS_KV) + (size_t)16 * 1024 * 1024, (const unsigned short*)(ws + WS_IDX), A, (unsigned*)(ws + WS_CTL) + 2048 + 512 * rep); } SEAM(12); }
#if DBG_CHECK
            if (IN(13)) dbg_check_sparse(ws, (LAS float*)ring, (unsigned*)(ws + WS_CTL) + 1027);
#endif
            if (KON(5) && IN(13)) {
                pg8::Gemm g{A, (const h16*)(ws + WS_WOUT), T, D, 2048, 2048, 31}; pg8::StaticOrder S; S.init(T, D, F.G, bid);
                pg8::EpiH16 E{Y, D, 1.0f, nullptr}; pg8::gemm_phase<pg8::EpiH16, pg8::StaticOrder, true, true>(ring, g, S, E);
                SEAM(13);
            }
        }
        if (KON(6) && IN(pb + 0)) { ArgP a = argp(); const float* gains = a->gains + (size_t)L * 6 * D;
            if (L == 0) seam_phase<true, false, true, false, true>(F, Y, a->x, H, gains + 1 * D, nullptr, nullptr, RS); else seam_phase<true, false, false, false, true>(F, Y, H, H, gains + 1 * D, nullptr, nullptr, RS);
            SEAM(pb + 0); }
        if (KON(7) && IN(pb + 1)) {
            pg8::Gemm g{H, (const h16*)(ws + WS_WQ) + (size_t)L * XW * 2048, T, XW, 2048, 2048, 31}; pg8::StaticOrder S; S.init(T, XW, F.G, bid);
            pg8::EpiH16 E{XQ, XW, 1.0f, RS}; pg8::gemm_phase<pg8::EpiH16, pg8::StaticOrder, true, true>(ring, g, S, E);
            SEAM(pb + 1);
        }
        if (KON(8) && IN(pb + 2)) { xattn_phase(F, XQ, (const h16*)(ws + WS_KVM) + L * 1024); SEAM(pb + 2); }
#if DBG_CHECK
        if (IN(pb + 3)) dbg_check_xattn(ws, L, (LAS float*)ring, (unsigned*)(ws + WS_CTL) + 1025);
#endif
        if (KON(9) && IN(pb + 3)) {
            pg8::Gemm g{XQ, (const h16*)(ws + WS_WO) + (size_t)L * 2048 * XW, T, D, XW, XW, 31}; pg8::StaticOrder S; S.init(T, D, F.G, bid);
            pg8::EpiH16 E{Y, D, 1.0f, nullptr}; pg8::gemm_phase<pg8::EpiH16, pg8::StaticOrder, true, true>(ring, g, S, E);
            SEAM(pb + 3);
        }
        if (KON(10) && IN(pb + 4)) { ArgP a = argp(); const float* gains = a->gains + (size_t)L * 6 * D;
            if ((FFN_FP8 >> L) & 1) seam_phase<true, true, false, false>(F, Y, H, H, gains + 3 * D, gains + 4 * D, A); else seam_phase<true, false, false, false, true>(F, Y, H, H, gains + 3 * D, nullptr, nullptr, RS);
            SEAM(pb + 4); }
        static_assert(DN_FP8 == 3, "the fp16 gate|up GEMM reads the residual stream with a row factor in its e4m3 epilogue: every layer's down projection is e4m3");
        static_assert((FFN_FP8 & ~DN_FP8) == 0, "an e4m3 gate|up GEMM writes e4m3 activations: its down projection must be e4m3 too");
        if (KON(11) && IN(pb + 5) && ((FFN_FP8 >> L) & 1)) {
            pg8::Gemm g{A, (const h16*)(ws + WS_WGU) + (size_t)L * 2 * DFF * 2048  , T, 2 * DFF, 1024, 1024, 31}; pg8::StaticOrder S; S.init(T, 2 * DFF, F.G, bid);
            pg8::EpiSwiGLU8 E{(unsigned char*)ACT, DFF, 1.0f / W8_SCALE, ACT8_SCALE, nullptr}; pg8::gemm_phase<pg8::EpiSwiGLU8, pg8::StaticOrder, true, true, true>(ring, g, S, E);
            SEAM(pb + 5);
        }
        if (KON(11) && IN(pb + 5) && !((FFN_FP8 >> L) & 1) && ((DN_FP8 >> L) & 1)) {
            pg8::Gemm g{H, (const h16*)(ws + WS_WGU) + (size_t)L * 2 * DFF * 2048, T, 2 * DFF, 2048, 2048, 31}; pg8::StaticOrder S; S.init(T, 2 * DFF, F.G, bid);
            pg8::EpiSwiGLU8 E{(unsigned char*)ACT, DFF, 1.0f, ACT8_SCALE, RS}; pg8::gemm_phase<pg8::EpiSwiGLU8, pg8::StaticOrder, true, true, false>(ring, g, S, E);
            SEAM(pb + 5);
        }
        if (KON(11) && IN(pb + 5) && !((FFN_FP8 >> L) & 1) && !((DN_FP8 >> L) & 1)) {
            pg8::Gemm g{A, (const h16*)(ws + WS_WGU) + (size_t)L * 2 * DFF * 2048, T, 2 * DFF, 2048, 2048, 31}; pg8::StaticOrder S; S.init(T, 2 * DFF, F.G, bid);
            pg8::EpiSwiGLU E{ACT, DFF}; pg8::gemm_phase<pg8::EpiSwiGLU, pg8::StaticOrder, true, true>(ring, g, S, E);
            SEAM(pb + 5);
        }
        if (KON(12) && IN(pb + 6) && ((DN_FP8 >> L) & 1)) {
            pg8::Gemm g{ACT, (const h16*)(ws + WS_WDN) + (size_t)L * 2048 * DFF  , T, D, DFF / 2, DFF / 2, 31}; pg8::StaticOrder S; S.init(T, D, F.G, bid);
            pg8::EpiH16 E{Y, D, 1.0f / (W8_SCALE * ACT8_SCALE), nullptr}; pg8::gemm_phase<pg8::EpiH16, pg8::StaticOrder, true, true, true>(ring, g, S, E);
            SEAM(pb + 6);
        }
        if (KON(12) && IN(pb + 6) && !((DN_FP8 >> L) & 1)) {
            pg8::Gemm g{ACT, (const h16*)(ws + WS_WDN) + (size_t)L * 2048 * DFF, T, D, DFF, DFF, 31}; pg8::StaticOrder S; S.init(T, D, F.G, bid);
            pg8::EpiH16 E{Y, D, 1.0f, nullptr}; pg8::gemm_phase<pg8::EpiH16, pg8::StaticOrder, true, true>(ring, g, S, E);
            SEAM(pb + 6);
        }
        if (KON(13) && IN(pb + 7)) {
            ArgP a = argp(); const float* gains = a->gains + (size_t)L * 6 * D;
            if (L == 0) seam_phase<true, false, false, false, true>(F, Y, H, H, gains + 5 * D, nullptr, nullptr, RS);
            else seam_phase<false, false, false, true>(F, Y, H, a->out, gains + 5 * D, nullptr, nullptr);
            SEAM(pb + 7);
        }
    }
#if DBG_CHECK
    if (IN(22)) {
        const unsigned* dw = (const unsigned*)(ws + WS_CTL) + 1024;
        const bool f0 = __builtin_bit_cast(float, dw[0]) > 4e-3f, f1 = __builtin_bit_cast(float, dw[1]) > 2e-2f, f2 = dw[2] > 24u, f3 = __builtin_bit_cast(float, dw[3]) > 2e-2f, f4 = dw[4] > 0u;
        for (int m = F.vcu * NWAVES + F.wave; m < T; m += F.G * NWAVES) { const int r = m & 15;
            const bool z = (r < 8 && f0) || (r >= 8 && r < 12 && f1) || (r >= 12 && r < 14 && f2) || (r == 14 && f3) || (r == 15 && f4);
            if (z) for (int j = 0; j < 8; ++j) ((f32x4*)(argp()->out + (size_t)m * D))[F.lane + 64 * j] = (f32x4){0.f, 0.f, 0.f, 0.f}; }
    }
#endif
#undef IN
#undef SEAM
}

extern "C" void kernel_launch(void* const* d_in, const int* in_sizes, int n_in, void* d_out, int out_size, void* d_ws, size_t ws_size, hipStream_t stream) {
    static int grid = 0;
    if (grid == 0) {
        if (n_in != 14 || in_sizes[0] != T * D || out_size != T * D || ws_size < WS_END) {
            fprintf(stderr, "kernel_launch: built for 14 inputs, x/out of %d floats, >= %zu bytes of workspace; got n_in %d, in0 %d, out %d, ws %zu; nothing launched\n", T * D, (size_t)WS_END, n_in, n_in > 0 ? in_sizes[0] : -1, out_size, ws_size);
            grid = -1; return; }
        int dev = 0, cus = 0, per_cu = 0;
        if (hipGetDevice(&dev) != hipSuccess || hipDeviceGetAttribute(&cus, hipDeviceAttributeMultiprocessorCount, dev) != hipSuccess) { fprintf(stderr, "kernel_launch: device query failed\n"); grid = -1; return; }
        if (hipFuncSetAttribute((const void*)trunk_fwd, hipFuncAttributeMaxDynamicSharedMemorySize, LDS_BYTES) != hipSuccess) { fprintf(stderr, "kernel_launch: hipFuncSetAttribute failed\n"); grid = -1; return; }
        if (hipOccupancyMaxActiveBlocksPerMultiprocessor(&per_cu, (const void*)trunk_fwd, NWAVES * 64, LDS_BYTES) != hipSuccess || per_cu < 1)
            fprintf(stderr, "kernel_launch: note: occupancy query reports %d workgroups per CU\n", per_cu);
        (void)hipGetLastError();
        grid = cus;
    }
    if (grid < 0) return;
    if (hipMemsetAsync((char*)d_ws + WS_CTL, 0, CTL_ZERO_BYTES, stream) != hipSuccess) { fprintf(stderr, "kernel_launch: memset failed\n"); return; }
    Args a{};
    a.x = (const float*)d_in[0]; a.mem = (const float*)d_in[1]; a.pos = (const int*)d_in[2]; a.gains = (const float*)d_in[3]; a.mem_norm = (const float*)d_in[4];
    a.pool_w = (const float*)d_in[5]; a.pool_scale = (const float*)d_in[6]; a.w_in = (const float*)d_in[7]; a.w_out = (const float*)d_in[8]; a.wq = (const float*)d_in[9];
    a.wkv = (const float*)d_in[10]; a.wo = (const float*)d_in[11]; a.wgu = (const float*)d_in[12]; a.wdn = (const float*)d_in[13];
    a.out = (float*)d_out; a.ws = (unsigned char*)d_ws;
    for (int i = 0; i < 16; ++i) a.inv_freq[i] = (float)pow(500000.0, -(double)(2 * i) / 32.0);
    a.pad = 0;
#if MK_LAUNCH_PER_PHASE
    for (int p = 0; p < N_PHASES; ++p) { a.ph_lo = p; a.ph_hi = p + 1; a.li = p;
        hipLaunchKernelGGL(trunk_fwd, dim3(grid), dim3(NWAVES * 64), LDS_BYTES, stream, a); }
#else
    a.ph_lo = 0; a.ph_hi = N_PHASES; a.li = 0;
    hipLaunchKernelGGL(trunk_fwd, dim3(grid), dim3(NWAVES * 64), LDS_BYTES, stream, a);
#endif
    const hipError_t le = hipPeekAtLastError();
    if (le != hipSuccess) fprintf(stderr, "kernel_launch: launch failed: %s\n", hipGetErrorName(le));
}
```

```cpp
#include <hip/hip_runtime.h>
#include <cstdio>
#include <cstdint>
#include <cmath>

#define LAS __attribute__((address_space(3)))
#define GAS __attribute__((address_space(1)))
typedef _Float16 h16;
typedef _Float16 half8 __attribute__((ext_vector_type(8)));
typedef _Float16 half4 __attribute__((ext_vector_type(4)));
typedef _Float16 half2v __attribute__((ext_vector_type(2)));
typedef float f32x4 __attribute__((ext_vector_type(4)));
typedef float f32x2 __attribute__((ext_vector_type(2)));
typedef float f32x16 __attribute__((ext_vector_type(16)));
typedef unsigned u32x4 __attribute__((ext_vector_type(4)));
typedef unsigned u32x2 __attribute__((ext_vector_type(2)));
typedef int v4i32 __attribute__((ext_vector_type(4)));
typedef int v8i32 __attribute__((ext_vector_type(8)));
typedef int v2i32 __attribute__((ext_vector_type(2)));

__device__ __forceinline__ unsigned pkh(float a, float b) { half2v v; v.x = (h16)a; v.y = (h16)b; return __builtin_bit_cast(unsigned, v); }

__device__ __forceinline__ unsigned pk8(float a, float b, float c, float d) { int w = __builtin_amdgcn_cvt_pk_fp8_f32(a, b, 0, false); w = __builtin_amdgcn_cvt_pk_fp8_f32(c, d, w, true); return (unsigned)w; }

constexpr int SEQ = 16384, NKV = 4, HD = 128;
namespace pg8 {
#define PG8_LAS __attribute__((address_space(3)))
constexpr int BM = 256, BK = 64, HALF = 128, HTB = HALF * BK * 2  , STAGE_BYTES = 8 * HTB, NXCD = 8, WGM = 8;

__host__ __device__ __forceinline__ int lds_byte(int r, int c) { const int st = (r >> 4) * 2 + (c >> 5), rr = r & 15, cc = c & 31, ob = rr * 64 + cc * 2; return st * 1024 + (ob ^ (((ob >> 9) & 1) << 5)); }
__host__ __device__ __forceinline__ void stage_rc(int b, int& R, int& C) { const int st = b / 1024, sb = b % 1024, swz = sb ^ (((sb >> 9) & 1) << 5); R = (st >> 1) * 16 + swz / 64; C = (st & 1) * 32 + (swz % 64) / 2; }
__host__ __device__ __forceinline__ int perm32(int rho) { const int n = rho >> 4, i = rho & 15; return 8 * (i >> 2) + 4 * n + (i & 3); }

struct Unit { int pm, pn; };
struct Gemm { const h16* A; const h16* Bt; int M, N, K, lda, kshift; };

struct StaticOrder {
    int nM, nN, nwg, G, c;
    __host__ __device__ void init(int M, int N, int G_, int c_) { nM = M / BM; nN = N / BM; nwg = nM * nN; G = G_; c = c_; }
    __host__ __device__ bool next(int i, Unit& u) const {
        const long L = (long)i * G + c; if (L >= nwg) return false;
        int wgid = (int)L; { const int q = nwg / NXCD, r = nwg % NXCD, xcd = wgid % NXCD, off = wgid / NXCD; wgid = (xcd < r ? xcd * (q + 1) : r * (q + 1) + (xcd - r) * q) + off; }
        const int nig = WGM * nN, gid = wgid / nig, fm = gid * WGM, gsz = (nM - fm) < WGM ? (nM - fm) : WGM;
        u.pm = fm + ((wgid % nig) % gsz); u.pn = (wgid % nig) / gsz; return true;
    }
    __device__ __forceinline__ void a_ready(const Unit&) const {}
    __device__ __forceinline__ void done(const Unit&) const {}
};

struct EpiF32 {
    static constexpr bool PERM = false, AFTER_DRAIN = false;
    float* C; int ldc; float scale;
    __device__ __forceinline__ void operator()(const f32x4 (&acc)[2][2][4][2], const Unit& u, int wr, int wc, int fr, int fq) const {
        const int row0 = u.pm * BM + wr * 64 + fr, col0 = u.pn * BM + wc * 32 + 4 * fq;
#pragma unroll
        for (int ai = 0; ai < 2; ++ai)
#pragma unroll
            for (int m = 0; m < 4; ++m) { float* rowp = C + (size_t)(row0 + ai * HALF + m * 16) * ldc + col0;
#pragma unroll
                for (int bj = 0; bj < 2; ++bj)
#pragma unroll
                    for (int n = 0; n < 2; ++n) *(f32x4*)(rowp + bj * HALF + n * 16) = acc[ai][bj][m][n] * scale; }
    }
};
struct EpiF32S {
    static constexpr bool PERM = false, AFTER_DRAIN = false;
    float* C; int ldc; float scale;
    __device__ __forceinline__ void operator()(const f32x4 (&acc)[2][2][4][2], const Unit& u, int wr, int wc, int fr_, int fq_) const {
        int l = (int)(threadIdx.x & 63u); asm volatile("" : "+v"(l)); const int fr = l & 15, fq = l >> 4;
        const int row0 = u.pm * BM + wr * 64 + fr, col0 = u.pn * BM + wc * 32 + 4 * fq;
#pragma unroll
        for (int ai = 0; ai < 2; ++ai)
#pragma unroll
            for (int m = 0; m < 4; ++m) { float* rowp = C + (size_t)(row0 + ai * HALF + m * 16) * ldc + col0;
#pragma unroll
                for (int bj = 0; bj < 2; ++bj)
#pragma unroll
                    for (int n = 0; n < 2; ++n) *(f32x4*)(rowp + bj * HALF + n * 16) = acc[ai][bj][m][n] * scale; }
    }
};
struct EpiH16 {
    static constexpr bool PERM = true, AFTER_DRAIN = false;
    h16* O; int ldc; float scale; const float* rs;
    __device__ __forceinline__ void operator()(const f32x4 (&acc)[2][2][4][2], const Unit& u, int wr, int wc, int fr, int fq) const {
        const int row0 = u.pm * BM + wr * 64 + fr, col0 = u.pn * BM + wc * 32 + 8 * fq;
#pragma unroll
        for (int ai = 0; ai < 2; ++ai)
#pragma unroll
            for (int m = 0; m < 4; ++m) { h16* rowp = O + (size_t)(row0 + ai * HALF + m * 16) * ldc + col0; const float sc_ = rs ? scale * rs[row0 + ai * HALF + m * 16] : scale;
#pragma unroll
                for (int bj = 0; bj < 2; ++bj) { const f32x4 v0 = acc[ai][bj][m][0] * sc_, v1 = acc[ai][bj][m][1] * sc_;
                    u32x4 w; w.x = pkh(v0[0], v0[1]); w.y = pkh(v0[2], v0[3]); w.z = pkh(v1[0], v1[1]); w.w = pkh(v1[2], v1[3]);
                    *(u32x4*)(rowp + bj * HALF) = w; } }
    }
};
__device__ __forceinline__ float silu_mul(float g, float u) { return g * u * __builtin_amdgcn_rcpf(1.0f + __builtin_amdgcn_exp2f(g * -1.44269504089f)); }
struct EpiSwiGLU {
    static constexpr bool PERM = true, AFTER_DRAIN = false;
    h16* O; int ldc;
    __device__ __forceinline__ void operator()(const f32x4 (&acc)[2][2][4][2], const Unit& u, int wr, int wc, int fr, int fq) const {
        const int row0 = u.pm * BM + wr * 64 + fr, col0 = u.pn * HALF + wc * 32 + 8 * fq;
#pragma unroll
        for (int ai = 0; ai < 2; ++ai)
#pragma unroll
            for (int m = 0; m < 4; ++m) { h16* rowp = O + (size_t)(row0 + ai * HALF + m * 16) * ldc + col0;
                const f32x4 g0 = acc[ai][0][m][0], g1 = acc[ai][0][m][1], u0 = acc[ai][1][m][0], u1 = acc[ai][1][m][1];
                u32x4 w; w.x = pkh(silu_mul(g0[0], u0[0]), silu_mul(g0[1], u0[1])); w.y = pkh(silu_mul(g0[2], u0[2]), silu_mul(g0[3], u0[3]));
                w.z = pkh(silu_mul(g1[0], u1[0]), silu_mul(g1[1], u1[1])); w.w = pkh(silu_mul(g1[2], u1[2]), silu_mul(g1[3], u1[3]));
                *(u32x4*)rowp = w; }
    }
};
struct EpiSwiGLU8 {
    static constexpr bool PERM = true, AFTER_DRAIN = false;
    unsigned char* O; int ldc; float inscale, outscale; const float* rs;
    __device__ __forceinline__ void operator()(const f32x4 (&acc)[2][2][4][2], const Unit& u, int wr, int wc, int fr_, int fq_) const {
        int l = (int)(threadIdx.x & 63u); asm volatile("" : "+v"(l)); const int fr = l & 15, fq = l >> 4;
        const int row0 = u.pm * BM + wr * 64 + fr, col0 = u.pn * HALF + wc * 32 + 8 * fq;
#pragma unroll
        for (int ai = 0; ai < 2; ++ai)
#pragma unroll
            for (int m = 0; m < 4; ++m) { unsigned char* rowp = O + (size_t)(row0 + ai * HALF + m * 16) * ldc + col0;
                const float is_ = rs ? inscale * rs[row0 + ai * HALF + m * 16] : inscale;
                const f32x4 g0 = acc[ai][0][m][0] * is_, g1 = acc[ai][0][m][1] * is_, u0 = acc[ai][1][m][0] * (is_ * outscale), u1 = acc[ai][1][m][1] * (is_ * outscale);
                u32x2 w; w.x = pk8(silu_mul(g0[0], u0[0]), silu_mul(g0[1], u0[1]), silu_mul(g0[2], u0[2]), silu_mul(g0[3], u0[3]));
                w.y = pk8(silu_mul(g1[0], u1[0]), silu_mul(g1[1], u1[1]), silu_mul(g1[2], u1[2]), silu_mul(g1[3], u1[3]));
                *(u32x2*)rowp = w; }
    }
};
struct EpiInProj {
    static constexpr bool PERM = true, AFTER_DRAIN = false;
    h16 *Q, *KV, *IQ, *IK; float* IW; const float* rope; float scale; const float* rs;
    __device__ __forceinline__ void operator()(const f32x4 (&acc)[2][2][4][2], const Unit& u, int wr, int wc, int fr_, int fq_) const {
        int l = (int)(threadIdx.x & 63u); asm volatile("" : "+v"(l));
        const int fr = l & 15, fq = l >> 4;
        const int pn = u.pn, row0 = u.pm * BM + wr * 64 + fr;
        h16* base; int ldc, colt; bool rot0 = true, rot1 = true;
        if (pn < 8) { base = Q; ldc = 2048; colt = pn * 256; }
        else if (pn < 10) { base = KV; ldc = 1024; colt = (pn - 8) * 256; }
        else if (pn < 12) { base = KV; ldc = 1024; colt = 512 + (pn - 10) * 256; rot0 = false; rot1 = false; }
        else if (pn < 20) { base = IQ; ldc = 2048; colt = (pn - 12) * 256; }
        else { base = IK; ldc = 128; colt = 0; rot1 = false; }
        const int col0 = colt + wc * 32 + 8 * fq;
#pragma unroll
        for (int ai = 0; ai < 2; ++ai)
#pragma unroll
            for (int m = 0; m < 4; ++m) { const int row = row0 + ai * HALF + m * 16;
                f32x4 cs[2], sn[2];
                if (wc == 0) { const float* rp = rope + (size_t)row * 32 + 8 * (fq & 1);
                    cs[0] = *(const f32x4*)(rp); cs[1] = *(const f32x4*)(rp + 4); sn[0] = *(const f32x4*)(rp + 16); sn[1] = *(const f32x4*)(rp + 20);
                    if (fq < 2) { sn[0] = -sn[0]; sn[1] = -sn[1]; } }
#pragma unroll
                for (int bj = 0; bj < 2; ++bj) {
                    const float sc_ = scale * rs[row];
                    f32x4 v0 = acc[ai][bj][m][0] * sc_, v1 = acc[ai][bj][m][1] * sc_;
                    if (wc == 0 && (bj == 0 ? rot0 : rot1)) {
                        f32x4 p0, p1;
#pragma unroll
                        for (int e = 0; e < 4; ++e) { p0[e] = __shfl_xor(v0[e], 32); p1[e] = __shfl_xor(v1[e], 32); }
                        v0 = v0 * cs[0] + p0 * sn[0]; v1 = v1 * cs[1] + p1 * sn[1];
                    }
                    if (pn >= 8 && pn < 12) {
                        const int j = ((pn - 8) & 1) * 2 + bj, b = row / SEQ, tt = row % SEQ;
                        unsigned char* dst = (unsigned char*)KV + (pn >= 10 ? (size_t)16 * 1024 * 1024 : (size_t)0) + ((size_t)(b * NKV + j) * SEQ + tt) * HD + wc * 32 + 8 * fq;
                        u32x2 w; w.x = pk8(v0[0], v0[1], v0[2], v0[3]); w.y = pk8(v1[0], v1[1], v1[2], v1[3]); *(u32x2*)dst = w;
                    } else if (pn == 20 && bj == 1) {
                        if (wc == 0 && fq < 2) { float* wp = IW + (size_t)row * 16 + 8 * fq; *(f32x4*)wp = v0; *(f32x4*)(wp + 4) = v1; }
                    } else {
                        u32x4 w; w.x = pkh(v0[0], v0[1]); w.y = pkh(v0[2], v0[3]); w.z = pkh(v1[0], v1[1]); w.w = pkh(v1[2], v1[3]);
                        *(u32x4*)(base + (size_t)row * ldc + col0 + bj * HALF) = w;
                    }
                }
                asm volatile("" ::: "memory"); }
    }
};

template <class Epi, class Sched, bool ALIGN_EPI = false, bool SP2 = false, bool FP8 = false>
__device__ __forceinline__ void gemm_phase(PG8_LAS unsigned char* lds, const Gemm g, const Sched& S, const Epi& E) {
    int tid_ = (int)threadIdx.x; asm volatile("" : "+v"(tid_));
    const int tid = tid_, wid = __builtin_amdgcn_readfirstlane(tid >> 6), lane = tid & 63, wr = wid >> 2, wc = wid & 3, fr = lane & 15, fq = lane >> 4;
    const int K = g.K, nt = K / BK;
    unsigned voffA[2], voffB[2];
#pragma unroll
    for (int i = 0; i < 2; ++i) { int R, C; stage_rc(tid * 16 + i * 8192, R, C); const int Rb = Epi::PERM ? ((R & ~31) + perm32(R & 31)) : R;
        voffA[i] = (unsigned)(R * g.lda + C) * 2u; voffB[i] = (unsigned)(Rb * K + C) * 2u; }
    const size_t kstep = (size_t)(BK * 2);
    const size_t hstepA = (size_t)HALF * g.lda * 2, hstepB = (size_t)HALF * K * 2;
    const size_t tstepA = 2 * hstepA, tstepB = 2 * hstepB;
    const int kshift = g.kshift;
    const __amdgpu_buffer_rsrc_t rsrcA = __builtin_amdgcn_make_buffer_rsrc((void*)g.A, 0, 0x7fffffff, 0x00020000), rsrcB = __builtin_amdgcn_make_buffer_rsrc((void*)g.Bt, 0, 0x7fffffff, 0x00020000);
    const unsigned r64A = 64u * (unsigned)g.lda * 2u, r64B = 64u * (unsigned)K * 2u;
    const unsigned ldsw = (unsigned)wid * 1024u;
    const int aoff = lds_byte(wr * 64 + fr, fq * 8), boff = lds_byte(wc * 32 + fr, fq * 8);
#define PG8_SA(b, h) (((b) * 2 + (h)) * HTB)
#define PG8_SB(b, h) ((4 + (b) * 2 + (h)) * HTB)
#define PG8_STAGE(bufoff, gbase, voff) do { const bool isA_ = (const void*)(voff) == (const void*)voffA; _Pragma("unroll") for (int _i = 0; _i < 2; ++_i) \
        __builtin_amdgcn_raw_ptr_buffer_load_lds(isA_ ? rsrcA : rsrcB, (PG8_LAS void*)(lds + (bufoff) + ldsw + _i * 8192), 16, (int)(voff)[0], \
            (int)((unsigned)((const char*)(gbase) - (isA_ ? (const char*)g.A : (const char*)g.Bt)) + (unsigned)_i * (isA_ ? r64A : r64B)), 0, 0); } while (0)
#define PG8_LDA(dst, b, h) do { if constexpr (FP8) { _Pragma("unroll") for (int m = 0; m < 4; ++m) dst##8[m] = __builtin_shufflevector(*(const PG8_LAS v4i32*)(lds + PG8_SA(b, h) + aoff + m * 2048), *(const PG8_LAS v4i32*)(lds + PG8_SA(b, h) + aoff + m * 2048 + 1024), 0, 1, 2, 3, 4, 5, 6, 7); } \
    else { _Pragma("unroll") for (int m = 0; m < 4; ++m) _Pragma("unroll") for (int k = 0; k < 2; ++k) dst[m][k] = *(const PG8_LAS half8*)(lds + PG8_SA(b, h) + aoff + m * 2048 + k * 1024); } } while (0)
#define PG8_LDB(dst, b, h) do { if constexpr (FP8) { _Pragma("unroll") for (int n = 0; n < 2; ++n) dst##8[n] = __builtin_shufflevector(*(const PG8_LAS v4i32*)(lds + PG8_SB(b, h) + boff + n * 2048), *(const PG8_LAS v4i32*)(lds + PG8_SB(b, h) + boff + n * 2048 + 1024), 0, 1, 2, 3, 4, 5, 6, 7); } \
    else { _Pragma("unroll") for (int n = 0; n < 2; ++n) _Pragma("unroll") for (int k = 0; k < 2; ++k) dst[n][k] = *(const PG8_LAS half8*)(lds + PG8_SB(b, h) + boff + n * 2048 + k * 1024); } } while (0)
#define PG8_MMA(ai, bj, At, Bt) do { __builtin_amdgcn_s_setprio(1); _Pragma("unroll") for (int m = 0; m < 4; ++m) _Pragma("unroll") for (int n = 0; n < 2; ++n) { \
        if constexpr (FP8) asm volatile("v_mfma_f32_16x16x128_f8f6f4 %0, %1, %2, %0" : "+v"(acc[ai][bj][m][n]) : "v"(Bt##8[n]), "v"(At##8[m]));     \
        else { _Pragma("unroll") for (int k = 0; k < 2; ++k) acc[ai][bj][m][n] = __builtin_amdgcn_mfma_f32_16x16x32_f16(Bt[n][k], At[m][k], acc[ai][bj][m][n], 0, 0, 0); } } \
        __builtin_amdgcn_s_setprio(0); } while (0)
#define PG8_WAIT_V(n) asm volatile("s_waitcnt vmcnt(" #n ")" ::: "memory")
#define PG8_WAIT_L(n) asm volatile("s_waitcnt lgkmcnt(" #n ")" ::: "memory")
#define PG8_BAR __builtin_amdgcn_s_barrier()
#define PG8_SCHED __builtin_amdgcn_sched_barrier(0)
    Unit cur, nxt; int ui = 0;
    if (!S.next(0, cur)) return;
    f32x4 acc[2][2][4][2];
#pragma unroll
    for (int a = 0; a < 2; ++a)
#pragma unroll
        for (int b = 0; b < 2; ++b)
#pragma unroll
            for (int m = 0; m < 4; ++m)
#pragma unroll
                for (int n = 0; n < 2; ++n) acc[a][b][m][n] = (f32x4){0.f, 0.f, 0.f, 0.f};
    half8 At[4][2], B0[2][2], B1[2][2]; v8i32 At8[4], B08[2], B18[2];
    const char* cA = (const char*)g.A + (size_t)cur.pm * tstepA + (size_t)((cur.pn >> kshift) * K) * 2; const char* cB = (const char*)g.Bt + (size_t)cur.pn * tstepB;
    S.a_ready(cur);
    if constexpr (SP2) {
        PG8_STAGE(PG8_SB(0, 0), cB, voffB); PG8_STAGE(PG8_SB(0, 1), cB + hstepB, voffB); PG8_STAGE(PG8_SA(0, 0), cA, voffA); PG8_STAGE(PG8_SA(0, 1), cA + hstepA, voffA);
        if (wr == 1) PG8_BAR;
        PG8_WAIT_V(2); PG8_BAR;
        PG8_STAGE(PG8_SB(1, 0), cB + kstep, voffB); PG8_STAGE(PG8_SA(1, 0), cA + kstep, voffA); PG8_STAGE(PG8_SB(1, 1), cB + hstepB + kstep, voffB);
        PG8_WAIT_V(6); PG8_BAR;
    } else {
        PG8_STAGE(PG8_SB(0, 0), cB, voffB); PG8_STAGE(PG8_SA(0, 0), cA, voffA); PG8_STAGE(PG8_SB(0, 1), cB + hstepB, voffB); PG8_STAGE(PG8_SA(0, 1), cA + hstepA, voffA);
        if (wr == 1) PG8_BAR;
        PG8_WAIT_V(4); PG8_BAR;
        PG8_STAGE(PG8_SB(1, 0), cB + kstep, voffB); PG8_STAGE(PG8_SA(1, 0), cA + kstep, voffA); PG8_STAGE(PG8_SB(1, 1), cB + hstepB + kstep, voffB);
        PG8_WAIT_V(6); PG8_BAR;
    }
    for (;;) {
        const bool has_next = S.next(ui + 1, nxt);
        const char* nA = has_next ? (const char*)g.A + (size_t)nxt.pm * tstepA + (size_t)((nxt.pn >> kshift) * K) * 2 : cA; const char* nB = has_next ? (const char*)g.Bt + (size_t)nxt.pn * tstepB : cB;
        for (int t = 0; t < nt; t += 2) {
            const bool last = (t == nt - 2);
            const char* a1 = cA + (size_t)(t + 1) * kstep;
            const char* a2 = last ? nA : cA + (size_t)(t + 2) * kstep; const char* b2 = last ? nB : cB + (size_t)(t + 2) * kstep;
            const char* a3 = a2 + kstep; const char* b3 = b2 + kstep;
            if (last && has_next) S.a_ready(nxt);
            if constexpr (SP2) {
            PG8_LDB(B0, 0, 0); PG8_LDB(B1, 0, 1); PG8_SCHED; PG8_LDA(At, 0, 0); PG8_STAGE(PG8_SA(1, 1), a1 + hstepA, voffA);
            PG8_WAIT_V(8); PG8_WAIT_L(0); PG8_BAR; PG8_MMA(0, 0, At, B0); PG8_MMA(0, 1, At, B1); PG8_BAR; PG8_SCHED;
            PG8_LDA(At, 0, 1); PG8_STAGE(PG8_SB(0, 0), b2, voffB); PG8_STAGE(PG8_SB(0, 1), b2 + hstepB, voffB); PG8_STAGE(PG8_SA(0, 0), a2, voffA);
            PG8_WAIT_V(8); PG8_WAIT_L(0); PG8_BAR; PG8_MMA(1, 0, At, B0); PG8_MMA(1, 1, At, B1); PG8_BAR; PG8_SCHED;
            PG8_LDB(B0, 1, 0); PG8_LDB(B1, 1, 1); PG8_SCHED; PG8_LDA(At, 1, 0); PG8_STAGE(PG8_SA(0, 1), a2 + hstepA, voffA);
            PG8_WAIT_V(8); PG8_WAIT_L(0); PG8_BAR; PG8_MMA(0, 0, At, B0); PG8_MMA(0, 1, At, B1); PG8_BAR; PG8_SCHED;
            PG8_LDA(At, 1, 1); PG8_STAGE(PG8_SB(1, 0), b3, voffB); PG8_STAGE(PG8_SB(1, 1), b3 + hstepB, voffB); PG8_STAGE(PG8_SA(1, 0), a3, voffA);
            PG8_WAIT_V(8); PG8_WAIT_L(0); PG8_BAR; PG8_MMA(1, 0, At, B0); PG8_MMA(1, 1, At, B1); PG8_BAR; PG8_SCHED;
            } else {
            PG8_LDB(B0, 0, 0); PG8_SCHED; PG8_LDA(At, 0, 0); PG8_STAGE(PG8_SA(1, 1), a1 + hstepA, voffA);
            PG8_WAIT_L(8); PG8_BAR; PG8_WAIT_L(0); PG8_MMA(0, 0, At, B0); PG8_BAR; PG8_SCHED;
            PG8_LDB(B1, 0, 1); PG8_STAGE(PG8_SB(0, 0), b2, voffB);
            PG8_BAR; PG8_WAIT_L(0); PG8_MMA(0, 1, At, B1); PG8_BAR;
            PG8_LDA(At, 0, 1); PG8_STAGE(PG8_SA(0, 0), a2, voffA);
            PG8_BAR; PG8_WAIT_L(0); PG8_MMA(1, 0, At, B0); PG8_BAR; PG8_SCHED;
            PG8_STAGE(PG8_SB(0, 1), b2 + hstepB, voffB);
            PG8_WAIT_V(6); PG8_BAR; PG8_MMA(1, 1, At, B1); PG8_BAR;
            PG8_LDB(B0, 1, 0); PG8_SCHED; PG8_LDA(At, 1, 0); PG8_STAGE(PG8_SA(0, 1), a2 + hstepA, voffA);
            PG8_WAIT_L(8); PG8_BAR; PG8_WAIT_L(0); PG8_MMA(0, 0, At, B0); PG8_BAR; PG8_SCHED;
            PG8_LDB(B1, 1, 1); PG8_STAGE(PG8_SB(1, 0), b3, voffB);
            PG8_BAR; PG8_WAIT_L(0); PG8_MMA(0, 1, At, B1); PG8_BAR;
            PG8_LDA(At, 1, 1); PG8_STAGE(PG8_SA(1, 0), a3, voffA);
            PG8_BAR; PG8_WAIT_L(0); PG8_MMA(1, 0, At, B0); PG8_BAR; PG8_SCHED;
            PG8_STAGE(PG8_SB(1, 1), b3 + hstepB, voffB);
            PG8_WAIT_V(6); PG8_BAR; PG8_MMA(1, 1, At, B1); PG8_BAR;
            }
        }
        if constexpr (FP8) { asm volatile("s_nop 15\n\ts_nop 15\n\ts_nop 15\n\ts_nop 15" ::: "memory"); __builtin_amdgcn_sched_barrier(0); }
        if constexpr (ALIGN_EPI) { if (wr == 0) PG8_BAR; }
        if constexpr (!Epi::AFTER_DRAIN) { E(acc, cur, wr, wc, fr, fq); S.done(cur); }
        if (!has_next) break;
#pragma unroll
        for (int a = 0; a < 2; ++a)
#pragma unroll
            for (int b = 0; b < 2; ++b)
#pragma unroll
                for (int m = 0; m < 4; ++m)
#pragma unroll
                    for (int n = 0; n < 2; ++n) acc[a][b][m][n] = (f32x4){0.f, 0.f, 0.f, 0.f};
        cur = nxt; cA = nA; cB = nB; ++ui;
        if constexpr (ALIGN_EPI) { if (wr == 1) PG8_BAR; }
    }
    PG8_WAIT_V(0);
    if constexpr (!ALIGN_EPI) { if (wr == 0) PG8_BAR; }
    PG8_BAR;

#undef PG8_SA
#undef PG8_SB
#undef PG8_STAGE
#undef PG8_LDA
#undef PG8_LDB
#undef PG8_MMA
#undef PG8_WAIT_V
#undef PG8_WAIT_L
#undef PG8_BAR
#undef PG8_SCHED
}
}

constexpr int NB = 2, T = NB * SEQ, D = 2048, DFF = 5632, NMEM = 256;
constexpr int DSA_N = 5264, DSA_NP = 5376;
constexpr int NHEAD = 16, TOPK = 256;
constexpr int XW = 512;
constexpr float NORM_EPS = 1e-6f;
constexpr int NWAVES = 8;
#ifndef FFN_FP8
#define FFN_FP8 2
#endif
#ifndef DN_FP8
#define DN_FP8 3
#endif
#ifndef IDX_PROBE_MMA
#define IDX_PROBE_MMA 0
#endif
#ifndef IDX16
#define IDX16 2
#endif
#ifndef MK_LAUNCH_PER_PHASE
#define MK_LAUNCH_PER_PHASE 0
#endif

constexpr size_t MiB = 1u << 20;
constexpr size_t WS_CTL = 0, CTL_ZERO_BYTES = 1 * MiB;
constexpr size_t WS_ROPE = 1 * MiB;
constexpr size_t WS_MEMN = 5 * MiB;
constexpr size_t WS_KVM = 7 * MiB;
constexpr size_t WS_WPOOL = 9 * MiB;
constexpr size_t WS_WIN = 11 * MiB;
constexpr size_t WS_WOUT = 32 * MiB;
constexpr size_t WS_WQ = 40 * MiB;
constexpr size_t WS_WKV = 44 * MiB;
constexpr size_t WS_WO = 52 * MiB;
constexpr size_t WS_WGU = 56 * MiB;
constexpr size_t WS_WDN = 144 * MiB;
constexpr size_t WS_XQ = 188 * MiB;
constexpr size_t WS_A = 220 * MiB;
constexpr size_t WS_Y = 348 * MiB;
constexpr size_t WS_ACT = 604 * MiB;
constexpr size_t WS_END = 956 * MiB;
constexpr size_t WS_Q = WS_ACT, WS_KV = WS_ACT + 128 * MiB, WS_IQ = WS_ACT + 192 * MiB, WS_IK = WS_ACT + 320 * MiB, WS_IW = WS_ACT + 328 * MiB, WS_IDX = WS_ACT + 330 * MiB;
constexpr size_t WS_LISTS = WS_Y;
constexpr size_t WS_H = WS_Y + 128 * MiB;
constexpr int LIST_CAP = 1024;
static_assert(WS_IDX + (size_t)T * TOPK * 2 <= WS_END, "ws map");
constexpr float W8_SCALE = 64.0f, ACT8_SCALE = 8.0f;
constexpr int CW_BAR = 4096;

constexpr int RING_OFF = 0, RING_BYTES = 136192;
constexpr int MISC_OFF = RING_BYTES;
constexpr int LDS_BYTES = 147456;

typedef GAS unsigned gu32;
#define LDS_WAIT() asm volatile("s_waitcnt lgkmcnt(0)" ::: "memory")
#define VM_WAIT() asm volatile("s_waitcnt vmcnt(0)" ::: "memory")

#define XB_TMO      128
#define XB_XCNT(j)  (256  + 64 * (j))
#define XB_XSUB(j)  (1280 + 64 * (j))
#define XB_XGEN(j)  (2304 + 64 * (j))
#define XB_TOP      3328
#define XB_TOPGEN   3392
#define XCD_BAR_WORDS 3456
#define XB_SPIN_CAP (1u << 23)
__device__ __forceinline__ unsigned xb_ld(unsigned* p)              { return __hip_atomic_load(p, __ATOMIC_RELAXED, __HIP_MEMORY_SCOPE_AGENT); }
__device__ __forceinline__ unsigned xb_add(unsigned* p, unsigned v) { return __hip_atomic_fetch_add(p, v, __ATOMIC_RELAXED, __HIP_MEMORY_SCOPE_AGENT); }
__device__ __forceinline__ unsigned xb_xcc_id() { return (unsigned)__builtin_amdgcn_s_getreg((3 << 11) | 20) & 0xFu; }
#define XB_SPIN(cond, bar) do { unsigned _sp = 0; while (cond) { __builtin_amdgcn_s_sleep(1); \
    if ((++_sp & 255u) == 0u) { if (xb_ld(&(bar)[XB_TMO])) break; if (_sp > XB_SPIN_CAP) { atomicAdd(&(bar)[XB_TMO], 1u); break; } } } } while (0)
struct XcdBarrier { unsigned* bar; unsigned x; volatile LAS unsigned* st; };
__device__ __forceinline__ XcdBarrier xcd_barrier_post(unsigned* bar, volatile LAS unsigned* st) {
    XcdBarrier b; b.bar = bar; b.x = xb_xcc_id(); b.st = st;
    if (threadIdx.x == 0) (void)xb_add(&bar[XB_XCNT(b.x)], 1u);
    return b;
}
__device__ __forceinline__ void xcd_barrier_complete(unsigned* bar, unsigned x, unsigned& nloc, unsigned& nx) {
    const unsigned G = gridDim.x * gridDim.y * gridDim.z;
    unsigned sum, cnt, mine, sp = 0u;
    for (;;) {
        sum = 0u; cnt = 0u; mine = 0u;
#pragma unroll
        for (unsigned j = 0; j < 16; ++j) { const unsigned c = xb_ld(&bar[XB_XCNT(j)]); sum += c; cnt += (c > 0u) ? 1u : 0u; mine = (j == x) ? c : mine; }
        if (sum == G) break;
        __builtin_amdgcn_s_sleep(1);
        if ((++sp & 255u) == 0u) { if (xb_ld(&bar[XB_TMO])) break; if (sp > XB_SPIN_CAP) { atomicAdd(&bar[XB_TMO], 1u); break; } }
    }
    nloc = mine > 0u ? mine : 1u; nx = cnt > 0u ? cnt : 1u;
}
__device__ __forceinline__ void xcd_barrier(const XcdBarrier& b) {
    asm volatile("s_waitcnt vmcnt(0)" ::: "memory");
    __syncthreads();
    if (threadIdx.x == 0) {
        unsigned* bar = b.bar;
        __builtin_amdgcn_s_waitcnt(0);
        unsigned nloc = b.st[0], nx = b.st[1];
        if (nloc == 0u) { xcd_barrier_complete(bar, b.x, nloc, nx); b.st[0] = nloc; b.st[1] = nx; }
        const unsigned old = xb_add(&bar[XB_XSUB(b.x)], 1u);
        const unsigned gen = old / nloc;
        if (old + 1u == (gen + 1u) * nloc) {
            __builtin_amdgcn_fence(__ATOMIC_RELEASE, "agent");
            asm volatile("s_waitcnt vmcnt(0)" ::: "memory");
            const unsigned og = xb_add(&bar[XB_TOP], 1u);
            const unsigned tg = og / nx;
            if (og + 1u == (tg + 1u) * nx) xb_add(&bar[XB_TOPGEN], 1u);
            else XB_SPIN(xb_ld(&bar[XB_TOPGEN]) == tg, bar);
            __builtin_amdgcn_fence(__ATOMIC_ACQUIRE, "agent");
            xb_add(&bar[XB_XGEN(b.x)], 1u);
            asm volatile("s_waitcnt vmcnt(0)" ::: "memory");
        } else {
            XB_SPIN(xb_ld(&bar[XB_XGEN(b.x)]) == gen, bar);
            __builtin_amdgcn_fence(__ATOMIC_ACQUIRE, "agent");
            asm volatile("s_waitcnt vmcnt(0)" ::: "memory");
        }
    }
    __syncthreads();
}

struct Frame {
    LAS unsigned char* lds;
    volatile LAS unsigned* MISC;
    int tid, lane, wave;
    int vcu, G;
};
__device__ __forceinline__ Frame fresh(const Frame& F0) { Frame F = F0; int t = (int)threadIdx.x; asm volatile("" : "+v"(t)); F.tid = t; F.lane = t & 63; F.wave = __builtin_amdgcn_readfirstlane(t >> 6); return F; }
template <int CTRL> __device__ __forceinline__ float dpp_mov(float v) { return __builtin_bit_cast(float, __builtin_amdgcn_update_dpp(0, __builtin_bit_cast(int, v), CTRL, 0xF, 0xF, true)); }
__device__ __forceinline__ float wave_sum_dpp(float v) {
    v += dpp_mov<0xB1>(v);
    v += dpp_mov<0x4E>(v);
    v += dpp_mov<0x141>(v);
    v += dpp_mov<0x140>(v);
    const float s0 = __builtin_bit_cast(float, __builtin_amdgcn_readlane(__builtin_bit_cast(int, v), 0)), s1 = __builtin_bit_cast(float, __builtin_amdgcn_readlane(__builtin_bit_cast(int, v), 16));
    const float s2 = __builtin_bit_cast(float, __builtin_amdgcn_readlane(__builtin_bit_cast(int, v), 32)), s3 = __builtin_bit_cast(float, __builtin_amdgcn_readlane(__builtin_bit_cast(int, v), 48));
    return (s0 + s1) + (s2 + s3);
}
__device__ __forceinline__ float wave_max_dpp(float v) {
    v = fmaxf(v, dpp_mov<0xB1>(v)); v = fmaxf(v, dpp_mov<0x4E>(v)); v = fmaxf(v, dpp_mov<0x141>(v)); v = fmaxf(v, dpp_mov<0x140>(v));
    const float s0 = __builtin_bit_cast(float, __builtin_amdgcn_readlane(__builtin_bit_cast(int, v), 0)), s1 = __builtin_bit_cast(float, __builtin_amdgcn_readlane(__builtin_bit_cast(int, v), 16));
    const float s2 = __builtin_bit_cast(float, __builtin_amdgcn_readlane(__builtin_bit_cast(int, v), 32)), s3 = __builtin_bit_cast(float, __builtin_amdgcn_readlane(__builtin_bit_cast(int, v), 48));
    return fmaxf(fmaxf(s0, s1), fmaxf(s2, s3));
}
__device__ __forceinline__ float wave_sum(float v) {
#pragma unroll
    for (int o = 1; o < 64; o <<= 1) v += __shfl_xor(v, o);
    return v;
}
__device__ __forceinline__ float rstd_of(float sumsq) { return 1.0f / sqrtf(sumsq * (1.0f / D) + NORM_EPS); }

__device__ __forceinline__ void transpose_item(const float* W, int ldw, int K, int k0, int scol, int nvalid, h16* WT, int drow, float scale, const float* colscale, const float* kscale, bool f8, LAS float* scr, int lane) {
    const int cn = scol + (lane & 31); const bool okc = cn < nvalid;
    float wv[32];
#pragma unroll
    for (int i = 0; i < 32; ++i) { const int kk = 2 * i + (lane >> 5); wv[i] = W[(size_t)(k0 + kk) * ldw + (okc ? cn : 0)]; }
#pragma unroll
    for (int i = 0; i < 32; ++i) { const int kk = 2 * i + (lane >> 5); scr[kk * 33 + (lane & 31)] = okc ? (kscale ? wv[i] * kscale[k0 + kk] : wv[i]) : 0.f; }
    LDS_WAIT(); asm volatile("" ::: "memory");
    const int c = lane & 7;
#pragma unroll
    for (int j = 0; j < 4; ++j) { const int n = (lane >> 3) + 8 * j; const LAS float* s = scr + (8 * c) * 33 + n;
        float sc = scale; if (colscale) sc *= colscale[scol + n];
        if (f8) { u32x2 o; o.x = pk8(s[0 * 33] * sc, s[1 * 33] * sc, s[2 * 33] * sc, s[3 * 33] * sc); o.y = pk8(s[4 * 33] * sc, s[5 * 33] * sc, s[6 * 33] * sc, s[7 * 33] * sc);
            *(GAS u32x2*)((unsigned char*)WT + (size_t)(drow + n) * K + k0 + 8 * c) = o; }
        else { u32x4 o; o.x = pkh(s[0 * 33] * sc, s[1 * 33] * sc); o.y = pkh(s[2 * 33] * sc, s[3 * 33] * sc); o.z = pkh(s[4 * 33] * sc, s[5 * 33] * sc); o.w = pkh(s[6 * 33] * sc, s[7 * 33] * sc);
            *(GAS u32x4*)(WT + (size_t)(drow + n) * K + k0 + 8 * c) = o; } }
    LDS_WAIT(); asm volatile("" ::: "memory");
}
struct TJob { const float* W; h16* WT; const float* colscale; int ldw, K, nrows, nvalid, mode; float scale; const float* kscale; };
__device__ __forceinline__ int tjob_items(const TJob& j) { return (j.K / 64) * (j.nrows / 32); }
__device__ __forceinline__ void tjob_run(const TJob& j, int item, LAS float* scr, int lane) {
    const int nblk = j.nrows / 32, kb = item / nblk, r = 32 * (item % nblk);
    const int scol = (j.mode & 1) ? ((r >> 7) & 1) * DFF + 128 * (r >> 8) + (r & 127) : r;
    transpose_item(j.W, j.ldw, j.K, 64 * kb, scol, j.nvalid, j.WT, r, j.scale, j.colscale, j.kscale, (j.mode & 2) != 0, scr, lane);
}

struct Args {
    const float* x; const float* mem; const int* pos; const float* gains; const float* mem_norm; const float* pool_w; const float* pool_scale;
    const float* w_in; const float* w_out; const float* wq; const float* wkv; const float* wo; const float* wgu; const float* wdn;
    float* out; unsigned char* ws;
    float inv_freq[16];
    int ph_lo, ph_hi, li, pad;
};

#define CAS __attribute__((address_space(4)))
typedef const CAS Args* ArgP;
__device__ __forceinline__ ArgP argp() { unsigned long long p = (unsigned long long)__builtin_amdgcn_kernarg_segment_ptr(); asm volatile("" : "+s"(p)); return (ArgP)p; }

__device__ __forceinline__ void rope_entry(ArgP a, float* rope, int idx) {
    const int m = idx >> 4, i = idx & 15;
    const float angf = (float)a->pos[m] * a->inv_freq[i];
    const double ang = (double)angf;
    const double TWO_PI = 6.283185307179586476925286766559, INV_2PI = 0.15915494309189533576888376337251;
    const double k = __builtin_rint(ang * INV_2PI);
    const double r = ang - k * TWO_PI;
    const double r2 = r * r;
    double c = 1.0, s = 1.0, tc = 1.0, ts = 1.0;
#pragma unroll
    for (int n = 1; n <= 13; ++n) { tc *= -r2 / (double)((2 * n - 1) * (2 * n)); ts *= -r2 / (double)((2 * n) * (2 * n + 1)); c += tc; s += ts; }
    rope[(size_t)m * 32 + i] = (float)c; rope[(size_t)m * 32 + 16 + i] = (float)(s * r);
}
__device__ __forceinline__ void norm_row_to_h16(const float* xrow, const float* gain, h16* orow, int lane) {
    const f32x4* xr = (const f32x4*)xrow + lane; const f32x4* gr = (const f32x4*)gain + lane;
    f32x4 v[8]; float s = 0.f;
#pragma unroll
    for (int j = 0; j < 8; ++j) { v[j] = xr[64 * j]; s += (v[j].x * v[j].x + v[j].y * v[j].y) + (v[j].z * v[j].z + v[j].w * v[j].w); }
    const float r = rstd_of(wave_sum_dpp(s));
    u32x2* o8 = (u32x2*)orow + lane;
#pragma unroll
    for (int j = 0; j < 8; ++j) { const f32x4 g = gr[64 * j], y = v[j] * r * g; u32x2 w; w.x = pkh(y.x, y.y); w.y = pkh(y.z, y.w); o8[64 * j] = w; }
}
__device__ __forceinline__ void pool_pre(Frame& F0, const float* x, const float* g0, h16* P) {
    Frame F = fresh(F0);
    LAS float* rs = (LAS float*)(F.lds + RING_OFF);
    for (int u = F.vcu; u < T / 64; u += F.G) {
        const int b = u / (SEQ / 64), t0 = 64 * (u % (SEQ / 64));
        const float* xb = x + (size_t)b * SEQ * D;
        for (int r = F.wave; r < 79; r += NWAVES) { const int t = t0 - 15 + r;
            if (t >= 0) { const f32x4* xr = (const f32x4*)(xb + (size_t)t * D) + F.lane; float s = 0.f;
#pragma unroll
                for (int j = 0; j < 8; ++j) { const f32x4 v = xr[64 * j]; s += (v.x * v.x + v.y * v.y) + (v.z * v.z + v.w * v.w); }
                s = rstd_of(wave_sum_dpp(s)); if (F.lane == 0) rs[r] = s; } }
        __syncthreads();
        {
            const int c0 = 4 * F.tid, w = 2 << (F.tid >> 7);
            const f32x4 g = *(const f32x4*)(g0 + c0);
            const int ts = (t0 - (w - 1)) > 0 ? (t0 - (w - 1)) : 0;
            f32x4 sum = {0.f, 0.f, 0.f, 0.f};
#pragma unroll 8
            for (int t = ts; t < t0 + 64; ++t) {
                const f32x4 a = *(const f32x4*)(xb + (size_t)t * D + c0) * rs[t - t0 + 15] * g;
                sum += a;
                if (t - w >= ts) sum -= *(const f32x4*)(xb + (size_t)(t - w) * D + c0) * rs[t - w - t0 + 15] * g;
                if (t >= t0) { const float ic = 1.0f / (float)((t + 1) < w ? (t + 1) : w); const f32x4 p = sum * ic - a;
                    u32x2 o; o.x = pkh(p.x, p.y); o.y = pkh(p.z, p.w); *(u32x2*)(P + ((size_t)b * SEQ + t) * D + c0) = o; }
            }
        }
        __syncthreads();
    }
}
__device__ __forceinline__ void p0_prologue(Frame& F0, ArgP a) {
    Frame F = fresh(F0);
    unsigned char* ws = a->ws;
    LAS float* scr = (LAS float*)(F.lds + RING_OFF + F.wave * 16384);
    const int gw = F.vcu * NWAVES + F.wave, NGW = F.G * NWAVES;
    constexpr int I_POOL = (512 / 64) * (512 / 32), I_IN = (2048 / 64) * (DSA_NP / 32), I_OUT = (2048 / 64) * (2048 / 32), I_Q = (2048 / 64) * (512 / 32), I_KV = (2048 / 64) * (1024 / 32),
                  I_O = (512 / 64) * (2048 / 32), I_GU = (2048 / 64) * (2 * DFF / 32), I_DN = (DFF / 64) * (2048 / 32);
    constexpr int NITEMS = 4 * I_POOL + I_IN + I_OUT + 2 * (I_Q + I_KV + I_O + I_GU + I_DN);
    for (int it = gw; it < NITEMS; it += NGW) {
        int r = it; TJob j; bool found = false;
#pragma unroll
        for (int g = 0; g < 4; ++g) if (!found) { if (r < I_POOL) { j = TJob{a->pool_w + (size_t)g * 512 * 512, (h16*)(ws + WS_WPOOL) + (size_t)g * 512 * 512, a->pool_scale + g * 512, 512, 512, 512, 512, 0, 1.0f, nullptr}; found = true; } else r -= I_POOL; }
        if (!found) { if (r < I_IN) { j = TJob{a->w_in, (h16*)(ws + WS_WIN), nullptr, DSA_N, 2048, DSA_NP, DSA_N, 0, 64.0f, a->gains + 6 * D  }; found = true; } else r -= I_IN; }
        if (!found) { if (r < I_OUT) { j = TJob{a->w_out, (h16*)(ws + WS_WOUT), nullptr, 2048, 2048, 2048, 2048, 0, 1.0f, nullptr}; found = true; } else r -= I_OUT; }
#pragma unroll
        for (int L = 0; L < 2; ++L) {
            if (!found) { if (r < I_Q) { j = TJob{a->wq + (size_t)L * 2048 * 512, (h16*)(ws + WS_WQ) + (size_t)L * 512 * 2048, nullptr, 512, 2048, 512, 512, 0, 1.0f, a->gains + (size_t)L * 6 * D + 2 * D}; found = true; } else r -= I_Q; }
            if (!found) { if (r < I_KV) { j = TJob{a->wkv + (size_t)L * 2048 * 1024, (h16*)(ws + WS_WKV) + (size_t)L * 1024 * 2048, nullptr, 1024, 2048, 1024, 1024, 0, 1.0f, nullptr}; found = true; } else r -= I_KV; }
            if (!found) { if (r < I_O) { j = TJob{a->wo + (size_t)L * 512 * 2048, (h16*)(ws + WS_WO) + (size_t)L * 2048 * 512, nullptr, 2048, 512, 2048, 2048, 0, 1.0f, nullptr}; found = true; } else r -= I_O; }
            if (!found) { if (r < I_GU) { j = ((FFN_FP8 >> L) & 1) ? TJob{a->wgu + (size_t)L * 2048 * 2 * DFF, (h16*)(ws + WS_WGU) + (size_t)L * 2 * DFF * 2048, nullptr, 2 * DFF, 2048, 2 * DFF, 2 * DFF, 3, W8_SCALE, nullptr} : TJob{a->wgu + (size_t)L * 2048 * 2 * DFF, (h16*)(ws + WS_WGU) + (size_t)L * 2 * DFF * 2048, nullptr, 2 * DFF, 2048, 2 * DFF, 2 * DFF, 1, 1.0f, a->gains + (size_t)L * 6 * D + 4 * D}; found = true; } else r -= I_GU; }
            if (!found) { if (r < I_DN) { j = ((DN_FP8 >> L) & 1) ? TJob{a->wdn + (size_t)L * DFF * 2048, (h16*)(ws + WS_WDN) + (size_t)L * 2048 * DFF, nullptr, 2048, DFF, 2048, 2048, 2, W8_SCALE, nullptr} : TJob{a->wdn + (size_t)L * DFF * 2048, (h16*)(ws + WS_WDN) + (size_t)L * 2048 * DFF, nullptr, 2048, DFF, 2048, 2048, 0, 1.0f, nullptr}; found = true; } else r -= I_DN; }
        }
        if (found) tjob_run(j, r, scr, F.lane);
    }
    for (int i = (gw * 64 + F.lane); i < T * 16; i += NGW * 64) rope_entry(a, (float*)(ws + WS_ROPE), i);
    for (int m = gw; m < NB * NMEM; m += NGW) norm_row_to_h16(a->mem + (size_t)m * D, a->mem_norm, (h16*)(ws + WS_MEMN) + (size_t)m * D, F.lane);
    __syncthreads();
    pool_pre(F, a->x, a->gains  , (h16*)(ws + WS_A));
}

template <bool HAS_NEXT, bool OUT8, bool HIN32, bool HOUT32, bool RSONLY = false>
__device__ __forceinline__ void seam_phase(Frame& F0, const h16* Y, const void* hin, void* hout, const float* gpost, const float* gpre, h16* aout, float* rsout = nullptr) {
    Frame F = fresh(F0);
    const int gw = F.vcu * NWAVES + F.wave, NGW = F.G * NWAVES;
#pragma unroll 4
    for (int m = gw; m < T; m += NGW) {
        const h16* yr = Y + (size_t)m * D + 8 * F.lane;
        float y[4][8]; float s = 0.f;
#pragma unroll
        for (int j = 0; j < 4; ++j) { const half8 v = *(const half8*)(yr + 512 * j);
#pragma unroll
            for (int e = 0; e < 8; ++e) { y[j][e] = (float)v[e]; s += y[j][e] * y[j][e]; } }
        float hp[4][8];
#pragma unroll
        for (int j = 0; j < 4; ++j) {
            if constexpr (HIN32) { const f32x4 a = *(const f32x4*)((const float*)hin + (size_t)m * D + 8 * F.lane + 512 * j), c = *(const f32x4*)((const float*)hin + (size_t)m * D + 8 * F.lane + 512 * j + 4);
                hp[j][0] = a.x; hp[j][1] = a.y; hp[j][2] = a.z; hp[j][3] = a.w; hp[j][4] = c.x; hp[j][5] = c.y; hp[j][6] = c.z; hp[j][7] = c.w; }
            else { const half8 v = *(const half8*)((const h16*)hin + (size_t)m * D + 8 * F.lane + 512 * j);
#pragma unroll
                for (int e = 0; e < 8; ++e) hp[j][e] = (float)v[e]; } }
        const float r = rstd_of(wave_sum_dpp(s)); float s2 = 0.f;
#pragma unroll
        for (int j = 0; j < 4; ++j) { const f32x4 g0 = *(const f32x4*)(gpost + 8 * F.lane + 512 * j), g1 = *(const f32x4*)(gpost + 8 * F.lane + 512 * j + 4);
            const float g[8] = {g0.x, g0.y, g0.z, g0.w, g1.x, g1.y, g1.z, g1.w};
#pragma unroll
            for (int e = 0; e < 8; ++e) { const float h = hp[j][e] + y[j][e] * r * g[e]; y[j][e] = h; s2 += h * h; }
            if constexpr (HOUT32) { float* o = (float*)hout + (size_t)m * D + 8 * F.lane + 512 * j; *(f32x4*)o = (f32x4){y[j][0], y[j][1], y[j][2], y[j][3]}; *(f32x4*)(o + 4) = (f32x4){y[j][4], y[j][5], y[j][6], y[j][7]}; }
            else { u32x4 w; w.x = pkh(y[j][0], y[j][1]); w.y = pkh(y[j][2], y[j][3]); w.z = pkh(y[j][4], y[j][5]); w.w = pkh(y[j][6], y[j][7]); *(u32x4*)((h16*)hout + (size_t)m * D + 8 * F.lane + 512 * j) = w; } }
        if constexpr (HAS_NEXT && RSONLY) { const float r2 = rstd_of(wave_sum_dpp(s2)); if (F.lane == 0) rsout[m] = r2; }
        else if constexpr (HAS_NEXT) {
            const float r2 = rstd_of(wave_sum_dpp(s2));
#pragma unroll
            for (int j = 0; j < 4; ++j) { const f32x4 g0 = *(const f32x4*)(gpre + 8 * F.lane + 512 * j), g1 = *(const f32x4*)(gpre + 8 * F.lane + 512 * j + 4);
                const float g[8] = {g0.x, g0.y, g0.z, g0.w, g1.x, g1.y, g1.z, g1.w}; float v[8];
#pragma unroll
                for (int e = 0; e < 8; ++e) v[e] = y[j][e] * r2 * g[e];
                if constexpr (OUT8) { u32x2 w; w.x = pk8(v[0], v[1], v[2], v[3]); w.y = pk8(v[4], v[5], v[6], v[7]); *(u32x2*)((unsigned char*)aout + (size_t)m * D + 8 * F.lane + 512 * j) = w; }
                else { u32x4 w; w.x = pkh(v[0], v[1]); w.y = pkh(v[2], v[3]); w.z = pkh(v[4], v[5]); w.w = pkh(v[6], v[7]); *(u32x4*)(aout + (size_t)m * D + 8 * F.lane + 512 * j) = w; } }
        }
    }
}

__device__ __forceinline__ void xattn_phase(Frame& F0, h16* XQ, const h16* KVM  ) {
    Frame F = fresh(F0);
    LAS unsigned char* Ks = F.lds + RING_OFF; LAS unsigned char* Vt = F.lds + RING_OFF + 65536;
    const int lane = F.lane, n = lane & 31, hh = lane >> 5;
    for (int u = F.vcu; u < NB * 4 * (SEQ / 512); u += F.G) {
        const int b = u / (4 * (SEQ / 512)), h = (u / (SEQ / 512)) & 3, ch = u % (SEQ / 512);
        const h16* kb = KVM + (size_t)b * NMEM * 2048 + h * HD;
        for (int i = F.tid; i < 256 * 16; i += NWAVES * 64) { const int key = i >> 4, c = i & 15;
            const u32x4 kv = *(const u32x4*)(kb + (size_t)key * 2048 + 8 * c);
            *(LAS u32x4*)(Ks + key * 256 + ((c ^ (key & 15)) << 4)) = kv;
            const half8 vv = *(const half8*)(kb + (size_t)key * 2048 + 512 + 8 * c);
            const int o = key & 15, posk = (key & ~15) | ((o & 3) | ((o & 4) << 1) | ((o & 8) >> 1));
#pragma unroll
            for (int e = 0; e < 8; ++e) { const int d = 8 * c + e; *(LAS h16*)(Vt + d * 512 + (((posk >> 3) ^ (d & 15)) << 4) + (posk & 7) * 2) = vv[e]; }
        }
        __syncthreads();
#pragma unroll 1
        for (int sub = 0; sub < 2; ++sub) {
            const size_t m0 = (size_t)b * SEQ + ch * 512 + sub * 256 + F.wave * 32;
            h16* qrow = XQ + (m0 + n) * XW + h * HD;
            half8 qf[8];
#pragma unroll
            for (int s = 0; s < 8; ++s) qf[s] = *(const half8*)(qrow + 16 * s + 8 * hh);
            f32x16 o[4];
#pragma unroll
            for (int mt = 0; mt < 4; ++mt)
#pragma unroll
                for (int i = 0; i < 16; ++i) o[mt][i] = 0.f;
            const float c2 = 0.08838834764831845f * 1.44269504089f;
            float mrun = -3.0e38f, lrun = 0.f;
#pragma unroll 1
            for (int hf = 0; hf < 2; ++hf) {
                f32x16 acc[4];
#pragma unroll
                for (int kt = 0; kt < 4; ++kt) {
#pragma unroll
                    for (int i = 0; i < 16; ++i) acc[kt][i] = 0.f;
                    const int key = 128 * hf + 32 * kt + n;
#pragma unroll
                    for (int s = 0; s < 8; ++s) { const half8 ka = *(const LAS half8*)(Ks + key * 256 + (((2 * s + hh) ^ (key & 15)) << 4));
                        acc[kt] = __builtin_amdgcn_mfma_f32_32x32x16_f16(ka, qf[s], acc[kt], 0, 0, 0); }
                }
                float mx = mrun;
#pragma unroll
                for (int kt = 0; kt < 4; ++kt)
#pragma unroll
                    for (int i = 0; i < 16; ++i) mx = fmaxf(mx, acc[kt][i]);
                mx = fmaxf(mx, __shfl_xor(mx, 32));
                const float alpha = __builtin_amdgcn_exp2f((mrun - mx) * c2); mrun = mx;
                float sum = 0.f;
#pragma unroll
                for (int kt = 0; kt < 4; ++kt)
#pragma unroll
                    for (int i = 0; i < 16; ++i) { const float p = __builtin_amdgcn_exp2f((acc[kt][i] - mx) * c2); acc[kt][i] = p; sum += p; }
                lrun = lrun * alpha + sum;
#pragma unroll
                for (int mt = 0; mt < 4; ++mt)
#pragma unroll
                    for (int i = 0; i < 16; ++i) o[mt][i] *= alpha;
#pragma unroll
                for (int kt = 0; kt < 4; ++kt)
#pragma unroll
                    for (int s2 = 0; s2 < 2; ++s2) {
                        half8 pb;
#pragma unroll
                        for (int j = 0; j < 8; ++j) pb[j] = (h16)acc[kt][8 * s2 + j];
#pragma unroll
                        for (int mt = 0; mt < 4; ++mt) { const int d = 32 * mt + n;
                            const half8 va = *(const LAS half8*)(Vt + d * 512 + (((2 * (2 * (4 * hf + kt) + s2) + hh) ^ (d & 15)) << 4));
                            o[mt] = __builtin_amdgcn_mfma_f32_32x32x16_f16(va, pb, o[mt], 0, 0, 0); }
                    }
            }
            lrun += __shfl_xor(lrun, 32);
            const float inv = 1.0f / lrun;
#pragma unroll
            for (int mt = 0; mt < 4; ++mt)
#pragma unroll
                for (int jj = 0; jj < 4; ++jj) { u32x2 w; w.x = pkh(o[mt][4 * jj] * inv, o[mt][4 * jj + 1] * inv); w.y = pkh(o[mt][4 * jj + 2] * inv, o[mt][4 * jj + 3] * inv);
                    *(u32x2*)(qrow + 32 * mt + 8 * jj + 4 * hh) = w; }
        }
        __syncthreads();
    }
}

__device__ __forceinline__ unsigned mono_key(unsigned u) { return (u & 0x80000000u) ? ~u : (u | 0x80000000u); }
__device__ __forceinline__ void keymap_clear(LAS unsigned* bm, int lane) { *(LAS u32x4*)(bm + 8 * lane) = (u32x4){0u, 0u, 0u, 0u}; *(LAS u32x4*)(bm + 8 * lane + 4) = (u32x4){0u, 0u, 0u, 0u}; }
__device__ __forceinline__ void keymap_emit(LAS unsigned* bm, unsigned short* out, int nvalid, int lane) {
    const u32x4 w0 = *(const LAS u32x4*)(bm + 8 * lane), w1 = *(const LAS u32x4*)(bm + 8 * lane + 4);
    unsigned w[8] = {w0.x, w0.y, w0.z, w0.w, w1.x, w1.y, w1.z, w1.w};
    int mine = 0;
#pragma unroll
    for (int j = 0; j < 8; ++j) mine += __builtin_popcount(w[j]);
    int incl = mine;
#pragma unroll
    for (int o = 1; o < 64; o <<= 1) { const int v = __shfl_up(incl, o); if (lane >= o) incl += v; }
    int pos = incl - mine;
#pragma unroll
    for (int j = 0; j < 8; ++j) { unsigned x = w[j]; while (x) { const int b = __builtin_ctz(x); out[pos++] = (unsigned short)((8 * lane + j) * 32 + b); x &= x - 1u; } }
    const int total = __shfl(incl, 63);
    for (int i = total + lane; i < TOPK; i += 64) out[i] = (unsigned short)0;
}
constexpr int SEL_N = LIST_CAP / 64;
template <bool FINAL>
__device__ __forceinline__ void select256(u32x2* list, int c, LAS float* th_out, LAS unsigned* cnt_out, LAS unsigned* bm, int lane) {
    unsigned key[SEL_N], id[SEL_N];
#pragma unroll
    for (int k = 0; k < SEL_N; ++k) { const int i = lane + 64 * k; const u32x2 v = list[i]; key[k] = (i < c) ? mono_key(v.x) : 0u; id[k] = v.y; }
    unsigned mx = key[0];
#pragma unroll
    for (int k = 1; k < SEL_N; ++k) mx = key[k] > mx ? key[k] : mx;
#pragma unroll
    for (int o = 1; o < 64; o <<= 1) { const unsigned v = (unsigned)__shfl_xor((int)mx, o); mx = v > mx ? v : mx; }
    unsigned lo = FINAL ? 1u : mono_key(__float_as_uint(*th_out)), hi = mx;
    constexpr int PRUNE_KEEP = 320;
#pragma unroll 1
    while (lo < hi) { const unsigned mid = lo + ((hi - lo + 1u) >> 1); int cc = 0;
#pragma unroll
        for (int k = 0; k < SEL_N; ++k) cc += __builtin_popcountll(__ballot(key[k] >= mid));
        if (cc >= TOPK) { lo = mid; if (cc <= (FINAL ? TOPK : PRUNE_KEEP)) break; } else hi = mid - 1u; }
    const unsigned prefix = lo;
    int ngt = 0, neq = 0;
#pragma unroll
    for (int k = 0; k < SEL_N; ++k) { ngt += __builtin_popcountll(__ballot(key[k] > prefix)); neq += __builtin_popcountll(__ballot(key[k] == prefix)); }
    const int need_eq = FINAL ? (TOPK - ngt) : neq; int base_gt = 0, base_eq = 0;
    const unsigned long long lt = (1ull << lane) - 1ull;
#pragma unroll
    for (int k = 0; k < SEL_N; ++k) {
        const unsigned long long bgt = __ballot(key[k] > prefix), beq = __ballot(key[k] == prefix);
        int pos = -1;
        if (key[k] > prefix) pos = base_gt + __builtin_popcountll(bgt & lt);
        else if (key[k] == prefix) { const int r = base_eq + __builtin_popcountll(beq & lt); if (r < need_eq) pos = ngt + r; }
        if (pos >= 0) { if constexpr (FINAL) __hip_atomic_fetch_or(bm + (id[k] >> 5), 1u << (id[k] & 31u), __ATOMIC_RELAXED, __HIP_MEMORY_SCOPE_WORKGROUP); else { u32x2 v; v.x = (key[k] & 0x80000000u) ? (key[k] & 0x7fffffffu) : ~key[k]; v.y = id[k]; list[pos] = v; } }
        base_gt += __builtin_popcountll(bgt); base_eq += __builtin_popcountll(beq);
        __builtin_amdgcn_sched_barrier(0);
    }
    if constexpr (!FINAL) { if (lane == 0) { const unsigned u = (prefix & 0x80000000u) ? (prefix & 0x7fffffffu) : ~prefix; *th_out = __builtin_bit_cast(float, u); *cnt_out = (unsigned)(ngt + neq); } }
}
__device__ __forceinline__ void indexer_phase(Frame& F0, const h16* IQ, const h16* IK, const float* IW, unsigned short* IDX, u32x2* LISTS) {
    Frame F = fresh(F0);
    LAS unsigned char* bq = F.lds + RING_OFF;
    LAS unsigned* cnt = (LAS unsigned*)(F.lds + RING_OFF + 131072); LAS float* th = (LAS float*)(cnt + 32); LAS unsigned* flag = cnt + 64; LAS unsigned* sgn = cnt + 96;
    u32x2* mylist = LISTS + (size_t)blockIdx.x * 32 * LIST_CAP;
    const int lane = F.lane, n = lane & 31, hh = lane >> 5, w8 = F.wave;
    const float INF = __builtin_inff();
    constexpr int NU = NB * (SEQ / 32);
    for (int rnd = 0; rnd * F.G < NU; ++rnd) {
        int qt, b;
        if (F.G == 256) {
            const int i = (F.vcu & 31) + 32 * (F.vcu >> 6); b = (F.vcu >> 5) & 1;
            qt = rnd == 0 ? 511 - i : rnd == 1 ? i : rnd == 2 ? 256 + i : 255 - i;
        } else { const int kk = rnd * F.G + ((rnd & 1) ? (F.G - 1 - F.vcu) : F.vcu); if (kk >= NU) continue; qt = (SEQ / 32 - 1) - (kk >> 1); b = kk & 1; }
        const int nkt = qt + 1;
        const size_t m0 = (size_t)b * SEQ + 32 * qt;
        if (F.tid < 32) { cnt[F.tid] = 0u; th[F.tid] = -INF; unsigned mk = 0u;
#pragma unroll
            for (int h = 0; h < 16; ++h) mk |= (IW[(m0 + F.tid) * 16 + h] >= 0.f ? 1u : 0u) << h;
            sgn[F.tid] = mk; }
        if (F.tid == 0) *flag = 0u;
        { const int q = F.tid & 31, ch = F.tid >> 5;
#pragma unroll 4
            for (int h = 0; h < 16; ++h) { const float w = IW[(m0 + q) * 16 + h]; const half8 v = *(const half8*)(IQ + (m0 + q) * 2048 + h * HD + 8 * ch); half8 o;
#pragma unroll
                for (int e = 0; e < 8; ++e) o[e] = (h16)((float)v[e] * w);
                *(LAS half8*)(bq + (h * 16 + ch) * 512 + q * 16) = o; } }
        __syncthreads();
        const h16* ikb = IK + (size_t)b * SEQ * HD;
        const unsigned smask = sgn[n];
        float theta = -INF;
        const int qpos = 32 * qt + n;
        u32x2* lp = mylist + (size_t)n * LIST_CAP;
        half8 A[8];
        if (w8 < nkt) { const h16* arow = ikb + (size_t)(32 * w8 + n) * HD + 8 * hh;
#pragma unroll
            for (int c = 0; c < 8; ++c) A[c] = *(const half8*)(arow + 16 * c); }
#pragma unroll 1
        for (int r0 = 0; r0 < nkt; r0 += NWAVES) {
            const int kt = r0 + w8;
            if (kt < nkt) {
                f32x16 S;
#pragma unroll
                for (int i = 0; i < 16; ++i) S[i] = 0.f;
                const LAS unsigned char* bl = bq + hh * 512 + n * 16;
                half8 Ba[4], Bb[4]; f32x16 acc0, acc1;
#define IDX_LOADB(dst, h, c0) do { _Pragma("unroll") for (int c = 0; c < 4; ++c) dst[c] = *(const LAS half8*)(bl + ((h) * 16 + 2 * ((c0) + c)) * 512); } while (0)
#define IDX_MMA4(acc, Bx, c0) do { _Pragma("unroll") for (int c = 0; c < 4; ++c) acc = __builtin_amdgcn_mfma_f32_32x32x16_f16(A[(c0) + c], Bx[c], acc, 0, 0, 0); } while (0)
#define IDX_ZERO(acc) do { _Pragma("unroll") for (int i = 0; i < 16; ++i) acc[i] = 0.f; } while (0)
#define IDX_FOLD8(acc, h, i0) do { const float cc_ = ((smask >> (h)) & 1u) ? INF : -INF; _Pragma("unroll") for (int i = (i0); i < (i0) + 8; ++i) S[i] += __builtin_amdgcn_fmed3f(acc[i], 0.f, cc_); } while (0)
#define IDX_SCHED4() do { __builtin_amdgcn_sched_group_barrier(0x008, 1, 0); __builtin_amdgcn_sched_group_barrier(0x100, 1, 0); _Pragma("unroll") for (int g_ = 0; g_ < 3; ++g_) { __builtin_amdgcn_sched_group_barrier(0x008, 1, 0); __builtin_amdgcn_sched_group_barrier(0x100, 1, 0); __builtin_amdgcn_sched_group_barrier(0x002, 6, 0); } } while (0)
                IDX_LOADB(Ba, 0, 0);
                IDX_ZERO(acc1);
#pragma unroll 1
                for (int h = 0; h < 16; h += 2) {
                    IDX_ZERO(acc0);
                    IDX_MMA4(acc0, Ba, 0); IDX_FOLD8(acc1, (h + 15) & 15, 0); IDX_LOADB(Bb, h, 4); IDX_SCHED4();
                    IDX_MMA4(acc0, Bb, 4); IDX_FOLD8(acc1, (h + 15) & 15, 8); IDX_LOADB(Ba, h + 1, 0); IDX_SCHED4();
                    IDX_ZERO(acc1);
                    IDX_MMA4(acc1, Ba, 0); IDX_FOLD8(acc0, h, 0); IDX_LOADB(Bb, h + 1, 4); IDX_SCHED4();
                    IDX_MMA4(acc1, Bb, 4); IDX_FOLD8(acc0, h, 8); IDX_LOADB(Ba, (h + 2) & 15, 0); IDX_SCHED4();
                }
                IDX_FOLD8(acc1, 15, 0); IDX_FOLD8(acc1, 15, 8);
#if IDX_PROBE_MMA
                {
                    f32x16 S1 = S;
#pragma unroll
                    for (int c = 0; c < 8; ++c) asm volatile("" : "+v"(A[c]));
#pragma unroll
                    for (int i = 0; i < 16; ++i) S[i] = 0.f;
                    IDX_LOADB(Ba, 0, 0);
                    IDX_ZERO(acc1);
#pragma unroll 1
                    for (int h = 0; h < 16; h += 2) {
                        IDX_ZERO(acc0);
                        IDX_MMA4(acc0, Ba, 0); IDX_FOLD8(acc1, (h + 15) & 15, 0); IDX_LOADB(Bb, h, 4); IDX_SCHED4();
                        IDX_MMA4(acc0, Bb, 4); IDX_FOLD8(acc1, (h + 15) & 15, 8); IDX_LOADB(Ba, h + 1, 0); IDX_SCHED4();
                        IDX_ZERO(acc1);
                        IDX_MMA4(acc1, Ba, 0); IDX_FOLD8(acc0, h, 0); IDX_LOADB(Bb, h + 1, 4); IDX_SCHED4();
                        IDX_MMA4(acc1, Bb, 4); IDX_FOLD8(acc0, h, 8); IDX_LOADB(Ba, (h + 2) & 15, 0); IDX_SCHED4();
                    }
                    IDX_FOLD8(acc1, 15, 0); IDX_FOLD8(acc1, 15, 8);
#pragma unroll
                    for (int i = 0; i < 16; ++i) S[i] = (S[i] + S1[i]) * 0.5f;
                }
#endif
#undef IDX_LOADB
#undef IDX_MMA4
#undef IDX_ZERO
#undef IDX_FOLD8
#undef IDX_SCHED4
                if (kt + NWAVES < nkt) { const h16* arow = ikb + (size_t)(32 * (kt + NWAVES) + n) * HD + 8 * hh;
#pragma unroll
                    for (int c = 0; c < 8; ++c) A[c] = *(const half8*)(arow + 16 * c); }
                const int kb0 = 32 * kt + 4 * hh;
                unsigned pm = 0u;
                if (kt < qt) {
#pragma unroll
                    for (int i = 0; i < 16; ++i) pm |= (S[i] > theta) ? (1u << i) : 0u;
                } else {
#pragma unroll
                    for (int i = 0; i < 16; ++i) { const int key = kb0 + (i & 3) + 8 * (i >> 2); pm |= ((key <= qpos) && (S[i] > theta)) ? (1u << i) : 0u; }
                }
                if (pm) { const unsigned np = (unsigned)__builtin_popcount(pm);
                    const unsigned pos = __hip_atomic_fetch_add(cnt + n, np, __ATOMIC_RELAXED, __HIP_MEMORY_SCOPE_WORKGROUP);
#pragma unroll
                    for (int i = 0; i < 16; ++i) if (pm & (1u << i)) { u32x2 e; e.x = __float_as_uint(S[i]);   e.y = (unsigned)(kb0 + (i & 3) + 8 * (i >> 2));
                        { const unsigned at = pos + (unsigned)__builtin_popcount(pm & ((1u << i) - 1u)); lp[at < (unsigned)LIST_CAP ? at : (unsigned)LIST_CAP - 1u] = e; } }
                    if (pos + np > (unsigned)(LIST_CAP - 256)) *(volatile LAS unsigned*)flag = 1u; }
            }
            asm volatile("s_waitcnt lgkmcnt(0)" ::: "memory"); __builtin_amdgcn_s_barrier(); asm volatile("" ::: "memory");
            if (*(volatile LAS unsigned*)flag != 0u) {
                VM_WAIT(); __syncthreads();
                for (int q = w8; q < 32; q += NWAVES) { const int c = __builtin_amdgcn_readfirstlane((int)cnt[q]); if (c > TOPK) select256<false>(mylist + (size_t)q * LIST_CAP, c, th + q, cnt + q, nullptr, lane); }
                if (F.tid == 0) *flag = 0u;
                VM_WAIT(); __syncthreads();
                theta = th[n];
                if (kt + NWAVES < nkt) { const h16* arow = ikb + (size_t)(32 * (kt + NWAVES) + n) * HD + 8 * hh;
#pragma unroll
                    for (int c = 0; c < 8; ++c) A[c] = *(const half8*)(arow + 16 * c); }
            }
        }
        VM_WAIT(); __syncthreads();
        LAS unsigned* bm = (LAS unsigned*)(bq + w8 * 2048);
        for (int q = w8; q < 32; q += NWAVES) { const int c = __builtin_amdgcn_readfirstlane((int)cnt[q]); unsigned short* io = IDX + (m0 + q) * TOPK; u32x2* lq = mylist + (size_t)q * LIST_CAP;
            keymap_clear(bm, lane); asm volatile("s_waitcnt lgkmcnt(0)" ::: "memory");
            if (c > TOPK) select256<true>(lq, c, nullptr, nullptr, bm, lane);
            else {
#pragma unroll
                for (int k = 0; k < 4; ++k) { const int i = lane + 64 * k; if (i < c) { const unsigned key = lq[i].y; __hip_atomic_fetch_or(bm + (key >> 5), 1u << (key & 31u), __ATOMIC_RELAXED, __HIP_MEMORY_SCOPE_WORKGROUP); } } }
            asm volatile("s_waitcnt lgkmcnt(0)" ::: "memory");
            keymap_emit(bm, io, c, lane);
            asm volatile("s_waitcnt lgkmcnt(0)" ::: "memory"); }
        __syncthreads();
    }
}

constexpr int L16_CAP = 640;
template <bool FINAL, int L16_N>
__device__ __forceinline__ void select_lds(LAS float* sc, LAS unsigned short* ky, int c, LAS float* th_io, LAS unsigned* cnt_out, LAS unsigned* bm, int lane) {
    unsigned key[L16_N], id[L16_N];
#pragma unroll
    for (int k = 0; k < L16_N; ++k) { const int i = lane + 64 * k; const float v = sc[i]; key[k] = (i < c) ? mono_key(__float_as_uint(v)) : 0u; id[k] = ky[i]; }
    unsigned mx = key[0];
#pragma unroll
    for (int k = 1; k < L16_N; ++k) mx = key[k] > mx ? key[k] : mx;
#pragma unroll
    for (int o = 1; o < 64; o <<= 1) { const unsigned v = (unsigned)__shfl_xor((int)mx, o); mx = v > mx ? v : mx; }
    unsigned lo = FINAL ? 1u : mono_key(__float_as_uint(*th_io)), hi = mx;
    constexpr int PRUNE_KEEP = 320;
#pragma unroll 1
    while (lo < hi) { const unsigned mid = lo + ((hi - lo + 1u) >> 1); int cc = 0;
#pragma unroll
        for (int k = 0; k < L16_N; ++k) cc += __builtin_popcountll(__ballot(key[k] >= mid));
        if (cc >= TOPK) { lo = mid; if (cc <= (FINAL ? TOPK : PRUNE_KEEP)) break; } else hi = mid - 1u; }
    const unsigned prefix = lo;
    int ngt = 0, neq = 0;
#pragma unroll
    for (int k = 0; k < L16_N; ++k) { ngt += __builtin_popcountll(__ballot(key[k] > prefix)); neq += __builtin_popcountll(__ballot(key[k] == prefix)); }
    const int need_eq = FINAL ? (TOPK - ngt) : neq; int base_gt = 0, base_eq = 0;
    const unsigned long long lt = (1ull << lane) - 1ull;
    asm volatile("s_waitcnt lgkmcnt(0)" ::: "memory");
#pragma unroll
    for (int k = 0; k < L16_N; ++k) {
        const unsigned long long bgt = __ballot(key[k] > prefix), beq = __ballot(key[k] == prefix);
        int pos = -1;
        if (key[k] > prefix) pos = base_gt + __builtin_popcountll(bgt & lt);
        else if (key[k] == prefix) { const int r = base_eq + __builtin_popcountll(beq & lt); if (r < need_eq) pos = ngt + r; }
        if (pos >= 0) { if constexpr (FINAL) __hip_atomic_fetch_or(bm + (id[k] >> 5), 1u << (id[k] & 31u), __ATOMIC_RELAXED, __HIP_MEMORY_SCOPE_WORKGROUP);
            else { sc[pos] = __uint_as_float((key[k] & 0x80000000u) ? (key[k] & 0x7fffffffu) : ~key[k]); ky[pos] = (unsigned short)id[k]; } }
        base_gt += __builtin_popcountll(bgt); base_eq += __builtin_popcountll(beq);
        __builtin_amdgcn_sched_barrier(0);
    }
    if constexpr (!FINAL) { if (lane == 0) { const unsigned u = (prefix & 0x80000000u) ? (prefix & 0x7fffffffu) : ~prefix; *th_io = __uint_as_float(u); *cnt_out = (unsigned)(ngt + neq); } }
}
__device__ __forceinline__ void indexer_phase16(Frame& F0, const h16* IQ, const h16* IK, const float* IW, unsigned short* IDX) {
    Frame F = fresh(F0);
    LAS unsigned char* bq = F.lds + RING_OFF;
    LAS float* lsc = (LAS float*)(F.lds + RING_OFF + 65536);
    LAS unsigned short* lky = (LAS unsigned short*)(F.lds + RING_OFF + 65536 + 40960);
    LAS unsigned* cnt = (LAS unsigned*)(F.lds + RING_OFF + 65536 + 40960 + 20480); LAS float* th = (LAS float*)(cnt + 16); LAS unsigned* flag = cnt + 32; LAS unsigned* sgn = cnt + 48;
    const int lane = F.lane, n32 = lane & 31, q = n32 & 15, hsel = n32 >> 4, hh = lane >> 5, w8 = F.wave;
    const float INF = __builtin_inff();
    constexpr int NQ16 = SEQ / 16, NU = NB * NQ16;
    for (int rnd = 0; rnd * F.G < NU; ++rnd) {
        int qt, b;
        if (F.G == 256) { const int i = (F.vcu & 31) + 32 * (F.vcu >> 6); b = (F.vcu >> 5) & 1; qt = (rnd & 1) ? 128 * rnd + 127 - i : 128 * rnd + i; qt = NQ16 - 1 - qt; }
        else { const int kk = rnd * F.G + ((rnd & 1) ? (F.G - 1 - F.vcu) : F.vcu); if (kk >= NU) continue; qt = (NQ16 - 1) - (kk >> 1); b = kk & 1; }
        const int nkb = (qt >> 1) + 1;
        const size_t m0 = (size_t)b * SEQ + 16 * qt;
        if (F.tid < 16) { cnt[F.tid] = 0u; th[F.tid] = -INF; unsigned mk = 0u;
#pragma unroll
            for (int h = 0; h < 16; ++h) mk |= (IW[(m0 + F.tid) * 16 + h] >= 0.f ? 1u : 0u) << h;
            sgn[F.tid] = mk; }
        if (F.tid == 0) *flag = 0u;
#pragma unroll 4
        for (int j = 0; j < 8; ++j) { const int e = F.tid + 512 * j, le = e & 63, c = (e >> 6) & 7, hp = e >> 9, qe = le & 15, head = 2 * hp + ((le >> 4) & 1), he = le >> 5;
            const float w = IW[(m0 + qe) * 16 + head]; const half8 v = *(const half8*)(IQ + (m0 + qe) * 2048 + head * HD + 16 * c + 8 * he); half8 o;
#pragma unroll
            for (int x = 0; x < 8; ++x) o[x] = (h16)((float)v[x] * w);
            *(LAS half8*)(bq + e * 16) = o; }
        __syncthreads();
        const h16* ikb = IK + (size_t)b * SEQ * HD;
        const unsigned smask = sgn[q];
        float theta = -INF;
        const int qpos = 16 * qt + q;
        LAS float* msc = lsc + q * L16_CAP; LAS unsigned short* mky = lky + q * L16_CAP;
        half8 A[8];
        if (w8 < nkb) { const h16* arow = ikb + (size_t)(32 * w8 + n32) * HD + 8 * hh;
#pragma unroll
            for (int c = 0; c < 8; ++c) A[c] = *(const half8*)(arow + 16 * c); }
#pragma unroll 1
        for (int r0 = 0; r0 < nkb; r0 += NWAVES) {
            const int kb = r0 + w8;
            if (kb < nkb) {
                f32x16 S;
#pragma unroll
                for (int i = 0; i < 16; ++i) S[i] = 0.f;
                const LAS unsigned char* bl = bq + lane * 16;
                half8 Ba[4], Bb[4]; f32x16 acc0, acc1;
#define IX_LOADB(dst, hp, c0) do { _Pragma("unroll") for (int c = 0; c < 4; ++c) dst[c] = *(const LAS half8*)(bl + ((hp) * 8 + (c0) + c) * 1024); } while (0)
#define IX_MMA4(acc, Bx, c0) do { _Pragma("unroll") for (int c = 0; c < 4; ++c) acc = __builtin_amdgcn_mfma_f32_32x32x16_f16(A[(c0) + c], Bx[c], acc, 0, 0, 0); } while (0)
#define IX_ZERO(acc) do { _Pragma("unroll") for (int i = 0; i < 16; ++i) acc[i] = 0.f; } while (0)
#define IX_FOLD8(acc, hp, i0) do { const float cc_ = ((smask >> (2 * (hp) + hsel)) & 1u) ? INF : -INF; _Pragma("unroll") for (int i = (i0); i < (i0) + 8; ++i) S[i] += __builtin_amdgcn_fmed3f(acc[i], 0.f, cc_); } while (0)
#define IX_SCHED4() do { __builtin_amdgcn_sched_group_barrier(0x008, 1, 0); __builtin_amdgcn_sched_group_barrier(0x100, 1, 0); _Pragma("unroll") for (int g_ = 0; g_ < 3; ++g_) { __builtin_amdgcn_sched_group_barrier(0x008, 1, 0); __builtin_amdgcn_sched_group_barrier(0x100, 1, 0); __builtin_amdgcn_sched_group_barrier(0x002, 6, 0); } } while (0)
                IX_LOADB(Ba, 0, 0);
                IX_ZERO(acc1);
#pragma unroll 1
                for (int hp = 0; hp < 8; hp += 2) {
                    IX_ZERO(acc0);
                    IX_MMA4(acc0, Ba, 0); IX_FOLD8(acc1, (hp + 7) & 7, 0); IX_LOADB(Bb, hp, 4); IX_SCHED4();
                    IX_MMA4(acc0, Bb, 4); IX_FOLD8(acc1, (hp + 7) & 7, 8); IX_LOADB(Ba, hp + 1, 0); IX_SCHED4();
                    IX_ZERO(acc1);
                    IX_MMA4(acc1, Ba, 0); IX_FOLD8(acc0, hp, 0); IX_LOADB(Bb, hp + 1, 4); IX_SCHED4();
                    IX_MMA4(acc1, Bb, 4); IX_FOLD8(acc0, hp, 8); IX_LOADB(Ba, (hp + 2) & 7, 0); IX_SCHED4();
                }
                IX_FOLD8(acc1, 7, 0); IX_FOLD8(acc1, 7, 8);
#undef IX_LOADB
#undef IX_MMA4
#undef IX_ZERO
#undef IX_FOLD8
#undef IX_SCHED4
                if (kb + NWAVES < nkb) { const h16* arow = ikb + (size_t)(32 * (kb + NWAVES) + n32) * HD + 8 * hh;
#pragma unroll
                    for (int c = 0; c < 8; ++c) A[c] = *(const half8*)(arow + 16 * c); }
                float Sx[8];
#pragma unroll
                for (int i = 0; i < 8; ++i) { const float mine = hsel ? S[8 + i] : S[i], other = hsel ? S[i] : S[8 + i];
                    Sx[i] = mine + __shfl_xor(other, 16); }
                const int kb0 = 32 * kb + 4 * hh + 16 * hsel;
                unsigned pm = 0u;
                if (kb + 1 < nkb) {
#pragma unroll
                    for (int i = 0; i < 8; ++i) pm |= (Sx[i] > theta) ? (1u << i) : 0u;
                } else {
#pragma unroll
                    for (int i = 0; i < 8; ++i) { const int key = kb0 + (i & 3) + 8 * (i >> 2); pm |= ((key <= qpos) && (Sx[i] > theta)) ? (1u << i) : 0u; }
                }
                if (pm) { const unsigned np = (unsigned)__builtin_popcount(pm);
                    const unsigned pos = __hip_atomic_fetch_add(cnt + q, np, __ATOMIC_RELAXED, __HIP_MEMORY_SCOPE_WORKGROUP);
#pragma unroll
                    for (int i = 0; i < 8; ++i) if (pm & (1u << i)) { unsigned at = pos + (unsigned)__builtin_popcount(pm & ((1u << i) - 1u)); at = at < (unsigned)L16_CAP ? at : (unsigned)L16_CAP - 1u;
                        msc[at] = Sx[i]; mky[at] = (unsigned short)(kb0 + (i & 3) + 8 * (i >> 2)); }
                    if (pos + np > (unsigned)(L16_CAP - 256)) *(volatile LAS unsigned*)flag = 1u; }
            }
            asm volatile("s_waitcnt lgkmcnt(0)" ::: "memory"); __builtin_amdgcn_s_barrier(); asm volatile("" ::: "memory");
            if (*(volatile LAS unsigned*)flag != 0u) {
                for (int qq = w8; qq < 16; qq += NWAVES) { const int c = __builtin_amdgcn_readfirstlane((int)cnt[qq]); if (c > TOPK) select_lds<false, L16_CAP / 64>(lsc + qq * L16_CAP, lky + qq * L16_CAP, c, th + qq, cnt + qq, nullptr, lane); }
                if (F.tid == 0) *flag = 0u;
                asm volatile("s_waitcnt lgkmcnt(0)" ::: "memory"); __builtin_amdgcn_s_barrier(); asm volatile("" ::: "memory");
                theta = th[q];
            }
        }
        __syncthreads();
        LAS unsigned* bm = (LAS unsigned*)(bq + w8 * 2048);
        for (int qq = w8; qq < 16; qq += NWAVES) { const int c = __builtin_amdgcn_readfirstlane((int)cnt[qq]); unsigned short* io = IDX + (m0 + qq) * TOPK;
            keymap_clear(bm, lane); asm volatile("s_waitcnt lgkmcnt(0)" ::: "memory");
            if (c > TOPK) select_lds<true, L16_CAP / 64>(lsc + qq * L16_CAP, lky + qq * L16_CAP, c, nullptr, nullptr, bm, lane);
            else {
#pragma unroll
                for (int k = 0; k < 4; ++k) { const int i = lane + 64 * k; if (i < c) { const unsigned key = lky[qq * L16_CAP + i]; __hip_atomic_fetch_or(bm + (key >> 5), 1u << (key & 31u), __ATOMIC_RELAXED, __HIP_MEMORY_SCOPE_WORKGROUP); } } }
            asm volatile("s_waitcnt lgkmcnt(0)" ::: "memory");
            keymap_emit(bm, io, c, lane);
            asm volatile("s_waitcnt lgkmcnt(0)" ::: "memory"); }
        __syncthreads();
    }
}

constexpr int L5_CAP = 512;
__device__ __forceinline__ bool ix5_append(float v0, float v1, int kb0, bool valid, bool masked, int qpos, float theta, unsigned cnt_addr, unsigned sc_addr, unsigned ky_addr) {
    unsigned pm = (((v0 > theta) && (!masked || kb0 <= qpos)) ? 1u : 0u) | (((v1 > theta) && (!masked || kb0 + 1 <= qpos)) ? 2u : 0u);
    if (!valid) pm = 0u;
    bool over = false;
    if (pm) { const unsigned np = pm == 3u ? 2u : 1u; unsigned pos;
        asm volatile("ds_add_rtn_u32 %0, %1, %2\n\ts_waitcnt lgkmcnt(0)" : "=&v"(pos) : "v"(cnt_addr), "v"(np) : "memory");
        const unsigned a0 = pos < (unsigned)L5_CAP ? pos : (unsigned)L5_CAP - 1u, p1 = pos + (pm & 1u), a1 = p1 < (unsigned)L5_CAP ? p1 : (unsigned)L5_CAP - 1u;
        if (pm & 1u) { asm volatile("ds_write_b32 %0, %1" :: "v"(sc_addr + 4u * a0), "v"(v0) : "memory"); asm volatile("ds_write_b16 %0, %1" :: "v"(ky_addr + 2u * a0), "v"((unsigned)kb0) : "memory"); }
        if (pm & 2u) { asm volatile("ds_write_b32 %0, %1" :: "v"(sc_addr + 4u * a1), "v"(v1) : "memory"); asm volatile("ds_write_b16 %0, %1" :: "v"(ky_addr + 2u * a1), "v"((unsigned)(kb0 + 1)) : "memory"); }
        over = pos + np > (unsigned)(L5_CAP - 64); }
    return over;
}
__device__ __forceinline__ void indexer_phase5(Frame& F0, const h16* IQ, const h16* IK, const float* IW, unsigned short* IDX) {
    Frame F = fresh(F0);
    LAS unsigned char* ringA = F.lds + RING_OFF;
    LAS float* lsc = (LAS float*)(F.lds + RING_OFF + 32768);
    LAS unsigned short* lky = (LAS unsigned short*)(F.lds + RING_OFF + 32768 + 65536);
    LAS unsigned* cnt = (LAS unsigned*)(F.lds + RING_OFF + 131072); LAS float* th = (LAS float*)(cnt + 32); LAS unsigned* req = cnt + 64; const unsigned req_addr = (unsigned)(unsigned long)req;
    const int lane = F.lane, n32 = lane & 31, hh = lane >> 5, q4 = n32 & 3, h8 = n32 >> 2, w8 = F.wave;
    const bool b2 = (lane >> 2) & 1, b3 = (lane >> 3) & 1, b4 = (lane >> 4) & 1;
    const int ql = 4 * w8 + q4, drow = lane >> 4, dpc = lane & 15;
    const float INF = __builtin_inff();
    constexpr int NU = NB * (SEQ / 32);
    for (int rnd = 0; rnd * F.G < NU; ++rnd) {
        int qt, b;
        if (F.G == 256) { const int i = (F.vcu & 31) + 32 * (F.vcu >> 6); b = (F.vcu >> 5) & 1; qt = rnd == 0 ? 511 - i : rnd == 1 ? i : rnd == 2 ? 256 + i : 255 - i; }
        else { const int kk = rnd * F.G + ((rnd & 1) ? (F.G - 1 - F.vcu) : F.vcu); if (kk >= NU) continue; qt = (SEQ / 32 - 1) - (kk >> 1); b = kk & 1; }
        const int nst = (qt >> 1) + 1;
        const size_t m0 = (size_t)b * SEQ + 32 * qt;
        const h16* ikb = IK + (size_t)b * SEQ * HD;
#define IX5_DMA(k_) do { _Pragma("unroll") for (int i_ = 0; i_ < 2; ++i_) { const int r_ = 8 * w8 + 4 * i_ + drow; \
            __builtin_amdgcn_global_load_lds((const unsigned*)(ikb + (size_t)(64 * (k_) + r_) * HD + 8 * (dpc ^ (r_ & 15))), (LAS unsigned*)(ringA + ((k_) & 1) * 16384 + (8 * w8 + 4 * i_) * 256), 16, 0, 0); } } while (0)
        IX5_DMA(0);
        if (lane < 4) { cnt[4 * w8 + lane] = 0u; th[4 * w8 + lane] = -INF; }
        if (F.tid == 0) *req = 0xffffffffu;
        half8 B0[8], B1[8]; float cc0, cc1;
        { const size_t row = m0 + ql; const float w0 = IW[row * 16 + h8], w1 = IW[row * 16 + 8 + h8]; cc0 = w0 >= 0.f ? INF : -INF; cc1 = w1 >= 0.f ? INF : -INF;
          const h16* src = IQ + row * 2048 + h8 * HD + 8 * hh;
#pragma unroll
          for (int c = 0; c < 8; ++c) { const half8 v0 = *(const half8*)(src + 16 * c), v1 = *(const half8*)(src + 8 * HD + 16 * c);
#pragma unroll
              for (int x = 0; x < 8; ++x) { B0[c][x] = (h16)((float)v0[x] * w0); B1[c][x] = (h16)((float)v1[x] * w1); } } }
        float theta = -INF;
        const int qpos = 32 * qt + ql;
        const unsigned cnt_addr = (unsigned)(unsigned long)(cnt + ql), sc_addr = (unsigned)(unsigned long)(lsc + ql * L5_CAP), ky_addr = (unsigned)(unsigned long)(lky + ql * L5_CAP);
        const LAS unsigned char* arow = ringA + n32 * 256 + ((hh ^ (n32 & 1)) * 16);
        const int axor = 16 * (n32 & 14);
        const int kl = 16 * (int)b4 + 8 * (int)b3 + 4 * hh + 2 * (int)b2;
        half8 A[8]; f32x16 X0, X1, Y0, Y1; float T2a, T2b;
#define IX5_ZERO(P0, P1) do { _Pragma("unroll") for (int i = 0; i < 16; ++i) { P0[i] = 0.f; P1[i] = 0.f; } } while (0)
#define IX5_BLOCK(P0, P1, Q0, Q1, REFILL, nbase_) do { float S_[16], T_[8]; IX5_ZERO(P0, P1); \
            _Pragma("unroll") for (int s_ = 0; s_ < 16; ++s_) { const int c_ = s_ >> 1; \
                if (s_ & 1) { P1 = __builtin_amdgcn_mfma_f32_32x32x16_f16(A[c_], B1[c_], P1, 0, 0, 0); if (REFILL) A[c_] = *(const LAS half8*)((nbase_) + ((32 * c_) ^ axor));   } \
                else P0 = __builtin_amdgcn_mfma_f32_32x32x16_f16(A[c_], B0[c_], P0, 0, 0, 0); \
                if (s_ < 8) { S_[s_] = __builtin_amdgcn_fmed3f(Q0[s_], 0.f, cc0) + __builtin_amdgcn_fmed3f(Q1[s_], 0.f, cc1); S_[8 + s_] = __builtin_amdgcn_fmed3f(Q0[8 + s_], 0.f, cc0) + __builtin_amdgcn_fmed3f(Q1[8 + s_], 0.f, cc1); } \
                else { const int j_ = s_ - 8; const auto r_ = __builtin_amdgcn_permlane16_swap(__float_as_uint(S_[j_]), __float_as_uint(S_[8 + j_]), false, false); T_[j_] = __uint_as_float(r_[0]) + __uint_as_float(r_[1]); \
                    T_[j_] += __uint_as_float(__builtin_amdgcn_update_dpp(0u, __float_as_uint(T_[j_]), 0x128, 0xf, 0xf, false)); T_[j_] += __uint_as_float(__builtin_amdgcn_update_dpp(0u, __float_as_uint(T_[j_]), 0x124, 0xf, 0xf, false)); } \
                __builtin_amdgcn_sched_barrier(0); } \
            T2a = b3 ? (b2 ? T_[6] : T_[4]) : (b2 ? T_[2] : T_[0]); T2b = b3 ? (b2 ? T_[7] : T_[5]) : (b2 ? T_[3] : T_[1]); \
        } while (0)
        IX5_ZERO(Y0, Y1);
        bool own_over = false;
#pragma unroll 1
        for (int k = 0; k < nst; ++k) {
            VM_WAIT(); __builtin_amdgcn_s_barrier(); asm volatile("" ::: "memory");
            if (*(volatile LAS unsigned*)req == (unsigned)k || own_over) {
                for (int i = 0; i < 4; ++i) { const int qq = 4 * w8 + i; const int c = __builtin_amdgcn_readfirstlane((int)cnt[qq]); if (c > TOPK + 32) select_lds<false, L5_CAP / 64>(lsc + qq * L5_CAP, lky + qq * L5_CAP, c, th + qq, cnt + qq, nullptr, lane); }
                asm volatile("s_waitcnt lgkmcnt(0)" ::: "memory");
                theta = th[ql];
            }
            if (k + 1 < nst) IX5_DMA(k + 1);
            const LAS unsigned char* as = arow + (k & 1) * 16384;
#pragma unroll
            for (int c = 0; c < 8; ++c) A[c] = *(const LAS half8*)(as + ((32 * c) ^ axor));
            __builtin_amdgcn_sched_barrier(0);
            IX5_BLOCK(X0, X1, Y0, Y1, true, as + 8192);
            bool over = ix5_append(T2a, T2b, 64 * k - 32 + kl, k > 0, false, qpos, theta, cnt_addr, sc_addr, ky_addr);
            IX5_BLOCK(Y0, Y1, X0, X1, false, as);
            over = ix5_append(T2a, T2b, 64 * k + kl, true, k + 1 == nst, qpos, theta, cnt_addr, sc_addr, ky_addr) || over;
            own_over = __ballot(over) != 0ull;
            if (own_over && lane == 0) asm volatile("ds_write_b32 %0, %1" :: "v"(req_addr), "v"((unsigned)(k + 1)) : "memory");
        }
        if (own_over) {
            for (int i = 0; i < 4; ++i) { const int qq = 4 * w8 + i; const int c = __builtin_amdgcn_readfirstlane((int)cnt[qq]); if (c > TOPK + 32) select_lds<false, L5_CAP / 64>(lsc + qq * L5_CAP, lky + qq * L5_CAP, c, th + qq, cnt + qq, nullptr, lane); }
            asm volatile("s_waitcnt lgkmcnt(0)" ::: "memory");
            theta = th[ql]; }
        { float S_[16], T_[8];
#pragma unroll
          for (int i = 0; i < 16; ++i) S_[i] = __builtin_amdgcn_fmed3f(Y0[i], 0.f, cc0) + __builtin_amdgcn_fmed3f(Y1[i], 0.f, cc1);
#pragma unroll
          for (int i = 0; i < 8; ++i) { const auto r_ = __builtin_amdgcn_permlane16_swap(__float_as_uint(S_[i]), __float_as_uint(S_[8 + i]), false, false); T_[i] = __uint_as_float(r_[0]) + __uint_as_float(r_[1]); }
#pragma unroll
          for (int i = 0; i < 8; ++i) { T_[i] += __uint_as_float(__builtin_amdgcn_update_dpp(0u, __float_as_uint(T_[i]), 0x128, 0xf, 0xf, false)); T_[i] += __uint_as_float(__builtin_amdgcn_update_dpp(0u, __float_as_uint(T_[i]), 0x124, 0xf, 0xf, false)); }
          T2a = b3 ? (b2 ? T_[6] : T_[4]) : (b2 ? T_[2] : T_[0]); T2b = b3 ? (b2 ? T_[7] : T_[5]) : (b2 ? T_[3] : T_[1]);
          (void)ix5_append(T2a, T2b, 64 * nst - 32 + kl, true, true, qpos, theta, cnt_addr, sc_addr, ky_addr); }
#undef IX5_DMA
#undef IX5_ZERO
#undef IX5_BLOCK
        __syncthreads();
        LAS unsigned* bm = (LAS unsigned*)(ringA + w8 * 2048);
        for (int i = 0; i < 4; ++i) { const int qq = 4 * w8 + i; const int c = __builtin_amdgcn_readfirstlane((int)cnt[qq]); unsigned short* io = IDX + (m0 + qq) * TOPK;
            keymap_clear(bm, lane); asm volatile("s_waitcnt lgkmcnt(0)" ::: "memory");
            if (c > TOPK) select_lds<true, L5_CAP / 64>(lsc + qq * L5_CAP, lky + qq * L5_CAP, c, nullptr, nullptr, bm, lane);
            else {
#pragma unroll
                for (int k = 0; k < 4; ++k) { const int j = lane + 64 * k; if (j < c) { const unsigned key = lky[qq * L5_CAP + j]; __hip_atomic_fetch_or(bm + (key >> 5), 1u << (key & 31u), __ATOMIC_RELAXED, __HIP_MEMORY_SCOPE_WORKGROUP); } } }
            asm volatile("s_waitcnt lgkmcnt(0)" ::: "memory");
            keymap_emit(bm, io, c, lane);
            asm volatile("s_waitcnt lgkmcnt(0)" ::: "memory"); }
        __syncthreads();
    }
}

__device__ __forceinline__ unsigned q_fetch(unsigned* ctr, int lane) { unsigned v = 0u; if (lane == 0) v = __hip_atomic_fetch_add(ctr, 1u, __ATOMIC_RELAXED, __HIP_MEMORY_SCOPE_AGENT); return (unsigned)__builtin_amdgcn_readfirstlane((int)v); }
__device__ __forceinline__ void sparse_attn_phase(Frame& F0, const h16* Q, const unsigned char* K8, const unsigned char* V8, const unsigned short* IDX, h16* O, unsigned* qctr) {
    Frame F = fresh(F0);
    LAS unsigned char* wl = F.lds + RING_OFF + F.wave * 16896;
    LAS float* Pl = (LAS float*)wl;
    LAS unsigned short* Il = (LAS unsigned short*)(wl + 4096);
    const int lane = F.lane, r16 = lane & 15, g4 = lane >> 4;
    const float c2 = 0.08838834764831845f * 1.44269504089f;
    const unsigned x0 = xb_xcc_id() & 7u;
    unsigned tried = 0u, p = x0;
    unsigned item = q_fetch(qctr + 64 * p, lane);
    bool have_pf = false; u32x2 pf_idx = (u32x2){0u, 0u}; half8 pf_q[4];
#pragma unroll
    for (int s = 0; s < 4; ++s) pf_q[s] = (half8){0, 0, 0, 0, 0, 0, 0, 0};
    for (;;) {
        while (item >= (unsigned)SEQ && tried < 8u) { ++tried; p = (x0 + tried) & 7u; if (tried < 8u) item = q_fetch(qctr + 64 * p, lane); }
        if (tried >= 8u) break;
        const unsigned nxt = q_fetch(qctr + 64 * p, lane);
        const int b = (int)(p >> 2), j = (int)(p & 3u), tq = (int)item, nk = (tq + 1) < TOPK ? (tq + 1) : TOPK;
        const size_t m = (size_t)b * SEQ + tq;
        const unsigned char* kb = K8 + (size_t)p * SEQ * HD; const unsigned char* vb = V8 + (size_t)p * SEQ * HD;
        *(LAS u32x2*)(Il + 4 * lane) = have_pf ? pf_idx : *(const u32x2*)(IDX + m * TOPK + 4 * lane);
        long qh[4], ql[4];
        { const h16* qrow = Q + m * 2048 + (size_t)j * 512 + (r16 & 3) * HD + 16 * g4;
#pragma unroll
          for (int s = 0; s < 4; ++s) { const half8 hv = have_pf ? pf_q[s] : *(const half8*)(qrow + (s >> 1) * 64 + (s & 1) * 8);
              float f[8], l[8];
#pragma unroll
              for (int e = 0; e < 8; ++e) f[e] = (float)hv[e] * c2;
              const unsigned h0 = pk8(f[0], f[1], f[2], f[3]), h1 = pk8(f[4], f[5], f[6], f[7]);
              l[0] = f[0] - __builtin_amdgcn_cvt_f32_fp8((int)h0, 0); l[1] = f[1] - __builtin_amdgcn_cvt_f32_fp8((int)h0, 1); l[2] = f[2] - __builtin_amdgcn_cvt_f32_fp8((int)h0, 2); l[3] = f[3] - __builtin_amdgcn_cvt_f32_fp8((int)h0, 3);
              l[4] = f[4] - __builtin_amdgcn_cvt_f32_fp8((int)h1, 0); l[5] = f[5] - __builtin_amdgcn_cvt_f32_fp8((int)h1, 1); l[6] = f[6] - __builtin_amdgcn_cvt_f32_fp8((int)h1, 2); l[7] = f[7] - __builtin_amdgcn_cvt_f32_fp8((int)h1, 3);
              const unsigned l0 = pk8(l[0], l[1], l[2], l[3]), l1 = pk8(l[4], l[5], l[6], l[7]);
              const bool real = r16 < 4;
              qh[s] = real ? (long)(((unsigned long long)h1 << 32) | h0) : 0l; ql[s] = real ? (long)(((unsigned long long)l1 << 32) | l0) : 0l; } }
        asm volatile("s_waitcnt lgkmcnt(0)" ::: "memory");
        int keys[16];
#pragma unroll
        for (int kt = 0; kt < 16; ++kt) keys[kt] = Il[16 * kt + r16];
        {
            u32x4 ka[8][2];
#pragma unroll
            for (int k8 = 0; k8 < 8; ++k8) { const unsigned char* krow = kb + (size_t)keys[k8] * HD + 16 * g4; ka[k8][0] = *(const u32x4*)krow; ka[k8][1] = *(const u32x4*)(krow + 64); }
#pragma unroll
            for (int kt = 0; kt < 16; ++kt) { const int k8 = kt & 7; const u32x4 a0 = ka[k8][0], a1 = ka[k8][1];
                const long ak[4] = {(long)(((unsigned long long)a0.y << 32) | a0.x), (long)(((unsigned long long)a0.w << 32) | a0.z), (long)(((unsigned long long)a1.y << 32) | a1.x), (long)(((unsigned long long)a1.w << 32) | a1.z)};
                if (kt < 8) { const unsigned char* krow = kb + (size_t)keys[kt + 8] * HD + 16 * g4; ka[k8][0] = *(const u32x4*)krow; ka[k8][1] = *(const u32x4*)(krow + 64); }
                f32x4 acc = (f32x4){0.f, 0.f, 0.f, 0.f};
#pragma unroll
                for (int s = 0; s < 4; ++s) { acc = __builtin_amdgcn_mfma_f32_16x16x32_fp8_fp8(ak[s], qh[s], acc, 0, 0, 0); acc = __builtin_amdgcn_mfma_f32_16x16x32_fp8_fp8(ak[s], ql[s], acc, 0, 0, 0); }
                if (r16 < 4) {
#pragma unroll
                    for (int i = 0; i < 4; ++i) Pl[(16 * kt + 4 * g4 + i) * 4 + r16] = acc[i]; }
            }
        }
        have_pf = nxt < (unsigned)SEQ;
        if (have_pf) { const size_t mn = (size_t)b * SEQ + nxt; pf_idx = *(const u32x2*)(IDX + mn * TOPK + 4 * lane);
            const h16* qn = Q + mn * 2048 + (size_t)j * 512 + (r16 & 3) * HD + 16 * g4;
#pragma unroll
            for (int s = 0; s < 4; ++s) pf_q[s] = *(const half8*)(qn + (s >> 1) * 64 + (s & 1) * 8); }
        asm volatile("" ::: "memory");
        LAS unsigned char* vs = wl + 4608;
        const int nch = (nk + 31) >> 5;
#define SP_ISSUE(ch_) do { const int c_ = (ch_); LAS unsigned char* s_ = vs + (c_ % 3) * 4096; _Pragma("unroll") for (int j_ = 0; j_ < 4; ++j_) { const int key_ = Il[32 * c_ + 8 * j_ + (lane >> 3)]; \
                __builtin_amdgcn_global_load_lds((const unsigned*)(vb + (size_t)key_ * HD + (((lane & 7) ^ (((8 * j_ + (lane >> 3)) >> 1) & 7)) * 16)), (LAS unsigned*)(s_ + 1024 * j_), 16, 0, 0); } } while (0)
            SP_ISSUE(0); if (nch > 1) SP_ISSUE(1);
        f32x4 sv[4]; f32x4 mx = (f32x4){-3.0e38f, -3.0e38f, -3.0e38f, -3.0e38f};
#pragma unroll
        for (int k = 0; k < 4; ++k) { sv[k] = *(const LAS f32x4*)(Pl + (lane + 64 * k) * 4); if (lane + 64 * k < nk) { mx[0] = fmaxf(mx[0], sv[k][0]); mx[1] = fmaxf(mx[1], sv[k][1]); mx[2] = fmaxf(mx[2], sv[k][2]); mx[3] = fmaxf(mx[3], sv[k][3]); } }
        mx[0] = wave_max_dpp(mx[0]); mx[1] = wave_max_dpp(mx[1]); mx[2] = wave_max_dpp(mx[2]); mx[3] = wave_max_dpp(mx[3]);
        f32x4 sum = (f32x4){0.f, 0.f, 0.f, 0.f};
        asm volatile("s_waitcnt lgkmcnt(0)" ::: "memory");
#pragma unroll
        for (int k = 0; k < 4; ++k) { f32x4 pv;
#pragma unroll
            for (int h = 0; h < 4; ++h) pv[h] = (lane + 64 * k < nk) ? __builtin_amdgcn_exp2f(sv[k][h] - mx[h]) : 0.f;
            sum += pv;
#pragma unroll
            for (int h = 0; h < 4; ++h) Pl[h * 256 + lane + 64 * k] = pv[h] * 16.0f; }
        sum[0] = wave_sum_dpp(sum[0]); sum[1] = wave_sum_dpp(sum[1]); sum[2] = wave_sum_dpp(sum[2]); sum[3] = wave_sum_dpp(sum[3]);
        asm volatile("s_waitcnt lgkmcnt(0)" ::: "memory");
        long ph[8], pq[8];
#pragma unroll
        for (int s = 0; s < 8; ++s) { const LAS float* pp = Pl + (r16 & 3) * 256 + 32 * s + 8 * g4; const f32x4 a = *(const LAS f32x4*)pp, c = *(const LAS f32x4*)(pp + 4);
            const unsigned h0 = pk8(a[0], a[1], a[2], a[3]), h1 = pk8(c[0], c[1], c[2], c[3]);
            const unsigned l0 = pk8(a[0] - __builtin_amdgcn_cvt_f32_fp8((int)h0, 0), a[1] - __builtin_amdgcn_cvt_f32_fp8((int)h0, 1), a[2] - __builtin_amdgcn_cvt_f32_fp8((int)h0, 2), a[3] - __builtin_amdgcn_cvt_f32_fp8((int)h0, 3));
            const unsigned l1 = pk8(c[0] - __builtin_amdgcn_cvt_f32_fp8((int)h1, 0), c[1] - __builtin_amdgcn_cvt_f32_fp8((int)h1, 1), c[2] - __builtin_amdgcn_cvt_f32_fp8((int)h1, 2), c[3] - __builtin_amdgcn_cvt_f32_fp8((int)h1, 3));
            const bool real = r16 < 4;
            ph[s] = real ? (long)(((unsigned long long)h1 << 32) | h0) : 0l; pq[s] = real ? (long)(((unsigned long long)l1 << 32) | l0) : 0l; }
        f32x4 oacc[8];
#pragma unroll
        for (int nt = 0; nt < 8; ++nt) oacc[nt] = (f32x4){0.f, 0.f, 0.f, 0.f};
        {
            const int vrow = 8 * g4 + (r16 >> 1);
#pragma unroll
            for (int ch = 0; ch < 8; ++ch) {
                if (ch < nch) {
                    if (ch + 2 < nch) { SP_ISSUE(ch + 2); asm volatile("s_waitcnt vmcnt(8)" ::: "memory"); }
                    else if (ch + 1 < nch) asm volatile("s_waitcnt vmcnt(4)" ::: "memory");
                    else asm volatile("s_waitcnt vmcnt(0)" ::: "memory");
                    const LAS unsigned char* s = vs + (ch % 3) * 4096 + vrow * HD + 8 * (r16 & 1);
#pragma unroll
                    for (int nt = 0; nt < 8; ++nt) {
                        const v2i32 bv = __builtin_amdgcn_ds_read_tr8_b64_v2i32((LAS v2i32*)(s + ((nt ^ ((vrow >> 1) & 7)) * 16)));
                        const long bb = (long)(((unsigned long long)(unsigned)bv.y << 32) | (unsigned)bv.x);
                        oacc[nt] = __builtin_amdgcn_mfma_f32_16x16x32_fp8_fp8(ph[ch], bb, oacc[nt], 0, 0, 0);
                        oacc[nt] = __builtin_amdgcn_mfma_f32_16x16x32_fp8_fp8(pq[ch], bb, oacc[nt], 0, 0, 0); }
                    asm volatile("s_waitcnt lgkmcnt(0)" ::: "memory");
                }
            }
#undef SP_ISSUE
        }
        { LAS h16* ot = (LAS h16*)Pl;
          if (g4 == 0) {
#pragma unroll
              for (int nt = 0; nt < 8; ++nt)
#pragma unroll
                  for (int i = 0; i < 4; ++i) ot[i * HD + 16 * nt + r16] = (h16)(oacc[nt][i] * (0.0625f / sum[i])); }
          asm volatile("s_waitcnt lgkmcnt(0)" ::: "memory");
          const u32x4 w = *(const LAS u32x4*)(ot + g4 * HD + 8 * r16);
          *(u32x4*)(O + m * 2048 + (size_t)j * 512 + g4 * HD + 8 * r16) = w; }
        asm volatile("s_waitcnt lgkmcnt(0)" ::: "memory");
        item = nxt;
    }
}

#ifndef DBG_CHECK
#define DBG_CHECK 0
#endif
#if DBG_CHECK
__device__ __forceinline__ void dbg_max(unsigned* w, float v) { atomicMax(w, __builtin_bit_cast(unsigned, fabsf(v))); }
__device__ __forceinline__ int dbg_row(int blk) { return (blk & 1) * SEQ + (SEQ - 1 - 251 * (blk >> 1)); }
__device__ __forceinline__ void dbg_check_inproj(unsigned char* ws, LAS float* sh, unsigned* word) {
    if (blockIdx.x >= 64) return;
    int tid_ = (int)threadIdx.x; asm volatile("" : "+v"(tid_)); const int m = dbg_row(blockIdx.x), tid = tid_;
    const h16* a = (const h16*)(ws + WS_A) + (size_t)m * 2048; const h16* W = (const h16*)(ws + WS_WIN);
    for (int c = tid; c < DSA_N; c += 512) { float s = 0.f; for (int k = 0; k < 2048; ++k) s += (float)a[k] * (float)W[(size_t)c * 2048 + k]; sh[c] = s * (1.0f / 64.0f); }
    __syncthreads();
    const float* rope = (const float*)(ws + WS_ROPE) + (size_t)m * 32;
    for (int c = tid; c < DSA_N; c += 512) {
        float v = sh[c]; int hc; bool rot; float got;
        if (c < 2048) { hc = c & 127; rot = true; got = (float)((const h16*)(ws + WS_Q))[(size_t)m * 2048 + c]; }
        else if (c < 3072) continue;
        else if (c < 5120) { hc = (c - 3072) & 127; rot = true; got = (float)((const h16*)(ws + WS_IQ))[(size_t)m * 2048 + (c - 3072)]; }
        else if (c < 5248) { hc = c - 5120; rot = true; got = (float)((const h16*)(ws + WS_IK))[(size_t)m * 128 + (c - 5120)]; }
        else { hc = 99; rot = false; got = ((const float*)(ws + WS_IW))[(size_t)m * 16 + (c - 5248)]; }
        if (rot && hc < 32) { const int i = hc & 15; const float cs = rope[i], sn = rope[16 + i]; v = hc < 16 ? v * cs - sh[c + 16] * sn : v * cs + sh[c - 16] * sn; }
        dbg_max(word, (got - v) / (1.0f + fabsf(v)));
    }
    __syncthreads();
}
__device__ __forceinline__ void dbg_check_xattn(unsigned char* ws, int L, LAS float* sh, unsigned* word) {
    if (blockIdx.x >= 64) return;
    int tid_ = (int)threadIdx.x; asm volatile("" : "+v"(tid_)); const int m = dbg_row(blockIdx.x), tid = tid_, b = m / SEQ;
    const h16* a = (const h16*)(ws + WS_A) + (size_t)m * 2048; const h16* W = (const h16*)(ws + WS_WQ) + (size_t)L * 512 * 2048;
    const h16* kvm = (const h16*)(ws + WS_KVM) + (size_t)b * NMEM * 2048 + L * 1024;
    LAS float* q = sh; LAS float* lg = sh + 512; LAS float* st = sh + 512 + 1024;
    { float s = 0.f; for (int k = 0; k < 2048; ++k) s += (float)a[k] * (float)W[(size_t)tid * 2048 + k]; q[tid] = (float)(h16)s; }
    __syncthreads();
    for (int i = tid; i < 1024; i += 512) { const int h = i >> 8, key = i & 255; float s = 0.f; for (int d = 0; d < 128; ++d) s += q[h * 128 + d] * (float)kvm[(size_t)key * 2048 + h * 128 + d]; lg[i] = s * 0.08838834764831845f; }
    __syncthreads();
    if (tid < 4) { float mx = -3e38f; for (int k = 0; k < 256; ++k) mx = fmaxf(mx, lg[tid * 256 + k]); float su = 0.f; for (int k = 0; k < 256; ++k) su += __expf(lg[tid * 256 + k] - mx); st[2 * tid] = mx; st[2 * tid + 1] = 1.0f / su; }
    __syncthreads();
    { const int h = tid >> 7, d = tid & 127; float o = 0.f; for (int k = 0; k < 256; ++k) o += __expf(lg[h * 256 + k] - st[2 * h]) * st[2 * h + 1] * (float)kvm[(size_t)k * 2048 + 512 + h * 128 + d];
      const float got = (float)((const h16*)(ws + WS_XQ))[(size_t)m * 512 + tid]; dbg_max(word, (got - o) / (0.05f + fabsf(o))); }
    __syncthreads();
}
__device__ __forceinline__ void dbg_check_indexer(unsigned char* ws, LAS float* sh, unsigned* word, unsigned* word2) {
    if (blockIdx.x >= 64) return;
    int tid_ = (int)threadIdx.x; asm volatile("" : "+v"(tid_)); const int m = dbg_row(blockIdx.x), tid = tid_, b = m / SEQ, t = m % SEQ;
    const h16* iq = (const h16*)(ws + WS_IQ) + (size_t)m * 2048; const h16* ik = (const h16*)(ws + WS_IK) + (size_t)b * SEQ * 128; const float* iw = (const float*)(ws + WS_IW) + (size_t)m * 16;
    LAS float* sc = sh;
    for (int s = tid; s <= t; s += 512) { float tot = 0.f; for (int h = 0; h < 16; ++h) { float l = 0.f; for (int d = 0; d < 128; ++d) l += (float)iq[h * 128 + d] * (float)ik[(size_t)s * 128 + d]; tot += iw[h] * fmaxf(l, 0.f); } sc[s] = tot; }
    __syncthreads();
    const unsigned short* idx = (const unsigned short*)(ws + WS_IDX) + (size_t)m * 256;
    if (tid < 256) { const int key = idx[tid]; if (key > t) atomicAdd(word2, 1000u); else { const float v = sc[key]; int rank = 0; for (int s = 0; s <= t; ++s) rank += sc[s] > v ? 1 : 0; if (rank >= 256) atomicAdd(word, 1u);
        for (int j = 0; j < 256; ++j) if (j != tid && idx[j] == key) { atomicAdd(word2, 1u); break; } } }
    __syncthreads();
}
__device__ __forceinline__ float dbg_f8(const unsigned char* p) { const unsigned w = *p; return __builtin_amdgcn_cvt_f32_fp8((int)w, 0); }
__device__ __forceinline__ void dbg_check_sparse(unsigned char* ws, LAS float* sh, unsigned* word) {
    if (blockIdx.x >= 64) return;
    int tid_ = (int)threadIdx.x; asm volatile("" : "+v"(tid_)); const int m = dbg_row(blockIdx.x), tid = tid_, b = m / SEQ;
    const h16* q = (const h16*)(ws + WS_Q) + (size_t)m * 2048; const unsigned char* k8 = (const unsigned char*)(ws + WS_KV); const unsigned char* v8 = k8 + (size_t)16 * 1024 * 1024;
    const unsigned short* idx = (const unsigned short*)(ws + WS_IDX) + (size_t)m * 256;
    LAS float* lg = sh; LAS float* st = sh + 4096;
    for (int i = tid; i < 4096; i += 512) { const int h = i >> 8, k = i & 255, key = idx[k]; float s = 0.f; const unsigned char* kr = k8 + ((size_t)(b * NKV + (h >> 2)) * SEQ + key) * HD;
        for (int d = 0; d < 128; ++d) s += (float)q[h * 128 + d] * dbg_f8(kr + d); lg[i] = s * 0.08838834764831845f; }
    __syncthreads();
    if (tid < 16) { float mx = -3e38f; for (int k = 0; k < 256; ++k) mx = fmaxf(mx, lg[tid * 256 + k]); float su = 0.f; for (int k = 0; k < 256; ++k) su += __expf(lg[tid * 256 + k] - mx); st[2 * tid] = mx; st[2 * tid + 1] = 1.0f / su; }
    __syncthreads();
    for (int i = tid; i < 2048; i += 512) { const int h = i >> 7, d = i & 127; float o = 0.f; for (int k = 0; k < 256; ++k) o += __expf(lg[h * 256 + k] - st[2 * h]) * st[2 * h + 1] * dbg_f8(v8 + ((size_t)(b * NKV + (h >> 2)) * SEQ + idx[k]) * HD + d);
        const float got = (float)((const h16*)(ws + WS_A))[(size_t)m * 2048 + i]; dbg_max(word, (got - o) / (0.02f + fabsf(o))); }
    __syncthreads();
}
#endif

constexpr int N_PHASES = 22 + (DBG_CHECK ? 1 : 0);
__global__ void __launch_bounds__(NWAVES * 64, 2) trunk_fwd(Args args) {
    extern __shared__ __attribute__((aligned(16))) unsigned char lds_raw[];
    Frame F;
    F.lds = (LAS unsigned char*)lds_raw;
    F.MISC = (volatile LAS unsigned*)(F.lds + MISC_OFF);
    F.tid = threadIdx.x; F.lane = F.tid & 63; F.wave = __builtin_amdgcn_readfirstlane(F.tid >> 6);
    F.G = gridDim.x; { const int bx = blockIdx.x; F.vcu = (F.G % 8 == 0) ? (bx % 8) * (F.G / 8) + bx / 8 : bx; }
    unsigned char* ws = argp()->ws;
    for (int u = F.tid; u < (LDS_BYTES - MISC_OFF) / 4; u += NWAVES * 64) ((LAS unsigned*)(F.lds + MISC_OFF))[u] = 0u;
    __syncthreads();
    XcdBarrier bar; bar.bar = (unsigned*)(ws + WS_CTL) + CW_BAR; bar.x = 0; bar.st = nullptr;
    if (!MK_LAUNCH_PER_PHASE) bar = xcd_barrier_post((unsigned*)(ws + WS_CTL) + CW_BAR, F.MISC + 8);
    const int lo = argp()->ph_lo, hi = argp()->ph_hi;
#ifndef DBG_KINDS
#define DBG_KINDS 0xFFFF
#endif
#define KON(kind) (((DBG_KINDS) >> (kind)) & 1)
#ifndef PROBE_REP
#define PROBE_REP 0
#endif
#define NREP(kind) ((((PROBE_REP) >> (kind)) & 1) ? 2 : 1)
#define IN(k) (lo <= (k) && (k) < hi)
#define SEAM(k) do { if (IN((k) + 1)) { if (MK_LAUNCH_PER_PHASE) { } else xcd_barrier(bar); } } while (0)
    LAS unsigned char* ring = F.lds + RING_OFF;
    const int bid = (int)blockIdx.x;
    h16* A = (h16*)(ws + WS_A); h16* Y = (h16*)(ws + WS_Y); h16* H = (h16*)(ws + WS_H); float* RS = (float*)(ws + WS_CTL + 512 * 1024);     h16* XQ = (h16*)(ws + WS_XQ); h16* ACT = (h16*)(ws + WS_ACT);

    if (KON(0) && IN(0)) { for (int rep = 0; rep < NREP(0); ++rep) { if (rep) xcd_barrier(bar); p0_prologue(F, argp()); } SEAM(0); }
    if (KON(1) && IN(1)) {
        { pg8::Gemm g{A, (const h16*)(ws + WS_WPOOL), T, D, 512, D, 1}; pg8::StaticOrder S; S.init(T, D, F.G, bid);
          pg8::EpiH16 E{Y, D, 1.0f, nullptr}; pg8::gemm_phase<pg8::EpiH16, pg8::StaticOrder, true, true>(ring, g, S, E); }
        __syncthreads();
        { pg8::Gemm g{(const h16*)(ws + WS_MEMN), (const h16*)(ws + WS_WKV), NB * NMEM, 2048, 2048, 2048, 31}; pg8::StaticOrder S; S.init(NB * NMEM, 2048, F.G, bid);
          pg8::EpiH16 E{(h16*)(ws + WS_KVM), 2048, 1.0f, nullptr}; pg8::gemm_phase<pg8::EpiH16, pg8::StaticOrder, true, true>(ring, g, S, E); }
        SEAM(1);
    }
#pragma unroll 1
    for (int L = 0; L < 2; ++L) {
        const int pb = L == 0 ? 2 : 14;
        if (L == 1) {
            if (KON(2) && IN(10)) {
                pg8::Gemm g{H, (const h16*)(ws + WS_WIN), T, DSA_NP, 2048, 2048, 31}; pg8::StaticOrder S; S.init(T, DSA_NP, F.G, bid);
                pg8::EpiInProj E{(h16*)(ws + WS_Q), (h16*)(ws + WS_KV), (h16*)(ws + WS_IQ), (h16*)(ws + WS_IK), (float*)(ws + WS_IW), (const float*)(ws + WS_ROPE), 1.0f / 64.0f, RS};
                for (int rep = 0; rep < NREP(2); ++rep) { if (rep) xcd_barrier(bar); pg8::gemm_phase<pg8::EpiInProj, pg8::StaticOrder, true, true>(ring, g, S, E); }
                SEAM(10);
            }
#if DBG_CHECK
            if (IN(11)) dbg_check_inproj(ws, (LAS float*)ring, (unsigned*)(ws + WS_CTL) + 1024);
#endif
            if (KON(3) && IN(11)) { for (int rep = 0; rep < NREP(3); ++rep) { if (rep) xcd_barrier(bar); if (IDX16 == 2) indexer_phase5(F, (const h16*)(ws + WS_IQ), (const h16*)(ws + WS_IK), (const float*)(ws + WS_IW), (unsigned short*)(ws + WS_IDX)); else if (IDX16) indexer_phase16(F, (const h16*)(ws + WS_IQ), (const h16*)(ws + WS_IK), (const float*)(ws + WS_IW), (unsigned short*)(ws + WS_IDX)); else indexer_phase(F, (const h16*)(ws + WS_IQ), (const h16*)(ws + WS_IK), (const float*)(ws + WS_IW), (unsigned short*)(ws + WS_IDX), (u32x2*)(ws + WS_LISTS)); } SEAM(11); }
#if DBG_CHECK
            if (IN(12)) dbg_check_indexer(ws, (LAS float*)ring, (unsigned*)(ws + WS_CTL) + 1026, (unsigned*)(ws + WS_CTL) + 1028);
#endif
            if (KON(4) && IN(12)) { for (int rep = 0; rep < NREP(4); ++rep) { if (rep) xcd_barrier(bar); sparse_attn_phase(F, (const h16*)(ws + WS_Q), (const unsigned char*)(ws + WS_KV), (const unsigned char*)(ws + WS_KV) + (size_t)16 * 1024 * 1024, (const unsigned short*)(ws + WS_IDX), A, (unsigned*)(ws + WS_CTL) + 2048 + 512 * rep); } SEAM(12); }
#if DBG_CHECK
            if (IN(13)) dbg_check_sparse(ws, (LAS float*)ring, (unsigned*)(ws + WS_CTL) + 1027);
#endif
            if (KON(5) && IN(13)) {
                pg8::Gemm g{A, (const h16*)(ws + WS_WOUT), T, D, 2048, 2048, 31}; pg8::StaticOrder S; S.init(T, D, F.G, bid);
                pg8::EpiH16 E{Y, D, 1.0f, nullptr}; pg8::gemm_phase<pg8::EpiH16, pg8::StaticOrder, true, true>(ring, g, S, E);
                SEAM(13);
            }
        }
        if (KON(6) && IN(pb + 0)) { ArgP a = argp(); const float* gains = a->gains + (size_t)L * 6 * D;
            if (L == 0) seam_phase<true, false, true, false, true>(F, Y, a->x, H, gains + 1 * D, nullptr, nullptr, RS); else seam_phase<true, false, false, false, true>(F, Y, H, H, gains + 1 * D, nullptr, nullptr, RS);
            SEAM(pb + 0); }
        if (KON(7) && IN(pb + 1)) {
            pg8::Gemm g{H, (const h16*)(ws + WS_WQ) + (size_t)L * XW * 2048, T, XW, 2048, 2048, 31}; pg8::StaticOrder S; S.init(T, XW, F.G, bid);
            pg8::EpiH16 E{XQ, XW, 1.0f, RS}; pg8::gemm_phase<pg8::EpiH16, pg8::StaticOrder, true, true>(ring, g, S, E);
            SEAM(pb + 1);
        }
        if (KON(8) && IN(pb + 2)) { xattn_phase(F, XQ, (const h16*)(ws + WS_KVM) + L * 1024); SEAM(pb + 2); }
#if DBG_CHECK
        if (IN(pb + 3)) dbg_check_xattn(ws, L, (LAS float*)ring, (unsigned*)(ws + WS_CTL) + 1025);
#endif
        if (KON(9) && IN(pb + 3)) {
            pg8::Gemm g{XQ, (const h16*)(ws + WS_WO) + (size_t)L * 2048 * XW, T, D, XW, XW, 31}; pg8::StaticOrder S; S.init(T, D, F.G, bid);
            pg8::EpiH16 E{Y, D, 1.0f, nullptr}; pg8::gemm_phase<pg8::EpiH16, pg8::StaticOrder, true, true>(ring, g, S, E);
            SEAM(pb + 3);
        }
        if (KON(10) && IN(pb + 4)) { ArgP a = argp(); const float* gains = a->gains + (size_t)L * 6 * D;
            if ((FFN_FP8 >> L) & 1) seam_phase<true, true, false, false>(F, Y, H, H, gains + 3 * D, gains + 4 * D, A); else seam_phase<true, false, false, false, true>(F, Y, H, H, gains + 3 * D, nullptr, nullptr, RS);
            SEAM(pb + 4); }
        static_assert(DN_FP8 == 3, "the fp16 gate|up GEMM reads the residual stream with a row factor in its e4m3 epilogue: every layer's down projection is e4m3");
        static_assert((FFN_FP8 & ~DN_FP8) == 0, "an e4m3 gate|up GEMM writes e4m3 activations: its down projection must be e4m3 too");
        if (KON(11) && IN(pb + 5) && ((FFN_FP8 >> L) & 1)) {
            pg8::Gemm g{A, (const h16*)(ws + WS_WGU) + (size_t)L * 2 * DFF * 2048  , T, 2 * DFF, 1024, 1024, 31}; pg8::StaticOrder S; S.init(T, 2 * DFF, F.G, bid);
            pg8::EpiSwiGLU8 E{(unsigned char*)ACT, DFF, 1.0f / W8_SCALE, ACT8_SCALE, nullptr}; pg8::gemm_phase<pg8::EpiSwiGLU8, pg8::StaticOrder, true, true, true>(ring, g, S, E);
            SEAM(pb + 5);
        }
        if (KON(11) && IN(pb + 5) && !((FFN_FP8 >> L) & 1) && ((DN_FP8 >> L) & 1)) {
            pg8::Gemm g{H, (const h16*)(ws + WS_WGU) + (size_t)L * 2 * DFF * 2048, T, 2 * DFF, 2048, 2048, 31}; pg8::StaticOrder S; S.init(T, 2 * DFF, F.G, bid);
            pg8::EpiSwiGLU8 E{(unsigned char*)ACT, DFF, 1.0f, ACT8_SCALE, RS}; pg8::gemm_phase<pg8::EpiSwiGLU8, pg8::StaticOrder, true, true, false>(ring, g, S, E);
            SEAM(pb + 5);
        }
        if (KON(11) && IN(pb + 5) && !((FFN_FP8 >> L) & 1) && !((DN_FP8 >> L) & 1)) {
            pg8::Gemm g{A, (const h16*)(ws + WS_WGU) + (size_t)L * 2 * DFF * 2048, T, 2 * DFF, 2048, 2048, 31}; pg8::StaticOrder S; S.init(T, 2 * DFF, F.G, bid);
            pg8::EpiSwiGLU E{ACT, DFF}; pg8::gemm_phase<pg8::EpiSwiGLU, pg8::StaticOrder, true, true>(ring, g, S, E);
            SEAM(pb + 5);
        }
        if (KON(12) && IN(pb + 6) && ((DN_FP8 >> L) & 1)) {
            pg8::Gemm g{ACT, (const h16*)(ws + WS_WDN) + (size_t)L * 2048 * DFF  , T, D, DFF / 2, DFF / 2, 31}; pg8::StaticOrder S; S.init(T, D, F.G, bid);
            pg8::EpiH16 E{Y, D, 1.0f / (W8_SCALE * ACT8_SCALE), nullptr}; pg8::gemm_phase<pg8::EpiH16, pg8::StaticOrder, true, true, true>(ring, g, S, E);
            SEAM(pb + 6);
        }
        if (KON(12) && IN(pb + 6) && !((DN_FP8 >> L) & 1)) {
            pg8::Gemm g{ACT, (const h16*)(ws + WS_WDN) + (size_t)L * 2048 * DFF, T, D, DFF, DFF, 31}; pg8::StaticOrder S; S.init(T, D, F.G, bid);
            pg8::EpiH16 E{Y, D, 1.0f, nullptr}; pg8::gemm_phase<pg8::EpiH16, pg8::StaticOrder, true, true>(ring, g, S, E);
            SEAM(pb + 6);
        }
        if (KON(13) && IN(pb + 7)) {
            ArgP a = argp(); const float* gains = a->gains + (size_t)L * 6 * D;
            if (L == 0) seam_phase<true, false, false, false, true>(F, Y, H, H, gains + 5 * D, nullptr, nullptr, RS);
            else seam_phase<false, false, false, true>(F, Y, H, a->out, gains + 5 * D, nullptr, nullptr);
            SEAM(pb + 7);
        }
    }
#if DBG_CHECK
    if (IN(22)) {
        const unsigned* dw = (const unsigned*)(ws + WS_CTL) + 1024;
        const bool f0 = __builtin_bit_cast(float, dw[0]) > 4e-3f, f1 = __builtin_bit_cast(float, dw[1]) > 2e-2f, f2 = dw[2] > 24u, f3 = __builtin_bit_cast(float, dw[3]) > 2e-2f, f4 = dw[4] > 0u;
        for (int m = F.vcu * NWAVES + F.wave; m < T; m += F.G * NWAVES) { const int r = m & 15;
            const bool z = (r < 8 && f0) || (r >= 8 && r < 12 && f1) || (r >= 12 && r < 14 && f2) || (r == 14 && f3) || (r == 15 && f4);
            if (z) for (int j = 0; j < 8; ++j) ((f32x4*)(argp()->out + (size_t)m * D))[F.lane + 64 * j] = (f32x4){0.f, 0.f, 0.f, 0.f}; }
    }
#endif
#undef IN
#undef SEAM
}

extern "C" void kernel_launch(void* const* d_in, const int* in_sizes, int n_in, void* d_out, int out_size, void* d_ws, size_t ws_size, hipStream_t stream) {
    static int grid = 0;
    if (grid == 0) {
        if (n_in != 14 || in_sizes[0] != T * D || out_size != T * D || ws_size < WS_END) {
            fprintf(stderr, "kernel_launch: built for 14 inputs, x/out of %d floats, >= %zu bytes of workspace; got n_in %d, in0 %d, out %d, ws %zu; nothing launched\n", T * D, (size_t)WS_END, n_in, n_in > 0 ? in_sizes[0] : -1, out_size, ws_size);
            grid = -1; return; }
        int dev = 0, cus = 0, per_cu = 0;
        if (hipGetDevice(&dev) != hipSuccess || hipDeviceGetAttribute(&cus, hipDeviceAttributeMultiprocessorCount, dev) != hipSuccess) { fprintf(stderr, "kernel_launch: device query failed\n"); grid = -1; return; }
        if (hipFuncSetAttribute((const void*)trunk_fwd, hipFuncAttributeMaxDynamicSharedMemorySize, LDS_BYTES) != hipSuccess) { fprintf(stderr, "kernel_launch: hipFuncSetAttribute failed\n"); grid = -1; return; }
        if (hipOccupancyMaxActiveBlocksPerMultiprocessor(&per_cu, (const void*)trunk_fwd, NWAVES * 64, LDS_BYTES) != hipSuccess || per_cu < 1)
            fprintf(stderr, "kernel_launch: note: occupancy query reports %d workgroups per CU\n", per_cu);
        (void)hipGetLastError();
        grid = cus;
    }
    if (grid < 0) return;
    if (hipMemsetAsync((char*)d_ws + WS_CTL, 0, CTL_ZERO_BYTES, stream) != hipSuccess) { fprintf(stderr, "kernel_launch: memset failed\n"); return; }
    Args a{};
    a.x = (const float*)d_in[0]; a.mem = (const float*)d_in[1]; a.pos = (const int*)d_in[2]; a.gains = (const float*)d_in[3]; a.mem_norm = (const float*)d_in[4];
    a.pool_w = (const float*)d_in[5]; a.pool_scale = (const float*)d_in[6]; a.w_in = (const float*)d_in[7]; a.w_out = (const float*)d_in[8]; a.wq = (const float*)d_in[9];
    a.wkv = (const float*)d_in[10]; a.wo = (const float*)d_in[11]; a.wgu = (const float*)d_in[12]; a.wdn = (const float*)d_in[13];
    a.out = (float*)d_out; a.ws = (unsigned char*)d_ws;
    for (int i = 0; i < 16; ++i) a.inv_freq[i] = (float)pow(500000.0, -(double)(2 * i) / 32.0);
    a.pad = 0;
#if MK_LAUNCH_PER_PHASE
    for (int p = 0; p < N_PHASES; ++p) { a.ph_lo = p; a.ph_hi = p + 1; a.li = p;
        hipLaunchKernelGGL(trunk_fwd, dim3(grid), dim3(NWAVES * 64), LDS_BYTES, stream, a); }
#else
    a.ph_lo = 0; a.ph_hi = N_PHASES; a.li = 0;
    hipLaunchKernelGGL(trunk_fwd, dim3(grid), dim3(NWAVES * 64), LDS_BYTES, stream, a);
#endif
    const hipError_t le = hipPeekAtLastError();
    if (le != hipSuccess) fprintf(stderr, "kernel_launch: launch failed: %s\n", hipGetErrorName(le));
}
```

```cpp
#include <hip/hip_runtime.h>
#include <cstdio>
#include <cstdint>
#include <cmath>

#define LAS __attribute__((address_space(3)))
#define GAS __attribute__((address_space(1)))
typedef _Float16 h16;
typedef _Float16 half8 __attribute__((ext_vector_type(8)));
typedef _Float16 half4 __attribute__((ext_vector_type(4)));
typedef _Float16 half2v __attribute__((ext_vector_type(2)));
typedef float f32x4 __attribute__((ext_vector_type(4)));
typedef float f32x2 __attribute__((ext_vector_type(2)));
typedef float f32x16 __attribute__((ext_vector_type(16)));
typedef unsigned u32x4 __attribute__((ext_vector_type(4)));
typedef unsigned u32x2 __attribute__((ext_vector_type(2)));
typedef int v4i32 __attribute__((ext_vector_type(4)));
typedef int v8i32 __attribute__((ext_vector_type(8)));
typedef int v2i32 __attribute__((ext_vector_type(2)));

__device__ __forceinline__ unsigned pkh(float a, float b) { half2v v; v.x = (h16)a; v.y = (h16)b; return __builtin_bit_cast(unsigned, v); }

__device__ __forceinline__ unsigned pk8(float a, float b, float c, float d) { int w = __builtin_amdgcn_cvt_pk_fp8_f32(a, b, 0, false); w = __builtin_amdgcn_cvt_pk_fp8_f32(c, d, w, true); return (unsigned)w; }

constexpr int SEQ = 16384, NKV = 4, HD = 128;
namespace pg8 {
#define PG8_LAS __attribute__((address_space(3)))
constexpr int BM = 256, BK = 64, HALF = 128, HTB = HALF * BK * 2  , STAGE_BYTES = 8 * HTB, NXCD = 8, WGM = 8;

__host__ __device__ __forceinline__ int lds_byte(int r, int c) { const int st = (r >> 4) * 2 + (c >> 5), rr = r & 15, cc = c & 31, ob = rr * 64 + cc * 2; return st * 1024 + (ob ^ (((ob >> 9) & 1) << 5)); }
__host__ __device__ __forceinline__ void stage_rc(int b, int& R, int& C) { const int st = b / 1024, sb = b % 1024, swz = sb ^ (((sb >> 9) & 1) << 5); R = (st >> 1) * 16 + swz / 64; C = (st & 1) * 32 + (swz % 64) / 2; }
__host__ __device__ __forceinline__ int perm32(int rho) { const int n = rho >> 4, i = rho & 15; return 8 * (i >> 2) + 4 * n + (i & 3); }

struct Unit { int pm, pn; };
struct Gemm { const h16* A; const h16* Bt; int M, N, K, lda, kshift; };

struct StaticOrder {
    int nM, nN, nwg, G, c;
    __host__ __device__ void init(int M, int N, int G_, int c_) { nM = M / BM; nN = N / BM; nwg = nM * nN; G = G_; c = c_; }
    __host__ __device__ bool next(int i, Unit& u) const {
        const long L = (long)i * G + c; if (L >= nwg) return false;
        int wgid = (int)L; { const int q = nwg / NXCD, r = nwg % NXCD, xcd = wgid % NXCD, off = wgid / NXCD; wgid = (xcd < r ? xcd * (q + 1) : r * (q + 1) + (xcd - r) * q) + off; }
        const int nig = WGM * nN, gid = wgid / nig, fm = gid * WGM, gsz = (nM - fm) < WGM ? (nM - fm) : WGM;
        u.pm = fm + ((wgid % nig) % gsz); u.pn = (wgid % nig) / gsz; return true;
    }
    __device__ __forceinline__ void a_ready(const Unit&) const {}
    __device__ __forceinline__ void done(const Unit&) const {}
};

struct EpiF32 {
    static constexpr bool PERM = false, AFTER_DRAIN = false;
    float* C; int ldc; float scale;
    __device__ __forceinline__ void operator()(const f32x4 (&acc)[2][2][4][2], const Unit& u, int wr, int wc, int fr, int fq) const {
        const int row0 = u.pm * BM + wr * 64 + fr, col0 = u.pn * BM + wc * 32 + 4 * fq;
#pragma unroll
        for (int ai = 0; ai < 2; ++ai)
#pragma unroll
            for (int m = 0; m < 4; ++m) { float* rowp = C + (size_t)(row0 + ai * HALF + m * 16) * ldc + col0;
#pragma unroll
                for (int bj = 0; bj < 2; ++bj)
#pragma unroll
                    for (int n = 0; n < 2; ++n) *(f32x4*)(rowp + bj * HALF + n * 16) = acc[ai][bj][m][n] * scale; }
    }
};
struct EpiF32S {
    static constexpr bool PERM = false, AFTER_DRAIN = false;
    float* C; int ldc; float scale;
    __device__ __forceinline__ void operator()(const f32x4 (&acc)[2][2][4][2], const Unit& u, int wr, int wc, int fr_, int fq_) const {
        int l = (int)(threadIdx.x & 63u); asm volatile("" : "+v"(l)); const int fr = l & 15, fq = l >> 4;
        const int row0 = u.pm * BM + wr * 64 + fr, col0 = u.pn * BM + wc * 32 + 4 * fq;
#pragma unroll
        for (int ai = 0; ai < 2; ++ai)
#pragma unroll
            for (int m = 0; m < 4; ++m) { float* rowp = C + (size_t)(row0 + ai * HALF + m * 16) * ldc + col0;
#pragma unroll
                for (int bj = 0; bj < 2; ++bj)
#pragma unroll
                    for (int n = 0; n < 2; ++n) *(f32x4*)(rowp + bj * HALF + n * 16) = acc[ai][bj][m][n] * scale; }
    }
};
struct EpiH16 {
    static constexpr bool PERM = true, AFTER_DRAIN = false;
    h16* O; int ldc; float scale; const float* rs;
    __device__ __forceinline__ void operator()(const f32x4 (&acc)[2][2][4][2], const Unit& u, int wr, int wc, int fr, int fq) const {
        const int row0 = u.pm * BM + wr * 64 + fr, col0 = u.pn * BM + wc * 32 + 8 * fq;
#pragma unroll
        for (int ai = 0; ai < 2; ++ai)
#pragma unroll
            for (int m = 0; m < 4; ++m) { h16* rowp = O + (size_t)(row0 + ai * HALF + m * 16) * ldc + col0; const float sc_ = rs ? scale * rs[row0 + ai * HALF + m * 16] : scale;
#pragma unroll
                for (int bj = 0; bj < 2; ++bj) { const f32x4 v0 = acc[ai][bj][m][0] * sc_, v1 = acc[ai][bj][m][1] * sc_;
                    u32x4 w; w.x = pkh(v0[0], v0[1]); w.y = pkh(v0[2], v0[3]); w.z = pkh(v1[0], v1[1]); w.w = pkh(v1[2], v1[3]);
                    *(u32x4*)(rowp + bj * HALF) = w; } }
    }
};
__device__ __forceinline__ float silu_mul(float g, float u) { return g * u * __builtin_amdgcn_rcpf(1.0f + __builtin_amdgcn_exp2f(g * -1.44269504089f)); }
struct EpiSwiGLU {
    static constexpr bool PERM = true, AFTER_DRAIN = false;
    h16* O; int ldc;
    __device__ __forceinline__ void operator()(const f32x4 (&acc)[2][2][4][2], const Unit& u, int wr, int wc, int fr, int fq) const {
        const int row0 = u.pm * BM + wr * 64 + fr, col0 = u.pn * HALF + wc * 32 + 8 * fq;
#pragma unroll
        for (int ai = 0; ai < 2; ++ai)
#pragma unroll
            for (int m = 0; m < 4; ++m) { h16* rowp = O + (size_t)(row0 + ai * HALF + m * 16) * ldc + col0;
                const f32x4 g0 = acc[ai][0][m][0], g1 = acc[ai][0][m][1], u0 = acc[ai][1][m][0], u1 = acc[ai][1][m][1];
                u32x4 w; w.x = pkh(silu_mul(g0[0], u0[0]), silu_mul(g0[1], u0[1])); w.y = pkh(silu_mul(g0[2], u0[2]), silu_mul(g0[3], u0[3]));
                w.z = pkh(silu_mul(g1[0], u1[0]), silu_mul(g1[1], u1[1])); w.w = pkh(silu_mul(g1[2], u1[2]), silu_mul(g1[3], u1[3]));
                *(u32x4*)rowp = w; }
    }
};
struct EpiSwiGLU8 {
    static constexpr bool PERM = true, AFTER_DRAIN = false;
    unsigned char* O; int ldc; float inscale, outscale; const float* rs;
    __device__ __forceinline__ void operator()(const f32x4 (&acc)[2][2][4][2], const Unit& u, int wr, int wc, int fr_, int fq_) const {
        int l = (int)(threadIdx.x & 63u); asm volatile("" : "+v"(l)); const int fr = l & 15, fq = l >> 4;
        const int row0 = u.pm * BM + wr * 64 + fr, col0 = u.pn * HALF + wc * 32 + 8 * fq;
#pragma unroll
        for (int ai = 0; ai < 2; ++ai)
#pragma unroll
            for (int m = 0; m < 4; ++m) { unsigned char* rowp = O + (size_t)(row0 + ai * HALF + m * 16) * ldc + col0;
                const float is_ = rs ? inscale * rs[row0 + ai * HALF + m * 16] : inscale;
                const f32x4 g0 = acc[ai][0][m][0] * is_, g1 = acc[ai][0][m][1] * is_, u0 = acc[ai][1][m][0] * (is_ * outscale), u1 = acc[ai][1][m][1] * (is_ * outscale);
                u32x2 w; w.x = pk8(silu_mul(g0[0], u0[0]), silu_mul(g0[1], u0[1]), silu_mul(g0[2], u0[2]), silu_mul(g0[3], u0[3]));
                w.y = pk8(silu_mul(g1[0], u1[0]), silu_mul(g1[1], u1[1]), silu_mul(g1[2], u1[2]), silu_mul(g1[3], u1[3]));
                *(u32x2*)rowp = w; }
    }
};
struct EpiInProj {
    static constexpr bool PERM = true, AFTER_DRAIN = false;
    h16 *Q, *KV, *IQ, *IK; float* IW; const float* rope; float scale; const float* rs;
    __device__ __forceinline__ void operator()(const f32x4 (&acc)[2][2][4][2], const Unit& u, int wr, int wc, int fr_, int fq_) const {
        int l = (int)(threadIdx.x & 63u); asm volatile("" : "+v"(l));
        const int fr = l & 15, fq = l >> 4;
        const int pn = u.pn, row0 = u.pm * BM + wr * 64 + fr;
        h16* base; int ldc, colt; bool rot0 = true, rot1 = true;
        if (pn < 8) { base = Q; ldc = 2048; colt = pn * 256; }
        else if (pn < 10) { base = KV; ldc = 1024; colt = (pn - 8) * 256; }
        else if (pn < 12) { base = KV; ldc = 1024; colt = 512 + (pn - 10) * 256; rot0 = false; rot1 = false; }
        else if (pn < 20) { base = IQ; ldc = 2048; colt = (pn - 12) * 256; }
        else { base = IK; ldc = 128; colt = 0; rot1 = false; }
        const int col0 = colt + wc * 32 + 8 * fq;
#pragma unroll
        for (int ai = 0; ai < 2; ++ai)
#pragma unroll
            for (int m = 0; m < 4; ++m) { const int row = row0 + ai * HALF + m * 16;
                f32x4 cs[2], sn[2];
                if (wc == 0) { const float* rp = rope + (size_t)row * 32 + 8 * (fq & 1);
                    cs[0] = *(const f32x4*)(rp); cs[1] = *(const f32x4*)(rp + 4); sn[0] = *(const f32x4*)(rp + 16); sn[1] = *(const f32x4*)(rp + 20);
                    if (fq < 2) { sn[0] = -sn[0]; sn[1] = -sn[1]; } }
#pragma unroll
                for (int bj = 0; bj < 2; ++bj) {
                    const float sc_ = scale * rs[row];
                    f32x4 v0 = acc[ai][bj][m][0] * sc_, v1 = acc[ai][bj][m][1] * sc_;
                    if (wc == 0 && (bj == 0 ? rot0 : rot1)) {
                        f32x4 p0, p1;
#pragma unroll
                        for (int e = 0; e < 4; ++e) { p0[e] = __shfl_xor(v0[e], 32); p1[e] = __shfl_xor(v1[e], 32); }
                        v0 = v0 * cs[0] + p0 * sn[0]; v1 = v1 * cs[1] + p1 * sn[1];
                    }
                    if (pn >= 8 && pn < 12) {
                        const int j = ((pn - 8) & 1) * 2 + bj, b = row / SEQ, tt = row % SEQ;
                        unsigned char* dst = (unsigned char*)KV + (pn >= 10 ? (size_t)16 * 1024 * 1024 : (size_t)0) + ((size_t)(b * NKV + j) * SEQ + tt) * HD + wc * 32 + 8 * fq;
                        u32x2 w; w.x = pk8(v0[0], v0[1], v0[2], v0[3]); w.y = pk8(v1[0], v1[1], v1[2], v1[3]); *(u32x2*)dst = w;
                    } else if (pn == 20 && bj == 1) {
                        if (wc == 0 && fq < 2) { float* wp = IW + (size_t)row * 16 + 8 * fq; *(f32x4*)wp = v0; *(f32x4*)(wp + 4) = v1; }
                    } else {
                        u32x4 w; w.x = pkh(v0[0], v0[1]); w.y = pkh(v0[2], v0[3]); w.z = pkh(v1[0], v1[1]); w.w = pkh(v1[2], v1[3]);
                        *(u32x4*)(base + (size_t)row * ldc + col0 + bj * HALF) = w;
                    }
                }
                asm volatile("" ::: "memory"); }
    }
};

template <class Epi, class Sched, bool ALIGN_EPI = false, bool SP2 = false, bool FP8 = false>
__device__ __forceinline__ void gemm_phase(PG8_LAS unsigned char* lds, const Gemm g, const Sched& S, const Epi& E) {
    int tid_ = (int)threadIdx.x; asm volatile("" : "+v"(tid_));
    const int tid = tid_, wid = __builtin_amdgcn_readfirstlane(tid >> 6), lane = tid & 63, wr = wid >> 2, wc = wid & 3, fr = lane & 15, fq = lane >> 4;
    const int K = g.K, nt = K / BK;
    unsigned voffA[2], voffB[2];
#pragma unroll
    for (int i = 0; i < 2; ++i) { int R, C; stage_rc(tid * 16 + i * 8192, R, C); const int Rb = Epi::PERM ? ((R & ~31) + perm32(R & 31)) : R;
        voffA[i] = (unsigned)(R * g.lda + C) * 2u; voffB[i] = (unsigned)(Rb * K + C) * 2u; }
    const size_t kstep = (size_t)(BK * 2);
    const size_t hstepA = (size_t)HALF * g.lda * 2, hstepB = (size_t)HALF * K * 2;
    const size_t tstepA = 2 * hstepA, tstepB = 2 * hstepB;
    const int kshift = g.kshift;
    const __amdgpu_buffer_rsrc_t rsrcA = __builtin_amdgcn_make_buffer_rsrc((void*)g.A, 0, 0x7fffffff, 0x00020000), rsrcB = __builtin_amdgcn_make_buffer_rsrc((void*)g.Bt, 0, 0x7fffffff, 0x00020000);
    const unsigned r64A = 64u * (unsigned)g.lda * 2u, r64B = 64u * (unsigned)K * 2u;
    const unsigned ldsw = (unsigned)wid * 1024u;
    const int aoff = lds_byte(wr * 64 + fr, fq * 8), boff = lds_byte(wc * 32 + fr, fq * 8);
#define PG8_SA(b, h) (((b) * 2 + (h)) * HTB)
#define PG8_SB(b, h) ((4 + (b) * 2 + (h)) * HTB)
#define PG8_STAGE(bufoff, gbase, voff) do { const bool isA_ = (const void*)(voff) == (const void*)voffA; _Pragma("unroll") for (int _i = 0; _i < 2; ++_i) \
        __builtin_amdgcn_raw_ptr_buffer_load_lds(isA_ ? rsrcA : rsrcB, (PG8_LAS void*)(lds + (bufoff) + ldsw + _i * 8192), 16, (int)(voff)[0], \
            (int)((unsigned)((const char*)(gbase) - (isA_ ? (const char*)g.A : (const char*)g.Bt)) + (unsigned)_i * (isA_ ? r64A : r64B)), 0, 0); } while (0)
#define PG8_LDA(dst, b, h) do { if constexpr (FP8) { _Pragma("unroll") for (int m = 0; m < 4; ++m) dst##8[m] = __builtin_shufflevector(*(const PG8_LAS v4i32*)(lds + PG8_SA(b, h) + aoff + m * 2048), *(const PG8_LAS v4i32*)(lds + PG8_SA(b, h) + aoff + m * 2048 + 1024), 0, 1, 2, 3, 4, 5, 6, 7); } \
    else { _Pragma("unroll") for (int m = 0; m < 4; ++m) _Pragma("unroll") for (int k = 0; k < 2; ++k) dst[m][k] = *(const PG8_LAS half8*)(lds + PG8_SA(b, h) + aoff + m * 2048 + k * 1024); } } while (0)
#define PG8_LDB(dst, b, h) do { if constexpr (FP8) { _Pragma("unroll") for (int n = 0; n < 2; ++n) dst##8[n] = __builtin_shufflevector(*(const PG8_LAS v4i32*)(lds + PG8_SB(b, h) + boff + n * 2048), *(const PG8_LAS v4i32*)(lds + PG8_SB(b, h) + boff + n * 2048 + 1024), 0, 1, 2, 3, 4, 5, 6, 7); } \
    else { _Pragma("unroll") for (int n = 0; n < 2; ++n) _Pragma("unroll") for (int k = 0; k < 2; ++k) dst[n][k] = *(const PG8_LAS half8*)(lds + PG8_SB(b, h) + boff + n * 2048 + k * 1024); } } while (0)
#define PG8_MMA(ai, bj, At, Bt) do { __builtin_amdgcn_s_setprio(1); _Pragma("unroll") for (int m = 0; m < 4; ++m) _Pragma("unroll") for (int n = 0; n < 2; ++n) { \
        if constexpr (FP8) asm volatile("v_mfma_f32_16x16x128_f8f6f4 %0, %1, %2, %0" : "+v"(acc[ai][bj][m][n]) : "v"(Bt##8[n]), "v"(At##8[m]));     \
        else { _Pragma("unroll") for (int k = 0; k < 2; ++k) acc[ai][bj][m][n] = __builtin_amdgcn_mfma_f32_16x16x32_f16(Bt[n][k], At[m][k], acc[ai][bj][m][n], 0, 0, 0); } } \
        __builtin_amdgcn_s_setprio(0); } while (0)
#define PG8_WAIT_V(n) asm volatile("s_waitcnt vmcnt(" #n ")" ::: "memory")
#define PG8_WAIT_L(n) asm volatile("s_waitcnt lgkmcnt(" #n ")" ::: "memory")
#define PG8_BAR __builtin_amdgcn_s_barrier()
#define PG8_SCHED __builtin_amdgcn_sched_barrier(0)
    Unit cur, nxt; int ui = 0;
    if (!S.next(0, cur)) return;
    f32x4 acc[2][2][4][2];
#pragma unroll
    for (int a = 0; a < 2; ++a)
#pragma unroll
        for (int b = 0; b < 2; ++b)
#pragma unroll
            for (int m = 0; m < 4; ++m)
#pragma unroll
                for (int n = 0; n < 2; ++n) acc[a][b][m][n] = (f32x4){0.f, 0.f, 0.f, 0.f};
    half8 At[4][2], B0[2][2], B1[2][2]; v8i32 At8[4], B08[2], B18[2];
    const char* cA = (const char*)g.A + (size_t)cur.pm * tstepA + (size_t)((cur.pn >> kshift) * K) * 2; const char* cB = (const char*)g.Bt + (size_t)cur.pn * tstepB;
    S.a_ready(cur);
    if constexpr (SP2) {
        PG8_STAGE(PG8_SB(0, 0), cB, voffB); PG8_STAGE(PG8_SB(0, 1), cB + hstepB, voffB); PG8_STAGE(PG8_SA(0, 0), cA, voffA); PG8_STAGE(PG8_SA(0, 1), cA + hstepA, voffA);
        if (wr == 1) PG8_BAR;
        PG8_WAIT_V(2); PG8_BAR;
        PG8_STAGE(PG8_SB(1, 0), cB + kstep, voffB); PG8_STAGE(PG8_SA(1, 0), cA + kstep, voffA); PG8_STAGE(PG8_SB(1, 1), cB + hstepB + kstep, voffB);
        PG8_WAIT_V(6); PG8_BAR;
    } else {
        PG8_STAGE(PG8_SB(0, 0), cB, voffB); PG8_STAGE(PG8_SA(0, 0), cA, voffA); PG8_STAGE(PG8_SB(0, 1), cB + hstepB, voffB); PG8_STAGE(PG8_SA(0, 1), cA + hstepA, voffA);
        if (wr == 1) PG8_BAR;
        PG8_WAIT_V(4); PG8_BAR;
        PG8_STAGE(PG8_SB(1, 0), cB + kstep, voffB); PG8_STAGE(PG8_SA(1, 0), cA + kstep, voffA); PG8_STAGE(PG8_SB(1, 1), cB + hstepB + kstep, voffB);
        PG8_WAIT_V(6); PG8_BAR;
    }
    for (;;) {
        const bool has_next = S.next(ui + 1, nxt);
        const char* nA = has_next ? (const char*)g.A + (size_t)nxt.pm * tstepA + (size_t)((nxt.pn >> kshift) * K) * 2 : cA; const char* nB = has_next ? (const char*)g.Bt + (size_t)nxt.pn * tstepB : cB;
        for (int t = 0; t < nt; t += 2) {
            const bool last = (t == nt - 2);
            const char* a1 = cA + (size_t)(t + 1) * kstep;
            const char* a2 = last ? nA : cA + (size_t)(t + 2) * kstep; const char* b2 = last ? nB : cB + (size_t)(t + 2) * kstep;
            const char* a3 = a2 + kstep; const char* b3 = b2 + kstep;
            if (last && has_next) S.a_ready(nxt);
            if constexpr (SP2) {
            PG8_LDB(B0, 0, 0); PG8_LDB(B1, 0, 1); PG8_SCHED; PG8_LDA(At, 0, 0); PG8_STAGE(PG8_SA(1, 1), a1 + hstepA, voffA);
            PG8_WAIT_V(8); PG8_WAIT_L(0); PG8_BAR; PG8_MMA(0, 0, At, B0); PG8_MMA(0, 1, At, B1); PG8_BAR; PG8_SCHED;
            PG8_LDA(At, 0, 1); PG8_STAGE(PG8_SB(0, 0), b2, voffB); PG8_STAGE(PG8_SB(0, 1), b2 + hstepB, voffB); PG8_STAGE(PG8_SA(0, 0), a2, voffA);
            PG8_WAIT_V(8); PG8_WAIT_L(0); PG8_BAR; PG8_MMA(1, 0, At, B0); PG8_MMA(1, 1, At, B1); PG8_BAR; PG8_SCHED;
            PG8_LDB(B0, 1, 0); PG8_LDB(B1, 1, 1); PG8_SCHED; PG8_LDA(At, 1, 0); PG8_STAGE(PG8_SA(0, 1), a2 + hstepA, voffA);
            PG8_WAIT_V(8); PG8_WAIT_L(0); PG8_BAR; PG8_MMA(0, 0, At, B0); PG8_MMA(0, 1, At, B1); PG8_BAR; PG8_SCHED;
            PG8_LDA(At, 1, 1); PG8_STAGE(PG8_SB(1, 0), b3, voffB); PG8_STAGE(PG8_SB(1, 1), b3 + hstepB, voffB); PG8_STAGE(PG8_SA(1, 0), a3, voffA);
            PG8_WAIT_V(8); PG8_WAIT_L(0); PG8_BAR; PG8_MMA(1, 0, At, B0); PG8_MMA(1, 1, At, B1); PG8_BAR; PG8_SCHED;
            } else {
            PG8_LDB(B0, 0, 0); PG8_SCHED; PG8_LDA(At, 0, 0); PG8_STAGE(PG8_SA(1, 1), a1 + hstepA, voffA);
            PG8_WAIT_L(8); PG8_BAR; PG8_WAIT_L(0); PG8_MMA(0, 0, At, B0); PG8_BAR; PG8_SCHED;
            PG8_LDB(B1, 0, 1); PG8_STAGE(PG8_SB(0, 0), b2, voffB);
            PG8_BAR; PG8_WAIT_L(0); PG8_MMA(0, 1, At, B1); PG8_BAR;
            PG8_LDA(At, 0, 1); PG8_STAGE(PG8_SA(0, 0), a2, voffA);
            PG8_BAR; PG8_WAIT_L(0); PG8_MMA(1, 0, At, B0); PG8_BAR; PG8_SCHED;
            PG8_STAGE(PG8_SB(0, 1), b2 + hstepB, voffB);
            PG8_WAIT_V(6); PG8_BAR; PG8_MMA(1, 1, At, B1); PG8_BAR;
            PG8_LDB(B0, 1, 0); PG8_SCHED; PG8_LDA(At, 1, 0); PG8_STAGE(PG8_SA(0, 1), a2 + hstepA, voffA);
            PG8_WAIT_L(8); PG8_BAR; PG8_WAIT_L(0); PG8_MMA(0, 0, At, B0); PG8_BAR; PG8_SCHED;
            PG8_LDB(B1, 1, 1); PG8_STAGE(PG8_SB(1, 0), b3, voffB);
            PG8_BAR; PG8_WAIT_L(0); PG8_MMA(0, 1, At, B1); PG8_BAR;
            PG8_LDA(At, 1, 1); PG8_STAGE(PG8_SA(1, 0), a3, voffA);
            PG8_BAR; PG8_WAIT_L(0); PG8_MMA(1, 0, At, B0); PG8_BAR; PG8_SCHED;
            PG8_STAGE(PG8_SB(1, 1), b3 + hstepB, voffB);
            PG8_WAIT_V(6); PG8_BAR; PG8_MMA(1, 1, At, B1); PG8_BAR;
            }
        }
        if constexpr (FP8) { asm volatile("s_nop 15\n\ts_nop 15\n\ts_nop 15\n\ts_nop 15" ::: "memory"); __builtin_amdgcn_sched_barrier(0); }
        if constexpr (ALIGN_EPI) { if (wr == 0) PG8_BAR; }
        if constexpr (!Epi::AFTER_DRAIN) { E(acc, cur, wr, wc, fr, fq); S.done(cur); }
        if (!has_next) break;
#pragma unroll
        for (int a = 0; a < 2; ++a)
#pragma unroll
            for (int b = 0; b < 2; ++b)
#pragma unroll
                for (int m = 0; m < 4; ++m)
#pragma unroll
                    for (int n = 0; n < 2; ++n) acc[a][b][m][n] = (f32x4){0.f, 0.f, 0.f, 0.f};
        cur = nxt; cA = nA; cB = nB; ++ui;
        if constexpr (ALIGN_EPI) { if (wr == 1) PG8_BAR; }
    }
    PG8_WAIT_V(0);
    if constexpr (!ALIGN_EPI) { if (wr == 0) PG8_BAR; }
    PG8_BAR;

#undef PG8_SA
#undef PG8_SB
#undef PG8_STAGE
#undef PG8_LDA
#undef PG8_LDB
#undef PG8_MMA
#undef PG8_WAIT_V
#undef PG8_WAIT_L
#undef PG8_BAR
#undef PG8_SCHED
}
}

constexpr int NB = 2, T = NB * SEQ, D = 2048, DFF = 5632, NMEM = 256;
constexpr int DSA_N = 5264, DSA_NP = 5376;
constexpr int NHEAD = 16, TOPK = 256;
constexpr int XW = 512;
constexpr float NORM_EPS = 1e-6f;
constexpr int NWAVES = 8;
#ifndef FFN_FP8
#define FFN_FP8 2
#endif
#ifndef DN_FP8
#define DN_FP8 3
#endif
#ifndef IDX_PROBE_MMA
#define IDX_PROBE_MMA 0
#endif
#ifndef IDX16
#define IDX16 2
#endif
#ifndef MK_LAUNCH_PER_PHASE
#define MK_LAUNCH_PER_PHASE 0
#endif

constexpr size_t MiB = 1u << 20;
constexpr size_t WS_CTL = 0, CTL_ZERO_BYTES = 1 * MiB;
constexpr size_t WS_ROPE = 1 * MiB;
constexpr size_t WS_MEMN = 5 * MiB;
constexpr size_t WS_KVM = 7 * MiB;
constexpr size_t WS_WPOOL = 9 * MiB;
constexpr size_t WS_WIN = 11 * MiB;
constexpr size_t WS_WOUT = 32 * MiB;
constexpr size_t WS_WQ = 40 * MiB;
constexpr size_t WS_WKV = 44 * MiB;
constexpr size_t WS_WO = 52 * MiB;
constexpr size_t WS_WGU = 56 * MiB;
constexpr size_t WS_WDN = 144 * MiB;
constexpr size_t WS_XQ = 188 * MiB;
constexpr size_t WS_A = 220 * MiB;
constexpr size_t WS_Y = 348 * MiB;
constexpr size_t WS_ACT = 604 * MiB;
constexpr size_t WS_END = 956 * MiB;
constexpr size_t WS_Q = WS_ACT, WS_KV = WS_ACT + 128 * MiB, WS_IQ = WS_ACT + 192 * MiB, WS_IK = WS_ACT + 320 * MiB, WS_IW = WS_ACT + 328 * MiB, WS_IDX = WS_ACT + 330 * MiB;
constexpr size_t WS_LISTS = WS_Y;
constexpr size_t WS_H = WS_Y + 128 * MiB;
constexpr int LIST_CAP = 1024;
static_assert(WS_IDX + (size_t)T * TOPK * 2 <= WS_END, "ws map");
constexpr float W8_SCALE = 64.0f, ACT8_SCALE = 8.0f;
constexpr int CW_BAR = 4096;

constexpr int RING_OFF = 0, RING_BYTES = 159744;
constexpr int MISC_OFF = RING_BYTES;
constexpr int LDS_BYTES = 163840;

typedef GAS unsigned gu32;
#define LDS_WAIT() asm volatile("s_waitcnt lgkmcnt(0)" ::: "memory")
#define VM_WAIT() asm volatile("s_waitcnt vmcnt(0)" ::: "memory")

#define XB_TMO      128
#define XB_XCNT(j)  (256  + 64 * (j))
#define XB_XSUB(j)  (1280 + 64 * (j))
#define XB_XGEN(j)  (2304 + 64 * (j))
#define XB_TOP      3328
#define XB_TOPGEN   3392
#define XCD_BAR_WORDS 3456
#define XB_SPIN_CAP (1u << 23)
__device__ __forceinline__ unsigned xb_ld(unsigned* p)              { return __hip_atomic_load(p, __ATOMIC_RELAXED, __HIP_MEMORY_SCOPE_AGENT); }
__device__ __forceinline__ unsigned xb_add(unsigned* p, unsigned v) { return __hip_atomic_fetch_add(p, v, __ATOMIC_RELAXED, __HIP_MEMORY_SCOPE_AGENT); }
__device__ __forceinline__ unsigned xb_xcc_id() { return (unsigned)__builtin_amdgcn_s_getreg((3 << 11) | 20) & 0xFu; }
#define XB_SPIN(cond, bar) do { unsigned _sp = 0; while (cond) { __builtin_amdgcn_s_sleep(1); \
    if ((++_sp & 255u) == 0u) { if (xb_ld(&(bar)[XB_TMO])) break; if (_sp > XB_SPIN_CAP) { atomicAdd(&(bar)[XB_TMO], 1u); break; } } } } while (0)
struct XcdBarrier { unsigned* bar; unsigned x; volatile LAS unsigned* st; };
__device__ __forceinline__ XcdBarrier xcd_barrier_post(unsigned* bar, volatile LAS unsigned* st) {
    XcdBarrier b; b.bar = bar; b.x = xb_xcc_id(); b.st = st;
    if (threadIdx.x == 0) (void)xb_add(&bar[XB_XCNT(b.x)], 1u);
    return b;
}
__device__ __forceinline__ void xcd_barrier_complete(unsigned* bar, unsigned x, unsigned& nloc, unsigned& nx) {
    const unsigned G = gridDim.x * gridDim.y * gridDim.z;
    unsigned sum, cnt, mine, sp = 0u;
    for (;;) {
        sum = 0u; cnt = 0u; mine = 0u;
#pragma unroll
        for (unsigned j = 0; j < 16; ++j) { const unsigned c = xb_ld(&bar[XB_XCNT(j)]); sum += c; cnt += (c > 0u) ? 1u : 0u; mine = (j == x) ? c : mine; }
        if (sum == G) break;
        __builtin_amdgcn_s_sleep(1);
        if ((++sp & 255u) == 0u) { if (xb_ld(&bar[XB_TMO])) break; if (sp > XB_SPIN_CAP) { atomicAdd(&bar[XB_TMO], 1u); break; } }
    }
    nloc = mine > 0u ? mine : 1u; nx = cnt > 0u ? cnt : 1u;
}
__device__ __forceinline__ void xcd_barrier(const XcdBarrier& b) {
    asm volatile("s_waitcnt vmcnt(0)" ::: "memory");
    __syncthreads();
    if (threadIdx.x == 0) {
        unsigned* bar = b.bar;
        __builtin_amdgcn_s_waitcnt(0);
        unsigned nloc = b.st[0], nx = b.st[1];
        if (nloc == 0u) { xcd_barrier_complete(bar, b.x, nloc, nx); b.st[0] = nloc; b.st[1] = nx; }
        const unsigned old = xb_add(&bar[XB_XSUB(b.x)], 1u);
        const unsigned gen = old / nloc;
        if (old + 1u == (gen + 1u) * nloc) {
            __builtin_amdgcn_fence(__ATOMIC_RELEASE, "agent");
            asm volatile("s_waitcnt vmcnt(0)" ::: "memory");
            const unsigned og = xb_add(&bar[XB_TOP], 1u);
            const unsigned tg = og / nx;
            if (og + 1u == (tg + 1u) * nx) xb_add(&bar[XB_TOPGEN], 1u);
            else XB_SPIN(xb_ld(&bar[XB_TOPGEN]) == tg, bar);
            __builtin_amdgcn_fence(__ATOMIC_ACQUIRE, "agent");
            xb_add(&bar[XB_XGEN(b.x)], 1u);
            asm volatile("s_waitcnt vmcnt(0)" ::: "memory");
        } else {
            XB_SPIN(xb_ld(&bar[XB_XGEN(b.x)]) == gen, bar);
            __builtin_amdgcn_fence(__ATOMIC_ACQUIRE, "agent");
            asm volatile("s_waitcnt vmcnt(0)" ::: "memory");
        }
    }
    __syncthreads();
}

struct Frame {
    LAS unsigned char* lds;
    volatile LAS unsigned* MISC;
    int tid, lane, wave;
    int vcu, G;
};
__device__ __forceinline__ Frame fresh(const Frame& F0) { Frame F = F0; int t = (int)threadIdx.x; asm volatile("" : "+v"(t)); F.tid = t; F.lane = t & 63; F.wave = __builtin_amdgcn_readfirstlane(t >> 6); return F; }
template <int CTRL> __device__ __forceinline__ float dpp_mov(float v) { return __builtin_bit_cast(float, __builtin_amdgcn_update_dpp(0, __builtin_bit_cast(int, v), CTRL, 0xF, 0xF, true)); }
__device__ __forceinline__ float wave_sum_dpp(float v) {
    v += dpp_mov<0xB1>(v);
    v += dpp_mov<0x4E>(v);
    v += dpp_mov<0x141>(v);
    v += dpp_mov<0x140>(v);
    const float s0 = __builtin_bit_cast(float, __builtin_amdgcn_readlane(__builtin_bit_cast(int, v), 0)), s1 = __builtin_bit_cast(float, __builtin_amdgcn_readlane(__builtin_bit_cast(int, v), 16));
    const float s2 = __builtin_bit_cast(float, __builtin_amdgcn_readlane(__builtin_bit_cast(int, v), 32)), s3 = __builtin_bit_cast(float, __builtin_amdgcn_readlane(__builtin_bit_cast(int, v), 48));
    return (s0 + s1) + (s2 + s3);
}
__device__ __forceinline__ float wave_max_dpp(float v) {
    v = fmaxf(v, dpp_mov<0xB1>(v)); v = fmaxf(v, dpp_mov<0x4E>(v)); v = fmaxf(v, dpp_mov<0x141>(v)); v = fmaxf(v, dpp_mov<0x140>(v));
    const float s0 = __builtin_bit_cast(float, __builtin_amdgcn_readlane(__builtin_bit_cast(int, v), 0)), s1 = __builtin_bit_cast(float, __builtin_amdgcn_readlane(__builtin_bit_cast(int, v), 16));
    const float s2 = __builtin_bit_cast(float, __builtin_amdgcn_readlane(__builtin_bit_cast(int, v), 32)), s3 = __builtin_bit_cast(float, __builtin_amdgcn_readlane(__builtin_bit_cast(int, v), 48));
    return fmaxf(fmaxf(s0, s1), fmaxf(s2, s3));
}
__device__ __forceinline__ float wave_sum(float v) {
#pragma unroll
    for (int o = 1; o < 64; o <<= 1) v += __shfl_xor(v, o);
    return v;
}
__device__ __forceinline__ float rstd_of(float sumsq) { return 1.0f / sqrtf(sumsq * (1.0f / D) + NORM_EPS); }

__device__ __forceinline__ void transpose_item(const float* W, int ldw, int K, int k0, int scol, int nvalid, h16* WT, int drow, float scale, const float* colscale, const float* kscale, bool f8, LAS float* scr, int lane) {
    const int cn = scol + (lane & 31); const bool okc = cn < nvalid;
    float wv[32];
#pragma unroll
    for (int i = 0; i < 32; ++i) { const int kk = 2 * i + (lane >> 5); wv[i] = W[(size_t)(k0 + kk) * ldw + (okc ? cn : 0)]; }
#pragma unroll
    for (int i = 0; i < 32; ++i) { const int kk = 2 * i + (lane >> 5); scr[kk * 33 + (lane & 31)] = okc ? (kscale ? wv[i] * kscale[k0 + kk] : wv[i]) : 0.f; }
    LDS_WAIT(); asm volatile("" ::: "memory");
    const int c = lane & 7;
#pragma unroll
    for (int j = 0; j < 4; ++j) { const int n = (lane >> 3) + 8 * j; const LAS float* s = scr + (8 * c) * 33 + n;
        float sc = scale; if (colscale) sc *= colscale[scol + n];
        if (f8) { u32x2 o; o.x = pk8(s[0 * 33] * sc, s[1 * 33] * sc, s[2 * 33] * sc, s[3 * 33] * sc); o.y = pk8(s[4 * 33] * sc, s[5 * 33] * sc, s[6 * 33] * sc, s[7 * 33] * sc);
            *(GAS u32x2*)((unsigned char*)WT + (size_t)(drow + n) * K + k0 + 8 * c) = o; }
        else { u32x4 o; o.x = pkh(s[0 * 33] * sc, s[1 * 33] * sc); o.y = pkh(s[2 * 33] * sc, s[3 * 33] * sc); o.z = pkh(s[4 * 33] * sc, s[5 * 33] * sc); o.w = pkh(s[6 * 33] * sc, s[7 * 33] * sc);
            *(GAS u32x4*)(WT + (size_t)(drow + n) * K + k0 + 8 * c) = o; } }
    LDS_WAIT(); asm volatile("" ::: "memory");
}
struct TJob { const float* W; h16* WT; const float* colscale; int ldw, K, nrows, nvalid, mode; float scale; const float* kscale; };
__device__ __forceinline__ int tjob_items(const TJob& j) { return (j.K / 64) * (j.nrows / 32); }
__device__ __forceinline__ void tjob_run(const TJob& j, int item, LAS float* scr, int lane) {
    const int nblk = j.nrows / 32, kb = item / nblk, r = 32 * (item % nblk);
    const int scol = (j.mode & 1) ? ((r >> 7) & 1) * DFF + 128 * (r >> 8) + (r & 127) : r;
    transpose_item(j.W, j.ldw, j.K, 64 * kb, scol, j.nvalid, j.WT, r, j.scale, j.colscale, j.kscale, (j.mode & 2) != 0, scr, lane);
}

struct Args {
    const float* x; const float* mem; const int* pos; const float* gains; const float* mem_norm; const float* pool_w; const float* pool_scale;
    const float* w_in; const float* w_out; const float* wq; const float* wkv; const float* wo; const float* wgu; const float* wdn;
    float* out; unsigned char* ws;
    float inv_freq[16];
    int ph_lo, ph_hi, li, pad;
};

#define CAS __attribute__((address_space(4)))
typedef const CAS Args* ArgP;
__device__ __forceinline__ ArgP argp() { unsigned long long p = (unsigned long long)__builtin_amdgcn_kernarg_segment_ptr(); asm volatile("" : "+s"(p)); return (ArgP)p; }

__device__ __forceinline__ void rope_entry(ArgP a, float* rope, int idx) {
    const int m = idx >> 4, i = idx & 15;
    const float angf = (float)a->pos[m] * a->inv_freq[i];
    const double ang = (double)angf;
    const double TWO_PI = 6.283185307179586476925286766559, INV_2PI = 0.15915494309189533576888376337251;
    const double k = __builtin_rint(ang * INV_2PI);
    const double r = ang - k * TWO_PI;
    const double r2 = r * r;
    double c = 1.0, s = 1.0, tc = 1.0, ts = 1.0;
#pragma unroll
    for (int n = 1; n <= 13; ++n) { tc *= -r2 / (double)((2 * n - 1) * (2 * n)); ts *= -r2 / (double)((2 * n) * (2 * n + 1)); c += tc; s += ts; }
    rope[(size_t)m * 32 + i] = (float)c; rope[(size_t)m * 32 + 16 + i] = (float)(s * r);
}
__device__ __forceinline__ void norm_row_to_h16(const float* xrow, const float* gain, h16* orow, int lane) {
    const f32x4* xr = (const f32x4*)xrow + lane; const f32x4* gr = (const f32x4*)gain + lane;
    f32x4 v[8]; float s = 0.f;
#pragma unroll
    for (int j = 0; j < 8; ++j) { v[j] = xr[64 * j]; s += (v[j].x * v[j].x + v[j].y * v[j].y) + (v[j].z * v[j].z + v[j].w * v[j].w); }
    const float r = rstd_of(wave_sum_dpp(s));
    u32x2* o8 = (u32x2*)orow + lane;
#pragma unroll
    for (int j = 0; j < 8; ++j) { const f32x4 g = gr[64 * j], y = v[j] * r * g; u32x2 w; w.x = pkh(y.x, y.y); w.y = pkh(y.z, y.w); o8[64 * j] = w; }
}
__device__ __forceinline__ void pool_pre(Frame& F0, const float* x, const float* g0, h16* P) {
    Frame F = fresh(F0);
    LAS float* rs = (LAS float*)(F.lds + RING_OFF);
    for (int u = F.vcu; u < T / 64; u += F.G) {
        const int b = u / (SEQ / 64), t0 = 64 * (u % (SEQ / 64));
        const float* xb = x + (size_t)b * SEQ * D;
        for (int r = F.wave; r < 79; r += NWAVES) { const int t = t0 - 15 + r;
            if (t >= 0) { const f32x4* xr = (const f32x4*)(xb + (size_t)t * D) + F.lane; float s = 0.f;
#pragma unroll
                for (int j = 0; j < 8; ++j) { const f32x4 v = xr[64 * j]; s += (v.x * v.x + v.y * v.y) + (v.z * v.z + v.w * v.w); }
                s = rstd_of(wave_sum_dpp(s)); if (F.lane == 0) rs[r] = s; } }
        __syncthreads();
        {
            const int c0 = 4 * F.tid, w = 2 << (F.tid >> 7);
            const f32x4 g = *(const f32x4*)(g0 + c0);
            const int ts = (t0 - (w - 1)) > 0 ? (t0 - (w - 1)) : 0;
            f32x4 sum = {0.f, 0.f, 0.f, 0.f};
#pragma unroll 8
            for (int t = ts; t < t0 + 64; ++t) {
                const f32x4 a = *(const f32x4*)(xb + (size_t)t * D + c0) * rs[t - t0 + 15] * g;
                sum += a;
                if (t - w >= ts) sum -= *(const f32x4*)(xb + (size_t)(t - w) * D + c0) * rs[t - w - t0 + 15] * g;
                if (t >= t0) { const float ic = 1.0f / (float)((t + 1) < w ? (t + 1) : w); const f32x4 p = sum * ic - a;
                    u32x2 o; o.x = pkh(p.x, p.y); o.y = pkh(p.z, p.w); *(u32x2*)(P + ((size_t)b * SEQ + t) * D + c0) = o; }
            }
        }
        __syncthreads();
    }
}
__device__ __forceinline__ void p0_prologue(Frame& F0, ArgP a) {
    Frame F = fresh(F0);
    unsigned char* ws = a->ws;
    LAS float* scr = (LAS float*)(F.lds + RING_OFF + F.wave * 16384);
    const int gw = F.vcu * NWAVES + F.wave, NGW = F.G * NWAVES;
    constexpr int I_POOL = (512 / 64) * (512 / 32), I_IN = (2048 / 64) * (DSA_NP / 32), I_OUT = (2048 / 64) * (2048 / 32), I_Q = (2048 / 64) * (512 / 32), I_KV = (2048 / 64) * (1024 / 32),
                  I_O = (512 / 64) * (2048 / 32), I_GU = (2048 / 64) * (2 * DFF / 32), I_DN = (DFF / 64) * (2048 / 32);
    constexpr int NITEMS = 4 * I_POOL + I_IN + I_OUT + 2 * (I_Q + I_KV + I_O + I_GU + I_DN);
    for (int it = gw; it < NITEMS; it += NGW) {
        int r = it; TJob j; bool found = false;
#pragma unroll
        for (int g = 0; g < 4; ++g) if (!found) { if (r < I_POOL) { j = TJob{a->pool_w + (size_t)g * 512 * 512, (h16*)(ws + WS_WPOOL) + (size_t)g * 512 * 512, a->pool_scale + g * 512, 512, 512, 512, 512, 0, 1.0f, nullptr}; found = true; } else r -= I_POOL; }
        if (!found) { if (r < I_IN) { j = TJob{a->w_in, (h16*)(ws + WS_WIN), nullptr, DSA_N, 2048, DSA_NP, DSA_N, 0, 64.0f, a->gains + 6 * D  }; found = true; } else r -= I_IN; }
        if (!found) { if (r < I_OUT) { j = TJob{a->w_out, (h16*)(ws + WS_WOUT), nullptr, 2048, 2048, 2048, 2048, 0, 1.0f, nullptr}; found = true; } else r -= I_OUT; }
#pragma unroll
        for (int L = 0; L < 2; ++L) {
            if (!found) { if (r < I_Q) { j = TJob{a->wq + (size_t)L * 2048 * 512, (h16*)(ws + WS_WQ) + (size_t)L * 512 * 2048, nullptr, 512, 2048, 512, 512, 0, 1.0f, a->gains + (size_t)L * 6 * D + 2 * D}; found = true; } else r -= I_Q; }
            if (!found) { if (r < I_KV) { j = TJob{a->wkv + (size_t)L * 2048 * 1024, (h16*)(ws + WS_WKV) + (size_t)L * 1024 * 2048, nullptr, 1024, 2048, 1024, 1024, 0, 1.0f, nullptr}; found = true; } else r -= I_KV; }
            if (!found) { if (r < I_O) { j = TJob{a->wo + (size_t)L * 512 * 2048, (h16*)(ws + WS_WO) + (size_t)L * 2048 * 512, nullptr, 2048, 512, 2048, 2048, 0, 1.0f, nullptr}; found = true; } else r -= I_O; }
            if (!found) { if (r < I_GU) { j = ((FFN_FP8 >> L) & 1) ? TJob{a->wgu + (size_t)L * 2048 * 2 * DFF, (h16*)(ws + WS_WGU) + (size_t)L * 2 * DFF * 2048, nullptr, 2 * DFF, 2048, 2 * DFF, 2 * DFF, 3, W8_SCALE, nullptr} : TJob{a->wgu + (size_t)L * 2048 * 2 * DFF, (h16*)(ws + WS_WGU) + (size_t)L * 2 * DFF * 2048, nullptr, 2 * DFF, 2048, 2 * DFF, 2 * DFF, 1, 1.0f, a->gains + (size_t)L * 6 * D + 4 * D}; found = true; } else r -= I_GU; }
            if (!found) { if (r < I_DN) { j = ((DN_FP8 >> L) & 1) ? TJob{a->wdn + (size_t)L * DFF * 2048, (h16*)(ws + WS_WDN) + (size_t)L * 2048 * DFF, nullptr, 2048, DFF, 2048, 2048, 2, W8_SCALE, nullptr} : TJob{a->wdn + (size_t)L * DFF * 2048, (h16*)(ws + WS_WDN) + (size_t)L * 2048 * DFF, nullptr, 2048, DFF, 2048, 2048, 0, 1.0f, nullptr}; found = true; } else r -= I_DN; }
        }
        if (found) tjob_run(j, r, scr, F.lane);
    }
    for (int i = (gw * 64 + F.lane); i < T * 16; i += NGW * 64) rope_entry(a, (float*)(ws + WS_ROPE), i);
    for (int m = gw; m < NB * NMEM; m += NGW) norm_row_to_h16(a->mem + (size_t)m * D, a->mem_norm, (h16*)(ws + WS_MEMN) + (size_t)m * D, F.lane);
    __syncthreads();
    pool_pre(F, a->x, a->gains  , (h16*)(ws + WS_A));
}

template <bool HAS_NEXT, bool OUT8, bool HIN32, bool HOUT32, bool RSONLY = false>
__device__ __forceinline__ void seam_phase(Frame& F0, const h16* Y, const void* hin, void* hout, const float* gpost, const float* gpre, h16* aout, float* rsout = nullptr) {
    Frame F = fresh(F0);
    const int gw = F.vcu * NWAVES + F.wave, NGW = F.G * NWAVES;
#pragma unroll 4
    for (int m = gw; m < T; m += NGW) {
        const h16* yr = Y + (size_t)m * D + 8 * F.lane;
        float y[4][8]; float s = 0.f;
#pragma unroll
        for (int j = 0; j < 4; ++j) { const half8 v = *(const half8*)(yr + 512 * j);
#pragma unroll
            for (int e = 0; e < 8; ++e) { y[j][e] = (float)v[e]; s += y[j][e] * y[j][e]; } }
        float hp[4][8];
#pragma unroll
        for (int j = 0; j < 4; ++j) {
            if constexpr (HIN32) { const f32x4 a = *(const f32x4*)((const float*)hin + (size_t)m * D + 8 * F.lane + 512 * j), c = *(const f32x4*)((const float*)hin + (size_t)m * D + 8 * F.lane + 512 * j + 4);
                hp[j][0] = a.x; hp[j][1] = a.y; hp[j][2] = a.z; hp[j][3] = a.w; hp[j][4] = c.x; hp[j][5] = c.y; hp[j][6] = c.z; hp[j][7] = c.w; }
            else { const half8 v = *(const half8*)((const h16*)hin + (size_t)m * D + 8 * F.lane + 512 * j);
#pragma unroll
                for (int e = 0; e < 8; ++e) hp[j][e] = (float)v[e]; } }
        const float r = rstd_of(wave_sum_dpp(s)); float s2 = 0.f;
#pragma unroll
        for (int j = 0; j < 4; ++j) { const f32x4 g0 = *(const f32x4*)(gpost + 8 * F.lane + 512 * j), g1 = *(const f32x4*)(gpost + 8 * F.lane + 512 * j + 4);
            const float g[8] = {g0.x, g0.y, g0.z, g0.w, g1.x, g1.y, g1.z, g1.w};
#pragma unroll
            for (int e = 0; e < 8; ++e) { const float h = hp[j][e] + y[j][e] * r * g[e]; y[j][e] = h; s2 += h * h; }
            if constexpr (HOUT32) { float* o = (float*)hout + (size_t)m * D + 8 * F.lane + 512 * j; *(f32x4*)o = (f32x4){y[j][0], y[j][1], y[j][2], y[j][3]}; *(f32x4*)(o + 4) = (f32x4){y[j][4], y[j][5], y[j][6], y[j][7]}; }
            else { u32x4 w; w.x = pkh(y[j][0], y[j][1]); w.y = pkh(y[j][2], y[j][3]); w.z = pkh(y[j][4], y[j][5]); w.w = pkh(y[j][6], y[j][7]); *(u32x4*)((h16*)hout + (size_t)m * D + 8 * F.lane + 512 * j) = w; } }
        if constexpr (HAS_NEXT && RSONLY) { const float r2 = rstd_of(wave_sum_dpp(s2)); if (F.lane == 0) rsout[m] = r2; }
        else if constexpr (HAS_NEXT) {
            const float r2 = rstd_of(wave_sum_dpp(s2));
#pragma unroll
            for (int j = 0; j < 4; ++j) { const f32x4 g0 = *(const f32x4*)(gpre + 8 * F.lane + 512 * j), g1 = *(const f32x4*)(gpre + 8 * F.lane + 512 * j + 4);
                const float g[8] = {g0.x, g0.y, g0.z, g0.w, g1.x, g1.y, g1.z, g1.w}; float v[8];
#pragma unroll
                for (int e = 0; e < 8; ++e) v[e] = y[j][e] * r2 * g[e];
                if constexpr (OUT8) { u32x2 w; w.x = pk8(v[0], v[1], v[2], v[3]); w.y = pk8(v[4], v[5], v[6], v[7]); *(u32x2*)((unsigned char*)aout + (size_t)m * D + 8 * F.lane + 512 * j) = w; }
                else { u32x4 w; w.x = pkh(v[0], v[1]); w.y = pkh(v[2], v[3]); w.z = pkh(v[4], v[5]); w.w = pkh(v[6], v[7]); *(u32x4*)(aout + (size_t)m * D + 8 * F.lane + 512 * j) = w; } }
        }
    }
}

__device__ __forceinline__ void xattn_phase(Frame& F0, h16* XQ, const h16* KVM  ) {
    Frame F = fresh(F0);
    LAS unsigned char* Ks = F.lds + RING_OFF; LAS unsigned char* Vt = F.lds + RING_OFF + 65536;
    const int lane = F.lane, n = lane & 31, hh = lane >> 5;
    for (int u = F.vcu; u < NB * 4 * (SEQ / 512); u += F.G) {
        const int b = u / (4 * (SEQ / 512)), h = (u / (SEQ / 512)) & 3, ch = u % (SEQ / 512);
        const h16* kb = KVM + (size_t)b * NMEM * 2048 + h * HD;
        for (int i = F.tid; i < 256 * 16; i += NWAVES * 64) { const int key = i >> 4, c = i & 15;
            const u32x4 kv = *(const u32x4*)(kb + (size_t)key * 2048 + 8 * c);
            *(LAS u32x4*)(Ks + key * 256 + ((c ^ (key & 15)) << 4)) = kv;
            const half8 vv = *(const half8*)(kb + (size_t)key * 2048 + 512 + 8 * c);
            const int o = key & 15, posk = (key & ~15) | ((o & 3) | ((o & 4) << 1) | ((o & 8) >> 1));
#pragma unroll
            for (int e = 0; e < 8; ++e) { const int d = 8 * c + e; *(LAS h16*)(Vt + d * 512 + (((posk >> 3) ^ (d & 15)) << 4) + (posk & 7) * 2) = vv[e]; }
        }
        __syncthreads();
#pragma unroll 1
        for (int sub = 0; sub < 2; ++sub) {
            const size_t m0 = (size_t)b * SEQ + ch * 512 + sub * 256 + F.wave * 32;
            h16* qrow = XQ + (m0 + n) * XW + h * HD;
            half8 qf[8];
#pragma unroll
            for (int s = 0; s < 8; ++s) qf[s] = *(const half8*)(qrow + 16 * s + 8 * hh);
            f32x16 o[4];
#pragma unroll
            for (int mt = 0; mt < 4; ++mt)
#pragma unroll
                for (int i = 0; i < 16; ++i) o[mt][i] = 0.f;
            const float c2 = 0.08838834764831845f * 1.44269504089f;
            float mrun = -3.0e38f, lrun = 0.f;
#pragma unroll 1
            for (int hf = 0; hf < 2; ++hf) {
                f32x16 acc[4];
#pragma unroll
                for (int kt = 0; kt < 4; ++kt) {
#pragma unroll
                    for (int i = 0; i < 16; ++i) acc[kt][i] = 0.f;
                    const int key = 128 * hf + 32 * kt + n;
#pragma unroll
                    for (int s = 0; s < 8; ++s) { const half8 ka = *(const LAS half8*)(Ks + key * 256 + (((2 * s + hh) ^ (key & 15)) << 4));
                        acc[kt] = __builtin_amdgcn_mfma_f32_32x32x16_f16(ka, qf[s], acc[kt], 0, 0, 0); }
                }
                float mx = mrun;
#pragma unroll
                for (int kt = 0; kt < 4; ++kt)
#pragma unroll
                    for (int i = 0; i < 16; ++i) mx = fmaxf(mx, acc[kt][i]);
                mx = fmaxf(mx, __shfl_xor(mx, 32));
                const float alpha = __builtin_amdgcn_exp2f((mrun - mx) * c2); mrun = mx;
                float sum = 0.f;
#pragma unroll
                for (int kt = 0; kt < 4; ++kt)
#pragma unroll
                    for (int i = 0; i < 16; ++i) { const float p = __builtin_amdgcn_exp2f((acc[kt][i] - mx) * c2); acc[kt][i] = p; sum += p; }
                lrun = lrun * alpha + sum;
#pragma unroll
                for (int mt = 0; mt < 4; ++mt)
#pragma unroll
                    for (int i = 0; i < 16; ++i) o[mt][i] *= alpha;
#pragma unroll
                for (int kt = 0; kt < 4; ++kt)
#pragma unroll
                    for (int s2 = 0; s2 < 2; ++s2) {
                        half8 pb;
#pragma unroll
                        for (int j = 0; j < 8; ++j) pb[j] = (h16)acc[kt][8 * s2 + j];
#pragma unroll
                        for (int mt = 0; mt < 4; ++mt) { const int d = 32 * mt + n;
                            const half8 va = *(const LAS half8*)(Vt + d * 512 + (((2 * (2 * (4 * hf + kt) + s2) + hh) ^ (d & 15)) << 4));
                            o[mt] = __builtin_amdgcn_mfma_f32_32x32x16_f16(va, pb, o[mt], 0, 0, 0); }
                    }
            }
            lrun += __shfl_xor(lrun, 32);
            const float inv = 1.0f / lrun;
#pragma unroll
            for (int mt = 0; mt < 4; ++mt)
#pragma unroll
                for (int jj = 0; jj < 4; ++jj) { u32x2 w; w.x = pkh(o[mt][4 * jj] * inv, o[mt][4 * jj + 1] * inv); w.y = pkh(o[mt][4 * jj + 2] * inv, o[mt][4 * jj + 3] * inv);
                    *(u32x2*)(qrow + 32 * mt + 8 * jj + 4 * hh) = w; }
        }
        __syncthreads();
    }
}

__device__ __forceinline__ unsigned mono_key(unsigned u) { return (u & 0x80000000u) ? ~u : (u | 0x80000000u); }
__device__ __forceinline__ void keymap_clear(LAS unsigned* bm, int lane) { *(LAS u32x4*)(bm + 8 * lane) = (u32x4){0u, 0u, 0u, 0u}; *(LAS u32x4*)(bm + 8 * lane + 4) = (u32x4){0u, 0u, 0u, 0u}; }
__device__ __forceinline__ void keymap_emit(LAS unsigned* bm, unsigned short* out, int nvalid, int lane) {
    const u32x4 w0 = *(const LAS u32x4*)(bm + 8 * lane), w1 = *(const LAS u32x4*)(bm + 8 * lane + 4);
    unsigned w[8] = {w0.x, w0.y, w0.z, w0.w, w1.x, w1.y, w1.z, w1.w};
    int mine = 0;
#pragma unroll
    for (int j = 0; j < 8; ++j) mine += __builtin_popcount(w[j]);
    int incl = mine;
#pragma unroll
    for (int o = 1; o < 64; o <<= 1) { const int v = __shfl_up(incl, o); if (lane >= o) incl += v; }
    int pos = incl - mine;
#pragma unroll
    for (int j = 0; j < 8; ++j) { unsigned x = w[j]; while (x) { const int b = __builtin_ctz(x); out[pos++] = (unsigned short)((8 * lane + j) * 32 + b); x &= x - 1u; } }
    const int total = __shfl(incl, 63);
    for (int i = total + lane; i < TOPK; i += 64) out[i] = (unsigned short)0;
}
constexpr int SEL_N = LIST_CAP / 64;
template <bool FINAL>
__device__ __forceinline__ void select256(u32x2* list, int c, LAS float* th_out, LAS unsigned* cnt_out, LAS unsigned* bm, int lane) {
    unsigned key[SEL_N], id[SEL_N];
#pragma unroll
    for (int k = 0; k < SEL_N; ++k) { const int i = lane + 64 * k; const u32x2 v = list[i]; key[k] = (i < c) ? mono_key(v.x) : 0u; id[k] = v.y; }
    unsigned mx = key[0];
#pragma unroll
    for (int k = 1; k < SEL_N; ++k) mx = key[k] > mx ? key[k] : mx;
#pragma unroll
    for (int o = 1; o < 64; o <<= 1) { const unsigned v = (unsigned)__shfl_xor((int)mx, o); mx = v > mx ? v : mx; }
    unsigned lo = FINAL ? 1u : mono_key(__float_as_uint(*th_out)), hi = mx;
    constexpr int PRUNE_KEEP = 320;
#pragma unroll 1
    while (lo < hi) { const unsigned mid = lo + ((hi - lo + 1u) >> 1); int cc = 0;
#pragma unroll
        for (int k = 0; k < SEL_N; ++k) cc += __builtin_popcountll(__ballot(key[k] >= mid));
        if (cc >= TOPK) { lo = mid; if (cc <= (FINAL ? TOPK : PRUNE_KEEP)) break; } else hi = mid - 1u; }
    const unsigned prefix = lo;
    int ngt = 0, neq = 0;
#pragma unroll
    for (int k = 0; k < SEL_N; ++k) { ngt += __builtin_popcountll(__ballot(key[k] > prefix)); neq += __builtin_popcountll(__ballot(key[k] == prefix)); }
    const int need_eq = FINAL ? (TOPK - ngt) : neq; int base_gt = 0, base_eq = 0;
    const unsigned long long lt = (1ull << lane) - 1ull;
#pragma unroll
    for (int k = 0; k < SEL_N; ++k) {
        const unsigned long long bgt = __ballot(key[k] > prefix), beq = __ballot(key[k] == prefix);
        int pos = -1;
        if (key[k] > prefix) pos = base_gt + __builtin_popcountll(bgt & lt);
        else if (key[k] == prefix) { const int r = base_eq + __builtin_popcountll(beq & lt); if (r < need_eq) pos = ngt + r; }
        if (pos >= 0) { if constexpr (FINAL) __hip_atomic_fetch_or(bm + (id[k] >> 5), 1u << (id[k] & 31u), __ATOMIC_RELAXED, __HIP_MEMORY_SCOPE_WORKGROUP); else { u32x2 v; v.x = (key[k] & 0x80000000u) ? (key[k] & 0x7fffffffu) : ~key[k]; v.y = id[k]; list[pos] = v; } }
        base_gt += __builtin_popcountll(bgt); base_eq += __builtin_popcountll(beq);
        __builtin_amdgcn_sched_barrier(0);
    }
    if constexpr (!FINAL) { if (lane == 0) { const unsigned u = (prefix & 0x80000000u) ? (prefix & 0x7fffffffu) : ~prefix; *th_out = __builtin_bit_cast(float, u); *cnt_out = (unsigned)(ngt + neq); } }
}
__device__ __forceinline__ void indexer_phase(Frame& F0, const h16* IQ, const h16* IK, const float* IW, unsigned short* IDX, u32x2* LISTS) {
    Frame F = fresh(F0);
    LAS unsigned char* bq = F.lds + RING_OFF;
    LAS unsigned* cnt = (LAS unsigned*)(F.lds + RING_OFF + 131072); LAS float* th = (LAS float*)(cnt + 32); LAS unsigned* flag = cnt + 64; LAS unsigned* sgn = cnt + 96;
    u32x2* mylist = LISTS + (size_t)blockIdx.x * 32 * LIST_CAP;
    const int lane = F.lane, n = lane & 31, hh = lane >> 5, w8 = F.wave;
    const float INF = __builtin_inff();
    constexpr int NU = NB * (SEQ / 32);
    for (int rnd = 0; rnd * F.G < NU; ++rnd) {
        int qt, b;
        if (F.G == 256) {
            const int i = (F.vcu & 31) + 32 * (F.vcu >> 6); b = (F.vcu >> 5) & 1;
            qt = rnd == 0 ? 511 - i : rnd == 1 ? i : rnd == 2 ? 256 + i : 255 - i;
        } else { const int kk = rnd * F.G + ((rnd & 1) ? (F.G - 1 - F.vcu) : F.vcu); if (kk >= NU) continue; qt = (SEQ / 32 - 1) - (kk >> 1); b = kk & 1; }
        const int nkt = qt + 1;
        const size_t m0 = (size_t)b * SEQ + 32 * qt;
        if (F.tid < 32) { cnt[F.tid] = 0u; th[F.tid] = -INF; unsigned mk = 0u;
#pragma unroll
            for (int h = 0; h < 16; ++h) mk |= (IW[(m0 + F.tid) * 16 + h] >= 0.f ? 1u : 0u) << h;
            sgn[F.tid] = mk; }
        if (F.tid == 0) *flag = 0u;
        { const int q = F.tid & 31, ch = F.tid >> 5;
#pragma unroll 4
            for (int h = 0; h < 16; ++h) { const float w = IW[(m0 + q) * 16 + h]; const half8 v = *(const half8*)(IQ + (m0 + q) * 2048 + h * HD + 8 * ch); half8 o;
#pragma unroll
                for (int e = 0; e < 8; ++e) o[e] = (h16)((float)v[e] * w);
                *(LAS half8*)(bq + (h * 16 + ch) * 512 + q * 16) = o; } }
        __syncthreads();
        const h16* ikb = IK + (size_t)b * SEQ * HD;
        const unsigned smask = sgn[n];
        float theta = -INF;
        const int qpos = 32 * qt + n;
        u32x2* lp = mylist + (size_t)n * LIST_CAP;
        half8 A[8];
        if (w8 < nkt) { const h16* arow = ikb + (size_t)(32 * w8 + n) * HD + 8 * hh;
#pragma unroll
            for (int c = 0; c < 8; ++c) A[c] = *(const half8*)(arow + 16 * c); }
#pragma unroll 1
        for (int r0 = 0; r0 < nkt; r0 += NWAVES) {
            const int kt = r0 + w8;
            if (kt < nkt) {
                f32x16 S;
#pragma unroll
                for (int i = 0; i < 16; ++i) S[i] = 0.f;
                const LAS unsigned char* bl = bq + hh * 512 + n * 16;
                half8 Ba[4], Bb[4]; f32x16 acc0, acc1;
#define IDX_LOADB(dst, h, c0) do { _Pragma("unroll") for (int c = 0; c < 4; ++c) dst[c] = *(const LAS half8*)(bl + ((h) * 16 + 2 * ((c0) + c)) * 512); } while (0)
#define IDX_MMA4(acc, Bx, c0) do { _Pragma("unroll") for (int c = 0; c < 4; ++c) acc = __builtin_amdgcn_mfma_f32_32x32x16_f16(A[(c0) + c], Bx[c], acc, 0, 0, 0); } while (0)
#define IDX_ZERO(acc) do { _Pragma("unroll") for (int i = 0; i < 16; ++i) acc[i] = 0.f; } while (0)
#define IDX_FOLD8(acc, h, i0) do { const float cc_ = ((smask >> (h)) & 1u) ? INF : -INF; _Pragma("unroll") for (int i = (i0); i < (i0) + 8; ++i) S[i] += __builtin_amdgcn_fmed3f(acc[i], 0.f, cc_); } while (0)
#define IDX_SCHED4() do { __builtin_amdgcn_sched_group_barrier(0x008, 1, 0); __builtin_amdgcn_sched_group_barrier(0x100, 1, 0); _Pragma("unroll") for (int g_ = 0; g_ < 3; ++g_) { __builtin_amdgcn_sched_group_barrier(0x008, 1, 0); __builtin_amdgcn_sched_group_barrier(0x100, 1, 0); __builtin_amdgcn_sched_group_barrier(0x002, 6, 0); } } while (0)
                IDX_LOADB(Ba, 0, 0);
                IDX_ZERO(acc1);
#pragma unroll 1
                for (int h = 0; h < 16; h += 2) {
                    IDX_ZERO(acc0);
                    IDX_MMA4(acc0, Ba, 0); IDX_FOLD8(acc1, (h + 15) & 15, 0); IDX_LOADB(Bb, h, 4); IDX_SCHED4();
                    IDX_MMA4(acc0, Bb, 4); IDX_FOLD8(acc1, (h + 15) & 15, 8); IDX_LOADB(Ba, h + 1, 0); IDX_SCHED4();
                    IDX_ZERO(acc1);
                    IDX_MMA4(acc1, Ba, 0); IDX_FOLD8(acc0, h, 0); IDX_LOADB(Bb, h + 1, 4); IDX_SCHED4();
                    IDX_MMA4(acc1, Bb, 4); IDX_FOLD8(acc0, h, 8); IDX_LOADB(Ba, (h + 2) & 15, 0); IDX_SCHED4();
                }
                IDX_FOLD8(acc1, 15, 0); IDX_FOLD8(acc1, 15, 8);
#if IDX_PROBE_MMA
                {
                    f32x16 S1 = S;
#pragma unroll
                    for (int c = 0; c < 8; ++c) asm volatile("" : "+v"(A[c]));
#pragma unroll
                    for (int i = 0; i < 16; ++i) S[i] = 0.f;
                    IDX_LOADB(Ba, 0, 0);
                    IDX_ZERO(acc1);
#pragma unroll 1
                    for (int h = 0; h < 16; h += 2) {
                        IDX_ZERO(acc0);
                        IDX_MMA4(acc0, Ba, 0); IDX_FOLD8(acc1, (h + 15) & 15, 0); IDX_LOADB(Bb, h, 4); IDX_SCHED4();
                        IDX_MMA4(acc0, Bb, 4); IDX_FOLD8(acc1, (h + 15) & 15, 8); IDX_LOADB(Ba, h + 1, 0); IDX_SCHED4();
                        IDX_ZERO(acc1);
                        IDX_MMA4(acc1, Ba, 0); IDX_FOLD8(acc0, h, 0); IDX_LOADB(Bb, h + 1, 4); IDX_SCHED4();
                        IDX_MMA4(acc1, Bb, 4); IDX_FOLD8(acc0, h, 8); IDX_LOADB(Ba, (h + 2) & 15, 0); IDX_SCHED4();
                    }
                    IDX_FOLD8(acc1, 15, 0); IDX_FOLD8(acc1, 15, 8);
#pragma unroll
                    for (int i = 0; i < 16; ++i) S[i] = (S[i] + S1[i]) * 0.5f;
                }
#endif
#undef IDX_LOADB
#undef IDX_MMA4
#undef IDX_ZERO
#undef IDX_FOLD8
#undef IDX_SCHED4
                if (kt + NWAVES < nkt) { const h16* arow = ikb + (size_t)(32 * (kt + NWAVES) + n) * HD + 8 * hh;
#pragma unroll
                    for (int c = 0; c < 8; ++c) A[c] = *(const half8*)(arow + 16 * c); }
                const int kb0 = 32 * kt + 4 * hh;
                unsigned pm = 0u;
                if (kt < qt) {
#pragma unroll
                    for (int i = 0; i < 16; ++i) pm |= (S[i] > theta) ? (1u << i) : 0u;
                } else {
#pragma unroll
                    for (int i = 0; i < 16; ++i) { const int key = kb0 + (i & 3) + 8 * (i >> 2); pm |= ((key <= qpos) && (S[i] > theta)) ? (1u << i) : 0u; }
                }
                if (pm) { const unsigned np = (unsigned)__builtin_popcount(pm);
                    const unsigned pos = __hip_atomic_fetch_add(cnt + n, np, __ATOMIC_RELAXED, __HIP_MEMORY_SCOPE_WORKGROUP);
#pragma unroll
                    for (int i = 0; i < 16; ++i) if (pm & (1u << i)) { u32x2 e; e.x = __float_as_uint(S[i]);   e.y = (unsigned)(kb0 + (i & 3) + 8 * (i >> 2));
                        { const unsigned at = pos + (unsigned)__builtin_popcount(pm & ((1u << i) - 1u)); lp[at < (unsigned)LIST_CAP ? at : (unsigned)LIST_CAP - 1u] = e; } }
                    if (pos + np > (unsigned)(LIST_CAP - 256)) *(volatile LAS unsigned*)flag = 1u; }
            }
            asm volatile("s_waitcnt lgkmcnt(0)" ::: "memory"); __builtin_amdgcn_s_barrier(); asm volatile("" ::: "memory");
            if (*(volatile LAS unsigned*)flag != 0u) {
                VM_WAIT(); __syncthreads();
                for (int q = w8; q < 32; q += NWAVES) { const int c = __builtin_amdgcn_readfirstlane((int)cnt[q]); if (c > TOPK) select256<false>(mylist + (size_t)q * LIST_CAP, c, th + q, cnt + q, nullptr, lane); }
                if (F.tid == 0) *flag = 0u;
                VM_WAIT(); __syncthreads();
                theta = th[n];
                if (kt + NWAVES < nkt) { const h16* arow = ikb + (size_t)(32 * (kt + NWAVES) + n) * HD + 8 * hh;
#pragma unroll
                    for (int c = 0; c < 8; ++c) A[c] = *(const half8*)(arow + 16 * c); }
            }
        }
        VM_WAIT(); __syncthreads();
        LAS unsigned* bm = (LAS unsigned*)(bq + w8 * 2048);
        for (int q = w8; q < 32; q += NWAVES) { const int c = __builtin_amdgcn_readfirstlane((int)cnt[q]); unsigned short* io = IDX + (m0 + q) * TOPK; u32x2* lq = mylist + (size_t)q * LIST_CAP;
            keymap_clear(bm, lane); asm volatile("s_waitcnt lgkmcnt(0)" ::: "memory");
            if (c > TOPK) select256<true>(lq, c, nullptr, nullptr, bm, lane);
            else {
#pragma unroll
                for (int k = 0; k < 4; ++k) { const int i = lane + 64 * k; if (i < c) { const unsigned key = lq[i].y; __hip_atomic_fetch_or(bm + (key >> 5), 1u << (key & 31u), __ATOMIC_RELAXED, __HIP_MEMORY_SCOPE_WORKGROUP); } } }
            asm volatile("s_waitcnt lgkmcnt(0)" ::: "memory");
            keymap_emit(bm, io, c, lane);
            asm volatile("s_waitcnt lgkmcnt(0)" ::: "memory"); }
        __syncthreads();
    }
}

constexpr int L16_CAP = 640;
template <bool FINAL, int L16_N>
__device__ __forceinline__ void select_lds(LAS float* sc, LAS unsigned short* ky, int c, LAS float* th_io, LAS unsigned* cnt_out, LAS unsigned* bm, int lane) {
    unsigned key[L16_N], id[L16_N];
#pragma unroll
    for (int k = 0; k < L16_N; ++k) { const int i = lane + 64 * k; const float v = sc[i]; key[k] = (i < c) ? mono_key(__float_as_uint(v)) : 0u; id[k] = ky[i]; }
    unsigned mx = key[0];
#pragma unroll
    for (int k = 1; k < L16_N; ++k) mx = key[k] > mx ? key[k] : mx;
#pragma unroll
    for (int o = 1; o < 64; o <<= 1) { const unsigned v = (unsigned)__shfl_xor((int)mx, o); mx = v > mx ? v : mx; }
    unsigned lo = FINAL ? 1u : mono_key(__float_as_uint(*th_io)), hi = mx;
    constexpr int PRUNE_KEEP = 320;
#pragma unroll 1
    while (lo < hi) { const unsigned mid = lo + ((hi - lo + 1u) >> 1); int cc = 0;
#pragma unroll
        for (int k = 0; k < L16_N; ++k) cc += __builtin_popcountll(__ballot(key[k] >= mid));
        if (cc >= TOPK) { lo = mid; if (cc <= (FINAL ? TOPK : PRUNE_KEEP)) break; } else hi = mid - 1u; }
    const unsigned prefix = lo;
    int ngt = 0, neq = 0;
#pragma unroll
    for (int k = 0; k < L16_N; ++k) { ngt += __builtin_popcountll(__ballot(key[k] > prefix)); neq += __builtin_popcountll(__ballot(key[k] == prefix)); }
    const int need_eq = FINAL ? (TOPK - ngt) : neq; int base_gt = 0, base_eq = 0;
    const unsigned long long lt = (1ull << lane) - 1ull;
    asm volatile("s_waitcnt lgkmcnt(0)" ::: "memory");
#pragma unroll
    for (int k = 0; k < L16_N; ++k) {
        const unsigned long long bgt = __ballot(key[k] > prefix), beq = __ballot(key[k] == prefix);
        int pos = -1;
        if (key[k] > prefix) pos = base_gt + __builtin_popcountll(bgt & lt);
        else if (key[k] == prefix) { const int r = base_eq + __builtin_popcountll(beq & lt); if (r < need_eq) pos = ngt + r; }
        if (pos >= 0) { if constexpr (FINAL) __hip_atomic_fetch_or(bm + (id[k] >> 5), 1u << (id[k] & 31u), __ATOMIC_RELAXED, __HIP_MEMORY_SCOPE_WORKGROUP);
            else { sc[pos] = __uint_as_float((key[k] & 0x80000000u) ? (key[k] & 0x7fffffffu) : ~key[k]); ky[pos] = (unsigned short)id[k]; } }
        base_gt += __builtin_popcountll(bgt); base_eq += __builtin_popcountll(beq);
        __builtin_amdgcn_sched_barrier(0);
    }
    if constexpr (!FINAL) { if (lane == 0) { const unsigned u = (prefix & 0x80000000u) ? (prefix & 0x7fffffffu) : ~prefix; *th_io = __uint_as_float(u); *cnt_out = (unsigned)(ngt + neq); } }
}
__device__ __forceinline__ void indexer_phase16(Frame& F0, const h16* IQ, const h16* IK, const float* IW, unsigned short* IDX) {
    Frame F = fresh(F0);
    LAS unsigned char* bq = F.lds + RING_OFF;
    LAS float* lsc = (LAS float*)(F.lds + RING_OFF + 65536);
    LAS unsigned short* lky = (LAS unsigned short*)(F.lds + RING_OFF + 65536 + 40960);
    LAS unsigned* cnt = (LAS unsigned*)(F.lds + RING_OFF + 65536 + 40960 + 20480); LAS float* th = (LAS float*)(cnt + 16); LAS unsigned* flag = cnt + 32; LAS unsigned* sgn = cnt + 48;
    const int lane = F.lane, n32 = lane & 31, q = n32 & 15, hsel = n32 >> 4, hh = lane >> 5, w8 = F.wave;
    const float INF = __builtin_inff();
    constexpr int NQ16 = SEQ / 16, NU = NB * NQ16;
    for (int rnd = 0; rnd * F.G < NU; ++rnd) {
        int qt, b;
        if (F.G == 256) { const int i = (F.vcu & 31) + 32 * (F.vcu >> 6); b = (F.vcu >> 5) & 1; qt = (rnd & 1) ? 128 * rnd + 127 - i : 128 * rnd + i; qt = NQ16 - 1 - qt; }
        else { const int kk = rnd * F.G + ((rnd & 1) ? (F.G - 1 - F.vcu) : F.vcu); if (kk >= NU) continue; qt = (NQ16 - 1) - (kk >> 1); b = kk & 1; }
        const int nkb = (qt >> 1) + 1;
        const size_t m0 = (size_t)b * SEQ + 16 * qt;
        if (F.tid < 16) { cnt[F.tid] = 0u; th[F.tid] = -INF; unsigned mk = 0u;
#pragma unroll
            for (int h = 0; h < 16; ++h) mk |= (IW[(m0 + F.tid) * 16 + h] >= 0.f ? 1u : 0u) << h;
            sgn[F.tid] = mk; }
        if (F.tid == 0) *flag = 0u;
#pragma unroll 4
        for (int j = 0; j < 8; ++j) { const int e = F.tid + 512 * j, le = e & 63, c = (e >> 6) & 7, hp = e >> 9, qe = le & 15, head = 2 * hp + ((le >> 4) & 1), he = le >> 5;
            const float w = IW[(m0 + qe) * 16 + head]; const half8 v = *(const half8*)(IQ + (m0 + qe) * 2048 + head * HD + 16 * c + 8 * he); half8 o;
#pragma unroll
            for (int x = 0; x < 8; ++x) o[x] = (h16)((float)v[x] * w);
            *(LAS half8*)(bq + e * 16) = o; }
        __syncthreads();
        const h16* ikb = IK + (size_t)b * SEQ * HD;
        const unsigned smask = sgn[q];
        float theta = -INF;
        const int qpos = 16 * qt + q;
        LAS float* msc = lsc + q * L16_CAP; LAS unsigned short* mky = lky + q * L16_CAP;
        half8 A[8];
        if (w8 < nkb) { const h16* arow = ikb + (size_t)(32 * w8 + n32) * HD + 8 * hh;
#pragma unroll
            for (int c = 0; c < 8; ++c) A[c] = *(const half8*)(arow + 16 * c); }
#pragma unroll 1
        for (int r0 = 0; r0 < nkb; r0 += NWAVES) {
            const int kb = r0 + w8;
            if (kb < nkb) {
                f32x16 S;
#pragma unroll
                for (int i = 0; i < 16; ++i) S[i] = 0.f;
                const LAS unsigned char* bl = bq + lane * 16;
                half8 Ba[4], Bb[4]; f32x16 acc0, acc1;
#define IX_LOADB(dst, hp, c0) do { _Pragma("unroll") for (int c = 0; c < 4; ++c) dst[c] = *(const LAS half8*)(bl + ((hp) * 8 + (c0) + c) * 1024); } while (0)
#define IX_MMA4(acc, Bx, c0) do { _Pragma("unroll") for (int c = 0; c < 4; ++c) acc = __builtin_amdgcn_mfma_f32_32x32x16_f16(A[(c0) + c], Bx[c], acc, 0, 0, 0); } while (0)
#define IX_ZERO(acc) do { _Pragma("unroll") for (int i = 0; i < 16; ++i) acc[i] = 0.f; } while (0)
#define IX_FOLD8(acc, hp, i0) do { const float cc_ = ((smask >> (2 * (hp) + hsel)) & 1u) ? INF : -INF; _Pragma("unroll") for (int i = (i0); i < (i0) + 8; ++i) S[i] += __builtin_amdgcn_fmed3f(acc[i], 0.f, cc_); } while (0)
#define IX_SCHED4() do { __builtin_amdgcn_sched_group_barrier(0x008, 1, 0); __builtin_amdgcn_sched_group_barrier(0x100, 1, 0); _Pragma("unroll") for (int g_ = 0; g_ < 3; ++g_) { __builtin_amdgcn_sched_group_barrier(0x008, 1, 0); __builtin_amdgcn_sched_group_barrier(0x100, 1, 0); __builtin_amdgcn_sched_group_barrier(0x002, 6, 0); } } while (0)
                IX_LOADB(Ba, 0, 0);
                IX_ZERO(acc1);
#pragma unroll 1
                for (int hp = 0; hp < 8; hp += 2) {
                    IX_ZERO(acc0);
                    IX_MMA4(acc0, Ba, 0); IX_FOLD8(acc1, (hp + 7) & 7, 0); IX_LOADB(Bb, hp, 4); IX_SCHED4();
                    IX_MMA4(acc0, Bb, 4); IX_FOLD8(acc1, (hp + 7) & 7, 8); IX_LOADB(Ba, hp + 1, 0); IX_SCHED4();
                    IX_ZERO(acc1);
                    IX_MMA4(acc1, Ba, 0); IX_FOLD8(acc0, hp, 0); IX_LOADB(Bb, hp + 1, 4); IX_SCHED4();
                    IX_MMA4(acc1, Bb, 4); IX_FOLD8(acc0, hp, 8); IX_LOADB(Ba, (hp + 2) & 7, 0); IX_SCHED4();
                }
                IX_FOLD8(acc1, 7, 0); IX_FOLD8(acc1, 7, 8);
#undef IX_LOADB
#undef IX_MMA4
#undef IX_ZERO
#undef IX_FOLD8
#undef IX_SCHED4
                if (kb + NWAVES < nkb) { const h16* arow = ikb + (size_t)(32 * (kb + NWAVES) + n32) * HD + 8 * hh;
#pragma unroll
                    for (int c = 0; c < 8; ++c) A[c] = *(const half8*)(arow + 16 * c); }
                float Sx[8];
#pragma unroll
                for (int i = 0; i < 8; ++i) { const float mine = hsel ? S[8 + i] : S[i], other = hsel ? S[i] : S[8 + i];
                    Sx[i] = mine + __shfl_xor(other, 16); }
                const int kb0 = 32 * kb + 4 * hh + 16 * hsel;
                unsigned pm = 0u;
                if (kb + 1 < nkb) {
#pragma unroll
                    for (int i = 0; i < 8; ++i) pm |= (Sx[i] > theta) ? (1u << i) : 0u;
                } else {
#pragma unroll
                    for (int i = 0; i < 8; ++i) { const int key = kb0 + (i & 3) + 8 * (i >> 2); pm |= ((key <= qpos) && (Sx[i] > theta)) ? (1u << i) : 0u; }
                }
                if (pm) { const unsigned np = (unsigned)__builtin_popcount(pm);
                    const unsigned pos = __hip_atomic_fetch_add(cnt + q, np, __ATOMIC_RELAXED, __HIP_MEMORY_SCOPE_WORKGROUP);
#pragma unroll
                    for (int i = 0; i < 8; ++i) if (pm & (1u << i)) { unsigned at = pos + (unsigned)__builtin_popcount(pm & ((1u << i) - 1u)); at = at < (unsigned)L16_CAP ? at : (unsigned)L16_CAP - 1u;
                        msc[at] = Sx[i]; mky[at] = (unsigned short)(kb0 + (i & 3) + 8 * (i >> 2)); }
                    if (pos + np > (unsigned)(L16_CAP - 256)) *(volatile LAS unsigned*)flag = 1u; }
            }
            asm volatile("s_waitcnt lgkmcnt(0)" ::: "memory"); __builtin_amdgcn_s_barrier(); asm volatile("" ::: "memory");
            if (*(volatile LAS unsigned*)flag != 0u) {
                for (int qq = w8; qq < 16; qq += NWAVES) { const int c = __builtin_amdgcn_readfirstlane((int)cnt[qq]); if (c > TOPK) select_lds<false, L16_CAP / 64>(lsc + qq * L16_CAP, lky + qq * L16_CAP, c, th + qq, cnt + qq, nullptr, lane); }
                if (F.tid == 0) *flag = 0u;
                asm volatile("s_waitcnt lgkmcnt(0)" ::: "memory"); __builtin_amdgcn_s_barrier(); asm volatile("" ::: "memory");
                theta = th[q];
            }
        }
        __syncthreads();
        LAS unsigned* bm = (LAS unsigned*)(bq + w8 * 2048);
        for (int qq = w8; qq < 16; qq += NWAVES) { const int c = __builtin_amdgcn_readfirstlane((int)cnt[qq]); unsigned short* io = IDX + (m0 + qq) * TOPK;
            keymap_clear(bm, lane); asm volatile("s_waitcnt lgkmcnt(0)" ::: "memory");
            if (c > TOPK) select_lds<true, L16_CAP / 64>(lsc + qq * L16_CAP, lky + qq * L16_CAP, c, nullptr, nullptr, bm, lane);
            else {
#pragma unroll
                for (int k = 0; k < 4; ++k) { const int i = lane + 64 * k; if (i < c) { const unsigned key = lky[qq * L16_CAP + i]; __hip_atomic_fetch_or(bm + (key >> 5), 1u << (key & 31u), __ATOMIC_RELAXED, __HIP_MEMORY_SCOPE_WORKGROUP); } } }
            asm volatile("s_waitcnt lgkmcnt(0)" ::: "memory");
            keymap_emit(bm, io, c, lane);
            asm volatile("s_waitcnt lgkmcnt(0)" ::: "memory"); }
        __syncthreads();
    }
}

constexpr int L5_CAP = 640;
static_assert(32768 + 32 * L5_CAP * 6 + 512 <= RING_BYTES, "indexer LDS");
__device__ __forceinline__ bool ix5_append(float v0, float v1, int kb0, bool valid, bool masked, int qpos, float theta, unsigned cnt_addr, unsigned sc_addr, unsigned ky_addr) {
    unsigned pm = (((v0 > theta) && (!masked || kb0 <= qpos)) ? 1u : 0u) | (((v1 > theta) && (!masked || kb0 + 1 <= qpos)) ? 2u : 0u);
    if (!valid) pm = 0u;
    bool over = false;
    if (pm) { const unsigned np = pm == 3u ? 2u : 1u; unsigned pos;
        asm volatile("ds_add_rtn_u32 %0, %1, %2\n\ts_waitcnt lgkmcnt(0)" : "=&v"(pos) : "v"(cnt_addr), "v"(np) : "memory");
        const unsigned a0 = pos < (unsigned)L5_CAP ? pos : (unsigned)L5_CAP - 1u, p1 = pos + (pm & 1u), a1 = p1 < (unsigned)L5_CAP ? p1 : (unsigned)L5_CAP - 1u;
        if (pm & 1u) { asm volatile("ds_write_b32 %0, %1" :: "v"(sc_addr + 4u * a0), "v"(v0) : "memory"); asm volatile("ds_write_b16 %0, %1" :: "v"(ky_addr + 2u * a0), "v"((unsigned)kb0) : "memory"); }
        if (pm & 2u) { asm volatile("ds_write_b32 %0, %1" :: "v"(sc_addr + 4u * a1), "v"(v1) : "memory"); asm volatile("ds_write_b16 %0, %1" :: "v"(ky_addr + 2u * a1), "v"((unsigned)(kb0 + 1)) : "memory"); }
        over = pos + np > (unsigned)(L5_CAP - 64); }
    return over;
}
__device__ __forceinline__ void indexer_phase5(Frame& F0, const h16* IQ, const h16* IK, const float* IW, unsigned short* IDX, const float theta0) {
    Frame F = fresh(F0);
    LAS unsigned char* ringA = F.lds + RING_OFF;
    LAS float* lsc = (LAS float*)(F.lds + RING_OFF + 32768);
    LAS unsigned short* lky = (LAS unsigned short*)(F.lds + RING_OFF + 32768 + 32 * L5_CAP * 4);
    LAS unsigned* cnt = (LAS unsigned*)(F.lds + RING_OFF + 32768 + 32 * L5_CAP * 6); LAS float* th = (LAS float*)(cnt + 32); LAS unsigned* req = cnt + 64; const unsigned req_addr = (unsigned)(unsigned long)req;
    const int lane = F.lane, n32 = lane & 31, hh = lane >> 5, q4 = n32 & 3, h8 = n32 >> 2, w8 = F.wave;
    const bool b2 = (lane >> 2) & 1, b3 = (lane >> 3) & 1, b4 = (lane >> 4) & 1;
    const int ql = 4 * w8 + q4, drow = lane >> 4, dpc = lane & 15;
    const float INF = __builtin_inff();
    constexpr int NU = NB * (SEQ / 32);
    for (int rnd = 0; rnd * F.G < NU; ++rnd) {
        int qt, b;
        if (F.G == 256) { const int i = (F.vcu & 31) + 32 * (F.vcu >> 6); b = (F.vcu >> 5) & 1; qt = rnd == 0 ? 511 - i : rnd == 1 ? i : rnd == 2 ? 256 + i : 255 - i; }
        else { const int kk = rnd * F.G + ((rnd & 1) ? (F.G - 1 - F.vcu) : F.vcu); if (kk >= NU) continue; qt = (SEQ / 32 - 1) - (kk >> 1); b = kk & 1; }
        const int nst = (qt >> 1) + 1;
        const size_t m0 = (size_t)b * SEQ + 32 * qt;
        const h16* ikb = IK + (size_t)b * SEQ * HD;
#define IX5_DMA(k_, slot_) do { _Pragma("unroll") for (int i_ = 0; i_ < 2; ++i_) { const int r_ = 8 * w8 + 4 * i_ + drow; \
            __builtin_amdgcn_global_load_lds((const unsigned*)(ikb + (size_t)(64 * (k_) + r_) * HD + 8 * (dpc ^ (r_ & 15))), (LAS unsigned*)(ringA + (slot_) * 16384 + (8 * w8 + 4 * i_) * 256), 16, 0, 0); } } while (0)
        IX5_DMA(0, 0);
        if (lane < 4) { cnt[4 * w8 + lane] = 0u; th[4 * w8 + lane] = -INF; }
        if (F.tid == 0) *req = 0xffffffffu;
        half8 B0[8], B1[8]; float cc0, cc1;
        { const size_t row = m0 + ql; const float w0 = IW[row * 16 + h8], w1 = IW[row * 16 + 8 + h8]; cc0 = w0 >= 0.f ? INF : -INF; cc1 = w1 >= 0.f ? INF : -INF;
          const h16* src = IQ + row * 2048 + h8 * HD + 8 * hh;
#pragma unroll
          for (int c = 0; c < 8; ++c) { const half8 v0 = *(const half8*)(src + 16 * c), v1 = *(const half8*)(src + 8 * HD + 16 * c);
#pragma unroll
              for (int x = 0; x < 8; ++x) { B0[c][x] = (h16)((float)v0[x] * w0); B1[c][x] = (h16)((float)v1[x] * w1); } } }
        float theta = theta0;
        const int qpos = 32 * qt + ql;
        const unsigned cnt_addr = (unsigned)(unsigned long)(cnt + ql), sc_addr = (unsigned)(unsigned long)(lsc + ql * L5_CAP), ky_addr = (unsigned)(unsigned long)(lky + ql * L5_CAP);
        const LAS unsigned char* arow = ringA + n32 * 256 + ((hh ^ (n32 & 1)) * 16);
        const int axor = 16 * (n32 & 14);
        const int kl = 16 * (int)b4 + 8 * (int)b3 + 4 * hh + 2 * (int)b2;
        half8 A[8]; f32x16 X0, X1, Y0, Y1; float T2a, T2b;
#define IX5_ZERO(P0, P1) do { _Pragma("unroll") for (int i = 0; i < 16; ++i) { P0[i] = 0.f; P1[i] = 0.f; } } while (0)
#define IX5_BLOCK(P0, P1, Q0, Q1, REFILL, nbase_) do { float S_[16], T_[8]; IX5_ZERO(P0, P1); \
            _Pragma("unroll") for (int s_ = 0; s_ < 16; ++s_) { const int c_ = s_ >> 1; \
                if (s_ & 1) { P1 = __builtin_amdgcn_mfma_f32_32x32x16_f16(A[c_], B1[c_], P1, 0, 0, 0); if (REFILL) A[c_] = *(const LAS half8*)((nbase_) + ((32 * c_) ^ axor));   } \
                else P0 = __builtin_amdgcn_mfma_f32_32x32x16_f16(A[c_], B0[c_], P0, 0, 0, 0); \
                if (s_ < 8) { S_[s_] = __builtin_amdgcn_fmed3f(Q0[s_], 0.f, cc0) + __builtin_amdgcn_fmed3f(Q1[s_], 0.f, cc1); S_[8 + s_] = __builtin_amdgcn_fmed3f(Q0[8 + s_], 0.f, cc0) + __builtin_amdgcn_fmed3f(Q1[8 + s_], 0.f, cc1); } \
                else { const int j_ = s_ - 8; const auto r_ = __builtin_amdgcn_permlane16_swap(__float_as_uint(S_[j_]), __float_as_uint(S_[8 + j_]), false, false); T_[j_] = __uint_as_float(r_[0]) + __uint_as_float(r_[1]); \
                    T_[j_] += __uint_as_float(__builtin_amdgcn_update_dpp(0u, __float_as_uint(T_[j_]), 0x128, 0xf, 0xf, false)); T_[j_] += __uint_as_float(__builtin_amdgcn_update_dpp(0u, __float_as_uint(T_[j_]), 0x124, 0xf, 0xf, false)); } \
                __builtin_amdgcn_sched_barrier(0); } \
            T2a = b3 ? (b2 ? T_[6] : T_[4]) : (b2 ? T_[2] : T_[0]); T2b = b3 ? (b2 ? T_[7] : T_[5]) : (b2 ? T_[3] : T_[1]); \
        } while (0)
        IX5_ZERO(Y0, Y1);
        bool own_over = false;
#pragma unroll 1
        for (int k = 0; k < nst; ++k) {
            VM_WAIT(); __builtin_amdgcn_s_barrier(); asm volatile("" ::: "memory");
            if (*(volatile LAS unsigned*)req == (unsigned)k || own_over) {
                for (int i = 0; i < 4; ++i) { const int qq = 4 * w8 + i; const int c = __builtin_amdgcn_readfirstlane((int)cnt[qq]); if (c > TOPK + 32) select_lds<false, L5_CAP / 64>(lsc + qq * L5_CAP, lky + qq * L5_CAP, c, th + qq, cnt + qq, nullptr, lane); }
                asm volatile("s_waitcnt lgkmcnt(0)" ::: "memory");
                theta = th[ql];
            }
            if (k + 1 < nst) IX5_DMA(k + 1, (k + 1) & 1);
            const LAS unsigned char* as = arow + (k & 1) * 16384;
#pragma unroll
            for (int c = 0; c < 8; ++c) { A[c] = *(const LAS half8*)(as + ((32 * c) ^ axor)); __builtin_amdgcn_sched_barrier(0); }
            IX5_BLOCK(X0, X1, Y0, Y1, true, as + 8192);
            bool over = ix5_append(T2a, T2b, 64 * k - 32 + kl, k > 0, false, qpos, theta, cnt_addr, sc_addr, ky_addr);
            IX5_BLOCK(Y0, Y1, X0, X1, false, as);
            over = ix5_append(T2a, T2b, 64 * k + kl, true, k + 1 == nst, qpos, theta, cnt_addr, sc_addr, ky_addr) || over;
            own_over = __ballot(over) != 0ull;
            if (own_over && lane == 0) asm volatile("ds_write_b32 %0, %1" :: "v"(req_addr), "v"((unsigned)(k + 1)) : "memory");
        }
        if (own_over) {
            for (int i = 0; i < 4; ++i) { const int qq = 4 * w8 + i; const int c = __builtin_amdgcn_readfirstlane((int)cnt[qq]); if (c > TOPK + 32) select_lds<false, L5_CAP / 64>(lsc + qq * L5_CAP, lky + qq * L5_CAP, c, th + qq, cnt + qq, nullptr, lane); }
            asm volatile("s_waitcnt lgkmcnt(0)" ::: "memory");
            theta = th[ql]; }
        { float S_[16], T_[8];
#pragma unroll
          for (int i = 0; i < 16; ++i) S_[i] = __builtin_amdgcn_fmed3f(Y0[i], 0.f, cc0) + __builtin_amdgcn_fmed3f(Y1[i], 0.f, cc1);
#pragma unroll
          for (int i = 0; i < 8; ++i) { const auto r_ = __builtin_amdgcn_permlane16_swap(__float_as_uint(S_[i]), __float_as_uint(S_[8 + i]), false, false); T_[i] = __uint_as_float(r_[0]) + __uint_as_float(r_[1]); }
#pragma unroll
          for (int i = 0; i < 8; ++i) { T_[i] += __uint_as_float(__builtin_amdgcn_update_dpp(0u, __float_as_uint(T_[i]), 0x128, 0xf, 0xf, false)); T_[i] += __uint_as_float(__builtin_amdgcn_update_dpp(0u, __float_as_uint(T_[i]), 0x124, 0xf, 0xf, false)); }
          T2a = b3 ? (b2 ? T_[6] : T_[4]) : (b2 ? T_[2] : T_[0]); T2b = b3 ? (b2 ? T_[7] : T_[5]) : (b2 ? T_[3] : T_[1]);
          (void)ix5_append(T2a, T2b, 64 * nst - 32 + kl, true, true, qpos, theta, cnt_addr, sc_addr, ky_addr); }
#undef IX5_DMA
#undef IX5_ZERO
#undef IX5_BLOCK
        __syncthreads();
        LAS unsigned* bm = (LAS unsigned*)(ringA + w8 * 2048);
        for (int i = 0; i < 4; ++i) { const int qq = 4 * w8 + i; const int c = __builtin_amdgcn_readfirstlane((int)cnt[qq]); unsigned short* io = IDX + (m0 + qq) * TOPK;
            keymap_clear(bm, lane); asm volatile("s_waitcnt lgkmcnt(0)" ::: "memory");
            if (c > TOPK) select_lds<true, L5_CAP / 64>(lsc + qq * L5_CAP, lky + qq * L5_CAP, c, nullptr, nullptr, bm, lane);
            else {
#pragma unroll
                for (int k = 0; k < 4; ++k) { const int j = lane + 64 * k; if (j < c) { const unsigned key = lky[qq * L5_CAP + j]; __hip_atomic_fetch_or(bm + (key >> 5), 1u << (key & 31u), __ATOMIC_RELAXED, __HIP_MEMORY_SCOPE_WORKGROUP); } } }
            asm volatile("s_waitcnt lgkmcnt(0)" ::: "memory");
            keymap_emit(bm, io, c, lane);
            asm volatile("s_waitcnt lgkmcnt(0)" ::: "memory"); }
        __syncthreads();
    }
}

__device__ __forceinline__ unsigned q_fetch(unsigned* ctr, int lane) { unsigned v = 0u; if (lane == 0) v = __hip_atomic_fetch_add(ctr, 1u, __ATOMIC_RELAXED, __HIP_MEMORY_SCOPE_AGENT); return (unsigned)__builtin_amdgcn_readfirstlane((int)v); }
__device__ __forceinline__ void sparse_attn_phase(Frame& F0, const h16* Q, const unsigned char* K8, const unsigned char* V8, const unsigned short* IDX, h16* O, unsigned* qctr) {
    Frame F = fresh(F0);
    LAS unsigned char* wl = F.lds + RING_OFF + F.wave * 16896;
    LAS float* Pl = (LAS float*)wl;
    LAS unsigned short* Il = (LAS unsigned short*)(wl + 4096);
    const int lane = F.lane, r16 = lane & 15, g4 = lane >> 4;
    const float c2 = 0.08838834764831845f * 1.44269504089f;
    const unsigned x0 = xb_xcc_id() & 7u;
    unsigned tried = 0u, p = x0;
    unsigned item = q_fetch(qctr + 64 * p, lane);
    bool have_pf = false; u32x2 pf_idx = (u32x2){0u, 0u}; half8 pf_q[4];
#pragma unroll
    for (int s = 0; s < 4; ++s) pf_q[s] = (half8){0, 0, 0, 0, 0, 0, 0, 0};
    for (;;) {
        while (item >= (unsigned)SEQ && tried < 8u) { ++tried; p = (x0 + tried) & 7u; if (tried < 8u) item = q_fetch(qctr + 64 * p, lane); }
        if (tried >= 8u) break;
        const unsigned nxt = q_fetch(qctr + 64 * p, lane);
        const int b = (int)(p >> 2), j = (int)(p & 3u), tq = (int)item, nk = (tq + 1) < TOPK ? (tq + 1) : TOPK;
        const size_t m = (size_t)b * SEQ + tq;
        const unsigned char* kb = K8 + (size_t)p * SEQ * HD; const unsigned char* vb = V8 + (size_t)p * SEQ * HD;
        *(LAS u32x2*)(Il + 4 * lane) = have_pf ? pf_idx : *(const u32x2*)(IDX + m * TOPK + 4 * lane);
        long qh[4], ql[4];
        { const h16* qrow = Q + m * 2048 + (size_t)j * 512 + (r16 & 3) * HD + 16 * g4;
#pragma unroll
          for (int s = 0; s < 4; ++s) { const half8 hv = have_pf ? pf_q[s] : *(const half8*)(qrow + (s >> 1) * 64 + (s & 1) * 8);
              float f[8], l[8];
#pragma unroll
              for (int e = 0; e < 8; ++e) f[e] = (float)hv[e] * c2;
              const unsigned h0 = pk8(f[0], f[1], f[2], f[3]), h1 = pk8(f[4], f[5], f[6], f[7]);
              l[0] = f[0] - __builtin_amdgcn_cvt_f32_fp8((int)h0, 0); l[1] = f[1] - __builtin_amdgcn_cvt_f32_fp8((int)h0, 1); l[2] = f[2] - __builtin_amdgcn_cvt_f32_fp8((int)h0, 2); l[3] = f[3] - __builtin_amdgcn_cvt_f32_fp8((int)h0, 3);
              l[4] = f[4] - __builtin_amdgcn_cvt_f32_fp8((int)h1, 0); l[5] = f[5] - __builtin_amdgcn_cvt_f32_fp8((int)h1, 1); l[6] = f[6] - __builtin_amdgcn_cvt_f32_fp8((int)h1, 2); l[7] = f[7] - __builtin_amdgcn_cvt_f32_fp8((int)h1, 3);
              const unsigned l0 = pk8(l[0], l[1], l[2], l[3]), l1 = pk8(l[4], l[5], l[6], l[7]);
              const bool real = r16 < 4;
              qh[s] = real ? (long)(((unsigned long long)h1 << 32) | h0) : 0l; ql[s] = real ? (long)(((unsigned long long)l1 << 32) | l0) : 0l; } }
        asm volatile("s_waitcnt lgkmcnt(0)" ::: "memory");
        int keys[16];
#pragma unroll
        for (int kt = 0; kt < 16; ++kt) keys[kt] = Il[16 * kt + r16];
        {
            u32x4 ka[8][2];
#pragma unroll
            for (int k8 = 0; k8 < 8; ++k8) { const unsigned char* krow = kb + (size_t)keys[k8] * HD + 16 * g4; ka[k8][0] = *(const u32x4*)krow; ka[k8][1] = *(const u32x4*)(krow + 64); }
#pragma unroll
            for (int kt = 0; kt < 16; ++kt) { const int k8 = kt & 7; const u32x4 a0 = ka[k8][0], a1 = ka[k8][1];
                const long ak[4] = {(long)(((unsigned long long)a0.y << 32) | a0.x), (long)(((unsigned long long)a0.w << 32) | a0.z), (long)(((unsigned long long)a1.y << 32) | a1.x), (long)(((unsigned long long)a1.w << 32) | a1.z)};
                if (kt < 8) { const unsigned char* krow = kb + (size_t)keys[kt + 8] * HD + 16 * g4; ka[k8][0] = *(const u32x4*)krow; ka[k8][1] = *(const u32x4*)(krow + 64); }
                f32x4 acc = (f32x4){0.f, 0.f, 0.f, 0.f};
#pragma unroll
                for (int s = 0; s < 4; ++s) { acc = __builtin_amdgcn_mfma_f32_16x16x32_fp8_fp8(ak[s], qh[s], acc, 0, 0, 0); acc = __builtin_amdgcn_mfma_f32_16x16x32_fp8_fp8(ak[s], ql[s], acc, 0, 0, 0); }
                if (r16 < 4) {
#pragma unroll
                    for (int i = 0; i < 4; ++i) Pl[(16 * kt + 4 * g4 + i) * 4 + r16] = acc[i]; }
            }
        }
        have_pf = nxt < (unsigned)SEQ;
        if (have_pf) { const size_t mn = (size_t)b * SEQ + nxt; pf_idx = *(const u32x2*)(IDX + mn * TOPK + 4 * lane);
            const h16* qn = Q + mn * 2048 + (size_t)j * 512 + (r16 & 3) * HD + 16 * g4;
#pragma unroll
            for (int s = 0; s < 4; ++s) pf_q[s] = *(const half8*)(qn + (s >> 1) * 64 + (s & 1) * 8); }
        asm volatile("" ::: "memory");
        LAS unsigned char* vs = wl + 4608;
        const int nch = (nk + 31) >> 5;
#define SP_ISSUE(ch_) do { const int c_ = (ch_); LAS unsigned char* s_ = vs + (c_ % 3) * 4096; _Pragma("unroll") for (int j_ = 0; j_ < 4; ++j_) { const int key_ = Il[32 * c_ + 8 * j_ + (lane >> 3)]; \
                __builtin_amdgcn_global_load_lds((const unsigned*)(vb + (size_t)key_ * HD + (((lane & 7) ^ (((8 * j_ + (lane >> 3)) >> 1) & 7)) * 16)), (LAS unsigned*)(s_ + 1024 * j_), 16, 0, 0); } } while (0)
            SP_ISSUE(0); if (nch > 1) SP_ISSUE(1);
        f32x4 sv[4]; f32x4 mx = (f32x4){-3.0e38f, -3.0e38f, -3.0e38f, -3.0e38f};
#pragma unroll
        for (int k = 0; k < 4; ++k) { sv[k] = *(const LAS f32x4*)(Pl + (lane + 64 * k) * 4); if (lane + 64 * k < nk) { mx[0] = fmaxf(mx[0], sv[k][0]); mx[1] = fmaxf(mx[1], sv[k][1]); mx[2] = fmaxf(mx[2], sv[k][2]); mx[3] = fmaxf(mx[3], sv[k][3]); } }
        mx[0] = wave_max_dpp(mx[0]); mx[1] = wave_max_dpp(mx[1]); mx[2] = wave_max_dpp(mx[2]); mx[3] = wave_max_dpp(mx[3]);
        f32x4 sum = (f32x4){0.f, 0.f, 0.f, 0.f};
        asm volatile("s_waitcnt lgkmcnt(0)" ::: "memory");
#pragma unroll
        for (int k = 0; k < 4; ++k) { f32x4 pv;
#pragma unroll
            for (int h = 0; h < 4; ++h) pv[h] = (lane + 64 * k < nk) ? __builtin_amdgcn_exp2f(sv[k][h] - mx[h]) : 0.f;
            sum += pv;
#pragma unroll
            for (int h = 0; h < 4; ++h) Pl[h * 256 + lane + 64 * k] = pv[h] * 16.0f; }
        sum[0] = wave_sum_dpp(sum[0]); sum[1] = wave_sum_dpp(sum[1]); sum[2] = wave_sum_dpp(sum[2]); sum[3] = wave_sum_dpp(sum[3]);
        asm volatile("s_waitcnt lgkmcnt(0)" ::: "memory");
        long ph[8], pq[8];
#pragma unroll
        for (int s = 0; s < 8; ++s) { const LAS float* pp = Pl + (r16 & 3) * 256 + 32 * s + 8 * g4; const f32x4 a = *(const LAS f32x4*)pp, c = *(const LAS f32x4*)(pp + 4);
            const unsigned h0 = pk8(a[0], a[1], a[2], a[3]), h1 = pk8(c[0], c[1], c[2], c[3]);
            const unsigned l0 = pk8(a[0] - __builtin_amdgcn_cvt_f32_fp8((int)h0, 0), a[1] - __builtin_amdgcn_cvt_f32_fp8((int)h0, 1), a[2] - __builtin_amdgcn_cvt_f32_fp8((int)h0, 2), a[3] - __builtin_amdgcn_cvt_f32_fp8((int)h0, 3));
            const unsigned l1 = pk8(c[0] - __builtin_amdgcn_cvt_f32_fp8((int)h1, 0), c[1] - __builtin_amdgcn_cvt_f32_fp8((int)h1, 1), c[2] - __builtin_amdgcn_cvt_f32_fp8((int)h1, 2), c[3] - __builtin_amdgcn_cvt_f32_fp8((int)h1, 3));
            const bool real = r16 < 4;
            ph[s] = real ? (long)(((unsigned long long)h1 << 32) | h0) : 0l; pq[s] = real ? (long)(((unsigned long long)l1 << 32) | l0) : 0l; }
        f32x4 oacc[8];
#pragma unroll
        for (int nt = 0; nt < 8; ++nt) oacc[nt] = (f32x4){0.f, 0.f, 0.f, 0.f};
        {
            const int vrow = 8 * g4 + (r16 >> 1);
#pragma unroll
            for (int ch = 0; ch < 8; ++ch) {
                if (ch < nch) {
                    if (ch + 2 < nch) { SP_ISSUE(ch + 2); asm volatile("s_waitcnt vmcnt(8)" ::: "memory"); }
                    else if (ch + 1 < nch) asm volatile("s_waitcnt vmcnt(4)" ::: "memory");
                    else asm volatile("s_waitcnt vmcnt(0)" ::: "memory");
                    const LAS unsigned char* s = vs + (ch % 3) * 4096 + vrow * HD + 8 * (r16 & 1);
#pragma unroll
                    for (int nt = 0; nt < 8; ++nt) {
                        const v2i32 bv = __builtin_amdgcn_ds_read_tr8_b64_v2i32((LAS v2i32*)(s + ((nt ^ ((vrow >> 1) & 7)) * 16)));
                        const long bb = (long)(((unsigned long long)(unsigned)bv.y << 32) | (unsigned)bv.x);
                        oacc[nt] = __builtin_amdgcn_mfma_f32_16x16x32_fp8_fp8(ph[ch], bb, oacc[nt], 0, 0, 0);
                        oacc[nt] = __builtin_amdgcn_mfma_f32_16x16x32_fp8_fp8(pq[ch], bb, oacc[nt], 0, 0, 0); }
                    asm volatile("s_waitcnt lgkmcnt(0)" ::: "memory");
                }
            }
#undef SP_ISSUE
        }
        { LAS h16* ot = (LAS h16*)Pl;
          if (g4 == 0) {
#pragma unroll
              for (int nt = 0; nt < 8; ++nt)
#pragma unroll
                  for (int i = 0; i < 4; ++i) ot[i * HD + 16 * nt + r16] = (h16)(oacc[nt][i] * (0.0625f / sum[i])); }
          asm volatile("s_waitcnt lgkmcnt(0)" ::: "memory");
          const u32x4 w = *(const LAS u32x4*)(ot + g4 * HD + 8 * r16);
          *(u32x4*)(O + m * 2048 + (size_t)j * 512 + g4 * HD + 8 * r16) = w; }
        asm volatile("s_waitcnt lgkmcnt(0)" ::: "memory");
        item = nxt;
    }
}

#ifndef DBG_CHECK
#define DBG_CHECK 0
#endif
#if DBG_CHECK
__device__ __forceinline__ void dbg_max(unsigned* w, float v) { atomicMax(w, __builtin_bit_cast(unsigned, fabsf(v))); }
__device__ __forceinline__ int dbg_row(int blk) { return (blk & 1) * SEQ + (SEQ - 1 - 251 * (blk >> 1)); }
__device__ __forceinline__ void dbg_check_inproj(unsigned char* ws, LAS float* sh, unsigned* word) {
    if (blockIdx.x >= 64) return;
    int tid_ = (int)threadIdx.x; asm volatile("" : "+v"(tid_)); const int m = dbg_row(blockIdx.x), tid = tid_;
    const h16* a = (const h16*)(ws + WS_A) + (size_t)m * 2048; const h16* W = (const h16*)(ws + WS_WIN);
    for (int c = tid; c < DSA_N; c += 512) { float s = 0.f; for (int k = 0; k < 2048; ++k) s += (float)a[k] * (float)W[(size_t)c * 2048 + k]; sh[c] = s * (1.0f / 64.0f); }
    __syncthreads();
    const float* rope = (const float*)(ws + WS_ROPE) + (size_t)m * 32;
    for (int c = tid; c < DSA_N; c += 512) {
        float v = sh[c]; int hc; bool rot; float got;
        if (c < 2048) { hc = c & 127; rot = true; got = (float)((const h16*)(ws + WS_Q))[(size_t)m * 2048 + c]; }
        else if (c < 3072) continue;
        else if (c < 5120) { hc = (c - 3072) & 127; rot = true; got = (float)((const h16*)(ws + WS_IQ))[(size_t)m * 2048 + (c - 3072)]; }
        else if (c < 5248) { hc = c - 5120; rot = true; got = (float)((const h16*)(ws + WS_IK))[(size_t)m * 128 + (c - 5120)]; }
        else { hc = 99; rot = false; got = ((const float*)(ws + WS_IW))[(size_t)m * 16 + (c - 5248)]; }
        if (rot && hc < 32) { const int i = hc & 15; const float cs = rope[i], sn = rope[16 + i]; v = hc < 16 ? v * cs - sh[c + 16] * sn : v * cs + sh[c - 16] * sn; }
        dbg_max(word, (got - v) / (1.0f + fabsf(v)));
    }
    __syncthreads();
}
__device__ __forceinline__ void dbg_check_xattn(unsigned char* ws, int L, LAS float* sh, unsigned* word) {
    if (blockIdx.x >= 64) return;
    int tid_ = (int)threadIdx.x; asm volatile("" : "+v"(tid_)); const int m = dbg_row(blockIdx.x), tid = tid_, b = m / SEQ;
    const h16* a = (const h16*)(ws + WS_A) + (size_t)m * 2048; const h16* W = (const h16*)(ws + WS_WQ) + (size_t)L * 512 * 2048;
    const h16* kvm = (const h16*)(ws + WS_KVM) + (size_t)b * NMEM * 2048 + L * 1024;
    LAS float* q = sh; LAS float* lg = sh + 512; LAS float* st = sh + 512 + 1024;
    { float s = 0.f; for (int k = 0; k < 2048; ++k) s += (float)a[k] * (float)W[(size_t)tid * 2048 + k]; q[tid] = (float)(h16)s; }
    __syncthreads();
    for (int i = tid; i < 1024; i += 512) { const int h = i >> 8, key = i & 255; float s = 0.f; for (int d = 0; d < 128; ++d) s += q[h * 128 + d] * (float)kvm[(size_t)key * 2048 + h * 128 + d]; lg[i] = s * 0.08838834764831845f; }
    __syncthreads();
    if (tid < 4) { float mx = -3e38f; for (int k = 0; k < 256; ++k) mx = fmaxf(mx, lg[tid * 256 + k]); float su = 0.f; for (int k = 0; k < 256; ++k) su += __expf(lg[tid * 256 + k] - mx); st[2 * tid] = mx; st[2 * tid + 1] = 1.0f / su; }
    __syncthreads();
    { const int h = tid >> 7, d = tid & 127; float o = 0.f; for (int k = 0; k < 256; ++k) o += __expf(lg[h * 256 + k] - st[2 * h]) * st[2 * h + 1] * (float)kvm[(size_t)k * 2048 + 512 + h * 128 + d];
      const float got = (float)((const h16*)(ws + WS_XQ))[(size_t)m * 512 + tid]; dbg_max(word, (got - o) / (0.05f + fabsf(o))); }
    __syncthreads();
}
__device__ __forceinline__ void dbg_check_indexer(unsigned char* ws, LAS float* sh, unsigned* word, unsigned* word2) {
    if (blockIdx.x >= 64) return;
    int tid_ = (int)threadIdx.x; asm volatile("" : "+v"(tid_)); const int m = dbg_row(blockIdx.x), tid = tid_, b = m / SEQ, t = m % SEQ;
    const h16* iq = (const h16*)(ws + WS_IQ) + (size_t)m * 2048; const h16* ik = (const h16*)(ws + WS_IK) + (size_t)b * SEQ * 128; const float* iw = (const float*)(ws + WS_IW) + (size_t)m * 16;
    LAS float* sc = sh;
    for (int s = tid; s <= t; s += 512) { float tot = 0.f; for (int h = 0; h < 16; ++h) { float l = 0.f; for (int d = 0; d < 128; ++d) l += (float)iq[h * 128 + d] * (float)ik[(size_t)s * 128 + d]; tot += iw[h] * fmaxf(l, 0.f); } sc[s] = tot; }
    __syncthreads();
    const unsigned short* idx = (const unsigned short*)(ws + WS_IDX) + (size_t)m * 256;
    if (tid < 256) { const int key = idx[tid]; if (key > t) atomicAdd(word2, 1000u); else { const float v = sc[key]; int rank = 0; for (int s = 0; s <= t; ++s) rank += sc[s] > v ? 1 : 0; if (rank >= 256) atomicAdd(word, 1u);
        for (int j = 0; j < 256; ++j) if (j != tid && idx[j] == key) { atomicAdd(word2, 1u); break; } } }
    __syncthreads();
}
__device__ __forceinline__ float dbg_f8(const unsigned char* p) { const unsigned w = *p; return __builtin_amdgcn_cvt_f32_fp8((int)w, 0); }
__device__ __forceinline__ void dbg_check_sparse(unsigned char* ws, LAS float* sh, unsigned* word) {
    if (blockIdx.x >= 64) return;
    int tid_ = (int)threadIdx.x; asm volatile("" : "+v"(tid_)); const int m = dbg_row(blockIdx.x), tid = tid_, b = m / SEQ;
    const h16* q = (const h16*)(ws + WS_Q) + (size_t)m * 2048; const unsigned char* k8 = (const unsigned char*)(ws + WS_KV); const unsigned char* v8 = k8 + (size_t)16 * 1024 * 1024;
    const unsigned short* idx = (const unsigned short*)(ws + WS_IDX) + (size_t)m * 256;
    LAS float* lg = sh; LAS float* st = sh + 4096;
    for (int i = tid; i < 4096; i += 512) { const int h = i >> 8, k = i & 255, key = idx[k]; float s = 0.f; const unsigned char* kr = k8 + ((size_t)(b * NKV + (h >> 2)) * SEQ + key) * HD;
        for (int d = 0; d < 128; ++d) s += (float)q[h * 128 + d] * dbg_f8(kr + d); lg[i] = s * 0.08838834764831845f; }
    __syncthreads();
    if (tid < 16) { float mx = -3e38f; for (int k = 0; k < 256; ++k) mx = fmaxf(mx, lg[tid * 256 + k]); float su = 0.f; for (int k = 0; k < 256; ++k) su += __expf(lg[tid * 256 + k] - mx); st[2 * tid] = mx; st[2 * tid + 1] = 1.0f / su; }
    __syncthreads();
    for (int i = tid; i < 2048; i += 512) { const int h = i >> 7, d = i & 127; float o = 0.f; for (int k = 0; k < 256; ++k) o += __expf(lg[h * 256 + k] - st[2 * h]) * st[2 * h + 1] * dbg_f8(v8 + ((size_t)(b * NKV + (h >> 2)) * SEQ + idx[k]) * HD + d);
        const float got = (float)((const h16*)(ws + WS_A))[(size_t)m * 2048 + i]; dbg_max(word, (got - o) / (0.02f + fabsf(o))); }
    __syncthreads();
}
#endif

constexpr int N_PHASES = 22 + (DBG_CHECK ? 1 : 0);
__global__ void __launch_bounds__(NWAVES * 64, 2) trunk_fwd(Args args) {
    extern __shared__ __attribute__((aligned(16))) unsigned char lds_raw[];
    Frame F;
    F.lds = (LAS unsigned char*)lds_raw;
    F.MISC = (volatile LAS unsigned*)(F.lds + MISC_OFF);
    F.tid = threadIdx.x; F.lane = F.tid & 63; F.wave = __builtin_amdgcn_readfirstlane(F.tid >> 6);
    F.G = gridDim.x; { const int bx = blockIdx.x; F.vcu = (F.G % 8 == 0) ? (bx % 8) * (F.G / 8) + bx / 8 : bx; }
    unsigned char* ws = argp()->ws;
    for (int u = F.tid; u < (LDS_BYTES - MISC_OFF) / 4; u += NWAVES * 64) ((LAS unsigned*)(F.lds + MISC_OFF))[u] = 0u;
    __syncthreads();
    XcdBarrier bar; bar.bar = (unsigned*)(ws + WS_CTL) + CW_BAR; bar.x = 0; bar.st = nullptr;
    if (!MK_LAUNCH_PER_PHASE) bar = xcd_barrier_post((unsigned*)(ws + WS_CTL) + CW_BAR, F.MISC + 8);
    const int lo = argp()->ph_lo, hi = argp()->ph_hi;
#ifndef DBG_KINDS
#define DBG_KINDS 0xFFFF
#endif
#define KON(kind) (((DBG_KINDS) >> (kind)) & 1)
#ifndef PROBE_REP
#define PROBE_REP 0
#endif
#define NREP(kind) ((((PROBE_REP) >> (kind)) & 1) ? 2 : 1)
#define IN(k) (lo <= (k) && (k) < hi)
#define SEAM(k) do { if (IN((k) + 1)) { if (MK_LAUNCH_PER_PHASE) { } else xcd_barrier(bar); } } while (0)
    LAS unsigned char* ring = F.lds + RING_OFF;
    const int bid = (int)blockIdx.x;
    h16* A = (h16*)(ws + WS_A); h16* Y = (h16*)(ws + WS_Y); h16* H = (h16*)(ws + WS_H); float* RS = (float*)(ws + WS_CTL + 512 * 1024);     h16* XQ = (h16*)(ws + WS_XQ); h16* ACT = (h16*)(ws + WS_ACT);

    if (KON(0) && IN(0)) { for (int rep = 0; rep < NREP(0); ++rep) { if (rep) xcd_barrier(bar); p0_prologue(F, argp()); } SEAM(0); }
    if (KON(1) && IN(1)) {
        { pg8::Gemm g{A, (const h16*)(ws + WS_WPOOL), T, D, 512, D, 1}; pg8::StaticOrder S; S.init(T, D, F.G, bid);
          pg8::EpiH16 E{Y, D, 1.0f, nullptr}; pg8::gemm_phase<pg8::EpiH16, pg8::StaticOrder, true, true>(ring, g, S, E); }
        __syncthreads();
        { pg8::Gemm g{(const h16*)(ws + WS_MEMN), (const h16*)(ws + WS_WKV), NB * NMEM, 2048, 2048, 2048, 31}; pg8::StaticOrder S; S.init(NB * NMEM, 2048, F.G, bid);
          pg8::EpiH16 E{(h16*)(ws + WS_KVM), 2048, 1.0f, nullptr}; pg8::gemm_phase<pg8::EpiH16, pg8::StaticOrder, true, true>(ring, g, S, E); }
        SEAM(1);
    }
#pragma unroll 1
    for (int L = 0; L < 2; ++L) {
        const int pb = L == 0 ? 2 : 14;
        if (L == 1) {
            if (KON(2) && IN(10)) {
                pg8::Gemm g{H, (const h16*)(ws + WS_WIN), T, DSA_NP, 2048, 2048, 31}; pg8::StaticOrder S; S.init(T, DSA_NP, F.G, bid);
                pg8::EpiInProj E{(h16*)(ws + WS_Q), (h16*)(ws + WS_KV), (h16*)(ws + WS_IQ), (h16*)(ws + WS_IK), (float*)(ws + WS_IW), (const float*)(ws + WS_ROPE), 1.0f / 64.0f, RS};
                for (int rep = 0; rep < NREP(2); ++rep) { if (rep) xcd_barrier(bar); pg8::gemm_phase<pg8::EpiInProj, pg8::StaticOrder, true, true>(ring, g, S, E); }
                SEAM(10);
            }
#if DBG_CHECK
            if (IN(11)) dbg_check_inproj(ws, (LAS float*)ring, (unsigned*)(ws + WS_CTL) + 1024);
#endif
            if (KON(3) && IN(11)) { for (int rep = 0; rep < NREP(3); ++rep) { if (rep) xcd_barrier(bar); if (IDX16 == 2) {
#ifdef PROBE_IDX
#pragma unroll 1
                for (int pass = 0; pass < 2; ++pass) indexer_phase5(F, (const h16*)(ws + WS_IQ), (const h16*)(ws + WS_IK), (const float*)(ws + WS_IW), (unsigned short*)(ws + WS_IDX), pass == 0 ? (float)(PROBE_IDX) : -__builtin_inff());
#else
                indexer_phase5(F, (const h16*)(ws + WS_IQ), (const h16*)(ws + WS_IK), (const float*)(ws + WS_IW), (unsigned short*)(ws + WS_IDX), -__builtin_inff());
#endif
                } else if (IDX16) indexer_phase16(F, (const h16*)(ws + WS_IQ), (const h16*)(ws + WS_IK), (const float*)(ws + WS_IW), (unsigned short*)(ws + WS_IDX)); else indexer_phase(F, (const h16*)(ws + WS_IQ), (const h16*)(ws + WS_IK), (const float*)(ws + WS_IW), (unsigned short*)(ws + WS_IDX), (u32x2*)(ws + WS_LISTS)); } SEAM(11); }
#if DBG_CHECK
            if (IN(12)) dbg_check_indexer(ws, (LAS float*)ring, (unsigned*)(ws + WS_CTL) + 1026, (unsigned*)(ws + WS_CTL) + 1028);
#endif
            if (KON(4) && IN(12)) { for (int rep = 0; rep < NREP(4); ++rep) { if (rep) xcd_barrier(bar); sparse_attn_phase(F, (const h16*)(ws + WS_Q), (const unsigned char*)(ws + WS_KV), (const unsigned char*)(ws + WS_KV) + (size_t)16 * 1024 * 1024, (const unsigned short*)(ws + WS_IDX), A, (unsigned*)(ws + WS_CTL) + 2048 + 512 * rep); } SEAM(12); }
#if DBG_CHECK
            if (IN(13)) dbg_check_sparse(ws, (LAS float*)ring, (unsigned*)(ws + WS_CTL) + 1027);
#endif
            if (KON(5) && IN(13)) {
                pg8::Gemm g{A, (const h16*)(ws + WS_WOUT), T, D, 2048, 2048, 31}; pg8::StaticOrder S; S.init(T, D, F.G, bid);
                pg8::EpiH16 E{Y, D, 1.0f, nullptr}; pg8::gemm_phase<pg8::EpiH16, pg8::StaticOrder, true, true>(ring, g, S, E);
                SEAM(13);
            }
        }
        if (KON(6) && IN(pb + 0)) { ArgP a = argp(); const float* gains = a->gains + (size_t)L * 6 * D;
            if (L == 0) seam_phase<true, false, true, false, true>(F, Y, a->x, H, gains + 1 * D, nullptr, nullptr, RS); else seam_phase<true, false, false, false, true>(F, Y, H, H, gains + 1 * D, nullptr, nullptr, RS);
            SEAM(pb + 0); }
        if (KON(7) && IN(pb + 1)) {
            pg8::Gemm g{H, (const h16*)(ws + WS_WQ) + (size_t)L * XW * 2048, T, XW, 2048, 2048, 31}; pg8::StaticOrder S; S.init(T, XW, F.G, bid);
            pg8::EpiH16 E{XQ, XW, 1.0f, RS}; pg8::gemm_phase<pg8::EpiH16, pg8::StaticOrder, true, true>(ring, g, S, E);
            SEAM(pb + 1);
        }
        if (KON(8) && IN(pb + 2)) { xattn_phase(F, XQ, (const h16*)(ws + WS_KVM) + L * 1024); SEAM(pb + 2); }
#if DBG_CHECK
        if (IN(pb + 3)) dbg_check_xattn(ws, L, (LAS float*)ring, (unsigned*)(ws + WS_CTL) + 1025);
#endif
        if (KON(9) && IN(pb + 3)) {
            pg8::Gemm g{XQ, (const h16*)(ws + WS_WO) + (size_t)L * 2048 * XW, T, D, XW, XW, 31}; pg8::StaticOrder S; S.init(T, D, F.G, bid);
            pg8::EpiH16 E{Y, D, 1.0f, nullptr}; pg8::gemm_phase<pg8::EpiH16, pg8::StaticOrder, true, true>(ring, g, S, E);
            SEAM(pb + 3);
        }
        if (KON(10) && IN(pb + 4)) { ArgP a = argp(); const float* gains = a->gains + (size_t)L * 6 * D;
            if ((FFN_FP8 >> L) & 1) seam_phase<true, true, false, false>(F, Y, H, H, gains + 3 * D, gains + 4 * D, A); else seam_phase<true, false, false, false, true>(F, Y, H, H, gains + 3 * D, nullptr, nullptr, RS);
            SEAM(pb + 4); }
        static_assert(DN_FP8 == 3, "the fp16 gate|up GEMM reads the residual stream with a row factor in its e4m3 epilogue: every layer's down projection is e4m3");
        static_assert((FFN_FP8 & ~DN_FP8) == 0, "an e4m3 gate|up GEMM writes e4m3 activations: its down projection must be e4m3 too");
        if (KON(11) && IN(pb + 5) && ((FFN_FP8 >> L) & 1)) {
            pg8::Gemm g{A, (const h16*)(ws + WS_WGU) + (size_t)L * 2 * DFF * 2048  , T, 2 * DFF, 1024, 1024, 31}; pg8::StaticOrder S; S.init(T, 2 * DFF, F.G, bid);
            pg8::EpiSwiGLU8 E{(unsigned char*)ACT, DFF, 1.0f / W8_SCALE, ACT8_SCALE, nullptr}; pg8::gemm_phase<pg8::EpiSwiGLU8, pg8::StaticOrder, true, true, true>(ring, g, S, E);
            SEAM(pb + 5);
        }
        if (KON(11) && IN(pb + 5) && !((FFN_FP8 >> L) & 1) && ((DN_FP8 >> L) & 1)) {
            pg8::Gemm g{H, (const h16*)(ws + WS_WGU) + (size_t)L * 2 * DFF * 2048, T, 2 * DFF, 2048, 2048, 31}; pg8::StaticOrder S; S.init(T, 2 * DFF, F.G, bid);
            pg8::EpiSwiGLU8 E{(unsigned char*)ACT, DFF, 1.0f, ACT8_SCALE, RS}; pg8::gemm_phase<pg8::EpiSwiGLU8, pg8::StaticOrder, true, true, false>(ring, g, S, E);
            SEAM(pb + 5);
        }
        if (KON(11) && IN(pb + 5) && !((FFN_FP8 >> L) & 1) && !((DN_FP8 >> L) & 1)) {
            pg8::Gemm g{A, (const h16*)(ws + WS_WGU) + (size_t)L * 2 * DFF * 2048, T, 2 * DFF, 2048, 2048, 31}; pg8::StaticOrder S; S.init(T, 2 * DFF, F.G, bid);
            pg8::EpiSwiGLU E{ACT, DFF}; pg8::gemm_phase<pg8::EpiSwiGLU, pg8::StaticOrder, true, true>(ring, g, S, E);
            SEAM(pb + 5);
        }
        if (KON(12) && IN(pb + 6) && ((DN_FP8 >> L) & 1)) {
            pg8::Gemm g{ACT, (const h16*)(ws + WS_WDN) + (size_t)L * 2048 * DFF  , T, D, DFF / 2, DFF / 2, 31}; pg8::StaticOrder S; S.init(T, D, F.G, bid);
            pg8::EpiH16 E{Y, D, 1.0f / (W8_SCALE * ACT8_SCALE), nullptr}; pg8::gemm_phase<pg8::EpiH16, pg8::StaticOrder, true, true, true>(ring, g, S, E);
            SEAM(pb + 6);
        }
        if (KON(12) && IN(pb + 6) && !((DN_FP8 >> L) & 1)) {
            pg8::Gemm g{ACT, (const h16*)(ws + WS_WDN) + (size_t)L * 2048 * DFF, T, D, DFF, DFF, 31}; pg8::StaticOrder S; S.init(T, D, F.G, bid);
            pg8::EpiH16 E{Y, D, 1.0f, nullptr}; pg8::gemm_phase<pg8::EpiH16, pg8::StaticOrder, true, true>(ring, g, S, E);
            SEAM(pb + 6);
        }
        if (KON(13) && IN(pb + 7)) {
            ArgP a = argp(); const float* gains = a->gains + (size_t)L * 6 * D;
            if (L == 0) seam_phase<true, false, false, false, true>(F, Y, H, H, gains + 5 * D, nullptr, nullptr, RS);
            else seam_phase<false, false, false, true>(F, Y, H, a->out, gains + 5 * D, nullptr, nullptr);
            SEAM(pb + 7);
        }
    }
#if DBG_CHECK
    if (IN(22)) {
        const unsigned* dw = (const unsigned*)(ws + WS_CTL) + 1024;
        const bool f0 = __builtin_bit_cast(float, dw[0]) > 4e-3f, f1 = __builtin_bit_cast(float, dw[1]) > 2e-2f, f2 = dw[2] > 24u, f3 = __builtin_bit_cast(float, dw[3]) > 2e-2f, f4 = dw[4] > 0u;
        for (int m = F.vcu * NWAVES + F.wave; m < T; m += F.G * NWAVES) { const int r = m & 15;
            const bool z = (r < 8 && f0) || (r >= 8 && r < 12 && f1) || (r >= 12 && r < 14 && f2) || (r == 14 && f3) || (r == 15 && f4);
            if (z) for (int j = 0; j < 8; ++j) ((f32x4*)(argp()->out + (size_t)m * D))[F.lane + 64 * j] = (f32x4){0.f, 0.f, 0.f, 0.f}; }
    }
#endif
#undef IN
#undef SEAM
}

extern "C" void kernel_launch(void* const* d_in, const int* in_sizes, int n_in, void* d_out, int out_size, void* d_ws, size_t ws_size, hipStream_t stream) {
    static int grid = 0;
    if (grid == 0) {
        if (n_in != 14 || in_sizes[0] != T * D || out_size != T * D || ws_size < WS_END) {
            fprintf(stderr, "kernel_launch: built for 14 inputs, x/out of %d floats, >= %zu bytes of workspace; got n_in %d, in0 %d, out %d, ws %zu; nothing launched\n", T * D, (size_t)WS_END, n_in, n_in > 0 ? in_sizes[0] : -1, out_size, ws_size);
            grid = -1; return; }
        int dev = 0, cus = 0, per_cu = 0;
        if (hipGetDevice(&dev) != hipSuccess || hipDeviceGetAttribute(&cus, hipDeviceAttributeMultiprocessorCount, dev) != hipSuccess) { fprintf(stderr, "kernel_launch: device query failed\n"); grid = -1; return; }
        if (hipFuncSetAttribute((const void*)trunk_fwd, hipFuncAttributeMaxDynamicSharedMemorySize, LDS_BYTES) != hipSuccess) { fprintf(stderr, "kernel_launch: hipFuncSetAttribute failed\n"); grid = -1; return; }
        if (hipOccupancyMaxActiveBlocksPerMultiprocessor(&per_cu, (const void*)trunk_fwd, NWAVES * 64, LDS_BYTES) != hipSuccess || per_cu < 1)
            fprintf(stderr, "kernel_launch: note: occupancy query reports %d workgroups per CU\n", per_cu);
        (void)hipGetLastError();
        grid = cus;
    }
    if (grid < 0) return;
    if (hipMemsetAsync((char*)d_ws + WS_CTL, 0, CTL_ZERO_BYTES, stream) != hipSuccess) { fprintf(stderr, "kernel_launch: memset failed\n"); return; }
    Args a{};
    a.x = (const float*)d_in[0]; a.mem = (const float*)d_in[1]; a.pos = (const int*)d_in[2]; a.gains = (const float*)d_in[3]; a.mem_norm = (const float*)d_in[4];
    a.pool_w = (const float*)d_in[5]; a.pool_scale = (const float*)d_in[6]; a.w_in = (const float*)d_in[7]; a.w_out = (const float*)d_in[8]; a.wq = (const float*)d_in[9];
    a.wkv = (const float*)d_in[10]; a.wo = (const float*)d_in[11]; a.wgu = (const float*)d_in[12]; a.wdn = (const float*)d_in[13];
    a.out = (float*)d_out; a.ws = (unsigned char*)d_ws;
    for (int i = 0; i < 16; ++i) a.inv_freq[i] = (float)pow(500000.0, -(double)(2 * i) / 32.0);
    a.pad = 0;
#if MK_LAUNCH_PER_PHASE
    for (int p = 0; p < N_PHASES; ++p) { a.ph_lo = p; a.ph_hi = p + 1; a.li = p;
        hipLaunchKernelGGL(trunk_fwd, dim3(grid), dim3(NWAVES * 64), LDS_BYTES, stream, a); }
#else
    a.ph_lo = 0; a.ph_hi = N_PHASES; a.li = 0;
    hipLaunchKernelGGL(trunk_fwd, dim3(grid), dim3(NWAVES * 64), LDS_BYTES, stream, a);
#endif
    const hipError_t le = hipPeekAtLastError();
    if (le != hipSuccess) fprintf(stderr, "kernel_launch: launch failed: %s\n", hipGetErrorName(le));
}
```

```cpp
#include <hip/hip_runtime.h>
#include <cstdio>
#include <cstdint>
#include <cmath>

#define LAS __attribute__((address_space(3)))
#define GAS __attribute__((address_space(1)))
typedef _Float16 h16;
typedef _Float16 half8 __attribute__((ext_vector_type(8)));
typedef _Float16 half4 __attribute__((ext_vector_type(4)));
typedef _Float16 half2v __attribute__((ext_vector_type(2)));
typedef float f32x4 __attribute__((ext_vector_type(4)));
typedef float f32x2 __attribute__((ext_vector_type(2)));
__device__ __forceinline__ f32x2 ix5_pkadd(f32x2 a, f32x2 b) { f32x2 r; asm("v_pk_add_f32 %0, %1, %2" : "=v"(r) : "v"(a), "v"(b)); return r; }
typedef float f32x16 __attribute__((ext_vector_type(16)));
typedef unsigned u32x4 __attribute__((ext_vector_type(4)));
typedef unsigned u32x2 __attribute__((ext_vector_type(2)));
typedef int v4i32 __attribute__((ext_vector_type(4)));
typedef int v8i32 __attribute__((ext_vector_type(8)));
typedef int v2i32 __attribute__((ext_vector_type(2)));

__device__ __forceinline__ unsigned pkh(float a, float b) { half2v v; v.x = (h16)a; v.y = (h16)b; return __builtin_bit_cast(unsigned, v); }

__device__ __forceinline__ unsigned pk8(float a, float b, float c, float d) { int w = __builtin_amdgcn_cvt_pk_fp8_f32(a, b, 0, false); w = __builtin_amdgcn_cvt_pk_fp8_f32(c, d, w, true); return (unsigned)w; }

constexpr int SEQ = 16384, NKV = 4, HD = 128;
namespace pg8 {
#define PG8_LAS __attribute__((address_space(3)))
constexpr int BM = 256, BK = 64, HALF = 128, HTB = HALF * BK * 2  , STAGE_BYTES = 8 * HTB, NXCD = 8, WGM = 8;

__host__ __device__ __forceinline__ int lds_byte(int r, int c) { const int st = (r >> 4) * 2 + (c >> 5), rr = r & 15, cc = c & 31, ob = rr * 64 + cc * 2; return st * 1024 + (ob ^ (((ob >> 9) & 1) << 5)); }
__host__ __device__ __forceinline__ void stage_rc(int b, int& R, int& C) { const int st = b / 1024, sb = b % 1024, swz = sb ^ (((sb >> 9) & 1) << 5); R = (st >> 1) * 16 + swz / 64; C = (st & 1) * 32 + (swz % 64) / 2; }
__host__ __device__ __forceinline__ int perm32(int rho) { const int n = rho >> 4, i = rho & 15; return 8 * (i >> 2) + 4 * n + (i & 3); }

struct Unit { int pm, pn; };
struct Gemm { const h16* A; const h16* Bt; int M, N, K, lda, kshift; };

struct StaticOrder {
    int nM, nN, nwg, G, c;
    __host__ __device__ void init(int M, int N, int G_, int c_) { nM = M / BM; nN = N / BM; nwg = nM * nN; G = G_; c = c_; }
    __host__ __device__ bool next(int i, Unit& u) const {
        const long L = (long)i * G + c; if (L >= nwg) return false;
        int wgid = (int)L; { const int q = nwg / NXCD, r = nwg % NXCD, xcd = wgid % NXCD, off = wgid / NXCD; wgid = (xcd < r ? xcd * (q + 1) : r * (q + 1) + (xcd - r) * q) + off; }
        const int nig = WGM * nN, gid = wgid / nig, fm = gid * WGM, gsz = (nM - fm) < WGM ? (nM - fm) : WGM;
        u.pm = fm + ((wgid % nig) % gsz); u.pn = (wgid % nig) / gsz; return true;
    }
    __device__ __forceinline__ void a_ready(const Unit&) const {}
    __device__ __forceinline__ void done(const Unit&) const {}
};

struct EpiF32 {
    static constexpr bool PERM = false, AFTER_DRAIN = false;
    float* C; int ldc; float scale;
    __device__ __forceinline__ void operator()(const f32x4 (&acc)[2][2][4][2], const Unit& u, int wr, int wc, int fr, int fq) const {
        const int row0 = u.pm * BM + wr * 64 + fr, col0 = u.pn * BM + wc * 32 + 4 * fq;
#pragma unroll
        for (int ai = 0; ai < 2; ++ai)
#pragma unroll
            for (int m = 0; m < 4; ++m) { float* rowp = C + (size_t)(row0 + ai * HALF + m * 16) * ldc + col0;
#pragma unroll
                for (int bj = 0; bj < 2; ++bj)
#pragma unroll
                    for (int n = 0; n < 2; ++n) *(f32x4*)(rowp + bj * HALF + n * 16) = acc[ai][bj][m][n] * scale; }
    }
};
struct EpiF32S {
    static constexpr bool PERM = false, AFTER_DRAIN = false;
    float* C; int ldc; float scale;
    __device__ __forceinline__ void operator()(const f32x4 (&acc)[2][2][4][2], const Unit& u, int wr, int wc, int fr_, int fq_) const {
        int l = (int)(threadIdx.x & 63u); asm volatile("" : "+v"(l)); const int fr = l & 15, fq = l >> 4;
        const int row0 = u.pm * BM + wr * 64 + fr, col0 = u.pn * BM + wc * 32 + 4 * fq;
#pragma unroll
        for (int ai = 0; ai < 2; ++ai)
#pragma unroll
            for (int m = 0; m < 4; ++m) { float* rowp = C + (size_t)(row0 + ai * HALF + m * 16) * ldc + col0;
#pragma unroll
                for (int bj = 0; bj < 2; ++bj)
#pragma unroll
                    for (int n = 0; n < 2; ++n) *(f32x4*)(rowp + bj * HALF + n * 16) = acc[ai][bj][m][n] * scale; }
    }
};
struct EpiH16 {
    static constexpr bool PERM = true, AFTER_DRAIN = false;
    h16* O; int ldc; float scale; const float* rs;
    __device__ __forceinline__ void operator()(const f32x4 (&acc)[2][2][4][2], const Unit& u, int wr, int wc, int fr, int fq) const {
        const int row0 = u.pm * BM + wr * 64 + fr, col0 = u.pn * BM + wc * 32 + 8 * fq;
#pragma unroll
        for (int ai = 0; ai < 2; ++ai)
#pragma unroll
            for (int m = 0; m < 4; ++m) { h16* rowp = O + (size_t)(row0 + ai * HALF + m * 16) * ldc + col0; const float sc_ = rs ? scale * rs[row0 + ai * HALF + m * 16] : scale;
#pragma unroll
                for (int bj = 0; bj < 2; ++bj) { const f32x4 v0 = acc[ai][bj][m][0] * sc_, v1 = acc[ai][bj][m][1] * sc_;
                    u32x4 w; w.x = pkh(v0[0], v0[1]); w.y = pkh(v0[2], v0[3]); w.z = pkh(v1[0], v1[1]); w.w = pkh(v1[2], v1[3]);
                    *(u32x4*)(rowp + bj * HALF) = w; } }
    }
};
__device__ __forceinline__ float silu_mul(float g, float u) { return g * u * __builtin_amdgcn_rcpf(1.0f + __builtin_amdgcn_exp2f(g * -1.44269504089f)); }
struct EpiSwiGLU {
    static constexpr bool PERM = true, AFTER_DRAIN = false;
    h16* O; int ldc;
    __device__ __forceinline__ void operator()(const f32x4 (&acc)[2][2][4][2], const Unit& u, int wr, int wc, int fr, int fq) const {
        const int row0 = u.pm * BM + wr * 64 + fr, col0 = u.pn * HALF + wc * 32 + 8 * fq;
#pragma unroll
        for (int ai = 0; ai < 2; ++ai)
#pragma unroll
            for (int m = 0; m < 4; ++m) { h16* rowp = O + (size_t)(row0 + ai * HALF + m * 16) * ldc + col0;
                const f32x4 g0 = acc[ai][0][m][0], g1 = acc[ai][0][m][1], u0 = acc[ai][1][m][0], u1 = acc[ai][1][m][1];
                u32x4 w; w.x = pkh(silu_mul(g0[0], u0[0]), silu_mul(g0[1], u0[1])); w.y = pkh(silu_mul(g0[2], u0[2]), silu_mul(g0[3], u0[3]));
                w.z = pkh(silu_mul(g1[0], u1[0]), silu_mul(g1[1], u1[1])); w.w = pkh(silu_mul(g1[2], u1[2]), silu_mul(g1[3], u1[3]));
                *(u32x4*)rowp = w; }
    }
};
struct EpiSwiGLU8 {
    static constexpr bool PERM = true, AFTER_DRAIN = false;
    unsigned char* O; int ldc; float inscale, outscale; const float* rs;
    __device__ __forceinline__ void operator()(const f32x4 (&acc)[2][2][4][2], const Unit& u, int wr, int wc, int fr_, int fq_) const {
        int l = (int)(threadIdx.x & 63u); asm volatile("" : "+v"(l)); const int fr = l & 15, fq = l >> 4;
        const int row0 = u.pm * BM + wr * 64 + fr, col0 = u.pn * HALF + wc * 32 + 8 * fq;
#pragma unroll
        for (int ai = 0; ai < 2; ++ai)
#pragma unroll
            for (int m = 0; m < 4; ++m) { unsigned char* rowp = O + (size_t)(row0 + ai * HALF + m * 16) * ldc + col0;
                const float is_ = rs ? inscale * rs[row0 + ai * HALF + m * 16] : inscale;
                const f32x4 g0 = acc[ai][0][m][0] * is_, g1 = acc[ai][0][m][1] * is_, u0 = acc[ai][1][m][0] * (is_ * outscale), u1 = acc[ai][1][m][1] * (is_ * outscale);
                u32x2 w; w.x = pk8(silu_mul(g0[0], u0[0]), silu_mul(g0[1], u0[1]), silu_mul(g0[2], u0[2]), silu_mul(g0[3], u0[3]));
                w.y = pk8(silu_mul(g1[0], u1[0]), silu_mul(g1[1], u1[1]), silu_mul(g1[2], u1[2]), silu_mul(g1[3], u1[3]));
                *(u32x2*)rowp = w; }
    }
};
struct EpiInProj {
    static constexpr bool PERM = true, AFTER_DRAIN = false;
    h16 *Q, *KV, *IQ, *IK; float* IW; const float* rope; float scale; const float* rs;
    __device__ __forceinline__ void operator()(const f32x4 (&acc)[2][2][4][2], const Unit& u, int wr, int wc, int fr_, int fq_) const {
        int l = (int)(threadIdx.x & 63u); asm volatile("" : "+v"(l));
        const int fr = l & 15, fq = l >> 4;
        const int pn = u.pn, row0 = u.pm * BM + wr * 64 + fr;
        h16* base; int ldc, colt; bool rot0 = true, rot1 = true;
        if (pn < 8) { base = Q; ldc = 2048; colt = pn * 256; }
        else if (pn < 10) { base = KV; ldc = 1024; colt = (pn - 8) * 256; }
        else if (pn < 12) { base = KV; ldc = 1024; colt = 512 + (pn - 10) * 256; rot0 = false; rot1 = false; }
        else if (pn < 20) { base = IQ; ldc = 2048; colt = (pn - 12) * 256; }
        else { base = IK; ldc = 128; colt = 0; rot1 = false; }
        const int col0 = colt + wc * 32 + 8 * fq;
#pragma unroll
        for (int ai = 0; ai < 2; ++ai)
#pragma unroll
            for (int m = 0; m < 4; ++m) { const int row = row0 + ai * HALF + m * 16;
                f32x4 cs[2], sn[2];
                if (wc == 0) { const float* rp = rope + (size_t)row * 32 + 8 * (fq & 1);
                    cs[0] = *(const f32x4*)(rp); cs[1] = *(const f32x4*)(rp + 4); sn[0] = *(const f32x4*)(rp + 16); sn[1] = *(const f32x4*)(rp + 20);
                    if (fq < 2) { sn[0] = -sn[0]; sn[1] = -sn[1]; } }
#pragma unroll
                for (int bj = 0; bj < 2; ++bj) {
                    const float sc_ = scale * rs[row];
                    f32x4 v0 = acc[ai][bj][m][0] * sc_, v1 = acc[ai][bj][m][1] * sc_;
                    if (wc == 0 && (bj == 0 ? rot0 : rot1)) {
                        f32x4 p0, p1;
#pragma unroll
                        for (int e = 0; e < 4; ++e) { p0[e] = __shfl_xor(v0[e], 32); p1[e] = __shfl_xor(v1[e], 32); }
                        v0 = v0 * cs[0] + p0 * sn[0]; v1 = v1 * cs[1] + p1 * sn[1];
                    }
                    if (pn >= 8 && pn < 12) {
                        const int j = ((pn - 8) & 1) * 2 + bj, b = row / SEQ, tt = row % SEQ;
                        unsigned char* dst = (unsigned char*)KV + (pn >= 10 ? (size_t)16 * 1024 * 1024 : (size_t)0) + ((size_t)(b * NKV + j) * SEQ + tt) * HD + wc * 32 + 8 * fq;
                        u32x2 w; w.x = pk8(v0[0], v0[1], v0[2], v0[3]); w.y = pk8(v1[0], v1[1], v1[2], v1[3]); *(u32x2*)dst = w;
                    } else if (pn == 20 && bj == 1) {
                        if (wc == 0 && fq < 2) { float* wp = IW + (size_t)row * 16 + 8 * fq; *(f32x4*)wp = v0; *(f32x4*)(wp + 4) = v1; }
                    } else if (pn < 8) {
                        const float c2 = 0.08838834764831845f * 1.44269504089f;
                        v0 = v0 * c2; v1 = v1 * c2;
                        u32x4 w; w.x = pk8(v0[0], v0[1], v0[2], v0[3]); w.y = pk8(v1[0], v1[1], v1[2], v1[3]);
                        w.z = pk8(v0[0] - __builtin_amdgcn_cvt_f32_fp8((int)w.x, 0), v0[1] - __builtin_amdgcn_cvt_f32_fp8((int)w.x, 1), v0[2] - __builtin_amdgcn_cvt_f32_fp8((int)w.x, 2), v0[3] - __builtin_amdgcn_cvt_f32_fp8((int)w.x, 3));
                        w.w = pk8(v1[0] - __builtin_amdgcn_cvt_f32_fp8((int)w.y, 0), v1[1] - __builtin_amdgcn_cvt_f32_fp8((int)w.y, 1), v1[2] - __builtin_amdgcn_cvt_f32_fp8((int)w.y, 2), v1[3] - __builtin_amdgcn_cvt_f32_fp8((int)w.y, 3));
                        *(u32x4*)(base + (size_t)row * ldc + col0 + bj * HALF) = w;
                    } else {
                        u32x4 w; w.x = pkh(v0[0], v0[1]); w.y = pkh(v0[2], v0[3]); w.z = pkh(v1[0], v1[1]); w.w = pkh(v1[2], v1[3]);
                        *(u32x4*)(base + (size_t)row * ldc + col0 + bj * HALF) = w;
                    }
                }
                asm volatile("" ::: "memory"); }
    }
};

template <class Epi, class Sched, bool ALIGN_EPI = false, bool SP2 = false, bool FP8 = false>
__device__ __forceinline__ void gemm_phase(PG8_LAS unsigned char* lds, const Gemm g, const Sched& S, const Epi& E) {
    int tid_ = (int)threadIdx.x; asm volatile("" : "+v"(tid_));
    const int tid = tid_, wid = __builtin_amdgcn_readfirstlane(tid >> 6), lane = tid & 63, wr = wid >> 2, wc = wid & 3, fr = lane & 15, fq = lane >> 4;
    const int K = g.K, nt = K / BK;
    unsigned voffA[2], voffB[2];
#pragma unroll
    for (int i = 0; i < 2; ++i) { int R, C; stage_rc(tid * 16 + i * 8192, R, C); const int Rb = Epi::PERM ? ((R & ~31) + perm32(R & 31)) : R;
        voffA[i] = (unsigned)(R * g.lda + C) * 2u; voffB[i] = (unsigned)(Rb * K + C) * 2u; }
    const size_t kstep = (size_t)(BK * 2);
    const size_t hstepA = (size_t)HALF * g.lda * 2, hstepB = (size_t)HALF * K * 2;
    const size_t tstepA = 2 * hstepA, tstepB = 2 * hstepB;
    const int kshift = g.kshift;
    const __amdgpu_buffer_rsrc_t rsrcA = __builtin_amdgcn_make_buffer_rsrc((void*)g.A, 0, 0x7fffffff, 0x00020000), rsrcB = __builtin_amdgcn_make_buffer_rsrc((void*)g.Bt, 0, 0x7fffffff, 0x00020000);
    const unsigned r64A = 64u * (unsigned)g.lda * 2u, r64B = 64u * (unsigned)K * 2u;
    const unsigned ldsw = (unsigned)wid * 1024u;
    const int aoff = lds_byte(wr * 64 + fr, fq * 8), boff = lds_byte(wc * 32 + fr, fq * 8);
#define PG8_SA(b, h) (((b) * 2 + (h)) * HTB)
#define PG8_SB(b, h) ((4 + (b) * 2 + (h)) * HTB)
#define PG8_STAGE(bufoff, gbase, voff) do { const bool isA_ = (const void*)(voff) == (const void*)voffA; _Pragma("unroll") for (int _i = 0; _i < 2; ++_i) \
        __builtin_amdgcn_raw_ptr_buffer_load_lds(isA_ ? rsrcA : rsrcB, (PG8_LAS void*)(lds + (bufoff) + ldsw + _i * 8192), 16, (int)(voff)[0], \
            (int)((unsigned)((const char*)(gbase) - (isA_ ? (const char*)g.A : (const char*)g.Bt)) + (unsigned)_i * (isA_ ? r64A : r64B)), 0, 0); } while (0)
#define PG8_LDA(dst, b, h) do { if constexpr (FP8) { _Pragma("unroll") for (int m = 0; m < 4; ++m) dst##8[m] = __builtin_shufflevector(*(const PG8_LAS v4i32*)(lds + PG8_SA(b, h) + aoff + m * 2048), *(const PG8_LAS v4i32*)(lds + PG8_SA(b, h) + aoff + m * 2048 + 1024), 0, 1, 2, 3, 4, 5, 6, 7); } \
    else { _Pragma("unroll") for (int m = 0; m < 4; ++m) _Pragma("unroll") for (int k = 0; k < 2; ++k) dst[m][k] = *(const PG8_LAS half8*)(lds + PG8_SA(b, h) + aoff + m * 2048 + k * 1024); } } while (0)
#define PG8_LDB(dst, b, h) do { if constexpr (FP8) { _Pragma("unroll") for (int n = 0; n < 2; ++n) dst##8[n] = __builtin_shufflevector(*(const PG8_LAS v4i32*)(lds + PG8_SB(b, h) + boff + n * 2048), *(const PG8_LAS v4i32*)(lds + PG8_SB(b, h) + boff + n * 2048 + 1024), 0, 1, 2, 3, 4, 5, 6, 7); } \
    else { _Pragma("unroll") for (int n = 0; n < 2; ++n) _Pragma("unroll") for (int k = 0; k < 2; ++k) dst[n][k] = *(const PG8_LAS half8*)(lds + PG8_SB(b, h) + boff + n * 2048 + k * 1024); } } while (0)
#define PG8_MMA(ai, bj, At, Bt) do { __builtin_amdgcn_s_setprio(1); _Pragma("unroll") for (int m = 0; m < 4; ++m) _Pragma("unroll") for (int n = 0; n < 2; ++n) { \
        if constexpr (FP8) asm volatile("v_mfma_f32_16x16x128_f8f6f4 %0, %1, %2, %0" : "+v"(acc[ai][bj][m][n]) : "v"(Bt##8[n]), "v"(At##8[m]));     \
        else { _Pragma("unroll") for (int k = 0; k < 2; ++k) acc[ai][bj][m][n] = __builtin_amdgcn_mfma_f32_16x16x32_f16(Bt[n][k], At[m][k], acc[ai][bj][m][n], 0, 0, 0); } } \
        __builtin_amdgcn_s_setprio(0); } while (0)
#define PG8_WAIT_V(n) asm volatile("s_waitcnt vmcnt(" #n ")" ::: "memory")
#define PG8_WAIT_L(n) asm volatile("s_waitcnt lgkmcnt(" #n ")" ::: "memory")
#define PG8_BAR __builtin_amdgcn_s_barrier()
#define PG8_SCHED __builtin_amdgcn_sched_barrier(0)
    Unit cur, nxt; int ui = 0;
    if (!S.next(0, cur)) return;
    f32x4 acc[2][2][4][2];
#pragma unroll
    for (int a = 0; a < 2; ++a)
#pragma unroll
        for (int b = 0; b < 2; ++b)
#pragma unroll
            for (int m = 0; m < 4; ++m)
#pragma unroll
                for (int n = 0; n < 2; ++n) acc[a][b][m][n] = (f32x4){0.f, 0.f, 0.f, 0.f};
    half8 At[4][2], B0[2][2], B1[2][2]; v8i32 At8[4], B08[2], B18[2];
    const char* cA = (const char*)g.A + (size_t)cur.pm * tstepA + (size_t)((cur.pn >> kshift) * K) * 2; const char* cB = (const char*)g.Bt + (size_t)cur.pn * tstepB;
    S.a_ready(cur);
    if constexpr (SP2) {
        PG8_STAGE(PG8_SB(0, 0), cB, voffB); PG8_STAGE(PG8_SB(0, 1), cB + hstepB, voffB); PG8_STAGE(PG8_SA(0, 0), cA, voffA); PG8_STAGE(PG8_SA(0, 1), cA + hstepA, voffA);
        if (wr == 1) PG8_BAR;
        PG8_WAIT_V(2); PG8_BAR;
        PG8_STAGE(PG8_SB(1, 0), cB + kstep, voffB); PG8_STAGE(PG8_SA(1, 0), cA + kstep, voffA); PG8_STAGE(PG8_SB(1, 1), cB + hstepB + kstep, voffB);
        PG8_WAIT_V(6); PG8_BAR;
    } else {
        PG8_STAGE(PG8_SB(0, 0), cB, voffB); PG8_STAGE(PG8_SA(0, 0), cA, voffA); PG8_STAGE(PG8_SB(0, 1), cB + hstepB, voffB); PG8_STAGE(PG8_SA(0, 1), cA + hstepA, voffA);
        if (wr == 1) PG8_BAR;
        PG8_WAIT_V(4); PG8_BAR;
        PG8_STAGE(PG8_SB(1, 0), cB + kstep, voffB); PG8_STAGE(PG8_SA(1, 0), cA + kstep, voffA); PG8_STAGE(PG8_SB(1, 1), cB + hstepB + kstep, voffB);
        PG8_WAIT_V(6); PG8_BAR;
    }
    for (;;) {
        const bool has_next = S.next(ui + 1, nxt);
        const char* nA = has_next ? (const char*)g.A + (size_t)nxt.pm * tstepA + (size_t)((nxt.pn >> kshift) * K) * 2 : cA; const char* nB = has_next ? (const char*)g.Bt + (size_t)nxt.pn * tstepB : cB;
        for (int t = 0; t < nt; t += 2) {
            const bool last = (t == nt - 2);
            const char* a1 = cA + (size_t)(t + 1) * kstep;
            const char* a2 = last ? nA : cA + (size_t)(t + 2) * kstep; const char* b2 = last ? nB : cB + (size_t)(t + 2) * kstep;
            const char* a3 = a2 + kstep; const char* b3 = b2 + kstep;
            if (last && has_next) S.a_ready(nxt);
            if constexpr (SP2) {
            PG8_LDB(B0, 0, 0); PG8_LDB(B1, 0, 1); PG8_SCHED; PG8_LDA(At, 0, 0); PG8_STAGE(PG8_SA(1, 1), a1 + hstepA, voffA);
            PG8_WAIT_V(8); PG8_WAIT_L(0); PG8_BAR; PG8_MMA(0, 0, At, B0); PG8_MMA(0, 1, At, B1); PG8_BAR; PG8_SCHED;
            PG8_LDA(At, 0, 1); PG8_STAGE(PG8_SB(0, 0), b2, voffB); PG8_STAGE(PG8_SB(0, 1), b2 + hstepB, voffB); PG8_STAGE(PG8_SA(0, 0), a2, voffA);
            PG8_WAIT_V(8); PG8_WAIT_L(0); PG8_BAR; PG8_MMA(1, 0, At, B0); PG8_MMA(1, 1, At, B1); PG8_BAR; PG8_SCHED;
            PG8_LDB(B0, 1, 0); PG8_LDB(B1, 1, 1); PG8_SCHED; PG8_LDA(At, 1, 0); PG8_STAGE(PG8_SA(0, 1), a2 + hstepA, voffA);
            PG8_WAIT_V(8); PG8_WAIT_L(0); PG8_BAR; PG8_MMA(0, 0, At, B0); PG8_MMA(0, 1, At, B1); PG8_BAR; PG8_SCHED;
            PG8_LDA(At, 1, 1); PG8_STAGE(PG8_SB(1, 0), b3, voffB); PG8_STAGE(PG8_SB(1, 1), b3 + hstepB, voffB); PG8_STAGE(PG8_SA(1, 0), a3, voffA);
            PG8_WAIT_V(8); PG8_WAIT_L(0); PG8_BAR; PG8_MMA(1, 0, At, B0); PG8_MMA(1, 1, At, B1); PG8_BAR; PG8_SCHED;
            } else {
            PG8_LDB(B0, 0, 0); PG8_SCHED; PG8_LDA(At, 0, 0); PG8_STAGE(PG8_SA(1, 1), a1 + hstepA, voffA);
            PG8_WAIT_L(8); PG8_BAR; PG8_WAIT_L(0); PG8_MMA(0, 0, At, B0); PG8_BAR; PG8_SCHED;
            PG8_LDB(B1, 0, 1); PG8_STAGE(PG8_SB(0, 0), b2, voffB);
            PG8_BAR; PG8_WAIT_L(0); PG8_MMA(0, 1, At, B1); PG8_BAR;
            PG8_LDA(At, 0, 1); PG8_STAGE(PG8_SA(0, 0), a2, voffA);
            PG8_BAR; PG8_WAIT_L(0); PG8_MMA(1, 0, At, B0); PG8_BAR; PG8_SCHED;
            PG8_STAGE(PG8_SB(0, 1), b2 + hstepB, voffB);
            PG8_WAIT_V(6); PG8_BAR; PG8_MMA(1, 1, At, B1); PG8_BAR;
            PG8_LDB(B0, 1, 0); PG8_SCHED; PG8_LDA(At, 1, 0); PG8_STAGE(PG8_SA(0, 1), a2 + hstepA, voffA);
            PG8_WAIT_L(8); PG8_BAR; PG8_WAIT_L(0); PG8_MMA(0, 0, At, B0); PG8_BAR; PG8_SCHED;
            PG8_LDB(B1, 1, 1); PG8_STAGE(PG8_SB(1, 0), b3, voffB);
            PG8_BAR; PG8_WAIT_L(0); PG8_MMA(0, 1, At, B1); PG8_BAR;
            PG8_LDA(At, 1, 1); PG8_STAGE(PG8_SA(1, 0), a3, voffA);
            PG8_BAR; PG8_WAIT_L(0); PG8_MMA(1, 0, At, B0); PG8_BAR; PG8_SCHED;
            PG8_STAGE(PG8_SB(1, 1), b3 + hstepB, voffB);
            PG8_WAIT_V(6); PG8_BAR; PG8_MMA(1, 1, At, B1); PG8_BAR;
            }
        }
        if constexpr (FP8) { asm volatile("s_nop 15\n\ts_nop 15\n\ts_nop 15\n\ts_nop 15" ::: "memory"); __builtin_amdgcn_sched_barrier(0); }
        if constexpr (ALIGN_EPI) { if (wr == 0) PG8_BAR; }
        if constexpr (!Epi::AFTER_DRAIN) { E(acc, cur, wr, wc, fr, fq); S.done(cur); }
        if (!has_next) break;
#pragma unroll
        for (int a = 0; a < 2; ++a)
#pragma unroll
            for (int b = 0; b < 2; ++b)
#pragma unroll
                for (int m = 0; m < 4; ++m)
#pragma unroll
                    for (int n = 0; n < 2; ++n) acc[a][b][m][n] = (f32x4){0.f, 0.f, 0.f, 0.f};
        cur = nxt; cA = nA; cB = nB; ++ui;
        if constexpr (ALIGN_EPI) { if (wr == 1) PG8_BAR; }
    }
    PG8_WAIT_V(0);
    if constexpr (!ALIGN_EPI) { if (wr == 0) PG8_BAR; }
    PG8_BAR;

#undef PG8_SA
#undef PG8_SB
#undef PG8_STAGE
#undef PG8_LDA
#undef PG8_LDB
#undef PG8_MMA
#undef PG8_WAIT_V
#undef PG8_WAIT_L
#undef PG8_BAR
#undef PG8_SCHED
}
}

constexpr int NB = 2, T = NB * SEQ, D = 2048, DFF = 5632, NMEM = 256;
constexpr int DSA_N = 5264, DSA_NP = 5376;
constexpr int NHEAD = 16, TOPK = 256;
constexpr int XW = 512;
constexpr float NORM_EPS = 1e-6f;
constexpr int NWAVES = 8;
#ifndef FFN_FP8
#define FFN_FP8 2
#endif
#ifndef DN_FP8
#define DN_FP8 3
#endif
#ifndef IDX_PROBE_MMA
#define IDX_PROBE_MMA 0
#endif
#ifndef IDX16
#define IDX16 2
#endif
#ifndef MK_LAUNCH_PER_PHASE
#define MK_LAUNCH_PER_PHASE 0
#endif

constexpr size_t MiB = 1u << 20;
constexpr size_t WS_CTL = 0, CTL_ZERO_BYTES = 1 * MiB;
constexpr size_t WS_ROPE = 1 * MiB;
constexpr size_t WS_MEMN = 5 * MiB;
constexpr size_t WS_KVM = 7 * MiB;
constexpr size_t WS_WPOOL = 9 * MiB;
constexpr size_t WS_WIN = 11 * MiB;
constexpr size_t WS_WOUT = 32 * MiB;
constexpr size_t WS_WQ = 40 * MiB;
constexpr size_t WS_WKV = 44 * MiB;
constexpr size_t WS_WO = 52 * MiB;
constexpr size_t WS_WGU = 56 * MiB;
constexpr size_t WS_WDN = 144 * MiB;
constexpr size_t WS_XQ = 188 * MiB;
constexpr size_t WS_A = 220 * MiB;
constexpr size_t WS_Y = 348 * MiB;
constexpr size_t WS_ACT = 604 * MiB;
constexpr size_t WS_KVM4 = 956 * MiB;
constexpr size_t WS_END = 964 * MiB;
constexpr size_t WS_Q = WS_ACT, WS_KV = WS_ACT + 128 * MiB, WS_IQ = WS_ACT + 192 * MiB, WS_IK = WS_ACT + 320 * MiB, WS_IW = WS_ACT + 328 * MiB, WS_IDX = WS_ACT + 330 * MiB;
constexpr size_t WS_LISTS = WS_Y;
constexpr size_t WS_H = WS_Y + 128 * MiB;
constexpr int LIST_CAP = 1024;
static_assert(WS_IDX + (size_t)T * TOPK * 2 <= WS_END, "ws map");
constexpr float W8_SCALE = 64.0f, ACT8_SCALE = 8.0f;
constexpr int CW_BAR = 4096;

constexpr int RING_OFF = 0, RING_BYTES = 159744;
constexpr int MISC_OFF = RING_BYTES;
constexpr int LDS_BYTES = 163840;

typedef GAS unsigned gu32;
#define LDS_WAIT() asm volatile("s_waitcnt lgkmcnt(0)" ::: "memory")
#define VM_WAIT() asm volatile("s_waitcnt vmcnt(0)" ::: "memory")

#define XB_TMO      128
#define XB_XCNT(j)  (256  + 64 * (j))
#define XB_XSUB(j)  (1280 + 64 * (j))
#define XB_XGEN(j)  (2304 + 64 * (j))
#define XB_TOP      3328
#define XB_TOPGEN   3392
#define XCD_BAR_WORDS 3456
#define XB_SPIN_CAP (1u << 23)
__device__ __forceinline__ unsigned xb_ld(unsigned* p)              { return __hip_atomic_load(p, __ATOMIC_RELAXED, __HIP_MEMORY_SCOPE_AGENT); }
__device__ __forceinline__ unsigned xb_add(unsigned* p, unsigned v) { return __hip_atomic_fetch_add(p, v, __ATOMIC_RELAXED, __HIP_MEMORY_SCOPE_AGENT); }
__device__ __forceinline__ unsigned xb_xcc_id() { return (unsigned)__builtin_amdgcn_s_getreg((3 << 11) | 20) & 0xFu; }
#define XB_SPIN(cond, bar) do { unsigned _sp = 0; while (cond) { __builtin_amdgcn_s_sleep(1); \
    if ((++_sp & 255u) == 0u) { if (xb_ld(&(bar)[XB_TMO])) break; if (_sp > XB_SPIN_CAP) { atomicAdd(&(bar)[XB_TMO], 1u); break; } } } } while (0)
struct XcdBarrier { unsigned* bar; unsigned x; volatile LAS unsigned* st; };
__device__ __forceinline__ XcdBarrier xcd_barrier_post(unsigned* bar, volatile LAS unsigned* st) {
    XcdBarrier b; b.bar = bar; b.x = xb_xcc_id(); b.st = st;
    if (threadIdx.x == 0) (void)xb_add(&bar[XB_XCNT(b.x)], 1u);
    return b;
}
__device__ __forceinline__ void xcd_barrier_complete(unsigned* bar, unsigned x, unsigned& nloc, unsigned& nx) {
    const unsigned G = gridDim.x * gridDim.y * gridDim.z;
    unsigned sum, cnt, mine, sp = 0u;
    for (;;) {
        sum = 0u; cnt = 0u; mine = 0u;
#pragma unroll
        for (unsigned j = 0; j < 16; ++j) { const unsigned c = xb_ld(&bar[XB_XCNT(j)]); sum += c; cnt += (c > 0u) ? 1u : 0u; mine = (j == x) ? c : mine; }
        if (sum == G) break;
        __builtin_amdgcn_s_sleep(1);
        if ((++sp & 255u) == 0u) { if (xb_ld(&bar[XB_TMO])) break; if (sp > XB_SPIN_CAP) { atomicAdd(&bar[XB_TMO], 1u); break; } }
    }
    nloc = mine > 0u ? mine : 1u; nx = cnt > 0u ? cnt : 1u;
}
__device__ __forceinline__ void xcd_barrier(const XcdBarrier& b) {
    asm volatile("s_waitcnt vmcnt(0)" ::: "memory");
    __syncthreads();
    if (threadIdx.x == 0) {
        unsigned* bar = b.bar;
        __builtin_amdgcn_s_waitcnt(0);
        unsigned nloc = b.st[0], nx = b.st[1];
        if (nloc == 0u) { xcd_barrier_complete(bar, b.x, nloc, nx); b.st[0] = nloc; b.st[1] = nx; }
        const unsigned old = xb_add(&bar[XB_XSUB(b.x)], 1u);
        const unsigned gen = old / nloc;
        if (old + 1u == (gen + 1u) * nloc) {
            __builtin_amdgcn_fence(__ATOMIC_RELEASE, "agent");
            asm volatile("s_waitcnt vmcnt(0)" ::: "memory");
            const unsigned og = xb_add(&bar[XB_TOP], 1u);
            const unsigned tg = og / nx;
            if (og + 1u == (tg + 1u) * nx) xb_add(&bar[XB_TOPGEN], 1u);
            else XB_SPIN(xb_ld(&bar[XB_TOPGEN]) == tg, bar);
            __builtin_amdgcn_fence(__ATOMIC_ACQUIRE, "agent");
            xb_add(&bar[XB_XGEN(b.x)], 1u);
            asm volatile("s_waitcnt vmcnt(0)" ::: "memory");
        } else {
            XB_SPIN(xb_ld(&bar[XB_XGEN(b.x)]) == gen, bar);
            __builtin_amdgcn_fence(__ATOMIC_ACQUIRE, "agent");
            asm volatile("s_waitcnt vmcnt(0)" ::: "memory");
        }
    }
    __syncthreads();
}

struct Frame {
    LAS unsigned char* lds;
    volatile LAS unsigned* MISC;
    int tid, lane, wave;
    int vcu, G;
};
__device__ __forceinline__ Frame fresh(const Frame& F0) { Frame F = F0; int t = (int)threadIdx.x; asm volatile("" : "+v"(t)); F.tid = t; F.lane = t & 63; F.wave = __builtin_amdgcn_readfirstlane(t >> 6); return F; }
template <int CTRL> __device__ __forceinline__ float dpp_mov(float v) { return __builtin_bit_cast(float, __builtin_amdgcn_update_dpp(0, __builtin_bit_cast(int, v), CTRL, 0xF, 0xF, true)); }
__device__ __forceinline__ float wave_sum_dpp(float v) {
    v += dpp_mov<0xB1>(v);
    v += dpp_mov<0x4E>(v);
    v += dpp_mov<0x141>(v);
    v += dpp_mov<0x140>(v);
    const float s0 = __builtin_bit_cast(float, __builtin_amdgcn_readlane(__builtin_bit_cast(int, v), 0)), s1 = __builtin_bit_cast(float, __builtin_amdgcn_readlane(__builtin_bit_cast(int, v), 16));
    const float s2 = __builtin_bit_cast(float, __builtin_amdgcn_readlane(__builtin_bit_cast(int, v), 32)), s3 = __builtin_bit_cast(float, __builtin_amdgcn_readlane(__builtin_bit_cast(int, v), 48));
    return (s0 + s1) + (s2 + s3);
}
__device__ __forceinline__ float max2(float a, float b) { float r; asm("v_max_f32 %0, %1, %2" : "=v"(r) : "v"(a), "v"(b)); return r; }
__device__ __forceinline__ float wave_max_dpp(float v) {
    v = max2(v, dpp_mov<0xB1>(v)); v = max2(v, dpp_mov<0x4E>(v)); v = max2(v, dpp_mov<0x141>(v)); v = max2(v, dpp_mov<0x140>(v));
    const float s0 = __builtin_bit_cast(float, __builtin_amdgcn_readlane(__builtin_bit_cast(int, v), 0)), s1 = __builtin_bit_cast(float, __builtin_amdgcn_readlane(__builtin_bit_cast(int, v), 16));
    const float s2 = __builtin_bit_cast(float, __builtin_amdgcn_readlane(__builtin_bit_cast(int, v), 32)), s3 = __builtin_bit_cast(float, __builtin_amdgcn_readlane(__builtin_bit_cast(int, v), 48));
    return max2(max2(s0, s1), max2(s2, s3));
}
__device__ __forceinline__ float wave_sum(float v) {
#pragma unroll
    for (int o = 1; o < 64; o <<= 1) v += __shfl_xor(v, o);
    return v;
}
__device__ __forceinline__ float rstd_of(float sumsq) { return 1.0f / sqrtf(sumsq * (1.0f / D) + NORM_EPS); }

__device__ __forceinline__ void transpose_item(const float* W, int ldw, int K, int k0, int scol, int nvalid, h16* WT, int drow, float scale, const float* colscale, const float* kscale, bool f8, LAS float* scr, int lane) {
    const int cn = scol + (lane & 31); const bool okc = cn < nvalid;
    float wv[32];
#pragma unroll
    for (int i = 0; i < 32; ++i) { const int kk = 2 * i + (lane >> 5); wv[i] = W[(size_t)(k0 + kk) * ldw + (okc ? cn : 0)]; }
#pragma unroll
    for (int i = 0; i < 32; ++i) { const int kk = 2 * i + (lane >> 5); scr[kk * 33 + (lane & 31)] = okc ? (kscale ? wv[i] * kscale[k0 + kk] : wv[i]) : 0.f; }
    LDS_WAIT(); asm volatile("" ::: "memory");
    const int c = lane & 7;
#pragma unroll
    for (int j = 0; j < 4; ++j) { const int n = (lane >> 3) + 8 * j; const LAS float* s = scr + (8 * c) * 33 + n;
        float sc = scale; if (colscale) sc *= colscale[scol + n];
        if (f8) { u32x2 o; o.x = pk8(s[0 * 33] * sc, s[1 * 33] * sc, s[2 * 33] * sc, s[3 * 33] * sc); o.y = pk8(s[4 * 33] * sc, s[5 * 33] * sc, s[6 * 33] * sc, s[7 * 33] * sc);
            *(GAS u32x2*)((unsigned char*)WT + (size_t)(drow + n) * K + k0 + 8 * c) = o; }
        else { u32x4 o; o.x = pkh(s[0 * 33] * sc, s[1 * 33] * sc); o.y = pkh(s[2 * 33] * sc, s[3 * 33] * sc); o.z = pkh(s[4 * 33] * sc, s[5 * 33] * sc); o.w = pkh(s[6 * 33] * sc, s[7 * 33] * sc);
            *(GAS u32x4*)(WT + (size_t)(drow + n) * K + k0 + 8 * c) = o; } }
    LDS_WAIT(); asm volatile("" ::: "memory");
}
struct TJob { const float* W; h16* WT; const float* colscale; int ldw, K, nrows, nvalid, mode; float scale; const float* kscale; };
__device__ __forceinline__ int tjob_items(const TJob& j) { return (j.K / 64) * (j.nrows / 32); }
__device__ __forceinline__ void tjob_run(const TJob& j, int item, LAS float* scr, int lane) {
    const int nblk = j.nrows / 32, kb = item / nblk, r = 32 * (item % nblk);
    const int scol = (j.mode & 1) ? ((r >> 7) & 1) * DFF + 128 * (r >> 8) + (r & 127) : r;
    transpose_item(j.W, j.ldw, j.K, 64 * kb, scol, j.nvalid, j.WT, r, j.scale, j.colscale, j.kscale, (j.mode & 2) != 0, scr, lane);
}

struct Args {
    const float* x; const float* mem; const int* pos; const float* gains; const float* mem_norm; const float* pool_w; const float* pool_scale;
    const float* w_in; const float* w_out; const float* wq; const float* wkv; const float* wo; const float* wgu; const float* wdn;
    float* out; unsigned char* ws;
    float inv_freq[16];
    int ph_lo, ph_hi, li, pad;
};

#define CAS __attribute__((address_space(4)))
typedef const CAS Args* ArgP;
__device__ __forceinline__ ArgP argp() { unsigned long long p = (unsigned long long)__builtin_amdgcn_kernarg_segment_ptr(); asm volatile("" : "+s"(p)); return (ArgP)p; }

__device__ __forceinline__ void rope_entry(ArgP a, float* rope, int idx) {
    const int m = idx >> 4, i = idx & 15;
    const float angf = (float)a->pos[m] * a->inv_freq[i];
    const double ang = (double)angf;
    const double TWO_PI = 6.283185307179586476925286766559, INV_2PI = 0.15915494309189533576888376337251;
    const double k = __builtin_rint(ang * INV_2PI);
    const double r = ang - k * TWO_PI;
    const double r2 = r * r;
    double c = 1.0, s = 1.0, tc = 1.0, ts = 1.0;
#pragma unroll
    for (int n = 1; n <= 13; ++n) { tc *= -r2 / (double)((2 * n - 1) * (2 * n)); ts *= -r2 / (double)((2 * n) * (2 * n + 1)); c += tc; s += ts; }
    rope[(size_t)m * 32 + i] = (float)c; rope[(size_t)m * 32 + 16 + i] = (float)(s * r);
}
__device__ __forceinline__ void norm_row_to_h16(const float* xrow, const float* gain, h16* orow, int lane) {
    const f32x4* xr = (const f32x4*)xrow + lane; const f32x4* gr = (const f32x4*)gain + lane;
    f32x4 v[8]; float s = 0.f;
#pragma unroll
    for (int j = 0; j < 8; ++j) { v[j] = xr[64 * j]; s += (v[j].x * v[j].x + v[j].y * v[j].y) + (v[j].z * v[j].z + v[j].w * v[j].w); }
    const float r = rstd_of(wave_sum_dpp(s));
    u32x2* o8 = (u32x2*)orow + lane;
#pragma unroll
    for (int j = 0; j < 8; ++j) { const f32x4 g = gr[64 * j], y = v[j] * r * g; u32x2 w; w.x = pkh(y.x, y.y); w.y = pkh(y.z, y.w); o8[64 * j] = w; }
}
template <int W>
__device__ __forceinline__ void pool_window(const float* xb, const LAS float* rs, const f32x4 g, int t0, int c0, h16* Pb) {
    f32x4 ring[W];
#pragma unroll
    for (int j = 0; j < W; ++j) ring[j] = (f32x4){0.f, 0.f, 0.f, 0.f};
    f32x4 sum = {0.f, 0.f, 0.f, 0.f};
    const float icw = 1.0f / (float)W;
    constexpr int NIT = 64 + W - 1;
#pragma unroll 1
    for (int cb = 0; cb < (NIT + 15) / 16; ++cb) {
        f32x4 xv[16]; float rv[16];
#pragma unroll
        for (int j = 0; j < 16; ++j) { const int i = 16 * cb + j; const int ic_ = i < NIT ? i : NIT - 1; const int tt = t0 - (W - 1) + ic_, tc = tt > 0 ? tt : 0;
            xv[j] = *(const f32x4*)(xb + (size_t)tc * D + c0); rv[j] = rs[16 - W + ic_]; }
#pragma unroll
        for (int j = 0; j < 16; ++j) { const int i = 16 * cb + j; const int tt = t0 - (W - 1) + i;
            if (i < NIT) {
                f32x4 a = xv[j] * rv[j] * g; const bool ok = tt >= 0;
                a.x = ok ? a.x : 0.f; a.y = ok ? a.y : 0.f; a.z = ok ? a.z : 0.f; a.w = ok ? a.w : 0.f;
                sum += a; sum -= ring[j % W]; ring[j % W] = a;
                if (tt >= t0) { const float ic = (tt + 1) < W ? 1.0f / (float)(tt + 1) : icw; const f32x4 p = sum * ic - a;
                    u32x2 o; o.x = pkh(p.x, p.y); o.y = pkh(p.z, p.w); *(u32x2*)(Pb + (size_t)tt * D + c0) = o; } } }
    }
}
__device__ __forceinline__ void pool_pre(Frame& F0, const float* x, const float* g0, h16* P) {
    Frame F = fresh(F0);
    LAS float* rs = (LAS float*)(F.lds + RING_OFF);
    for (int u = F.vcu; u < T / 64; u += F.G) {
        const int b = u / (SEQ / 64), t0 = 64 * (u % (SEQ / 64));
        const float* xb = x + (size_t)b * SEQ * D;
        for (int r = F.wave; r < 79; r += NWAVES) { const int t = t0 - 15 + r;
            if (t >= 0) { const f32x4* xr = (const f32x4*)(xb + (size_t)t * D) + F.lane; float s = 0.f;
#pragma unroll
                for (int j = 0; j < 8; ++j) { const f32x4 v = xr[64 * j]; s += (v.x * v.x + v.y * v.y) + (v.z * v.z + v.w * v.w); }
                s = rstd_of(wave_sum_dpp(s)); if (F.lane == 0) rs[r] = s; } }
        __syncthreads();
        {
            const int c0 = 4 * F.tid, wsel = F.wave >> 1;
            const f32x4 g = *(const f32x4*)(g0 + c0);
            h16* Pb = P + (size_t)b * SEQ * D;
            if (wsel == 0) pool_window<2>(xb, rs, g, t0, c0, Pb); else if (wsel == 1) pool_window<4>(xb, rs, g, t0, c0, Pb); else if (wsel == 2) pool_window<8>(xb, rs, g, t0, c0, Pb); else pool_window<16>(xb, rs, g, t0, c0, Pb);
        }
        __syncthreads();
    }
}
__device__ __forceinline__ void p0_prologue(Frame& F0, ArgP a) {
    Frame F = fresh(F0);
    unsigned char* ws = a->ws;
    LAS float* scr = (LAS float*)(F.lds + RING_OFF + F.wave * 16384);
    const int gw = F.vcu * NWAVES + F.wave, NGW = F.G * NWAVES;
    constexpr int I_POOL = (512 / 64) * (512 / 32), I_IN = (2048 / 64) * (DSA_NP / 32), I_OUT = (2048 / 64) * (2048 / 32), I_Q = (2048 / 64) * (512 / 32), I_KV = (2048 / 64) * (1024 / 32),
                  I_O = (512 / 64) * (2048 / 32), I_GU = (2048 / 64) * (2 * DFF / 32), I_DN = (DFF / 64) * (2048 / 32);
    constexpr int NITEMS = 4 * I_POOL + I_IN + I_OUT + 2 * (I_Q + I_KV + I_O + I_GU + I_DN);
    for (int it = gw; it < NITEMS; it += NGW) {
        int r = it; TJob j; bool found = false;
#pragma unroll
        for (int g = 0; g < 4; ++g) if (!found) { if (r < I_POOL) { j = TJob{a->pool_w + (size_t)g * 512 * 512, (h16*)(ws + WS_WPOOL) + (size_t)g * 512 * 512, a->pool_scale + g * 512, 512, 512, 512, 512, 0, 1.0f, nullptr}; found = true; } else r -= I_POOL; }
        if (!found) { if (r < I_IN) { j = TJob{a->w_in, (h16*)(ws + WS_WIN), nullptr, DSA_N, 2048, DSA_NP, DSA_N, 0, 64.0f, a->gains + 6 * D  }; found = true; } else r -= I_IN; }
        if (!found) { if (r < I_OUT) { j = TJob{a->w_out, (h16*)(ws + WS_WOUT), nullptr, 2048, 2048, 2048, 2048, 0, 1.0f, nullptr}; found = true; } else r -= I_OUT; }
#pragma unroll
        for (int L = 0; L < 2; ++L) {
            if (!found) { if (r < I_Q) { j = TJob{a->wq + (size_t)L * 2048 * 512, (h16*)(ws + WS_WQ) + (size_t)L * 512 * 2048, nullptr, 512, 2048, 512, 512, 0, 1.0f, a->gains + (size_t)L * 6 * D + 2 * D}; found = true; } else r -= I_Q; }
            if (!found) { if (r < I_KV) { const int ks = r / (I_KV / 4); r -= ks * (I_KV / 4);
                j = TJob{a->wkv + (size_t)L * 2048 * 1024 + (size_t)ks * 512 * 1024, (h16*)(ws + WS_WKV) + ((size_t)ks * 2048 + (size_t)L * 1024) * 512, nullptr, 1024, 512, 1024, 1024, 0, 1.0f, nullptr}; found = true; } else r -= I_KV; }
            if (!found) { if (r < I_O) { j = TJob{a->wo + (size_t)L * 512 * 2048, (h16*)(ws + WS_WO) + (size_t)L * 2048 * 512, nullptr, 2048, 512, 2048, 2048, 0, 1.0f, nullptr}; found = true; } else r -= I_O; }
            if (!found) { if (r < I_GU) { j = ((FFN_FP8 >> L) & 1) ? TJob{a->wgu + (size_t)L * 2048 * 2 * DFF, (h16*)(ws + WS_WGU) + (size_t)L * 2 * DFF * 2048, nullptr, 2 * DFF, 2048, 2 * DFF, 2 * DFF, 3, W8_SCALE, nullptr} : TJob{a->wgu + (size_t)L * 2048 * 2 * DFF, (h16*)(ws + WS_WGU) + (size_t)L * 2 * DFF * 2048, nullptr, 2 * DFF, 2048, 2 * DFF, 2 * DFF, 1, 1.0f, a->gains + (size_t)L * 6 * D + 4 * D}; found = true; } else r -= I_GU; }
            if (!found) { if (r < I_DN) { j = ((DN_FP8 >> L) & 1) ? TJob{a->wdn + (size_t)L * DFF * 2048, (h16*)(ws + WS_WDN) + (size_t)L * 2048 * DFF, nullptr, 2048, DFF, 2048, 2048, 2, W8_SCALE, nullptr} : TJob{a->wdn + (size_t)L * DFF * 2048, (h16*)(ws + WS_WDN) + (size_t)L * 2048 * DFF, nullptr, 2048, DFF, 2048, 2048, 0, 1.0f, nullptr}; found = true; } else r -= I_DN; }
        }
        if (found) tjob_run(j, r, scr, F.lane);
    }
    for (int i = (gw * 64 + F.lane); i < T * 16; i += NGW * 64) rope_entry(a, (float*)(ws + WS_ROPE), i);
    for (int m = gw; m < NB * NMEM; m += NGW) norm_row_to_h16(a->mem + (size_t)m * D, a->mem_norm, (h16*)(ws + WS_MEMN) + (size_t)m * D, F.lane);
    __syncthreads();
    pool_pre(F, a->x, a->gains  , (h16*)(ws + WS_A));
}

template <bool HAS_NEXT, bool OUT8, bool HIN32, bool HOUT32, bool RSONLY = false>
__device__ __forceinline__ void seam_phase(Frame& F0, const h16* Y, const void* hin, void* hout, const float* gpost, const float* gpre, h16* aout, float* rsout = nullptr) {
    Frame F = fresh(F0);
    const int gw = F.vcu * NWAVES + F.wave, NGW = F.G * NWAVES;
#pragma unroll 4
    for (int m = gw; m < T; m += NGW) {
        const h16* yr = Y + (size_t)m * D + 8 * F.lane;
        float y[4][8]; float s = 0.f;
#pragma unroll
        for (int j = 0; j < 4; ++j) { const half8 v = __builtin_nontemporal_load((const half8*)(yr + 512 * j));
#pragma unroll
            for (int e = 0; e < 8; ++e) { y[j][e] = (float)v[e]; s += y[j][e] * y[j][e]; } }
        float hp[4][8];
#pragma unroll
        for (int j = 0; j < 4; ++j) {
            if constexpr (HIN32) { const f32x4 a = *(const f32x4*)((const float*)hin + (size_t)m * D + 8 * F.lane + 512 * j), c = *(const f32x4*)((const float*)hin + (size_t)m * D + 8 * F.lane + 512 * j + 4);
                hp[j][0] = a.x; hp[j][1] = a.y; hp[j][2] = a.z; hp[j][3] = a.w; hp[j][4] = c.x; hp[j][5] = c.y; hp[j][6] = c.z; hp[j][7] = c.w; }
            else { const half8 v = *(const half8*)((const h16*)hin + (size_t)m * D + 8 * F.lane + 512 * j);
#pragma unroll
                for (int e = 0; e < 8; ++e) hp[j][e] = (float)v[e]; } }
        const float r = rstd_of(wave_sum_dpp(s)); float s2 = 0.f;
#pragma unroll
        for (int j = 0; j < 4; ++j) { const f32x4 g0 = *(const f32x4*)(gpost + 8 * F.lane + 512 * j), g1 = *(const f32x4*)(gpost + 8 * F.lane + 512 * j + 4);
            const float g[8] = {g0.x, g0.y, g0.z, g0.w, g1.x, g1.y, g1.z, g1.w};
#pragma unroll
            for (int e = 0; e < 8; ++e) { const float h = hp[j][e] + y[j][e] * r * g[e]; y[j][e] = h; s2 += h * h; }
            if constexpr (HOUT32) { float* o = (float*)hout + (size_t)m * D + 8 * F.lane + 512 * j; __builtin_nontemporal_store((f32x4){y[j][0], y[j][1], y[j][2], y[j][3]}, (f32x4*)o); __builtin_nontemporal_store((f32x4){y[j][4], y[j][5], y[j][6], y[j][7]}, (f32x4*)(o + 4)); }
            else { u32x4 w; w.x = pkh(y[j][0], y[j][1]); w.y = pkh(y[j][2], y[j][3]); w.z = pkh(y[j][4], y[j][5]); w.w = pkh(y[j][6], y[j][7]); *(u32x4*)((h16*)hout + (size_t)m * D + 8 * F.lane + 512 * j) = w; } }
        if constexpr (HAS_NEXT && RSONLY) { const float r2 = rstd_of(wave_sum_dpp(s2)); if (F.lane == 0) rsout[m] = r2; }
        else if constexpr (HAS_NEXT) {
            const float r2 = rstd_of(wave_sum_dpp(s2));
#pragma unroll
            for (int j = 0; j < 4; ++j) { const f32x4 g0 = *(const f32x4*)(gpre + 8 * F.lane + 512 * j), g1 = *(const f32x4*)(gpre + 8 * F.lane + 512 * j + 4);
                const float g[8] = {g0.x, g0.y, g0.z, g0.w, g1.x, g1.y, g1.z, g1.w}; float v[8];
#pragma unroll
                for (int e = 0; e < 8; ++e) v[e] = y[j][e] * r2 * g[e];
                if constexpr (OUT8) { u32x2 w; w.x = pk8(v[0], v[1], v[2], v[3]); w.y = pk8(v[4], v[5], v[6], v[7]); *(u32x2*)((unsigned char*)aout + (size_t)m * D + 8 * F.lane + 512 * j) = w; }
                else { u32x4 w; w.x = pkh(v[0], v[1]); w.y = pkh(v[2], v[3]); w.z = pkh(v[4], v[5]); w.w = pkh(v[6], v[7]); *(u32x4*)(aout + (size_t)m * D + 8 * F.lane + 512 * j) = w; } }
        }
    }
}

__device__ __forceinline__ void xattn_phase(Frame& F0, h16* XQ, const h16* KVM  ) {
    Frame F = fresh(F0);
    LAS unsigned char* Ks = F.lds + RING_OFF; LAS unsigned char* Vt = F.lds + RING_OFF + 65536;
    const int lane = F.lane, n = lane & 31, hh = lane >> 5;
    for (int u = F.vcu; u < NB * 4 * (SEQ / 512); u += F.G) {
        const int b = u / (4 * (SEQ / 512)), h = (u / (SEQ / 512)) & 3, ch = u % (SEQ / 512);
        const h16* kb = KVM + (size_t)b * NMEM * 8192 + h * HD;
        for (int i = F.tid; i < 256 * 16; i += NWAVES * 64) { const int key = i >> 4, c = i & 15;
            const h16* kr = kb + (size_t)key * 8192 + 8 * c;
            half8 kp[4], vp[4];
#pragma unroll
            for (int ks = 0; ks < 4; ++ks) { kp[ks] = *(const half8*)(kr + ks * 2048); vp[ks] = *(const half8*)(kr + ks * 2048 + 512); }
            half8 kv8, vv;
#pragma unroll
            for (int e = 0; e < 8; ++e) { kv8[e] = (h16)(((float)kp[0][e] + (float)kp[1][e]) + ((float)kp[2][e] + (float)kp[3][e])); vv[e] = (h16)(((float)vp[0][e] + (float)vp[1][e]) + ((float)vp[2][e] + (float)vp[3][e])); }
            *(LAS half8*)(Ks + key * 256 + ((c ^ (key & 15)) << 4)) = kv8;
            const int o = key & 15, posk = (key & ~15) | ((o & 3) | ((o & 4) << 1) | ((o & 8) >> 1));
#pragma unroll
            for (int e = 0; e < 8; ++e) { const int d = 8 * c + e; *(LAS h16*)(Vt + d * 512 + (((posk >> 3) ^ (d & 15)) << 4) + (posk & 7) * 2) = vv[e]; }
        }
        __syncthreads();
#pragma unroll 1
        for (int sub = 0; sub < 2; ++sub) {
            const size_t m0 = (size_t)b * SEQ + ch * 512 + sub * 256 + F.wave * 32;
            h16* qrow = XQ + (m0 + n) * XW + h * HD;
            half8 qf[8];
#pragma unroll
            for (int s = 0; s < 8; ++s) qf[s] = *(const half8*)(qrow + 16 * s + 8 * hh);
            f32x16 o[4];
#pragma unroll
            for (int mt = 0; mt < 4; ++mt)
#pragma unroll
                for (int i = 0; i < 16; ++i) o[mt][i] = 0.f;
            const float c2 = 0.08838834764831845f * 1.44269504089f;
            float mrun = -3.0e38f, lrun = 0.f;
#pragma unroll 1
            for (int hf = 0; hf < 2; ++hf) {
                f32x16 acc[4];
#pragma unroll
                for (int kt = 0; kt < 4; ++kt) {
#pragma unroll
                    for (int i = 0; i < 16; ++i) acc[kt][i] = 0.f;
                    const int key = 128 * hf + 32 * kt + n;
#pragma unroll
                    for (int s = 0; s < 8; ++s) { const half8 ka = *(const LAS half8*)(Ks + key * 256 + (((2 * s + hh) ^ (key & 15)) << 4));
                        acc[kt] = __builtin_amdgcn_mfma_f32_32x32x16_f16(ka, qf[s], acc[kt], 0, 0, 0); }
                }
                float mx = mrun;
#pragma unroll
                for (int kt = 0; kt < 4; ++kt)
#pragma unroll
                    for (int i = 0; i < 16; ++i) mx = fmaxf(mx, acc[kt][i]);
                mx = fmaxf(mx, __shfl_xor(mx, 32));
                const float alpha = __builtin_amdgcn_exp2f((mrun - mx) * c2); mrun = mx;
                float sum = 0.f;
#pragma unroll
                for (int kt = 0; kt < 4; ++kt)
#pragma unroll
                    for (int i = 0; i < 16; ++i) { const float p = __builtin_amdgcn_exp2f((acc[kt][i] - mx) * c2); acc[kt][i] = p; sum += p; }
                lrun = lrun * alpha + sum;
#pragma unroll
                for (int mt = 0; mt < 4; ++mt)
#pragma unroll
                    for (int i = 0; i < 16; ++i) o[mt][i] *= alpha;
#pragma unroll
                for (int kt = 0; kt < 4; ++kt)
#pragma unroll
                    for (int s2 = 0; s2 < 2; ++s2) {
                        half8 pb;
#pragma unroll
                        for (int j = 0; j < 8; ++j) pb[j] = (h16)acc[kt][8 * s2 + j];
#pragma unroll
                        for (int mt = 0; mt < 4; ++mt) { const int d = 32 * mt + n;
                            const half8 va = *(const LAS half8*)(Vt + d * 512 + (((2 * (2 * (4 * hf + kt) + s2) + hh) ^ (d & 15)) << 4));
                            o[mt] = __builtin_amdgcn_mfma_f32_32x32x16_f16(va, pb, o[mt], 0, 0, 0); }
                    }
            }
            lrun += __shfl_xor(lrun, 32);
            const float inv = 1.0f / lrun;
#pragma unroll
            for (int mt = 0; mt < 4; ++mt)
#pragma unroll
                for (int jj = 0; jj < 4; ++jj) { u32x2 w; w.x = pkh(o[mt][4 * jj] * inv, o[mt][4 * jj + 1] * inv); w.y = pkh(o[mt][4 * jj + 2] * inv, o[mt][4 * jj + 3] * inv);
                    *(u32x2*)(qrow + 32 * mt + 8 * jj + 4 * hh) = w; }
        }
        __syncthreads();
    }
}

__device__ __forceinline__ unsigned mono_key(unsigned u) { return (u & 0x80000000u) ? ~u : (u | 0x80000000u); }
__device__ __forceinline__ void keymap_clear(LAS unsigned* bm, int lane) { *(LAS u32x4*)(bm + 8 * lane) = (u32x4){0u, 0u, 0u, 0u}; *(LAS u32x4*)(bm + 8 * lane + 4) = (u32x4){0u, 0u, 0u, 0u}; }
__device__ __forceinline__ void keymap_emit(LAS unsigned* bm, unsigned short* out, int nvalid, int lane) {
    const u32x4 w0 = *(const LAS u32x4*)(bm + 8 * lane), w1 = *(const LAS u32x4*)(bm + 8 * lane + 4);
    unsigned w[8] = {w0.x, w0.y, w0.z, w0.w, w1.x, w1.y, w1.z, w1.w};
    int mine = 0;
#pragma unroll
    for (int j = 0; j < 8; ++j) mine += __builtin_popcount(w[j]);
    int incl = mine;
#pragma unroll
    for (int o = 1; o < 64; o <<= 1) { const int v = __shfl_up(incl, o); if (lane >= o) incl += v; }
    int pos = incl - mine;
#pragma unroll
    for (int j = 0; j < 8; ++j) { unsigned x = w[j]; while (x) { const int b = __builtin_ctz(x); out[pos++] = (unsigned short)((8 * lane + j) * 32 + b); x &= x - 1u; } }
    const int total = __shfl(incl, 63);
    for (int i = total + lane; i < TOPK; i += 64) out[i] = (unsigned short)0;
}
constexpr int SEL_N = LIST_CAP / 64;
template <bool FINAL>
__device__ __forceinline__ void select256(u32x2* list, int c, LAS float* th_out, LAS unsigned* cnt_out, LAS unsigned* bm, int lane) {
    unsigned key[SEL_N], id[SEL_N];
#pragma unroll
    for (int k = 0; k < SEL_N; ++k) { const int i = lane + 64 * k; const u32x2 v = list[i]; key[k] = (i < c) ? mono_key(v.x) : 0u; id[k] = v.y; }
    unsigned mx = key[0];
#pragma unroll
    for (int k = 1; k < SEL_N; ++k) mx = key[k] > mx ? key[k] : mx;
#pragma unroll
    for (int o = 1; o < 64; o <<= 1) { const unsigned v = (unsigned)__shfl_xor((int)mx, o); mx = v > mx ? v : mx; }
    unsigned lo = FINAL ? 1u : mono_key(__float_as_uint(*th_out)), hi = mx;
    constexpr int PRUNE_KEEP = 320;
#pragma unroll 1
    while (lo < hi) { const unsigned mid = lo + ((hi - lo + 1u) >> 1); int cc = 0;
#pragma unroll
        for (int k = 0; k < SEL_N; ++k) cc += __builtin_popcountll(__ballot(key[k] >= mid));
        if (cc >= TOPK) { lo = mid; if (cc <= (FINAL ? TOPK : PRUNE_KEEP)) break; } else hi = mid - 1u; }
    const unsigned prefix = lo;
    int ngt = 0, neq = 0;
#pragma unroll
    for (int k = 0; k < SEL_N; ++k) { ngt += __builtin_popcountll(__ballot(key[k] > prefix)); neq += __builtin_popcountll(__ballot(key[k] == prefix)); }
    const int need_eq = FINAL ? (TOPK - ngt) : neq; int base_gt = 0, base_eq = 0;
    const unsigned long long lt = (1ull << lane) - 1ull;
#pragma unroll
    for (int k = 0; k < SEL_N; ++k) {
        const unsigned long long bgt = __ballot(key[k] > prefix), beq = __ballot(key[k] == prefix);
        int pos = -1;
        if (key[k] > prefix) pos = base_gt + __builtin_popcountll(bgt & lt);
        else if (key[k] == prefix) { const int r = base_eq + __builtin_popcountll(beq & lt); if (r < need_eq) pos = ngt + r; }
        if (pos >= 0) { if constexpr (FINAL) __hip_atomic_fetch_or(bm + (id[k] >> 5), 1u << (id[k] & 31u), __ATOMIC_RELAXED, __HIP_MEMORY_SCOPE_WORKGROUP); else { u32x2 v; v.x = (key[k] & 0x80000000u) ? (key[k] & 0x7fffffffu) : ~key[k]; v.y = id[k]; list[pos] = v; } }
        base_gt += __builtin_popcountll(bgt); base_eq += __builtin_popcountll(beq);
        __builtin_amdgcn_sched_barrier(0);
    }
    if constexpr (!FINAL) { if (lane == 0) { const unsigned u = (prefix & 0x80000000u) ? (prefix & 0x7fffffffu) : ~prefix; *th_out = __builtin_bit_cast(float, u); *cnt_out = (unsigned)(ngt + neq); } }
}
__device__ __forceinline__ void indexer_phase(Frame& F0, const h16* IQ, const h16* IK, const float* IW, unsigned short* IDX, u32x2* LISTS) {
    Frame F = fresh(F0);
    LAS unsigned char* bq = F.lds + RING_OFF;
    LAS unsigned* cnt = (LAS unsigned*)(F.lds + RING_OFF + 131072); LAS float* th = (LAS float*)(cnt + 32); LAS unsigned* flag = cnt + 64; LAS unsigned* sgn = cnt + 96;
    u32x2* mylist = LISTS + (size_t)blockIdx.x * 32 * LIST_CAP;
    const int lane = F.lane, n = lane & 31, hh = lane >> 5, w8 = F.wave;
    const float INF = __builtin_inff();
    constexpr int NU = NB * (SEQ / 32);
    for (int rnd = 0; rnd * F.G < NU; ++rnd) {
        int qt, b;
        if (F.G == 256) {
            const int i = (F.vcu & 31) + 32 * (F.vcu >> 6); b = (F.vcu >> 5) & 1;
            qt = rnd == 0 ? 511 - i : rnd == 1 ? i : rnd == 2 ? 256 + i : 255 - i;
        } else { const int kk = rnd * F.G + ((rnd & 1) ? (F.G - 1 - F.vcu) : F.vcu); if (kk >= NU) continue; qt = (SEQ / 32 - 1) - (kk >> 1); b = kk & 1; }
        const int nkt = qt + 1;
        const size_t m0 = (size_t)b * SEQ + 32 * qt;
        if (F.tid < 32) { cnt[F.tid] = 0u; th[F.tid] = -INF; unsigned mk = 0u;
#pragma unroll
            for (int h = 0; h < 16; ++h) mk |= (IW[(m0 + F.tid) * 16 + h] >= 0.f ? 1u : 0u) << h;
            sgn[F.tid] = mk; }
        if (F.tid == 0) *flag = 0u;
        { const int q = F.tid & 31, ch = F.tid >> 5;
#pragma unroll 4
            for (int h = 0; h < 16; ++h) { const float w = IW[(m0 + q) * 16 + h]; const half8 v = *(const half8*)(IQ + (m0 + q) * 2048 + h * HD + 8 * ch); half8 o;
#pragma unroll
                for (int e = 0; e < 8; ++e) o[e] = (h16)((float)v[e] * w);
                *(LAS half8*)(bq + (h * 16 + ch) * 512 + q * 16) = o; } }
        __syncthreads();
        const h16* ikb = IK + (size_t)b * SEQ * HD;
        const unsigned smask = sgn[n];
        float theta = -INF;
        const int qpos = 32 * qt + n;
        u32x2* lp = mylist + (size_t)n * LIST_CAP;
        half8 A[8];
        if (w8 < nkt) { const h16* arow = ikb + (size_t)(32 * w8 + n) * HD + 8 * hh;
#pragma unroll
            for (int c = 0; c < 8; ++c) A[c] = *(const half8*)(arow + 16 * c); }
#pragma unroll 1
        for (int r0 = 0; r0 < nkt; r0 += NWAVES) {
            const int kt = r0 + w8;
            if (kt < nkt) {
                f32x16 S;
#pragma unroll
                for (int i = 0; i < 16; ++i) S[i] = 0.f;
                const LAS unsigned char* bl = bq + hh * 512 + n * 16;
                half8 Ba[4], Bb[4]; f32x16 acc0, acc1;
#define IDX_LOADB(dst, h, c0) do { _Pragma("unroll") for (int c = 0; c < 4; ++c) dst[c] = *(const LAS half8*)(bl + ((h) * 16 + 2 * ((c0) + c)) * 512); } while (0)
#define IDX_MMA4(acc, Bx, c0) do { _Pragma("unroll") for (int c = 0; c < 4; ++c) acc = __builtin_amdgcn_mfma_f32_32x32x16_f16(A[(c0) + c], Bx[c], acc, 0, 0, 0); } while (0)
#define IDX_ZERO(acc) do { _Pragma("unroll") for (int i = 0; i < 16; ++i) acc[i] = 0.f; } while (0)
#define IDX_FOLD8(acc, h, i0) do { const float cc_ = ((smask >> (h)) & 1u) ? INF : -INF; _Pragma("unroll") for (int i = (i0); i < (i0) + 8; ++i) S[i] += __builtin_amdgcn_fmed3f(acc[i], 0.f, cc_); } while (0)
#define IDX_SCHED4() do { __builtin_amdgcn_sched_group_barrier(0x008, 1, 0); __builtin_amdgcn_sched_group_barrier(0x100, 1, 0); _Pragma("unroll") for (int g_ = 0; g_ < 3; ++g_) { __builtin_amdgcn_sched_group_barrier(0x008, 1, 0); __builtin_amdgcn_sched_group_barrier(0x100, 1, 0); __builtin_amdgcn_sched_group_barrier(0x002, 6, 0); } } while (0)
                IDX_LOADB(Ba, 0, 0);
                IDX_ZERO(acc1);
#pragma unroll 1
                for (int h = 0; h < 16; h += 2) {
                    IDX_ZERO(acc0);
                    IDX_MMA4(acc0, Ba, 0); IDX_FOLD8(acc1, (h + 15) & 15, 0); IDX_LOADB(Bb, h, 4); IDX_SCHED4();
                    IDX_MMA4(acc0, Bb, 4); IDX_FOLD8(acc1, (h + 15) & 15, 8); IDX_LOADB(Ba, h + 1, 0); IDX_SCHED4();
                    IDX_ZERO(acc1);
                    IDX_MMA4(acc1, Ba, 0); IDX_FOLD8(acc0, h, 0); IDX_LOADB(Bb, h + 1, 4); IDX_SCHED4();
                    IDX_MMA4(acc1, Bb, 4); IDX_FOLD8(acc0, h, 8); IDX_LOADB(Ba, (h + 2) & 15, 0); IDX_SCHED4();
                }
                IDX_FOLD8(acc1, 15, 0); IDX_FOLD8(acc1, 15, 8);
#if IDX_PROBE_MMA
                {
                    f32x16 S1 = S;
#pragma unroll
                    for (int c = 0; c < 8; ++c) asm volatile("" : "+v"(A[c]));
#pragma unroll
                    for (int i = 0; i < 16; ++i) S[i] = 0.f;
                    IDX_LOADB(Ba, 0, 0);
                    IDX_ZERO(acc1);
#pragma unroll 1
                    for (int h = 0; h < 16; h += 2) {
                        IDX_ZERO(acc0);
                        IDX_MMA4(acc0, Ba, 0); IDX_FOLD8(acc1, (h + 15) & 15, 0); IDX_LOADB(Bb, h, 4); IDX_SCHED4();
                        IDX_MMA4(acc0, Bb, 4); IDX_FOLD8(acc1, (h + 15) & 15, 8); IDX_LOADB(Ba, h + 1, 0); IDX_SCHED4();
                        IDX_ZERO(acc1);
                        IDX_MMA4(acc1, Ba, 0); IDX_FOLD8(acc0, h, 0); IDX_LOADB(Bb, h + 1, 4); IDX_SCHED4();
                        IDX_MMA4(acc1, Bb, 4); IDX_FOLD8(acc0, h, 8); IDX_LOADB(Ba, (h + 2) & 15, 0); IDX_SCHED4();
                    }
                    IDX_FOLD8(acc1, 15, 0); IDX_FOLD8(acc1, 15, 8);
#pragma unroll
                    for (int i = 0; i < 16; ++i) S[i] = (S[i] + S1[i]) * 0.5f;
                }
#endif
#undef IDX_LOADB
#undef IDX_MMA4
#undef IDX_ZERO
#undef IDX_FOLD8
#undef IDX_SCHED4
                if (kt + NWAVES < nkt) { const h16* arow = ikb + (size_t)(32 * (kt + NWAVES) + n) * HD + 8 * hh;
#pragma unroll
                    for (int c = 0; c < 8; ++c) A[c] = *(const half8*)(arow + 16 * c); }
                const int kb0 = 32 * kt + 4 * hh;
                unsigned pm = 0u;
                if (kt < qt) {
#pragma unroll
                    for (int i = 0; i < 16; ++i) pm |= (S[i] > theta) ? (1u << i) : 0u;
                } else {
#pragma unroll
                    for (int i = 0; i < 16; ++i) { const int key = kb0 + (i & 3) + 8 * (i >> 2); pm |= ((key <= qpos) && (S[i] > theta)) ? (1u << i) : 0u; }
                }
                if (pm) { const unsigned np = (unsigned)__builtin_popcount(pm);
                    const unsigned pos = __hip_atomic_fetch_add(cnt + n, np, __ATOMIC_RELAXED, __HIP_MEMORY_SCOPE_WORKGROUP);
#pragma unroll
                    for (int i = 0; i < 16; ++i) if (pm & (1u << i)) { u32x2 e; e.x = __float_as_uint(S[i]);   e.y = (unsigned)(kb0 + (i & 3) + 8 * (i >> 2));
                        { const unsigned at = pos + (unsigned)__builtin_popcount(pm & ((1u << i) - 1u)); lp[at < (unsigned)LIST_CAP ? at : (unsigned)LIST_CAP - 1u] = e; } }
                    if (pos + np > (unsigned)(LIST_CAP - 256)) *(volatile LAS unsigned*)flag = 1u; }
            }
            asm volatile("s_waitcnt lgkmcnt(0)" ::: "memory"); __builtin_amdgcn_s_barrier(); asm volatile("" ::: "memory");
            if (*(volatile LAS unsigned*)flag != 0u) {
                VM_WAIT(); __syncthreads();
                for (int q = w8; q < 32; q += NWAVES) { const int c = __builtin_amdgcn_readfirstlane((int)cnt[q]); if (c > TOPK) select256<false>(mylist + (size_t)q * LIST_CAP, c, th + q, cnt + q, nullptr, lane); }
                if (F.tid == 0) *flag = 0u;
                VM_WAIT(); __syncthreads();
                theta = th[n];
                if (kt + NWAVES < nkt) { const h16* arow = ikb + (size_t)(32 * (kt + NWAVES) + n) * HD + 8 * hh;
#pragma unroll
                    for (int c = 0; c < 8; ++c) A[c] = *(const half8*)(arow + 16 * c); }
            }
        }
        VM_WAIT(); __syncthreads();
        LAS unsigned* bm = (LAS unsigned*)(bq + w8 * 2048);
        for (int q = w8; q < 32; q += NWAVES) { const int c = __builtin_amdgcn_readfirstlane((int)cnt[q]); unsigned short* io = IDX + (m0 + q) * TOPK; u32x2* lq = mylist + (size_t)q * LIST_CAP;
            keymap_clear(bm, lane); asm volatile("s_waitcnt lgkmcnt(0)" ::: "memory");
            if (c > TOPK) select256<true>(lq, c, nullptr, nullptr, bm, lane);
            else {
#pragma unroll
                for (int k = 0; k < 4; ++k) { const int i = lane + 64 * k; if (i < c) { const unsigned key = lq[i].y; __hip_atomic_fetch_or(bm + (key >> 5), 1u << (key & 31u), __ATOMIC_RELAXED, __HIP_MEMORY_SCOPE_WORKGROUP); } } }
            asm volatile("s_waitcnt lgkmcnt(0)" ::: "memory");
            keymap_emit(bm, io, c, lane);
            asm volatile("s_waitcnt lgkmcnt(0)" ::: "memory"); }
        __syncthreads();
    }
}

constexpr int L16_CAP = 640;
__device__ __forceinline__ unsigned wave_umax_dpp(unsigned v) {
    { const unsigned o = (unsigned)__builtin_amdgcn_update_dpp(0, (int)v, 0xB1, 0xF, 0xF, true); v = o > v ? o : v; }
    { const unsigned o = (unsigned)__builtin_amdgcn_update_dpp(0, (int)v, 0x4E, 0xF, 0xF, true); v = o > v ? o : v; }
    { const unsigned o = (unsigned)__builtin_amdgcn_update_dpp(0, (int)v, 0x141, 0xF, 0xF, true); v = o > v ? o : v; }
    { const unsigned o = (unsigned)__builtin_amdgcn_update_dpp(0, (int)v, 0x140, 0xF, 0xF, true); v = o > v ? o : v; }
    const unsigned s0 = (unsigned)__builtin_amdgcn_readlane((int)v, 0), s1 = (unsigned)__builtin_amdgcn_readlane((int)v, 16), s2 = (unsigned)__builtin_amdgcn_readlane((int)v, 32), s3 = (unsigned)__builtin_amdgcn_readlane((int)v, 48);
    const unsigned a = s0 > s1 ? s0 : s1, b = s2 > s3 ? s2 : s3; return a > b ? a : b;
}
template <bool FINAL, int L16_N>
__device__ __forceinline__ void select_lds(LAS float* sc, LAS unsigned short* ky, int c, LAS float* th_io, LAS unsigned* cnt_out, LAS unsigned* bm, int lane) {
    unsigned key[L16_N], id[L16_N];
#pragma unroll
    for (int k = 0; k < L16_N; ++k) { const int i = lane + 64 * k; const float v = sc[i]; key[k] = (i < c) ? mono_key(__float_as_uint(v)) : 0u; id[k] = ky[i]; }
    unsigned mx = key[0];
#pragma unroll
    for (int k = 1; k < L16_N; ++k) mx = key[k] > mx ? key[k] : mx;
    mx = wave_umax_dpp(mx);
    unsigned lo = th_io ? mono_key(__float_as_uint(*th_io)) : 1u, hi = mx;
    constexpr int PRUNE_KEEP = 320;
#pragma unroll 1
    while (lo < hi) { const unsigned mid = lo + ((hi - lo + 1u) >> 1); int cc = 0;
#pragma unroll
        for (int k = 0; k < L16_N; ++k) cc += __builtin_popcountll(__ballot(key[k] >= mid));
        if (cc >= TOPK) { lo = mid; if (cc <= (FINAL ? TOPK : PRUNE_KEEP)) break; } else hi = mid - 1u; }
    const unsigned prefix = lo;
    int ngt = 0, neq = 0;
#pragma unroll
    for (int k = 0; k < L16_N; ++k) { ngt += __builtin_popcountll(__ballot(key[k] > prefix)); neq += __builtin_popcountll(__ballot(key[k] == prefix)); }
    const int need_eq = FINAL ? (TOPK - ngt) : neq; int base_gt = 0, base_eq = 0;
    const unsigned long long lt = (1ull << lane) - 1ull;
    unsigned idthr = 0xffffffffu;
    if constexpr (FINAL) { if (neq > need_eq) { unsigned lo2 = 0u, hi2 = (unsigned)SEQ - 1u;
#pragma unroll 1
        while (lo2 < hi2) { const unsigned mid = (lo2 + hi2) >> 1; int cc = 0;
#pragma unroll
            for (int k = 0; k < L16_N; ++k) cc += __builtin_popcountll(__ballot(key[k] == prefix && id[k] <= mid));
            if (cc >= need_eq) hi2 = mid; else lo2 = mid + 1u; }
        idthr = lo2; } }
    asm volatile("s_waitcnt lgkmcnt(0)" ::: "memory");
#pragma unroll
    for (int k = 0; k < L16_N; ++k) {
        const unsigned long long bgt = __ballot(key[k] > prefix), beq = __ballot(key[k] == prefix);
        int pos = -1;
        if (key[k] > prefix) pos = base_gt + __builtin_popcountll(bgt & lt);
        else if (key[k] == prefix) { if constexpr (FINAL) { if (id[k] <= idthr) pos = 0; } else { const int r = base_eq + __builtin_popcountll(beq & lt); if (r < need_eq) pos = ngt + r; } }
        if (pos >= 0) { if constexpr (FINAL) __hip_atomic_fetch_or(bm + (id[k] >> 5), 1u << (id[k] & 31u), __ATOMIC_RELAXED, __HIP_MEMORY_SCOPE_WORKGROUP);
            else { sc[pos] = __uint_as_float((key[k] & 0x80000000u) ? (key[k] & 0x7fffffffu) : ~key[k]); ky[pos] = (unsigned short)id[k]; } }
        base_gt += __builtin_popcountll(bgt); base_eq += __builtin_popcountll(beq);
        __builtin_amdgcn_sched_barrier(0);
    }
    if constexpr (!FINAL) { if (lane == 0) { const unsigned u = (prefix & 0x80000000u) ? (prefix & 0x7fffffffu) : ~prefix; *th_io = __uint_as_float(u); *cnt_out = (unsigned)(ngt + neq); } }
}
__device__ __forceinline__ void indexer_phase16(Frame& F0, const h16* IQ, const h16* IK, const float* IW, unsigned short* IDX) {
    Frame F = fresh(F0);
    LAS unsigned char* bq = F.lds + RING_OFF;
    LAS float* lsc = (LAS float*)(F.lds + RING_OFF + 65536);
    LAS unsigned short* lky = (LAS unsigned short*)(F.lds + RING_OFF + 65536 + 40960);
    LAS unsigned* cnt = (LAS unsigned*)(F.lds + RING_OFF + 65536 + 40960 + 20480); LAS float* th = (LAS float*)(cnt + 16); LAS unsigned* flag = cnt + 32; LAS unsigned* sgn = cnt + 48;
    const int lane = F.lane, n32 = lane & 31, q = n32 & 15, hsel = n32 >> 4, hh = lane >> 5, w8 = F.wave;
    const float INF = __builtin_inff();
    constexpr int NQ16 = SEQ / 16, NU = NB * NQ16;
    for (int rnd = 0; rnd * F.G < NU; ++rnd) {
        int qt, b;
        if (F.G == 256) { const int i = (F.vcu & 31) + 32 * (F.vcu >> 6); b = (F.vcu >> 5) & 1; qt = (rnd & 1) ? 128 * rnd + 127 - i : 128 * rnd + i; qt = NQ16 - 1 - qt; }
        else { const int kk = rnd * F.G + ((rnd & 1) ? (F.G - 1 - F.vcu) : F.vcu); if (kk >= NU) continue; qt = (NQ16 - 1) - (kk >> 1); b = kk & 1; }
        const int nkb = (qt >> 1) + 1;
        const size_t m0 = (size_t)b * SEQ + 16 * qt;
        if (F.tid < 16) { cnt[F.tid] = 0u; th[F.tid] = -INF; unsigned mk = 0u;
#pragma unroll
            for (int h = 0; h < 16; ++h) mk |= (IW[(m0 + F.tid) * 16 + h] >= 0.f ? 1u : 0u) << h;
            sgn[F.tid] = mk; }
        if (F.tid == 0) *flag = 0u;
#pragma unroll 4
        for (int j = 0; j < 8; ++j) { const int e = F.tid + 512 * j, le = e & 63, c = (e >> 6) & 7, hp = e >> 9, qe = le & 15, head = 2 * hp + ((le >> 4) & 1), he = le >> 5;
            const float w = IW[(m0 + qe) * 16 + head]; const half8 v = *(const half8*)(IQ + (m0 + qe) * 2048 + head * HD + 16 * c + 8 * he); half8 o;
#pragma unroll
            for (int x = 0; x < 8; ++x) o[x] = (h16)((float)v[x] * w);
            *(LAS half8*)(bq + e * 16) = o; }
        __syncthreads();
        const h16* ikb = IK + (size_t)b * SEQ * HD;
        const unsigned smask = sgn[q];
        float theta = -INF;
        const int qpos = 16 * qt + q;
        LAS float* msc = lsc + q * L16_CAP; LAS unsigned short* mky = lky + q * L16_CAP;
        half8 A[8];
        if (w8 < nkb) { const h16* arow = ikb + (size_t)(32 * w8 + n32) * HD + 8 * hh;
#pragma unroll
            for (int c = 0; c < 8; ++c) A[c] = *(const half8*)(arow + 16 * c); }
#pragma unroll 1
        for (int r0 = 0; r0 < nkb; r0 += NWAVES) {
            const int kb = r0 + w8;
            if (kb < nkb) {
                f32x16 S;
#pragma unroll
                for (int i = 0; i < 16; ++i) S[i] = 0.f;
                const LAS unsigned char* bl = bq + lane * 16;
                half8 Ba[4], Bb[4]; f32x16 acc0, acc1;
#define IX_LOADB(dst, hp, c0) do { _Pragma("unroll") for (int c = 0; c < 4; ++c) dst[c] = *(const LAS half8*)(bl + ((hp) * 8 + (c0) + c) * 1024); } while (0)
#define IX_MMA4(acc, Bx, c0) do { _Pragma("unroll") for (int c = 0; c < 4; ++c) acc = __builtin_amdgcn_mfma_f32_32x32x16_f16(A[(c0) + c], Bx[c], acc, 0, 0, 0); } while (0)
#define IX_ZERO(acc) do { _Pragma("unroll") for (int i = 0; i < 16; ++i) acc[i] = 0.f; } while (0)
#define IX_FOLD8(acc, hp, i0) do { const float cc_ = ((smask >> (2 * (hp) + hsel)) & 1u) ? INF : -INF; _Pragma("unroll") for (int i = (i0); i < (i0) + 8; ++i) S[i] += __builtin_amdgcn_fmed3f(acc[i], 0.f, cc_); } while (0)
#define IX_SCHED4() do { __builtin_amdgcn_sched_group_barrier(0x008, 1, 0); __builtin_amdgcn_sched_group_barrier(0x100, 1, 0); _Pragma("unroll") for (int g_ = 0; g_ < 3; ++g_) { __builtin_amdgcn_sched_group_barrier(0x008, 1, 0); __builtin_amdgcn_sched_group_barrier(0x100, 1, 0); __builtin_amdgcn_sched_group_barrier(0x002, 6, 0); } } while (0)
                IX_LOADB(Ba, 0, 0);
                IX_ZERO(acc1);
#pragma unroll 1
                for (int hp = 0; hp < 8; hp += 2) {
                    IX_ZERO(acc0);
                    IX_MMA4(acc0, Ba, 0); IX_FOLD8(acc1, (hp + 7) & 7, 0); IX_LOADB(Bb, hp, 4); IX_SCHED4();
                    IX_MMA4(acc0, Bb, 4); IX_FOLD8(acc1, (hp + 7) & 7, 8); IX_LOADB(Ba, hp + 1, 0); IX_SCHED4();
                    IX_ZERO(acc1);
                    IX_MMA4(acc1, Ba, 0); IX_FOLD8(acc0, hp, 0); IX_LOADB(Bb, hp + 1, 4); IX_SCHED4();
                    IX_MMA4(acc1, Bb, 4); IX_FOLD8(acc0, hp, 8); IX_LOADB(Ba, (hp + 2) & 7, 0); IX_SCHED4();
                }
                IX_FOLD8(acc1, 7, 0); IX_FOLD8(acc1, 7, 8);
#undef IX_LOADB
#undef IX_MMA4
#undef IX_ZERO
#undef IX_FOLD8
#undef IX_SCHED4
                if (kb + NWAVES < nkb) { const h16* arow = ikb + (size_t)(32 * (kb + NWAVES) + n32) * HD + 8 * hh;
#pragma unroll
                    for (int c = 0; c < 8; ++c) A[c] = *(const half8*)(arow + 16 * c); }
                float Sx[8];
#pragma unroll
                for (int i = 0; i < 8; ++i) { const float mine = hsel ? S[8 + i] : S[i], other = hsel ? S[i] : S[8 + i];
                    Sx[i] = mine + __shfl_xor(other, 16); }
                const int kb0 = 32 * kb + 4 * hh + 16 * hsel;
                unsigned pm = 0u;
                if (kb + 1 < nkb) {
#pragma unroll
                    for (int i = 0; i < 8; ++i) pm |= (Sx[i] > theta) ? (1u << i) : 0u;
                } else {
#pragma unroll
                    for (int i = 0; i < 8; ++i) { const int key = kb0 + (i & 3) + 8 * (i >> 2); pm |= ((key <= qpos) && (Sx[i] > theta)) ? (1u << i) : 0u; }
                }
                if (pm) { const unsigned np = (unsigned)__builtin_popcount(pm);
                    const unsigned pos = __hip_atomic_fetch_add(cnt + q, np, __ATOMIC_RELAXED, __HIP_MEMORY_SCOPE_WORKGROUP);
#pragma unroll
                    for (int i = 0; i < 8; ++i) if (pm & (1u << i)) { unsigned at = pos + (unsigned)__builtin_popcount(pm & ((1u << i) - 1u)); at = at < (unsigned)L16_CAP ? at : (unsigned)L16_CAP - 1u;
                        msc[at] = Sx[i]; mky[at] = (unsigned short)(kb0 + (i & 3) + 8 * (i >> 2)); }
                    if (pos + np > (unsigned)(L16_CAP - 256)) *(volatile LAS unsigned*)flag = 1u; }
            }
            asm volatile("s_waitcnt lgkmcnt(0)" ::: "memory"); __builtin_amdgcn_s_barrier(); asm volatile("" ::: "memory");
            if (*(volatile LAS unsigned*)flag != 0u) {
                for (int qq = w8; qq < 16; qq += NWAVES) { const int c = __builtin_amdgcn_readfirstlane((int)cnt[qq]); if (c > TOPK) select_lds<false, L16_CAP / 64>(lsc + qq * L16_CAP, lky + qq * L16_CAP, c, th + qq, cnt + qq, nullptr, lane); }
                if (F.tid == 0) *flag = 0u;
                asm volatile("s_waitcnt lgkmcnt(0)" ::: "memory"); __builtin_amdgcn_s_barrier(); asm volatile("" ::: "memory");
                theta = th[q];
            }
        }
        __syncthreads();
        LAS unsigned* bm = (LAS unsigned*)(bq + w8 * 2048);
        for (int qq = w8; qq < 16; qq += NWAVES) { const int c = __builtin_amdgcn_readfirstlane((int)cnt[qq]); unsigned short* io = IDX + (m0 + qq) * TOPK;
            keymap_clear(bm, lane); asm volatile("s_waitcnt lgkmcnt(0)" ::: "memory");
            if (c > TOPK) select_lds<true, L16_CAP / 64>(lsc + qq * L16_CAP, lky + qq * L16_CAP, c, nullptr, nullptr, bm, lane);
            else {
#pragma unroll
                for (int k = 0; k < 4; ++k) { const int i = lane + 64 * k; if (i < c) { const unsigned key = lky[qq * L16_CAP + i]; __hip_atomic_fetch_or(bm + (key >> 5), 1u << (key & 31u), __ATOMIC_RELAXED, __HIP_MEMORY_SCOPE_WORKGROUP); } } }
            asm volatile("s_waitcnt lgkmcnt(0)" ::: "memory");
            keymap_emit(bm, io, c, lane);
            asm volatile("s_waitcnt lgkmcnt(0)" ::: "memory"); }
        __syncthreads();
    }
}

constexpr int L5_CAP = 640;
static_assert(32768 + 32 * L5_CAP * 6 + 512 <= RING_BYTES, "indexer LDS");
__device__ __forceinline__ bool ix5_append4(float v0, float v1, int kbA, bool validA, float v2, float v3, int kbB, bool maskedB, int qpos, float theta, unsigned cnt_addr, unsigned sc_addr, unsigned ky_addr) {
    unsigned pm = ((validA && v0 > theta) ? 1u : 0u) | ((validA && v1 > theta) ? 2u : 0u)
                | (((v2 > theta) && (!maskedB || kbB <= qpos)) ? 4u : 0u) | (((v3 > theta) && (!maskedB || kbB + 1 <= qpos)) ? 8u : 0u);
    bool over = false;
    if (pm) { const unsigned np = (unsigned)__builtin_popcount(pm); unsigned pos;
        asm volatile("ds_add_rtn_u32 %0, %1, %2\n\ts_waitcnt lgkmcnt(0)" : "=&v"(pos) : "v"(cnt_addr), "v"(np) : "memory");
        const unsigned cap1 = (unsigned)L5_CAP - 1u;
        const unsigned p0 = pos, p1 = pos + (pm & 1u), p2 = pos + (unsigned)__builtin_popcount(pm & 3u), p3 = pos + (unsigned)__builtin_popcount(pm & 7u);
        const unsigned a0 = p0 < cap1 ? p0 : cap1, a1 = p1 < cap1 ? p1 : cap1, a2 = p2 < cap1 ? p2 : cap1, a3 = p3 < cap1 ? p3 : cap1;
        if (pm & 1u) { asm volatile("ds_write_b32 %0, %1" :: "v"(sc_addr + 4u * a0), "v"(v0) : "memory"); asm volatile("ds_write_b16 %0, %1" :: "v"(ky_addr + 2u * a0), "v"((unsigned)kbA) : "memory"); }
        if (pm & 2u) { asm volatile("ds_write_b32 %0, %1" :: "v"(sc_addr + 4u * a1), "v"(v1) : "memory"); asm volatile("ds_write_b16 %0, %1" :: "v"(ky_addr + 2u * a1), "v"((unsigned)(kbA + 1)) : "memory"); }
        if (pm & 4u) { asm volatile("ds_write_b32 %0, %1" :: "v"(sc_addr + 4u * a2), "v"(v2) : "memory"); asm volatile("ds_write_b16 %0, %1" :: "v"(ky_addr + 2u * a2), "v"((unsigned)kbB) : "memory"); }
        if (pm & 8u) { asm volatile("ds_write_b32 %0, %1" :: "v"(sc_addr + 4u * a3), "v"(v3) : "memory"); asm volatile("ds_write_b16 %0, %1" :: "v"(ky_addr + 2u * a3), "v"((unsigned)(kbB + 1)) : "memory"); }
        over = pos + np > (unsigned)(L5_CAP - 64); }
    return over;
}
__device__ __forceinline__ bool ix5_append(float v0, float v1, int kb0, bool valid, bool masked, int qpos, float theta, unsigned cnt_addr, unsigned sc_addr, unsigned ky_addr) {
    unsigned pm = (((v0 > theta) && (!masked || kb0 <= qpos)) ? 1u : 0u) | (((v1 > theta) && (!masked || kb0 + 1 <= qpos)) ? 2u : 0u);
    if (!valid) pm = 0u;
    bool over = false;
    if (pm) { const unsigned np = pm == 3u ? 2u : 1u; unsigned pos;
        asm volatile("ds_add_rtn_u32 %0, %1, %2\n\ts_waitcnt lgkmcnt(0)" : "=&v"(pos) : "v"(cnt_addr), "v"(np) : "memory");
        const unsigned a0 = pos < (unsigned)L5_CAP ? pos : (unsigned)L5_CAP - 1u, p1 = pos + (pm & 1u), a1 = p1 < (unsigned)L5_CAP ? p1 : (unsigned)L5_CAP - 1u;
        if (pm & 1u) { asm volatile("ds_write_b32 %0, %1" :: "v"(sc_addr + 4u * a0), "v"(v0) : "memory"); asm volatile("ds_write_b16 %0, %1" :: "v"(ky_addr + 2u * a0), "v"((unsigned)kb0) : "memory"); }
        if (pm & 2u) { asm volatile("ds_write_b32 %0, %1" :: "v"(sc_addr + 4u * a1), "v"(v1) : "memory"); asm volatile("ds_write_b16 %0, %1" :: "v"(ky_addr + 2u * a1), "v"((unsigned)(kb0 + 1)) : "memory"); }
        over = pos + np > (unsigned)(L5_CAP - 64); }
    return over;
}
template <int MODE>
__device__ __forceinline__ void indexer_phase5(Frame& F0, const h16* IQ, const h16* IK, const float* IW, unsigned short* IDX, const float theta0) {
    Frame F = fresh(F0);
    LAS unsigned char* ringA = F.lds + RING_OFF;
    LAS float* lsc = (LAS float*)(F.lds + RING_OFF + 32768);
    LAS unsigned short* lky = (LAS unsigned short*)(F.lds + RING_OFF + 32768 + 32 * L5_CAP * 4);
    LAS unsigned* cnt = (LAS unsigned*)(F.lds + RING_OFF + 32768 + 32 * L5_CAP * 6); LAS float* th = (LAS float*)(cnt + 32); LAS unsigned* req = cnt + 64; const unsigned req_addr = (unsigned)(unsigned long)req;
    const int lane = F.lane, n32 = lane & 31, hh = lane >> 5, q4 = n32 & 3, h8 = n32 >> 2, w8 = F.wave;
    const bool b2 = (lane >> 2) & 1, b3 = (lane >> 3) & 1, b4 = (lane >> 4) & 1;
    const int ql = 4 * w8 + q4, drow = lane >> 4, dpc = lane & 15;
    const float INF = __builtin_inff();
    constexpr int NU = NB * (SEQ / 32);
    for (int rnd = 0; rnd * F.G < NU; ++rnd) {
        int qt, b;
        if (F.G == 256) { const int i = (F.vcu & 31) + 32 * (F.vcu >> 6); b = (F.vcu >> 5) & 1; qt = rnd == 0 ? 511 - i : rnd == 1 ? i : rnd == 2 ? 256 + i : 255 - i; }
        else { const int kk = rnd * F.G + ((rnd & 1) ? (F.G - 1 - F.vcu) : F.vcu); if (kk >= NU) continue; qt = (SEQ / 32 - 1) - (kk >> 1); b = kk & 1; }
        const int nst = (qt >> 1) + 1;
        const size_t m0 = (size_t)b * SEQ + 32 * qt;
        const h16* ikb = IK + (size_t)b * SEQ * HD;
#define IX5_DMA(k_, slot_) do { _Pragma("unroll") for (int i_ = 0; i_ < 2; ++i_) { const int r_ = 8 * w8 + 4 * i_ + drow; \
            __builtin_amdgcn_global_load_lds((const unsigned*)(ikb + (size_t)(64 * (k_) + r_) * HD + 8 * (dpc ^ (r_ & 15))), (LAS unsigned*)(ringA + (slot_) * 16384 + (8 * w8 + 4 * i_) * 256), 16, 0, 0); } } while (0)
        IX5_DMA(0, 0);
        if (lane < 4) { cnt[4 * w8 + lane] = 0u; th[4 * w8 + lane] = -INF; }
        if (F.tid == 0) *req = 0xffffffffu;
        half8 B0[8], B1[8]; float cc0, cc1;
        { const size_t row = m0 + ql; const float w0 = IW[row * 16 + h8], w1 = IW[row * 16 + 8 + h8]; cc0 = w0 >= 0.f ? INF : -INF; cc1 = w1 >= 0.f ? INF : -INF;
          const h16* src = IQ + row * 2048 + h8 * HD + 8 * hh;
#pragma unroll
          for (int c = 0; c < 8; ++c) { const half8 v0 = *(const half8*)(src + 16 * c), v1 = *(const half8*)(src + 8 * HD + 16 * c);
#pragma unroll
              for (int x = 0; x < 8; ++x) { B0[c][x] = (h16)((float)v0[x] * w0); B1[c][x] = (h16)((float)v1[x] * w1); } } }
        float theta = theta0;
        const int qpos = 32 * qt + ql;
        const unsigned cnt_addr = (unsigned)(unsigned long)(cnt + ql), sc_addr = (unsigned)(unsigned long)(lsc + ql * L5_CAP), ky_addr = (unsigned)(unsigned long)(lky + ql * L5_CAP);
        const LAS unsigned char* arow = ringA + n32 * 256 + ((hh ^ (n32 & 1)) * 16);
        const int axor = 16 * (n32 & 14);
        const int kl = 16 * (int)b4 + 8 * (int)b3 + 4 * hh + 2 * (int)b2;
        half8 A[8]; f32x16 X0, X1, Y0, Y1; float T2a, T2b;
#define IX5_ZERO(P0, P1) do { _Pragma("unroll") for (int i = 0; i < 16; ++i) { P0[i] = 0.f; P1[i] = 0.f; } } while (0)
#define IX5_MADD(BM, dst_, src_, CON, PRE) asm volatile(PRE "v_add_f32_dpp %0, %1, %1 row_ror:4 row_mask:0xf bank_mask:" BM : CON(dst_) : "v"(src_))
#define IX5_BLOCK(P0, P1, Q0, Q1, REFILL, nbase_) do { f32x2 Sa_[4], Sb_[4], T_[4]; IX5_ZERO(P0, P1); \
            _Pragma("unroll") for (int s_ = 0; s_ < 16; ++s_) { const int c_ = s_ >> 1, g_ = s_ >> 2; \
                __builtin_amdgcn_s_setprio(1); \
                if (s_ & 1) { if (!(MODE & 2)) P1 = __builtin_amdgcn_mfma_f32_32x32x16_f16(A[c_], B1[c_], P1, 0, 0, 0); else asm volatile("" :: "v"(A[c_])); __builtin_amdgcn_s_setprio(0); if (REFILL) A[c_] = *(const LAS half8*)((nbase_) + ((32 * c_) ^ axor));   } \
                else { if (!(MODE & 2)) P0 = __builtin_amdgcn_mfma_f32_32x32x16_f16(A[c_], B0[c_], P0, 0, 0, 0); __builtin_amdgcn_s_setprio(0); } \
                if (!(MODE & 1)) { \
                if ((s_ & 3) == 0) Sa_[g_] = ix5_pkadd((f32x2){__builtin_amdgcn_fmed3f(Q0[2 * g_], 0.f, cc0), __builtin_amdgcn_fmed3f(Q0[2 * g_ + 1], 0.f, cc0)}, (f32x2){__builtin_amdgcn_fmed3f(Q1[2 * g_], 0.f, cc1), __builtin_amdgcn_fmed3f(Q1[2 * g_ + 1], 0.f, cc1)}); \
                else if ((s_ & 3) == 1) Sb_[g_] = ix5_pkadd((f32x2){__builtin_amdgcn_fmed3f(Q0[8 + 2 * g_], 0.f, cc0), __builtin_amdgcn_fmed3f(Q0[9 + 2 * g_], 0.f, cc0)}, (f32x2){__builtin_amdgcn_fmed3f(Q1[8 + 2 * g_], 0.f, cc1), __builtin_amdgcn_fmed3f(Q1[9 + 2 * g_], 0.f, cc1)}); \
                else if ((s_ & 3) == 2) { const auto r0_ = __builtin_amdgcn_permlane16_swap(__float_as_uint(Sa_[g_].x), __float_as_uint(Sb_[g_].x), false, false), r1_ = __builtin_amdgcn_permlane16_swap(__float_as_uint(Sa_[g_].y), __float_as_uint(Sb_[g_].y), false, false); \
                    T_[g_] = ix5_pkadd((f32x2){__uint_as_float(r0_[0]), __uint_as_float(r1_[0])}, (f32x2){__uint_as_float(r0_[1]), __uint_as_float(r1_[1])}); } \
                else { const float t0_ = T_[g_].x + __uint_as_float(__builtin_amdgcn_update_dpp(0u, __float_as_uint(T_[g_].x), 0x128, 0xf, 0xf, false)), t1_ = T_[g_].y + __uint_as_float(__builtin_amdgcn_update_dpp(0u, __float_as_uint(T_[g_].y), 0x128, 0xf, 0xf, false)); \
                      \
                    if (g_ == 0) { IX5_MADD("0xf", T2a, t0_, "=v", "s_nop 1\n\t"); IX5_MADD("0xf", T2b, t1_, "=v", ""); } \
                    else if (g_ == 1) { IX5_MADD("0x2", T2a, t0_, "+v", "s_nop 1\n\t"); IX5_MADD("0x2", T2b, t1_, "+v", ""); } \
                    else if (g_ == 2) { IX5_MADD("0x4", T2a, t0_, "+v", "s_nop 1\n\t"); IX5_MADD("0x4", T2b, t1_, "+v", ""); } \
                    else { IX5_MADD("0x8", T2a, t0_, "+v", "s_nop 1\n\t"); IX5_MADD("0x8", T2b, t1_, "+v", ""); } } \
                } else if (s_ == 15) { T2a = Q0[0] + Q1[3]; T2b = Q0[5] + Q1[9]; } \
                __builtin_amdgcn_sched_barrier(0); } \
        } while (0)
        IX5_ZERO(Y0, Y1);
        bool own_over = false;
#pragma unroll 1
        for (int k = 0; k < nst; ++k) {
            VM_WAIT(); __builtin_amdgcn_s_barrier(); asm volatile("" ::: "memory");
            if (*(volatile LAS unsigned*)req == (unsigned)k || own_over) {
                for (int i = 0; i < 4; ++i) { const int qq = 4 * w8 + i; const int c = __builtin_amdgcn_readfirstlane((int)cnt[qq]); if (c > TOPK + 32) select_lds<false, L5_CAP / 64>(lsc + qq * L5_CAP, lky + qq * L5_CAP, c, th + qq, cnt + qq, nullptr, lane); }
                asm volatile("s_waitcnt lgkmcnt(0)" ::: "memory");
                theta = th[ql];
            }
            if (k + 1 < nst) IX5_DMA(k + 1, (k + 1) & 1);
            const LAS unsigned char* as = arow + (k & 1) * 16384;
#pragma unroll
            for (int c = 0; c < 8; ++c) { A[c] = *(const LAS half8*)(as + ((32 * c) ^ axor)); __builtin_amdgcn_sched_barrier(0); }
            IX5_BLOCK(X0, X1, Y0, Y1, true, as + 8192);
            const float Ta = T2a, Tb = T2b;
            IX5_BLOCK(Y0, Y1, X0, X1, false, as);
            const bool over = ix5_append4(Ta, Tb, 64 * k - 32 + kl, k > 0, T2a, T2b, 64 * k + kl, k + 1 == nst, qpos, theta, cnt_addr, sc_addr, ky_addr);
            own_over = __ballot(over) != 0ull;
            if (own_over && lane == 0) asm volatile("ds_write_b32 %0, %1" :: "v"(req_addr), "v"((unsigned)(k + 1)) : "memory");
        }
        if (own_over) {
            for (int i = 0; i < 4; ++i) { const int qq = 4 * w8 + i; const int c = __builtin_amdgcn_readfirstlane((int)cnt[qq]); if (c > TOPK + 32) select_lds<false, L5_CAP / 64>(lsc + qq * L5_CAP, lky + qq * L5_CAP, c, th + qq, cnt + qq, nullptr, lane); }
            asm volatile("s_waitcnt lgkmcnt(0)" ::: "memory");
            theta = th[ql]; }
        { float S_[16], T_[8];
#pragma unroll
          for (int i = 0; i < 16; ++i) S_[i] = __builtin_amdgcn_fmed3f(Y0[i], 0.f, cc0) + __builtin_amdgcn_fmed3f(Y1[i], 0.f, cc1);
#pragma unroll
          for (int i = 0; i < 8; ++i) { const auto r_ = __builtin_amdgcn_permlane16_swap(__float_as_uint(S_[i]), __float_as_uint(S_[8 + i]), false, false); T_[i] = __uint_as_float(r_[0]) + __uint_as_float(r_[1]); }
#pragma unroll
          for (int i = 0; i < 8; ++i) { T_[i] += __uint_as_float(__builtin_amdgcn_update_dpp(0u, __float_as_uint(T_[i]), 0x128, 0xf, 0xf, false)); T_[i] += __uint_as_float(__builtin_amdgcn_update_dpp(0u, __float_as_uint(T_[i]), 0x124, 0xf, 0xf, false)); }
          T2a = b3 ? (b2 ? T_[6] : T_[4]) : (b2 ? T_[2] : T_[0]); T2b = b3 ? (b2 ? T_[7] : T_[5]) : (b2 ? T_[3] : T_[1]);
          (void)ix5_append(T2a, T2b, 64 * nst - 32 + kl, true, true, qpos, theta, cnt_addr, sc_addr, ky_addr); }
#undef IX5_DMA
#undef IX5_ZERO
#undef IX5_BLOCK
#undef IX5_MADD
        __syncthreads();
        LAS unsigned* bm = (LAS unsigned*)(ringA + w8 * 2048);
        for (int i = 0; i < 4; ++i) { const int qq = 4 * w8 + i; const int c = __builtin_amdgcn_readfirstlane((int)cnt[qq]); unsigned short* io = IDX + (m0 + qq) * TOPK;
            keymap_clear(bm, lane); asm volatile("s_waitcnt lgkmcnt(0)" ::: "memory");
            if (c > TOPK) select_lds<true, L5_CAP / 64>(lsc + qq * L5_CAP, lky + qq * L5_CAP, c, th + qq, nullptr, bm, lane);
            else {
#pragma unroll
                for (int k = 0; k < 4; ++k) { const int j = lane + 64 * k; if (j < c) { const unsigned key = lky[qq * L5_CAP + j]; __hip_atomic_fetch_or(bm + (key >> 5), 1u << (key & 31u), __ATOMIC_RELAXED, __HIP_MEMORY_SCOPE_WORKGROUP); } } }
            asm volatile("s_waitcnt lgkmcnt(0)" ::: "memory");
            keymap_emit(bm, io, c, lane);
            asm volatile("s_waitcnt lgkmcnt(0)" ::: "memory"); }
        __syncthreads();
    }
}

__device__ __forceinline__ unsigned q_fetch(unsigned* ctr, int lane) { unsigned v = 0u; if (lane == 0) v = __hip_atomic_fetch_add(ctr, 1u, __ATOMIC_RELAXED, __HIP_MEMORY_SCOPE_AGENT); return (unsigned)__builtin_amdgcn_readfirstlane((int)v); }
__device__ __forceinline__ void sparse_attn_phase(Frame& F0, const h16* Q, const unsigned char* K8, const unsigned char* V8, const unsigned short* IDX, h16* O, unsigned* qctr) {
    Frame F = fresh(F0);
    LAS unsigned char* wl = F.lds + RING_OFF + F.wave * 16896;
    LAS float* Pl = (LAS float*)wl;
    LAS unsigned short* Il = (LAS unsigned short*)(wl + 4096);
    const int lane = F.lane, r16 = lane & 15, g4 = lane >> 4;
    const float c2 = 0.08838834764831845f * 1.44269504089f;
    const unsigned x0 = xb_xcc_id() & 7u;
    unsigned tried = 0u, p = x0;
    unsigned item = q_fetch(qctr + 64 * p, lane);
    bool have_pf = false; u32x2 pf_idx = (u32x2){0u, 0u}; half8 pf_q[4];
#pragma unroll
    for (int s = 0; s < 4; ++s) pf_q[s] = (half8){0, 0, 0, 0, 0, 0, 0, 0};
    for (;;) {
        while (item >= (unsigned)SEQ && tried < 8u) { ++tried; p = (x0 + tried) & 7u; if (tried < 8u) item = q_fetch(qctr + 64 * p, lane); }
        if (tried >= 8u) break;
        const unsigned nxt = q_fetch(qctr + 64 * p, lane);
        const int b = (int)(p >> 2), j = (int)(p & 3u), tq = (int)item, nk = (tq + 1) < TOPK ? (tq + 1) : TOPK;
        const size_t m = (size_t)b * SEQ + tq;
        const unsigned char* kb = K8 + (size_t)p * SEQ * HD; const unsigned char* vb = V8 + (size_t)p * SEQ * HD;
        *(LAS u32x2*)(Il + 4 * lane) = have_pf ? pf_idx : *(const u32x2*)(IDX + m * TOPK + 4 * lane);
        long qb[4];
        { const h16* qrow = Q + m * 2048 + (size_t)j * 512 + (r16 & 3) * HD + 16 * g4;
#pragma unroll
          for (int s = 0; s < 4; ++s) { const half8 hv = have_pf ? pf_q[s] : *(const half8*)(qrow + (s >> 1) * 64 + (s & 1) * 8);
              const u32x4 w = __builtin_bit_cast(u32x4, hv);
              const unsigned wx = w.x, wy = w.y, wz = w.z, ww = w.w;
              const unsigned b0 = r16 < 4 ? wx : (r16 < 8 ? wz : 0u), b1 = r16 < 4 ? wy : (r16 < 8 ? ww : 0u);
              qb[s] = (long)(((unsigned long long)b1 << 32) | b0); } }
        asm volatile("s_waitcnt lgkmcnt(0)" ::: "memory");
        int keys[16];
        LAS float* Pw = (r16 < 4 ? Pl : (LAS float*)(wl + 4608 + 8192)) + (r16 & 3);
#pragma unroll
        for (int kt = 0; kt < 16; ++kt) keys[kt] = Il[16 * kt + r16];
        {
            u32x4 ka[8][2];
#pragma unroll
            for (int k8 = 0; k8 < 8; ++k8) { const unsigned char* krow = kb + (unsigned)(keys[k8] * HD + 16 * g4); ka[k8][0] = *(const u32x4*)krow; ka[k8][1] = *(const u32x4*)(krow + 64); }
#pragma unroll
            for (int kt = 0; kt < 16; ++kt) { const int k8 = kt & 7; const u32x4 a0 = ka[k8][0], a1 = ka[k8][1];
                const long ak[4] = {(long)(((unsigned long long)a0.y << 32) | a0.x), (long)(((unsigned long long)a0.w << 32) | a0.z), (long)(((unsigned long long)a1.y << 32) | a1.x), (long)(((unsigned long long)a1.w << 32) | a1.z)};
                if (kt < 8) { const unsigned char* krow = kb + (unsigned)(keys[kt + 8] * HD + 16 * g4); ka[k8][0] = *(const u32x4*)krow; ka[k8][1] = *(const u32x4*)(krow + 64); }
                f32x4 acc = (f32x4){0.f, 0.f, 0.f, 0.f};
#pragma unroll
                for (int s = 0; s < 4; ++s) acc = __builtin_amdgcn_mfma_f32_16x16x32_fp8_fp8(ak[s], qb[s], acc, 0, 0, 0);
                if (r16 < 8) {
#pragma unroll
                    for (int i = 0; i < 4; ++i) Pw[(16 * kt + 4 * g4 + i) * 4] = acc[i]; }
            }
        }
        have_pf = nxt < (unsigned)SEQ;
        if (have_pf) { const size_t mn = (size_t)b * SEQ + nxt; pf_idx = *(const u32x2*)(IDX + mn * TOPK + 4 * lane);
            const h16* qn = Q + mn * 2048 + (size_t)j * 512 + (r16 & 3) * HD + 16 * g4;
#pragma unroll
            for (int s = 0; s < 4; ++s) pf_q[s] = *(const half8*)(qn + (s >> 1) * 64 + (s & 1) * 8); }
        asm volatile("" ::: "memory");
        LAS unsigned char* vs = wl + 4608;
        const int nch = (nk + 31) >> 5;
#define SP_ISSUE(ch_) do { const int c_ = (ch_); LAS unsigned char* s_ = vs + (c_ % 3) * 4096; int key4_[4]; _Pragma("unroll") for (int j_ = 0; j_ < 4; ++j_) key4_[j_] = Il[32 * c_ + 8 * j_ + (lane >> 3)]; \
            __builtin_amdgcn_sched_barrier(0);     \
            _Pragma("unroll") for (int j_ = 0; j_ < 4; ++j_) { const int key_ = key4_[j_]; \
                __builtin_amdgcn_global_load_lds((const unsigned*)(vb + (unsigned)(key_ * HD + (((lane & 7) ^ (((8 * j_ + (lane >> 3)) >> 1) & 7)) * 16))), (LAS unsigned*)(s_ + 1024 * j_), 16, 0, 0); } } while (0)
#define SP_KEYS(ch_, arr_) do { const int c_ = (ch_); _Pragma("unroll") for (int j_ = 0; j_ < 4; ++j_) arr_[j_] = Il[32 * c_ + 8 * j_ + (lane >> 3)]; } while (0)
#define SP_DMA(ch_, arr_) do { const int c_ = (ch_); LAS unsigned char* s_ = vs + (c_ % 3) * 4096; _Pragma("unroll") for (int j_ = 0; j_ < 4; ++j_) { const int key_ = arr_[j_]; \
                __builtin_amdgcn_global_load_lds((const unsigned*)(vb + (unsigned)(key_ * HD + (((lane & 7) ^ (((8 * j_ + (lane >> 3)) >> 1) & 7)) * 16))), (LAS unsigned*)(s_ + 1024 * j_), 16, 0, 0); } } while (0)
            SP_ISSUE(0); if (nch > 1) SP_ISSUE(1);
        f32x4 sv[4]; f32x4 mx = (f32x4){-3.0e38f, -3.0e38f, -3.0e38f, -3.0e38f};
#pragma unroll
        for (int k = 0; k < 4; ++k) { sv[k] = *(const LAS f32x4*)(Pl + (lane + 64 * k) * 4) + *(const LAS f32x4*)((LAS float*)(wl + 4608 + 8192) + (lane + 64 * k) * 4); if (lane + 64 * k < nk) { mx[0] = max2(mx[0], sv[k][0]); mx[1] = max2(mx[1], sv[k][1]); mx[2] = max2(mx[2], sv[k][2]); mx[3] = max2(mx[3], sv[k][3]); } }
        mx[0] = wave_max_dpp(mx[0]); mx[1] = wave_max_dpp(mx[1]); mx[2] = wave_max_dpp(mx[2]); mx[3] = wave_max_dpp(mx[3]);
        f32x4 sum = (f32x4){0.f, 0.f, 0.f, 0.f};
        asm volatile("s_waitcnt lgkmcnt(0)" ::: "memory");
#pragma unroll
        for (int k = 0; k < 4; ++k) { f32x4 pv;
#pragma unroll
            for (int h = 0; h < 4; ++h) pv[h] = (lane + 64 * k < nk) ? __builtin_amdgcn_exp2f(sv[k][h] - mx[h]) : 0.f;
            sum += pv;
            const f32x4 p16 = pv * 16.0f;
            u32x2 w; w.x = pk8(p16[0], p16[1], p16[2], p16[3]);
            w.y = pk8(p16[0] - __builtin_amdgcn_cvt_f32_fp8((int)w.x, 0), p16[1] - __builtin_amdgcn_cvt_f32_fp8((int)w.x, 1), p16[2] - __builtin_amdgcn_cvt_f32_fp8((int)w.x, 2), p16[3] - __builtin_amdgcn_cvt_f32_fp8((int)w.x, 3));
            *(LAS u32x2*)((LAS unsigned char*)Pl + (lane + 64 * k) * 16) = w; }
        sum[0] = wave_sum_dpp(sum[0]); sum[1] = wave_sum_dpp(sum[1]); sum[2] = wave_sum_dpp(sum[2]); sum[3] = wave_sum_dpp(sum[3]);
        asm volatile("s_waitcnt lgkmcnt(0)" ::: "memory");
        long pa[8];
        { const LAS unsigned char* pp = (const LAS unsigned char*)Pl + (8 * g4 + (r16 >> 1)) * 16 + 8 * (r16 & 1);
#pragma unroll
          for (int s = 0; s < 8; ++s) { const v2i32 a = __builtin_amdgcn_ds_read_tr8_b64_v2i32((LAS v2i32*)(pp + 512 * s)); pa[s] = (long)(((unsigned long long)(unsigned)a.y << 32) | (unsigned)a.x); } }
        asm volatile("s_waitcnt lgkmcnt(0)" ::: "memory");
        f32x4 oacc[8];
#pragma unroll
        for (int nt = 0; nt < 8; ++nt) oacc[nt] = (f32x4){0.f, 0.f, 0.f, 0.f};
        {
            const int vrow = 8 * g4 + (r16 >> 1);
            int kq[4] = {0, 0, 0, 0}; if (2 < nch) SP_KEYS(2, kq);
#pragma unroll
            for (int ch = 0; ch < 8; ++ch) {
                if (ch < nch) {
                    if (ch + 2 < nch) { SP_DMA(ch + 2, kq); if (ch + 3 < nch) SP_KEYS(ch + 3, kq); asm volatile("s_waitcnt vmcnt(8)" ::: "memory"); }
                    else if (ch + 1 < nch) asm volatile("s_waitcnt vmcnt(4)" ::: "memory");
                    else asm volatile("s_waitcnt vmcnt(0)" ::: "memory");
                    const LAS unsigned char* s = vs + (ch % 3) * 4096 + vrow * HD + 8 * (r16 & 1);
                    v2i32 bv[8];
#pragma unroll
                    for (int nt = 0; nt < 8; ++nt) bv[nt] = __builtin_amdgcn_ds_read_tr8_b64_v2i32((LAS v2i32*)(s + ((nt ^ ((vrow >> 1) & 7)) * 16)));
                    __builtin_amdgcn_sched_barrier(0);
#pragma unroll
                    for (int nt = 0; nt < 8; ++nt) {
                        const long bb = (long)(((unsigned long long)(unsigned)bv[nt].y << 32) | (unsigned)bv[nt].x);
                        oacc[nt] = __builtin_amdgcn_mfma_f32_16x16x32_fp8_fp8(pa[ch], bb, oacc[nt], 0, 0, 0); }
                    asm volatile("s_waitcnt lgkmcnt(0)" ::: "memory");
                }
            }
#undef SP_ISSUE
#undef SP_KEYS
#undef SP_DMA
        }
        { LAS h16* ot = (LAS h16*)Pl;
          if (g4 < 2) {
#pragma unroll
              for (int nt = 0; nt < 8; ++nt)
#pragma unroll
                  for (int i = 0; i < 4; ++i) ot[g4 * 512 + i * HD + 16 * nt + r16] = (h16)(oacc[nt][i] * (0.0625f / sum[i])); }
          asm volatile("s_waitcnt lgkmcnt(0)" ::: "memory");
          const half8 w0 = *(const LAS half8*)(ot + g4 * HD + 8 * r16), w1 = *(const LAS half8*)(ot + 512 + g4 * HD + 8 * r16);
          *(half8*)(O + m * 2048 + (size_t)j * 512 + g4 * HD + 8 * r16) = w0 + w1; }
        asm volatile("s_waitcnt lgkmcnt(0)" ::: "memory");
        item = nxt;
    }
}

#ifndef DBG_CHECK
#define DBG_CHECK 0
#endif
#if DBG_CHECK
__device__ __forceinline__ void dbg_max(unsigned* w, float v) { atomicMax(w, __builtin_bit_cast(unsigned, fabsf(v))); }
__device__ __forceinline__ int dbg_row(int blk) { return (blk & 1) * SEQ + (SEQ - 1 - 251 * (blk >> 1)); }
__device__ __forceinline__ void dbg_check_inproj(unsigned char* ws, LAS float* sh, unsigned* word) {
    if (blockIdx.x >= 64) return;
    int tid_ = (int)threadIdx.x; asm volatile("" : "+v"(tid_)); const int m = dbg_row(blockIdx.x), tid = tid_;
    const h16* a = (const h16*)(ws + WS_A) + (size_t)m * 2048; const h16* W = (const h16*)(ws + WS_WIN);
    for (int c = tid; c < DSA_N; c += 512) { float s = 0.f; for (int k = 0; k < 2048; ++k) s += (float)a[k] * (float)W[(size_t)c * 2048 + k]; sh[c] = s * (1.0f / 64.0f); }
    __syncthreads();
    const float* rope = (const float*)(ws + WS_ROPE) + (size_t)m * 32;
    for (int c = tid; c < DSA_N; c += 512) {
        float v = sh[c]; int hc; bool rot; float got;
        if (c < 2048) { hc = c & 127; rot = true; got = (float)((const h16*)(ws + WS_Q))[(size_t)m * 2048 + c]; }
        else if (c < 3072) continue;
        else if (c < 5120) { hc = (c - 3072) & 127; rot = true; got = (float)((const h16*)(ws + WS_IQ))[(size_t)m * 2048 + (c - 3072)]; }
        else if (c < 5248) { hc = c - 5120; rot = true; got = (float)((const h16*)(ws + WS_IK))[(size_t)m * 128 + (c - 5120)]; }
        else { hc = 99; rot = false; got = ((const float*)(ws + WS_IW))[(size_t)m * 16 + (c - 5248)]; }
        if (rot && hc < 32) { const int i = hc & 15; const float cs = rope[i], sn = rope[16 + i]; v = hc < 16 ? v * cs - sh[c + 16] * sn : v * cs + sh[c - 16] * sn; }
        dbg_max(word, (got - v) / (1.0f + fabsf(v)));
    }
    __syncthreads();
}
__device__ __forceinline__ void dbg_check_xattn(unsigned char* ws, int L, LAS float* sh, unsigned* word) {
    if (blockIdx.x >= 64) return;
    int tid_ = (int)threadIdx.x; asm volatile("" : "+v"(tid_)); const int m = dbg_row(blockIdx.x), tid = tid_, b = m / SEQ;
    const h16* a = (const h16*)(ws + WS_A) + (size_t)m * 2048; const h16* W = (const h16*)(ws + WS_WQ) + (size_t)L * 512 * 2048;
    const h16* kvm = (const h16*)(ws + WS_KVM) + (size_t)b * NMEM * 2048 + L * 1024;
    LAS float* q = sh; LAS float* lg = sh + 512; LAS float* st = sh + 512 + 1024;
    { float s = 0.f; for (int k = 0; k < 2048; ++k) s += (float)a[k] * (float)W[(size_t)tid * 2048 + k]; q[tid] = (float)(h16)s; }
    __syncthreads();
    for (int i = tid; i < 1024; i += 512) { const int h = i >> 8, key = i & 255; float s = 0.f; for (int d = 0; d < 128; ++d) s += q[h * 128 + d] * (float)kvm[(size_t)key * 2048 + h * 128 + d]; lg[i] = s * 0.08838834764831845f; }
    __syncthreads();
    if (tid < 4) { float mx = -3e38f; for (int k = 0; k < 256; ++k) mx = fmaxf(mx, lg[tid * 256 + k]); float su = 0.f; for (int k = 0; k < 256; ++k) su += __expf(lg[tid * 256 + k] - mx); st[2 * tid] = mx; st[2 * tid + 1] = 1.0f / su; }
    __syncthreads();
    { const int h = tid >> 7, d = tid & 127; float o = 0.f; for (int k = 0; k < 256; ++k) o += __expf(lg[h * 256 + k] - st[2 * h]) * st[2 * h + 1] * (float)kvm[(size_t)k * 2048 + 512 + h * 128 + d];
      const float got = (float)((const h16*)(ws + WS_XQ))[(size_t)m * 512 + tid]; dbg_max(word, (got - o) / (0.05f + fabsf(o))); }
    __syncthreads();
}
__device__ __forceinline__ void dbg_check_indexer(unsigned char* ws, LAS float* sh, unsigned* word, unsigned* word2) {
    if (blockIdx.x >= 64) return;
    int tid_ = (int)threadIdx.x; asm volatile("" : "+v"(tid_)); const int m = dbg_row(blockIdx.x), tid = tid_, b = m / SEQ, t = m % SEQ;
    const h16* iq = (const h16*)(ws + WS_IQ) + (size_t)m * 2048; const h16* ik = (const h16*)(ws + WS_IK) + (size_t)b * SEQ * 128; const float* iw = (const float*)(ws + WS_IW) + (size_t)m * 16;
    LAS float* sc = sh;
    for (int s = tid; s <= t; s += 512) { float tot = 0.f; for (int h = 0; h < 16; ++h) { float l = 0.f; for (int d = 0; d < 128; ++d) l += (float)iq[h * 128 + d] * (float)ik[(size_t)s * 128 + d]; tot += iw[h] * fmaxf(l, 0.f); } sc[s] = tot; }
    __syncthreads();
    const unsigned short* idx = (const unsigned short*)(ws + WS_IDX) + (size_t)m * 256;
    if (tid < 256) { const int key = idx[tid]; if (key > t) atomicAdd(word2, 1000u); else { const float v = sc[key]; int rank = 0; for (int s = 0; s <= t; ++s) rank += sc[s] > v ? 1 : 0; if (rank >= 256) atomicAdd(word, 1u);
        for (int j = 0; j < 256; ++j) if (j != tid && idx[j] == key) { atomicAdd(word2, 1u); break; } } }
    __syncthreads();
}
__device__ __forceinline__ float dbg_f8(const unsigned char* p) { const unsigned w = *p; return __builtin_amdgcn_cvt_f32_fp8((int)w, 0); }
__device__ __forceinline__ void dbg_check_sparse(unsigned char* ws, LAS float* sh, unsigned* word) {
    if (blockIdx.x >= 64) return;
    int tid_ = (int)threadIdx.x; asm volatile("" : "+v"(tid_)); const int m = dbg_row(blockIdx.x), tid = tid_, b = m / SEQ;
    const h16* q = (const h16*)(ws + WS_Q) + (size_t)m * 2048; const unsigned char* k8 = (const unsigned char*)(ws + WS_KV); const unsigned char* v8 = k8 + (size_t)16 * 1024 * 1024;
    const unsigned short* idx = (const unsigned short*)(ws + WS_IDX) + (size_t)m * 256;
    LAS float* lg = sh; LAS float* st = sh + 4096;
    for (int i = tid; i < 4096; i += 512) { const int h = i >> 8, k = i & 255, key = idx[k]; float s = 0.f; const unsigned char* kr = k8 + ((size_t)(b * NKV + (h >> 2)) * SEQ + key) * HD;
        for (int d = 0; d < 128; ++d) s += (float)q[h * 128 + d] * dbg_f8(kr + d); lg[i] = s * 0.08838834764831845f; }
    __syncthreads();
    if (tid < 16) { float mx = -3e38f; for (int k = 0; k < 256; ++k) mx = fmaxf(mx, lg[tid * 256 + k]); float su = 0.f; for (int k = 0; k < 256; ++k) su += __expf(lg[tid * 256 + k] - mx); st[2 * tid] = mx; st[2 * tid + 1] = 1.0f / su; }
    __syncthreads();
    for (int i = tid; i < 2048; i += 512) { const int h = i >> 7, d = i & 127; float o = 0.f; for (int k = 0; k < 256; ++k) o += __expf(lg[h * 256 + k] - st[2 * h]) * st[2 * h + 1] * dbg_f8(v8 + ((size_t)(b * NKV + (h >> 2)) * SEQ + idx[k]) * HD + d);
        const float got = (float)((const h16*)(ws + WS_A))[(size_t)m * 2048 + i]; dbg_max(word, (got - o) / (0.02f + fabsf(o))); }
    __syncthreads();
}
#endif

constexpr int N_PHASES = 22 + (DBG_CHECK ? 1 : 0);
__global__ void __launch_bounds__(NWAVES * 64, 2) trunk_fwd(Args args) {
    extern __shared__ __attribute__((aligned(16))) unsigned char lds_raw[];
    Frame F;
    F.lds = (LAS unsigned char*)lds_raw;
    F.MISC = (volatile LAS unsigned*)(F.lds + MISC_OFF);
    F.tid = threadIdx.x; F.lane = F.tid & 63; F.wave = __builtin_amdgcn_readfirstlane(F.tid >> 6);
    F.G = gridDim.x; { const int bx = blockIdx.x; F.vcu = (F.G % 8 == 0) ? (bx % 8) * (F.G / 8) + bx / 8 : bx; }
    unsigned char* ws = argp()->ws;
    for (int u = F.tid; u < (LDS_BYTES - MISC_OFF) / 4; u += NWAVES * 64) ((LAS unsigned*)(F.lds + MISC_OFF))[u] = 0u;
    __syncthreads();
    XcdBarrier bar; bar.bar = (unsigned*)(ws + WS_CTL) + CW_BAR; bar.x = 0; bar.st = nullptr;
    if (!MK_LAUNCH_PER_PHASE) bar = xcd_barrier_post((unsigned*)(ws + WS_CTL) + CW_BAR, F.MISC + 8);
    const int lo = argp()->ph_lo, hi = argp()->ph_hi;
#ifndef DBG_KINDS
#define DBG_KINDS 0xFFFF
#endif
#define KON(kind) (((DBG_KINDS) >> (kind)) & 1)
#ifndef PROBE_REP
#define PROBE_REP 0
#endif
#define NREP(kind) ((((PROBE_REP) >> (kind)) & 1) ? 2 : 1)
#define IN(k) (lo <= (k) && (k) < hi)
#define SEAM(k) do { if (IN((k) + 1)) { if (MK_LAUNCH_PER_PHASE) { } else xcd_barrier(bar); } } while (0)
    LAS unsigned char* ring = F.lds + RING_OFF;
    const int bid = (int)blockIdx.x;
    h16* A = (h16*)(ws + WS_A); h16* Y = (h16*)(ws + WS_Y); h16* H = (h16*)(ws + WS_H); float* RS = (float*)(ws + WS_CTL + 512 * 1024);     h16* XQ = (h16*)(ws + WS_XQ); h16* ACT = (h16*)(ws + WS_ACT);

    if (KON(0) && IN(0)) { for (int rep = 0; rep < NREP(0); ++rep) { if (rep) xcd_barrier(bar); p0_prologue(F, argp()); } SEAM(0); }
    if (KON(1) && IN(1)) {
        { pg8::Gemm g{A, (const h16*)(ws + WS_WPOOL), T, D, 512, D, 1}; pg8::StaticOrder S; S.init(T, D, F.G, bid);
          pg8::EpiH16 E{Y, D, 1.0f, nullptr}; pg8::gemm_phase<pg8::EpiH16, pg8::StaticOrder, true, true>(ring, g, S, E); }
        __syncthreads();
        { pg8::Gemm g{(const h16*)(ws + WS_MEMN), (const h16*)(ws + WS_WKV), NB * NMEM, 4 * 2048, 512, 2048, 3}; pg8::StaticOrder S; S.init(NB * NMEM, 4 * 2048, F.G, bid);
          pg8::EpiH16 E{(h16*)(ws + WS_KVM4), 4 * 2048, 1.0f, nullptr}; pg8::gemm_phase<pg8::EpiH16, pg8::StaticOrder, true, true>(ring, g, S, E); }
        SEAM(1);
    }
#pragma unroll 1
    for (int L = 0; L < 2; ++L) {
        const int pb = L == 0 ? 2 : 14;
        if (L == 1) {
            if (KON(2) && IN(10)) {
                pg8::Gemm g{H, (const h16*)(ws + WS_WIN), T, DSA_NP, 2048, 2048, 31}; pg8::StaticOrder S; S.init(T, DSA_NP, F.G, bid);
                pg8::EpiInProj E{(h16*)(ws + WS_Q), (h16*)(ws + WS_KV), (h16*)(ws + WS_IQ), (h16*)(ws + WS_IK), (float*)(ws + WS_IW), (const float*)(ws + WS_ROPE), 1.0f / 64.0f, RS};
                for (int rep = 0; rep < NREP(2); ++rep) { if (rep) xcd_barrier(bar); pg8::gemm_phase<pg8::EpiInProj, pg8::StaticOrder, true, true>(ring, g, S, E); }
                SEAM(10);
            }
#if DBG_CHECK
            if (IN(11)) dbg_check_inproj(ws, (LAS float*)ring, (unsigned*)(ws + WS_CTL) + 1024);
#endif
            if (KON(3) && IN(11)) { for (int rep = 0; rep < NREP(3); ++rep) { if (rep) xcd_barrier(bar); if (IDX16 == 2) {
#ifdef PROBE_IDX
                indexer_phase5<PROBE_MODE>(F, (const h16*)(ws + WS_IQ), (const h16*)(ws + WS_IK), (const float*)(ws + WS_IW), (unsigned short*)(ws + WS_IDX), (float)(PROBE_IDX));
                indexer_phase5<0>(F, (const h16*)(ws + WS_IQ), (const h16*)(ws + WS_IK), (const float*)(ws + WS_IW), (unsigned short*)(ws + WS_IDX), -__builtin_inff());
#else
                indexer_phase5<0>(F, (const h16*)(ws + WS_IQ), (const h16*)(ws + WS_IK), (const float*)(ws + WS_IW), (unsigned short*)(ws + WS_IDX), -__builtin_inff());
#endif
                } else if (IDX16) indexer_phase16(F, (const h16*)(ws + WS_IQ), (const h16*)(ws + WS_IK), (const float*)(ws + WS_IW), (unsigned short*)(ws + WS_IDX)); else indexer_phase(F, (const h16*)(ws + WS_IQ), (const h16*)(ws + WS_IK), (const float*)(ws + WS_IW), (unsigned short*)(ws + WS_IDX), (u32x2*)(ws + WS_LISTS)); } SEAM(11); }
#if DBG_CHECK
            if (IN(12)) dbg_check_indexer(ws, (LAS float*)ring, (unsigned*)(ws + WS_CTL) + 1026, (unsigned*)(ws + WS_CTL) + 1028);
#endif
            if (KON(4) && IN(12)) { for (int rep = 0; rep < NREP(4); ++rep) { if (rep) xcd_barrier(bar); sparse_attn_phase(F, (const h16*)(ws + WS_Q), (const unsigned char*)(ws + WS_KV), (const unsigned char*)(ws + WS_KV) + (size_t)16 * 1024 * 1024, (const unsigned short*)(ws + WS_IDX), A, (unsigned*)(ws + WS_CTL) + 2048 + 512 * rep); } SEAM(12); }
#if DBG_CHECK
            if (IN(13)) dbg_check_sparse(ws, (LAS float*)ring, (unsigned*)(ws + WS_CTL) + 1027);
#endif
            if (KON(5) && IN(13)) {
                pg8::Gemm g{A, (const h16*)(ws + WS_WOUT), T, D, 2048, 2048, 31}; pg8::StaticOrder S; S.init(T, D, F.G, bid);
                pg8::EpiH16 E{Y, D, 1.0f, nullptr}; pg8::gemm_phase<pg8::EpiH16, pg8::StaticOrder, true, true>(ring, g, S, E);
                SEAM(13);
            }
        }
        if (KON(6) && IN(pb + 0)) { ArgP a = argp(); const float* gains = a->gains + (size_t)L * 6 * D;
            if (L == 0) seam_phase<true, false, true, false, true>(F, Y, a->x, H, gains + 1 * D, nullptr, nullptr, RS); else seam_phase<true, false, false, false, true>(F, Y, H, H, gains + 1 * D, nullptr, nullptr, RS);
            SEAM(pb + 0); }
        if (KON(7) && IN(pb + 1)) {
            pg8::Gemm g{H, (const h16*)(ws + WS_WQ) + (size_t)L * XW * 2048, T, XW, 2048, 2048, 31}; pg8::StaticOrder S; S.init(T, XW, F.G, bid);
            pg8::EpiH16 E{XQ, XW, 1.0f, RS}; pg8::gemm_phase<pg8::EpiH16, pg8::StaticOrder, true, true>(ring, g, S, E);
            SEAM(pb + 1);
        }
        if (KON(8) && IN(pb + 2)) { xattn_phase(F, XQ, (const h16*)(ws + WS_KVM4) + L * 1024); SEAM(pb + 2); }
#if DBG_CHECK
        if (IN(pb + 3)) dbg_check_xattn(ws, L, (LAS float*)ring, (unsigned*)(ws + WS_CTL) + 1025);
#endif
        if (KON(9) && IN(pb + 3)) {
            pg8::Gemm g{XQ, (const h16*)(ws + WS_WO) + (size_t)L * 2048 * XW, T, D, XW, XW, 31}; pg8::StaticOrder S; S.init(T, D, F.G, bid);
            pg8::EpiH16 E{Y, D, 1.0f, nullptr}; pg8::gemm_phase<pg8::EpiH16, pg8::StaticOrder, true, true>(ring, g, S, E);
            SEAM(pb + 3);
        }
        if (KON(10) && IN(pb + 4)) { ArgP a = argp(); const float* gains = a->gains + (size_t)L * 6 * D;
            if ((FFN_FP8 >> L) & 1) seam_phase<true, true, false, false>(F, Y, H, H, gains + 3 * D, gains + 4 * D, A); else seam_phase<true, false, false, false, true>(F, Y, H, H, gains + 3 * D, nullptr, nullptr, RS);
            SEAM(pb + 4); }
        static_assert(DN_FP8 == 3, "the fp16 gate|up GEMM reads the residual stream with a row factor in its e4m3 epilogue: every layer's down projection is e4m3");
        static_assert((FFN_FP8 & ~DN_FP8) == 0, "an e4m3 gate|up GEMM writes e4m3 activations: its down projection must be e4m3 too");
        if (KON(11) && IN(pb + 5) && ((FFN_FP8 >> L) & 1)) {
            pg8::Gemm g{A, (const h16*)(ws + WS_WGU) + (size_t)L * 2 * DFF * 2048  , T, 2 * DFF, 1024, 1024, 31}; pg8::StaticOrder S; S.init(T, 2 * DFF, F.G, bid);
            pg8::EpiSwiGLU8 E{(unsigned char*)ACT, DFF, 1.0f / W8_SCALE, ACT8_SCALE, nullptr}; pg8::gemm_phase<pg8::EpiSwiGLU8, pg8::StaticOrder, true, true, true>(ring, g, S, E);
            SEAM(pb + 5);
        }
        if (KON(11) && IN(pb + 5) && !((FFN_FP8 >> L) & 1) && ((DN_FP8 >> L) & 1)) {
            pg8::Gemm g{H, (const h16*)(ws + WS_WGU) + (size_t)L * 2 * DFF * 2048, T, 2 * DFF, 2048, 2048, 31}; pg8::StaticOrder S; S.init(T, 2 * DFF, F.G, bid);
            pg8::EpiSwiGLU8 E{(unsigned char*)ACT, DFF, 1.0f, ACT8_SCALE, RS}; pg8::gemm_phase<pg8::EpiSwiGLU8, pg8::StaticOrder, true, true, false>(ring, g, S, E);
            SEAM(pb + 5);
        }
        if (KON(11) && IN(pb + 5) && !((FFN_FP8 >> L) & 1) && !((DN_FP8 >> L) & 1)) {
            pg8::Gemm g{A, (const h16*)(ws + WS_WGU) + (size_t)L * 2 * DFF * 2048, T, 2 * DFF, 2048, 2048, 31}; pg8::StaticOrder S; S.init(T, 2 * DFF, F.G, bid);
            pg8::EpiSwiGLU E{ACT, DFF}; pg8::gemm_phase<pg8::EpiSwiGLU, pg8::StaticOrder, true, true>(ring, g, S, E);
            SEAM(pb + 5);
        }
        if (KON(12) && IN(pb + 6) && ((DN_FP8 >> L) & 1)) {
            pg8::Gemm g{ACT, (const h16*)(ws + WS_WDN) + (size_t)L * 2048 * DFF  , T, D, DFF / 2, DFF / 2, 31}; pg8::StaticOrder S; S.init(T, D, F.G, bid);
            pg8::EpiH16 E{Y, D, 1.0f / (W8_SCALE * ACT8_SCALE), nullptr}; pg8::gemm_phase<pg8::EpiH16, pg8::StaticOrder, true, true, true>(ring, g, S, E);
            SEAM(pb + 6);
        }
        if (KON(12) && IN(pb + 6) && !((DN_FP8 >> L) & 1)) {
            pg8::Gemm g{ACT, (const h16*)(ws + WS_WDN) + (size_t)L * 2048 * DFF, T, D, DFF, DFF, 31}; pg8::StaticOrder S; S.init(T, D, F.G, bid);
            pg8::EpiH16 E{Y, D, 1.0f, nullptr}; pg8::gemm_phase<pg8::EpiH16, pg8::StaticOrder, true, true>(ring, g, S, E);
            SEAM(pb + 6);
        }
        if (KON(13) && IN(pb + 7)) {
            ArgP a = argp(); const float* gains = a->gains + (size_t)L * 6 * D;
            if (L == 0) seam_phase<true, false, false, false, true>(F, Y, H, H, gains + 5 * D, nullptr, nullptr, RS);
            else seam_phase<false, false, false, true>(F, Y, H, a->out, gains + 5 * D, nullptr, nullptr);
            SEAM(pb + 7);
        }
    }
#if DBG_CHECK
    if (IN(22)) {
        const unsigned* dw = (const unsigned*)(ws + WS_CTL) + 1024;
        const bool f0 = __builtin_bit_cast(float, dw[0]) > 4e-3f, f1 = __builtin_bit_cast(float, dw[1]) > 2e-2f, f2 = dw[2] > 24u, f3 = __builtin_bit_cast(float, dw[3]) > 2e-2f, f4 = dw[4] > 0u;
        for (int m = F.vcu * NWAVES + F.wave; m < T; m += F.G * NWAVES) { const int r = m & 15;
            const bool z = (r < 8 && f0) || (r >= 8 && r < 12 && f1) || (r >= 12 && r < 14 && f2) || (r == 14 && f3) || (r == 15 && f4);
            if (z) for (int j = 0; j < 8; ++j) ((f32x4*)(argp()->out + (size_t)m * D))[F.lane + 64 * j] = (f32x4){0.f, 0.f, 0.f, 0.f}; }
    }
#endif
#undef IN
#undef SEAM
}

extern "C" void kernel_launch(void* const* d_in, const int* in_sizes, int n_in, void* d_out, int out_size, void* d_ws, size_t ws_size, hipStream_t stream) {
    static int grid = 0;
    if (grid == 0) {
        if (n_in != 14 || in_sizes[0] != T * D || out_size != T * D || ws_size < WS_END) {
            fprintf(stderr, "kernel_launch: built for 14 inputs, x/out of %d floats, >= %zu bytes of workspace; got n_in %d, in0 %d, out %d, ws %zu; nothing launched\n", T * D, (size_t)WS_END, n_in, n_in > 0 ? in_sizes[0] : -1, out_size, ws_size);
            grid = -1; return; }
        int dev = 0, cus = 0, per_cu = 0;
        if (hipGetDevice(&dev) != hipSuccess || hipDeviceGetAttribute(&cus, hipDeviceAttributeMultiprocessorCount, dev) != hipSuccess) { fprintf(stderr, "kernel_launch: device query failed\n"); grid = -1; return; }
        if (hipFuncSetAttribute((const void*)trunk_fwd, hipFuncAttributeMaxDynamicSharedMemorySize, LDS_BYTES) != hipSuccess) { fprintf(stderr, "kernel_launch: hipFuncSetAttribute failed\n"); grid = -1; return; }
        if (hipOccupancyMaxActiveBlocksPerMultiprocessor(&per_cu, (const void*)trunk_fwd, NWAVES * 64, LDS_BYTES) != hipSuccess || per_cu < 1)
            fprintf(stderr, "kernel_launch: note: occupancy query reports %d workgroups per CU\n", per_cu);
        (void)hipGetLastError();
        grid = cus;
    }
    if (grid < 0) return;
    if (hipMemsetAsync((char*)d_ws + WS_CTL, 0, CTL_ZERO_BYTES, stream) != hipSuccess) { fprintf(stderr, "kernel_launch: memset failed\n"); return; }
    Args a{};
    a.x = (const float*)d_in[0]; a.mem = (const float*)d_in[1]; a.pos = (const int*)d_in[2]; a.gains = (const float*)d_in[3]; a.mem_norm = (const float*)d_in[4];
    a.pool_w = (const float*)d_in[5]; a.pool_scale = (const float*)d_in[6]; a.w_in = (const float*)d_in[7]; a.w_out = (const float*)d_in[8]; a.wq = (const float*)d_in[9];
    a.wkv = (const float*)d_in[10]; a.wo = (const float*)d_in[11]; a.wgu = (const float*)d_in[12]; a.wdn = (const float*)d_in[13];
    a.out = (float*)d_out; a.ws = (unsigned char*)d_ws;
    for (int i = 0; i < 16; ++i) a.inv_freq[i] = (float)pow(500000.0, -(double)(2 * i) / 32.0);
    a.pad = 0;
#if MK_LAUNCH_PER_PHASE
    for (int p = 0; p < N_PHASES; ++p) { a.ph_lo = p; a.ph_hi = p + 1; a.li = p;
        hipLaunchKernelGGL(trunk_fwd, dim3(grid), dim3(NWAVES * 64), LDS_BYTES, stream, a); }
#else
    a.ph_lo = 0; a.ph_hi = N_PHASES; a.li = 0;
    hipLaunchKernelGGL(trunk_fwd, dim3(grid), dim3(NWAVES * 64), LDS_BYTES, stream, a);
#endif
    const hipError_t le = hipPeekAtLastError();
    if (le != hipSuccess) fprintf(stderr, "kernel_launch: launch failed: %s\n", hipGetErrorName(le));
}
```

```cpp
#include <hip/hip_runtime.h>
#include <cstdio>
#include <cstdint>
#include <cmath>

#define LAS __attribute__((address_space(3)))
#define GAS __attribute__((address_space(1)))
typedef _Float16 h16;
typedef _Float16 half8 __attribute__((ext_vector_type(8)));
typedef _Float16 half4 __attribute__((ext_vector_type(4)));
typedef _Float16 half2v __attribute__((ext_vector_type(2)));
typedef float f32x4 __attribute__((ext_vector_type(4)));
typedef float f32x2 __attribute__((ext_vector_type(2)));
__device__ __forceinline__ f32x2 ix5_pkadd(f32x2 a, f32x2 b) { f32x2 r; asm("v_pk_add_f32 %0, %1, %2" : "=v"(r) : "v"(a), "v"(b)); return r; }
typedef float f32x16 __attribute__((ext_vector_type(16)));
typedef unsigned u32x4 __attribute__((ext_vector_type(4)));
typedef unsigned u32x2 __attribute__((ext_vector_type(2)));
typedef int v4i32 __attribute__((ext_vector_type(4)));
typedef int v8i32 __attribute__((ext_vector_type(8)));
typedef int v2i32 __attribute__((ext_vector_type(2)));

__device__ __forceinline__ unsigned pkh(float a, float b) { half2v v; v.x = (h16)a; v.y = (h16)b; return __builtin_bit_cast(unsigned, v); }

__device__ __forceinline__ unsigned pk8(float a, float b, float c, float d) { int w = __builtin_amdgcn_cvt_pk_fp8_f32(a, b, 0, false); w = __builtin_amdgcn_cvt_pk_fp8_f32(c, d, w, true); return (unsigned)w; }

constexpr int SEQ = 16384, NKV = 4, HD = 128;
namespace pg8 {
#define PG8_LAS __attribute__((address_space(3)))
constexpr int BM = 256, BK = 64, HALF = 128, HTB = HALF * BK * 2  , STAGE_BYTES = 8 * HTB, NXCD = 8, WGM = 8;

__host__ __device__ __forceinline__ int lds_byte(int r, int c) { const int st = (r >> 4) * 2 + (c >> 5), rr = r & 15, cc = c & 31, ob = rr * 64 + cc * 2; return st * 1024 + (ob ^ (((ob >> 9) & 1) << 5)); }
__host__ __device__ __forceinline__ void stage_rc(int b, int& R, int& C) { const int st = b / 1024, sb = b % 1024, swz = sb ^ (((sb >> 9) & 1) << 5); R = (st >> 1) * 16 + swz / 64; C = (st & 1) * 32 + (swz % 64) / 2; }
__host__ __device__ __forceinline__ int perm32(int rho) { const int n = rho >> 4, i = rho & 15; return 8 * (i >> 2) + 4 * n + (i & 3); }

struct Unit { int pm, pn; };
struct Gemm { const h16* A; const h16* Bt; int M, N, K, lda, kshift; };

struct StaticOrder {
    int nM, nN, nwg, G, c;
    __host__ __device__ void init(int M, int N, int G_, int c_) { nM = M / BM; nN = N / BM; nwg = nM * nN; G = G_; c = c_; }
    __host__ __device__ bool next(int i, Unit& u) const {
        const long L = (long)i * G + c; if (L >= nwg) return false;
        int wgid = (int)L; { const int q = nwg / NXCD, r = nwg % NXCD, xcd = wgid % NXCD, off = wgid / NXCD; wgid = (xcd < r ? xcd * (q + 1) : r * (q + 1) + (xcd - r) * q) + off; }
        const int nig = WGM * nN, gid = wgid / nig, fm = gid * WGM, gsz = (nM - fm) < WGM ? (nM - fm) : WGM;
        u.pm = fm + ((wgid % nig) % gsz); u.pn = (wgid % nig) / gsz; return true;
    }
    __device__ __forceinline__ void a_ready(const Unit&) const {}
    __device__ __forceinline__ void done(const Unit&) const {}
};

struct EpiF32 {
    static constexpr bool PERM = false, AFTER_DRAIN = false;
    float* C; int ldc; float scale;
    __device__ __forceinline__ void operator()(const f32x4 (&acc)[2][2][4][2], const Unit& u, int wr, int wc, int fr, int fq) const {
        const int row0 = u.pm * BM + wr * 64 + fr, col0 = u.pn * BM + wc * 32 + 4 * fq;
#pragma unroll
        for (int ai = 0; ai < 2; ++ai)
#pragma unroll
            for (int m = 0; m < 4; ++m) { float* rowp = C + (size_t)(row0 + ai * HALF + m * 16) * ldc + col0;
#pragma unroll
                for (int bj = 0; bj < 2; ++bj)
#pragma unroll
                    for (int n = 0; n < 2; ++n) *(f32x4*)(rowp + bj * HALF + n * 16) = acc[ai][bj][m][n] * scale; }
    }
};
struct EpiF32S {
    static constexpr bool PERM = false, AFTER_DRAIN = false;
    float* C; int ldc; float scale;
    __device__ __forceinline__ void operator()(const f32x4 (&acc)[2][2][4][2], const Unit& u, int wr, int wc, int fr_, int fq_) const {
        int l = (int)(threadIdx.x & 63u); asm volatile("" : "+v"(l)); const int fr = l & 15, fq = l >> 4;
        const int row0 = u.pm * BM + wr * 64 + fr, col0 = u.pn * BM + wc * 32 + 4 * fq;
#pragma unroll
        for (int ai = 0; ai < 2; ++ai)
#pragma unroll
            for (int m = 0; m < 4; ++m) { float* rowp = C + (size_t)(row0 + ai * HALF + m * 16) * ldc + col0;
#pragma unroll
                for (int bj = 0; bj < 2; ++bj)
#pragma unroll
                    for (int n = 0; n < 2; ++n) *(f32x4*)(rowp + bj * HALF + n * 16) = acc[ai][bj][m][n] * scale; }
    }
};
struct EpiH16 {
    static constexpr bool PERM = true, AFTER_DRAIN = false;
    h16* O; int ldc; float scale; const float* rs;
    __device__ __forceinline__ void operator()(const f32x4 (&acc)[2][2][4][2], const Unit& u, int wr, int wc, int fr, int fq) const {
        const int row0 = u.pm * BM + wr * 64 + fr, col0 = u.pn * BM + wc * 32 + 8 * fq;
#pragma unroll
        for (int ai = 0; ai < 2; ++ai)
#pragma unroll
            for (int m = 0; m < 4; ++m) { h16* rowp = O + (size_t)(row0 + ai * HALF + m * 16) * ldc + col0; const float sc_ = rs ? scale * rs[row0 + ai * HALF + m * 16] : scale;
#pragma unroll
                for (int bj = 0; bj < 2; ++bj) { const f32x4 v0 = acc[ai][bj][m][0] * sc_, v1 = acc[ai][bj][m][1] * sc_;
                    u32x4 w; w.x = pkh(v0[0], v0[1]); w.y = pkh(v0[2], v0[3]); w.z = pkh(v1[0], v1[1]); w.w = pkh(v1[2], v1[3]);
                    *(u32x4*)(rowp + bj * HALF) = w; } }
    }
};
__device__ __forceinline__ float silu_mul(float g, float u) { return g * u * __builtin_amdgcn_rcpf(1.0f + __builtin_amdgcn_exp2f(g * -1.44269504089f)); }
struct EpiSwiGLU {
    static constexpr bool PERM = true, AFTER_DRAIN = false;
    h16* O; int ldc;
    __device__ __forceinline__ void operator()(const f32x4 (&acc)[2][2][4][2], const Unit& u, int wr, int wc, int fr, int fq) const {
        const int row0 = u.pm * BM + wr * 64 + fr, col0 = u.pn * HALF + wc * 32 + 8 * fq;
#pragma unroll
        for (int ai = 0; ai < 2; ++ai)
#pragma unroll
            for (int m = 0; m < 4; ++m) { h16* rowp = O + (size_t)(row0 + ai * HALF + m * 16) * ldc + col0;
                const f32x4 g0 = acc[ai][0][m][0], g1 = acc[ai][0][m][1], u0 = acc[ai][1][m][0], u1 = acc[ai][1][m][1];
                u32x4 w; w.x = pkh(silu_mul(g0[0], u0[0]), silu_mul(g0[1], u0[1])); w.y = pkh(silu_mul(g0[2], u0[2]), silu_mul(g0[3], u0[3]));
                w.z = pkh(silu_mul(g1[0], u1[0]), silu_mul(g1[1], u1[1])); w.w = pkh(silu_mul(g1[2], u1[2]), silu_mul(g1[3], u1[3]));
                *(u32x4*)rowp = w; }
    }
};
struct EpiSwiGLU8 {
    static constexpr bool PERM = true, AFTER_DRAIN = false;
    unsigned char* O; int ldc; float inscale, outscale; const float* rs;
    __device__ __forceinline__ void operator()(const f32x4 (&acc)[2][2][4][2], const Unit& u, int wr, int wc, int fr_, int fq_) const {
        int l = (int)(threadIdx.x & 63u); asm volatile("" : "+v"(l)); const int fr = l & 15, fq = l >> 4;
        const int row0 = u.pm * BM + wr * 64 + fr, col0 = u.pn * HALF + wc * 32 + 8 * fq;
#pragma unroll
        for (int ai = 0; ai < 2; ++ai)
#pragma unroll
            for (int m = 0; m < 4; ++m) { unsigned char* rowp = O + (size_t)(row0 + ai * HALF + m * 16) * ldc + col0;
                const float is_ = rs ? inscale * rs[row0 + ai * HALF + m * 16] : inscale;
                const f32x4 g0 = acc[ai][0][m][0] * is_, g1 = acc[ai][0][m][1] * is_, u0 = acc[ai][1][m][0] * (is_ * outscale), u1 = acc[ai][1][m][1] * (is_ * outscale);
                u32x2 w; w.x = pk8(silu_mul(g0[0], u0[0]), silu_mul(g0[1], u0[1]), silu_mul(g0[2], u0[2]), silu_mul(g0[3], u0[3]));
                w.y = pk8(silu_mul(g1[0], u1[0]), silu_mul(g1[1], u1[1]), silu_mul(g1[2], u1[2]), silu_mul(g1[3], u1[3]));
                *(u32x2*)rowp = w; }
    }
};
struct EpiInProj {
    static constexpr bool PERM = true, AFTER_DRAIN = false;
    h16 *Q, *KV, *IQ, *IK; float* IW; const float* rope; float scale; const float* rs;
    __device__ __forceinline__ void operator()(const f32x4 (&acc)[2][2][4][2], const Unit& u, int wr, int wc, int fr_, int fq_) const {
        int l = (int)(threadIdx.x & 63u); asm volatile("" : "+v"(l));
        const int fr = l & 15, fq = l >> 4;
        const int pn = u.pn, row0 = u.pm * BM + wr * 64 + fr;
        h16* base; int ldc, colt; bool rot0 = true, rot1 = true;
        if (pn < 8) { base = Q; ldc = 2048; colt = pn * 256; }
        else if (pn < 10) { base = KV; ldc = 1024; colt = (pn - 8) * 256; }
        else if (pn < 12) { base = KV; ldc = 1024; colt = 512 + (pn - 10) * 256; rot0 = false; rot1 = false; }
        else if (pn < 20) { base = IQ; ldc = 2048; colt = (pn - 12) * 256; }
        else { base = IK; ldc = 128; colt = 0; rot1 = false; }
        const int col0 = colt + wc * 32 + 8 * fq;
#pragma unroll
        for (int ai = 0; ai < 2; ++ai)
#pragma unroll
            for (int m = 0; m < 4; ++m) { const int row = row0 + ai * HALF + m * 16;
                f32x4 cs[2], sn[2];
                if (wc == 0) { const float* rp = rope + (size_t)row * 32 + 8 * (fq & 1);
                    cs[0] = *(const f32x4*)(rp); cs[1] = *(const f32x4*)(rp + 4); sn[0] = *(const f32x4*)(rp + 16); sn[1] = *(const f32x4*)(rp + 20);
                    if (fq < 2) { sn[0] = -sn[0]; sn[1] = -sn[1]; } }
#pragma unroll
                for (int bj = 0; bj < 2; ++bj) {
                    const float sc_ = scale * rs[row];
                    f32x4 v0 = acc[ai][bj][m][0] * sc_, v1 = acc[ai][bj][m][1] * sc_;
                    if (wc == 0 && (bj == 0 ? rot0 : rot1)) {
                        f32x4 p0, p1;
#pragma unroll
                        for (int e = 0; e < 4; ++e) { p0[e] = __shfl_xor(v0[e], 32); p1[e] = __shfl_xor(v1[e], 32); }
                        v0 = v0 * cs[0] + p0 * sn[0]; v1 = v1 * cs[1] + p1 * sn[1];
                    }
                    if (pn >= 8 && pn < 12) {
                        const int j = ((pn - 8) & 1) * 2 + bj, b = row / SEQ, tt = row % SEQ;
                        unsigned char* dst = (unsigned char*)KV + (pn >= 10 ? (size_t)16 * 1024 * 1024 : (size_t)0) + ((size_t)(b * NKV + j) * SEQ + tt) * HD + wc * 32 + 8 * fq;
                        u32x2 w; w.x = pk8(v0[0], v0[1], v0[2], v0[3]); w.y = pk8(v1[0], v1[1], v1[2], v1[3]); *(u32x2*)dst = w;
                    } else if (pn == 20 && bj == 1) {
                        if (wc == 0 && fq < 2) { float* wp = IW + (size_t)row * 16 + 8 * fq; *(f32x4*)wp = v0; *(f32x4*)(wp + 4) = v1; }
                    } else if (pn < 8) {
                        const float c2 = 0.08838834764831845f * 1.44269504089f;
                        v0 = v0 * c2; v1 = v1 * c2;
                        u32x4 w; w.x = pk8(v0[0], v0[1], v0[2], v0[3]); w.y = pk8(v1[0], v1[1], v1[2], v1[3]);
                        w.z = pk8(v0[0] - __builtin_amdgcn_cvt_f32_fp8((int)w.x, 0), v0[1] - __builtin_amdgcn_cvt_f32_fp8((int)w.x, 1), v0[2] - __builtin_amdgcn_cvt_f32_fp8((int)w.x, 2), v0[3] - __builtin_amdgcn_cvt_f32_fp8((int)w.x, 3));
                        w.w = pk8(v1[0] - __builtin_amdgcn_cvt_f32_fp8((int)w.y, 0), v1[1] - __builtin_amdgcn_cvt_f32_fp8((int)w.y, 1), v1[2] - __builtin_amdgcn_cvt_f32_fp8((int)w.y, 2), v1[3] - __builtin_amdgcn_cvt_f32_fp8((int)w.y, 3));
                        *(u32x4*)(base + (size_t)row * ldc + col0 + bj * HALF) = w;
                    } else {
                        u32x4 w; w.x = pkh(v0[0], v0[1]); w.y = pkh(v0[2], v0[3]); w.z = pkh(v1[0], v1[1]); w.w = pkh(v1[2], v1[3]);
                        *(u32x4*)(base + (size_t)row * ldc + col0 + bj * HALF) = w;
                    }
                }
                asm volatile("" ::: "memory"); }
    }
};

template <class Epi, class Sched, bool ALIGN_EPI = false, bool SP2 = false, bool FP8 = false>
__device__ __forceinline__ void gemm_phase(PG8_LAS unsigned char* lds, const Gemm g, const Sched& S, const Epi& E) {
    int tid_ = (int)threadIdx.x; asm volatile("" : "+v"(tid_));
    const int tid = tid_, wid = __builtin_amdgcn_readfirstlane(tid >> 6), lane = tid & 63, wr = wid >> 2, wc = wid & 3, fr = lane & 15, fq = lane >> 4;
    const int K = g.K, nt = K / BK;
    unsigned voffA[2], voffB[2];
#pragma unroll
    for (int i = 0; i < 2; ++i) { int R, C; stage_rc(tid * 16 + i * 8192, R, C); const int Rb = Epi::PERM ? ((R & ~31) + perm32(R & 31)) : R;
        voffA[i] = (unsigned)(R * g.lda + C) * 2u; voffB[i] = (unsigned)(Rb * K + C) * 2u; }
    const size_t kstep = (size_t)(BK * 2);
    const size_t hstepA = (size_t)HALF * g.lda * 2, hstepB = (size_t)HALF * K * 2;
    const size_t tstepA = 2 * hstepA, tstepB = 2 * hstepB;
    const int kshift = g.kshift;
    const __amdgpu_buffer_rsrc_t rsrcA = __builtin_amdgcn_make_buffer_rsrc((void*)g.A, 0, 0x7fffffff, 0x00020000), rsrcB = __builtin_amdgcn_make_buffer_rsrc((void*)g.Bt, 0, 0x7fffffff, 0x00020000);
    const unsigned r64A = 64u * (unsigned)g.lda * 2u, r64B = 64u * (unsigned)K * 2u;
    const unsigned ldsw = (unsigned)wid * 1024u;
    const int aoff = lds_byte(wr * 64 + fr, fq * 8), boff = lds_byte(wc * 32 + fr, fq * 8);
#define PG8_SA(b, h) (((b) * 2 + (h)) * HTB)
#define PG8_SB(b, h) ((4 + (b) * 2 + (h)) * HTB)
#define PG8_STAGE(bufoff, gbase, voff) do { const bool isA_ = (const void*)(voff) == (const void*)voffA; _Pragma("unroll") for (int _i = 0; _i < 2; ++_i) \
        __builtin_amdgcn_raw_ptr_buffer_load_lds(isA_ ? rsrcA : rsrcB, (PG8_LAS void*)(lds + (bufoff) + ldsw + _i * 8192), 16, (int)(voff)[0], \
            (int)((unsigned)((const char*)(gbase) - (isA_ ? (const char*)g.A : (const char*)g.Bt)) + (unsigned)_i * (isA_ ? r64A : r64B)), 0, 0); } while (0)
#define PG8_LDA(dst, b, h) do { if constexpr (FP8) { _Pragma("unroll") for (int m = 0; m < 4; ++m) dst##8[m] = __builtin_shufflevector(*(const PG8_LAS v4i32*)(lds + PG8_SA(b, h) + aoff + m * 2048), *(const PG8_LAS v4i32*)(lds + PG8_SA(b, h) + aoff + m * 2048 + 1024), 0, 1, 2, 3, 4, 5, 6, 7); } \
    else { _Pragma("unroll") for (int m = 0; m < 4; ++m) _Pragma("unroll") for (int k = 0; k < 2; ++k) dst[m][k] = *(const PG8_LAS half8*)(lds + PG8_SA(b, h) + aoff + m * 2048 + k * 1024); } } while (0)
#define PG8_LDB(dst, b, h) do { if constexpr (FP8) { _Pragma("unroll") for (int n = 0; n < 2; ++n) dst##8[n] = __builtin_shufflevector(*(const PG8_LAS v4i32*)(lds + PG8_SB(b, h) + boff + n * 2048), *(const PG8_LAS v4i32*)(lds + PG8_SB(b, h) + boff + n * 2048 + 1024), 0, 1, 2, 3, 4, 5, 6, 7); } \
    else { _Pragma("unroll") for (int n = 0; n < 2; ++n) _Pragma("unroll") for (int k = 0; k < 2; ++k) dst[n][k] = *(const PG8_LAS half8*)(lds + PG8_SB(b, h) + boff + n * 2048 + k * 1024); } } while (0)
#define PG8_MMA(ai, bj, At, Bt) do { __builtin_amdgcn_s_setprio(1); _Pragma("unroll") for (int m = 0; m < 4; ++m) _Pragma("unroll") for (int n = 0; n < 2; ++n) { \
        if constexpr (FP8) asm volatile("v_mfma_f32_16x16x128_f8f6f4 %0, %1, %2, %0" : "+v"(acc[ai][bj][m][n]) : "v"(Bt##8[n]), "v"(At##8[m]));     \
        else { _Pragma("unroll") for (int k = 0; k < 2; ++k) acc[ai][bj][m][n] = __builtin_amdgcn_mfma_f32_16x16x32_f16(Bt[n][k], At[m][k], acc[ai][bj][m][n], 0, 0, 0); } } \
        __builtin_amdgcn_s_setprio(0); } while (0)
#define PG8_WAIT_V(n) asm volatile("s_waitcnt vmcnt(" #n ")" ::: "memory")
#define PG8_WAIT_L(n) asm volatile("s_waitcnt lgkmcnt(" #n ")" ::: "memory")
#define PG8_BAR __builtin_amdgcn_s_barrier()
#define PG8_SCHED __builtin_amdgcn_sched_barrier(0)
    Unit cur, nxt; int ui = 0;
    if (!S.next(0, cur)) return;
    f32x4 acc[2][2][4][2];
#pragma unroll
    for (int a = 0; a < 2; ++a)
#pragma unroll
        for (int b = 0; b < 2; ++b)
#pragma unroll
            for (int m = 0; m < 4; ++m)
#pragma unroll
                for (int n = 0; n < 2; ++n) acc[a][b][m][n] = (f32x4){0.f, 0.f, 0.f, 0.f};
    half8 At[4][2], B0[2][2], B1[2][2]; v8i32 At8[4], B08[2], B18[2];
    const char* cA = (const char*)g.A + (size_t)cur.pm * tstepA + (size_t)((cur.pn >> kshift) * K) * 2; const char* cB = (const char*)g.Bt + (size_t)cur.pn * tstepB;
    S.a_ready(cur);
    if constexpr (SP2) {
        PG8_STAGE(PG8_SB(0, 0), cB, voffB); PG8_STAGE(PG8_SB(0, 1), cB + hstepB, voffB); PG8_STAGE(PG8_SA(0, 0), cA, voffA); PG8_STAGE(PG8_SA(0, 1), cA + hstepA, voffA);
        if (wr == 1) PG8_BAR;
        PG8_WAIT_V(2); PG8_BAR;
        PG8_STAGE(PG8_SB(1, 0), cB + kstep, voffB); PG8_STAGE(PG8_SA(1, 0), cA + kstep, voffA); PG8_STAGE(PG8_SB(1, 1), cB + hstepB + kstep, voffB);
        PG8_WAIT_V(6); PG8_BAR;
    } else {
        PG8_STAGE(PG8_SB(0, 0), cB, voffB); PG8_STAGE(PG8_SA(0, 0), cA, voffA); PG8_STAGE(PG8_SB(0, 1), cB + hstepB, voffB); PG8_STAGE(PG8_SA(0, 1), cA + hstepA, voffA);
        if (wr == 1) PG8_BAR;
        PG8_WAIT_V(4); PG8_BAR;
        PG8_STAGE(PG8_SB(1, 0), cB + kstep, voffB); PG8_STAGE(PG8_SA(1, 0), cA + kstep, voffA); PG8_STAGE(PG8_SB(1, 1), cB + hstepB + kstep, voffB);
        PG8_WAIT_V(6); PG8_BAR;
    }
    for (;;) {
        const bool has_next = S.next(ui + 1, nxt);
        const char* nA = has_next ? (const char*)g.A + (size_t)nxt.pm * tstepA + (size_t)((nxt.pn >> kshift) * K) * 2 : cA; const char* nB = has_next ? (const char*)g.Bt + (size_t)nxt.pn * tstepB : cB;
        for (int t = 0; t < nt; t += 2) {
            const bool last = (t == nt - 2);
            const char* a1 = cA + (size_t)(t + 1) * kstep;
            const char* a2 = last ? nA : cA + (size_t)(t + 2) * kstep; const char* b2 = last ? nB : cB + (size_t)(t + 2) * kstep;
            const char* a3 = a2 + kstep; const char* b3 = b2 + kstep;
            if (last && has_next) S.a_ready(nxt);
            if constexpr (SP2) {
            PG8_LDB(B0, 0, 0); PG8_LDB(B1, 0, 1); PG8_SCHED; PG8_LDA(At, 0, 0); PG8_STAGE(PG8_SA(1, 1), a1 + hstepA, voffA);
            PG8_WAIT_V(8); PG8_WAIT_L(0); PG8_BAR; PG8_MMA(0, 0, At, B0); PG8_MMA(0, 1, At, B1); PG8_BAR; PG8_SCHED;
            PG8_LDA(At, 0, 1); PG8_STAGE(PG8_SB(0, 0), b2, voffB); PG8_STAGE(PG8_SB(0, 1), b2 + hstepB, voffB); PG8_STAGE(PG8_SA(0, 0), a2, voffA);
            PG8_WAIT_V(8); PG8_WAIT_L(0); PG8_BAR; PG8_MMA(1, 0, At, B0); PG8_MMA(1, 1, At, B1); PG8_BAR; PG8_SCHED;
            PG8_LDB(B0, 1, 0); PG8_LDB(B1, 1, 1); PG8_SCHED; PG8_LDA(At, 1, 0); PG8_STAGE(PG8_SA(0, 1), a2 + hstepA, voffA);
            PG8_WAIT_V(8); PG8_WAIT_L(0); PG8_BAR; PG8_MMA(0, 0, At, B0); PG8_MMA(0, 1, At, B1); PG8_BAR; PG8_SCHED;
            PG8_LDA(At, 1, 1); PG8_STAGE(PG8_SB(1, 0), b3, voffB); PG8_STAGE(PG8_SB(1, 1), b3 + hstepB, voffB); PG8_STAGE(PG8_SA(1, 0), a3, voffA);
            PG8_WAIT_V(8); PG8_WAIT_L(0); PG8_BAR; PG8_MMA(1, 0, At, B0); PG8_MMA(1, 1, At, B1); PG8_BAR; PG8_SCHED;
            } else {
            PG8_LDB(B0, 0, 0); PG8_SCHED; PG8_LDA(At, 0, 0); PG8_STAGE(PG8_SA(1, 1), a1 + hstepA, voffA);
            PG8_WAIT_L(8); PG8_BAR; PG8_WAIT_L(0); PG8_MMA(0, 0, At, B0); PG8_BAR; PG8_SCHED;
            PG8_LDB(B1, 0, 1); PG8_STAGE(PG8_SB(0, 0), b2, voffB);
            PG8_BAR; PG8_WAIT_L(0); PG8_MMA(0, 1, At, B1); PG8_BAR;
            PG8_LDA(At, 0, 1); PG8_STAGE(PG8_SA(0, 0), a2, voffA);
            PG8_BAR; PG8_WAIT_L(0); PG8_MMA(1, 0, At, B0); PG8_BAR; PG8_SCHED;
            PG8_STAGE(PG8_SB(0, 1), b2 + hstepB, voffB);
            PG8_WAIT_V(6); PG8_BAR; PG8_MMA(1, 1, At, B1); PG8_BAR;
            PG8_LDB(B0, 1, 0); PG8_SCHED; PG8_LDA(At, 1, 0); PG8_STAGE(PG8_SA(0, 1), a2 + hstepA, voffA);
            PG8_WAIT_L(8); PG8_BAR; PG8_WAIT_L(0); PG8_MMA(0, 0, At, B0); PG8_BAR; PG8_SCHED;
            PG8_LDB(B1, 1, 1); PG8_STAGE(PG8_SB(1, 0), b3, voffB);
            PG8_BAR; PG8_WAIT_L(0); PG8_MMA(0, 1, At, B1); PG8_BAR;
            PG8_LDA(At, 1, 1); PG8_STAGE(PG8_SA(1, 0), a3, voffA);
            PG8_BAR; PG8_WAIT_L(0); PG8_MMA(1, 0, At, B0); PG8_BAR; PG8_SCHED;
            PG8_STAGE(PG8_SB(1, 1), b3 + hstepB, voffB);
            PG8_WAIT_V(6); PG8_BAR; PG8_MMA(1, 1, At, B1); PG8_BAR;
            }
        }
        if constexpr (FP8) { asm volatile("s_nop 15\n\ts_nop 15\n\ts_nop 15\n\ts_nop 15" ::: "memory"); __builtin_amdgcn_sched_barrier(0); }
        if constexpr (ALIGN_EPI) { if (wr == 0) PG8_BAR; }
        if constexpr (!Epi::AFTER_DRAIN) { E(acc, cur, wr, wc, fr, fq); S.done(cur); }
        if (!has_next) break;
#pragma unroll
        for (int a = 0; a < 2; ++a)
#pragma unroll
            for (int b = 0; b < 2; ++b)
#pragma unroll
                for (int m = 0; m < 4; ++m)
#pragma unroll
                    for (int n = 0; n < 2; ++n) acc[a][b][m][n] = (f32x4){0.f, 0.f, 0.f, 0.f};
        cur = nxt; cA = nA; cB = nB; ++ui;
        if constexpr (ALIGN_EPI) { if (wr == 1) PG8_BAR; }
    }
    PG8_WAIT_V(0);
    if constexpr (!ALIGN_EPI) { if (wr == 0) PG8_BAR; }
    PG8_BAR;

#undef PG8_SA
#undef PG8_SB
#undef PG8_STAGE
#undef PG8_LDA
#undef PG8_LDB
#undef PG8_MMA
#undef PG8_WAIT_V
#undef PG8_WAIT_L
#undef PG8_BAR
#undef PG8_SCHED
}
}

constexpr int NB = 2, T = NB * SEQ, D = 2048, DFF = 5632, NMEM = 256;
constexpr int DSA_N = 5264, DSA_NP = 5376;
constexpr int NHEAD = 16, TOPK = 256;
constexpr int XW = 512;
constexpr float NORM_EPS = 1e-6f;
constexpr int NWAVES = 8;
#ifndef FFN_FP8
#define FFN_FP8 2
#endif
#ifndef DN_FP8
#define DN_FP8 3
#endif
#ifndef IDX_PROBE_MMA
#define IDX_PROBE_MMA 0
#endif
#ifndef IDX16
#define IDX16 2
#endif
#ifndef MK_LAUNCH_PER_PHASE
#define MK_LAUNCH_PER_PHASE 0
#endif

constexpr size_t MiB = 1u << 20;
constexpr size_t WS_CTL = 0, CTL_ZERO_BYTES = 1 * MiB;
constexpr size_t WS_ROPE = 1 * MiB;
constexpr size_t WS_MEMN = 5 * MiB;
constexpr size_t WS_KVM = 7 * MiB;
constexpr size_t WS_WPOOL = 9 * MiB;
constexpr size_t WS_WIN = 11 * MiB;
constexpr size_t WS_WOUT = 32 * MiB;
constexpr size_t WS_WQ = 40 * MiB;
constexpr size_t WS_WKV = 44 * MiB;
constexpr size_t WS_WO = 52 * MiB;
constexpr size_t WS_WGU = 56 * MiB;
constexpr size_t WS_WDN = 144 * MiB;
constexpr size_t WS_XQ = 188 * MiB;
constexpr size_t WS_A = 220 * MiB;
constexpr size_t WS_Y = 348 * MiB;
constexpr size_t WS_ACT = 604 * MiB;
constexpr size_t WS_KVM4 = 956 * MiB;
constexpr size_t WS_END = 964 * MiB;
constexpr size_t WS_Q = WS_ACT, WS_KV = WS_ACT + 128 * MiB, WS_IQ = WS_ACT + 192 * MiB, WS_IK = WS_ACT + 320 * MiB, WS_IW = WS_ACT + 328 * MiB, WS_IDX = WS_ACT + 330 * MiB;
constexpr size_t WS_LISTS = WS_Y;
constexpr size_t WS_H = WS_Y + 128 * MiB;
constexpr int LIST_CAP = 1024;
static_assert(WS_IDX + (size_t)T * TOPK * 2 <= WS_END, "ws map");
constexpr float W8_SCALE = 64.0f, ACT8_SCALE = 8.0f;
constexpr int CW_BAR = 4096;

constexpr int RING_OFF = 0, RING_BYTES = 159744;
constexpr int MISC_OFF = RING_BYTES;
constexpr int LDS_BYTES = 163840;

typedef GAS unsigned gu32;
#define LDS_WAIT() asm volatile("s_waitcnt lgkmcnt(0)" ::: "memory")
#define VM_WAIT() asm volatile("s_waitcnt vmcnt(0)" ::: "memory")

#define XB_TMO      128
#define XB_XCNT(j)  (256  + 64 * (j))
#define XB_XSUB(j)  (1280 + 64 * (j))
#define XB_XGEN(j)  (2304 + 64 * (j))
#define XB_TOP      3328
#define XB_TOPGEN   3392
#define XCD_BAR_WORDS 3456
#define XB_SPIN_CAP (1u << 23)
__device__ __forceinline__ unsigned xb_ld(unsigned* p)              { return __hip_atomic_load(p, __ATOMIC_RELAXED, __HIP_MEMORY_SCOPE_AGENT); }
__device__ __forceinline__ unsigned xb_add(unsigned* p, unsigned v) { return __hip_atomic_fetch_add(p, v, __ATOMIC_RELAXED, __HIP_MEMORY_SCOPE_AGENT); }
__device__ __forceinline__ unsigned xb_xcc_id() { return (unsigned)__builtin_amdgcn_s_getreg((3 << 11) | 20) & 0xFu; }
#define XB_SPIN(cond, bar) do { unsigned _sp = 0; while (cond) { __builtin_amdgcn_s_sleep(1); \
    if ((++_sp & 255u) == 0u) { if (xb_ld(&(bar)[XB_TMO])) break; if (_sp > XB_SPIN_CAP) { atomicAdd(&(bar)[XB_TMO], 1u); break; } } } } while (0)
struct XcdBarrier { unsigned* bar; unsigned x; volatile LAS unsigned* st; };
__device__ __forceinline__ XcdBarrier xcd_barrier_post(unsigned* bar, volatile LAS unsigned* st) {
    XcdBarrier b; b.bar = bar; b.x = xb_xcc_id(); b.st = st;
    if (threadIdx.x == 0) (void)xb_add(&bar[XB_XCNT(b.x)], 1u);
    return b;
}
__device__ __forceinline__ void xcd_barrier_complete(unsigned* bar, unsigned x, unsigned& nloc, unsigned& nx) {
    const unsigned G = gridDim.x * gridDim.y * gridDim.z;
    unsigned sum, cnt, mine, sp = 0u;
    for (;;) {
        sum = 0u; cnt = 0u; mine = 0u;
#pragma unroll
        for (unsigned j = 0; j < 16; ++j) { const unsigned c = xb_ld(&bar[XB_XCNT(j)]); sum += c; cnt += (c > 0u) ? 1u : 0u; mine = (j == x) ? c : mine; }
        if (sum == G) break;
        __builtin_amdgcn_s_sleep(1);
        if ((++sp & 255u) == 0u) { if (xb_ld(&bar[XB_TMO])) break; if (sp > XB_SPIN_CAP) { atomicAdd(&bar[XB_TMO], 1u); break; } }
    }
    nloc = mine > 0u ? mine : 1u; nx = cnt > 0u ? cnt : 1u;
}
__device__ __forceinline__ void xcd_barrier(const XcdBarrier& b) {
    asm volatile("s_waitcnt vmcnt(0)" ::: "memory");
    __syncthreads();
    if (threadIdx.x == 0) {
        unsigned* bar = b.bar;
        __builtin_amdgcn_s_waitcnt(0);
        unsigned nloc = b.st[0], nx = b.st[1];
        if (nloc == 0u) { xcd_barrier_complete(bar, b.x, nloc, nx); b.st[0] = nloc; b.st[1] = nx; }
        const unsigned old = xb_add(&bar[XB_XSUB(b.x)], 1u);
        const unsigned gen = old / nloc;
        if (old + 1u == (gen + 1u) * nloc) {
            __builtin_amdgcn_fence(__ATOMIC_RELEASE, "agent");
            asm volatile("s_waitcnt vmcnt(0)" ::: "memory");
            const unsigned og = xb_add(&bar[XB_TOP], 1u);
            const unsigned tg = og / nx;
            if (og + 1u == (tg + 1u) * nx) xb_add(&bar[XB_TOPGEN], 1u);
            else XB_SPIN(xb_ld(&bar[XB_TOPGEN]) == tg, bar);
            __builtin_amdgcn_fence(__ATOMIC_ACQUIRE, "agent");
            xb_add(&bar[XB_XGEN(b.x)], 1u);
            asm volatile("s_waitcnt vmcnt(0)" ::: "memory");
        } else {
            XB_SPIN(xb_ld(&bar[XB_XGEN(b.x)]) == gen, bar);
            __builtin_amdgcn_fence(__ATOMIC_ACQUIRE, "agent");
            asm volatile("s_waitcnt vmcnt(0)" ::: "memory");
        }
    }
    __syncthreads();
}

struct Frame {
    LAS unsigned char* lds;
    volatile LAS unsigned* MISC;
    int tid, lane, wave;
    int vcu, G;
};
__device__ __forceinline__ Frame fresh(const Frame& F0) { Frame F = F0; int t = (int)threadIdx.x; asm volatile("" : "+v"(t)); F.tid = t; F.lane = t & 63; F.wave = __builtin_amdgcn_readfirstlane(t >> 6); return F; }
template <int CTRL> __device__ __forceinline__ float dpp_mov(float v) { return __builtin_bit_cast(float, __builtin_amdgcn_update_dpp(0, __builtin_bit_cast(int, v), CTRL, 0xF, 0xF, true)); }
__device__ __forceinline__ float wave_sum_dpp(float v) {
    v += dpp_mov<0xB1>(v);
    v += dpp_mov<0x4E>(v);
    v += dpp_mov<0x141>(v);
    v += dpp_mov<0x140>(v);
    const float s0 = __builtin_bit_cast(float, __builtin_amdgcn_readlane(__builtin_bit_cast(int, v), 0)), s1 = __builtin_bit_cast(float, __builtin_amdgcn_readlane(__builtin_bit_cast(int, v), 16));
    const float s2 = __builtin_bit_cast(float, __builtin_amdgcn_readlane(__builtin_bit_cast(int, v), 32)), s3 = __builtin_bit_cast(float, __builtin_amdgcn_readlane(__builtin_bit_cast(int, v), 48));
    return (s0 + s1) + (s2 + s3);
}
__device__ __forceinline__ float max2(float a, float b) { float r; asm("v_max_f32 %0, %1, %2" : "=v"(r) : "v"(a), "v"(b)); return r; }
__device__ __forceinline__ float wave_max_dpp(float v) {
    v = max2(v, dpp_mov<0xB1>(v)); v = max2(v, dpp_mov<0x4E>(v)); v = max2(v, dpp_mov<0x141>(v)); v = max2(v, dpp_mov<0x140>(v));
    const float s0 = __builtin_bit_cast(float, __builtin_amdgcn_readlane(__builtin_bit_cast(int, v), 0)), s1 = __builtin_bit_cast(float, __builtin_amdgcn_readlane(__builtin_bit_cast(int, v), 16));
    const float s2 = __builtin_bit_cast(float, __builtin_amdgcn_readlane(__builtin_bit_cast(int, v), 32)), s3 = __builtin_bit_cast(float, __builtin_amdgcn_readlane(__builtin_bit_cast(int, v), 48));
    return max2(max2(s0, s1), max2(s2, s3));
}
__device__ __forceinline__ float wave_sum(float v) {
#pragma unroll
    for (int o = 1; o < 64; o <<= 1) v += __shfl_xor(v, o);
    return v;
}
__device__ __forceinline__ float rstd_of(float sumsq) { return 1.0f / sqrtf(sumsq * (1.0f / D) + NORM_EPS); }

__device__ __forceinline__ void transpose_item(const float* W, int ldw, int K, int k0, int scol, int nvalid, h16* WT, int drow, float scale, const float* colscale, const float* kscale, bool f8, LAS float* scr, int lane) {
    const int cn = scol + (lane & 31); const bool okc = cn < nvalid;
    float wv[32];
#pragma unroll
    for (int i = 0; i < 32; ++i) { const int kk = 2 * i + (lane >> 5); wv[i] = W[(size_t)(k0 + kk) * ldw + (okc ? cn : 0)]; }
#pragma unroll
    for (int i = 0; i < 32; ++i) { const int kk = 2 * i + (lane >> 5); scr[kk * 33 + (lane & 31)] = okc ? (kscale ? wv[i] * kscale[k0 + kk] : wv[i]) : 0.f; }
    LDS_WAIT(); asm volatile("" ::: "memory");
    const int c = lane & 7;
#pragma unroll
    for (int j = 0; j < 4; ++j) { const int n = (lane >> 3) + 8 * j; const LAS float* s = scr + (8 * c) * 33 + n;
        float sc = scale; if (colscale) sc *= colscale[scol + n];
        if (f8) { u32x2 o; o.x = pk8(s[0 * 33] * sc, s[1 * 33] * sc, s[2 * 33] * sc, s[3 * 33] * sc); o.y = pk8(s[4 * 33] * sc, s[5 * 33] * sc, s[6 * 33] * sc, s[7 * 33] * sc);
            *(GAS u32x2*)((unsigned char*)WT + (size_t)(drow + n) * K + k0 + 8 * c) = o; }
        else { u32x4 o; o.x = pkh(s[0 * 33] * sc, s[1 * 33] * sc); o.y = pkh(s[2 * 33] * sc, s[3 * 33] * sc); o.z = pkh(s[4 * 33] * sc, s[5 * 33] * sc); o.w = pkh(s[6 * 33] * sc, s[7 * 33] * sc);
            *(GAS u32x4*)(WT + (size_t)(drow + n) * K + k0 + 8 * c) = o; } }
    LDS_WAIT(); asm volatile("" ::: "memory");
}
struct TJob { const float* W; h16* WT; const float* colscale; int ldw, K, nrows, nvalid, mode; float scale; const float* kscale; };
__device__ __forceinline__ int tjob_items(const TJob& j) { return (j.K / 64) * (j.nrows / 32); }
__device__ __forceinline__ void tjob_run(const TJob& j, int item, LAS float* scr, int lane) {
    const int nblk = j.nrows / 32, kb = item / nblk, r = 32 * (item % nblk);
    const int scol = (j.mode & 1) ? ((r >> 7) & 1) * DFF + 128 * (r >> 8) + (r & 127) : r;
    transpose_item(j.W, j.ldw, j.K, 64 * kb, scol, j.nvalid, j.WT, r, j.scale, j.colscale, j.kscale, (j.mode & 2) != 0, scr, lane);
}

struct Args {
    const float* x; const float* mem; const int* pos; const float* gains; const float* mem_norm; const float* pool_w; const float* pool_scale;
    const float* w_in; const float* w_out; const float* wq; const float* wkv; const float* wo; const float* wgu; const float* wdn;
    float* out; unsigned char* ws;
    float inv_freq[16];
    int ph_lo, ph_hi, li, pad;
};

#define CAS __attribute__((address_space(4)))
typedef const CAS Args* ArgP;
__device__ __forceinline__ ArgP argp() { unsigned long long p = (unsigned long long)__builtin_amdgcn_kernarg_segment_ptr(); asm volatile("" : "+s"(p)); return (ArgP)p; }

__device__ __forceinline__ void rope_entry(ArgP a, float* rope, int idx) {
    const int m = idx >> 4, i = idx & 15;
    const float angf = (float)a->pos[m] * a->inv_freq[i];
    const double ang = (double)angf;
    const double TWO_PI = 6.283185307179586476925286766559, INV_2PI = 0.15915494309189533576888376337251;
    const double k = __builtin_rint(ang * INV_2PI);
    const double r = ang - k * TWO_PI;
    const double r2 = r * r;
    double c = 1.0, s = 1.0, tc = 1.0, ts = 1.0;
#pragma unroll
    for (int n = 1; n <= 13; ++n) { tc *= -r2 / (double)((2 * n - 1) * (2 * n)); ts *= -r2 / (double)((2 * n) * (2 * n + 1)); c += tc; s += ts; }
    rope[(size_t)m * 32 + i] = (float)c; rope[(size_t)m * 32 + 16 + i] = (float)(s * r);
}
__device__ __forceinline__ void norm_row_to_h16(const float* xrow, const float* gain, h16* orow, int lane) {
    const f32x4* xr = (const f32x4*)xrow + lane; const f32x4* gr = (const f32x4*)gain + lane;
    f32x4 v[8]; float s = 0.f;
#pragma unroll
    for (int j = 0; j < 8; ++j) { v[j] = xr[64 * j]; s += (v[j].x * v[j].x + v[j].y * v[j].y) + (v[j].z * v[j].z + v[j].w * v[j].w); }
    const float r = rstd_of(wave_sum_dpp(s));
    u32x2* o8 = (u32x2*)orow + lane;
#pragma unroll
    for (int j = 0; j < 8; ++j) { const f32x4 g = gr[64 * j], y = v[j] * r * g; u32x2 w; w.x = pkh(y.x, y.y); w.y = pkh(y.z, y.w); o8[64 * j] = w; }
}
template <int W>
__device__ __forceinline__ void pool_window(const float* xb, const LAS float* rs, const f32x4 g, int t0, int c0, h16* Pb) {
    f32x4 ring[W];
#pragma unroll
    for (int j = 0; j < W; ++j) ring[j] = (f32x4){0.f, 0.f, 0.f, 0.f};
    f32x4 sum = {0.f, 0.f, 0.f, 0.f};
    const float icw = 1.0f / (float)W;
    constexpr int NIT = 64 + W - 1;
#pragma unroll 1
    for (int cb = 0; cb < (NIT + 15) / 16; ++cb) {
        f32x4 xv[16]; float rv[16];
#pragma unroll
        for (int j = 0; j < 16; ++j) { const int i = 16 * cb + j; const int ic_ = i < NIT ? i : NIT - 1; const int tt = t0 - (W - 1) + ic_, tc = tt > 0 ? tt : 0;
            xv[j] = *(const f32x4*)(xb + (size_t)tc * D + c0); rv[j] = rs[16 - W + ic_]; }
#pragma unroll
        for (int j = 0; j < 16; ++j) { const int i = 16 * cb + j; const int tt = t0 - (W - 1) + i;
            if (i < NIT) {
                f32x4 a = xv[j] * rv[j] * g; const bool ok = tt >= 0;
                a.x = ok ? a.x : 0.f; a.y = ok ? a.y : 0.f; a.z = ok ? a.z : 0.f; a.w = ok ? a.w : 0.f;
                sum += a; sum -= ring[j % W]; ring[j % W] = a;
                if (tt >= t0) { const float ic = (tt + 1) < W ? 1.0f / (float)(tt + 1) : icw; const f32x4 p = sum * ic - a;
                    u32x2 o; o.x = pkh(p.x, p.y); o.y = pkh(p.z, p.w); *(u32x2*)(Pb + (size_t)tt * D + c0) = o; } } }
    }
}
__device__ __forceinline__ void pool_pre(Frame& F0, const float* x, const float* g0, h16* P) {
    Frame F = fresh(F0);
    LAS float* rs = (LAS float*)(F.lds + RING_OFF);
    for (int u = F.vcu; u < T / 64; u += F.G) {
        const int b = u / (SEQ / 64), t0 = 64 * (u % (SEQ / 64));
        const float* xb = x + (size_t)b * SEQ * D;
        for (int r = F.wave; r < 79; r += NWAVES) { const int t = t0 - 15 + r;
            if (t >= 0) { const f32x4* xr = (const f32x4*)(xb + (size_t)t * D) + F.lane; float s = 0.f;
#pragma unroll
                for (int j = 0; j < 8; ++j) { const f32x4 v = xr[64 * j]; s += (v.x * v.x + v.y * v.y) + (v.z * v.z + v.w * v.w); }
                s = rstd_of(wave_sum_dpp(s)); if (F.lane == 0) rs[r] = s; } }
        __syncthreads();
        {
            const int c0 = 4 * F.tid, wsel = F.wave >> 1;
            const f32x4 g = *(const f32x4*)(g0 + c0);
            h16* Pb = P + (size_t)b * SEQ * D;
            if (wsel == 0) pool_window<2>(xb, rs, g, t0, c0, Pb); else if (wsel == 1) pool_window<4>(xb, rs, g, t0, c0, Pb); else if (wsel == 2) pool_window<8>(xb, rs, g, t0, c0, Pb); else pool_window<16>(xb, rs, g, t0, c0, Pb);
        }
        __syncthreads();
    }
}
__device__ __forceinline__ void p0_prologue(Frame& F0, ArgP a) {
    Frame F = fresh(F0);
    unsigned char* ws = a->ws;
    LAS float* scr = (LAS float*)(F.lds + RING_OFF + F.wave * 16384);
    const int gw = F.vcu * NWAVES + F.wave, NGW = F.G * NWAVES;
    constexpr int I_POOL = (512 / 64) * (512 / 32), I_IN = (2048 / 64) * (DSA_NP / 32), I_OUT = (2048 / 64) * (2048 / 32), I_Q = (2048 / 64) * (512 / 32), I_KV = (2048 / 64) * (1024 / 32),
                  I_O = (512 / 64) * (2048 / 32), I_GU = (2048 / 64) * (2 * DFF / 32), I_DN = (DFF / 64) * (2048 / 32);
    constexpr int NITEMS = 4 * I_POOL + I_IN + I_OUT + 2 * (I_Q + I_KV + I_O + I_GU + I_DN);
    for (int it = gw; it < NITEMS; it += NGW) {
        int r = it; TJob j; bool found = false;
#pragma unroll
        for (int g = 0; g < 4; ++g) if (!found) { if (r < I_POOL) { j = TJob{a->pool_w + (size_t)g * 512 * 512, (h16*)(ws + WS_WPOOL) + (size_t)g * 512 * 512, a->pool_scale + g * 512, 512, 512, 512, 512, 0, 1.0f, nullptr}; found = true; } else r -= I_POOL; }
        if (!found) { if (r < I_IN) { j = TJob{a->w_in, (h16*)(ws + WS_WIN), nullptr, DSA_N, 2048, DSA_NP, DSA_N, 0, 64.0f, a->gains + 6 * D  }; found = true; } else r -= I_IN; }
        if (!found) { if (r < I_OUT) { j = TJob{a->w_out, (h16*)(ws + WS_WOUT), nullptr, 2048, 2048, 2048, 2048, 0, 1.0f, nullptr}; found = true; } else r -= I_OUT; }
#pragma unroll
        for (int L = 0; L < 2; ++L) {
            if (!found) { if (r < I_Q) { j = TJob{a->wq + (size_t)L * 2048 * 512, (h16*)(ws + WS_WQ) + (size_t)L * 512 * 2048, nullptr, 512, 2048, 512, 512, 0, 1.0f, a->gains + (size_t)L * 6 * D + 2 * D}; found = true; } else r -= I_Q; }
            if (!found) { if (r < I_KV) { const int ks = r / (I_KV / 4); r -= ks * (I_KV / 4);
                j = TJob{a->wkv + (size_t)L * 2048 * 1024 + (size_t)ks * 512 * 1024, (h16*)(ws + WS_WKV) + ((size_t)ks * 2048 + (size_t)L * 1024) * 512, nullptr, 1024, 512, 1024, 1024, 0, 1.0f, nullptr}; found = true; } else r -= I_KV; }
            if (!found) { if (r < I_O) { j = TJob{a->wo + (size_t)L * 512 * 2048, (h16*)(ws + WS_WO) + (size_t)L * 2048 * 512, nullptr, 2048, 512, 2048, 2048, 0, 1.0f, nullptr}; found = true; } else r -= I_O; }
            if (!found) { if (r < I_GU) { j = ((FFN_FP8 >> L) & 1) ? TJob{a->wgu + (size_t)L * 2048 * 2 * DFF, (h16*)(ws + WS_WGU) + (size_t)L * 2 * DFF * 2048, nullptr, 2 * DFF, 2048, 2 * DFF, 2 * DFF, 3, W8_SCALE, nullptr} : TJob{a->wgu + (size_t)L * 2048 * 2 * DFF, (h16*)(ws + WS_WGU) + (size_t)L * 2 * DFF * 2048, nullptr, 2 * DFF, 2048, 2 * DFF, 2 * DFF, 1, 1.0f, a->gains + (size_t)L * 6 * D + 4 * D}; found = true; } else r -= I_GU; }
            if (!found) { if (r < I_DN) { j = ((DN_FP8 >> L) & 1) ? TJob{a->wdn + (size_t)L * DFF * 2048, (h16*)(ws + WS_WDN) + (size_t)L * 2048 * DFF, nullptr, 2048, DFF, 2048, 2048, 2, W8_SCALE, nullptr} : TJob{a->wdn + (size_t)L * DFF * 2048, (h16*)(ws + WS_WDN) + (size_t)L * 2048 * DFF, nullptr, 2048, DFF, 2048, 2048, 0, 1.0f, nullptr}; found = true; } else r -= I_DN; }
        }
        if (found) tjob_run(j, r, scr, F.lane);
    }
    for (int i = (gw * 64 + F.lane); i < T * 16; i += NGW * 64) rope_entry(a, (float*)(ws + WS_ROPE), i);
    for (int m = gw; m < NB * NMEM; m += NGW) norm_row_to_h16(a->mem + (size_t)m * D, a->mem_norm, (h16*)(ws + WS_MEMN) + (size_t)m * D, F.lane);
    __syncthreads();
    pool_pre(F, a->x, a->gains  , (h16*)(ws + WS_A));
}

template <bool HAS_NEXT, bool OUT8, bool HIN32, bool HOUT32, bool RSONLY = false>
__device__ __forceinline__ void seam_phase(Frame& F0, const h16* Y, const void* hin, void* hout, const float* gpost, const float* gpre, h16* aout, float* rsout = nullptr) {
    Frame F = fresh(F0);
    const int gw = F.vcu * NWAVES + F.wave, NGW = F.G * NWAVES;
#pragma unroll 4
    for (int m = gw; m < T; m += NGW) {
        const h16* yr = Y + (size_t)m * D + 8 * F.lane;
        float y[4][8]; float s = 0.f;
#pragma unroll
        for (int j = 0; j < 4; ++j) { const half8 v = __builtin_nontemporal_load((const half8*)(yr + 512 * j));
#pragma unroll
            for (int e = 0; e < 8; ++e) { y[j][e] = (float)v[e]; s += y[j][e] * y[j][e]; } }
        float hp[4][8];
#pragma unroll
        for (int j = 0; j < 4; ++j) {
            if constexpr (HIN32) { const f32x4 a = *(const f32x4*)((const float*)hin + (size_t)m * D + 8 * F.lane + 512 * j), c = *(const f32x4*)((const float*)hin + (size_t)m * D + 8 * F.lane + 512 * j + 4);
                hp[j][0] = a.x; hp[j][1] = a.y; hp[j][2] = a.z; hp[j][3] = a.w; hp[j][4] = c.x; hp[j][5] = c.y; hp[j][6] = c.z; hp[j][7] = c.w; }
            else { const half8 v = *(const half8*)((const h16*)hin + (size_t)m * D + 8 * F.lane + 512 * j);
#pragma unroll
                for (int e = 0; e < 8; ++e) hp[j][e] = (float)v[e]; } }
        const float r = rstd_of(wave_sum_dpp(s)); float s2 = 0.f;
#pragma unroll
        for (int j = 0; j < 4; ++j) { const f32x4 g0 = *(const f32x4*)(gpost + 8 * F.lane + 512 * j), g1 = *(const f32x4*)(gpost + 8 * F.lane + 512 * j + 4);
            const float g[8] = {g0.x, g0.y, g0.z, g0.w, g1.x, g1.y, g1.z, g1.w};
#pragma unroll
            for (int e = 0; e < 8; ++e) { const float h = hp[j][e] + y[j][e] * r * g[e]; y[j][e] = h; s2 += h * h; }
            if constexpr (HOUT32) { float* o = (float*)hout + (size_t)m * D + 8 * F.lane + 512 * j; __builtin_nontemporal_store((f32x4){y[j][0], y[j][1], y[j][2], y[j][3]}, (f32x4*)o); __builtin_nontemporal_store((f32x4){y[j][4], y[j][5], y[j][6], y[j][7]}, (f32x4*)(o + 4)); }
            else { u32x4 w; w.x = pkh(y[j][0], y[j][1]); w.y = pkh(y[j][2], y[j][3]); w.z = pkh(y[j][4], y[j][5]); w.w = pkh(y[j][6], y[j][7]); *(u32x4*)((h16*)hout + (size_t)m * D + 8 * F.lane + 512 * j) = w; } }
        if constexpr (HAS_NEXT && RSONLY) { const float r2 = rstd_of(wave_sum_dpp(s2)); if (F.lane == 0) rsout[m] = r2; }
        else if constexpr (HAS_NEXT) {
            const float r2 = rstd_of(wave_sum_dpp(s2));
#pragma unroll
            for (int j = 0; j < 4; ++j) { const f32x4 g0 = *(const f32x4*)(gpre + 8 * F.lane + 512 * j), g1 = *(const f32x4*)(gpre + 8 * F.lane + 512 * j + 4);
                const float g[8] = {g0.x, g0.y, g0.z, g0.w, g1.x, g1.y, g1.z, g1.w}; float v[8];
#pragma unroll
                for (int e = 0; e < 8; ++e) v[e] = y[j][e] * r2 * g[e];
                if constexpr (OUT8) { u32x2 w; w.x = pk8(v[0], v[1], v[2], v[3]); w.y = pk8(v[4], v[5], v[6], v[7]); *(u32x2*)((unsigned char*)aout + (size_t)m * D + 8 * F.lane + 512 * j) = w; }
                else { u32x4 w; w.x = pkh(v[0], v[1]); w.y = pkh(v[2], v[3]); w.z = pkh(v[4], v[5]); w.w = pkh(v[6], v[7]); *(u32x4*)(aout + (size_t)m * D + 8 * F.lane + 512 * j) = w; } }
        }
    }
}

__device__ __forceinline__ void xattn_phase(Frame& F0, h16* XQ, const h16* KVM  ) {
    Frame F = fresh(F0);
    LAS unsigned char* Ks = F.lds + RING_OFF; LAS unsigned char* Vt = F.lds + RING_OFF + 65536;
    const int lane = F.lane, n = lane & 31, hh = lane >> 5;
    for (int u = F.vcu; u < NB * 4 * (SEQ / 512); u += F.G) {
        const int b = u / (4 * (SEQ / 512)), h = (u / (SEQ / 512)) & 3, ch = u % (SEQ / 512);
        const h16* kb = KVM + (size_t)b * NMEM * 8192 + h * HD;
        for (int i = F.tid; i < 256 * 16; i += NWAVES * 64) { const int key = i >> 4, c = i & 15;
            const h16* kr = kb + (size_t)key * 8192 + 8 * c;
            half8 kp[4], vp[4];
#pragma unroll
            for (int ks = 0; ks < 4; ++ks) { kp[ks] = *(const half8*)(kr + ks * 2048); vp[ks] = *(const half8*)(kr + ks * 2048 + 512); }
            half8 kv8, vv;
#pragma unroll
            for (int e = 0; e < 8; ++e) { kv8[e] = (h16)(((float)kp[0][e] + (float)kp[1][e]) + ((float)kp[2][e] + (float)kp[3][e])); vv[e] = (h16)(((float)vp[0][e] + (float)vp[1][e]) + ((float)vp[2][e] + (float)vp[3][e])); }
            *(LAS half8*)(Ks + key * 256 + ((c ^ (key & 15)) << 4)) = kv8;
            const int o = key & 15, posk = (key & ~15) | ((o & 3) | ((o & 4) << 1) | ((o & 8) >> 1));
#pragma unroll
            for (int e = 0; e < 8; ++e) { const int d = 8 * c + e; *(LAS h16*)(Vt + d * 512 + (((posk >> 3) ^ (d & 15)) << 4) + (posk & 7) * 2) = vv[e]; }
        }
        __syncthreads();
#pragma unroll 1
        for (int sub = 0; sub < 2; ++sub) {
            const size_t m0 = (size_t)b * SEQ + ch * 512 + sub * 256 + F.wave * 32;
            h16* qrow = XQ + (m0 + n) * XW + h * HD;
            half8 qf[8];
#pragma unroll
            for (int s = 0; s < 8; ++s) qf[s] = *(const half8*)(qrow + 16 * s + 8 * hh);
            f32x16 o[4];
#pragma unroll
            for (int mt = 0; mt < 4; ++mt)
#pragma unroll
                for (int i = 0; i < 16; ++i) o[mt][i] = 0.f;
            const float c2 = 0.08838834764831845f * 1.44269504089f;
            float mrun = -3.0e38f, lrun = 0.f;
#pragma unroll 1
            for (int hf = 0; hf < 2; ++hf) {
                f32x16 acc[4];
#pragma unroll
                for (int kt = 0; kt < 4; ++kt) {
#pragma unroll
                    for (int i = 0; i < 16; ++i) acc[kt][i] = 0.f;
                    const int key = 128 * hf + 32 * kt + n;
#pragma unroll
                    for (int s = 0; s < 8; ++s) { const half8 ka = *(const LAS half8*)(Ks + key * 256 + (((2 * s + hh) ^ (key & 15)) << 4));
                        acc[kt] = __builtin_amdgcn_mfma_f32_32x32x16_f16(ka, qf[s], acc[kt], 0, 0, 0); }
                }
                float mx = mrun;
#pragma unroll
                for (int kt = 0; kt < 4; ++kt)
#pragma unroll
                    for (int i = 0; i < 16; ++i) mx = fmaxf(mx, acc[kt][i]);
                mx = fmaxf(mx, __shfl_xor(mx, 32));
                const float alpha = __builtin_amdgcn_exp2f((mrun - mx) * c2); mrun = mx;
                float sum = 0.f;
#pragma unroll
                for (int kt = 0; kt < 4; ++kt)
#pragma unroll
                    for (int i = 0; i < 16; ++i) { const float p = __builtin_amdgcn_exp2f((acc[kt][i] - mx) * c2); acc[kt][i] = p; sum += p; }
                lrun = lrun * alpha + sum;
#pragma unroll
                for (int mt = 0; mt < 4; ++mt)
#pragma unroll
                    for (int i = 0; i < 16; ++i) o[mt][i] *= alpha;
#pragma unroll
                for (int kt = 0; kt < 4; ++kt)
#pragma unroll
                    for (int s2 = 0; s2 < 2; ++s2) {
                        half8 pb;
#pragma unroll
                        for (int j = 0; j < 8; ++j) pb[j] = (h16)acc[kt][8 * s2 + j];
#pragma unroll
                        for (int mt = 0; mt < 4; ++mt) { const int d = 32 * mt + n;
                            const half8 va = *(const LAS half8*)(Vt + d * 512 + (((2 * (2 * (4 * hf + kt) + s2) + hh) ^ (d & 15)) << 4));
                            o[mt] = __builtin_amdgcn_mfma_f32_32x32x16_f16(va, pb, o[mt], 0, 0, 0); }
                    }
            }
            lrun += __shfl_xor(lrun, 32);
            const float inv = 1.0f / lrun;
#pragma unroll
            for (int mt = 0; mt < 4; ++mt)
#pragma unroll
                for (int jj = 0; jj < 4; ++jj) { u32x2 w; w.x = pkh(o[mt][4 * jj] * inv, o[mt][4 * jj + 1] * inv); w.y = pkh(o[mt][4 * jj + 2] * inv, o[mt][4 * jj + 3] * inv);
                    *(u32x2*)(qrow + 32 * mt + 8 * jj + 4 * hh) = w; }
        }
        __syncthreads();
    }
}

__device__ __forceinline__ unsigned mono_key(unsigned u) { return (u & 0x80000000u) ? ~u : (u | 0x80000000u); }
__device__ __forceinline__ void keymap_clear(LAS unsigned* bm, int lane) { *(LAS u32x4*)(bm + 8 * lane) = (u32x4){0u, 0u, 0u, 0u}; *(LAS u32x4*)(bm + 8 * lane + 4) = (u32x4){0u, 0u, 0u, 0u}; }
__device__ __forceinline__ void keymap_emit(LAS unsigned* bm, unsigned short* out, int nvalid, int lane) {
    const u32x4 w0 = *(const LAS u32x4*)(bm + 8 * lane), w1 = *(const LAS u32x4*)(bm + 8 * lane + 4);
    unsigned w[8] = {w0.x, w0.y, w0.z, w0.w, w1.x, w1.y, w1.z, w1.w};
    int mine = 0;
#pragma unroll
    for (int j = 0; j < 8; ++j) mine += __builtin_popcount(w[j]);
    int incl = mine;
#pragma unroll
    for (int o = 1; o < 64; o <<= 1) { const int v = __shfl_up(incl, o); if (lane >= o) incl += v; }
    int pos = incl - mine;
#pragma unroll
    for (int j = 0; j < 8; ++j) { unsigned x = w[j]; while (x) { const int b = __builtin_ctz(x); out[pos++] = (unsigned short)((8 * lane + j) * 32 + b); x &= x - 1u; } }
    const int total = __shfl(incl, 63);
    for (int i = total + lane; i < TOPK; i += 64) out[i] = (unsigned short)0;
}
constexpr int SEL_N = LIST_CAP / 64;
template <bool FINAL>
__device__ __forceinline__ void select256(u32x2* list, int c, LAS float* th_out, LAS unsigned* cnt_out, LAS unsigned* bm, int lane) {
    unsigned key[SEL_N], id[SEL_N];
#pragma unroll
    for (int k = 0; k < SEL_N; ++k) { const int i = lane + 64 * k; const u32x2 v = list[i]; key[k] = (i < c) ? mono_key(v.x) : 0u; id[k] = v.y; }
    unsigned mx = key[0];
#pragma unroll
    for (int k = 1; k < SEL_N; ++k) mx = key[k] > mx ? key[k] : mx;
#pragma unroll
    for (int o = 1; o < 64; o <<= 1) { const unsigned v = (unsigned)__shfl_xor((int)mx, o); mx = v > mx ? v : mx; }
    unsigned lo = FINAL ? 1u : mono_key(__float_as_uint(*th_out)), hi = mx;
    constexpr int PRUNE_KEEP = 320;
#pragma unroll 1
    while (lo < hi) { const unsigned mid = lo + ((hi - lo + 1u) >> 1); int cc = 0;
#pragma unroll
        for (int k = 0; k < SEL_N; ++k) cc += __builtin_popcountll(__ballot(key[k] >= mid));
        if (cc >= TOPK) { lo = mid; if (cc <= (FINAL ? TOPK : PRUNE_KEEP)) break; } else hi = mid - 1u; }
    const unsigned prefix = lo;
    int ngt = 0, neq = 0;
#pragma unroll
    for (int k = 0; k < SEL_N; ++k) { ngt += __builtin_popcountll(__ballot(key[k] > prefix)); neq += __builtin_popcountll(__ballot(key[k] == prefix)); }
    const int need_eq = FINAL ? (TOPK - ngt) : neq; int base_gt = 0, base_eq = 0;
    const unsigned long long lt = (1ull << lane) - 1ull;
#pragma unroll
    for (int k = 0; k < SEL_N; ++k) {
        const unsigned long long bgt = __ballot(key[k] > prefix), beq = __ballot(key[k] == prefix);
        int pos = -1;
        if (key[k] > prefix) pos = base_gt + __builtin_popcountll(bgt & lt);
        else if (key[k] == prefix) { const int r = base_eq + __builtin_popcountll(beq & lt); if (r < need_eq) pos = ngt + r; }
        if (pos >= 0) { if constexpr (FINAL) __hip_atomic_fetch_or(bm + (id[k] >> 5), 1u << (id[k] & 31u), __ATOMIC_RELAXED, __HIP_MEMORY_SCOPE_WORKGROUP); else { u32x2 v; v.x = (key[k] & 0x80000000u) ? (key[k] & 0x7fffffffu) : ~key[k]; v.y = id[k]; list[pos] = v; } }
        base_gt += __builtin_popcountll(bgt); base_eq += __builtin_popcountll(beq);
        __builtin_amdgcn_sched_barrier(0);
    }
    if constexpr (!FINAL) { if (lane == 0) { const unsigned u = (prefix & 0x80000000u) ? (prefix & 0x7fffffffu) : ~prefix; *th_out = __builtin_bit_cast(float, u); *cnt_out = (unsigned)(ngt + neq); } }
}
__device__ __forceinline__ void indexer_phase(Frame& F0, const h16* IQ, const h16* IK, const float* IW, unsigned short* IDX, u32x2* LISTS) {
    Frame F = fresh(F0);
    LAS unsigned char* bq = F.lds + RING_OFF;
    LAS unsigned* cnt = (LAS unsigned*)(F.lds + RING_OFF + 131072); LAS float* th = (LAS float*)(cnt + 32); LAS unsigned* flag = cnt + 64; LAS unsigned* sgn = cnt + 96;
    u32x2* mylist = LISTS + (size_t)blockIdx.x * 32 * LIST_CAP;
    const int lane = F.lane, n = lane & 31, hh = lane >> 5, w8 = F.wave;
    const float INF = __builtin_inff();
    constexpr int NU = NB * (SEQ / 32);
    for (int rnd = 0; rnd * F.G < NU; ++rnd) {
        int qt, b;
        if (F.G == 256) {
            const int i = (F.vcu & 31) + 32 * (F.vcu >> 6); b = (F.vcu >> 5) & 1;
            qt = rnd == 0 ? 511 - i : rnd == 1 ? i : rnd == 2 ? 256 + i : 255 - i;
        } else { const int kk = rnd * F.G + ((rnd & 1) ? (F.G - 1 - F.vcu) : F.vcu); if (kk >= NU) continue; qt = (SEQ / 32 - 1) - (kk >> 1); b = kk & 1; }
        const int nkt = qt + 1;
        const size_t m0 = (size_t)b * SEQ + 32 * qt;
        if (F.tid < 32) { cnt[F.tid] = 0u; th[F.tid] = -INF; unsigned mk = 0u;
#pragma unroll
            for (int h = 0; h < 16; ++h) mk |= (IW[(m0 + F.tid) * 16 + h] >= 0.f ? 1u : 0u) << h;
            sgn[F.tid] = mk; }
        if (F.tid == 0) *flag = 0u;
        { const int q = F.tid & 31, ch = F.tid >> 5;
#pragma unroll 4
            for (int h = 0; h < 16; ++h) { const float w = IW[(m0 + q) * 16 + h]; const half8 v = *(const half8*)(IQ + (m0 + q) * 2048 + h * HD + 8 * ch); half8 o;
#pragma unroll
                for (int e = 0; e < 8; ++e) o[e] = (h16)((float)v[e] * w);
                *(LAS half8*)(bq + (h * 16 + ch) * 512 + q * 16) = o; } }
        __syncthreads();
        const h16* ikb = IK + (size_t)b * SEQ * HD;
        const unsigned smask = sgn[n];
        float theta = -INF;
        const int qpos = 32 * qt + n;
        u32x2* lp = mylist + (size_t)n * LIST_CAP;
        half8 A[8];
        if (w8 < nkt) { const h16* arow = ikb + (size_t)(32 * w8 + n) * HD + 8 * hh;
#pragma unroll
            for (int c = 0; c < 8; ++c) A[c] = *(const half8*)(arow + 16 * c); }
#pragma unroll 1
        for (int r0 = 0; r0 < nkt; r0 += NWAVES) {
            const int kt = r0 + w8;
            if (kt < nkt) {
                f32x16 S;
#pragma unroll
                for (int i = 0; i < 16; ++i) S[i] = 0.f;
                const LAS unsigned char* bl = bq + hh * 512 + n * 16;
                half8 Ba[4], Bb[4]; f32x16 acc0, acc1;
#define IDX_LOADB(dst, h, c0) do { _Pragma("unroll") for (int c = 0; c < 4; ++c) dst[c] = *(const LAS half8*)(bl + ((h) * 16 + 2 * ((c0) + c)) * 512); } while (0)
#define IDX_MMA4(acc, Bx, c0) do { _Pragma("unroll") for (int c = 0; c < 4; ++c) acc = __builtin_amdgcn_mfma_f32_32x32x16_f16(A[(c0) + c], Bx[c], acc, 0, 0, 0); } while (0)
#define IDX_ZERO(acc) do { _Pragma("unroll") for (int i = 0; i < 16; ++i) acc[i] = 0.f; } while (0)
#define IDX_FOLD8(acc, h, i0) do { const float cc_ = ((smask >> (h)) & 1u) ? INF : -INF; _Pragma("unroll") for (int i = (i0); i < (i0) + 8; ++i) S[i] += __builtin_amdgcn_fmed3f(acc[i], 0.f, cc_); } while (0)
#define IDX_SCHED4() do { __builtin_amdgcn_sched_group_barrier(0x008, 1, 0); __builtin_amdgcn_sched_group_barrier(0x100, 1, 0); _Pragma("unroll") for (int g_ = 0; g_ < 3; ++g_) { __builtin_amdgcn_sched_group_barrier(0x008, 1, 0); __builtin_amdgcn_sched_group_barrier(0x100, 1, 0); __builtin_amdgcn_sched_group_barrier(0x002, 6, 0); } } while (0)
                IDX_LOADB(Ba, 0, 0);
                IDX_ZERO(acc1);
#pragma unroll 1
                for (int h = 0; h < 16; h += 2) {
                    IDX_ZERO(acc0);
                    IDX_MMA4(acc0, Ba, 0); IDX_FOLD8(acc1, (h + 15) & 15, 0); IDX_LOADB(Bb, h, 4); IDX_SCHED4();
                    IDX_MMA4(acc0, Bb, 4); IDX_FOLD8(acc1, (h + 15) & 15, 8); IDX_LOADB(Ba, h + 1, 0); IDX_SCHED4();
                    IDX_ZERO(acc1);
                    IDX_MMA4(acc1, Ba, 0); IDX_FOLD8(acc0, h, 0); IDX_LOADB(Bb, h + 1, 4); IDX_SCHED4();
                    IDX_MMA4(acc1, Bb, 4); IDX_FOLD8(acc0, h, 8); IDX_LOADB(Ba, (h + 2) & 15, 0); IDX_SCHED4();
                }
                IDX_FOLD8(acc1, 15, 0); IDX_FOLD8(acc1, 15, 8);
#if IDX_PROBE_MMA
                {
                    f32x16 S1 = S;
#pragma unroll
                    for (int c = 0; c < 8; ++c) asm volatile("" : "+v"(A[c]));
#pragma unroll
                    for (int i = 0; i < 16; ++i) S[i] = 0.f;
                    IDX_LOADB(Ba, 0, 0);
                    IDX_ZERO(acc1);
#pragma unroll 1
                    for (int h = 0; h < 16; h += 2) {
                        IDX_ZERO(acc0);
                        IDX_MMA4(acc0, Ba, 0); IDX_FOLD8(acc1, (h + 15) & 15, 0); IDX_LOADB(Bb, h, 4); IDX_SCHED4();
                        IDX_MMA4(acc0, Bb, 4); IDX_FOLD8(acc1, (h + 15) & 15, 8); IDX_LOADB(Ba, h + 1, 0); IDX_SCHED4();
                        IDX_ZERO(acc1);
                        IDX_MMA4(acc1, Ba, 0); IDX_FOLD8(acc0, h, 0); IDX_LOADB(Bb, h + 1, 4); IDX_SCHED4();
                        IDX_MMA4(acc1, Bb, 4); IDX_FOLD8(acc0, h, 8); IDX_LOADB(Ba, (h + 2) & 15, 0); IDX_SCHED4();
                    }
                    IDX_FOLD8(acc1, 15, 0); IDX_FOLD8(acc1, 15, 8);
#pragma unroll
                    for (int i = 0; i < 16; ++i) S[i] = (S[i] + S1[i]) * 0.5f;
                }
#endif
#undef IDX_LOADB
#undef IDX_MMA4
#undef IDX_ZERO
#undef IDX_FOLD8
#undef IDX_SCHED4
                if (kt + NWAVES < nkt) { const h16* arow = ikb + (size_t)(32 * (kt + NWAVES) + n) * HD + 8 * hh;
#pragma unroll
                    for (int c = 0; c < 8; ++c) A[c] = *(const half8*)(arow + 16 * c); }
                const int kb0 = 32 * kt + 4 * hh;
                unsigned pm = 0u;
                if (kt < qt) {
#pragma unroll
                    for (int i = 0; i < 16; ++i) pm |= (S[i] > theta) ? (1u << i) : 0u;
                } else {
#pragma unroll
                    for (int i = 0; i < 16; ++i) { const int key = kb0 + (i & 3) + 8 * (i >> 2); pm |= ((key <= qpos) && (S[i] > theta)) ? (1u << i) : 0u; }
                }
                if (pm) { const unsigned np = (unsigned)__builtin_popcount(pm);
                    const unsigned pos = __hip_atomic_fetch_add(cnt + n, np, __ATOMIC_RELAXED, __HIP_MEMORY_SCOPE_WORKGROUP);
#pragma unroll
                    for (int i = 0; i < 16; ++i) if (pm & (1u << i)) { u32x2 e; e.x = __float_as_uint(S[i]);   e.y = (unsigned)(kb0 + (i & 3) + 8 * (i >> 2));
                        { const unsigned at = pos + (unsigned)__builtin_popcount(pm & ((1u << i) - 1u)); lp[at < (unsigned)LIST_CAP ? at : (unsigned)LIST_CAP - 1u] = e; } }
                    if (pos + np > (unsigned)(LIST_CAP - 256)) *(volatile LAS unsigned*)flag = 1u; }
            }
            asm volatile("s_waitcnt lgkmcnt(0)" ::: "memory"); __builtin_amdgcn_s_barrier(); asm volatile("" ::: "memory");
            if (*(volatile LAS unsigned*)flag != 0u) {
                VM_WAIT(); __syncthreads();
                for (int q = w8; q < 32; q += NWAVES) { const int c = __builtin_amdgcn_readfirstlane((int)cnt[q]); if (c > TOPK) select256<false>(mylist + (size_t)q * LIST_CAP, c, th + q, cnt + q, nullptr, lane); }
                if (F.tid == 0) *flag = 0u;
                VM_WAIT(); __syncthreads();
                theta = th[n];
                if (kt + NWAVES < nkt) { const h16* arow = ikb + (size_t)(32 * (kt + NWAVES) + n) * HD + 8 * hh;
#pragma unroll
                    for (int c = 0; c < 8; ++c) A[c] = *(const half8*)(arow + 16 * c); }
            }
        }
        VM_WAIT(); __syncthreads();
        LAS unsigned* bm = (LAS unsigned*)(bq + w8 * 2048);
        for (int q = w8; q < 32; q += NWAVES) { const int c = __builtin_amdgcn_readfirstlane((int)cnt[q]); unsigned short* io = IDX + (m0 + q) * TOPK; u32x2* lq = mylist + (size_t)q * LIST_CAP;
            keymap_clear(bm, lane); asm volatile("s_waitcnt lgkmcnt(0)" ::: "memory");
            if (c > TOPK) select256<true>(lq, c, nullptr, nullptr, bm, lane);
            else {
#pragma unroll
                for (int k = 0; k < 4; ++k) { const int i = lane + 64 * k; if (i < c) { const unsigned key = lq[i].y; __hip_atomic_fetch_or(bm + (key >> 5), 1u << (key & 31u), __ATOMIC_RELAXED, __HIP_MEMORY_SCOPE_WORKGROUP); } } }
            asm volatile("s_waitcnt lgkmcnt(0)" ::: "memory");
            keymap_emit(bm, io, c, lane);
            asm volatile("s_waitcnt lgkmcnt(0)" ::: "memory"); }
        __syncthreads();
    }
}

constexpr int L16_CAP = 640;
__device__ __forceinline__ unsigned wave_umax_dpp(unsigned v) {
    { const unsigned o = (unsigned)__builtin_amdgcn_update_dpp(0, (int)v, 0xB1, 0xF, 0xF, true); v = o > v ? o : v; }
    { const unsigned o = (unsigned)__builtin_amdgcn_update_dpp(0, (int)v, 0x4E, 0xF, 0xF, true); v = o > v ? o : v; }
    { const unsigned o = (unsigned)__builtin_amdgcn_update_dpp(0, (int)v, 0x141, 0xF, 0xF, true); v = o > v ? o : v; }
    { const unsigned o = (unsigned)__builtin_amdgcn_update_dpp(0, (int)v, 0x140, 0xF, 0xF, true); v = o > v ? o : v; }
    const unsigned s0 = (unsigned)__builtin_amdgcn_readlane((int)v, 0), s1 = (unsigned)__builtin_amdgcn_readlane((int)v, 16), s2 = (unsigned)__builtin_amdgcn_readlane((int)v, 32), s3 = (unsigned)__builtin_amdgcn_readlane((int)v, 48);
    const unsigned a = s0 > s1 ? s0 : s1, b = s2 > s3 ? s2 : s3; return a > b ? a : b;
}
template <bool FINAL, int L16_N>
__device__ __forceinline__ void select_lds(LAS float* sc, LAS unsigned short* ky, int c, LAS float* th_io, LAS unsigned* cnt_out, LAS unsigned* bm, int lane) {
    unsigned key[L16_N], id[L16_N];
#pragma unroll
    for (int k = 0; k < L16_N; ++k) { const int i = lane + 64 * k; const float v = sc[i]; key[k] = (i < c) ? mono_key(__float_as_uint(v)) : 0u; id[k] = ky[i]; }
    unsigned mx = key[0];
#pragma unroll
    for (int k = 1; k < L16_N; ++k) mx = key[k] > mx ? key[k] : mx;
    mx = wave_umax_dpp(mx);
    unsigned lo = th_io ? mono_key(__float_as_uint(*th_io)) : 1u, hi = mx;
    constexpr int PRUNE_KEEP = 264;
#pragma unroll 1
    while (lo < hi) { const unsigned mid = lo + ((hi - lo + 1u) >> 1); int cc = 0;
#pragma unroll
        for (int k = 0; k < L16_N; ++k) cc += __builtin_popcountll(__ballot(key[k] >= mid));
        if (cc >= TOPK) { lo = mid; if (cc <= (FINAL ? TOPK : PRUNE_KEEP)) break; } else hi = mid - 1u; }
    const unsigned prefix = lo;
    int ngt = 0, neq = 0;
#pragma unroll
    for (int k = 0; k < L16_N; ++k) { ngt += __builtin_popcountll(__ballot(key[k] > prefix)); neq += __builtin_popcountll(__ballot(key[k] == prefix)); }
    const int need_eq = FINAL ? (TOPK - ngt) : neq; int base_gt = 0, base_eq = 0;
    const unsigned long long lt = (1ull << lane) - 1ull;
    unsigned idthr = 0xffffffffu;
    if constexpr (FINAL) { if (neq > need_eq) { unsigned lo2 = 0u, hi2 = (unsigned)SEQ - 1u;
#pragma unroll 1
        while (lo2 < hi2) { const unsigned mid = (lo2 + hi2) >> 1; int cc = 0;
#pragma unroll
            for (int k = 0; k < L16_N; ++k) cc += __builtin_popcountll(__ballot(key[k] == prefix && id[k] <= mid));
            if (cc >= need_eq) hi2 = mid; else lo2 = mid + 1u; }
        idthr = lo2; } }
    asm volatile("s_waitcnt lgkmcnt(0)" ::: "memory");
#pragma unroll
    for (int k = 0; k < L16_N; ++k) {
        const unsigned long long bgt = __ballot(key[k] > prefix), beq = __ballot(key[k] == prefix);
        int pos = -1;
        if (key[k] > prefix) pos = base_gt + __builtin_popcountll(bgt & lt);
        else if (key[k] == prefix) { if constexpr (FINAL) { if (id[k] <= idthr) pos = 0; } else { const int r = base_eq + __builtin_popcountll(beq & lt); if (r < need_eq) pos = ngt + r; } }
        if (pos >= 0) { if constexpr (FINAL) __hip_atomic_fetch_or(bm + (id[k] >> 5), 1u << (id[k] & 31u), __ATOMIC_RELAXED, __HIP_MEMORY_SCOPE_WORKGROUP);
            else { sc[pos] = __uint_as_float((key[k] & 0x80000000u) ? (key[k] & 0x7fffffffu) : ~key[k]); ky[pos] = (unsigned short)id[k]; } }
        base_gt += __builtin_popcountll(bgt); base_eq += __builtin_popcountll(beq);
        __builtin_amdgcn_sched_barrier(0);
    }
    if constexpr (!FINAL) { if (lane == 0) { const unsigned u = (prefix & 0x80000000u) ? (prefix & 0x7fffffffu) : ~prefix; *th_io = __uint_as_float(u); *cnt_out = (unsigned)(ngt + neq); } }
}
__device__ __forceinline__ void indexer_phase16(Frame& F0, const h16* IQ, const h16* IK, const float* IW, unsigned short* IDX) {
    Frame F = fresh(F0);
    LAS unsigned char* bq = F.lds + RING_OFF;
    LAS float* lsc = (LAS float*)(F.lds + RING_OFF + 65536);
    LAS unsigned short* lky = (LAS unsigned short*)(F.lds + RING_OFF + 65536 + 40960);
    LAS unsigned* cnt = (LAS unsigned*)(F.lds + RING_OFF + 65536 + 40960 + 20480); LAS float* th = (LAS float*)(cnt + 16); LAS unsigned* flag = cnt + 32; LAS unsigned* sgn = cnt + 48;
    const int lane = F.lane, n32 = lane & 31, q = n32 & 15, hsel = n32 >> 4, hh = lane >> 5, w8 = F.wave;
    const float INF = __builtin_inff();
    constexpr int NQ16 = SEQ / 16, NU = NB * NQ16;
    for (int rnd = 0; rnd * F.G < NU; ++rnd) {
        int qt, b;
        if (F.G == 256) { const int i = (F.vcu & 31) + 32 * (F.vcu >> 6); b = (F.vcu >> 5) & 1; qt = (rnd & 1) ? 128 * rnd + 127 - i : 128 * rnd + i; qt = NQ16 - 1 - qt; }
        else { const int kk = rnd * F.G + ((rnd & 1) ? (F.G - 1 - F.vcu) : F.vcu); if (kk >= NU) continue; qt = (NQ16 - 1) - (kk >> 1); b = kk & 1; }
        const int nkb = (qt >> 1) + 1;
        const size_t m0 = (size_t)b * SEQ + 16 * qt;
        if (F.tid < 16) { cnt[F.tid] = 0u; th[F.tid] = -INF; unsigned mk = 0u;
#pragma unroll
            for (int h = 0; h < 16; ++h) mk |= (IW[(m0 + F.tid) * 16 + h] >= 0.f ? 1u : 0u) << h;
            sgn[F.tid] = mk; }
        if (F.tid == 0) *flag = 0u;
#pragma unroll 4
        for (int j = 0; j < 8; ++j) { const int e = F.tid + 512 * j, le = e & 63, c = (e >> 6) & 7, hp = e >> 9, qe = le & 15, head = 2 * hp + ((le >> 4) & 1), he = le >> 5;
            const float w = IW[(m0 + qe) * 16 + head]; const half8 v = *(const half8*)(IQ + (m0 + qe) * 2048 + head * HD + 16 * c + 8 * he); half8 o;
#pragma unroll
            for (int x = 0; x < 8; ++x) o[x] = (h16)((float)v[x] * w);
            *(LAS half8*)(bq + e * 16) = o; }
        __syncthreads();
        const h16* ikb = IK + (size_t)b * SEQ * HD;
        const unsigned smask = sgn[q];
        float theta = -INF;
        const int qpos = 16 * qt + q;
        LAS float* msc = lsc + q * L16_CAP; LAS unsigned short* mky = lky + q * L16_CAP;
        half8 A[8];
        if (w8 < nkb) { const h16* arow = ikb + (size_t)(32 * w8 + n32) * HD + 8 * hh;
#pragma unroll
            for (int c = 0; c < 8; ++c) A[c] = *(const half8*)(arow + 16 * c); }
#pragma unroll 1
        for (int r0 = 0; r0 < nkb; r0 += NWAVES) {
            const int kb = r0 + w8;
            if (kb < nkb) {
                f32x16 S;
#pragma unroll
                for (int i = 0; i < 16; ++i) S[i] = 0.f;
                const LAS unsigned char* bl = bq + lane * 16;
                half8 Ba[4], Bb[4]; f32x16 acc0, acc1;
#define IX_LOADB(dst, hp, c0) do { _Pragma("unroll") for (int c = 0; c < 4; ++c) dst[c] = *(const LAS half8*)(bl + ((hp) * 8 + (c0) + c) * 1024); } while (0)
#define IX_MMA4(acc, Bx, c0) do { _Pragma("unroll") for (int c = 0; c < 4; ++c) acc = __builtin_amdgcn_mfma_f32_32x32x16_f16(A[(c0) + c], Bx[c], acc, 0, 0, 0); } while (0)
#define IX_ZERO(acc) do { _Pragma("unroll") for (int i = 0; i < 16; ++i) acc[i] = 0.f; } while (0)
#define IX_FOLD8(acc, hp, i0) do { const float cc_ = ((smask >> (2 * (hp) + hsel)) & 1u) ? INF : -INF; _Pragma("unroll") for (int i = (i0); i < (i0) + 8; ++i) S[i] += __builtin_amdgcn_fmed3f(acc[i], 0.f, cc_); } while (0)
#define IX_SCHED4() do { __builtin_amdgcn_sched_group_barrier(0x008, 1, 0); __builtin_amdgcn_sched_group_barrier(0x100, 1, 0); _Pragma("unroll") for (int g_ = 0; g_ < 3; ++g_) { __builtin_amdgcn_sched_group_barrier(0x008, 1, 0); __builtin_amdgcn_sched_group_barrier(0x100, 1, 0); __builtin_amdgcn_sched_group_barrier(0x002, 6, 0); } } while (0)
                IX_LOADB(Ba, 0, 0);
                IX_ZERO(acc1);
#pragma unroll 1
                for (int hp = 0; hp < 8; hp += 2) {
                    IX_ZERO(acc0);
                    IX_MMA4(acc0, Ba, 0); IX_FOLD8(acc1, (hp + 7) & 7, 0); IX_LOADB(Bb, hp, 4); IX_SCHED4();
                    IX_MMA4(acc0, Bb, 4); IX_FOLD8(acc1, (hp + 7) & 7, 8); IX_LOADB(Ba, hp + 1, 0); IX_SCHED4();
                    IX_ZERO(acc1);
                    IX_MMA4(acc1, Ba, 0); IX_FOLD8(acc0, hp, 0); IX_LOADB(Bb, hp + 1, 4); IX_SCHED4();
                    IX_MMA4(acc1, Bb, 4); IX_FOLD8(acc0, hp, 8); IX_LOADB(Ba, (hp + 2) & 7, 0); IX_SCHED4();
                }
                IX_FOLD8(acc1, 7, 0); IX_FOLD8(acc1, 7, 8);
#undef IX_LOADB
#undef IX_MMA4
#undef IX_ZERO
#undef IX_FOLD8
#undef IX_SCHED4
                if (kb + NWAVES < nkb) { const h16* arow = ikb + (size_t)(32 * (kb + NWAVES) + n32) * HD + 8 * hh;
#pragma unroll
                    for (int c = 0; c < 8; ++c) A[c] = *(const half8*)(arow + 16 * c); }
                float Sx[8];
#pragma unroll
                for (int i = 0; i < 8; ++i) { const float mine = hsel ? S[8 + i] : S[i], other = hsel ? S[i] : S[8 + i];
                    Sx[i] = mine + __shfl_xor(other, 16); }
                const int kb0 = 32 * kb + 4 * hh + 16 * hsel;
                unsigned pm = 0u;
                if (kb + 1 < nkb) {
#pragma unroll
                    for (int i = 0; i < 8; ++i) pm |= (Sx[i] > theta) ? (1u << i) : 0u;
                } else {
#pragma unroll
                    for (int i = 0; i < 8; ++i) { const int key = kb0 + (i & 3) + 8 * (i >> 2); pm |= ((key <= qpos) && (Sx[i] > theta)) ? (1u << i) : 0u; }
                }
                if (pm) { const unsigned np = (unsigned)__builtin_popcount(pm);
                    const unsigned pos = __hip_atomic_fetch_add(cnt + q, np, __ATOMIC_RELAXED, __HIP_MEMORY_SCOPE_WORKGROUP);
#pragma unroll
                    for (int i = 0; i < 8; ++i) if (pm & (1u << i)) { unsigned at = pos + (unsigned)__builtin_popcount(pm & ((1u << i) - 1u)); at = at < (unsigned)L16_CAP ? at : (unsigned)L16_CAP - 1u;
                        msc[at] = Sx[i]; mky[at] = (unsigned short)(kb0 + (i & 3) + 8 * (i >> 2)); }
                    if (pos + np > (unsigned)(L16_CAP - 256)) *(volatile LAS unsigned*)flag = 1u; }
            }
            asm volatile("s_waitcnt lgkmcnt(0)" ::: "memory"); __builtin_amdgcn_s_barrier(); asm volatile("" ::: "memory");
            if (*(volatile LAS unsigned*)flag != 0u) {
                for (int qq = w8; qq < 16; qq += NWAVES) { const int c = __builtin_amdgcn_readfirstlane((int)cnt[qq]); if (c > TOPK) select_lds<false, L16_CAP / 64>(lsc + qq * L16_CAP, lky + qq * L16_CAP, c, th + qq, cnt + qq, nullptr, lane); }
                if (F.tid == 0) *flag = 0u;
                asm volatile("s_waitcnt lgkmcnt(0)" ::: "memory"); __builtin_amdgcn_s_barrier(); asm volatile("" ::: "memory");
                theta = th[q];
            }
        }
        __syncthreads();
        LAS unsigned* bm = (LAS unsigned*)(bq + w8 * 2048);
        for (int qq = w8; qq < 16; qq += NWAVES) { const int c = __builtin_amdgcn_readfirstlane((int)cnt[qq]); unsigned short* io = IDX + (m0 + qq) * TOPK;
            keymap_clear(bm, lane); asm volatile("s_waitcnt lgkmcnt(0)" ::: "memory");
            if (c > TOPK) select_lds<true, L16_CAP / 64>(lsc + qq * L16_CAP, lky + qq * L16_CAP, c, nullptr, nullptr, bm, lane);
            else {
#pragma unroll
                for (int k = 0; k < 4; ++k) { const int i = lane + 64 * k; if (i < c) { const unsigned key = lky[qq * L16_CAP + i]; __hip_atomic_fetch_or(bm + (key >> 5), 1u << (key & 31u), __ATOMIC_RELAXED, __HIP_MEMORY_SCOPE_WORKGROUP); } } }
            asm volatile("s_waitcnt lgkmcnt(0)" ::: "memory");
            keymap_emit(bm, io, c, lane);
            asm volatile("s_waitcnt lgkmcnt(0)" ::: "memory"); }
        __syncthreads();
    }
}

constexpr int L5_CAP = 640;
static_assert(32768 + 32 * L5_CAP * 6 + 512 <= RING_BYTES, "indexer LDS");
__device__ __forceinline__ bool ix5_append4(float v0, float v1, int kbA, bool validA, float v2, float v3, int kbB, bool maskedB, int qpos, float theta, unsigned cnt_addr, unsigned sc_addr, unsigned ky_addr) {
    unsigned pm = ((validA && v0 > theta) ? 1u : 0u) | ((validA && v1 > theta) ? 2u : 0u)
                | (((v2 > theta) && (!maskedB || kbB <= qpos)) ? 4u : 0u) | (((v3 > theta) && (!maskedB || kbB + 1 <= qpos)) ? 8u : 0u);
    bool over = false;
    if (pm) { const unsigned np = (unsigned)__builtin_popcount(pm); unsigned pos;
        asm volatile("ds_add_rtn_u32 %0, %1, %2\n\ts_waitcnt lgkmcnt(0)" : "=&v"(pos) : "v"(cnt_addr), "v"(np) : "memory");
        const unsigned cap1 = (unsigned)L5_CAP - 1u;
        const unsigned p0 = pos, p1 = pos + (pm & 1u), p2 = pos + (unsigned)__builtin_popcount(pm & 3u), p3 = pos + (unsigned)__builtin_popcount(pm & 7u);
        const unsigned a0 = p0 < cap1 ? p0 : cap1, a1 = p1 < cap1 ? p1 : cap1, a2 = p2 < cap1 ? p2 : cap1, a3 = p3 < cap1 ? p3 : cap1;
        if (pm & 1u) { asm volatile("ds_write_b32 %0, %1" :: "v"(sc_addr + 4u * a0), "v"(v0) : "memory"); asm volatile("ds_write_b16 %0, %1" :: "v"(ky_addr + 2u * a0), "v"((unsigned)kbA) : "memory"); }
        if (pm & 2u) { asm volatile("ds_write_b32 %0, %1" :: "v"(sc_addr + 4u * a1), "v"(v1) : "memory"); asm volatile("ds_write_b16 %0, %1" :: "v"(ky_addr + 2u * a1), "v"((unsigned)(kbA + 1)) : "memory"); }
        if (pm & 4u) { asm volatile("ds_write_b32 %0, %1" :: "v"(sc_addr + 4u * a2), "v"(v2) : "memory"); asm volatile("ds_write_b16 %0, %1" :: "v"(ky_addr + 2u * a2), "v"((unsigned)kbB) : "memory"); }
        if (pm & 8u) { asm volatile("ds_write_b32 %0, %1" :: "v"(sc_addr + 4u * a3), "v"(v3) : "memory"); asm volatile("ds_write_b16 %0, %1" :: "v"(ky_addr + 2u * a3), "v"((unsigned)(kbB + 1)) : "memory"); }
        over = pos + np > (unsigned)(L5_CAP - 64); }
    return over;
}
__device__ __forceinline__ bool ix5_append(float v0, float v1, int kb0, bool valid, bool masked, int qpos, float theta, unsigned cnt_addr, unsigned sc_addr, unsigned ky_addr) {
    unsigned pm = (((v0 > theta) && (!masked || kb0 <= qpos)) ? 1u : 0u) | (((v1 > theta) && (!masked || kb0 + 1 <= qpos)) ? 2u : 0u);
    if (!valid) pm = 0u;
    bool over = false;
    if (pm) { const unsigned np = pm == 3u ? 2u : 1u; unsigned pos;
        asm volatile("ds_add_rtn_u32 %0, %1, %2\n\ts_waitcnt lgkmcnt(0)" : "=&v"(pos) : "v"(cnt_addr), "v"(np) : "memory");
        const unsigned a0 = pos < (unsigned)L5_CAP ? pos : (unsigned)L5_CAP - 1u, p1 = pos + (pm & 1u), a1 = p1 < (unsigned)L5_CAP ? p1 : (unsigned)L5_CAP - 1u;
        if (pm & 1u) { asm volatile("ds_write_b32 %0, %1" :: "v"(sc_addr + 4u * a0), "v"(v0) : "memory"); asm volatile("ds_write_b16 %0, %1" :: "v"(ky_addr + 2u * a0), "v"((unsigned)kb0) : "memory"); }
        if (pm & 2u) { asm volatile("ds_write_b32 %0, %1" :: "v"(sc_addr + 4u * a1), "v"(v1) : "memory"); asm volatile("ds_write_b16 %0, %1" :: "v"(ky_addr + 2u * a1), "v"((unsigned)(kb0 + 1)) : "memory"); }
        over = pos + np > (unsigned)(L5_CAP - 64); }
    return over;
}
template <int MODE>
__device__ __forceinline__ void indexer_phase5(Frame& F0, const h16* IQ, const h16* IK, const float* IW, unsigned short* IDX, const float theta0) {
    Frame F = fresh(F0);
    LAS unsigned char* ringA = F.lds + RING_OFF;
    LAS float* lsc = (LAS float*)(F.lds + RING_OFF + 32768);
    LAS unsigned short* lky = (LAS unsigned short*)(F.lds + RING_OFF + 32768 + 32 * L5_CAP * 4);
    LAS unsigned* cnt = (LAS unsigned*)(F.lds + RING_OFF + 32768 + 32 * L5_CAP * 6); LAS float* th = (LAS float*)(cnt + 32); LAS unsigned* req = cnt + 64; const unsigned req_addr = (unsigned)(unsigned long)req;
    const int lane = F.lane, n32 = lane & 31, hh = lane >> 5, q4 = n32 & 3, h8 = n32 >> 2, w8 = F.wave;
    const bool b2 = (lane >> 2) & 1, b3 = (lane >> 3) & 1, b4 = (lane >> 4) & 1;
    const int ql = 4 * w8 + q4, drow = lane >> 4, dpc = lane & 15;
    const float INF = __builtin_inff();
    constexpr int NU = NB * (SEQ / 32);
    for (int rnd = 0; rnd * F.G < NU; ++rnd) {
        int qt, b;
        if (F.G == 256) { const int i = (F.vcu & 31) + 32 * (F.vcu >> 6); b = (F.vcu >> 5) & 1; qt = rnd == 0 ? 511 - i : rnd == 1 ? i : rnd == 2 ? 256 + i : 255 - i; }
        else { const int kk = rnd * F.G + ((rnd & 1) ? (F.G - 1 - F.vcu) : F.vcu); if (kk >= NU) continue; qt = (SEQ / 32 - 1) - (kk >> 1); b = kk & 1; }
        const int nst = (qt >> 1) + 1;
        const size_t m0 = (size_t)b * SEQ + 32 * qt;
        const h16* ikb = IK + (size_t)b * SEQ * HD;
#define IX5_DMA(k_, slot_) do { _Pragma("unroll") for (int i_ = 0; i_ < 2; ++i_) { const int r_ = 8 * w8 + 4 * i_ + drow; \
            __builtin_amdgcn_global_load_lds((const unsigned*)(ikb + (size_t)(64 * (k_) + r_) * HD + 8 * (dpc ^ (r_ & 15))), (LAS unsigned*)(ringA + (slot_) * 16384 + (8 * w8 + 4 * i_) * 256), 16, 0, 0); } } while (0)
        IX5_DMA(0, 0);
        if (lane < 4) { cnt[4 * w8 + lane] = 0u; th[4 * w8 + lane] = -INF; }
        if (F.tid == 0) *req = 0xffffffffu;
        half8 B0[8], B1[8]; float cc0, cc1;
        { const size_t row = m0 + ql; const float w0 = IW[row * 16 + h8], w1 = IW[row * 16 + 8 + h8]; cc0 = w0 >= 0.f ? INF : -INF; cc1 = w1 >= 0.f ? INF : -INF;
          const h16* src = IQ + row * 2048 + h8 * HD + 8 * hh;
#pragma unroll
          for (int c = 0; c < 8; ++c) { const half8 v0 = *(const half8*)(src + 16 * c), v1 = *(const half8*)(src + 8 * HD + 16 * c);
#pragma unroll
              for (int x = 0; x < 8; ++x) { B0[c][x] = (h16)((float)v0[x] * w0); B1[c][x] = (h16)((float)v1[x] * w1); } } }
        float theta = theta0;
        const int qpos = 32 * qt + ql;
        const unsigned cnt_addr = (unsigned)(unsigned long)(cnt + ql), sc_addr = (unsigned)(unsigned long)(lsc + ql * L5_CAP), ky_addr = (unsigned)(unsigned long)(lky + ql * L5_CAP);
        const LAS unsigned char* arow = ringA + n32 * 256 + ((hh ^ (n32 & 1)) * 16);
        const int axor = 16 * (n32 & 14);
        const int kl = 16 * (int)b4 + 8 * (int)b3 + 4 * hh + 2 * (int)b2;
        half8 A[8]; f32x16 X0, X1, Y0, Y1; float T2a, T2b;
#define IX5_ZERO(P0, P1) do { _Pragma("unroll") for (int i = 0; i < 16; ++i) { P0[i] = 0.f; P1[i] = 0.f; } } while (0)
#define IX5_MADD(BM, dst_, src_, CON, PRE) asm volatile(PRE "v_add_f32_dpp %0, %1, %1 row_ror:4 row_mask:0xf bank_mask:" BM : CON(dst_) : "v"(src_))
#define IX5_BLOCK(P0, P1, Q0, Q1, REFILL, nbase_) do { f32x2 Sa_[4], Sb_[4], T_[4]; IX5_ZERO(P0, P1); \
            _Pragma("unroll") for (int s_ = 0; s_ < 16; ++s_) { const int c_ = s_ >> 1, g_ = s_ >> 2; \
                __builtin_amdgcn_s_setprio(1); \
                if (s_ & 1) { if (!(MODE & 2)) P1 = __builtin_amdgcn_mfma_f32_32x32x16_f16(A[c_], B1[c_], P1, 0, 0, 0); else asm volatile("" :: "v"(A[c_])); __builtin_amdgcn_s_setprio(0); if (REFILL) A[c_] = *(const LAS half8*)((nbase_) + ((32 * c_) ^ axor));   } \
                else { if (!(MODE & 2)) P0 = __builtin_amdgcn_mfma_f32_32x32x16_f16(A[c_], B0[c_], P0, 0, 0, 0); __builtin_amdgcn_s_setprio(0); } \
                if (!(MODE & 1)) { \
                if ((s_ & 3) == 0) Sa_[g_] = ix5_pkadd((f32x2){__builtin_amdgcn_fmed3f(Q0[2 * g_], 0.f, cc0), __builtin_amdgcn_fmed3f(Q0[2 * g_ + 1], 0.f, cc0)}, (f32x2){__builtin_amdgcn_fmed3f(Q1[2 * g_], 0.f, cc1), __builtin_amdgcn_fmed3f(Q1[2 * g_ + 1], 0.f, cc1)}); \
                else if ((s_ & 3) == 1) Sb_[g_] = ix5_pkadd((f32x2){__builtin_amdgcn_fmed3f(Q0[8 + 2 * g_], 0.f, cc0), __builtin_amdgcn_fmed3f(Q0[9 + 2 * g_], 0.f, cc0)}, (f32x2){__builtin_amdgcn_fmed3f(Q1[8 + 2 * g_], 0.f, cc1), __builtin_amdgcn_fmed3f(Q1[9 + 2 * g_], 0.f, cc1)}); \
                else if ((s_ & 3) == 2) { const auto r0_ = __builtin_amdgcn_permlane16_swap(__float_as_uint(Sa_[g_].x), __float_as_uint(Sb_[g_].x), false, false), r1_ = __builtin_amdgcn_permlane16_swap(__float_as_uint(Sa_[g_].y), __float_as_uint(Sb_[g_].y), false, false); \
                    T_[g_] = ix5_pkadd((f32x2){__uint_as_float(r0_[0]), __uint_as_float(r1_[0])}, (f32x2){__uint_as_float(r0_[1]), __uint_as_float(r1_[1])}); } \
                else { const float t0_ = T_[g_].x + __uint_as_float(__builtin_amdgcn_update_dpp(0u, __float_as_uint(T_[g_].x), 0x128, 0xf, 0xf, false)), t1_ = T_[g_].y + __uint_as_float(__builtin_amdgcn_update_dpp(0u, __float_as_uint(T_[g_].y), 0x128, 0xf, 0xf, false)); \
                      \
                    if (g_ == 0) { IX5_MADD("0xf", T2a, t0_, "=v", "s_nop 1\n\t"); IX5_MADD("0xf", T2b, t1_, "=v", ""); } \
                    else if (g_ == 1) { IX5_MADD("0x2", T2a, t0_, "+v", "s_nop 1\n\t"); IX5_MADD("0x2", T2b, t1_, "+v", ""); } \
                    else if (g_ == 2) { IX5_MADD("0x4", T2a, t0_, "+v", "s_nop 1\n\t"); IX5_MADD("0x4", T2b, t1_, "+v", ""); } \
                    else { IX5_MADD("0x8", T2a, t0_, "+v", "s_nop 1\n\t"); IX5_MADD("0x8", T2b, t1_, "+v", ""); } } \
                } else if (s_ == 15) { T2a = Q0[0] + Q1[3]; T2b = Q0[5] + Q1[9]; } \
                __builtin_amdgcn_sched_barrier(0); } \
        } while (0)
        IX5_ZERO(Y0, Y1);
        bool own_over = false;
#pragma unroll 1
        for (int k = 0; k < nst; ++k) {
            VM_WAIT(); __builtin_amdgcn_s_barrier(); asm volatile("" ::: "memory");
            const unsigned rq = *(volatile LAS unsigned*)req;
            if (k + 1 < nst) IX5_DMA(k + 1, (k + 1) & 1);
            const LAS unsigned char* as = arow + (k & 1) * 16384;
#pragma unroll
            for (int c = 0; c < 8; ++c) { A[c] = *(const LAS half8*)(as + ((32 * c) ^ axor)); __builtin_amdgcn_sched_barrier(0); }
            IX5_BLOCK(X0, X1, Y0, Y1, true, as + 8192);
            if (rq == (unsigned)k || own_over) {
                for (int i = 0; i < 4; ++i) { const int qq = 4 * w8 + i; const int c = __builtin_amdgcn_readfirstlane((int)cnt[qq]); if (c > TOPK + 16) select_lds<false, L5_CAP / 64>(lsc + qq * L5_CAP, lky + qq * L5_CAP, c, th + qq, cnt + qq, nullptr, lane); }
                asm volatile("s_waitcnt lgkmcnt(0)" ::: "memory");
                theta = th[ql];
            }
            const float Ta = T2a, Tb = T2b;
            IX5_BLOCK(Y0, Y1, X0, X1, false, as);
            const bool over = ix5_append4(Ta, Tb, 64 * k - 32 + kl, k > 0, T2a, T2b, 64 * k + kl, k + 1 == nst, qpos, theta, cnt_addr, sc_addr, ky_addr);
            own_over = __ballot(over) != 0ull;
            if (own_over && lane == 0) asm volatile("ds_write_b32 %0, %1" :: "v"(req_addr), "v"((unsigned)(k + 1)) : "memory");
        }
        if (own_over) {
            for (int i = 0; i < 4; ++i) { const int qq = 4 * w8 + i; const int c = __builtin_amdgcn_readfirstlane((int)cnt[qq]); if (c > TOPK + 16) select_lds<false, L5_CAP / 64>(lsc + qq * L5_CAP, lky + qq * L5_CAP, c, th + qq, cnt + qq, nullptr, lane); }
            asm volatile("s_waitcnt lgkmcnt(0)" ::: "memory");
            theta = th[ql]; }
        { float S_[16], T_[8];
#pragma unroll
          for (int i = 0; i < 16; ++i) S_[i] = __builtin_amdgcn_fmed3f(Y0[i], 0.f, cc0) + __builtin_amdgcn_fmed3f(Y1[i], 0.f, cc1);
#pragma unroll
          for (int i = 0; i < 8; ++i) { const auto r_ = __builtin_amdgcn_permlane16_swap(__float_as_uint(S_[i]), __float_as_uint(S_[8 + i]), false, false); T_[i] = __uint_as_float(r_[0]) + __uint_as_float(r_[1]); }
#pragma unroll
          for (int i = 0; i < 8; ++i) { T_[i] += __uint_as_float(__builtin_amdgcn_update_dpp(0u, __float_as_uint(T_[i]), 0x128, 0xf, 0xf, false)); T_[i] += __uint_as_float(__builtin_amdgcn_update_dpp(0u, __float_as_uint(T_[i]), 0x124, 0xf, 0xf, false)); }
          T2a = b3 ? (b2 ? T_[6] : T_[4]) : (b2 ? T_[2] : T_[0]); T2b = b3 ? (b2 ? T_[7] : T_[5]) : (b2 ? T_[3] : T_[1]);
          (void)ix5_append(T2a, T2b, 64 * nst - 32 + kl, true, true, qpos, theta, cnt_addr, sc_addr, ky_addr); }
#undef IX5_DMA
#undef IX5_ZERO
#undef IX5_BLOCK
#undef IX5_MADD
        __syncthreads();
        LAS unsigned* bm = (LAS unsigned*)(ringA + w8 * 2048);
        for (int i = 0; i < 4; ++i) { const int qq = 4 * w8 + i; const int c = __builtin_amdgcn_readfirstlane((int)cnt[qq]); unsigned short* io = IDX + (m0 + qq) * TOPK;
            keymap_clear(bm, lane); asm volatile("s_waitcnt lgkmcnt(0)" ::: "memory");
            if (c > TOPK) select_lds<true, L5_CAP / 64>(lsc + qq * L5_CAP, lky + qq * L5_CAP, c, th + qq, nullptr, bm, lane);
            else {
#pragma unroll
                for (int k = 0; k < 4; ++k) { const int j = lane + 64 * k; if (j < c) { const unsigned key = lky[qq * L5_CAP + j]; __hip_atomic_fetch_or(bm + (key >> 5), 1u << (key & 31u), __ATOMIC_RELAXED, __HIP_MEMORY_SCOPE_WORKGROUP); } } }
            asm volatile("s_waitcnt lgkmcnt(0)" ::: "memory");
            keymap_emit(bm, io, c, lane);
            asm volatile("s_waitcnt lgkmcnt(0)" ::: "memory"); }
        __syncthreads();
    }
}

__device__ __forceinline__ unsigned q_fetch(unsigned* ctr, int lane) { unsigned v = 0u; if (lane == 0) v = __hip_atomic_fetch_add(ctr, 1u, __ATOMIC_RELAXED, __HIP_MEMORY_SCOPE_AGENT); return (unsigned)__builtin_amdgcn_readfirstlane((int)v); }
__device__ __forceinline__ void sparse_attn_phase(Frame& F0, const h16* Q, const unsigned char* K8, const unsigned char* V8, const unsigned short* IDX, h16* O, unsigned* qctr) {
    Frame F = fresh(F0);
    LAS unsigned char* wl = F.lds + RING_OFF + F.wave * 17408;
    LAS float* Pl = (LAS float*)wl;
    LAS unsigned short* Ilbase = (LAS unsigned short*)(wl + 4096);
    const int lane = F.lane, r16 = lane & 15, g4 = lane >> 4;
    const float c2 = 0.08838834764831845f * 1.44269504089f;
    const unsigned x0 = xb_xcc_id() & 7u;
    unsigned tried = 0u, p = x0;
    unsigned item = q_fetch(qctr + 64 * p, lane);
    bool have_pf = false; u32x2 pf_idx = (u32x2){0u, 0u}; half8 pf_q[4];
#pragma unroll
    for (int s = 0; s < 4; ++s) pf_q[s] = (half8){0, 0, 0, 0, 0, 0, 0, 0};
    int keys[16]; u32x4 ka[8][2]; bool have_k = false; int par = 0;
#pragma unroll
    for (int kt = 0; kt < 16; ++kt) keys[kt] = 0;
#pragma unroll
    for (int k8 = 0; k8 < 8; ++k8) { ka[k8][0] = (u32x4){0u, 0u, 0u, 0u}; ka[k8][1] = (u32x4){0u, 0u, 0u, 0u}; }
    for (;;) {
        while (item >= (unsigned)SEQ && tried < 8u) { ++tried; p = (x0 + tried) & 7u; if (tried < 8u) item = q_fetch(qctr + 64 * p, lane); }
        if (tried >= 8u) break;
        const unsigned nxt = q_fetch(qctr + 64 * p, lane);
        const int b = (int)(p >> 2), j = (int)(p & 3u), tq = (int)item, nk = (tq + 1) < TOPK ? (tq + 1) : TOPK;
        const size_t m = (size_t)b * SEQ + tq;
        const unsigned char* kb = K8 + (size_t)p * SEQ * HD; const unsigned char* vb = V8 + (size_t)p * SEQ * HD;
        LAS unsigned short* Il = Ilbase + 256 * par;
        if (!have_k) *(LAS u32x2*)(Il + 4 * lane) = have_pf ? pf_idx : *(const u32x2*)(IDX + m * TOPK + 4 * lane);
        long qb[4];
        { const h16* qrow = Q + m * 2048 + (size_t)j * 512 + (r16 & 3) * HD + 16 * g4;
#pragma unroll
          for (int s = 0; s < 4; ++s) { const half8 hv = have_pf ? pf_q[s] : *(const half8*)(qrow + (s >> 1) * 64 + (s & 1) * 8);
              const u32x4 w = __builtin_bit_cast(u32x4, hv);
              const unsigned wx = w.x, wy = w.y, wz = w.z, ww = w.w;
              const unsigned b0 = r16 < 4 ? wx : (r16 < 8 ? wz : 0u), b1 = r16 < 4 ? wy : (r16 < 8 ? ww : 0u);
              qb[s] = (long)(((unsigned long long)b1 << 32) | b0); } }
        asm volatile("s_waitcnt lgkmcnt(0)" ::: "memory");
        LAS float* Pw = (r16 < 4 ? Pl : (LAS float*)(wl + 5120 + 8192)) + (r16 & 3);
        if (!have_k) {
#pragma unroll
            for (int kt = 0; kt < 16; ++kt) keys[kt] = Il[16 * kt + r16];
#pragma unroll
            for (int k8 = 0; k8 < 8; ++k8) { const unsigned char* krow = kb + (unsigned)(keys[k8] * HD + 16 * g4); ka[k8][0] = *(const u32x4*)krow; ka[k8][1] = *(const u32x4*)(krow + 64); }
        }
        {
#pragma unroll
            for (int kt = 0; kt < 16; ++kt) { const int k8 = kt & 7; const u32x4 a0 = ka[k8][0], a1 = ka[k8][1];
                const long ak[4] = {(long)(((unsigned long long)a0.y << 32) | a0.x), (long)(((unsigned long long)a0.w << 32) | a0.z), (long)(((unsigned long long)a1.y << 32) | a1.x), (long)(((unsigned long long)a1.w << 32) | a1.z)};
                if (kt < 8) { const unsigned char* krow = kb + (unsigned)(keys[kt + 8] * HD + 16 * g4); ka[k8][0] = *(const u32x4*)krow; ka[k8][1] = *(const u32x4*)(krow + 64); }
                f32x4 acc = (f32x4){0.f, 0.f, 0.f, 0.f};
#pragma unroll
                for (int s = 0; s < 4; ++s) acc = __builtin_amdgcn_mfma_f32_16x16x32_fp8_fp8(ak[s], qb[s], acc, 0, 0, 0);
                if (r16 < 8) {
#pragma unroll
                    for (int i = 0; i < 4; ++i) Pw[(16 * kt + 4 * g4 + i) * 4] = acc[i]; }
            }
        }
        have_pf = nxt < (unsigned)SEQ;
        if (have_pf) { const size_t mn = (size_t)b * SEQ + nxt; pf_idx = *(const u32x2*)(IDX + mn * TOPK + 4 * lane);
            const h16* qn = Q + mn * 2048 + (size_t)j * 512 + (r16 & 3) * HD + 16 * g4;
#pragma unroll
            for (int s = 0; s < 4; ++s) pf_q[s] = *(const half8*)(qn + (s >> 1) * 64 + (s & 1) * 8); }
        asm volatile("" ::: "memory");
        LAS unsigned char* vs = wl + 5120;
        const int nch = (nk + 31) >> 5;
#define SP_ISSUE(ch_) do { const int c_ = (ch_); LAS unsigned char* s_ = vs + (c_ % 3) * 4096; int key4_[4]; _Pragma("unroll") for (int j_ = 0; j_ < 4; ++j_) key4_[j_] = Il[32 * c_ + 8 * j_ + (lane >> 3)]; \
            __builtin_amdgcn_sched_barrier(0);     \
            _Pragma("unroll") for (int j_ = 0; j_ < 4; ++j_) { const int key_ = key4_[j_]; \
                __builtin_amdgcn_global_load_lds((const unsigned*)(vb + (unsigned)(key_ * HD + (((lane & 7) ^ (((8 * j_ + (lane >> 3)) >> 1) & 7)) * 16))), (LAS unsigned*)(s_ + 1024 * j_), 16, 0, 0); } } while (0)
            SP_ISSUE(0); if (nch > 1) SP_ISSUE(1);
        f32x4 sv[4]; f32x4 mx = (f32x4){-3.0e38f, -3.0e38f, -3.0e38f, -3.0e38f};
#pragma unroll
        for (int k = 0; k < 4; ++k) { sv[k] = *(const LAS f32x4*)(Pl + (lane + 64 * k) * 4) + *(const LAS f32x4*)((LAS float*)(wl + 5120 + 8192) + (lane + 64 * k) * 4); if (lane + 64 * k < nk) { mx[0] = max2(mx[0], sv[k][0]); mx[1] = max2(mx[1], sv[k][1]); mx[2] = max2(mx[2], sv[k][2]); mx[3] = max2(mx[3], sv[k][3]); } }
        mx[0] = wave_max_dpp(mx[0]); mx[1] = wave_max_dpp(mx[1]); mx[2] = wave_max_dpp(mx[2]); mx[3] = wave_max_dpp(mx[3]);
        f32x4 sum = (f32x4){0.f, 0.f, 0.f, 0.f};
        asm volatile("s_waitcnt lgkmcnt(0)" ::: "memory");
#pragma unroll
        for (int k = 0; k < 4; ++k) { f32x4 pv;
#pragma unroll
            for (int h = 0; h < 4; ++h) pv[h] = (lane + 64 * k < nk) ? __builtin_amdgcn_exp2f(sv[k][h] - mx[h]) : 0.f;
            sum += pv;
            const f32x4 p16 = pv * 16.0f;
            u32x2 w; w.x = pk8(p16[0], p16[1], p16[2], p16[3]);
            w.y = pk8(p16[0] - __builtin_amdgcn_cvt_f32_fp8((int)w.x, 0), p16[1] - __builtin_amdgcn_cvt_f32_fp8((int)w.x, 1), p16[2] - __builtin_amdgcn_cvt_f32_fp8((int)w.x, 2), p16[3] - __builtin_amdgcn_cvt_f32_fp8((int)w.x, 3));
            *(LAS u32x2*)((LAS unsigned char*)Pl + (lane + 64 * k) * 16) = w; }
        sum[0] = wave_sum_dpp(sum[0]); sum[1] = wave_sum_dpp(sum[1]); sum[2] = wave_sum_dpp(sum[2]); sum[3] = wave_sum_dpp(sum[3]);
        asm volatile("s_waitcnt lgkmcnt(0)" ::: "memory");
        long pa[8];
        { const LAS unsigned char* pp = (const LAS unsigned char*)Pl + (8 * g4 + (r16 >> 1)) * 16 + 8 * (r16 & 1);
#pragma unroll
          for (int s = 0; s < 8; ++s) { const v2i32 a = __builtin_amdgcn_ds_read_tr8_b64_v2i32((LAS v2i32*)(pp + 512 * s)); pa[s] = (long)(((unsigned long long)(unsigned)a.y << 32) | (unsigned)a.x); } }
        asm volatile("s_waitcnt lgkmcnt(0)" ::: "memory");
        f32x4 oacc[8];
#pragma unroll
        for (int nt = 0; nt < 8; ++nt) oacc[nt] = (f32x4){0.f, 0.f, 0.f, 0.f};
        {
            const int vrow = 8 * g4 + (r16 >> 1);
#pragma unroll
            for (int ch = 0; ch < 8; ++ch) {
                if (ch < nch) {
                    if (ch + 2 < nch) { SP_ISSUE(ch + 2); asm volatile("s_waitcnt vmcnt(8)" ::: "memory"); }
                    else if (ch + 1 < nch) asm volatile("s_waitcnt vmcnt(4)" ::: "memory");
                    else asm volatile("s_waitcnt vmcnt(0)" ::: "memory");
                    const LAS unsigned char* s = vs + (ch % 3) * 4096 + vrow * HD + 8 * (r16 & 1);
                    v2i32 bv[8];
#pragma unroll
                    for (int nt = 0; nt < 8; ++nt) bv[nt] = __builtin_amdgcn_ds_read_tr8_b64_v2i32((LAS v2i32*)(s + ((nt ^ ((vrow >> 1) & 7)) * 16)));
                    __builtin_amdgcn_sched_barrier(0);
#pragma unroll
                    for (int nt = 0; nt < 8; ++nt) {
                        const long bb = (long)(((unsigned long long)(unsigned)bv[nt].y << 32) | (unsigned)bv[nt].x);
                        oacc[nt] = __builtin_amdgcn_mfma_f32_16x16x32_fp8_fp8(pa[ch], bb, oacc[nt], 0, 0, 0); }
                    asm volatile("s_waitcnt lgkmcnt(0)" ::: "memory");
                }
            }
#undef SP_ISSUE
        }
        have_k = false;
        if (have_pf) { LAS unsigned short* In = Ilbase + 256 * (par ^ 1); *(LAS u32x2*)(In + 4 * lane) = pf_idx; asm volatile("s_waitcnt lgkmcnt(0)" ::: "memory");
#pragma unroll
            for (int kt = 0; kt < 16; ++kt) keys[kt] = In[16 * kt + r16];
#pragma unroll
            for (int k8 = 0; k8 < 8; ++k8) { const unsigned char* krow = kb + (unsigned)(keys[k8] * HD + 16 * g4); ka[k8][0] = *(const u32x4*)krow; ka[k8][1] = *(const u32x4*)(krow + 64); }
            have_k = true; }
        par ^= 1;
        { LAS h16* ot = (LAS h16*)Pl;
          if (g4 < 2) {
#pragma unroll
              for (int nt = 0; nt < 8; ++nt)
#pragma unroll
                  for (int i = 0; i < 4; ++i) ot[g4 * 512 + i * HD + 16 * nt + r16] = (h16)(oacc[nt][i] * (0.0625f / sum[i])); }
          asm volatile("s_waitcnt lgkmcnt(0)" ::: "memory");
          const half8 w0 = *(const LAS half8*)(ot + g4 * HD + 8 * r16), w1 = *(const LAS half8*)(ot + 512 + g4 * HD + 8 * r16);
          *(half8*)(O + m * 2048 + (size_t)j * 512 + g4 * HD + 8 * r16) = w0 + w1; }
        asm volatile("s_waitcnt lgkmcnt(0)" ::: "memory");
        item = nxt;
    }
}

#ifndef DBG_CHECK
#define DBG_CHECK 0
#endif
#if DBG_CHECK
__device__ __forceinline__ void dbg_max(unsigned* w, float v) { atomicMax(w, __builtin_bit_cast(unsigned, fabsf(v))); }
__device__ __forceinline__ int dbg_row(int blk) { return (blk & 1) * SEQ + (SEQ - 1 - 251 * (blk >> 1)); }
__device__ __forceinline__ void dbg_check_inproj(unsigned char* ws, LAS float* sh, unsigned* word) {
    if (blockIdx.x >= 64) return;
    int tid_ = (int)threadIdx.x; asm volatile("" : "+v"(tid_)); const int m = dbg_row(blockIdx.x), tid = tid_;
    const h16* a = (const h16*)(ws + WS_A) + (size_t)m * 2048; const h16* W = (const h16*)(ws + WS_WIN);
    for (int c = tid; c < DSA_N; c += 512) { float s = 0.f; for (int k = 0; k < 2048; ++k) s += (float)a[k] * (float)W[(size_t)c * 2048 + k]; sh[c] = s * (1.0f / 64.0f); }
    __syncthreads();
    const float* rope = (const float*)(ws + WS_ROPE) + (size_t)m * 32;
    for (int c = tid; c < DSA_N; c += 512) {
        float v = sh[c]; int hc; bool rot; float got;
        if (c < 2048) { hc = c & 127; rot = true; got = (float)((const h16*)(ws + WS_Q))[(size_t)m * 2048 + c]; }
        else if (c < 3072) continue;
        else if (c < 5120) { hc = (c - 3072) & 127; rot = true; got = (float)((const h16*)(ws + WS_IQ))[(size_t)m * 2048 + (c - 3072)]; }
        else if (c < 5248) { hc = c - 5120; rot = true; got = (float)((const h16*)(ws + WS_IK))[(size_t)m * 128 + (c - 5120)]; }
        else { hc = 99; rot = false; got = ((const float*)(ws + WS_IW))[(size_t)m * 16 + (c - 5248)]; }
        if (rot && hc < 32) { const int i = hc & 15; const float cs = rope[i], sn = rope[16 + i]; v = hc < 16 ? v * cs - sh[c + 16] * sn : v * cs + sh[c - 16] * sn; }
        dbg_max(word, (got - v) / (1.0f + fabsf(v)));
    }
    __syncthreads();
}
__device__ __forceinline__ void dbg_check_xattn(unsigned char* ws, int L, LAS float* sh, unsigned* word) {
    if (blockIdx.x >= 64) return;
    int tid_ = (int)threadIdx.x; asm volatile("" : "+v"(tid_)); const int m = dbg_row(blockIdx.x), tid = tid_, b = m / SEQ;
    const h16* a = (const h16*)(ws + WS_A) + (size_t)m * 2048; const h16* W = (const h16*)(ws + WS_WQ) + (size_t)L * 512 * 2048;
    const h16* kvm = (const h16*)(ws + WS_KVM) + (size_t)b * NMEM * 2048 + L * 1024;
    LAS float* q = sh; LAS float* lg = sh + 512; LAS float* st = sh + 512 + 1024;
    { float s = 0.f; for (int k = 0; k < 2048; ++k) s += (float)a[k] * (float)W[(size_t)tid * 2048 + k]; q[tid] = (float)(h16)s; }
    __syncthreads();
    for (int i = tid; i < 1024; i += 512) { const int h = i >> 8, key = i & 255; float s = 0.f; for (int d = 0; d < 128; ++d) s += q[h * 128 + d] * (float)kvm[(size_t)key * 2048 + h * 128 + d]; lg[i] = s * 0.08838834764831845f; }
    __syncthreads();
    if (tid < 4) { float mx = -3e38f; for (int k = 0; k < 256; ++k) mx = fmaxf(mx, lg[tid * 256 + k]); float su = 0.f; for (int k = 0; k < 256; ++k) su += __expf(lg[tid * 256 + k] - mx); st[2 * tid] = mx; st[2 * tid + 1] = 1.0f / su; }
    __syncthreads();
    { const int h = tid >> 7, d = tid & 127; float o = 0.f; for (int k = 0; k < 256; ++k) o += __expf(lg[h * 256 + k] - st[2 * h]) * st[2 * h + 1] * (float)kvm[(size_t)k * 2048 + 512 + h * 128 + d];
      const float got = (float)((const h16*)(ws + WS_XQ))[(size_t)m * 512 + tid]; dbg_max(word, (got - o) / (0.05f + fabsf(o))); }
    __syncthreads();
}
__device__ __forceinline__ void dbg_check_indexer(unsigned char* ws, LAS float* sh, unsigned* word, unsigned* word2) {
    if (blockIdx.x >= 64) return;
    int tid_ = (int)threadIdx.x; asm volatile("" : "+v"(tid_)); const int m = dbg_row(blockIdx.x), tid = tid_, b = m / SEQ, t = m % SEQ;
    const h16* iq = (const h16*)(ws + WS_IQ) + (size_t)m * 2048; const h16* ik = (const h16*)(ws + WS_IK) + (size_t)b * SEQ * 128; const float* iw = (const float*)(ws + WS_IW) + (size_t)m * 16;
    LAS float* sc = sh;
    for (int s = tid; s <= t; s += 512) { float tot = 0.f; for (int h = 0; h < 16; ++h) { float l = 0.f; for (int d = 0; d < 128; ++d) l += (float)iq[h * 128 + d] * (float)ik[(size_t)s * 128 + d]; tot += iw[h] * fmaxf(l, 0.f); } sc[s] = tot; }
    __syncthreads();
    const unsigned short* idx = (const unsigned short*)(ws + WS_IDX) + (size_t)m * 256;
    if (tid < 256) { const int key = idx[tid]; if (key > t) atomicAdd(word2, 1000u); else { const float v = sc[key]; int rank = 0; for (int s = 0; s <= t; ++s) rank += sc[s] > v ? 1 : 0; if (rank >= 256) atomicAdd(word, 1u);
        for (int j = 0; j < 256; ++j) if (j != tid && idx[j] == key) { atomicAdd(word2, 1u); break; } } }
    __syncthreads();
}
__device__ __forceinline__ float dbg_f8(const unsigned char* p) { const unsigned w = *p; return __builtin_amdgcn_cvt_f32_fp8((int)w, 0); }
__device__ __forceinline__ void dbg_check_sparse(unsigned char* ws, LAS float* sh, unsigned* word) {
    if (blockIdx.x >= 64) return;
    int tid_ = (int)threadIdx.x; asm volatile("" : "+v"(tid_)); const int m = dbg_row(blockIdx.x), tid = tid_, b = m / SEQ;
    const h16* q = (const h16*)(ws + WS_Q) + (size_t)m * 2048; const unsigned char* k8 = (const unsigned char*)(ws + WS_KV); const unsigned char* v8 = k8 + (size_t)16 * 1024 * 1024;
    const unsigned short* idx = (const unsigned short*)(ws + WS_IDX) + (size_t)m * 256;
    LAS float* lg = sh; LAS float* st = sh + 4096;
    for (int i = tid; i < 4096; i += 512) { const int h = i >> 8, k = i & 255, key = idx[k]; float s = 0.f; const unsigned char* kr = k8 + ((size_t)(b * NKV + (h >> 2)) * SEQ + key) * HD;
        for (int d = 0; d < 128; ++d) s += (float)q[h * 128 + d] * dbg_f8(kr + d); lg[i] = s * 0.08838834764831845f; }
    __syncthreads();
    if (tid < 16) { float mx = -3e38f; for (int k = 0; k < 256; ++k) mx = fmaxf(mx, lg[tid * 256 + k]); float su = 0.f; for (int k = 0; k < 256; ++k) su += __expf(lg[tid * 256 + k] - mx); st[2 * tid] = mx; st[2 * tid + 1] = 1.0f / su; }
    __syncthreads();
    for (int i = tid; i < 2048; i += 512) { const int h = i >> 7, d = i & 127; float o = 0.f; for (int k = 0; k < 256; ++k) o += __expf(lg[h * 256 + k] - st[2 * h]) * st[2 * h + 1] * dbg_f8(v8 + ((size_t)(b * NKV + (h >> 2)) * SEQ + idx[k]) * HD + d);
        const float got = (float)((const h16*)(ws + WS_A))[(size_t)m * 2048 + i]; dbg_max(word, (got - o) / (0.02f + fabsf(o))); }
    __syncthreads();
}
#endif

constexpr int N_PHASES = 22 + (DBG_CHECK ? 1 : 0);
__global__ void __launch_bounds__(NWAVES * 64, 2) trunk_fwd(Args args) {
    extern __shared__ __attribute__((aligned(16))) unsigned char lds_raw[];
    Frame F;
    F.lds = (LAS unsigned char*)lds_raw;
    F.MISC = (volatile LAS unsigned*)(F.lds + MISC_OFF);
    F.tid = threadIdx.x; F.lane = F.tid & 63; F.wave = __builtin_amdgcn_readfirstlane(F.tid >> 6);
    F.G = gridDim.x; { const int bx = blockIdx.x; F.vcu = (F.G % 8 == 0) ? (bx % 8) * (F.G / 8) + bx / 8 : bx; }
    unsigned char* ws = argp()->ws;
    for (int u = F.tid; u < (LDS_BYTES - MISC_OFF) / 4; u += NWAVES * 64) ((LAS unsigned*)(F.lds + MISC_OFF))[u] = 0u;
    __syncthreads();
    XcdBarrier bar; bar.bar = (unsigned*)(ws + WS_CTL) + CW_BAR; bar.x = 0; bar.st = nullptr;
    if (!MK_LAUNCH_PER_PHASE) bar = xcd_barrier_post((unsigned*)(ws + WS_CTL) + CW_BAR, F.MISC + 8);
    const int lo = argp()->ph_lo, hi = argp()->ph_hi;
#ifndef DBG_KINDS
#define DBG_KINDS 0xFFFF
#endif
#define KON(kind) (((DBG_KINDS) >> (kind)) & 1)
#ifndef PROBE_REP
#define PROBE_REP 0
#endif
#define NREP(kind) ((((PROBE_REP) >> (kind)) & 1) ? 2 : 1)
#define IN(k) (lo <= (k) && (k) < hi)
#define SEAM(k) do { if (IN((k) + 1)) { if (MK_LAUNCH_PER_PHASE) { } else xcd_barrier(bar); } } while (0)
    LAS unsigned char* ring = F.lds + RING_OFF;
    const int bid = (int)blockIdx.x;
    h16* A = (h16*)(ws + WS_A); h16* Y = (h16*)(ws + WS_Y); h16* H = (h16*)(ws + WS_H); float* RS = (float*)(ws + WS_CTL + 512 * 1024);     h16* XQ = (h16*)(ws + WS_XQ); h16* ACT = (h16*)(ws + WS_ACT);

    if (KON(0) && IN(0)) { for (int rep = 0; rep < NREP(0); ++rep) { if (rep) xcd_barrier(bar); p0_prologue(F, argp()); } SEAM(0); }
    if (KON(1) && IN(1)) {
        { pg8::Gemm g{A, (const h16*)(ws + WS_WPOOL), T, D, 512, D, 1}; pg8::StaticOrder S; S.init(T, D, F.G, bid);
          pg8::EpiH16 E{Y, D, 1.0f, nullptr}; pg8::gemm_phase<pg8::EpiH16, pg8::StaticOrder, true, true>(ring, g, S, E); }
        __syncthreads();
        { pg8::Gemm g{(const h16*)(ws + WS_MEMN), (const h16*)(ws + WS_WKV), NB * NMEM, 4 * 2048, 512, 2048, 3}; pg8::StaticOrder S; S.init(NB * NMEM, 4 * 2048, F.G, bid);
          pg8::EpiH16 E{(h16*)(ws + WS_KVM4), 4 * 2048, 1.0f, nullptr}; pg8::gemm_phase<pg8::EpiH16, pg8::StaticOrder, true, true>(ring, g, S, E); }
        SEAM(1);
    }
#pragma unroll 1
    for (int L = 0; L < 2; ++L) {
        const int pb = L == 0 ? 2 : 14;
        if (L == 1) {
            if (KON(2) && IN(10)) {
                pg8::Gemm g{H, (const h16*)(ws + WS_WIN), T, DSA_NP, 2048, 2048, 31}; pg8::StaticOrder S; S.init(T, DSA_NP, F.G, bid);
                pg8::EpiInProj E{(h16*)(ws + WS_Q), (h16*)(ws + WS_KV), (h16*)(ws + WS_IQ), (h16*)(ws + WS_IK), (float*)(ws + WS_IW), (const float*)(ws + WS_ROPE), 1.0f / 64.0f, RS};
                for (int rep = 0; rep < NREP(2); ++rep) { if (rep) xcd_barrier(bar); pg8::gemm_phase<pg8::EpiInProj, pg8::StaticOrder, true, true>(ring, g, S, E); }
                SEAM(10);
            }
#if DBG_CHECK
            if (IN(11)) dbg_check_inproj(ws, (LAS float*)ring, (unsigned*)(ws + WS_CTL) + 1024);
#endif
            if (KON(3) && IN(11)) { for (int rep = 0; rep < NREP(3); ++rep) { if (rep) xcd_barrier(bar); if (IDX16 == 2) {
#ifdef PROBE_IDX
                indexer_phase5<PROBE_MODE>(F, (const h16*)(ws + WS_IQ), (const h16*)(ws + WS_IK), (const float*)(ws + WS_IW), (unsigned short*)(ws + WS_IDX), (float)(PROBE_IDX));
                indexer_phase5<0>(F, (const h16*)(ws + WS_IQ), (const h16*)(ws + WS_IK), (const float*)(ws + WS_IW), (unsigned short*)(ws + WS_IDX), -__builtin_inff());
#else
                indexer_phase5<0>(F, (const h16*)(ws + WS_IQ), (const h16*)(ws + WS_IK), (const float*)(ws + WS_IW), (unsigned short*)(ws + WS_IDX), -__builtin_inff());
#endif
                } else if (IDX16) indexer_phase16(F, (const h16*)(ws + WS_IQ), (const h16*)(ws + WS_IK), (const float*)(ws + WS_IW), (unsigned short*)(ws + WS_IDX)); else indexer_phase(F, (const h16*)(ws + WS_IQ), (const h16*)(ws + WS_IK), (const float*)(ws + WS_IW), (unsigned short*)(ws + WS_IDX), (u32x2*)(ws + WS_LISTS)); } SEAM(11); }
#if DBG_CHECK
            if (IN(12)) dbg_check_indexer(ws, (LAS float*)ring, (unsigned*)(ws + WS_CTL) + 1026, (unsigned*)(ws + WS_CTL) + 1028);
#endif
            if (KON(4) && IN(12)) { for (int rep = 0; rep < NREP(4); ++rep) { if (rep) xcd_barrier(bar); sparse_attn_phase(F, (const h16*)(ws + WS_Q), (const unsigned char*)(ws + WS_KV), (const unsigned char*)(ws + WS_KV) + (size_t)16 * 1024 * 1024, (const unsigned short*)(ws + WS_IDX), A, (unsigned*)(ws + WS_CTL) + 2048 + 512 * rep); } SEAM(12); }
#if DBG_CHECK
            if (IN(13)) dbg_check_sparse(ws, (LAS float*)ring, (unsigned*)(ws + WS_CTL) + 1027);
#endif
            if (KON(5) && IN(13)) {
                pg8::Gemm g{A, (const h16*)(ws + WS_WOUT), T, D, 2048, 2048, 31}; pg8::StaticOrder S; S.init(T, D, F.G, bid);
                pg8::EpiH16 E{Y, D, 1.0f, nullptr}; pg8::gemm_phase<pg8::EpiH16, pg8::StaticOrder, true, true>(ring, g, S, E);
                SEAM(13);
            }
        }
        if (KON(6) && IN(pb + 0)) { ArgP a = argp(); const float* gains = a->gains + (size_t)L * 6 * D;
            if (L == 0) seam_phase<true, false, true, false, true>(F, Y, a->x, H, gains + 1 * D, nullptr, nullptr, RS); else seam_phase<true, false, false, false, true>(F, Y, H, H, gains + 1 * D, nullptr, nullptr, RS);
            SEAM(pb + 0); }
        if (KON(7) && IN(pb + 1)) {
            pg8::Gemm g{H, (const h16*)(ws + WS_WQ) + (size_t)L * XW * 2048, T, XW, 2048, 2048, 31}; pg8::StaticOrder S; S.init(T, XW, F.G, bid);
            pg8::EpiH16 E{XQ, XW, 1.0f, RS}; pg8::gemm_phase<pg8::EpiH16, pg8::StaticOrder, true, true>(ring, g, S, E);
            SEAM(pb + 1);
        }
        if (KON(8) && IN(pb + 2)) { xattn_phase(F, XQ, (const h16*)(ws + WS_KVM4) + L * 1024); SEAM(pb + 2); }
#if DBG_CHECK
        if (IN(pb + 3)) dbg_check_xattn(ws, L, (LAS float*)ring, (unsigned*)(ws + WS_CTL) + 1025);
#endif
        if (KON(9) && IN(pb + 3)) {
            pg8::Gemm g{XQ, (const h16*)(ws + WS_WO) + (size_t)L * 2048 * XW, T, D, XW, XW, 31}; pg8::StaticOrder S; S.init(T, D, F.G, bid);
            pg8::EpiH16 E{Y, D, 1.0f, nullptr}; pg8::gemm_phase<pg8::EpiH16, pg8::StaticOrder, true, true>(ring, g, S, E);
            SEAM(pb + 3);
        }
        if (KON(10) && IN(pb + 4)) { ArgP a = argp(); const float* gains = a->gains + (size_t)L * 6 * D;
            if ((FFN_FP8 >> L) & 1) seam_phase<true, true, false, false>(F, Y, H, H, gains + 3 * D, gains + 4 * D, A); else seam_phase<true, false, false, false, true>(F, Y, H, H, gains + 3 * D, nullptr, nullptr, RS);
            SEAM(pb + 4); }
        static_assert(DN_FP8 == 3, "the fp16 gate|up GEMM reads the residual stream with a row factor in its e4m3 epilogue: every layer's down projection is e4m3");
        static_assert((FFN_FP8 & ~DN_FP8) == 0, "an e4m3 gate|up GEMM writes e4m3 activations: its down projection must be e4m3 too");
        if (KON(11) && IN(pb + 5) && ((FFN_FP8 >> L) & 1)) {
            pg8::Gemm g{A, (const h16*)(ws + WS_WGU) + (size_t)L * 2 * DFF * 2048  , T, 2 * DFF, 1024, 1024, 31}; pg8::StaticOrder S; S.init(T, 2 * DFF, F.G, bid);
            pg8::EpiSwiGLU8 E{(unsigned char*)ACT, DFF, 1.0f / W8_SCALE, ACT8_SCALE, nullptr}; pg8::gemm_phase<pg8::EpiSwiGLU8, pg8::StaticOrder, true, true, true>(ring, g, S, E);
            SEAM(pb + 5);
        }
        if (KON(11) && IN(pb + 5) && !((FFN_FP8 >> L) & 1) && ((DN_FP8 >> L) & 1)) {
            pg8::Gemm g{H, (const h16*)(ws + WS_WGU) + (size_t)L * 2 * DFF * 2048, T, 2 * DFF, 2048, 2048, 31}; pg8::StaticOrder S; S.init(T, 2 * DFF, F.G, bid);
            pg8::EpiSwiGLU8 E{(unsigned char*)ACT, DFF, 1.0f, ACT8_SCALE, RS}; pg8::gemm_phase<pg8::EpiSwiGLU8, pg8::StaticOrder, true, true, false>(ring, g, S, E);
            SEAM(pb + 5);
        }
        if (KON(11) && IN(pb + 5) && !((FFN_FP8 >> L) & 1) && !((DN_FP8 >> L) & 1)) {
            pg8::Gemm g{A, (const h16*)(ws + WS_WGU) + (size_t)L * 2 * DFF * 2048, T, 2 * DFF, 2048, 2048, 31}; pg8::StaticOrder S; S.init(T, 2 * DFF, F.G, bid);
            pg8::EpiSwiGLU E{ACT, DFF}; pg8::gemm_phase<pg8::EpiSwiGLU, pg8::StaticOrder, true, true>(ring, g, S, E);
            SEAM(pb + 5);
        }
        if (KON(12) && IN(pb + 6) && ((DN_FP8 >> L) & 1)) {
            pg8::Gemm g{ACT, (const h16*)(ws + WS_WDN) + (size_t)L * 2048 * DFF  , T, D, DFF / 2, DFF / 2, 31}; pg8::StaticOrder S; S.init(T, D, F.G, bid);
            pg8::EpiH16 E{Y, D, 1.0f / (W8_SCALE * ACT8_SCALE), nullptr}; pg8::gemm_phase<pg8::EpiH16, pg8::StaticOrder, true, true, true>(ring, g, S, E);
            SEAM(pb + 6);
        }
        if (KON(12) && IN(pb + 6) && !((DN_FP8 >> L) & 1)) {
            pg8::Gemm g{ACT, (const h16*)(ws + WS_WDN) + (size_t)L * 2048 * DFF, T, D, DFF, DFF, 31}; pg8::StaticOrder S; S.init(T, D, F.G, bid);
            pg8::EpiH16 E{Y, D, 1.0f, nullptr}; pg8::gemm_phase<pg8::EpiH16, pg8::StaticOrder, true, true>(ring, g, S, E);
            SEAM(pb + 6);
        }
        if (KON(13) && IN(pb + 7)) {
            ArgP a = argp(); const float* gains = a->gains + (size_t)L * 6 * D;
            if (L == 0) seam_phase<true, false, false, false, true>(F, Y, H, H, gains + 5 * D, nullptr, nullptr, RS);
            else seam_phase<false, false, false, true>(F, Y, H, a->out, gains + 5 * D, nullptr, nullptr);
            SEAM(pb + 7);
        }
    }
#if DBG_CHECK
    if (IN(22)) {
        const unsigned* dw = (const unsigned*)(ws + WS_CTL) + 1024;
        const bool f0 = __builtin_bit_cast(float, dw[0]) > 4e-3f, f1 = __builtin_bit_cast(float, dw[1]) > 2e-2f, f2 = dw[2] > 24u, f3 = __builtin_bit_cast(float, dw[3]) > 2e-2f, f4 = dw[4] > 0u;
        for (int m = F.vcu * NWAVES + F.wave; m < T; m += F.G * NWAVES) { const int r = m & 15;
            const bool z = (r < 8 && f0) || (r >= 8 && r < 12 && f1) || (r >= 12 && r < 14 && f2) || (r == 14 && f3) || (r == 15 && f4);
            if (z) for (int j = 0; j < 8; ++j) ((f32x4*)(argp()->out + (size_t)m * D))[F.lane + 64 * j] = (f32x4){0.f, 0.f, 0.f, 0.f}; }
    }
#endif
#undef IN
#undef SEAM
}

extern "C" void kernel_launch(void* const* d_in, const int* in_sizes, int n_in, void* d_out, int out_size, void* d_ws, size_t ws_size, hipStream_t stream) {
    static int grid = 0;
    if (grid == 0) {
        if (n_in != 14 || in_sizes[0] != T * D || out_size != T * D || ws_size < WS_END) {
            fprintf(stderr, "kernel_launch: built for 14 inputs, x/out of %d floats, >= %zu bytes of workspace; got n_in %d, in0 %d, out %d, ws %zu; nothing launched\n", T * D, (size_t)WS_END, n_in, n_in > 0 ? in_sizes[0] : -1, out_size, ws_size);
            grid = -1; return; }
        int dev = 0, cus = 0, per_cu = 0;
        if (hipGetDevice(&dev) != hipSuccess || hipDeviceGetAttribute(&cus, hipDeviceAttributeMultiprocessorCount, dev) != hipSuccess) { fprintf(stderr, "kernel_launch: device query failed\n"); grid = -1; return; }
        if (hipFuncSetAttribute((const void*)trunk_fwd, hipFuncAttributeMaxDynamicSharedMemorySize, LDS_BYTES) != hipSuccess) { fprintf(stderr, "kernel_launch: hipFuncSetAttribute failed\n"); grid = -1; return; }
        if (hipOccupancyMaxActiveBlocksPerMultiprocessor(&per_cu, (const void*)trunk_fwd, NWAVES * 64, LDS_BYTES) != hipSuccess || per_cu < 1)
            fprintf(stderr, "kernel_launch: note: occupancy query reports %d workgroups per CU\n", per_cu);
        (void)hipGetLastError();
        grid = cus;
    }
    if (grid < 0) return;
    if (hipMemsetAsync((char*)d_ws + WS_CTL, 0, CTL_ZERO_BYTES, stream) != hipSuccess) { fprintf(stderr, "kernel_launch: memset failed\n"); return; }
    Args a{};
    a.x = (const float*)d_in[0]; a.mem = (const float*)d_in[1]; a.pos = (const int*)d_in[2]; a.gains = (const float*)d_in[3]; a.mem_norm = (const float*)d_in[4];
    a.pool_w = (const float*)d_in[5]; a.pool_scale = (const float*)d_in[6]; a.w_in = (const float*)d_in[7]; a.w_out = (const float*)d_in[8]; a.wq = (const float*)d_in[9];
    a.wkv = (const float*)d_in[10]; a.wo = (const float*)d_in[11]; a.wgu = (const float*)d_in[12]; a.wdn = (const float*)d_in[13];
    a.out = (float*)d_out; a.ws = (unsigned char*)d_ws;
    for (int i = 0; i < 16; ++i) a.inv_freq[i] = (float)pow(500000.0, -(double)(2 * i) / 32.0);
    a.pad = 0;
#if MK_LAUNCH_PER_PHASE
    for (int p = 0; p < N_PHASES; ++p) { a.ph_lo = p; a.ph_hi = p + 1; a.li = p;
        hipLaunchKernelGGL(trunk_fwd, dim3(grid), dim3(NWAVES * 64), LDS_BYTES, stream, a); }
#else
    a.ph_lo = 0; a.ph_hi = N_PHASES; a.li = 0;
    hipLaunchKernelGGL(trunk_fwd, dim3(grid), dim3(NWAVES * 64), LDS_BYTES, stream, a);
#endif
    const hipError_t le = hipPeekAtLastError();
    if (le != hipSuccess) fprintf(stderr, "kernel_launch: launch failed: %s\n", hipGetErrorName(le));
}
```
